# Optimizing an MI355X kernel written in HIP

```python
import jax, jax.numpy as jnp
from jax import lax
import numpy as np

D_MODEL = 1024
BATCH = 32
SEQ = 256
DEPTH = 2
DEC_BATCH = 8
DEC_SEQ = 1024
PAST_LEN = 256

GRID_W = 64
Q_BLOCK = 128
CHUNK = 128
HEAD_DIM = 64
ATTN_W = D_MODEL // 2
N_HEADS = ATTN_W // HEAD_DIM
N_KV_HEADS = N_HEADS // 4
KV_W = N_KV_HEADS * HEAD_DIM
LRU_W = D_MODEL // 4
LRU_BLOCKS = 4
LRU_BW = LRU_W // LRU_BLOCKS
CONV_W = 4
RG_C = 8.0
MLP_W = D_MODEL // 4
MLP_GROUPS = 4
MLP_GW = MLP_W // MLP_GROUPS
MIX_W = ATTN_W + LRU_W + MLP_W
IN_W = ATTN_W + 2 * KV_W + 2 * LRU_W + 2 * MLP_W
SPLITS = (ATTN_W, ATTN_W + KV_W, ATTN_W + 2 * KV_W,
          ATTN_W + 2 * KV_W + LRU_W, ATTN_W + 2 * KV_W + 2 * LRU_W)
D_FF = 4 * D_MODEL
ROPE_THETA = 10000.0
ALPHA = (2 * DEPTH) ** 0.25
BETA = (8 * DEPTH) ** -0.25
EPS = 1e-6

kernel_name = "hybrid_diffusion_parallel_groups_step"


def _layernorm(x, g, b):
    xf = x.astype(jnp.float32)
    mu = jnp.mean(xf, -1, keepdims=True)
    var = jnp.mean(jnp.square(xf - mu), -1, keepdims=True)
    return ((xf - mu) * lax.rsqrt(var + EPS) * g + b).astype(x.dtype)


def _rmsnorm(x, g):
    xf = x.astype(jnp.float32)
    return (xf * lax.rsqrt(jnp.mean(xf * xf, -1, keepdims=True) + EPS) * g).astype(x.dtype)


def _axial_rope(x):
    L = x.shape[1]
    rows = L // GRID_W
    pos_row = jnp.repeat(jnp.arange(rows), GRID_W).astype(jnp.float32)
    pos_col = jnp.tile(jnp.arange(GRID_W), rows).astype(jnp.float32)
    n_f = HEAD_DIM // 4
    inv = ROPE_THETA ** (-jnp.arange(n_f, dtype=jnp.float32) / n_f)
    ang = jnp.concatenate([pos_row[:, None] * inv, pos_col[:, None] * inv], -1)
    cos = jnp.cos(ang)[None, :, None, :]
    sin = jnp.sin(ang)[None, :, None, :]
    x1 = x[..., 0::2].astype(jnp.float32)
    x2 = x[..., 1::2].astype(jnp.float32)
    o = jnp.stack([x1 * cos - x2 * sin, x1 * sin + x2 * cos], -1)
    return o.reshape(x.shape).astype(x.dtype)


def _block_attention(q, k, v):
    B, Lq = q.shape[:2]
    G = N_HEADS // N_KV_HEADS
    nb = Lq // Q_BLOCK
    qb = q.reshape(B, nb, Q_BLOCK, N_KV_HEADS, G, HEAD_DIM).transpose(1, 0, 2, 3, 4, 5)
    scale = HEAD_DIM ** -0.5

    def one_block(qblk):
        s = jnp.einsum('bqkgd,btkd->bkgqt', qblk, k).astype(jnp.float32) * scale
        p = jax.nn.softmax(s, axis=-1).astype(v.dtype)
        return jnp.einsum('bkgqt,btkd->bqkgd', p, v)

    o = lax.map(one_block, qb)
    return o.transpose(1, 0, 2, 3, 4, 5).reshape(B, Lq, ATTN_W)


def _dwconv(x, w, b):
    L = x.shape[1]
    left = (CONV_W - 1) // 2
    right = CONV_W - 1 - left
    xp = jnp.pad(x, ((0, 0), (left, right), (0, 0)))
    return sum(xp[:, j:j + L] * w[j] for j in range(CONV_W)) + b


def _rglru_dir(x, wa, ba, wx, bx, lam, h0):
    B, L, _ = x.shape
    xb = x.reshape(B, L, LRU_BLOCKS, LRU_BW)
    r = jax.nn.sigmoid((jnp.einsum('blnc,ncd->blnd', xb, wa).reshape(B, L, LRU_W) + ba).astype(jnp.float32))
    i = jax.nn.sigmoid((jnp.einsum('blnc,ncd->blnd', xb, wx).reshape(B, L, LRU_W) + bx).astype(jnp.float32))
    log_a = -RG_C * jax.nn.softplus(-lam.astype(jnp.float32)) * r
    a = jnp.exp(log_a)
    u = jnp.sqrt(-jnp.expm1(2.0 * log_a)) * i * x.astype(jnp.float32)

    def combine(e1, e2):
        a1, b1 = e1
        a2, b2 = e2
        return a1 * a2, a2 * b1 + b2

    A, Bc = lax.associative_scan(combine, (a, u), axis=1)
    h = A * h0.astype(jnp.float32)[:, None, :] + Bc
    return h, h[:, -1]


def _rglru_bidir(x, lp, h0):
    hf, sf = _rglru_dir(x, lp['wa'][0], lp['ba'][0], lp['wx'][0], lp['bx'][0], lp['lam'][0], h0[:, 0])
    hb, sb = _rglru_dir(jnp.flip(x, 1), lp['wa'][1], lp['ba'][1], lp['wx'][1], lp['bx'][1],
                        lp['lam'][1], h0[:, 1])
    y = (hf + jnp.flip(hb, 1)).astype(x.dtype)
    return y, jnp.stack([sf, sb], 1).astype(x.dtype)


def _chunk_gmlp(zm, lp):
    z = jax.nn.gelu(zm)
    u, v = z[..., :MLP_W], z[..., MLP_W:]
    v = _layernorm(v, lp['mlp_g'], lp['mlp_b'])
    B, L, _ = v.shape
    vb = v.reshape(B, L // CHUNK, CHUNK, MLP_GROUPS, MLP_GW)
    s = jnp.einsum('gpq,bnqgc->bnpgc', lp['ws'], vb) + lp['bs'].T[None, None, :, :, None]
    return u * s.reshape(B, L, MLP_W)


def _mixer(h, lp, ctx):
    B, L, _ = h.shape
    z = h @ lp['w_in']
    q, k, v, xr, gr, zm = jnp.split(z, SPLITS, axis=-1)
    q = _rmsnorm(q.reshape(B, L, N_HEADS, HEAD_DIM), lp['q_g'])
    k = _rmsnorm(k.reshape(B, L, N_KV_HEADS, HEAD_DIM), lp['k_g'])
    v = v.reshape(B, L, N_KV_HEADS, HEAD_DIM)
    if ctx is None:
        attn = _block_attention(q, k, v)
        h0 = jnp.zeros((B, 2, LRU_W), h.dtype)
    else:
        ck, cv, cs = ctx
        keys = jnp.concatenate([ck, _axial_rope(k)], axis=1)
        vals = jnp.concatenate([cv, v], axis=1)
        attn = _block_attention(_axial_rope(q), keys, vals)
        h0 = cs
    xc = _dwconv(xr, lp['conv_w'], lp['conv_b'])
    y_lru, s_fin = _rglru_bidir(xc, lp, h0)
    y_lru = y_lru * jax.nn.gelu(gr)
    y_mlp = _chunk_gmlp(zm, lp)
    out = jnp.concatenate([attn, y_lru, y_mlp], axis=-1) @ lp['w_out']
    return out, k, v, s_fin


def _layer(x, mod, lp, ctx):
    sh1, sc1, g1, sh2, sc2, g2 = jnp.split(mod, 6, axis=-1)
    out, k, v, s = _mixer(x * (1 + sc1) + sh1, lp, ctx)
    x = _layernorm(ALPHA * x + g1 * out, lp['ln1_g'], lp['ln1_b'])
    hff = x * (1 + sc2) + sh2
    f = jnp.square(jax.nn.relu(hff @ lp['w_ff1'] + lp['b_ff1'])) @ lp['w_ff2'] + lp['b_ff2']
    x = _layernorm(ALPHA * x + g2 * f, lp['ln2_g'], lp['ln2_b'])
    return x, k, v, s


def setup_inputs(seed: int = 0) -> dict:
    key = jax.random.key(seed)
    ks = jax.random.split(key, 40)
    nrm = lambda i, shape, s: jax.random.normal(ks[i], shape, jnp.float32) * s
    a8 = jax.random.uniform(ks[20], (DEPTH, 2, LRU_W), jnp.float32, 0.9, 0.999)
    sig = a8 ** (1.0 / RG_C)
    lam = jnp.log(sig) - jnp.log1p(-sig)
    return {
        "x_prompt": nrm(0, (BATCH, SEQ, D_MODEL), 1.0),
        "x_sample": nrm(1, (DEC_BATCH, DEC_SEQ, D_MODEL), 1.0),
        "c": nrm(2, (DEC_BATCH, D_MODEL), 1.0),
        "cache_k": nrm(3, (DEC_BATCH, DEPTH, PAST_LEN, N_KV_HEADS, HEAD_DIM), 1.0),
        "cache_v": nrm(4, (DEC_BATCH, DEPTH, PAST_LEN, N_KV_HEADS, HEAD_DIM), 1.0),
        "state_lru": nrm(5, (DEC_BATCH, DEPTH, 2, LRU_W), 0.5),
        "c_ctx": nrm(6, (D_MODEL,), 1.0),
        "w_ada": nrm(7, (DEPTH, D_MODEL, 6 * D_MODEL), 0.5 * D_MODEL ** -0.5),
        "b_ada": nrm(8, (DEPTH, 6 * D_MODEL), 0.02),
        "w_in": nrm(9, (DEPTH, D_MODEL, IN_W), D_MODEL ** -0.5),
        "q_norm_g": 1.0 + nrm(10, (DEPTH, HEAD_DIM), 0.02),
        "k_norm_g": 1.0 + nrm(11, (DEPTH, HEAD_DIM), 0.02),
        "conv_w": nrm(12, (DEPTH, CONV_W, LRU_W), CONV_W ** -0.5),
        "conv_b": nrm(13, (DEPTH, LRU_W), 0.02),
        "lru_wa": nrm(14, (DEPTH, 2, LRU_BLOCKS, LRU_BW, LRU_BW), LRU_BW ** -0.5),
        "lru_ba": nrm(15, (DEPTH, 2, LRU_W), 0.02),
        "lru_wx": nrm(16, (DEPTH, 2, LRU_BLOCKS, LRU_BW, LRU_BW), LRU_BW ** -0.5),
        "lru_bx": nrm(17, (DEPTH, 2, LRU_W), 0.02),
        "lru_lam": lam,
        "mlp_norm_g": 1.0 + nrm(18, (DEPTH, MLP_W), 0.02),
        "mlp_norm_b": nrm(19, (DEPTH, MLP_W), 0.02),
        "mlp_ws": nrm(21, (DEPTH, MLP_GROUPS, CHUNK, CHUNK), 0.5 * CHUNK ** -0.5),
        "mlp_bs": 1.0 + nrm(22, (DEPTH, MLP_GROUPS, CHUNK), 0.02),
        "w_out": nrm(23, (DEPTH, MIX_W, D_MODEL), BETA * MIX_W ** -0.5),
        "ln1_g": 1.0 + nrm(24, (DEPTH, D_MODEL), 0.02),
        "ln1_b": nrm(25, (DEPTH, D_MODEL), 0.02),
        "w_ff1": nrm(26, (DEPTH, D_MODEL, D_FF), D_MODEL ** -0.5),
        "b_ff1": nrm(27, (DEPTH, D_FF), 0.02),
        "w_ff2": nrm(28, (DEPTH, D_FF, D_MODEL), BETA * D_FF ** -0.5),
        "b_ff2": nrm(29, (DEPTH, D_MODEL), 0.02),
        "ln2_g": 1.0 + nrm(30, (DEPTH, D_MODEL), 0.02),
        "ln2_b": nrm(31, (DEPTH, D_MODEL), 0.02),
    }


def reference(x_prompt, x_sample, c, cache_k, cache_v, state_lru, c_ctx, w_ada, b_ada, w_in,
              q_norm_g, k_norm_g, conv_w, conv_b, lru_wa, lru_ba, lru_wx, lru_bx, lru_lam,
              mlp_norm_g, mlp_norm_b, mlp_ws, mlp_bs, w_out, ln1_g, ln1_b, w_ff1, b_ff1,
              w_ff2, b_ff2, ln2_g, ln2_b):
    y_prompt = x_prompt
    y_sample = x_sample
    new_k, new_v, new_s = [], [], []
    for l in range(DEPTH):
        lp = dict(w_in=w_in[l], q_g=q_norm_g[l], k_g=k_norm_g[l], conv_w=conv_w[l], conv_b=conv_b[l],
                  wa=lru_wa[l], ba=lru_ba[l], wx=lru_wx[l], bx=lru_bx[l], lam=lru_lam[l],
                  mlp_g=mlp_norm_g[l], mlp_b=mlp_norm_b[l], ws=mlp_ws[l], bs=mlp_bs[l],
                  w_out=w_out[l], ln1_g=ln1_g[l], ln1_b=ln1_b[l], w_ff1=w_ff1[l], b_ff1=b_ff1[l],
                  w_ff2=w_ff2[l], b_ff2=b_ff2[l], ln2_g=ln2_g[l], ln2_b=ln2_b[l])
        mod_ctx = (jax.nn.silu(c_ctx) @ w_ada[l] + b_ada[l])[None, None, :]
        mod_lat = (jax.nn.silu(c) @ w_ada[l] + b_ada[l])[:, None, :]
        y_prompt, k_l, v_l, s_l = _layer(y_prompt, mod_ctx, lp, None)
        new_k.append(k_l)
        new_v.append(v_l)
        new_s.append(s_l)
        y_sample, _, _, _ = _layer(y_sample, mod_lat, lp,
                                   (cache_k[:, l], cache_v[:, l], state_lru[:, l]))
    new_cache_k = jnp.stack(new_k, axis=1)
    new_cache_v = jnp.stack(new_v, axis=1)
    new_state_lru = jnp.stack(new_s, axis=1)
    return (y_prompt, y_sample, new_cache_k, new_cache_v, new_state_lru)
```

```cpp
#include <hip/hip_runtime.h>
#include <hip/hip_cooperative_groups.h>
#include <cstdio>
#include <cstdint>
namespace cg = cooperative_groups;

#ifndef MULTI_LAUNCH
#define MULTI_LAUNCH 0
#endif

typedef unsigned short bf16_t;
using bf16x8 = __attribute__((ext_vector_type(8))) short;
using f32x4 = __attribute__((ext_vector_type(4))) float;
#define DEV __device__ __forceinline__

constexpr int MT = 16384;
constexpr int NPHASE = 18;
constexpr size_t OFF_YK = 16777216, OFF_YV = OFF_YK + 2097152, OFF_ST = OFF_YV + 2097152;
constexpr float ALPHA = 1.41421356237f;
constexpr int SMEM_BYTES = 73728;

struct Params {
  const float *x_prompt, *x_sample, *c, *cache_k, *cache_v, *state_lru, *c_ctx, *w_ada, *b_ada, *w_in,
      *q_g, *k_g, *conv_w, *conv_b, *lru_wa, *lru_ba, *lru_wx, *lru_bx, *lru_lam, *mlp_g, *mlp_b, *mlp_ws, *mlp_bs,
      *w_out, *ln1_g, *ln1_b, *w_ff1, *b_ff1, *w_ff2, *b_ff2, *ln2_g, *ln2_b;
  float* out;
  bf16_t *wt_in, *wt_out, *wt_ff1, *wt_ff2, *wt_lru;
  float *mod, *rope;
  bf16_t *abuf;
  bf16_t *zf;
  float *au;
};

union U8 { uint4 u; bf16x8 v; bf16_t h[8]; unsigned w[4]; };

DEV float bf2f(bf16_t h) { return __uint_as_float(((unsigned)h) << 16); }
DEV bf16_t f2bf(float f) { unsigned u = __float_as_uint(f); u += 0x7fffu + ((u >> 16) & 1u); return (bf16_t)(u >> 16); }
DEV unsigned pack2(float a, float b) { return (unsigned)f2bf(a) | ((unsigned)f2bf(b) << 16); }
DEV float gelu_t(float x) { float y = 0.7978845608028654f * (x + 0.044715f * x * x * x); float t = 1.f - 2.f / (1.f + __expf(2.f * y)); return 0.5f * x * (1.f + t); }
DEV float sigmoidf_(float x) { return 1.f / (1.f + __expf(-x)); }
DEV int cond_of(int m) { return m < 8192 ? 0 : 1 + ((m - 8192) >> 10); }
DEV f32x4 mfma16(bf16x8 a, bf16x8 b, f32x4 c) { return __builtin_amdgcn_mfma_f32_16x16x32_bf16(a, b, c, 0, 0, 0); }
DEV float wave_sum(float v) {
#pragma unroll
  for (int o = 32; o >= 1; o >>= 1) v += __shfl_xor(v, o);
  return v;
}

DEV void transpose_tile(const float* __restrict__ src, bf16_t* __restrict__ dst, int K, int N, int tk, int tn, char* smem) {
  float* T = (float*)smem;
  const int tid = threadIdx.x;
#pragma unroll
  for (int i = 0; i < 4; ++i) {
    int k = (tid >> 4) + 16 * i, n4 = (tid & 15) * 4;
    float4 v = *(const float4*)(src + (size_t)(tk * 64 + k) * N + tn * 64 + n4);
    T[k * 65 + n4 + 0] = v.x; T[k * 65 + n4 + 1] = v.y; T[k * 65 + n4 + 2] = v.z; T[k * 65 + n4 + 3] = v.w;
  }
  __syncthreads();
#pragma unroll
  for (int i = 0; i < 2; ++i) {
    int n = (tid >> 3) + 32 * i, k8 = (tid & 7) * 8;
    U8 o;
#pragma unroll
    for (int j = 0; j < 4; ++j) o.w[j] = pack2(T[(k8 + 2 * j) * 65 + n], T[(k8 + 2 * j + 1) * 65 + n]);
    *(uint4*)(dst + (size_t)(tn * 64 + n) * K + tk * 64 + k8) = o.u;
  }
  __syncthreads();
}

DEV void phase0(const Params& p, char* smem) {
  const int tid = threadIdx.x;
  const int NITEMS = 193 + 2 * 2768;
  for (int it = blockIdx.x; it < NITEMS; it += gridDim.x) {
    if (it < 192) {
      const int l = it / 96, n0 = (it % 96) * 64;
      float* s = (float*)smem;
      float* red = s + 9 * 1024;
      for (int idx = tid; idx < 9 * 1024; idx += 256) {
        int c = idx >> 10, k = idx & 1023;
        float v = (c == 0) ? p.c_ctx[k] : p.c[(c - 1) * 1024 + k];
        s[idx] = v / (1.f + __expf(-v));
      }
      __syncthreads();
      const int kq = tid >> 6, n = tid & 63;
      float acc[9];
#pragma unroll
      for (int c = 0; c < 9; ++c) acc[c] = 0.f;
      const float* wp = p.w_ada + ((size_t)l * 1024 + kq * 256) * 6144 + n0 + n;
#pragma unroll 4
      for (int k = 0; k < 256; ++k) {
        float wv = wp[(size_t)k * 6144];
#pragma unroll
        for (int c = 0; c < 9; ++c) acc[c] += s[c * 1024 + kq * 256 + k] * wv;
      }
#pragma unroll
      for (int c = 0; c < 9; ++c) red[(kq * 9 + c) * 64 + n] = acc[c];
      __syncthreads();
      for (int idx = tid; idx < 576; idx += 256) {
        int c = idx >> 6, nn = idx & 63;
        float v = red[(0 * 9 + c) * 64 + nn] + red[(1 * 9 + c) * 64 + nn] + red[(2 * 9 + c) * 64 + nn] + red[(3 * 9 + c) * 64 + nn] +
                  p.b_ada[l * 6144 + n0 + nn];
        p.mod[((size_t)l * 9 + c) * 6144 + n0 + nn] = v;
      }
      __syncthreads();
    } else if (it == 192) {
      for (int idx = tid; idx < 1024; idx += 256) {
        int pp = idx >> 4, f = idx & 15;
        float inv = powf(10000.f, -(float)f / 16.f);
        float ang = (float)pp * inv;
        float nrev = rintf(ang * 0.15915494309189535f);
        float r = fmaf(-nrev, 6.28125f, ang);
        r = fmaf(-nrev, 0.0019353071795864769f, r);
        p.rope[idx * 2 + 0] = __cosf(r);
        p.rope[idx * 2 + 1] = __sinf(r);
      }
    } else {
      int t = it - 193;
      const int l = t / 2768, r = t % 2768;
      if (r < 448) transpose_tile(p.w_in + (size_t)l * 1024 * 1792, p.wt_in + (size_t)l * 1792 * 1024, 1024, 1792, r / 28, r % 28, smem);
      else if (r < 704) { int i = r - 448; transpose_tile(p.w_out + (size_t)l * 1024 * 1024, p.wt_out + (size_t)l * 1024 * 1024, 1024, 1024, i / 16, i % 16, smem); }
      else if (r < 1728) { int i = r - 704; transpose_tile(p.w_ff1 + (size_t)l * 1024 * 4096, p.wt_ff1 + (size_t)l * 4096 * 1024, 1024, 4096, i / 64, i % 64, smem); }
      else if (r < 2752) { int i = r - 1728; transpose_tile(p.w_ff2 + (size_t)l * 4096 * 1024, p.wt_ff2 + (size_t)l * 1024 * 4096, 4096, 1024, i / 16, i % 16, smem); }
      else {
        int idx = r - 2752;
        int dir = idx >> 3, blk = (idx >> 1) & 3, mat = idx & 1;
        const float* src = (mat == 0 ? p.lru_wa : p.lru_wx) + (size_t)(((l * 2 + dir) * 4 + blk)) * 4096;
        bf16_t* dst = p.wt_lru + (size_t)((((l * 2 + dir) * 4 + blk) * 2 + mat)) * 4096;
        transpose_tile(src, dst, 64, 64, 0, 0, smem);
      }
    }
  }
}

DEV void ln_mod_phase(const Params& p, int l, int mode) {
  const int lane = threadIdx.x & 63, w = threadIdx.x >> 6;
  const float* lg = nullptr; const float* lb = nullptr;
  if (mode == 1) { lg = p.ln2_g + (l - 1) * 1024; lb = p.ln2_b + (l - 1) * 1024; }
  else if (mode == 2) { lg = p.ln1_g + l * 1024; lb = p.ln1_b + l * 1024; }
  else if (mode == 3) { lg = p.ln2_g + l * 1024; lb = p.ln2_b + l * 1024; }
  const int shoff = (mode == 2) ? 3072 : 0;
  for (int m = blockIdx.x * 4 + w; m < MT; m += gridDim.x * 4) {
    const float* src;
    if (mode == 0) src = (m < 8192) ? p.x_prompt + (size_t)m * 1024 : p.x_sample + (size_t)(m - 8192) * 1024;
    else src = p.out + (size_t)m * 1024;
    float4 v[4];
#pragma unroll
    for (int i = 0; i < 4; ++i) v[i] = *(const float4*)(src + i * 256 + lane * 4);
    if (mode != 0) {
      float s = 0.f;
#pragma unroll
      for (int i = 0; i < 4; ++i) s += v[i].x + v[i].y + v[i].z + v[i].w;
      const float mean = wave_sum(s) * (1.f / 1024.f);
      float s2 = 0.f;
#pragma unroll
      for (int i = 0; i < 4; ++i) { float a = v[i].x - mean, b = v[i].y - mean, c = v[i].z - mean, d = v[i].w - mean; s2 += a * a + b * b + c * c + d * d; }
      const float rstd = rsqrtf(wave_sum(s2) * (1.f / 1024.f) + 1e-6f);
#pragma unroll
      for (int i = 0; i < 4; ++i) {
        float4 g = *(const float4*)(lg + i * 256 + lane * 4), b = *(const float4*)(lb + i * 256 + lane * 4);
        v[i].x = (v[i].x - mean) * rstd * g.x + b.x; v[i].y = (v[i].y - mean) * rstd * g.y + b.y;
        v[i].z = (v[i].z - mean) * rstd * g.z + b.z; v[i].w = (v[i].w - mean) * rstd * g.w + b.w;
        *(float4*)(p.out + (size_t)m * 1024 + i * 256 + lane * 4) = v[i];
      }
    }
    if (mode != 3) {
      const float* md = p.mod + ((size_t)l * 9 + cond_of(m)) * 6144 + shoff;
#pragma unroll
      for (int i = 0; i < 4; ++i) {
        float4 sh = *(const float4*)(md + i * 256 + lane * 4), sc = *(const float4*)(md + 1024 + i * 256 + lane * 4);
        uint2 o;
        o.x = pack2(v[i].x * (1.f + sc.x) + sh.x, v[i].y * (1.f + sc.y) + sh.y);
        o.y = pack2(v[i].z * (1.f + sc.z) + sh.z, v[i].w * (1.f + sc.w) + sh.w);
        *(uint2*)(p.abuf + (size_t)m * 1024 + i * 256 + lane * 4) = o;
      }
    }
  }
}

template <int EPI>
DEV void gemm_tile(const Params& p, int l, const bf16_t* __restrict__ A, const bf16_t* __restrict__ Bt, int N, int K, int tm, int tn, char* smem) {
  bf16_t* As = (bf16_t*)smem;
  bf16_t* Bs = As + 2 * 128 * 72;
  const int tid = threadIdx.x, lane = tid & 63, w = tid >> 6;
  const int wm = w >> 1, wn = w & 1, q = lane >> 4, c15 = lane & 15;
  const int lr = tid >> 3, lc = (tid & 7) * 8;
  const bf16_t* Ag = A + (size_t)(tm * 128 + lr) * K + lc;
  const bf16_t* Bg = Bt + (size_t)(tn * 128 + lr) * K + lc;
  uint4 ra[4], rb[4];
#pragma unroll
  for (int i = 0; i < 4; ++i) { ra[i] = *(const uint4*)(Ag + (size_t)i * 32 * K); rb[i] = *(const uint4*)(Bg + (size_t)i * 32 * K); }
#pragma unroll
  for (int i = 0; i < 4; ++i) { *(uint4*)(As + (lr + 32 * i) * 72 + lc) = ra[i]; *(uint4*)(Bs + (lr + 32 * i) * 72 + lc) = rb[i]; }
  __syncthreads();
  f32x4 acc[4][4];
#pragma unroll
  for (int i = 0; i < 4; ++i)
#pragma unroll
    for (int j = 0; j < 4; ++j) acc[i][j] = f32x4{0.f, 0.f, 0.f, 0.f};
  const int nk = K >> 6;
  for (int kt = 0; kt < nk; ++kt) {
    const int cur = kt & 1;
    if (kt + 1 < nk) {
#pragma unroll
      for (int i = 0; i < 4; ++i) { ra[i] = *(const uint4*)(Ag + (size_t)i * 32 * K + (kt + 1) * 64); rb[i] = *(const uint4*)(Bg + (size_t)i * 32 * K + (kt + 1) * 64); }
    }
    const bf16_t* as = As + cur * 128 * 72 + (wm * 64 + c15) * 72 + q * 8;
    const bf16_t* bs = Bs + cur * 128 * 72 + (wn * 64 + c15) * 72 + q * 8;
#pragma unroll
    for (int s = 0; s < 2; ++s) {
      bf16x8 af[4], bfr[4];
#pragma unroll
      for (int i = 0; i < 4; ++i) af[i] = *(const bf16x8*)(as + i * 16 * 72 + s * 32);
#pragma unroll
      for (int j = 0; j < 4; ++j) bfr[j] = *(const bf16x8*)(bs + j * 16 * 72 + s * 32);
#pragma unroll
      for (int i = 0; i < 4; ++i)
#pragma unroll
        for (int j = 0; j < 4; ++j) acc[i][j] = mfma16(af[i], bfr[j], acc[i][j]);
    }
    if (kt + 1 < nk) {
      bf16_t* ad = As + (cur ^ 1) * 128 * 72; bf16_t* bd = Bs + (cur ^ 1) * 128 * 72;
#pragma unroll
      for (int i = 0; i < 4; ++i) { *(uint4*)(ad + (lr + 32 * i) * 72 + lc) = ra[i]; *(uint4*)(bd + (lr + 32 * i) * 72 + lc) = rb[i]; }
    }
    __syncthreads();
  }
  const int cond = cond_of(tm * 128);
  const float* md = p.mod + ((size_t)l * 9 + cond) * 6144;
#pragma unroll
  for (int j = 0; j < 4; ++j) {
    const int col = tn * 128 + wn * 64 + j * 16 + c15;
    float gate = 0.f, bias = 0.f;
    if (EPI == 2) gate = md[2048 + col];
    if (EPI == 3) bias = p.b_ff1[l * 4096 + col];
    if (EPI == 4) { gate = md[5120 + col]; bias = p.b_ff2[l * 1024 + col]; }
#pragma unroll
    for (int i = 0; i < 4; ++i) {
#pragma unroll
      for (int r = 0; r < 4; ++r) {
        const int row = tm * 128 + wm * 64 + i * 16 + q * 4 + r;
        const float v = acc[i][j][r];
        if (EPI == 1) p.zf[(size_t)row * 1792 + col] = f2bf(v);
        else if (EPI == 2) {
          float x;
          if (l == 0) x = (row < 8192) ? p.x_prompt[(size_t)row * 1024 + col] : p.x_sample[(size_t)(row - 8192) * 1024 + col];
          else x = p.out[(size_t)row * 1024 + col];
          p.out[(size_t)row * 1024 + col] = ALPHA * x + gate * v;
        } else if (EPI == 3) { float t = fmaxf(v + bias, 0.f); p.zf[(size_t)row * 4096 + col] = f2bf(t * t); }
        else { float x = p.out[(size_t)row * 1024 + col]; p.out[(size_t)row * 1024 + col] = ALPHA * x + gate * (v + bias); }
      }
    }
  }
}

template <int EPI>
DEV void gemm_phase(const Params& p, int l, const bf16_t* A, const bf16_t* Bt, int N, int K, char* smem) {
  const int tn_count = N >> 7, ntiles = 128 * tn_count;
  for (int t = blockIdx.x; t < ntiles; t += gridDim.x) gemm_tile<EPI>(p, l, A, Bt, N, K, t / tn_count, t % tn_count, smem);
}

DEV void rope8(float (&v)[8], int d0, int prow, int pcol, const float* __restrict__ rope) {
  const int pp = (d0 < 32) ? prow : pcol;
#pragma unroll
  for (int i = 0; i < 4; ++i) {
    const int f = ((d0 >> 1) + i) & 15;
    const float cs = rope[(pp * 16 + f) * 2], sn = rope[(pp * 16 + f) * 2 + 1];
    const float x1 = v[2 * i], x2 = v[2 * i + 1];
    v[2 * i] = x1 * cs - x2 * sn; v[2 * i + 1] = x1 * sn + x2 * cs;
  }
}

DEV void prep_token_row(const Params& p, int l, int m, int lane) {
  bf16_t* zr = p.zf + (size_t)m * 1792;
  const bool lat = m >= 8192;
  const int pos = lat ? ((m - 8192) & 1023) : (m & 255);
  const int prow = pos >> 6, pcol = pos & 63;
  const int d0 = (lane & 7) * 8;
  {
    U8 u; u.u = *(const uint4*)(zr + lane * 8);
    float v[8]; float ss = 0.f;
#pragma unroll
    for (int j = 0; j < 8; ++j) { v[j] = bf2f(u.h[j]); ss += v[j] * v[j]; }
    ss += __shfl_xor(ss, 1); ss += __shfl_xor(ss, 2); ss += __shfl_xor(ss, 4);
    const float rinv = rsqrtf(ss * (1.f / 64.f) + 1e-6f);
#pragma unroll
    for (int j = 0; j < 8; ++j) v[j] = v[j] * rinv * p.q_g[l * 64 + d0 + j];
    if (lat) rope8(v, d0, prow, pcol, p.rope);
#pragma unroll
    for (int j = 0; j < 4; ++j) u.w[j] = pack2(v[2 * j] * 0.125f, v[2 * j + 1] * 0.125f);
    *(uint4*)(zr + lane * 8) = u.u;
  }
  {
    const int col = lane < 32 ? 512 + lane * 8 : 1024 + (lane - 32) * 8;
    U8 u; u.u = *(const uint4*)(zr + col);
    float v[8]; float ss = 0.f;
#pragma unroll
    for (int j = 0; j < 8; ++j) { v[j] = bf2f(u.h[j]); ss += v[j] * v[j]; }
    ss += __shfl_xor(ss, 1); ss += __shfl_xor(ss, 2); ss += __shfl_xor(ss, 4);
    if (lane < 16) {
      const float rinv = rsqrtf(ss * (1.f / 64.f) + 1e-6f);
#pragma unroll
      for (int j = 0; j < 8; ++j) v[j] = v[j] * rinv * p.k_g[l * 64 + d0 + j];
      if (!lat) {
        float* o = p.out + OFF_YK + ((((size_t)(m >> 8)) * 2 + l) * 256 + pos) * 128 + lane * 8;
        *(float4*)o = make_float4(v[0], v[1], v[2], v[3]); *(float4*)(o + 4) = make_float4(v[4], v[5], v[6], v[7]);
      } else rope8(v, d0, prow, pcol, p.rope);
#pragma unroll
      for (int j = 0; j < 4; ++j) u.w[j] = pack2(v[2 * j], v[2 * j + 1]);
      *(uint4*)(zr + col) = u.u;
    } else if (lane < 32) {
      if (!lat) {
        float* o = p.out + OFF_YV + ((((size_t)(m >> 8)) * 2 + l) * 256 + pos) * 128 + (lane - 16) * 8;
        *(float4*)o = make_float4(v[0], v[1], v[2], v[3]); *(float4*)(o + 4) = make_float4(v[4], v[5], v[6], v[7]);
      }
    } else {
#pragma unroll
      for (int j = 0; j < 4; ++j) u.w[j] = pack2(gelu_t(v[2 * j]), gelu_t(v[2 * j + 1]));
      *(uint4*)(zr + col) = u.u;
    }
  }
  {
    const int col = 1280 + lane * 8;
    U8 u; u.u = *(const uint4*)(zr + col);
    float v[8]; float s = 0.f;
#pragma unroll
    for (int j = 0; j < 8; ++j) { v[j] = gelu_t(bf2f(u.h[j])); s += v[j]; }
#pragma unroll
    for (int o = 1; o <= 16; o <<= 1) s += __shfl_xor(s, o);
    const float mean = s * (1.f / 256.f);
    float s2 = 0.f;
#pragma unroll
    for (int j = 0; j < 8; ++j) { float d = v[j] - mean; s2 += d * d; }
#pragma unroll
    for (int o = 1; o <= 16; o <<= 1) s2 += __shfl_xor(s2, o);
    if (lane >= 32) {
      const float rstd = rsqrtf(s2 * (1.f / 256.f) + 1e-6f);
      const int ch = (lane - 32) * 8;
#pragma unroll
      for (int j = 0; j < 8; ++j) v[j] = (v[j] - mean) * rstd * p.mlp_g[l * 256 + ch + j] + p.mlp_b[l * 256 + ch + j];
    }
#pragma unroll
    for (int j = 0; j < 4; ++j) u.w[j] = pack2(v[2 * j], v[2 * j + 1]);
    *(uint4*)(zr + col) = u.u;
  }
}

template <bool REV>
DEV void tile_scan(float (&a)[4][4], float (&u)[4][4], int lane) {
  const int q = lane >> 4;
  float C = 0.f, CP = 1.f;
  const int src1 = (REV ? lane + 16 : lane - 16) & 63;
  const int src2 = (REV ? lane + 32 : lane - 32) & 63;
  const int srcT = (lane & 15) + (REV ? 0 : 48);
  const bool c1 = REV ? (q <= 2) : (q >= 1);
  const bool c2 = REV ? (q <= 1) : (q >= 2);
  const bool first = REV ? (q == 3) : (q == 0);
#pragma unroll
  for (int mi = 0; mi < 4; ++mi) {
    const int mt = REV ? 3 - mi : mi;
    float P = 1.f, H = 0.f, pl[4], hl[4];
#pragma unroll
    for (int ri = 0; ri < 4; ++ri) {
      const int r = REV ? 3 - ri : ri;
      H = a[mt][r] * H + u[mt][r]; P *= a[mt][r]; pl[r] = P; hl[r] = H;
    }
    float Pi = P, Hi = H;
    float Pp = __shfl(Pi, src1), Hp = __shfl(Hi, src1);
    if (c1) { Hi = Pi * Hp + Hi; Pi = Pi * Pp; }
    Pp = __shfl(Pi, src2); Hp = __shfl(Hi, src2);
    if (c2) { Hi = Pi * Hp + Hi; Pi = Pi * Pp; }
    float Pe = __shfl(Pi, src1), He = __shfl(Hi, src1);
    if (first) { Pe = 1.f; He = 0.f; }
    const float hin = Pe * C + He, pin = Pe * CP;
#pragma unroll
    for (int r = 0; r < 4; ++r) { u[mt][r] = pl[r] * hin + hl[r]; a[mt][r] = pl[r] * pin; }
    const float Pt = __shfl(Pi, srcT), Ht = __shfl(Hi, srcT);
    C = Pt * C + Ht; CP = Pt * CP;
  }
}

DEV void lru_gate_item(const Params& p, int l, int item, char* smem) {
  const int tid = threadIdx.x, lane = tid & 63, w = tid >> 6;
  const int tile = item >> 2, blk = item & 3;
  const int m0 = tile * 64;
  int ms, L;
  if (m0 < 8192) { ms = m0 & ~255; L = 256; } else { ms = 8192 + ((m0 - 8192) & ~1023); L = 1024; }
  float* xs = (float*)smem;
  float* xcf = xs + 67 * 64;
  bf16_t* xcb = (bf16_t*)(xcf + 64 * 64);
  for (int idx = tid; idx < 67 * 8; idx += 256) {
    const int rr = idx >> 3, cc = idx & 7;
    const int m = m0 - 1 + rr;
    float v[8];
    if (m >= ms && m < ms + L) {
      U8 u; u.u = *(const uint4*)(p.zf + (size_t)m * 1792 + 768 + blk * 64 + cc * 8);
#pragma unroll
      for (int j = 0; j < 8; ++j) v[j] = bf2f(u.h[j]);
    } else {
#pragma unroll
      for (int j = 0; j < 8; ++j) v[j] = 0.f;
    }
#pragma unroll
    for (int j = 0; j < 8; ++j) xs[rr * 64 + cc * 8 + j] = v[j];
  }
  __syncthreads();
  {
    const int ch = tid & 63, Cg = blk * 64 + ch;
    const float w0 = p.conv_w[(l * 4 + 0) * 256 + Cg], w1 = p.conv_w[(l * 4 + 1) * 256 + Cg], w2 = p.conv_w[(l * 4 + 2) * 256 + Cg],
                w3 = p.conv_w[(l * 4 + 3) * 256 + Cg], cb = p.conv_b[l * 256 + Cg];
#pragma unroll 4
    for (int tt = 0; tt < 16; ++tt) {
      const int t = (tid >> 6) * 16 + tt;
      const float v = cb + w0 * xs[t * 64 + ch] + w1 * xs[(t + 1) * 64 + ch] + w2 * xs[(t + 2) * 64 + ch] + w3 * xs[(t + 3) * 64 + ch];
      xcf[t * 64 + ch] = v; xcb[t * 72 + ch] = f2bf(v);
    }
  }
  __syncthreads();
  const int dir = w >> 1, half = w & 1, q = lane >> 4, c15 = lane & 15;
  const bf16_t* wt = p.wt_lru + (size_t)((((l * 2 + dir) * 4 + blk) * 2)) * 4096;
  bf16x8 bfr[2][2][2];
#pragma unroll
  for (int mat = 0; mat < 2; ++mat)
#pragma unroll
    for (int j = 0; j < 2; ++j)
#pragma unroll
      for (int s = 0; s < 2; ++s) bfr[mat][j][s] = *(const bf16x8*)(wt + mat * 4096 + (half * 32 + j * 16 + c15) * 64 + s * 32 + q * 8);
  f32x4 acc[2][4][2];
#pragma unroll
  for (int mat = 0; mat < 2; ++mat)
#pragma unroll
    for (int mt = 0; mt < 4; ++mt)
#pragma unroll
      for (int j = 0; j < 2; ++j) acc[mat][mt][j] = f32x4{0.f, 0.f, 0.f, 0.f};
#pragma unroll
  for (int mt = 0; mt < 4; ++mt)
#pragma unroll
    for (int s = 0; s < 2; ++s) {
      const bf16x8 af = *(const bf16x8*)(xcb + (mt * 16 + c15) * 72 + s * 32 + q * 8);
#pragma unroll
      for (int mat = 0; mat < 2; ++mat)
#pragma unroll
        for (int j = 0; j < 2; ++j) acc[mat][mt][j] = mfma16(af, bfr[mat][j][s], acc[mat][mt][j]);
    }
  float* PCp = p.au + (size_t)(dir * 2 + 0) * MT * 256;
  float* HLp = p.au + (size_t)(dir * 2 + 1) * MT * 256;
#pragma unroll
  for (int j = 0; j < 2; ++j) {
    const int ch = half * 32 + j * 16 + c15, Cg = blk * 64 + ch, pidx = (l * 2 + dir) * 256 + Cg;
    const float ba = p.lru_ba[pidx], bx = p.lru_bx[pidx], lam = p.lru_lam[pidx];
    const float xn = -lam;
    const float sp = fmaxf(xn, 0.f) + log1pf(expf(-fabsf(xn)));
    const float cdec = -8.f * sp;
    float a[4][4], u[4][4];
#pragma unroll
    for (int mt = 0; mt < 4; ++mt)
#pragma unroll
      for (int r = 0; r < 4; ++r) {
        const int t = mt * 16 + q * 4 + r;
        const float rg = sigmoidf_(acc[0][mt][j][r] + ba), ig = sigmoidf_(acc[1][mt][j][r] + bx);
        const float la = cdec * rg;
        a[mt][r] = __expf(la);
        u[mt][r] = sqrtf(-expm1f(2.f * la)) * ig * xcf[t * 64 + ch];
      }
    if (dir == 0) tile_scan<false>(a, u, lane); else tile_scan<true>(a, u, lane);
#pragma unroll
    for (int mt = 0; mt < 4; ++mt)
#pragma unroll
      for (int r = 0; r < 4; ++r) {
        const size_t m = m0 + mt * 16 + q * 4 + r;
        PCp[m * 256 + Cg] = a[mt][r]; HLp[m * 256 + Cg] = u[mt][r];
      }
  }
  __syncthreads();
}

DEV void attn_item(const Params& p, int l, int it, char* smem) {
  const int tid = threadIdx.x, lane = tid & 63, w = tid >> 6, q = lane >> 4, c15 = lane & 15;
  int b, h, qb, ms, nkt; bool lat;
  if (it < 1024) { lat = true; b = it >> 7; h = (it >> 4) & 7; qb = it & 15; ms = 8192 + b * 1024; nkt = 20; }
  else { const int i2 = it - 1024; lat = false; b = i2 >> 5; h = (i2 >> 2) & 7; qb = i2 & 3; ms = b * 256; nkt = 4; }
  const int kvh = h >> 2;
  bf16_t* Ks = (bf16_t*)smem;
  bf16_t* Vt = Ks + 64 * 72;
  bf16_t* Pw = Vt + 64 * 72 + w * 16 * 72;
  const int mq = ms + qb * 64 + w * 16;
  bf16x8 qf[2];
#pragma unroll
  for (int s = 0; s < 2; ++s) qf[s] = *(const bf16x8*)(p.zf + (size_t)(mq + c15) * 1792 + h * 64 + s * 32 + q * 8);
  f32x4 o[4];
  float mrow[4], lrow[4];
#pragma unroll
  for (int j = 0; j < 4; ++j) { o[j] = f32x4{0.f, 0.f, 0.f, 0.f}; mrow[j] = -1e30f; lrow[j] = 0.f; }
  for (int kt = 0; kt < nkt; ++kt) {
#pragma unroll
    for (int i = 0; i < 2; ++i) {
      const int id = tid + 256 * i, key = id >> 3, cc = id & 7;
      U8 kk, vv;
      if (lat && kt < 4) {
        const int t = kt * 64 + key;
        const size_t off = ((((size_t)b * 2 + l) * 256 + t) * 2 + kvh) * 64 + cc * 8;
        const float4 a0 = *(const float4*)(p.cache_k + off), a1 = *(const float4*)(p.cache_k + off + 4);
        kk.w[0] = pack2(a0.x, a0.y); kk.w[1] = pack2(a0.z, a0.w); kk.w[2] = pack2(a1.x, a1.y); kk.w[3] = pack2(a1.z, a1.w);
        const float4 b0 = *(const float4*)(p.cache_v + off), b1 = *(const float4*)(p.cache_v + off + 4);
        vv.w[0] = pack2(b0.x, b0.y); vv.w[1] = pack2(b0.z, b0.w); vv.w[2] = pack2(b1.x, b1.y); vv.w[3] = pack2(b1.z, b1.w);
      } else {
        const int t = lat ? (kt - 4) * 64 + key : kt * 64 + key;
        const bf16_t* zr = p.zf + (size_t)(ms + t) * 1792;
        kk.u = *(const uint4*)(zr + 512 + kvh * 64 + cc * 8);
        vv.u = *(const uint4*)(zr + 640 + kvh * 64 + cc * 8);
      }
      *(uint4*)(Ks + key * 72 + cc * 8) = kk.u;
#pragma unroll
      for (int j = 0; j < 8; ++j) Vt[(cc * 8 + j) * 72 + key] = vv.h[j];
    }
    __syncthreads();
    f32x4 s4[4];
#pragma unroll
    for (int jn = 0; jn < 4; ++jn) {
      s4[jn] = f32x4{0.f, 0.f, 0.f, 0.f};
#pragma unroll
      for (int s = 0; s < 2; ++s) {
        const bf16x8 kb = *(const bf16x8*)(Ks + (jn * 16 + c15) * 72 + s * 32 + q * 8);
        s4[jn] = mfma16(qf[s], kb, s4[jn]);
      }
    }
#pragma unroll
    for (int r = 0; r < 4; ++r) {
      float mx = fmaxf(fmaxf(s4[0][r], s4[1][r]), fmaxf(s4[2][r], s4[3][r]));
      mx = fmaxf(mx, __shfl_xor(mx, 1)); mx = fmaxf(mx, __shfl_xor(mx, 2)); mx = fmaxf(mx, __shfl_xor(mx, 4)); mx = fmaxf(mx, __shfl_xor(mx, 8));
      const float mnew = fmaxf(mrow[r], mx);
      const float alpha = __expf(mrow[r] - mnew);
      mrow[r] = mnew;
      float ls = lrow[r] * alpha;
#pragma unroll
      for (int jn = 0; jn < 4; ++jn) {
        o[jn][r] *= alpha;
        const float pv = __expf(s4[jn][r] - mnew);
        ls += pv;
        Pw[(q * 4 + r) * 72 + jn * 16 + c15] = f2bf(pv);
      }
      lrow[r] = ls;
    }
    __builtin_amdgcn_wave_barrier();
    bf16x8 pf[2];
#pragma unroll
    for (int s = 0; s < 2; ++s) pf[s] = *(const bf16x8*)(Pw + c15 * 72 + s * 32 + q * 8);
#pragma unroll
    for (int jn = 0; jn < 4; ++jn)
#pragma unroll
      for (int s = 0; s < 2; ++s) {
        const bf16x8 vb = *(const bf16x8*)(Vt + (jn * 16 + c15) * 72 + s * 32 + q * 8);
        o[jn] = mfma16(pf[s], vb, o[jn]);
      }
    __syncthreads();
  }
#pragma unroll
  for (int r = 0; r < 4; ++r) {
    float lt = lrow[r];
    lt += __shfl_xor(lt, 1); lt += __shfl_xor(lt, 2); lt += __shfl_xor(lt, 4); lt += __shfl_xor(lt, 8);
    const float inv = 1.f / lt;
    const size_t m = mq + q * 4 + r;
#pragma unroll
    for (int jn = 0; jn < 4; ++jn) p.abuf[m * 1024 + h * 64 + jn * 16 + c15] = f2bf(o[jn][r] * inv);
  }
}

DEV void gmlp_item(const Params& p, int l, int it, char* smem) {
  const int tid = threadIdx.x, lane = tid & 63, w = tid >> 6, q = lane >> 4, c15 = lane & 15;
  const int chunk = it >> 2, g = it & 3, m0 = chunk * 128;
  bf16_t* vt = (bf16_t*)smem;
#pragma unroll
  for (int i = 0; i < 4; ++i) {
    const int id = tid + 256 * i, qq = id >> 3, cc = id & 7;
    U8 v; v.u = *(const uint4*)(p.zf + (size_t)(m0 + qq) * 1792 + 1536 + g * 64 + cc * 8);
#pragma unroll
    for (int j = 0; j < 8; ++j) vt[(cc * 8 + j) * 136 + qq] = v.h[j];
  }
  __syncthreads();
  f32x4 acc[2][4];
#pragma unroll
  for (int i = 0; i < 2; ++i)
#pragma unroll
    for (int jn = 0; jn < 4; ++jn) acc[i][jn] = f32x4{0.f, 0.f, 0.f, 0.f};
  const float* wsg = p.mlp_ws + (size_t)(l * 4 + g) * 16384;
#pragma unroll
  for (int s = 0; s < 4; ++s) {
    U8 af[2];
#pragma unroll
    for (int i = 0; i < 2; ++i) {
      const float* ap = wsg + (w * 32 + i * 16 + c15) * 128 + s * 32 + q * 8;
      const float4 a0 = *(const float4*)ap, a1 = *(const float4*)(ap + 4);
      af[i].w[0] = pack2(a0.x, a0.y); af[i].w[1] = pack2(a0.z, a0.w); af[i].w[2] = pack2(a1.x, a1.y); af[i].w[3] = pack2(a1.z, a1.w);
    }
#pragma unroll
    for (int jn = 0; jn < 4; ++jn) {
      const bf16x8 bb = *(const bf16x8*)(vt + (jn * 16 + c15) * 136 + s * 32 + q * 8);
#pragma unroll
      for (int i = 0; i < 2; ++i) acc[i][jn] = mfma16(af[i].v, bb, acc[i][jn]);
    }
  }
#pragma unroll
  for (int i = 0; i < 2; ++i)
#pragma unroll
    for (int r = 0; r < 4; ++r) {
      const int pp = w * 32 + i * 16 + q * 4 + r;
      const size_t m = m0 + pp;
      const float bsv = p.mlp_bs[(l * 4 + g) * 128 + pp];
#pragma unroll
      for (int jn = 0; jn < 4; ++jn) {
        const int c = jn * 16 + c15;
        const float uu = bf2f(p.zf[m * 1792 + 1280 + g * 64 + c]);
        p.abuf[m * 1024 + 768 + g * 64 + c] = f2bf(uu * (acc[i][jn][r] + bsv));
      }
    }
  __syncthreads();
}

DEV void lru_apply_item(const Params& p, int l, int ti) {
  const int C = threadIdx.x;
  const int m0 = ti * 64;
  int ms, L, b; bool lat = m0 >= 8192;
  if (!lat) { ms = m0 & ~255; L = 256; b = m0 >> 8; } else { ms = 8192 + ((m0 - 8192) & ~1023); L = 1024; b = (m0 - 8192) >> 10; }
  const int k = (m0 - ms) >> 6, nt = L >> 6;
  const float* PCf = p.au; const float* HLf = p.au + (size_t)MT * 256;
  const float* PCb = p.au + (size_t)2 * MT * 256; const float* HLb = p.au + (size_t)3 * MT * 256;
  float cf = lat ? p.state_lru[((size_t)(b * 2 + l) * 2 + 0) * 256 + C] : 0.f;
  float cb = lat ? p.state_lru[((size_t)(b * 2 + l) * 2 + 1) * 256 + C] : 0.f;
  {
    float pc[15], hl[15];
#pragma unroll
    for (int i = 0; i < 15; ++i) {
      const bool act = i < k;
      const size_t e = (size_t)(ms + 64 * i + 63) * 256 + C;
      pc[i] = act ? PCf[e] : 1.f; hl[i] = act ? HLf[e] : 0.f;
    }
#pragma unroll
    for (int i = 0; i < 15; ++i) cf = pc[i] * cf + hl[i];
  }
  {
    float pc[15], hl[15];
#pragma unroll
    for (int i = 0; i < 15; ++i) {
      const int tix = nt - 1 - i;
      const bool act = tix > k;
      const size_t e = (size_t)(ms + 64 * tix) * 256 + C;
      pc[i] = act ? PCb[e] : 1.f; hl[i] = act ? HLb[e] : 0.f;
    }
#pragma unroll
    for (int i = 0; i < 15; ++i) cb = pc[i] * cb + hl[i];
  }
  float hf_last = 0.f, hb_first = 0.f;
#pragma unroll 8
  for (int t = 0; t < 64; ++t) {
    const size_t m = m0 + t;
    const float hf = PCf[m * 256 + C] * cf + HLf[m * 256 + C];
    const float hb = PCb[m * 256 + C] * cb + HLb[m * 256 + C];
    const float g = bf2f(p.zf[m * 1792 + 1024 + C]);
    p.abuf[m * 1024 + 512 + C] = f2bf((hf + hb) * g);
    if (t == 0) hb_first = hb;
    if (t == 63) hf_last = hf;
  }
  if (!lat) {
    if (k == nt - 1) p.out[OFF_ST + ((size_t)(b * 2 + l) * 2 + 0) * 256 + C] = hf_last;
    if (k == 0) p.out[OFF_ST + ((size_t)(b * 2 + l) * 2 + 1) * 256 + C] = hb_first;
  }
}

DEV void mixer_phase(const Params& p, int l, char* smem) {
  const int NITEMS = 1024 + 256 + 512 + 1024;
  for (int it = blockIdx.x; it < NITEMS; it += gridDim.x) {
    if (it < 1024) attn_item(p, l, it, smem);
    else if (it < 1280) lru_apply_item(p, l, it - 1024);
    else if (it < 1792) gmlp_item(p, l, it - 1280, smem);
    else attn_item(p, l, it - 1792 + 1024, smem);
  }
}

DEV void prep_phase_full(const Params& p, int l, char* smem) {
  const int NITEMS = 1024 + 4096;
  for (int it = blockIdx.x; it < NITEMS; it += gridDim.x) {
    if (it < 1024) lru_gate_item(p, l, it, smem);
    else prep_token_row(p, l, (it - 1024) * 4 + (threadIdx.x >> 6), threadIdx.x & 63);
  }
}

#define PH(i, call) if (ph_lo <= (i) && (i) < ph_hi) { if ((i) > ph_lo) grid.sync(); call; }
#define LAYER(l, b) \
  PH(b + 0, ln_mod_phase(p, l, l == 0 ? 0 : 1)) \
  PH(b + 1, gemm_phase<1>(p, l, p.abuf, p.wt_in + (size_t)l * 1792 * 1024, 1792, 1024, smem)) \
  PH(b + 2, prep_phase_full(p, l, smem)) \
  PH(b + 3, mixer_phase(p, l, smem)) \
  PH(b + 4, gemm_phase<2>(p, l, p.abuf, p.wt_out + (size_t)l * 1024 * 1024, 1024, 1024, smem)) \
  PH(b + 5, ln_mod_phase(p, l, 2)) \
  PH(b + 6, gemm_phase<3>(p, l, p.abuf, p.wt_ff1 + (size_t)l * 4096 * 1024, 4096, 1024, smem)) \
  PH(b + 7, gemm_phase<4>(p, l, p.zf, p.wt_ff2 + (size_t)l * 1024 * 4096, 1024, 4096, smem))

__global__ void __launch_bounds__(256, 2) mega_kernel(Params p, int ph_lo, int ph_hi) {
  extern __shared__ __attribute__((aligned(16))) char smem[];
  cg::grid_group grid = cg::this_grid();
  PH(0, phase0(p, smem))
  LAYER(0, 1)
  LAYER(1, 9)
  PH(17, ln_mod_phase(p, 1, 3))
}

extern "C" void kernel_launch(void* const* d_in, const int* in_sizes, int n_in, void* d_out, int out_size, void* d_ws, size_t ws_size,
                              hipStream_t stream) {
  static int grid_blocks = 0;
  if (!grid_blocks) {
    int dev = 0, cus = 0, per_cu = 0;
    hipGetDevice(&dev);
    hipDeviceGetAttribute(&cus, hipDeviceAttributeMultiprocessorCount, dev);
    hipFuncSetAttribute((const void*)mega_kernel, hipFuncAttributeMaxDynamicSharedMemorySize, SMEM_BYTES);
    hipOccupancyMaxActiveBlocksPerMultiprocessor(&per_cu, (const void*)mega_kernel, 256, SMEM_BYTES);
    if (per_cu < 1) per_cu = 1;
    if (per_cu > 2) per_cu = 2;
    grid_blocks = cus * per_cu;
  }
  Params p{};
  const float** pin = (const float**)&p;
  for (int i = 0; i < 32; ++i) pin[i] = (const float*)d_in[i];
  p.out = (float*)d_out;
  char* ws = (char*)d_ws;
  size_t off = 0;
  p.wt_in = (bf16_t*)(ws + off); off += (size_t)2 * 1792 * 1024 * 2;
  p.wt_out = (bf16_t*)(ws + off); off += (size_t)2 * 1024 * 1024 * 2;
  p.wt_ff1 = (bf16_t*)(ws + off); off += (size_t)2 * 4096 * 1024 * 2;
  p.wt_ff2 = (bf16_t*)(ws + off); off += (size_t)2 * 4096 * 1024 * 2;
  p.wt_lru = (bf16_t*)(ws + off); off += (size_t)64 * 4096 * 2;
  p.mod = (float*)(ws + off); off += (size_t)2 * 9 * 6144 * 4;
  p.rope = (float*)(ws + off); off += (size_t)2048 * 4;
  p.abuf = (bf16_t*)(ws + off); off += (size_t)MT * 1024 * 2;
  p.zf = (bf16_t*)(ws + off);
  p.au = (float*)(ws + off + (size_t)MT * 1792 * 2);
  off += (size_t)MT * 4096 * 2;
  if (off > ws_size) { fprintf(stderr, "workspace too small: need %zu have %zu\n", off, ws_size); return; }
#if MULTI_LAUNCH
  for (int ph = 0; ph < NPHASE; ++ph) {
    hipLaunchKernelGGL(mega_kernel, dim3(grid_blocks), dim3(256), SMEM_BYTES, stream, p, ph, ph + 1);
  }
#else
  int lo = 0, hi = NPHASE;
  void* args[] = {&p, &lo, &hi};
  hipError_t e = hipLaunchCooperativeKernel((void*)mega_kernel, dim3(grid_blocks), dim3(256), args, SMEM_BYTES, stream);
  if (e != hipSuccess) fprintf(stderr, "cooperative launch failed: %s (grid %d)\n", hipGetErrorString(e), grid_blocks);
#endif
}
```

```cpp
#include <hip/hip_runtime.h>
#include <hip/hip_cooperative_groups.h>
#include <cstdio>
#include <cstdint>
namespace cg = cooperative_groups;

#ifndef MULTI_LAUNCH
#define MULTI_LAUNCH 0
#endif

typedef unsigned short bf16_t;
using bf16x8 = __attribute__((ext_vector_type(8))) short;
using f32x4 = __attribute__((ext_vector_type(4))) float;
#define DEV __device__ __forceinline__

constexpr int MT = 16384;
constexpr int NPHASE = 18;
constexpr size_t OFF_YK = 16777216, OFF_YV = OFF_YK + 2097152, OFF_ST = OFF_YV + 2097152;
constexpr float ALPHA = 1.41421356237f;
constexpr int SMEM_BYTES = 73728;

struct Params {
  const float *x_prompt, *x_sample, *c, *cache_k, *cache_v, *state_lru, *c_ctx, *w_ada, *b_ada, *w_in,
      *q_g, *k_g, *conv_w, *conv_b, *lru_wa, *lru_ba, *lru_wx, *lru_bx, *lru_lam, *mlp_g, *mlp_b, *mlp_ws, *mlp_bs,
      *w_out, *ln1_g, *ln1_b, *w_ff1, *b_ff1, *w_ff2, *b_ff2, *ln2_g, *ln2_b;
  float* out;
  bf16_t *wt_in, *wt_out, *wt_ff1, *wt_ff2, *wt_lru;
  float *mod, *rope;
  bf16_t *abuf;
  bf16_t *zf;
  float *au;
  unsigned *bar;
};

union U8 { uint4 u; bf16x8 v; bf16_t h[8]; unsigned w[4]; };

DEV float bf2f(bf16_t h) { return __uint_as_float(((unsigned)h) << 16); }
DEV bf16_t f2bf(float f) { unsigned u = __float_as_uint(f); u += 0x7fffu + ((u >> 16) & 1u); return (bf16_t)(u >> 16); }
DEV unsigned pack2(float a, float b) { return (unsigned)f2bf(a) | ((unsigned)f2bf(b) << 16); }
DEV float gelu_t(float x) { float y = 0.7978845608028654f * (x + 0.044715f * x * x * x); float t = 1.f - 2.f / (1.f + __expf(2.f * y)); return 0.5f * x * (1.f + t); }
DEV float sigmoidf_(float x) { return 1.f / (1.f + __expf(-x)); }
DEV int cond_of(int m) { return m < 8192 ? 0 : 1 + ((m - 8192) >> 10); }
DEV f32x4 mfma16(bf16x8 a, bf16x8 b, f32x4 c) { return __builtin_amdgcn_mfma_f32_16x16x32_bf16(a, b, c, 0, 0, 0); }
DEV float wave_sum(float v) {
#pragma unroll
  for (int o = 32; o >= 1; o >>= 1) v += __shfl_xor(v, o);
  return v;
}

DEV void transpose_tile(const float* __restrict__ src, bf16_t* __restrict__ dst, int K, int N, int tk, int tn, char* smem) {
  float* T = (float*)smem;
  const int tid = threadIdx.x;
#pragma unroll
  for (int i = 0; i < 4; ++i) {
    int k = (tid >> 4) + 16 * i, n4 = (tid & 15) * 4;
    float4 v = *(const float4*)(src + (size_t)(tk * 64 + k) * N + tn * 64 + n4);
    T[k * 65 + n4 + 0] = v.x; T[k * 65 + n4 + 1] = v.y; T[k * 65 + n4 + 2] = v.z; T[k * 65 + n4 + 3] = v.w;
  }
  __syncthreads();
#pragma unroll
  for (int i = 0; i < 2; ++i) {
    int n = (tid >> 3) + 32 * i, k8 = (tid & 7) * 8;
    U8 o;
#pragma unroll
    for (int j = 0; j < 4; ++j) o.w[j] = pack2(T[(k8 + 2 * j) * 65 + n], T[(k8 + 2 * j + 1) * 65 + n]);
    *(uint4*)(dst + (size_t)(tn * 64 + n) * K + tk * 64 + k8) = o.u;
  }
  __syncthreads();
}

DEV void phase0(const Params& p, char* smem) {
  const int tid = threadIdx.x;
  const int NITEMS = 193 + 2 * 2768;
  for (int it = blockIdx.x; it < NITEMS; it += gridDim.x) {
    if (it < 192) {
      const int l = it / 96, n0 = (it % 96) * 64;
      float* s = (float*)smem;
      float* red = s + 9 * 1024;
      for (int idx = tid; idx < 9 * 1024; idx += 256) {
        int c = idx >> 10, k = idx & 1023;
        float v = (c == 0) ? p.c_ctx[k] : p.c[(c - 1) * 1024 + k];
        s[idx] = v / (1.f + __expf(-v));
      }
      __syncthreads();
      const int kq = tid >> 6, n = tid & 63;
      float acc[9];
#pragma unroll
      for (int c = 0; c < 9; ++c) acc[c] = 0.f;
      const float* wp = p.w_ada + ((size_t)l * 1024 + kq * 256) * 6144 + n0 + n;
#pragma unroll 4
      for (int k = 0; k < 256; ++k) {
        float wv = wp[(size_t)k * 6144];
#pragma unroll
        for (int c = 0; c < 9; ++c) acc[c] += s[c * 1024 + kq * 256 + k] * wv;
      }
#pragma unroll
      for (int c = 0; c < 9; ++c) red[(kq * 9 + c) * 64 + n] = acc[c];
      __syncthreads();
      for (int idx = tid; idx < 576; idx += 256) {
        int c = idx >> 6, nn = idx & 63;
        float v = red[(0 * 9 + c) * 64 + nn] + red[(1 * 9 + c) * 64 + nn] + red[(2 * 9 + c) * 64 + nn] + red[(3 * 9 + c) * 64 + nn] +
                  p.b_ada[l * 6144 + n0 + nn];
        p.mod[((size_t)l * 9 + c) * 6144 + n0 + nn] = v;
      }
      __syncthreads();
    } else if (it == 192) {
      for (int idx = tid; idx < 1024; idx += 256) {
        int pp = idx >> 4, f = idx & 15;
        float inv = powf(10000.f, -(float)f / 16.f);
        float ang = (float)pp * inv;
        float nrev = rintf(ang * 0.15915494309189535f);
        float r = fmaf(-nrev, 6.28125f, ang);
        r = fmaf(-nrev, 0.0019353071795864769f, r);
        p.rope[idx * 2 + 0] = __cosf(r);
        p.rope[idx * 2 + 1] = __sinf(r);
      }
    } else {
      int t = it - 193;
      const int l = t / 2768, r = t % 2768;
      if (r < 448) transpose_tile(p.w_in + (size_t)l * 1024 * 1792, p.wt_in + (size_t)l * 1792 * 1024, 1024, 1792, r / 28, r % 28, smem);
      else if (r < 704) { int i = r - 448; transpose_tile(p.w_out + (size_t)l * 1024 * 1024, p.wt_out + (size_t)l * 1024 * 1024, 1024, 1024, i / 16, i % 16, smem); }
      else if (r < 1728) { int i = r - 704; transpose_tile(p.w_ff1 + (size_t)l * 1024 * 4096, p.wt_ff1 + (size_t)l * 4096 * 1024, 1024, 4096, i / 64, i % 64, smem); }
      else if (r < 2752) { int i = r - 1728; transpose_tile(p.w_ff2 + (size_t)l * 4096 * 1024, p.wt_ff2 + (size_t)l * 1024 * 4096, 4096, 1024, i / 16, i % 16, smem); }
      else {
        int idx = r - 2752;
        int dir = idx >> 3, blk = (idx >> 1) & 3, mat = idx & 1;
        const float* src = (mat == 0 ? p.lru_wa : p.lru_wx) + (size_t)(((l * 2 + dir) * 4 + blk)) * 4096;
        bf16_t* dst = p.wt_lru + (size_t)((((l * 2 + dir) * 4 + blk) * 2 + mat)) * 4096;
        transpose_tile(src, dst, 64, 64, 0, 0, smem);
      }
    }
  }
}

DEV void ln_mod_phase(const Params& p, int l, int mode) {
  const int lane = threadIdx.x & 63, w = threadIdx.x >> 6;
  const float* lg = nullptr; const float* lb = nullptr;
  if (mode == 1) { lg = p.ln2_g + (l - 1) * 1024; lb = p.ln2_b + (l - 1) * 1024; }
  else if (mode == 2) { lg = p.ln1_g + l * 1024; lb = p.ln1_b + l * 1024; }
  else if (mode == 3) { lg = p.ln2_g + l * 1024; lb = p.ln2_b + l * 1024; }
  const int shoff = (mode == 2) ? 3072 : 0;
  for (int m = blockIdx.x * 4 + w; m < MT; m += gridDim.x * 4) {
    const float* src;
    if (mode == 0) src = (m < 8192) ? p.x_prompt + (size_t)m * 1024 : p.x_sample + (size_t)(m - 8192) * 1024;
    else src = p.out + (size_t)m * 1024;
    float4 v[4];
#pragma unroll
    for (int i = 0; i < 4; ++i) v[i] = *(const float4*)(src + i * 256 + lane * 4);
    if (mode != 0) {
      float s = 0.f;
#pragma unroll
      for (int i = 0; i < 4; ++i) s += v[i].x + v[i].y + v[i].z + v[i].w;
      const float mean = wave_sum(s) * (1.f / 1024.f);
      float s2 = 0.f;
#pragma unroll
      for (int i = 0; i < 4; ++i) { float a = v[i].x - mean, b = v[i].y - mean, c = v[i].z - mean, d = v[i].w - mean; s2 += a * a + b * b + c * c + d * d; }
      const float rstd = rsqrtf(wave_sum(s2) * (1.f / 1024.f) + 1e-6f);
#pragma unroll
      for (int i = 0; i < 4; ++i) {
        float4 g = *(const float4*)(lg + i * 256 + lane * 4), b = *(const float4*)(lb + i * 256 + lane * 4);
        v[i].x = (v[i].x - mean) * rstd * g.x + b.x; v[i].y = (v[i].y - mean) * rstd * g.y + b.y;
        v[i].z = (v[i].z - mean) * rstd * g.z + b.z; v[i].w = (v[i].w - mean) * rstd * g.w + b.w;
        *(float4*)(p.out + (size_t)m * 1024 + i * 256 + lane * 4) = v[i];
      }
    }
    if (mode != 3) {
      const float* md = p.mod + ((size_t)l * 9 + cond_of(m)) * 6144 + shoff;
#pragma unroll
      for (int i = 0; i < 4; ++i) {
        float4 sh = *(const float4*)(md + i * 256 + lane * 4), sc = *(const float4*)(md + 1024 + i * 256 + lane * 4);
        uint2 o;
        o.x = pack2(v[i].x * (1.f + sc.x) + sh.x, v[i].y * (1.f + sc.y) + sh.y);
        o.y = pack2(v[i].z * (1.f + sc.z) + sh.z, v[i].w * (1.f + sc.w) + sh.w);
        *(uint2*)(p.abuf + (size_t)m * 1024 + i * 256 + lane * 4) = o;
      }
    }
  }
}

template <int EPI>
DEV void gemm_tile(const Params& p, int l, const bf16_t* __restrict__ A, const bf16_t* __restrict__ Bt, int N, int K, int tm, int tn, char* smem) {
  bf16_t* As = (bf16_t*)smem;
  bf16_t* Bs = As + 2 * 128 * 72;
  const int tid = threadIdx.x, lane = tid & 63, w = tid >> 6;
  const int wm = w >> 1, wn = w & 1, q = lane >> 4, c15 = lane & 15;
  const int lr = tid >> 3, lc = (tid & 7) * 8;
  const bf16_t* Ag = A + (size_t)(tm * 128 + lr) * K + lc;
  const bf16_t* Bg = Bt + (size_t)(tn * 128 + lr) * K + lc;
  uint4 ra[4], rb[4];
#pragma unroll
  for (int i = 0; i < 4; ++i) { ra[i] = *(const uint4*)(Ag + (size_t)i * 32 * K); rb[i] = *(const uint4*)(Bg + (size_t)i * 32 * K); }
#pragma unroll
  for (int i = 0; i < 4; ++i) { *(uint4*)(As + (lr + 32 * i) * 72 + lc) = ra[i]; *(uint4*)(Bs + (lr + 32 * i) * 72 + lc) = rb[i]; }
  __syncthreads();
  f32x4 acc[4][4];
#pragma unroll
  for (int i = 0; i < 4; ++i)
#pragma unroll
    for (int j = 0; j < 4; ++j) acc[i][j] = f32x4{0.f, 0.f, 0.f, 0.f};
  const int nk = K >> 6;
  for (int kt = 0; kt < nk; ++kt) {
    const int cur = kt & 1;
    if (kt + 1 < nk) {
#pragma unroll
      for (int i = 0; i < 4; ++i) { ra[i] = *(const uint4*)(Ag + (size_t)i * 32 * K + (kt + 1) * 64); rb[i] = *(const uint4*)(Bg + (size_t)i * 32 * K + (kt + 1) * 64); }
    }
    const bf16_t* as = As + cur * 128 * 72 + (wm * 64 + c15) * 72 + q * 8;
    const bf16_t* bs = Bs + cur * 128 * 72 + (wn * 64 + c15) * 72 + q * 8;
#pragma unroll
    for (int s = 0; s < 2; ++s) {
      bf16x8 af[4], bfr[4];
#pragma unroll
      for (int i = 0; i < 4; ++i) af[i] = *(const bf16x8*)(as + i * 16 * 72 + s * 32);
#pragma unroll
      for (int j = 0; j < 4; ++j) bfr[j] = *(const bf16x8*)(bs + j * 16 * 72 + s * 32);
#pragma unroll
      for (int i = 0; i < 4; ++i)
#pragma unroll
        for (int j = 0; j < 4; ++j) acc[i][j] = mfma16(af[i], bfr[j], acc[i][j]);
    }
    if (kt + 1 < nk) {
      bf16_t* ad = As + (cur ^ 1) * 128 * 72; bf16_t* bd = Bs + (cur ^ 1) * 128 * 72;
#pragma unroll
      for (int i = 0; i < 4; ++i) { *(uint4*)(ad + (lr + 32 * i) * 72 + lc) = ra[i]; *(uint4*)(bd + (lr + 32 * i) * 72 + lc) = rb[i]; }
    }
    __syncthreads();
  }
  const int cond = cond_of(tm * 128);
  const float* md = p.mod + ((size_t)l * 9 + cond) * 6144;
#pragma unroll
  for (int j = 0; j < 4; ++j) {
    const int col = tn * 128 + wn * 64 + j * 16 + c15;
    float gate = 0.f, bias = 0.f;
    if (EPI == 2) gate = md[2048 + col];
    if (EPI == 3) bias = p.b_ff1[l * 4096 + col];
    if (EPI == 4) { gate = md[5120 + col]; bias = p.b_ff2[l * 1024 + col]; }
#pragma unroll
    for (int i = 0; i < 4; ++i) {
#pragma unroll
      for (int r = 0; r < 4; ++r) {
        const int row = tm * 128 + wm * 64 + i * 16 + q * 4 + r;
        const float v = acc[i][j][r];
        if (EPI == 1) p.zf[(size_t)row * 1792 + col] = f2bf(v);
        else if (EPI == 2) {
          float x;
          if (l == 0) x = (row < 8192) ? p.x_prompt[(size_t)row * 1024 + col] : p.x_sample[(size_t)(row - 8192) * 1024 + col];
          else x = p.out[(size_t)row * 1024 + col];
          p.out[(size_t)row * 1024 + col] = ALPHA * x + gate * v;
        } else if (EPI == 3) { float t = fmaxf(v + bias, 0.f); p.zf[(size_t)row * 4096 + col] = f2bf(t * t); }
        else { float x = p.out[(size_t)row * 1024 + col]; p.out[(size_t)row * 1024 + col] = ALPHA * x + gate * (v + bias); }
      }
    }
  }
}

template <int EPI>
DEV void gemm_phase(const Params& p, int l, const bf16_t* A, const bf16_t* Bt, int N, int K, char* smem) {
  const int tn_count = N >> 7, ntiles = 128 * tn_count;
  for (int t = blockIdx.x; t < ntiles; t += gridDim.x) gemm_tile<EPI>(p, l, A, Bt, N, K, t / tn_count, t % tn_count, smem);
}

DEV void rope8(float (&v)[8], int d0, int prow, int pcol, const float* __restrict__ rope) {
  const int pp = (d0 < 32) ? prow : pcol;
#pragma unroll
  for (int i = 0; i < 4; ++i) {
    const int f = ((d0 >> 1) + i) & 15;
    const float cs = rope[(pp * 16 + f) * 2], sn = rope[(pp * 16 + f) * 2 + 1];
    const float x1 = v[2 * i], x2 = v[2 * i + 1];
    v[2 * i] = x1 * cs - x2 * sn; v[2 * i + 1] = x1 * sn + x2 * cs;
  }
}

DEV void prep_token_row(const Params& p, int l, int m, int lane) {
  bf16_t* zr = p.zf + (size_t)m * 1792;
  const bool lat = m >= 8192;
  const int pos = lat ? ((m - 8192) & 1023) : (m & 255);
  const int prow = pos >> 6, pcol = pos & 63;
  const int d0 = (lane & 7) * 8;
  {
    U8 u; u.u = *(const uint4*)(zr + lane * 8);
    float v[8]; float ss = 0.f;
#pragma unroll
    for (int j = 0; j < 8; ++j) { v[j] = bf2f(u.h[j]); ss += v[j] * v[j]; }
    ss += __shfl_xor(ss, 1); ss += __shfl_xor(ss, 2); ss += __shfl_xor(ss, 4);
    const float rinv = rsqrtf(ss * (1.f / 64.f) + 1e-6f);
#pragma unroll
    for (int j = 0; j < 8; ++j) v[j] = v[j] * rinv * p.q_g[l * 64 + d0 + j];
    if (lat) rope8(v, d0, prow, pcol, p.rope);
#pragma unroll
    for (int j = 0; j < 4; ++j) u.w[j] = pack2(v[2 * j] * 0.125f, v[2 * j + 1] * 0.125f);
    *(uint4*)(zr + lane * 8) = u.u;
  }
  {
    const int col = lane < 32 ? 512 + lane * 8 : 1024 + (lane - 32) * 8;
    U8 u; u.u = *(const uint4*)(zr + col);
    float v[8]; float ss = 0.f;
#pragma unroll
    for (int j = 0; j < 8; ++j) { v[j] = bf2f(u.h[j]); ss += v[j] * v[j]; }
    ss += __shfl_xor(ss, 1); ss += __shfl_xor(ss, 2); ss += __shfl_xor(ss, 4);
    if (lane < 16) {
      const float rinv = rsqrtf(ss * (1.f / 64.f) + 1e-6f);
#pragma unroll
      for (int j = 0; j < 8; ++j) v[j] = v[j] * rinv * p.k_g[l * 64 + d0 + j];
      if (!lat) {
        float* o = p.out + OFF_YK + ((((size_t)(m >> 8)) * 2 + l) * 256 + pos) * 128 + lane * 8;
        *(float4*)o = make_float4(v[0], v[1], v[2], v[3]); *(float4*)(o + 4) = make_float4(v[4], v[5], v[6], v[7]);
      } else rope8(v, d0, prow, pcol, p.rope);
#pragma unroll
      for (int j = 0; j < 4; ++j) u.w[j] = pack2(v[2 * j], v[2 * j + 1]);
      *(uint4*)(zr + col) = u.u;
    } else if (lane < 32) {
      if (!lat) {
        float* o = p.out + OFF_YV + ((((size_t)(m >> 8)) * 2 + l) * 256 + pos) * 128 + (lane - 16) * 8;
        *(float4*)o = make_float4(v[0], v[1], v[2], v[3]); *(float4*)(o + 4) = make_float4(v[4], v[5], v[6], v[7]);
      }
    } else {
#pragma unroll
      for (int j = 0; j < 4; ++j) u.w[j] = pack2(gelu_t(v[2 * j]), gelu_t(v[2 * j + 1]));
      *(uint4*)(zr + col) = u.u;
    }
  }
  {
    const int col = 1280 + lane * 8;
    U8 u; u.u = *(const uint4*)(zr + col);
    float v[8]; float s = 0.f;
#pragma unroll
    for (int j = 0; j < 8; ++j) { v[j] = gelu_t(bf2f(u.h[j])); s += v[j]; }
#pragma unroll
    for (int o = 1; o <= 16; o <<= 1) s += __shfl_xor(s, o);
    const float mean = s * (1.f / 256.f);
    float s2 = 0.f;
#pragma unroll
    for (int j = 0; j < 8; ++j) { float d = v[j] - mean; s2 += d * d; }
#pragma unroll
    for (int o = 1; o <= 16; o <<= 1) s2 += __shfl_xor(s2, o);
    if (lane >= 32) {
      const float rstd = rsqrtf(s2 * (1.f / 256.f) + 1e-6f);
      const int ch = (lane - 32) * 8;
#pragma unroll
      for (int j = 0; j < 8; ++j) v[j] = (v[j] - mean) * rstd * p.mlp_g[l * 256 + ch + j] + p.mlp_b[l * 256 + ch + j];
    }
#pragma unroll
    for (int j = 0; j < 4; ++j) u.w[j] = pack2(v[2 * j], v[2 * j + 1]);
    *(uint4*)(zr + col) = u.u;
  }
}

template <bool REV>
DEV void tile_scan(float (&a)[4][4], float (&u)[4][4], int lane) {
  const int q = lane >> 4;
  float C = 0.f, CP = 1.f;
  const int src1 = (REV ? lane + 16 : lane - 16) & 63;
  const int src2 = (REV ? lane + 32 : lane - 32) & 63;
  const int srcT = (lane & 15) + (REV ? 0 : 48);
  const bool c1 = REV ? (q <= 2) : (q >= 1);
  const bool c2 = REV ? (q <= 1) : (q >= 2);
  const bool first = REV ? (q == 3) : (q == 0);
#pragma unroll
  for (int mi = 0; mi < 4; ++mi) {
    const int mt = REV ? 3 - mi : mi;
    float P = 1.f, H = 0.f, pl[4], hl[4];
#pragma unroll
    for (int ri = 0; ri < 4; ++ri) {
      const int r = REV ? 3 - ri : ri;
      H = a[mt][r] * H + u[mt][r]; P *= a[mt][r]; pl[r] = P; hl[r] = H;
    }
    float Pi = P, Hi = H;
    float Pp = __shfl(Pi, src1), Hp = __shfl(Hi, src1);
    if (c1) { Hi = Pi * Hp + Hi; Pi = Pi * Pp; }
    Pp = __shfl(Pi, src2); Hp = __shfl(Hi, src2);
    if (c2) { Hi = Pi * Hp + Hi; Pi = Pi * Pp; }
    float Pe = __shfl(Pi, src1), He = __shfl(Hi, src1);
    if (first) { Pe = 1.f; He = 0.f; }
    const float hin = Pe * C + He, pin = Pe * CP;
#pragma unroll
    for (int r = 0; r < 4; ++r) { u[mt][r] = pl[r] * hin + hl[r]; a[mt][r] = pl[r] * pin; }
    const float Pt = __shfl(Pi, srcT), Ht = __shfl(Hi, srcT);
    C = Pt * C + Ht; CP = Pt * CP;
  }
}

DEV void lru_gate_item(const Params& p, int l, int item, char* smem) {
  const int tid = threadIdx.x, lane = tid & 63, w = tid >> 6;
  const int tile = item >> 2, blk = item & 3;
  const int m0 = tile * 64;
  int ms, L;
  if (m0 < 8192) { ms = m0 & ~255; L = 256; } else { ms = 8192 + ((m0 - 8192) & ~1023); L = 1024; }
  float* xs = (float*)smem;
  float* xcf = xs + 67 * 64;
  bf16_t* xcb = (bf16_t*)(xcf + 64 * 64);
  for (int idx = tid; idx < 67 * 8; idx += 256) {
    const int rr = idx >> 3, cc = idx & 7;
    const int m = m0 - 1 + rr;
    float v[8];
    if (m >= ms && m < ms + L) {
      U8 u; u.u = *(const uint4*)(p.zf + (size_t)m * 1792 + 768 + blk * 64 + cc * 8);
#pragma unroll
      for (int j = 0; j < 8; ++j) v[j] = bf2f(u.h[j]);
    } else {
#pragma unroll
      for (int j = 0; j < 8; ++j) v[j] = 0.f;
    }
#pragma unroll
    for (int j = 0; j < 8; ++j) xs[rr * 64 + cc * 8 + j] = v[j];
  }
  __syncthreads();
  {
    const int ch = tid & 63, Cg = blk * 64 + ch;
    const float w0 = p.conv_w[(l * 4 + 0) * 256 + Cg], w1 = p.conv_w[(l * 4 + 1) * 256 + Cg], w2 = p.conv_w[(l * 4 + 2) * 256 + Cg],
                w3 = p.conv_w[(l * 4 + 3) * 256 + Cg], cb = p.conv_b[l * 256 + Cg];
#pragma unroll 4
    for (int tt = 0; tt < 16; ++tt) {
      const int t = (tid >> 6) * 16 + tt;
      const float v = cb + w0 * xs[t * 64 + ch] + w1 * xs[(t + 1) * 64 + ch] + w2 * xs[(t + 2) * 64 + ch] + w3 * xs[(t + 3) * 64 + ch];
      xcf[t * 64 + ch] = v; xcb[t * 72 + ch] = f2bf(v);
    }
  }
  __syncthreads();
  const int dir = w >> 1, half = w & 1, q = lane >> 4, c15 = lane & 15;
  const bf16_t* wt = p.wt_lru + (size_t)((((l * 2 + dir) * 4 + blk) * 2)) * 4096;
  bf16x8 bfr[2][2][2];
#pragma unroll
  for (int mat = 0; mat < 2; ++mat)
#pragma unroll
    for (int j = 0; j < 2; ++j)
#pragma unroll
      for (int s = 0; s < 2; ++s) bfr[mat][j][s] = *(const bf16x8*)(wt + mat * 4096 + (half * 32 + j * 16 + c15) * 64 + s * 32 + q * 8);
  f32x4 acc[2][4][2];
#pragma unroll
  for (int mat = 0; mat < 2; ++mat)
#pragma unroll
    for (int mt = 0; mt < 4; ++mt)
#pragma unroll
      for (int j = 0; j < 2; ++j) acc[mat][mt][j] = f32x4{0.f, 0.f, 0.f, 0.f};
#pragma unroll
  for (int mt = 0; mt < 4; ++mt)
#pragma unroll
    for (int s = 0; s < 2; ++s) {
      const bf16x8 af = *(const bf16x8*)(xcb + (mt * 16 + c15) * 72 + s * 32 + q * 8);
#pragma unroll
      for (int mat = 0; mat < 2; ++mat)
#pragma unroll
        for (int j = 0; j < 2; ++j) acc[mat][mt][j] = mfma16(af, bfr[mat][j][s], acc[mat][mt][j]);
    }
  float* PCp = p.au + (size_t)(dir * 2 + 0) * MT * 256;
  float* HLp = p.au + (size_t)(dir * 2 + 1) * MT * 256;
#pragma unroll
  for (int j = 0; j < 2; ++j) {
    const int ch = half * 32 + j * 16 + c15, Cg = blk * 64 + ch, pidx = (l * 2 + dir) * 256 + Cg;
    const float ba = p.lru_ba[pidx], bx = p.lru_bx[pidx], lam = p.lru_lam[pidx];
    const float xn = -lam;
    const float sp = fmaxf(xn, 0.f) + log1pf(expf(-fabsf(xn)));
    const float cdec = -8.f * sp;
    float a[4][4], u[4][4];
#pragma unroll
    for (int mt = 0; mt < 4; ++mt)
#pragma unroll
      for (int r = 0; r < 4; ++r) {
        const int t = mt * 16 + q * 4 + r;
        const float rg = sigmoidf_(acc[0][mt][j][r] + ba), ig = sigmoidf_(acc[1][mt][j][r] + bx);
        const float la = cdec * rg;
        a[mt][r] = __expf(la);
        u[mt][r] = sqrtf(-expm1f(2.f * la)) * ig * xcf[t * 64 + ch];
      }
    if (dir == 0) tile_scan<false>(a, u, lane); else tile_scan<true>(a, u, lane);
#pragma unroll
    for (int mt = 0; mt < 4; ++mt)
#pragma unroll
      for (int r = 0; r < 4; ++r) {
        const size_t m = m0 + mt * 16 + q * 4 + r;
        PCp[m * 256 + Cg] = a[mt][r]; HLp[m * 256 + Cg] = u[mt][r];
      }
  }
  __syncthreads();
}

DEV void attn_item(const Params& p, int l, int it, char* smem) {
  const int tid = threadIdx.x, lane = tid & 63, w = tid >> 6, q = lane >> 4, c15 = lane & 15;
  int b, h, qb, ms, nkt; bool lat;
  if (it < 1024) { lat = true; b = it >> 7; h = (it >> 4) & 7; qb = it & 15; ms = 8192 + b * 1024; nkt = 20; }
  else { const int i2 = it - 1024; lat = false; b = i2 >> 5; h = (i2 >> 2) & 7; qb = i2 & 3; ms = b * 256; nkt = 4; }
  const int kvh = h >> 2;
  bf16_t* Ks = (bf16_t*)smem;
  bf16_t* Vt = Ks + 64 * 72;
  bf16_t* Pw = Vt + 64 * 72 + w * 16 * 72;
  const int mq = ms + qb * 64 + w * 16;
  bf16x8 qf[2];
#pragma unroll
  for (int s = 0; s < 2; ++s) qf[s] = *(const bf16x8*)(p.zf + (size_t)(mq + c15) * 1792 + h * 64 + s * 32 + q * 8);
  f32x4 o[4];
  float mrow[4], lrow[4];
#pragma unroll
  for (int j = 0; j < 4; ++j) { o[j] = f32x4{0.f, 0.f, 0.f, 0.f}; mrow[j] = -1e30f; lrow[j] = 0.f; }
  for (int kt = 0; kt < nkt; ++kt) {
#pragma unroll
    for (int i = 0; i < 2; ++i) {
      const int id = tid + 256 * i, key = id >> 3, cc = id & 7;
      U8 kk, vv;
      if (lat && kt < 4) {
        const int t = kt * 64 + key;
        const size_t off = ((((size_t)b * 2 + l) * 256 + t) * 2 + kvh) * 64 + cc * 8;
        const float4 a0 = *(const float4*)(p.cache_k + off), a1 = *(const float4*)(p.cache_k + off + 4);
        kk.w[0] = pack2(a0.x, a0.y); kk.w[1] = pack2(a0.z, a0.w); kk.w[2] = pack2(a1.x, a1.y); kk.w[3] = pack2(a1.z, a1.w);
        const float4 b0 = *(const float4*)(p.cache_v + off), b1 = *(const float4*)(p.cache_v + off + 4);
        vv.w[0] = pack2(b0.x, b0.y); vv.w[1] = pack2(b0.z, b0.w); vv.w[2] = pack2(b1.x, b1.y); vv.w[3] = pack2(b1.z, b1.w);
      } else {
        const int t = lat ? (kt - 4) * 64 + key : kt * 64 + key;
        const bf16_t* zr = p.zf + (size_t)(ms + t) * 1792;
        kk.u = *(const uint4*)(zr + 512 + kvh * 64 + cc * 8);
        vv.u = *(const uint4*)(zr + 640 + kvh * 64 + cc * 8);
      }
      *(uint4*)(Ks + key * 72 + cc * 8) = kk.u;
#pragma unroll
      for (int j = 0; j < 8; ++j) Vt[(cc * 8 + j) * 72 + key] = vv.h[j];
    }
    __syncthreads();
    f32x4 s4[4];
#pragma unroll
    for (int jn = 0; jn < 4; ++jn) {
      s4[jn] = f32x4{0.f, 0.f, 0.f, 0.f};
#pragma unroll
      for (int s = 0; s < 2; ++s) {
        const bf16x8 kb = *(const bf16x8*)(Ks + (jn * 16 + c15) * 72 + s * 32 + q * 8);
        s4[jn] = mfma16(qf[s], kb, s4[jn]);
      }
    }
#pragma unroll
    for (int r = 0; r < 4; ++r) {
      float mx = fmaxf(fmaxf(s4[0][r], s4[1][r]), fmaxf(s4[2][r], s4[3][r]));
      mx = fmaxf(mx, __shfl_xor(mx, 1)); mx = fmaxf(mx, __shfl_xor(mx, 2)); mx = fmaxf(mx, __shfl_xor(mx, 4)); mx = fmaxf(mx, __shfl_xor(mx, 8));
      const float mnew = fmaxf(mrow[r], mx);
      const float alpha = __expf(mrow[r] - mnew);
      mrow[r] = mnew;
      float ls = lrow[r] * alpha;
#pragma unroll
      for (int jn = 0; jn < 4; ++jn) {
        o[jn][r] *= alpha;
        const float pv = __expf(s4[jn][r] - mnew);
        ls += pv;
        Pw[(q * 4 + r) * 72 + jn * 16 + c15] = f2bf(pv);
      }
      lrow[r] = ls;
    }
    __builtin_amdgcn_wave_barrier();
    bf16x8 pf[2];
#pragma unroll
    for (int s = 0; s < 2; ++s) pf[s] = *(const bf16x8*)(Pw + c15 * 72 + s * 32 + q * 8);
#pragma unroll
    for (int jn = 0; jn < 4; ++jn)
#pragma unroll
      for (int s = 0; s < 2; ++s) {
        const bf16x8 vb = *(const bf16x8*)(Vt + (jn * 16 + c15) * 72 + s * 32 + q * 8);
        o[jn] = mfma16(pf[s], vb, o[jn]);
      }
    __syncthreads();
  }
#pragma unroll
  for (int r = 0; r < 4; ++r) {
    float lt = lrow[r];
    lt += __shfl_xor(lt, 1); lt += __shfl_xor(lt, 2); lt += __shfl_xor(lt, 4); lt += __shfl_xor(lt, 8);
    const float inv = 1.f / lt;
    const size_t m = mq + q * 4 + r;
#pragma unroll
    for (int jn = 0; jn < 4; ++jn) p.abuf[m * 1024 + h * 64 + jn * 16 + c15] = f2bf(o[jn][r] * inv);
  }
}

DEV void gmlp_item(const Params& p, int l, int it, char* smem) {
  const int tid = threadIdx.x, lane = tid & 63, w = tid >> 6, q = lane >> 4, c15 = lane & 15;
  const int chunk = it >> 2, g = it & 3, m0 = chunk * 128;
  bf16_t* vt = (bf16_t*)smem;
#pragma unroll
  for (int i = 0; i < 4; ++i) {
    const int id = tid + 256 * i, qq = id >> 3, cc = id & 7;
    U8 v; v.u = *(const uint4*)(p.zf + (size_t)(m0 + qq) * 1792 + 1536 + g * 64 + cc * 8);
#pragma unroll
    for (int j = 0; j < 8; ++j) vt[(cc * 8 + j) * 136 + qq] = v.h[j];
  }
  __syncthreads();
  f32x4 acc[2][4];
#pragma unroll
  for (int i = 0; i < 2; ++i)
#pragma unroll
    for (int jn = 0; jn < 4; ++jn) acc[i][jn] = f32x4{0.f, 0.f, 0.f, 0.f};
  const float* wsg = p.mlp_ws + (size_t)(l * 4 + g) * 16384;
#pragma unroll
  for (int s = 0; s < 4; ++s) {
    U8 af[2];
#pragma unroll
    for (int i = 0; i < 2; ++i) {
      const float* ap = wsg + (w * 32 + i * 16 + c15) * 128 + s * 32 + q * 8;
      const float4 a0 = *(const float4*)ap, a1 = *(const float4*)(ap + 4);
      af[i].w[0] = pack2(a0.x, a0.y); af[i].w[1] = pack2(a0.z, a0.w); af[i].w[2] = pack2(a1.x, a1.y); af[i].w[3] = pack2(a1.z, a1.w);
    }
#pragma unroll
    for (int jn = 0; jn < 4; ++jn) {
      const bf16x8 bb = *(const bf16x8*)(vt + (jn * 16 + c15) * 136 + s * 32 + q * 8);
#pragma unroll
      for (int i = 0; i < 2; ++i) acc[i][jn] = mfma16(af[i].v, bb, acc[i][jn]);
    }
  }
#pragma unroll
  for (int i = 0; i < 2; ++i)
#pragma unroll
    for (int r = 0; r < 4; ++r) {
      const int pp = w * 32 + i * 16 + q * 4 + r;
      const size_t m = m0 + pp;
      const float bsv = p.mlp_bs[(l * 4 + g) * 128 + pp];
#pragma unroll
      for (int jn = 0; jn < 4; ++jn) {
        const int c = jn * 16 + c15;
        const float uu = bf2f(p.zf[m * 1792 + 1280 + g * 64 + c]);
        p.abuf[m * 1024 + 768 + g * 64 + c] = f2bf(uu * (acc[i][jn][r] + bsv));
      }
    }
  __syncthreads();
}

DEV void lru_apply_item(const Params& p, int l, int ti) {
  const int C = threadIdx.x;
  const int m0 = ti * 64;
  int ms, L, b; bool lat = m0 >= 8192;
  if (!lat) { ms = m0 & ~255; L = 256; b = m0 >> 8; } else { ms = 8192 + ((m0 - 8192) & ~1023); L = 1024; b = (m0 - 8192) >> 10; }
  const int k = (m0 - ms) >> 6, nt = L >> 6;
  const float* PCf = p.au; const float* HLf = p.au + (size_t)MT * 256;
  const float* PCb = p.au + (size_t)2 * MT * 256; const float* HLb = p.au + (size_t)3 * MT * 256;
  float cf = lat ? p.state_lru[((size_t)(b * 2 + l) * 2 + 0) * 256 + C] : 0.f;
  float cb = lat ? p.state_lru[((size_t)(b * 2 + l) * 2 + 1) * 256 + C] : 0.f;
  {
    float pc[15], hl[15];
#pragma unroll
    for (int i = 0; i < 15; ++i) {
      const bool act = i < k;
      const size_t e = (size_t)(ms + 64 * i + 63) * 256 + C;
      pc[i] = act ? PCf[e] : 1.f; hl[i] = act ? HLf[e] : 0.f;
    }
#pragma unroll
    for (int i = 0; i < 15; ++i) cf = pc[i] * cf + hl[i];
  }
  {
    float pc[15], hl[15];
#pragma unroll
    for (int i = 0; i < 15; ++i) {
      const int tix = nt - 1 - i;
      const bool act = tix > k;
      const size_t e = (size_t)(ms + 64 * tix) * 256 + C;
      pc[i] = act ? PCb[e] : 1.f; hl[i] = act ? HLb[e] : 0.f;
    }
#pragma unroll
    for (int i = 0; i < 15; ++i) cb = pc[i] * cb + hl[i];
  }
  float hf_last = 0.f, hb_first = 0.f;
#pragma unroll 8
  for (int t = 0; t < 64; ++t) {
    const size_t m = m0 + t;
    const float hf = PCf[m * 256 + C] * cf + HLf[m * 256 + C];
    const float hb = PCb[m * 256 + C] * cb + HLb[m * 256 + C];
    const float g = bf2f(p.zf[m * 1792 + 1024 + C]);
    p.abuf[m * 1024 + 512 + C] = f2bf((hf + hb) * g);
    if (t == 0) hb_first = hb;
    if (t == 63) hf_last = hf;
  }
  if (!lat) {
    if (k == nt - 1) p.out[OFF_ST + ((size_t)(b * 2 + l) * 2 + 0) * 256 + C] = hf_last;
    if (k == 0) p.out[OFF_ST + ((size_t)(b * 2 + l) * 2 + 1) * 256 + C] = hb_first;
  }
}

DEV void mixer_phase(const Params& p, int l, char* smem) {
  const int NITEMS = 1024 + 256 + 512 + 1024;
  for (int it = blockIdx.x; it < NITEMS; it += gridDim.x) {
    if (it < 1024) attn_item(p, l, it, smem);
    else if (it < 1280) lru_apply_item(p, l, it - 1024);
    else if (it < 1792) gmlp_item(p, l, it - 1280, smem);
    else attn_item(p, l, it - 1792 + 1024, smem);
  }
}

DEV void prep_phase_full(const Params& p, int l, char* smem) {
  const int NITEMS = 1024 + 4096;
  for (int it = blockIdx.x; it < NITEMS; it += gridDim.x) {
    if (it < 1024) lru_gate_item(p, l, it, smem);
    else prep_token_row(p, l, (it - 1024) * 4 + (threadIdx.x >> 6), threadIdx.x & 63);
  }
}


#define XB_TMO      128
#define XB_XCNT(j)  (256  + 64 * (j))
#define XB_XSUB(j)  (1280 + 64 * (j))
#define XB_XGEN(j)  (2304 + 64 * (j))
#define XB_TOP      3328
#define XB_TOPGEN   3392
#define XCD_BAR_WORDS 3456
#define XB_SPIN_CAP (1u << 18)
#define LAS __attribute__((address_space(3)))
DEV unsigned xb_ld(unsigned* p) { return __hip_atomic_load(p, __ATOMIC_RELAXED, __HIP_MEMORY_SCOPE_AGENT); }
DEV unsigned xb_add(unsigned* p, unsigned v) { return __hip_atomic_fetch_add(p, v, __ATOMIC_RELAXED, __HIP_MEMORY_SCOPE_AGENT); }
DEV unsigned xb_xcc_id() { return (unsigned)__builtin_amdgcn_s_getreg((3 << 11) | 20) & 0xFu; }
#define XB_SPIN(cond, bar) do { unsigned _sp = 0; while (cond) { __builtin_amdgcn_s_sleep(1); \
    if ((++_sp & 255u) == 0u) { if (xb_ld(&(bar)[XB_TMO])) break; if (_sp > XB_SPIN_CAP) { atomicAdd(&(bar)[XB_TMO], 1u); break; } } } } while (0)
struct XcdBarrier { unsigned* bar; unsigned x; volatile LAS unsigned* st; };
DEV XcdBarrier xcd_barrier_post(unsigned* bar, volatile LAS unsigned* st) {
  XcdBarrier b; b.bar = bar; b.x = xb_xcc_id(); b.st = st;
  if (threadIdx.x == 0) (void)xb_add(&bar[XB_XCNT(b.x)], 1u);
  return b;
}
DEV void xcd_barrier_complete(unsigned* bar, unsigned x, unsigned& nloc, unsigned& nx) {
  const unsigned G = gridDim.x * gridDim.y * gridDim.z;
  unsigned sum, cnt, mine, sp = 0u;
  for (;;) {
    sum = 0u; cnt = 0u; mine = 0u;
#pragma unroll
    for (unsigned j = 0; j < 16; ++j) { const unsigned c = xb_ld(&bar[XB_XCNT(j)]); sum += c; cnt += (c > 0u) ? 1u : 0u; mine = (j == x) ? c : mine; }
    if (sum == G) break;
    __builtin_amdgcn_s_sleep(1);
    if ((++sp & 255u) == 0u) { if (xb_ld(&bar[XB_TMO])) break; if (sp > XB_SPIN_CAP) { atomicAdd(&bar[XB_TMO], 1u); break; } }
  }
  nloc = mine > 0u ? mine : 1u; nx = cnt > 0u ? cnt : 1u;
}
DEV void xcd_barrier(const XcdBarrier& b) {
  asm volatile("s_waitcnt vmcnt(0)" ::: "memory");
  __syncthreads();
  if (threadIdx.x == 0) {
    unsigned* bar = b.bar;
    __builtin_amdgcn_s_waitcnt(0);
    unsigned nloc = b.st[0], nx = b.st[1];
    if (nloc == 0u) { xcd_barrier_complete(bar, b.x, nloc, nx); b.st[0] = nloc; b.st[1] = nx; }
    const unsigned old = xb_add(&bar[XB_XSUB(b.x)], 1u);
    const unsigned gen = old / nloc;
    if (old + 1u == (gen + 1u) * nloc) {
      __builtin_amdgcn_fence(__ATOMIC_RELEASE, "agent");
      asm volatile("s_waitcnt vmcnt(0)" ::: "memory");
      const unsigned og = xb_add(&bar[XB_TOP], 1u);
      const unsigned tg = og / nx;
      if (og + 1u == (tg + 1u) * nx) xb_add(&bar[XB_TOPGEN], 1u);
      else XB_SPIN(xb_ld(&bar[XB_TOPGEN]) == tg, bar);
      __builtin_amdgcn_fence(__ATOMIC_ACQUIRE, "agent");
      xb_add(&bar[XB_XGEN(b.x)], 1u);
      asm volatile("s_waitcnt vmcnt(0)" ::: "memory");
    } else {
      XB_SPIN(xb_ld(&bar[XB_XGEN(b.x)]) == gen, bar);
      __builtin_amdgcn_fence(__ATOMIC_ACQUIRE, "agent");
      asm volatile("s_waitcnt vmcnt(0)" ::: "memory");
    }
  }
  __syncthreads();
}

#define PH(i, call) if (ph_lo <= (i) && (i) < ph_hi) { if ((i) > ph_lo) xcd_barrier(xb); call; }
#define LAYER(l, b) \
  PH(b + 0, ln_mod_phase(p, l, l == 0 ? 0 : 1)) \
  PH(b + 1, gemm_phase<1>(p, l, p.abuf, p.wt_in + (size_t)l * 1792 * 1024, 1792, 1024, smem)) \
  PH(b + 2, prep_phase_full(p, l, smem)) \
  PH(b + 3, mixer_phase(p, l, smem)) \
  PH(b + 4, gemm_phase<2>(p, l, p.abuf, p.wt_out + (size_t)l * 1024 * 1024, 1024, 1024, smem)) \
  PH(b + 5, ln_mod_phase(p, l, 2)) \
  PH(b + 6, gemm_phase<3>(p, l, p.abuf, p.wt_ff1 + (size_t)l * 4096 * 1024, 4096, 1024, smem)) \
  PH(b + 7, gemm_phase<4>(p, l, p.zf, p.wt_ff2 + (size_t)l * 1024 * 4096, 1024, 4096, smem))

__global__ void __launch_bounds__(256, 2) mega_kernel(Params p, int ph_lo, int ph_hi) {
  extern __shared__ __attribute__((aligned(16))) char smem[];
  __shared__ uint4 xb_words;
  if (threadIdx.x == 0) xb_words = make_uint4(0u, 0u, 0u, 0u);
  __syncthreads();
  XcdBarrier xb = xcd_barrier_post(p.bar, (volatile LAS unsigned*)&xb_words);
  if (ph_hi > 1000) { cg::grid_group grid = cg::this_grid(); grid.sync(); }
  PH(0, phase0(p, smem))
  LAYER(0, 1)
  LAYER(1, 9)
  PH(17, ln_mod_phase(p, 1, 3))
}

extern "C" void kernel_launch(void* const* d_in, const int* in_sizes, int n_in, void* d_out, int out_size, void* d_ws, size_t ws_size,
                              hipStream_t stream) {
  static int grid_blocks = 0;
  if (!grid_blocks) {
    int dev = 0, cus = 0, per_cu = 0;
    hipGetDevice(&dev);
    hipDeviceGetAttribute(&cus, hipDeviceAttributeMultiprocessorCount, dev);
    hipFuncSetAttribute((const void*)mega_kernel, hipFuncAttributeMaxDynamicSharedMemorySize, SMEM_BYTES);
    hipOccupancyMaxActiveBlocksPerMultiprocessor(&per_cu, (const void*)mega_kernel, 256, SMEM_BYTES);
    if (per_cu < 1) per_cu = 1;
    if (per_cu > 2) per_cu = 2;
    grid_blocks = cus * per_cu;
  }
  Params p{};
  const float** pin = (const float**)&p;
  for (int i = 0; i < 32; ++i) pin[i] = (const float*)d_in[i];
  p.out = (float*)d_out;
  char* ws = (char*)d_ws;
  size_t off = 0;
  p.bar = (unsigned*)(ws + off); off += 16384;
  p.wt_in = (bf16_t*)(ws + off); off += (size_t)2 * 1792 * 1024 * 2;
  p.wt_out = (bf16_t*)(ws + off); off += (size_t)2 * 1024 * 1024 * 2;
  p.wt_ff1 = (bf16_t*)(ws + off); off += (size_t)2 * 4096 * 1024 * 2;
  p.wt_ff2 = (bf16_t*)(ws + off); off += (size_t)2 * 4096 * 1024 * 2;
  p.wt_lru = (bf16_t*)(ws + off); off += (size_t)64 * 4096 * 2;
  p.mod = (float*)(ws + off); off += (size_t)2 * 9 * 6144 * 4;
  p.rope = (float*)(ws + off); off += (size_t)2048 * 4;
  p.abuf = (bf16_t*)(ws + off); off += (size_t)MT * 1024 * 2;
  p.zf = (bf16_t*)(ws + off);
  p.au = (float*)(ws + off + (size_t)MT * 1792 * 2);
  off += (size_t)MT * 4096 * 2;
  if (off > ws_size) { fprintf(stderr, "workspace too small: need %zu have %zu\n", off, ws_size); return; }
  (void)hipMemsetAsync(p.bar, 0, XCD_BAR_WORDS * 4, stream);
#if MULTI_LAUNCH
  for (int ph = 0; ph < NPHASE; ++ph) {
    hipLaunchKernelGGL(mega_kernel, dim3(grid_blocks), dim3(256), SMEM_BYTES, stream, p, ph, ph + 1);
  }
#else
  int lo = 0, hi = NPHASE;
  void* args[] = {&p, &lo, &hi};
  hipError_t e = hipLaunchCooperativeKernel((void*)mega_kernel, dim3(grid_blocks), dim3(256), args, SMEM_BYTES, stream);
  if (e != hipSuccess) fprintf(stderr, "cooperative launch failed: %s (grid %d)\n", hipGetErrorString(e), grid_blocks);
#endif
}
```

```cpp
#include <hip/hip_runtime.h>
#include <hip/hip_cooperative_groups.h>
#include <cstdio>
#include <cstdint>
namespace cg = cooperative_groups;

#ifndef MULTI_LAUNCH
#define MULTI_LAUNCH 0
#endif

typedef unsigned short bf16_t;
using bf16x8 = __attribute__((ext_vector_type(8))) short;
using f32x4 = __attribute__((ext_vector_type(4))) float;
#define DEV __device__ __forceinline__
#define VTID ((int)(threadIdx.x & 255))
#define VBID ((int)(blockIdx.x * 2 + (threadIdx.x >> 8)))
#define VNB ((int)(gridDim.x * 2))

constexpr int MT = 16384;
constexpr int NPHASE = 18;
constexpr size_t OFF_YK = 16777216, OFF_YV = OFF_YK + 2097152, OFF_ST = OFF_YV + 2097152;
constexpr float ALPHA = 1.41421356237f;
constexpr int SMEM_BYTES = 131072;

struct Params {
  const float *x_prompt, *x_sample, *c, *cache_k, *cache_v, *state_lru, *c_ctx, *w_ada, *b_ada, *w_in,
      *q_g, *k_g, *conv_w, *conv_b, *lru_wa, *lru_ba, *lru_wx, *lru_bx, *lru_lam, *mlp_g, *mlp_b, *mlp_ws, *mlp_bs,
      *w_out, *ln1_g, *ln1_b, *w_ff1, *b_ff1, *w_ff2, *b_ff2, *ln2_g, *ln2_b;
  float* out;
  bf16_t *wt_in, *wt_out, *wt_ff1, *wt_ff2, *wt_lru;
  float *mod, *rope;
  bf16_t *abuf;
  bf16_t *zf;
  float *au;
  unsigned *bar;
};

union U8 { uint4 u; bf16x8 v; bf16_t h[8]; unsigned w[4]; };

DEV float bf2f(bf16_t h) { return __uint_as_float(((unsigned)h) << 16); }
DEV bf16_t f2bf(float f) { unsigned u = __float_as_uint(f); u += 0x7fffu + ((u >> 16) & 1u); return (bf16_t)(u >> 16); }
DEV unsigned pack2(float a, float b) { return (unsigned)f2bf(a) | ((unsigned)f2bf(b) << 16); }
DEV float gelu_t(float x) { float y = 0.7978845608028654f * (x + 0.044715f * x * x * x); float t = 1.f - 2.f / (1.f + __expf(2.f * y)); return 0.5f * x * (1.f + t); }
DEV float sigmoidf_(float x) { return 1.f / (1.f + __expf(-x)); }
DEV int cond_of(int m) { return m < 8192 ? 0 : 1 + ((m - 8192) >> 10); }
DEV f32x4 mfma16(bf16x8 a, bf16x8 b, f32x4 c) { return __builtin_amdgcn_mfma_f32_16x16x32_bf16(a, b, c, 0, 0, 0); }
DEV float wave_sum(float v) {
#pragma unroll
  for (int o = 32; o >= 1; o >>= 1) v += __shfl_xor(v, o);
  return v;
}

DEV void transpose_tile(const float* __restrict__ src, bf16_t* __restrict__ dst, int K, int N, int tk, int tn, char* smem) {
  float* T = (float*)smem;
  const int tid = VTID;
#pragma unroll
  for (int i = 0; i < 4; ++i) {
    int k = (tid >> 4) + 16 * i, n4 = (tid & 15) * 4;
    float4 v = *(const float4*)(src + (size_t)(tk * 64 + k) * N + tn * 64 + n4);
    T[k * 65 + n4 + 0] = v.x; T[k * 65 + n4 + 1] = v.y; T[k * 65 + n4 + 2] = v.z; T[k * 65 + n4 + 3] = v.w;
  }
  __syncthreads();
#pragma unroll
  for (int i = 0; i < 2; ++i) {
    int n = (tid >> 3) + 32 * i, k8 = (tid & 7) * 8;
    U8 o;
#pragma unroll
    for (int j = 0; j < 4; ++j) o.w[j] = pack2(T[(k8 + 2 * j) * 65 + n], T[(k8 + 2 * j + 1) * 65 + n]);
    *(uint4*)(dst + (size_t)(tn * 64 + n) * K + tk * 64 + k8) = o.u;
  }
  __syncthreads();
}

DEV void phase0(const Params& p, char* smem) {
  const int tid = VTID;
  const int NITEMS = 192 + 2 * 2768 + 2;
  for (int it = VBID; it < NITEMS; it += VNB) {
    if (it < 192) {
      const int l = it / 96, n0 = (it % 96) * 64;
      float* s = (float*)smem;
      float* red = s + 9 * 1024;
      for (int idx = tid; idx < 9 * 1024; idx += 256) {
        int c = idx >> 10, k = idx & 1023;
        float v = (c == 0) ? p.c_ctx[k] : p.c[(c - 1) * 1024 + k];
        s[idx] = v / (1.f + __expf(-v));
      }
      __syncthreads();
      const int kq = tid >> 6, n = tid & 63;
      float acc[9];
#pragma unroll
      for (int c = 0; c < 9; ++c) acc[c] = 0.f;
      const float* wp = p.w_ada + ((size_t)l * 1024 + kq * 256) * 6144 + n0 + n;
#pragma unroll 4
      for (int k = 0; k < 256; ++k) {
        float wv = wp[(size_t)k * 6144];
#pragma unroll
        for (int c = 0; c < 9; ++c) acc[c] += s[c * 1024 + kq * 256 + k] * wv;
      }
#pragma unroll
      for (int c = 0; c < 9; ++c) red[(kq * 9 + c) * 64 + n] = acc[c];
      __syncthreads();
      for (int idx = tid; idx < 576; idx += 256) {
        int c = idx >> 6, nn = idx & 63;
        float v = red[(0 * 9 + c) * 64 + nn] + red[(1 * 9 + c) * 64 + nn] + red[(2 * 9 + c) * 64 + nn] + red[(3 * 9 + c) * 64 + nn] +
                  p.b_ada[l * 6144 + n0 + nn];
        p.mod[((size_t)l * 9 + c) * 6144 + n0 + nn] = v;
      }
      __syncthreads();
    } else if (it >= 192 + 2 * 2768) {
      if (it == 192 + 2 * 2768)
      for (int idx = tid; idx < 1024; idx += 256) {
        int pp = idx >> 4, f = idx & 15;
        float inv = powf(10000.f, -(float)f / 16.f);
        float ang = (float)pp * inv;
        float nrev = rintf(ang * 0.15915494309189535f);
        float r = fmaf(-nrev, 6.28125f, ang);
        r = fmaf(-nrev, 0.0019353071795864769f, r);
        p.rope[idx * 2 + 0] = __cosf(r);
        p.rope[idx * 2 + 1] = __sinf(r);
      }
    } else {
      int t = it - 192;
      const int l = t / 2768, r = t % 2768;
      if (r < 448) transpose_tile(p.w_in + (size_t)l * 1024 * 1792, p.wt_in + (size_t)l * 1792 * 1024, 1024, 1792, r / 28, r % 28, smem);
      else if (r < 704) { int i = r - 448; transpose_tile(p.w_out + (size_t)l * 1024 * 1024, p.wt_out + (size_t)l * 1024 * 1024, 1024, 1024, i / 16, i % 16, smem); }
      else if (r < 1728) { int i = r - 704; transpose_tile(p.w_ff1 + (size_t)l * 1024 * 4096, p.wt_ff1 + (size_t)l * 4096 * 1024, 1024, 4096, i / 64, i % 64, smem); }
      else if (r < 2752) { int i = r - 1728; transpose_tile(p.w_ff2 + (size_t)l * 4096 * 1024, p.wt_ff2 + (size_t)l * 1024 * 4096, 4096, 1024, i / 16, i % 16, smem); }
      else {
        int idx = r - 2752;
        int dir = idx >> 3, blk = (idx >> 1) & 3, mat = idx & 1;
        const float* src = (mat == 0 ? p.lru_wa : p.lru_wx) + (size_t)(((l * 2 + dir) * 4 + blk)) * 4096;
        bf16_t* dst = p.wt_lru + (size_t)((((l * 2 + dir) * 4 + blk) * 2 + mat)) * 4096;
        transpose_tile(src, dst, 64, 64, 0, 0, smem);
      }
    }
  }
}

DEV void ln_mod_phase(const Params& p, int l, int mode) {
  const int lane = threadIdx.x & 63, w = threadIdx.x >> 6;
  const float* lg = nullptr; const float* lb = nullptr;
  if (mode == 1) { lg = p.ln2_g + (l - 1) * 1024; lb = p.ln2_b + (l - 1) * 1024; }
  else if (mode == 2) { lg = p.ln1_g + l * 1024; lb = p.ln1_b + l * 1024; }
  else if (mode == 3) { lg = p.ln2_g + l * 1024; lb = p.ln2_b + l * 1024; }
  const int shoff = (mode == 2) ? 3072 : 0;
  for (int m = blockIdx.x * 8 + w; m < MT; m += gridDim.x * 8) {
    const float* src;
    if (mode == 0) src = (m < 8192) ? p.x_prompt + (size_t)m * 1024 : p.x_sample + (size_t)(m - 8192) * 1024;
    else src = p.out + (size_t)m * 1024;
    float4 v[4];
#pragma unroll
    for (int i = 0; i < 4; ++i) v[i] = *(const float4*)(src + i * 256 + lane * 4);
    if (mode != 0) {
      float s = 0.f;
#pragma unroll
      for (int i = 0; i < 4; ++i) s += v[i].x + v[i].y + v[i].z + v[i].w;
      const float mean = wave_sum(s) * (1.f / 1024.f);
      float s2 = 0.f;
#pragma unroll
      for (int i = 0; i < 4; ++i) { float a = v[i].x - mean, b = v[i].y - mean, c = v[i].z - mean, d = v[i].w - mean; s2 += a * a + b * b + c * c + d * d; }
      const float rstd = rsqrtf(wave_sum(s2) * (1.f / 1024.f) + 1e-6f);
#pragma unroll
      for (int i = 0; i < 4; ++i) {
        float4 g = *(const float4*)(lg + i * 256 + lane * 4), b = *(const float4*)(lb + i * 256 + lane * 4);
        v[i].x = (v[i].x - mean) * rstd * g.x + b.x; v[i].y = (v[i].y - mean) * rstd * g.y + b.y;
        v[i].z = (v[i].z - mean) * rstd * g.z + b.z; v[i].w = (v[i].w - mean) * rstd * g.w + b.w;
        *(float4*)(p.out + (size_t)m * 1024 + i * 256 + lane * 4) = v[i];
      }
    }
    if (mode != 3) {
      const float* md = p.mod + ((size_t)l * 9 + cond_of(m)) * 6144 + shoff;
#pragma unroll
      for (int i = 0; i < 4; ++i) {
        float4 sh = *(const float4*)(md + i * 256 + lane * 4), sc = *(const float4*)(md + 1024 + i * 256 + lane * 4);
        uint2 o;
        o.x = pack2(v[i].x * (1.f + sc.x) + sh.x, v[i].y * (1.f + sc.y) + sh.y);
        o.y = pack2(v[i].z * (1.f + sc.z) + sh.z, v[i].w * (1.f + sc.w) + sh.w);
        *(uint2*)(p.abuf + (size_t)m * 1024 + i * 256 + lane * 4) = o;
      }
    }
  }
}

#define LAS3 __attribute__((address_space(3)))
namespace g8 {
constexpr int BM = 256, BK = 64, HALF = 128, HTB = HALF * BK * 2, NXCD = 8, WGM = 8;
DEV int lds_byte(int r, int c) { const int st = (r >> 4) * 2 + (c >> 5), rr = r & 15, cc = c & 31, ob = rr * 64 + cc * 2; return st * 1024 + (ob ^ (((ob >> 9) & 1) << 5)); }
DEV void stage_rc(int b, int& R, int& C) { const int st = b / 1024, sb = b % 1024, swz = sb ^ (((sb >> 9) & 1) << 5); R = (st >> 1) * 16 + swz / 64; C = (st & 1) * 32 + (swz % 64) / 2; }
DEV bool unit_of(int i, int nM, int nN, int& pm, int& pn) {
  const int nwg = nM * nN;
  const long L = (long)i * gridDim.x + blockIdx.x; if (L >= nwg) return false;
  int wgid = (int)L; { const int q = nwg / NXCD, r = nwg % NXCD, xcd = wgid % NXCD, off = wgid / NXCD; wgid = (xcd < r ? xcd * (q + 1) : r * (q + 1) + (xcd - r) * q) + off; }
  const int nig = WGM * nN, gid = wgid / nig, fm = gid * WGM, gsz = (nM - fm) < WGM ? (nM - fm) : WGM;
  pm = fm + ((wgid % nig) % gsz); pn = (wgid % nig) / gsz; return true;
}
}

template <int EPI>
DEV void gemm_epilogue(const Params& p, int l, f32x4 (&acc)[2][2][4][2], int pm, int pn, int wr, int wc, int fr, int fq) {
  const int brow = pm * 256, bcol = pn * 256;
  const float* md = p.mod + ((size_t)l * 9 + cond_of(brow)) * 6144;
#pragma unroll
  for (int bj = 0; bj < 2; ++bj)
#pragma unroll
    for (int n = 0; n < 2; ++n) {
      const int col = bcol + bj * 128 + wc * 32 + n * 16 + fq * 4;
      float4 gate = make_float4(0.f, 0.f, 0.f, 0.f), bias = make_float4(0.f, 0.f, 0.f, 0.f);
      if (EPI == 2) gate = *(const float4*)(md + 2048 + col);
      if (EPI == 3) bias = *(const float4*)(p.b_ff1 + l * 4096 + col);
      if (EPI == 4) { gate = *(const float4*)(md + 5120 + col); bias = *(const float4*)(p.b_ff2 + l * 1024 + col); }
#pragma unroll
      for (int ai = 0; ai < 2; ++ai)
#pragma unroll
        for (int m = 0; m < 4; ++m) {
          const int row = brow + ai * 128 + wr * 64 + m * 16 + fr;
          const f32x4 v = acc[ai][bj][m][n];
          if (EPI == 1) {
            uint2 o; o.x = pack2(v[0], v[1]); o.y = pack2(v[2], v[3]);
            *(uint2*)(p.zf + (size_t)row * 1792 + col) = o;
          } else if (EPI == 2) {
            const float* xs = (l == 0) ? ((row < 8192) ? p.x_prompt + (size_t)row * 1024 : p.x_sample + (size_t)(row - 8192) * 1024) : p.out + (size_t)row * 1024;
            const float4 x = *(const float4*)(xs + col);
            *(float4*)(p.out + (size_t)row * 1024 + col) = make_float4(ALPHA * x.x + gate.x * v[0], ALPHA * x.y + gate.y * v[1], ALPHA * x.z + gate.z * v[2], ALPHA * x.w + gate.w * v[3]);
          } else if (EPI == 3) {
            const float t0 = fmaxf(v[0] + bias.x, 0.f), t1 = fmaxf(v[1] + bias.y, 0.f), t2 = fmaxf(v[2] + bias.z, 0.f), t3 = fmaxf(v[3] + bias.w, 0.f);
            uint2 o; o.x = pack2(t0 * t0, t1 * t1); o.y = pack2(t2 * t2, t3 * t3);
            *(uint2*)(p.zf + (size_t)row * 4096 + col) = o;
          } else {
            float* xo = p.out + (size_t)row * 1024 + col;
            const float4 x = *(const float4*)xo;
            *(float4*)xo = make_float4(ALPHA * x.x + gate.x * (v[0] + bias.x), ALPHA * x.y + gate.y * (v[1] + bias.y), ALPHA * x.z + gate.z * (v[2] + bias.z), ALPHA * x.w + gate.w * (v[3] + bias.w));
          }
        }
    }
}

template <int EPI>
DEV void gemm_phase(const Params& p, int l, const bf16_t* Ag, const bf16_t* Btg, int N, int K, LAS3 unsigned char* lds) {
  using namespace g8;
  const int tid = threadIdx.x, wid = __builtin_amdgcn_readfirstlane(tid >> 6), lane = tid & 63, wr = wid >> 2, wc = wid & 3, fr = lane & 15, fq = lane >> 4;
  const int nt = K / BK, nM = MT / BM, nN = N / BM;
  unsigned voff[2];
#pragma unroll
  for (int i = 0; i < 2; ++i) { int R, C; stage_rc(tid * 16 + i * 8192, R, C); voff[i] = (unsigned)(R * K + C) * 2u; }
  const size_t kstep = (size_t)(BK * 2);
  const size_t hstep = (size_t)HALF * K * 2;
  const size_t tstep = 2 * hstep;
  const unsigned ldsw = (unsigned)wid * 1024u;
  const int aoff = lds_byte(wr * 64 + fr, fq * 8), boff = lds_byte(wc * 32 + fr, fq * 8);
#define PG8_SA(b, h) (((b) * 2 + (h)) * HTB)
#define PG8_SB(b, h) ((4 + (b) * 2 + (h)) * HTB)
#define PG8_STAGE(bufoff, gbase) do { _Pragma("unroll") for (int _i = 0; _i < 2; ++_i) \
    __builtin_amdgcn_global_load_lds((const unsigned*)((const char*)(gbase) + voff[_i]), (LAS3 unsigned*)(lds + (bufoff) + ldsw + _i * 8192), 16, 0, 0); } while (0)
#define PG8_LDA(dst, b, h) do { _Pragma("unroll") for (int m = 0; m < 4; ++m) _Pragma("unroll") for (int k = 0; k < 2; ++k) dst[m][k] = *(const LAS3 bf16x8*)(lds + PG8_SA(b, h) + aoff + m * 2048 + k * 1024); } while (0)
#define PG8_LDB(dst, b, h) do { _Pragma("unroll") for (int n = 0; n < 2; ++n) _Pragma("unroll") for (int k = 0; k < 2; ++k) dst[n][k] = *(const LAS3 bf16x8*)(lds + PG8_SB(b, h) + boff + n * 2048 + k * 1024); } while (0)
#define PG8_MMA(ai, bj, At_, Bt_) do { __builtin_amdgcn_s_setprio(1); _Pragma("unroll") for (int m = 0; m < 4; ++m) _Pragma("unroll") for (int n = 0; n < 2; ++n) _Pragma("unroll") for (int k = 0; k < 2; ++k) \
    acc[ai][bj][m][n] = __builtin_amdgcn_mfma_f32_16x16x32_bf16(Bt_[n][k], At_[m][k], acc[ai][bj][m][n], 0, 0, 0); __builtin_amdgcn_s_setprio(0); } while (0)
#define PG8_WAIT_V(n) asm volatile("s_waitcnt vmcnt(" #n ")" ::: "memory")
#define PG8_WAIT_L(n) asm volatile("s_waitcnt lgkmcnt(" #n ")" ::: "memory")
#define PG8_BAR __builtin_amdgcn_s_barrier()
#define PG8_SCHED __builtin_amdgcn_sched_barrier(0)
  int cpm, cpn, npm = 0, npn = 0, ui = 0;
  if (!unit_of(0, nM, nN, cpm, cpn)) return;
  f32x4 acc[2][2][4][2];
#pragma unroll
  for (int a = 0; a < 2; ++a)
#pragma unroll
    for (int b = 0; b < 2; ++b)
#pragma unroll
      for (int m = 0; m < 4; ++m)
#pragma unroll
        for (int n = 0; n < 2; ++n) acc[a][b][m][n] = (f32x4){0.f, 0.f, 0.f, 0.f};
  bf16x8 At[4][2], B0[2][2], B1[2][2];
  const char* cA = (const char*)Ag + (size_t)cpm * tstep; const char* cB = (const char*)Btg + (size_t)cpn * tstep;
  PG8_STAGE(PG8_SB(0, 0), cB); PG8_STAGE(PG8_SA(0, 0), cA); PG8_STAGE(PG8_SB(0, 1), cB + hstep); PG8_STAGE(PG8_SA(0, 1), cA + hstep);
  if (wr == 1) PG8_BAR;
  PG8_WAIT_V(4); PG8_BAR;
  PG8_STAGE(PG8_SB(1, 0), cB + kstep); PG8_STAGE(PG8_SA(1, 0), cA + kstep); PG8_STAGE(PG8_SB(1, 1), cB + hstep + kstep);
  PG8_WAIT_V(6); PG8_BAR;
  for (;;) {
    const bool has_next = unit_of(ui + 1, nM, nN, npm, npn);
    const char* nA = has_next ? (const char*)Ag + (size_t)npm * tstep : cA; const char* nB = has_next ? (const char*)Btg + (size_t)npn * tstep : cB;
    for (int t = 0; t < nt; t += 2) {
      const bool last = (t == nt - 2);
      const char* a1 = cA + (size_t)(t + 1) * kstep;
      const char* a2 = last ? nA : cA + (size_t)(t + 2) * kstep; const char* b2 = last ? nB : cB + (size_t)(t + 2) * kstep;
      const char* a3 = a2 + kstep; const char* b3 = b2 + kstep;
      PG8_LDB(B0, 0, 0); PG8_SCHED; PG8_LDA(At, 0, 0); PG8_STAGE(PG8_SA(1, 1), a1 + hstep);
      PG8_WAIT_L(8); PG8_BAR; PG8_WAIT_L(0); PG8_MMA(0, 0, At, B0); PG8_BAR; PG8_SCHED;
      PG8_LDB(B1, 0, 1); PG8_STAGE(PG8_SB(0, 0), b2);
      PG8_BAR; PG8_WAIT_L(0); PG8_MMA(0, 1, At, B1); PG8_BAR;
      PG8_LDA(At, 0, 1); PG8_STAGE(PG8_SA(0, 0), a2);
      PG8_BAR; PG8_WAIT_L(0); PG8_MMA(1, 0, At, B0); PG8_BAR; PG8_SCHED;
      PG8_STAGE(PG8_SB(0, 1), b2 + hstep);
      PG8_WAIT_V(6); PG8_BAR; PG8_MMA(1, 1, At, B1); PG8_BAR;
      PG8_LDB(B0, 1, 0); PG8_SCHED; PG8_LDA(At, 1, 0); PG8_STAGE(PG8_SA(0, 1), a2 + hstep);
      PG8_WAIT_L(8); PG8_BAR; PG8_WAIT_L(0); PG8_MMA(0, 0, At, B0); PG8_BAR; PG8_SCHED;
      PG8_LDB(B1, 1, 1); PG8_STAGE(PG8_SB(1, 0), b3);
      PG8_BAR; PG8_WAIT_L(0); PG8_MMA(0, 1, At, B1); PG8_BAR;
      PG8_LDA(At, 1, 1); PG8_STAGE(PG8_SA(1, 0), a3);
      PG8_BAR; PG8_WAIT_L(0); PG8_MMA(1, 0, At, B0); PG8_BAR; PG8_SCHED;
      PG8_STAGE(PG8_SB(1, 1), b3 + hstep);
      PG8_WAIT_V(6); PG8_BAR; PG8_MMA(1, 1, At, B1); PG8_BAR;
    }
    gemm_epilogue<EPI>(p, l, acc, cpm, cpn, wr, wc, fr, fq);
    if (!has_next) break;
#pragma unroll
    for (int a = 0; a < 2; ++a)
#pragma unroll
      for (int b = 0; b < 2; ++b)
#pragma unroll
        for (int m = 0; m < 4; ++m)
#pragma unroll
          for (int n = 0; n < 2; ++n) acc[a][b][m][n] = (f32x4){0.f, 0.f, 0.f, 0.f};
    cpm = npm; cpn = npn; cA = nA; cB = nB; ++ui;
  }
  PG8_WAIT_V(0);
  if (wr == 0) PG8_BAR;
  PG8_BAR;
#undef PG8_SA
#undef PG8_SB
#undef PG8_STAGE
#undef PG8_LDA
#undef PG8_LDB
#undef PG8_MMA
#undef PG8_WAIT_V
#undef PG8_WAIT_L
#undef PG8_BAR
#undef PG8_SCHED
}

DEV void rope8(float (&v)[8], int d0, int prow, int pcol, const float* __restrict__ rope) {
  const int pp = (d0 < 32) ? prow : pcol;
#pragma unroll
  for (int i = 0; i < 4; ++i) {
    const int f = ((d0 >> 1) + i) & 15;
    const float cs = rope[(pp * 16 + f) * 2], sn = rope[(pp * 16 + f) * 2 + 1];
    const float x1 = v[2 * i], x2 = v[2 * i + 1];
    v[2 * i] = x1 * cs - x2 * sn; v[2 * i + 1] = x1 * sn + x2 * cs;
  }
}

DEV void prep_token_row(const Params& p, int l, int m, int lane) {
  bf16_t* zr = p.zf + (size_t)m * 1792;
  const bool lat = m >= 8192;
  const int pos = lat ? ((m - 8192) & 1023) : (m & 255);
  const int prow = pos >> 6, pcol = pos & 63;
  const int d0 = (lane & 7) * 8;
  {
    U8 u; u.u = *(const uint4*)(zr + lane * 8);
    float v[8]; float ss = 0.f;
#pragma unroll
    for (int j = 0; j < 8; ++j) { v[j] = bf2f(u.h[j]); ss += v[j] * v[j]; }
    ss += __shfl_xor(ss, 1); ss += __shfl_xor(ss, 2); ss += __shfl_xor(ss, 4);
    const float rinv = rsqrtf(ss * (1.f / 64.f) + 1e-6f);
#pragma unroll
    for (int j = 0; j < 8; ++j) v[j] = v[j] * rinv * p.q_g[l * 64 + d0 + j];
    if (lat) rope8(v, d0, prow, pcol, p.rope);
#pragma unroll
    for (int j = 0; j < 4; ++j) u.w[j] = pack2(v[2 * j] * 0.125f, v[2 * j + 1] * 0.125f);
    *(uint4*)(zr + lane * 8) = u.u;
  }
  {
    const int col = lane < 32 ? 512 + lane * 8 : 1024 + (lane - 32) * 8;
    U8 u; u.u = *(const uint4*)(zr + col);
    float v[8]; float ss = 0.f;
#pragma unroll
    for (int j = 0; j < 8; ++j) { v[j] = bf2f(u.h[j]); ss += v[j] * v[j]; }
    ss += __shfl_xor(ss, 1); ss += __shfl_xor(ss, 2); ss += __shfl_xor(ss, 4);
    if (lane < 16) {
      const float rinv = rsqrtf(ss * (1.f / 64.f) + 1e-6f);
#pragma unroll
      for (int j = 0; j < 8; ++j) v[j] = v[j] * rinv * p.k_g[l * 64 + d0 + j];
      if (!lat) {
        float* o = p.out + OFF_YK + ((((size_t)(m >> 8)) * 2 + l) * 256 + pos) * 128 + lane * 8;
        *(float4*)o = make_float4(v[0], v[1], v[2], v[3]); *(float4*)(o + 4) = make_float4(v[4], v[5], v[6], v[7]);
      } else rope8(v, d0, prow, pcol, p.rope);
#pragma unroll
      for (int j = 0; j < 4; ++j) u.w[j] = pack2(v[2 * j], v[2 * j + 1]);
      *(uint4*)(zr + col) = u.u;
    } else if (lane < 32) {
      if (!lat) {
        float* o = p.out + OFF_YV + ((((size_t)(m >> 8)) * 2 + l) * 256 + pos) * 128 + (lane - 16) * 8;
        *(float4*)o = make_float4(v[0], v[1], v[2], v[3]); *(float4*)(o + 4) = make_float4(v[4], v[5], v[6], v[7]);
      }
    } else {
#pragma unroll
      for (int j = 0; j < 4; ++j) u.w[j] = pack2(gelu_t(v[2 * j]), gelu_t(v[2 * j + 1]));
      *(uint4*)(zr + col) = u.u;
    }
  }
  {
    const int col = 1280 + lane * 8;
    U8 u; u.u = *(const uint4*)(zr + col);
    float v[8]; float s = 0.f;
#pragma unroll
    for (int j = 0; j < 8; ++j) { v[j] = gelu_t(bf2f(u.h[j])); s += v[j]; }
#pragma unroll
    for (int o = 1; o <= 16; o <<= 1) s += __shfl_xor(s, o);
    const float mean = s * (1.f / 256.f);
    float s2 = 0.f;
#pragma unroll
    for (int j = 0; j < 8; ++j) { float d = v[j] - mean; s2 += d * d; }
#pragma unroll
    for (int o = 1; o <= 16; o <<= 1) s2 += __shfl_xor(s2, o);
    if (lane >= 32) {
      const float rstd = rsqrtf(s2 * (1.f / 256.f) + 1e-6f);
      const int ch = (lane - 32) * 8;
#pragma unroll
      for (int j = 0; j < 8; ++j) v[j] = (v[j] - mean) * rstd * p.mlp_g[l * 256 + ch + j] + p.mlp_b[l * 256 + ch + j];
    }
#pragma unroll
    for (int j = 0; j < 4; ++j) u.w[j] = pack2(v[2 * j], v[2 * j + 1]);
    *(uint4*)(zr + col) = u.u;
  }
}

template <bool REV>
DEV void tile_scan(float (&a)[4][4], float (&u)[4][4], int lane) {
  const int q = lane >> 4;
  float C = 0.f, CP = 1.f;
  const int src1 = (REV ? lane + 16 : lane - 16) & 63;
  const int src2 = (REV ? lane + 32 : lane - 32) & 63;
  const int srcT = (lane & 15) + (REV ? 0 : 48);
  const bool c1 = REV ? (q <= 2) : (q >= 1);
  const bool c2 = REV ? (q <= 1) : (q >= 2);
  const bool first = REV ? (q == 3) : (q == 0);
#pragma unroll
  for (int mi = 0; mi < 4; ++mi) {
    const int mt = REV ? 3 - mi : mi;
    float P = 1.f, H = 0.f, pl[4], hl[4];
#pragma unroll
    for (int ri = 0; ri < 4; ++ri) {
      const int r = REV ? 3 - ri : ri;
      H = a[mt][r] * H + u[mt][r]; P *= a[mt][r]; pl[r] = P; hl[r] = H;
    }
    float Pi = P, Hi = H;
    float Pp = __shfl(Pi, src1), Hp = __shfl(Hi, src1);
    if (c1) { Hi = Pi * Hp + Hi; Pi = Pi * Pp; }
    Pp = __shfl(Pi, src2); Hp = __shfl(Hi, src2);
    if (c2) { Hi = Pi * Hp + Hi; Pi = Pi * Pp; }
    float Pe = __shfl(Pi, src1), He = __shfl(Hi, src1);
    if (first) { Pe = 1.f; He = 0.f; }
    const float hin = Pe * C + He, pin = Pe * CP;
#pragma unroll
    for (int r = 0; r < 4; ++r) { u[mt][r] = pl[r] * hin + hl[r]; a[mt][r] = pl[r] * pin; }
    const float Pt = __shfl(Pi, srcT), Ht = __shfl(Hi, srcT);
    C = Pt * C + Ht; CP = Pt * CP;
  }
}

DEV void lru_gate_item(const Params& p, int l, int item, char* smem) {
  const int tid = VTID, lane = tid & 63, w = tid >> 6;
  const int tile = item >> 2, blk = item & 3;
  const int m0 = tile * 64;
  int ms, L;
  if (m0 < 8192) { ms = m0 & ~255; L = 256; } else { ms = 8192 + ((m0 - 8192) & ~1023); L = 1024; }
  float* xs = (float*)smem;
  float* xcf = xs + 67 * 64;
  bf16_t* xcb = (bf16_t*)(xcf + 64 * 64);
  for (int idx = tid; idx < 67 * 8; idx += 256) {
    const int rr = idx >> 3, cc = idx & 7;
    const int m = m0 - 1 + rr;
    float v[8];
    if (m >= ms && m < ms + L) {
      U8 u; u.u = *(const uint4*)(p.zf + (size_t)m * 1792 + 768 + blk * 64 + cc * 8);
#pragma unroll
      for (int j = 0; j < 8; ++j) v[j] = bf2f(u.h[j]);
    } else {
#pragma unroll
      for (int j = 0; j < 8; ++j) v[j] = 0.f;
    }
#pragma unroll
    for (int j = 0; j < 8; ++j) xs[rr * 64 + cc * 8 + j] = v[j];
  }
  __syncthreads();
  {
    const int ch = tid & 63, Cg = blk * 64 + ch;
    const float w0 = p.conv_w[(l * 4 + 0) * 256 + Cg], w1 = p.conv_w[(l * 4 + 1) * 256 + Cg], w2 = p.conv_w[(l * 4 + 2) * 256 + Cg],
                w3 = p.conv_w[(l * 4 + 3) * 256 + Cg], cb = p.conv_b[l * 256 + Cg];
#pragma unroll 4
    for (int tt = 0; tt < 16; ++tt) {
      const int t = (tid >> 6) * 16 + tt;
      const float v = cb + w0 * xs[t * 64 + ch] + w1 * xs[(t + 1) * 64 + ch] + w2 * xs[(t + 2) * 64 + ch] + w3 * xs[(t + 3) * 64 + ch];
      xcf[t * 64 + ch] = v; xcb[t * 72 + ch] = f2bf(v);
    }
  }
  __syncthreads();
  const int dir = w >> 1, half = w & 1, q = lane >> 4, c15 = lane & 15;
  const bf16_t* wt = p.wt_lru + (size_t)((((l * 2 + dir) * 4 + blk) * 2)) * 4096;
  bf16x8 bfr[2][2][2];
#pragma unroll
  for (int mat = 0; mat < 2; ++mat)
#pragma unroll
    for (int j = 0; j < 2; ++j)
#pragma unroll
      for (int s = 0; s < 2; ++s) bfr[mat][j][s] = *(const bf16x8*)(wt + mat * 4096 + (half * 32 + j * 16 + c15) * 64 + s * 32 + q * 8);
  f32x4 acc[2][4][2];
#pragma unroll
  for (int mat = 0; mat < 2; ++mat)
#pragma unroll
    for (int mt = 0; mt < 4; ++mt)
#pragma unroll
      for (int j = 0; j < 2; ++j) acc[mat][mt][j] = f32x4{0.f, 0.f, 0.f, 0.f};
#pragma unroll
  for (int mt = 0; mt < 4; ++mt)
#pragma unroll
    for (int s = 0; s < 2; ++s) {
      const bf16x8 af = *(const bf16x8*)(xcb + (mt * 16 + c15) * 72 + s * 32 + q * 8);
#pragma unroll
      for (int mat = 0; mat < 2; ++mat)
#pragma unroll
        for (int j = 0; j < 2; ++j) acc[mat][mt][j] = mfma16(af, bfr[mat][j][s], acc[mat][mt][j]);
    }
  float* PCp = p.au + (size_t)(dir * 2 + 0) * MT * 256;
  float* HLp = p.au + (size_t)(dir * 2 + 1) * MT * 256;
#pragma unroll
  for (int j = 0; j < 2; ++j) {
    const int ch = half * 32 + j * 16 + c15, Cg = blk * 64 + ch, pidx = (l * 2 + dir) * 256 + Cg;
    const float ba = p.lru_ba[pidx], bx = p.lru_bx[pidx], lam = p.lru_lam[pidx];
    const float xn = -lam;
    const float sp = fmaxf(xn, 0.f) + log1pf(expf(-fabsf(xn)));
    const float cdec = -8.f * sp;
    float a[4][4], u[4][4];
#pragma unroll
    for (int mt = 0; mt < 4; ++mt)
#pragma unroll
      for (int r = 0; r < 4; ++r) {
        const int t = mt * 16 + q * 4 + r;
        const float rg = sigmoidf_(acc[0][mt][j][r] + ba), ig = sigmoidf_(acc[1][mt][j][r] + bx);
        const float la = cdec * rg;
        a[mt][r] = __expf(la);
        u[mt][r] = sqrtf(-expm1f(2.f * la)) * ig * xcf[t * 64 + ch];
      }
    if (dir == 0) tile_scan<false>(a, u, lane); else tile_scan<true>(a, u, lane);
#pragma unroll
    for (int mt = 0; mt < 4; ++mt)
#pragma unroll
      for (int r = 0; r < 4; ++r) {
        const size_t m = m0 + mt * 16 + q * 4 + r;
        PCp[m * 256 + Cg] = a[mt][r]; HLp[m * 256 + Cg] = u[mt][r];
      }
  }
  __syncthreads();
}

DEV void attn_item(const Params& p, int l, int it, char* smem) {
  const int tid = VTID, lane = tid & 63, w = tid >> 6, q = lane >> 4, c15 = lane & 15;
  int b, h, qb, ms, nkt; bool lat;
  if (it < 1024) { lat = true; b = it >> 7; h = (it >> 4) & 7; qb = it & 15; ms = 8192 + b * 1024; nkt = 20; }
  else { const int i2 = it - 1024; lat = false; b = i2 >> 5; h = (i2 >> 2) & 7; qb = i2 & 3; ms = b * 256; nkt = 4; }
  const int kvh = h >> 2;
  bf16_t* Ks = (bf16_t*)smem;
  bf16_t* Vt = Ks + 64 * 72;
  bf16_t* Pw = Vt + 64 * 72 + w * 16 * 72;
  const int mq = ms + qb * 64 + w * 16;
  bf16x8 qf[2];
#pragma unroll
  for (int s = 0; s < 2; ++s) qf[s] = *(const bf16x8*)(p.zf + (size_t)(mq + c15) * 1792 + h * 64 + s * 32 + q * 8);
  f32x4 o[4];
  float mrow[4], lrow[4];
#pragma unroll
  for (int j = 0; j < 4; ++j) { o[j] = f32x4{0.f, 0.f, 0.f, 0.f}; mrow[j] = -1e30f; lrow[j] = 0.f; }
  for (int kt = 0; kt < nkt; ++kt) {
#pragma unroll
    for (int i = 0; i < 2; ++i) {
      const int id = tid + 256 * i, key = id >> 3, cc = id & 7;
      U8 kk, vv;
      if (lat && kt < 4) {
        const int t = kt * 64 + key;
        const size_t off = ((((size_t)b * 2 + l) * 256 + t) * 2 + kvh) * 64 + cc * 8;
        const float4 a0 = *(const float4*)(p.cache_k + off), a1 = *(const float4*)(p.cache_k + off + 4);
        kk.w[0] = pack2(a0.x, a0.y); kk.w[1] = pack2(a0.z, a0.w); kk.w[2] = pack2(a1.x, a1.y); kk.w[3] = pack2(a1.z, a1.w);
        const float4 b0 = *(const float4*)(p.cache_v + off), b1 = *(const float4*)(p.cache_v + off + 4);
        vv.w[0] = pack2(b0.x, b0.y); vv.w[1] = pack2(b0.z, b0.w); vv.w[2] = pack2(b1.x, b1.y); vv.w[3] = pack2(b1.z, b1.w);
      } else {
        const int t = lat ? (kt - 4) * 64 + key : kt * 64 + key;
        const bf16_t* zr = p.zf + (size_t)(ms + t) * 1792;
        kk.u = *(const uint4*)(zr + 512 + kvh * 64 + cc * 8);
        vv.u = *(const uint4*)(zr + 640 + kvh * 64 + cc * 8);
      }
      *(uint4*)(Ks + key * 72 + cc * 8) = kk.u;
#pragma unroll
      for (int j = 0; j < 8; ++j) Vt[(cc * 8 + j) * 72 + key] = vv.h[j];
    }
    __syncthreads();
    f32x4 s4[4];
#pragma unroll
    for (int jn = 0; jn < 4; ++jn) {
      s4[jn] = f32x4{0.f, 0.f, 0.f, 0.f};
#pragma unroll
      for (int s = 0; s < 2; ++s) {
        const bf16x8 kb = *(const bf16x8*)(Ks + (jn * 16 + c15) * 72 + s * 32 + q * 8);
        s4[jn] = mfma16(qf[s], kb, s4[jn]);
      }
    }
#pragma unroll
    for (int r = 0; r < 4; ++r) {
      float mx = fmaxf(fmaxf(s4[0][r], s4[1][r]), fmaxf(s4[2][r], s4[3][r]));
      mx = fmaxf(mx, __shfl_xor(mx, 1)); mx = fmaxf(mx, __shfl_xor(mx, 2)); mx = fmaxf(mx, __shfl_xor(mx, 4)); mx = fmaxf(mx, __shfl_xor(mx, 8));
      const float mnew = fmaxf(mrow[r], mx);
      const float alpha = __expf(mrow[r] - mnew);
      mrow[r] = mnew;
      float ls = lrow[r] * alpha;
#pragma unroll
      for (int jn = 0; jn < 4; ++jn) {
        o[jn][r] *= alpha;
        const float pv = __expf(s4[jn][r] - mnew);
        ls += pv;
        Pw[(q * 4 + r) * 72 + jn * 16 + c15] = f2bf(pv);
      }
      lrow[r] = ls;
    }
    __builtin_amdgcn_wave_barrier();
    bf16x8 pf[2];
#pragma unroll
    for (int s = 0; s < 2; ++s) pf[s] = *(const bf16x8*)(Pw + c15 * 72 + s * 32 + q * 8);
#pragma unroll
    for (int jn = 0; jn < 4; ++jn)
#pragma unroll
      for (int s = 0; s < 2; ++s) {
        const bf16x8 vb = *(const bf16x8*)(Vt + (jn * 16 + c15) * 72 + s * 32 + q * 8);
        o[jn] = mfma16(pf[s], vb, o[jn]);
      }
    __syncthreads();
  }
#pragma unroll
  for (int r = 0; r < 4; ++r) {
    float lt = lrow[r];
    lt += __shfl_xor(lt, 1); lt += __shfl_xor(lt, 2); lt += __shfl_xor(lt, 4); lt += __shfl_xor(lt, 8);
    const float inv = 1.f / lt;
    const size_t m = mq + q * 4 + r;
#pragma unroll
    for (int jn = 0; jn < 4; ++jn) p.abuf[m * 1024 + h * 64 + jn * 16 + c15] = f2bf(o[jn][r] * inv);
  }
}

DEV void gmlp_item(const Params& p, int l, int it, char* smem) {
  const int tid = VTID, lane = tid & 63, w = tid >> 6, q = lane >> 4, c15 = lane & 15;
  const int chunk = it >> 2, g = it & 3, m0 = chunk * 128;
  bf16_t* vt = (bf16_t*)smem;
#pragma unroll
  for (int i = 0; i < 4; ++i) {
    const int id = tid + 256 * i, qq = id >> 3, cc = id & 7;
    U8 v; v.u = *(const uint4*)(p.zf + (size_t)(m0 + qq) * 1792 + 1536 + g * 64 + cc * 8);
#pragma unroll
    for (int j = 0; j < 8; ++j) vt[(cc * 8 + j) * 136 + qq] = v.h[j];
  }
  __syncthreads();
  f32x4 acc[2][4];
#pragma unroll
  for (int i = 0; i < 2; ++i)
#pragma unroll
    for (int jn = 0; jn < 4; ++jn) acc[i][jn] = f32x4{0.f, 0.f, 0.f, 0.f};
  const float* wsg = p.mlp_ws + (size_t)(l * 4 + g) * 16384;
#pragma unroll
  for (int s = 0; s < 4; ++s) {
    U8 af[2];
#pragma unroll
    for (int i = 0; i < 2; ++i) {
      const float* ap = wsg + (w * 32 + i * 16 + c15) * 128 + s * 32 + q * 8;
      const float4 a0 = *(const float4*)ap, a1 = *(const float4*)(ap + 4);
      af[i].w[0] = pack2(a0.x, a0.y); af[i].w[1] = pack2(a0.z, a0.w); af[i].w[2] = pack2(a1.x, a1.y); af[i].w[3] = pack2(a1.z, a1.w);
    }
#pragma unroll
    for (int jn = 0; jn < 4; ++jn) {
      const bf16x8 bb = *(const bf16x8*)(vt + (jn * 16 + c15) * 136 + s * 32 + q * 8);
#pragma unroll
      for (int i = 0; i < 2; ++i) acc[i][jn] = mfma16(af[i].v, bb, acc[i][jn]);
    }
  }
#pragma unroll
  for (int i = 0; i < 2; ++i)
#pragma unroll
    for (int r = 0; r < 4; ++r) {
      const int pp = w * 32 + i * 16 + q * 4 + r;
      const size_t m = m0 + pp;
      const float bsv = p.mlp_bs[(l * 4 + g) * 128 + pp];
#pragma unroll
      for (int jn = 0; jn < 4; ++jn) {
        const int c = jn * 16 + c15;
        const float uu = bf2f(p.zf[m * 1792 + 1280 + g * 64 + c]);
        p.abuf[m * 1024 + 768 + g * 64 + c] = f2bf(uu * (acc[i][jn][r] + bsv));
      }
    }
  __syncthreads();
}

DEV void lru_apply_item(const Params& p, int l, int ti) {
  const int C = VTID;
  const int m0 = ti * 64;
  int ms, L, b; bool lat = m0 >= 8192;
  if (!lat) { ms = m0 & ~255; L = 256; b = m0 >> 8; } else { ms = 8192 + ((m0 - 8192) & ~1023); L = 1024; b = (m0 - 8192) >> 10; }
  const int k = (m0 - ms) >> 6, nt = L >> 6;
  const float* PCf = p.au; const float* HLf = p.au + (size_t)MT * 256;
  const float* PCb = p.au + (size_t)2 * MT * 256; const float* HLb = p.au + (size_t)3 * MT * 256;
  float cf = lat ? p.state_lru[((size_t)(b * 2 + l) * 2 + 0) * 256 + C] : 0.f;
  float cb = lat ? p.state_lru[((size_t)(b * 2 + l) * 2 + 1) * 256 + C] : 0.f;
  {
    float pc[15], hl[15];
#pragma unroll
    for (int i = 0; i < 15; ++i) {
      const bool act = i < k;
      const size_t e = (size_t)(ms + 64 * i + 63) * 256 + C;
      pc[i] = act ? PCf[e] : 1.f; hl[i] = act ? HLf[e] : 0.f;
    }
#pragma unroll
    for (int i = 0; i < 15; ++i) cf = pc[i] * cf + hl[i];
  }
  {
    float pc[15], hl[15];
#pragma unroll
    for (int i = 0; i < 15; ++i) {
      const int tix = nt - 1 - i;
      const bool act = tix > k;
      const size_t e = (size_t)(ms + 64 * tix) * 256 + C;
      pc[i] = act ? PCb[e] : 1.f; hl[i] = act ? HLb[e] : 0.f;
    }
#pragma unroll
    for (int i = 0; i < 15; ++i) cb = pc[i] * cb + hl[i];
  }
  float hf_last = 0.f, hb_first = 0.f;
#pragma unroll 8
  for (int t = 0; t < 64; ++t) {
    const size_t m = m0 + t;
    const float hf = PCf[m * 256 + C] * cf + HLf[m * 256 + C];
    const float hb = PCb[m * 256 + C] * cb + HLb[m * 256 + C];
    const float g = bf2f(p.zf[m * 1792 + 1024 + C]);
    p.abuf[m * 1024 + 512 + C] = f2bf((hf + hb) * g);
    if (t == 0) hb_first = hb;
    if (t == 63) hf_last = hf;
  }
  if (!lat) {
    if (k == nt - 1) p.out[OFF_ST + ((size_t)(b * 2 + l) * 2 + 0) * 256 + C] = hf_last;
    if (k == 0) p.out[OFF_ST + ((size_t)(b * 2 + l) * 2 + 1) * 256 + C] = hb_first;
  }
}

DEV void mixer_phase(const Params& p, int l, char* smem) {
  const int NITEMS = 1024 + 256 + 512 + 1024;
  for (int it = VBID; it < NITEMS; it += VNB) {
    if (it < 1024) attn_item(p, l, it, smem);
    else if (it < 1280) lru_apply_item(p, l, it - 1024);
    else if (it < 1792) gmlp_item(p, l, it - 1280, smem);
    else attn_item(p, l, it - 1792 + 1024, smem);
  }
}

DEV void prep_phase_full(const Params& p, int l, char* smem) {
  const int NITEMS = 1024 + 4096;
  for (int it = VBID; it < NITEMS; it += VNB) {
    if (it < 1024) lru_gate_item(p, l, it, smem);
    else prep_token_row(p, l, (it - 1024) * 4 + (VTID >> 6), VTID & 63);
  }
}


#define XB_TMO      128
#define XB_XCNT(j)  (256  + 64 * (j))
#define XB_XSUB(j)  (1280 + 64 * (j))
#define XB_XGEN(j)  (2304 + 64 * (j))
#define XB_TOP      3328
#define XB_TOPGEN   3392
#define XCD_BAR_WORDS 3456
#define XB_SPIN_CAP (1u << 18)
#define LAS __attribute__((address_space(3)))
DEV unsigned xb_ld(unsigned* p) { return __hip_atomic_load(p, __ATOMIC_RELAXED, __HIP_MEMORY_SCOPE_AGENT); }
DEV unsigned xb_add(unsigned* p, unsigned v) { return __hip_atomic_fetch_add(p, v, __ATOMIC_RELAXED, __HIP_MEMORY_SCOPE_AGENT); }
DEV unsigned xb_xcc_id() { return (unsigned)__builtin_amdgcn_s_getreg((3 << 11) | 20) & 0xFu; }
#define XB_SPIN(cond, bar) do { unsigned _sp = 0; while (cond) { __builtin_amdgcn_s_sleep(1); \
    if ((++_sp & 255u) == 0u) { if (xb_ld(&(bar)[XB_TMO])) break; if (_sp > XB_SPIN_CAP) { atomicAdd(&(bar)[XB_TMO], 1u); break; } } } } while (0)
struct XcdBarrier { unsigned* bar; unsigned x; volatile LAS unsigned* st; };
DEV XcdBarrier xcd_barrier_post(unsigned* bar, volatile LAS unsigned* st) {
  XcdBarrier b; b.bar = bar; b.x = xb_xcc_id(); b.st = st;
  if (threadIdx.x == 0) (void)xb_add(&bar[XB_XCNT(b.x)], 1u);
  return b;
}
DEV void xcd_barrier_complete(unsigned* bar, unsigned x, unsigned& nloc, unsigned& nx) {
  const unsigned G = gridDim.x * gridDim.y * gridDim.z;
  unsigned sum, cnt, mine, sp = 0u;
  for (;;) {
    sum = 0u; cnt = 0u; mine = 0u;
#pragma unroll
    for (unsigned j = 0; j < 16; ++j) { const unsigned c = xb_ld(&bar[XB_XCNT(j)]); sum += c; cnt += (c > 0u) ? 1u : 0u; mine = (j == x) ? c : mine; }
    if (sum == G) break;
    __builtin_amdgcn_s_sleep(1);
    if ((++sp & 255u) == 0u) { if (xb_ld(&bar[XB_TMO])) break; if (sp > XB_SPIN_CAP) { atomicAdd(&bar[XB_TMO], 1u); break; } }
  }
  nloc = mine > 0u ? mine : 1u; nx = cnt > 0u ? cnt : 1u;
}
DEV void xcd_barrier(const XcdBarrier& b) {
  asm volatile("s_waitcnt vmcnt(0)" ::: "memory");
  __syncthreads();
  if (threadIdx.x == 0) {
    unsigned* bar = b.bar;
    __builtin_amdgcn_s_waitcnt(0);
    unsigned nloc = b.st[0], nx = b.st[1];
    if (nloc == 0u) { xcd_barrier_complete(bar, b.x, nloc, nx); b.st[0] = nloc; b.st[1] = nx; }
    const unsigned old = xb_add(&bar[XB_XSUB(b.x)], 1u);
    const unsigned gen = old / nloc;
    if (old + 1u == (gen + 1u) * nloc) {
      __builtin_amdgcn_fence(__ATOMIC_RELEASE, "agent");
      asm volatile("s_waitcnt vmcnt(0)" ::: "memory");
      const unsigned og = xb_add(&bar[XB_TOP], 1u);
      const unsigned tg = og / nx;
      if (og + 1u == (tg + 1u) * nx) xb_add(&bar[XB_TOPGEN], 1u);
      else XB_SPIN(xb_ld(&bar[XB_TOPGEN]) == tg, bar);
      __builtin_amdgcn_fence(__ATOMIC_ACQUIRE, "agent");
      xb_add(&bar[XB_XGEN(b.x)], 1u);
      asm volatile("s_waitcnt vmcnt(0)" ::: "memory");
    } else {
      XB_SPIN(xb_ld(&bar[XB_XGEN(b.x)]) == gen, bar);
      __builtin_amdgcn_fence(__ATOMIC_ACQUIRE, "agent");
      asm volatile("s_waitcnt vmcnt(0)" ::: "memory");
    }
  }
  __syncthreads();
}

#define PH(i, call) if (ph_lo <= (i) && (i) < ph_hi) { if ((i) > ph_lo) xcd_barrier(xb); call; }
#define LAYER(l, b) \
  PH(b + 0, ln_mod_phase(p, l, l == 0 ? 0 : 1)) \
  PH(b + 1, gemm_phase<1>(p, l, p.abuf, p.wt_in + (size_t)l * 1792 * 1024, 1792, 1024, (LAS3 unsigned char*)smem_raw)) \
  PH(b + 2, prep_phase_full(p, l, smem)) \
  PH(b + 3, mixer_phase(p, l, smem)) \
  PH(b + 4, gemm_phase<2>(p, l, p.abuf, p.wt_out + (size_t)l * 1024 * 1024, 1024, 1024, (LAS3 unsigned char*)smem_raw)) \
  PH(b + 5, ln_mod_phase(p, l, 2)) \
  PH(b + 6, gemm_phase<3>(p, l, p.abuf, p.wt_ff1 + (size_t)l * 4096 * 1024, 4096, 1024, (LAS3 unsigned char*)smem_raw)) \
  PH(b + 7, gemm_phase<4>(p, l, p.zf, p.wt_ff2 + (size_t)l * 1024 * 4096, 1024, 4096, (LAS3 unsigned char*)smem_raw))

__global__ void __launch_bounds__(512, 2) mega_kernel(Params p, int ph_lo, int ph_hi) {
  extern __shared__ __attribute__((aligned(16))) char smem_raw[];
  char* smem = smem_raw + (threadIdx.x >> 8) * 65536;
  __shared__ uint4 xb_words;
  if (threadIdx.x == 0) xb_words = make_uint4(0u, 0u, 0u, 0u);
  __syncthreads();
  XcdBarrier xb = xcd_barrier_post(p.bar, (volatile LAS unsigned*)&xb_words);
  if (ph_hi > 1000) { cg::grid_group grid = cg::this_grid(); grid.sync(); }
  PH(0, phase0(p, smem))
  LAYER(0, 1)
  LAYER(1, 9)
  PH(17, ln_mod_phase(p, 1, 3))
}

extern "C" void kernel_launch(void* const* d_in, const int* in_sizes, int n_in, void* d_out, int out_size, void* d_ws, size_t ws_size,
                              hipStream_t stream) {
  static int grid_blocks = 0;
  if (!grid_blocks) {
    int dev = 0, cus = 0, per_cu = 0;
    hipGetDevice(&dev);
    hipDeviceGetAttribute(&cus, hipDeviceAttributeMultiprocessorCount, dev);
    hipFuncSetAttribute((const void*)mega_kernel, hipFuncAttributeMaxDynamicSharedMemorySize, SMEM_BYTES);
    hipOccupancyMaxActiveBlocksPerMultiprocessor(&per_cu, (const void*)mega_kernel, 512, SMEM_BYTES);
    if (per_cu < 1) per_cu = 1;
    if (per_cu > 1) per_cu = 1;
    grid_blocks = cus * per_cu;
  }
  Params p{};
  const float** pin = (const float**)&p;
  for (int i = 0; i < 32; ++i) pin[i] = (const float*)d_in[i];
  p.out = (float*)d_out;
  char* ws = (char*)d_ws;
  size_t off = 0;
  p.bar = (unsigned*)(ws + off); off += 16384;
  p.wt_in = (bf16_t*)(ws + off); off += (size_t)2 * 1792 * 1024 * 2;
  p.wt_out = (bf16_t*)(ws + off); off += (size_t)2 * 1024 * 1024 * 2;
  p.wt_ff1 = (bf16_t*)(ws + off); off += (size_t)2 * 4096 * 1024 * 2;
  p.wt_ff2 = (bf16_t*)(ws + off); off += (size_t)2 * 4096 * 1024 * 2;
  p.wt_lru = (bf16_t*)(ws + off); off += (size_t)64 * 4096 * 2;
  p.mod = (float*)(ws + off); off += (size_t)2 * 9 * 6144 * 4;
  p.rope = (float*)(ws + off); off += (size_t)2048 * 4;
  p.abuf = (bf16_t*)(ws + off); off += (size_t)MT * 1024 * 2;
  p.zf = (bf16_t*)(ws + off);
  p.au = (float*)(ws + off + (size_t)MT * 1792 * 2);
  off += (size_t)MT * 4096 * 2;
  if (off > ws_size) { fprintf(stderr, "workspace too small: need %zu have %zu\n", off, ws_size); return; }
  (void)hipMemsetAsync(p.bar, 0, XCD_BAR_WORDS * 4, stream);
#if MULTI_LAUNCH
  for (int ph = 0; ph < NPHASE; ++ph) {
    hipLaunchKernelGGL(mega_kernel, dim3(grid_blocks), dim3(512), SMEM_BYTES, stream, p, ph, ph + 1);
  }
#else
  int lo = 0, hi = NPHASE;
  void* args[] = {&p, &lo, &hi};
  hipError_t e = hipLaunchCooperativeKernel((void*)mega_kernel, dim3(grid_blocks), dim3(512), args, SMEM_BYTES, stream);
  if (e != hipSuccess) fprintf(stderr, "cooperative launch failed: %s (grid %d)\n", hipGetErrorString(e), grid_blocks);
#endif
}
```

```cpp
#include <hip/hip_runtime.h>
#include <hip/hip_cooperative_groups.h>
#include <cstdio>
#include <cstdint>
namespace cg = cooperative_groups;

#ifndef MULTI_LAUNCH
#define MULTI_LAUNCH 0
#endif

typedef unsigned short bf16_t;
using bf16x8 = __attribute__((ext_vector_type(8))) short;
using f32x4 = __attribute__((ext_vector_type(4))) float;
#define DEV __device__ __forceinline__
#define VTID ((int)(threadIdx.x & 255))
#define VBID ((int)(blockIdx.x * 2 + (threadIdx.x >> 8)))
#define VNB ((int)(gridDim.x * 2))

constexpr int MT = 16384;
constexpr int NPHASE = 18;
constexpr size_t OFF_YK = 16777216, OFF_YV = OFF_YK + 2097152, OFF_ST = OFF_YV + 2097152;
constexpr float ALPHA = 1.41421356237f;
constexpr float QSCALE = 0.125f * 1.4426950408889634f;
constexpr int SMEM_BYTES = 131072;

struct Params {
  const float *x_prompt, *x_sample, *c, *cache_k, *cache_v, *state_lru, *c_ctx, *w_ada, *b_ada, *w_in,
      *q_g, *k_g, *conv_w, *conv_b, *lru_wa, *lru_ba, *lru_wx, *lru_bx, *lru_lam, *mlp_g, *mlp_b, *mlp_ws, *mlp_bs,
      *w_out, *ln1_g, *ln1_b, *w_ff1, *b_ff1, *w_ff2, *b_ff2, *ln2_g, *ln2_b;
  float* out;
  bf16_t *wt_in, *wt_out, *wt_ff1, *wt_ff2, *wt_lru;
  float *mod, *rope;
  bf16_t *abuf;
  bf16_t *zf;
  float *au;
  bf16_t *kb_lat, *vt_lat;
  bf16_t *kb_ctx, *vt_ctx;
  unsigned *bar;
};

union U8 { uint4 u; bf16x8 v; bf16_t h[8]; unsigned w[4]; };

DEV float bf2f(bf16_t h) { return __uint_as_float(((unsigned)h) << 16); }
DEV bf16_t f2bf(float f) { unsigned u = __float_as_uint(f); u += 0x7fffu + ((u >> 16) & 1u); return (bf16_t)(u >> 16); }
DEV unsigned pack2(float a, float b) { unsigned r; asm volatile("v_cvt_pk_bf16_f32 %0, %1, %2" : "=v"(r) : "v"(a), "v"(b)); return r; }
DEV float gelu_t(float x) { float y = 0.7978845608028654f * (x + 0.044715f * x * x * x); float t = 1.f - 2.f / (1.f + __expf(2.f * y)); return 0.5f * x * (1.f + t); }
DEV float sigmoidf_(float x) { return 1.f / (1.f + __expf(-x)); }
DEV int cond_of(int m) { return m < 8192 ? 0 : 1 + ((m - 8192) >> 10); }
DEV f32x4 mfma16(bf16x8 a, bf16x8 b, f32x4 c) { return __builtin_amdgcn_mfma_f32_16x16x32_bf16(a, b, c, 0, 0, 0); }
DEV float wave_sum(float v) {
#pragma unroll
  for (int o = 32; o >= 1; o >>= 1) v += __shfl_xor(v, o);
  return v;
}

DEV void transpose_tile(const float* __restrict__ src, bf16_t* __restrict__ dst, int lds_, int ldd, char* smem) {
  float* T = (float*)smem;
  const int tid = VTID;
#pragma unroll
  for (int i = 0; i < 4; ++i) {
    int k = (tid >> 4) + 16 * i, n4 = (tid & 15) * 4;
    float4 v = *(const float4*)(src + (size_t)k * lds_ + n4);
    T[k * 65 + n4 + 0] = v.x; T[k * 65 + n4 + 1] = v.y; T[k * 65 + n4 + 2] = v.z; T[k * 65 + n4 + 3] = v.w;
  }
  __syncthreads();
#pragma unroll
  for (int i = 0; i < 2; ++i) {
    int n = (tid >> 3) + 32 * i, k8 = (tid & 7) * 8;
    U8 o;
#pragma unroll
    for (int j = 0; j < 4; ++j) o.w[j] = pack2(T[(k8 + 2 * j) * 65 + n], T[(k8 + 2 * j + 1) * 65 + n]);
    *(uint4*)(dst + (size_t)n * ldd + k8) = o.u;
  }
  __syncthreads();
}
DEV void transpose_w(const float* __restrict__ W, bf16_t* __restrict__ Wt, int K, int N, int tk, int tn, char* smem) {
  transpose_tile(W + (size_t)(tk * 64) * N + tn * 64, Wt + (size_t)(tn * 64) * K + tk * 64, N, K, smem);
}

DEV void phase0(const Params& p, char* smem) {
  const int tid = VTID;
  const int NT0 = 192 + 2 * 2768, NITEMS = NT0 + 128 + 64 + 2;
  for (int it = VBID; it < NITEMS; it += VNB) {
    if (it < 192) {
      const int l = it / 96, n0 = (it % 96) * 64;
      float* s = (float*)smem;
      float* red = s + 9 * 1024;
      for (int idx = tid; idx < 9 * 1024; idx += 256) {
        int c = idx >> 10, k = idx & 1023;
        float v = (c == 0) ? p.c_ctx[k] : p.c[(c - 1) * 1024 + k];
        s[idx] = v / (1.f + __expf(-v));
      }
      __syncthreads();
      const int kq = tid >> 6, n = tid & 63;
      float acc[9];
#pragma unroll
      for (int c = 0; c < 9; ++c) acc[c] = 0.f;
      const float* wp = p.w_ada + ((size_t)l * 1024 + kq * 256) * 6144 + n0 + n;
#pragma unroll 4
      for (int k = 0; k < 256; ++k) {
        float wv = wp[(size_t)k * 6144];
#pragma unroll
        for (int c = 0; c < 9; ++c) acc[c] += s[c * 1024 + kq * 256 + k] * wv;
      }
#pragma unroll
      for (int c = 0; c < 9; ++c) red[(kq * 9 + c) * 64 + n] = acc[c];
      __syncthreads();
      for (int idx = tid; idx < 576; idx += 256) {
        int c = idx >> 6, nn = idx & 63;
        float v = red[(0 * 9 + c) * 64 + nn] + red[(1 * 9 + c) * 64 + nn] + red[(2 * 9 + c) * 64 + nn] + red[(3 * 9 + c) * 64 + nn] +
                  p.b_ada[l * 6144 + n0 + nn];
        p.mod[((size_t)l * 9 + c) * 6144 + n0 + nn] = v;
      }
      __syncthreads();
    } else if (it >= NT0 && it < NT0 + 128) {
      const int j = it - NT0, tt = j & 3, kvh = (j >> 2) & 1, l = (j >> 3) & 1, b = j >> 4;
      transpose_tile(p.cache_v + ((size_t)(b * 2 + l) * 256 + tt * 64) * 128 + kvh * 64, p.vt_lat + ((size_t)((l * 8 + b) * 2 + kvh) * 64) * 1280 + tt * 64, 128, 1280, smem);
    } else if (it >= NT0 + 128 && it < NT0 + 192) {
      const int j = it - NT0 - 128;
#pragma unroll
      for (int i = 0; i < 4; ++i) {
        const int e = (j * 1024 + i * 256 + tid) * 8;
        const int d = e & 63, kvh = (e >> 6) & 1, t = (e >> 7) & 255, l = (e >> 15) & 1, b = e >> 16;
        const float4 a0 = *(const float4*)(p.cache_k + e), a1 = *(const float4*)(p.cache_k + e + 4);
        U8 o; o.w[0] = pack2(a0.x, a0.y); o.w[1] = pack2(a0.z, a0.w); o.w[2] = pack2(a1.x, a1.y); o.w[3] = pack2(a1.z, a1.w);
        *(uint4*)(p.kb_lat + ((size_t)((l * 8 + b) * 2 + kvh) * 1280 + t) * 64 + d) = o.u;
      }
    } else if (it >= NT0 + 192) {
      if (it == NT0 + 192)
      for (int idx = tid; idx < 1024; idx += 256) {
        int pp = idx >> 4, f = idx & 15;
        float inv = powf(10000.f, -(float)f / 16.f);
        float ang = (float)pp * inv;
        float nrev = rintf(ang * 0.15915494309189535f);
        float r = fmaf(-nrev, 6.28125f, ang);
        r = fmaf(-nrev, 0.0019353071795864769f, r);
        p.rope[idx * 2 + 0] = __cosf(r);
        p.rope[idx * 2 + 1] = __sinf(r);
      }
    } else {
      int t = it - 192;
      const int l = t / 2768, r = t % 2768;
      if (r < 448) transpose_w(p.w_in + (size_t)l * 1024 * 1792, p.wt_in + (size_t)l * 1792 * 1024, 1024, 1792, r / 28, r % 28, smem);
      else if (r < 704) { int i = r - 448; transpose_w(p.w_out + (size_t)l * 1024 * 1024, p.wt_out + (size_t)l * 1024 * 1024, 1024, 1024, i / 16, i % 16, smem); }
      else if (r < 1728) { int i = r - 704; transpose_w(p.w_ff1 + (size_t)l * 1024 * 4096, p.wt_ff1 + (size_t)l * 4096 * 1024, 1024, 4096, i / 64, i % 64, smem); }
      else if (r < 2752) { int i = r - 1728; transpose_w(p.w_ff2 + (size_t)l * 4096 * 1024, p.wt_ff2 + (size_t)l * 1024 * 4096, 4096, 1024, i / 16, i % 16, smem); }
      else {
        int idx = r - 2752;
        int dir = idx >> 3, blk = (idx >> 1) & 3, mat = idx & 1;
        const float* src = (mat == 0 ? p.lru_wa : p.lru_wx) + (size_t)(((l * 2 + dir) * 4 + blk)) * 4096;
        bf16_t* dst = p.wt_lru + (size_t)((((l * 2 + dir) * 4 + blk) * 2 + mat)) * 4096;
        transpose_tile(src, dst, 64, 64, smem);
      }
    }
  }
}

DEV void ln_mod_phase(const Params& p, int l, int mode) {
  const int lane = threadIdx.x & 63, w = threadIdx.x >> 6;
  const float* lg = nullptr; const float* lb = nullptr;
  if (mode == 1) { lg = p.ln2_g + (l - 1) * 1024; lb = p.ln2_b + (l - 1) * 1024; }
  else if (mode == 2) { lg = p.ln1_g + l * 1024; lb = p.ln1_b + l * 1024; }
  else if (mode == 3) { lg = p.ln2_g + l * 1024; lb = p.ln2_b + l * 1024; }
  const int shoff = (mode == 2) ? 3072 : 0;
  for (int m = blockIdx.x * 8 + w; m < MT; m += gridDim.x * 8) {
    const float* src;
    if (mode == 0) src = (m < 8192) ? p.x_prompt + (size_t)m * 1024 : p.x_sample + (size_t)(m - 8192) * 1024;
    else src = p.out + (size_t)m * 1024;
    float4 v[4];
#pragma unroll
    for (int i = 0; i < 4; ++i) v[i] = *(const float4*)(src + i * 256 + lane * 4);
    if (mode != 0) {
      float s = 0.f;
#pragma unroll
      for (int i = 0; i < 4; ++i) s += v[i].x + v[i].y + v[i].z + v[i].w;
      const float mean = wave_sum(s) * (1.f / 1024.f);
      float s2 = 0.f;
#pragma unroll
      for (int i = 0; i < 4; ++i) { float a = v[i].x - mean, b = v[i].y - mean, c = v[i].z - mean, d = v[i].w - mean; s2 += a * a + b * b + c * c + d * d; }
      const float rstd = rsqrtf(wave_sum(s2) * (1.f / 1024.f) + 1e-6f);
#pragma unroll
      for (int i = 0; i < 4; ++i) {
        float4 g = *(const float4*)(lg + i * 256 + lane * 4), b = *(const float4*)(lb + i * 256 + lane * 4);
        v[i].x = (v[i].x - mean) * rstd * g.x + b.x; v[i].y = (v[i].y - mean) * rstd * g.y + b.y;
        v[i].z = (v[i].z - mean) * rstd * g.z + b.z; v[i].w = (v[i].w - mean) * rstd * g.w + b.w;
        *(float4*)(p.out + (size_t)m * 1024 + i * 256 + lane * 4) = v[i];
      }
    }
    if (mode != 3) {
      const float* md = p.mod + ((size_t)l * 9 + cond_of(m)) * 6144 + shoff;
#pragma unroll
      for (int i = 0; i < 4; ++i) {
        float4 sh = *(const float4*)(md + i * 256 + lane * 4), sc = *(const float4*)(md + 1024 + i * 256 + lane * 4);
        uint2 o;
        o.x = pack2(v[i].x * (1.f + sc.x) + sh.x, v[i].y * (1.f + sc.y) + sh.y);
        o.y = pack2(v[i].z * (1.f + sc.z) + sh.z, v[i].w * (1.f + sc.w) + sh.w);
        *(uint2*)(p.abuf + (size_t)m * 1024 + i * 256 + lane * 4) = o;
      }
    }
  }
}

#define LAS3 __attribute__((address_space(3)))
namespace g8 {
constexpr int BM = 256, BK = 64, HALF = 128, HTB = HALF * BK * 2, NXCD = 8, WGM = 8;
DEV int lds_byte(int r, int c) { const int st = (r >> 4) * 2 + (c >> 5), rr = r & 15, cc = c & 31, ob = rr * 64 + cc * 2; return st * 1024 + (ob ^ (((ob >> 9) & 1) << 5)); }
DEV void stage_rc(int b, int& R, int& C) { const int st = b / 1024, sb = b % 1024, swz = sb ^ (((sb >> 9) & 1) << 5); R = (st >> 1) * 16 + swz / 64; C = (st & 1) * 32 + (swz % 64) / 2; }
DEV bool unit_of(int i, int nM, int nN, int& pm, int& pn) {
  const int nwg = nM * nN;
  const long L = (long)i * gridDim.x + blockIdx.x; if (L >= nwg) return false;
  int wgid = (int)L; { const int q = nwg / NXCD, r = nwg % NXCD, xcd = wgid % NXCD, off = wgid / NXCD; wgid = (xcd < r ? xcd * (q + 1) : r * (q + 1) + (xcd - r) * q) + off; }
  const int nig = WGM * nN, gid = wgid / nig, fm = gid * WGM, gsz = (nM - fm) < WGM ? (nM - fm) : WGM;
  pm = fm + ((wgid % nig) % gsz); pn = (wgid % nig) / gsz; return true;
}
}

template <int EPI>
DEV void gemm_epilogue(const Params& p, int l, f32x4 (&acc)[2][2][4][2], int pm, int pn, int wr, int wc, int fr, int fq) {
  const int brow = pm * 256, bcol = pn * 256;
  const float* md = p.mod + ((size_t)l * 9 + cond_of(brow)) * 6144;
#pragma unroll
  for (int bj = 0; bj < 2; ++bj)
#pragma unroll
    for (int n = 0; n < 2; ++n) {
      const int col = bcol + bj * 128 + wc * 32 + n * 16 + fq * 4;
      float4 gate = make_float4(0.f, 0.f, 0.f, 0.f), bias = make_float4(0.f, 0.f, 0.f, 0.f);
      if (EPI == 2) gate = *(const float4*)(md + 2048 + col);
      if (EPI == 3) bias = *(const float4*)(p.b_ff1 + l * 4096 + col);
      if (EPI == 4) { gate = *(const float4*)(md + 5120 + col); bias = *(const float4*)(p.b_ff2 + l * 1024 + col); }
#pragma unroll
      for (int ai = 0; ai < 2; ++ai)
#pragma unroll
        for (int m = 0; m < 4; ++m) {
          const int row = brow + ai * 128 + wr * 64 + m * 16 + fr;
          const f32x4 v = acc[ai][bj][m][n];
          if (EPI == 1) {
            uint2 o; o.x = pack2(v[0], v[1]); o.y = pack2(v[2], v[3]);
            *(uint2*)(p.zf + (size_t)row * 1792 + col) = o;
          } else if (EPI == 2) {
            const float* xs = (l == 0) ? ((row < 8192) ? p.x_prompt + (size_t)row * 1024 : p.x_sample + (size_t)(row - 8192) * 1024) : p.out + (size_t)row * 1024;
            const float4 x = *(const float4*)(xs + col);
            *(float4*)(p.out + (size_t)row * 1024 + col) = make_float4(ALPHA * x.x + gate.x * v[0], ALPHA * x.y + gate.y * v[1], ALPHA * x.z + gate.z * v[2], ALPHA * x.w + gate.w * v[3]);
          } else if (EPI == 3) {
            const float t0 = fmaxf(v[0] + bias.x, 0.f), t1 = fmaxf(v[1] + bias.y, 0.f), t2 = fmaxf(v[2] + bias.z, 0.f), t3 = fmaxf(v[3] + bias.w, 0.f);
            uint2 o; o.x = pack2(t0 * t0, t1 * t1); o.y = pack2(t2 * t2, t3 * t3);
            *(uint2*)(p.zf + (size_t)row * 4096 + col) = o;
          } else {
            float* xo = p.out + (size_t)row * 1024 + col;
            const float4 x = *(const float4*)xo;
            *(float4*)xo = make_float4(ALPHA * x.x + gate.x * (v[0] + bias.x), ALPHA * x.y + gate.y * (v[1] + bias.y), ALPHA * x.z + gate.z * (v[2] + bias.z), ALPHA * x.w + gate.w * (v[3] + bias.w));
          }
        }
    }
}

template <int EPI>
DEV void gemm_phase(const Params& p, int l, const bf16_t* Ag, const bf16_t* Btg, int N, int K, LAS3 unsigned char* lds) {
  using namespace g8;
  const int tid = threadIdx.x, wid = __builtin_amdgcn_readfirstlane(tid >> 6), lane = tid & 63, wr = wid >> 2, wc = wid & 3, fr = lane & 15, fq = lane >> 4;
  const int nt = K / BK, nM = MT / BM, nN = N / BM;
  unsigned voff[2];
#pragma unroll
  for (int i = 0; i < 2; ++i) { int R, C; stage_rc(tid * 16 + i * 8192, R, C); voff[i] = (unsigned)(R * K + C) * 2u; }
  const size_t kstep = (size_t)(BK * 2);
  const size_t hstep = (size_t)HALF * K * 2;
  const size_t tstep = 2 * hstep;
  const unsigned ldsw = (unsigned)wid * 1024u;
  const int aoff = lds_byte(wr * 64 + fr, fq * 8), boff = lds_byte(wc * 32 + fr, fq * 8);
#define PG8_SA(b, h) (((b) * 2 + (h)) * HTB)
#define PG8_SB(b, h) ((4 + (b) * 2 + (h)) * HTB)
#define PG8_STAGE(bufoff, gbase) do { _Pragma("unroll") for (int _i = 0; _i < 2; ++_i) \
    __builtin_amdgcn_global_load_lds((const unsigned*)((const char*)(gbase) + voff[_i]), (LAS3 unsigned*)(lds + (bufoff) + ldsw + _i * 8192), 16, 0, 0); } while (0)
#define PG8_LDA(dst, b, h) do { _Pragma("unroll") for (int m = 0; m < 4; ++m) _Pragma("unroll") for (int k = 0; k < 2; ++k) dst[m][k] = *(const LAS3 bf16x8*)(lds + PG8_SA(b, h) + aoff + m * 2048 + k * 1024); } while (0)
#define PG8_LDB(dst, b, h) do { _Pragma("unroll") for (int n = 0; n < 2; ++n) _Pragma("unroll") for (int k = 0; k < 2; ++k) dst[n][k] = *(const LAS3 bf16x8*)(lds + PG8_SB(b, h) + boff + n * 2048 + k * 1024); } while (0)
#define PG8_MMA(ai, bj, At_, Bt_) do { __builtin_amdgcn_s_setprio(1); _Pragma("unroll") for (int m = 0; m < 4; ++m) _Pragma("unroll") for (int n = 0; n < 2; ++n) _Pragma("unroll") for (int k = 0; k < 2; ++k) \
    acc[ai][bj][m][n] = __builtin_amdgcn_mfma_f32_16x16x32_bf16(Bt_[n][k], At_[m][k], acc[ai][bj][m][n], 0, 0, 0); __builtin_amdgcn_s_setprio(0); } while (0)
#define PG8_WAIT_V(n) asm volatile("s_waitcnt vmcnt(" #n ")" ::: "memory")
#define PG8_WAIT_L(n) asm volatile("s_waitcnt lgkmcnt(" #n ")" ::: "memory")
#define PG8_BAR __builtin_amdgcn_s_barrier()
#define PG8_SCHED __builtin_amdgcn_sched_barrier(0)
  int cpm, cpn, npm = 0, npn = 0, ui = 0;
  if (!unit_of(0, nM, nN, cpm, cpn)) return;
  f32x4 acc[2][2][4][2];
#pragma unroll
  for (int a = 0; a < 2; ++a)
#pragma unroll
    for (int b = 0; b < 2; ++b)
#pragma unroll
      for (int m = 0; m < 4; ++m)
#pragma unroll
        for (int n = 0; n < 2; ++n) acc[a][b][m][n] = (f32x4){0.f, 0.f, 0.f, 0.f};
  bf16x8 At[4][2], B0[2][2], B1[2][2];
  const char* cA = (const char*)Ag + (size_t)cpm * tstep; const char* cB = (const char*)Btg + (size_t)cpn * tstep;
  PG8_STAGE(PG8_SB(0, 0), cB); PG8_STAGE(PG8_SA(0, 0), cA); PG8_STAGE(PG8_SB(0, 1), cB + hstep); PG8_STAGE(PG8_SA(0, 1), cA + hstep);
  if (wr == 1) PG8_BAR;
  PG8_WAIT_V(4); PG8_BAR;
  PG8_STAGE(PG8_SB(1, 0), cB + kstep); PG8_STAGE(PG8_SA(1, 0), cA + kstep); PG8_STAGE(PG8_SB(1, 1), cB + hstep + kstep);
  PG8_WAIT_V(6); PG8_BAR;
  for (;;) {
    const bool has_next = unit_of(ui + 1, nM, nN, npm, npn);
    const char* nA = has_next ? (const char*)Ag + (size_t)npm * tstep : cA; const char* nB = has_next ? (const char*)Btg + (size_t)npn * tstep : cB;
    for (int t = 0; t < nt; t += 2) {
      const bool last = (t == nt - 2);
      const char* a1 = cA + (size_t)(t + 1) * kstep;
      const char* a2 = last ? nA : cA + (size_t)(t + 2) * kstep; const char* b2 = last ? nB : cB + (size_t)(t + 2) * kstep;
      const char* a3 = a2 + kstep; const char* b3 = b2 + kstep;
      PG8_LDB(B0, 0, 0); PG8_SCHED; PG8_LDA(At, 0, 0); PG8_STAGE(PG8_SA(1, 1), a1 + hstep);
      PG8_WAIT_L(8); PG8_BAR; PG8_WAIT_L(0); PG8_MMA(0, 0, At, B0); PG8_BAR; PG8_SCHED;
      PG8_LDB(B1, 0, 1); PG8_STAGE(PG8_SB(0, 0), b2);
      PG8_BAR; PG8_WAIT_L(0); PG8_MMA(0, 1, At, B1); PG8_BAR;
      PG8_LDA(At, 0, 1); PG8_STAGE(PG8_SA(0, 0), a2);
      PG8_BAR; PG8_WAIT_L(0); PG8_MMA(1, 0, At, B0); PG8_BAR; PG8_SCHED;
      PG8_STAGE(PG8_SB(0, 1), b2 + hstep);
      PG8_WAIT_V(6); PG8_BAR; PG8_MMA(1, 1, At, B1); PG8_BAR;
      PG8_LDB(B0, 1, 0); PG8_SCHED; PG8_LDA(At, 1, 0); PG8_STAGE(PG8_SA(0, 1), a2 + hstep);
      PG8_WAIT_L(8); PG8_BAR; PG8_WAIT_L(0); PG8_MMA(0, 0, At, B0); PG8_BAR; PG8_SCHED;
      PG8_LDB(B1, 1, 1); PG8_STAGE(PG8_SB(1, 0), b3);
      PG8_BAR; PG8_WAIT_L(0); PG8_MMA(0, 1, At, B1); PG8_BAR;
      PG8_LDA(At, 1, 1); PG8_STAGE(PG8_SA(1, 0), a3);
      PG8_BAR; PG8_WAIT_L(0); PG8_MMA(1, 0, At, B0); PG8_BAR; PG8_SCHED;
      PG8_STAGE(PG8_SB(1, 1), b3 + hstep);
      PG8_WAIT_V(6); PG8_BAR; PG8_MMA(1, 1, At, B1); PG8_BAR;
    }
    gemm_epilogue<EPI>(p, l, acc, cpm, cpn, wr, wc, fr, fq);
    if (!has_next) break;
#pragma unroll
    for (int a = 0; a < 2; ++a)
#pragma unroll
      for (int b = 0; b < 2; ++b)
#pragma unroll
        for (int m = 0; m < 4; ++m)
#pragma unroll
          for (int n = 0; n < 2; ++n) acc[a][b][m][n] = (f32x4){0.f, 0.f, 0.f, 0.f};
    cpm = npm; cpn = npn; cA = nA; cB = nB; ++ui;
  }
  PG8_WAIT_V(0);
  if (wr == 0) PG8_BAR;
  PG8_BAR;
#undef PG8_SA
#undef PG8_SB
#undef PG8_STAGE
#undef PG8_LDA
#undef PG8_LDB
#undef PG8_MMA
#undef PG8_WAIT_V
#undef PG8_WAIT_L
#undef PG8_BAR
#undef PG8_SCHED
}

DEV void rope8(float (&v)[8], int d0, int prow, int pcol, const float* __restrict__ rope) {
  const int pp = (d0 < 32) ? prow : pcol;
#pragma unroll
  for (int i = 0; i < 4; ++i) {
    const int f = ((d0 >> 1) + i) & 15;
    const float cs = rope[(pp * 16 + f) * 2], sn = rope[(pp * 16 + f) * 2 + 1];
    const float x1 = v[2 * i], x2 = v[2 * i + 1];
    v[2 * i] = x1 * cs - x2 * sn; v[2 * i + 1] = x1 * sn + x2 * cs;
  }
}

DEV void prep_token_row(const Params& p, int l, int m, int lane) {
  bf16_t* zr = p.zf + (size_t)m * 1792;
  const bool lat = m >= 8192;
  const int pos = lat ? ((m - 8192) & 1023) : (m & 255);
  const int prow = pos >> 6, pcol = pos & 63;
  const int d0 = (lane & 7) * 8;
  {
    U8 u; u.u = *(const uint4*)(zr + lane * 8);
    float v[8]; float ss = 0.f;
#pragma unroll
    for (int j = 0; j < 8; ++j) { v[j] = bf2f(u.h[j]); ss += v[j] * v[j]; }
    ss += __shfl_xor(ss, 1); ss += __shfl_xor(ss, 2); ss += __shfl_xor(ss, 4);
    const float rinv = rsqrtf(ss * (1.f / 64.f) + 1e-6f);
#pragma unroll
    for (int j = 0; j < 8; ++j) v[j] = v[j] * rinv * p.q_g[l * 64 + d0 + j];
    if (lat) rope8(v, d0, prow, pcol, p.rope);
#pragma unroll
    for (int j = 0; j < 4; ++j) u.w[j] = pack2(v[2 * j] * QSCALE, v[2 * j + 1] * QSCALE);
    *(uint4*)(zr + lane * 8) = u.u;
  }
  {
    const int col = lane < 32 ? 512 + lane * 8 : 1024 + (lane - 32) * 8;
    U8 u; u.u = *(const uint4*)(zr + col);
    float v[8]; float ss = 0.f;
#pragma unroll
    for (int j = 0; j < 8; ++j) { v[j] = bf2f(u.h[j]); ss += v[j] * v[j]; }
    ss += __shfl_xor(ss, 1); ss += __shfl_xor(ss, 2); ss += __shfl_xor(ss, 4);
    if (lane < 16) {
      const float rinv = rsqrtf(ss * (1.f / 64.f) + 1e-6f);
#pragma unroll
      for (int j = 0; j < 8; ++j) v[j] = v[j] * rinv * p.k_g[l * 64 + d0 + j];
      if (!lat) {
        float* o = p.out + OFF_YK + ((((size_t)(m >> 8)) * 2 + l) * 256 + pos) * 128 + lane * 8;
        *(float4*)o = make_float4(v[0], v[1], v[2], v[3]); *(float4*)(o + 4) = make_float4(v[4], v[5], v[6], v[7]);
      } else rope8(v, d0, prow, pcol, p.rope);
#pragma unroll
      for (int j = 0; j < 4; ++j) u.w[j] = pack2(v[2 * j], v[2 * j + 1]);
      const int kvh = lane >> 3;
      bf16_t* kd = lat ? p.kb_lat + ((size_t)((l * 8 + ((m - 8192) >> 10)) * 2 + kvh) * 1280 + 256 + pos) * 64 + d0
                       : p.kb_ctx + ((size_t)((m >> 8) * 2 + kvh) * 256 + pos) * 64 + d0;
      *(uint4*)kd = u.u;
    } else if (lane < 32) {
      if (!lat) {
        float* o = p.out + OFF_YV + ((((size_t)(m >> 8)) * 2 + l) * 256 + pos) * 128 + (lane - 16) * 8;
        *(float4*)o = make_float4(v[0], v[1], v[2], v[3]); *(float4*)(o + 4) = make_float4(v[4], v[5], v[6], v[7]);
      }
      const int kvh = (lane - 16) >> 3;
      bf16_t* vd; int T;
      if (lat) { T = 1280; vd = p.vt_lat + ((size_t)((l * 8 + ((m - 8192) >> 10)) * 2 + kvh) * 64 + d0) * 1280 + 256 + pos; }
      else { T = 256; vd = p.vt_ctx + ((size_t)((m >> 8) * 2 + kvh) * 64 + d0) * 256 + pos; }
#pragma unroll
      for (int j = 0; j < 8; ++j) vd[(size_t)j * T] = u.h[j];
    } else {
#pragma unroll
      for (int j = 0; j < 4; ++j) u.w[j] = pack2(gelu_t(v[2 * j]), gelu_t(v[2 * j + 1]));
      *(uint4*)(zr + col) = u.u;
    }
  }
  {
    const int col = 1280 + lane * 8;
    U8 u; u.u = *(const uint4*)(zr + col);
    float v[8]; float s = 0.f;
#pragma unroll
    for (int j = 0; j < 8; ++j) { v[j] = gelu_t(bf2f(u.h[j])); s += v[j]; }
#pragma unroll
    for (int o = 1; o <= 16; o <<= 1) s += __shfl_xor(s, o);
    const float mean = s * (1.f / 256.f);
    float s2 = 0.f;
#pragma unroll
    for (int j = 0; j < 8; ++j) { float d = v[j] - mean; s2 += d * d; }
#pragma unroll
    for (int o = 1; o <= 16; o <<= 1) s2 += __shfl_xor(s2, o);
    if (lane >= 32) {
      const float rstd = rsqrtf(s2 * (1.f / 256.f) + 1e-6f);
      const int ch = (lane - 32) * 8;
#pragma unroll
      for (int j = 0; j < 8; ++j) v[j] = (v[j] - mean) * rstd * p.mlp_g[l * 256 + ch + j] + p.mlp_b[l * 256 + ch + j];
    }
#pragma unroll
    for (int j = 0; j < 4; ++j) u.w[j] = pack2(v[2 * j], v[2 * j + 1]);
    *(uint4*)(zr + col) = u.u;
  }
}

template <bool REV>
DEV void tile_scan(float (&a)[4][4], float (&u)[4][4], int lane) {
  const int q = lane >> 4;
  float C = 0.f, CP = 1.f;
  const int src1 = (REV ? lane + 16 : lane - 16) & 63;
  const int src2 = (REV ? lane + 32 : lane - 32) & 63;
  const int srcT = (lane & 15) + (REV ? 0 : 48);
  const bool c1 = REV ? (q <= 2) : (q >= 1);
  const bool c2 = REV ? (q <= 1) : (q >= 2);
  const bool first = REV ? (q == 3) : (q == 0);
#pragma unroll
  for (int mi = 0; mi < 4; ++mi) {
    const int mt = REV ? 3 - mi : mi;
    float P = 1.f, H = 0.f, pl[4], hl[4];
#pragma unroll
    for (int ri = 0; ri < 4; ++ri) {
      const int r = REV ? 3 - ri : ri;
      H = a[mt][r] * H + u[mt][r]; P *= a[mt][r]; pl[r] = P; hl[r] = H;
    }
    float Pi = P, Hi = H;
    float Pp = __shfl(Pi, src1), Hp = __shfl(Hi, src1);
    if (c1) { Hi = Pi * Hp + Hi; Pi = Pi * Pp; }
    Pp = __shfl(Pi, src2); Hp = __shfl(Hi, src2);
    if (c2) { Hi = Pi * Hp + Hi; Pi = Pi * Pp; }
    float Pe = __shfl(Pi, src1), He = __shfl(Hi, src1);
    if (first) { Pe = 1.f; He = 0.f; }
    const float hin = Pe * C + He, pin = Pe * CP;
#pragma unroll
    for (int r = 0; r < 4; ++r) { u[mt][r] = pl[r] * hin + hl[r]; a[mt][r] = pl[r] * pin; }
    const float Pt = __shfl(Pi, srcT), Ht = __shfl(Hi, srcT);
    C = Pt * C + Ht; CP = Pt * CP;
  }
}

DEV void lru_gate_item(const Params& p, int l, int item, char* smem) {
  const int tid = VTID, lane = tid & 63, w = tid >> 6;
  const int tile = item >> 2, blk = item & 3;
  const int m0 = tile * 64;
  int ms, L;
  if (m0 < 8192) { ms = m0 & ~255; L = 256; } else { ms = 8192 + ((m0 - 8192) & ~1023); L = 1024; }
  float* xs = (float*)smem;
  float* xcf = xs + 67 * 64;
  bf16_t* xcb = (bf16_t*)(xcf + 64 * 64);
  for (int idx = tid; idx < 67 * 8; idx += 256) {
    const int rr = idx >> 3, cc = idx & 7;
    const int m = m0 - 1 + rr;
    float v[8];
    if (m >= ms && m < ms + L) {
      U8 u; u.u = *(const uint4*)(p.zf + (size_t)m * 1792 + 768 + blk * 64 + cc * 8);
#pragma unroll
      for (int j = 0; j < 8; ++j) v[j] = bf2f(u.h[j]);
    } else {
#pragma unroll
      for (int j = 0; j < 8; ++j) v[j] = 0.f;
    }
#pragma unroll
    for (int j = 0; j < 8; ++j) xs[rr * 64 + cc * 8 + j] = v[j];
  }
  __syncthreads();
  {
    const int ch = tid & 63, Cg = blk * 64 + ch;
    const float w0 = p.conv_w[(l * 4 + 0) * 256 + Cg], w1 = p.conv_w[(l * 4 + 1) * 256 + Cg], w2 = p.conv_w[(l * 4 + 2) * 256 + Cg],
                w3 = p.conv_w[(l * 4 + 3) * 256 + Cg], cb = p.conv_b[l * 256 + Cg];
#pragma unroll 4
    for (int tt = 0; tt < 16; ++tt) {
      const int t = (tid >> 6) * 16 + tt;
      const float v = cb + w0 * xs[t * 64 + ch] + w1 * xs[(t + 1) * 64 + ch] + w2 * xs[(t + 2) * 64 + ch] + w3 * xs[(t + 3) * 64 + ch];
      xcf[t * 64 + ch] = v; xcb[t * 72 + ch] = f2bf(v);
    }
  }
  __syncthreads();
  const int dir = w >> 1, half = w & 1, q = lane >> 4, c15 = lane & 15;
  const bf16_t* wt = p.wt_lru + (size_t)((((l * 2 + dir) * 4 + blk) * 2)) * 4096;
  bf16x8 bfr[2][2][2];
#pragma unroll
  for (int mat = 0; mat < 2; ++mat)
#pragma unroll
    for (int j = 0; j < 2; ++j)
#pragma unroll
      for (int s = 0; s < 2; ++s) bfr[mat][j][s] = *(const bf16x8*)(wt + mat * 4096 + (half * 32 + j * 16 + c15) * 64 + s * 32 + q * 8);
  f32x4 acc[2][4][2];
#pragma unroll
  for (int mat = 0; mat < 2; ++mat)
#pragma unroll
    for (int mt = 0; mt < 4; ++mt)
#pragma unroll
      for (int j = 0; j < 2; ++j) acc[mat][mt][j] = f32x4{0.f, 0.f, 0.f, 0.f};
#pragma unroll
  for (int mt = 0; mt < 4; ++mt)
#pragma unroll
    for (int s = 0; s < 2; ++s) {
      const bf16x8 af = *(const bf16x8*)(xcb + (mt * 16 + c15) * 72 + s * 32 + q * 8);
#pragma unroll
      for (int mat = 0; mat < 2; ++mat)
#pragma unroll
        for (int j = 0; j < 2; ++j) acc[mat][mt][j] = mfma16(af, bfr[mat][j][s], acc[mat][mt][j]);
    }
  float* PCp = p.au + (size_t)(dir * 2 + 0) * MT * 256;
  float* HLp = p.au + (size_t)(dir * 2 + 1) * MT * 256;
#pragma unroll
  for (int j = 0; j < 2; ++j) {
    const int ch = half * 32 + j * 16 + c15, Cg = blk * 64 + ch, pidx = (l * 2 + dir) * 256 + Cg;
    const float ba = p.lru_ba[pidx], bx = p.lru_bx[pidx], lam = p.lru_lam[pidx];
    const float xn = -lam;
    const float sp = fmaxf(xn, 0.f) + log1pf(expf(-fabsf(xn)));
    const float cdec = -8.f * sp;
    float a[4][4], u[4][4];
#pragma unroll
    for (int mt = 0; mt < 4; ++mt)
#pragma unroll
      for (int r = 0; r < 4; ++r) {
        const int t = mt * 16 + q * 4 + r;
        const float rg = sigmoidf_(acc[0][mt][j][r] + ba), ig = sigmoidf_(acc[1][mt][j][r] + bx);
        const float la = cdec * rg;
        a[mt][r] = __expf(la);
        u[mt][r] = sqrtf(-expm1f(2.f * la)) * ig * xcf[t * 64 + ch];
      }
    if (dir == 0) tile_scan<false>(a, u, lane); else tile_scan<true>(a, u, lane);
#pragma unroll
    for (int mt = 0; mt < 4; ++mt)
#pragma unroll
      for (int r = 0; r < 4; ++r) {
        const size_t m = m0 + mt * 16 + q * 4 + r;
        PCp[m * 256 + Cg] = a[mt][r]; HLp[m * 256 + Cg] = u[mt][r];
      }
  }
  __syncthreads();
}

DEV void attn_item(const Params& p, int l, int it, char* sm) {
  const int tid = threadIdx.x, lane = tid & 63, w = tid >> 6, q = lane >> 4, c15 = lane & 15;
  int h, ms, nkt, T; const bf16_t* Kg; const bf16_t* Vg;
  if (it < 512) {
    const int b = it >> 6, qb = it & 7; h = (it >> 3) & 7; ms = 8192 + b * 1024 + qb * 128; nkt = 10; T = 1280;
    Kg = p.kb_lat + (size_t)((l * 8 + b) * 2 + (h >> 2)) * 1280 * 64; Vg = p.vt_lat + (size_t)((l * 8 + b) * 2 + (h >> 2)) * 64 * 1280;
  } else {
    const int i2 = it - 512, b = i2 >> 4, qb = i2 & 1; h = (i2 >> 1) & 7; ms = b * 256 + qb * 128; nkt = 2; T = 256;
    Kg = p.kb_ctx + (size_t)(b * 2 + (h >> 2)) * 256 * 64; Vg = p.vt_ctx + (size_t)(b * 2 + (h >> 2)) * 64 * 256;
  }
  bf16_t* Pw = (bf16_t*)(sm + 73728) + w * 16 * 136;
  const int kc0 = tid, kc1 = tid + 512;
  const int vd0 = tid >> 4, vk = (tid & 15) * 8;
  const bf16_t* vg0 = Vg + (size_t)vd0 * T + vk;
  const bf16_t* vg1 = Vg + (size_t)(vd0 + 32) * T + vk;
  uint4 rk0, rk1, rv0, rv1;
#define ATT_LOAD(kt) do { rk0 = *(const uint4*)(Kg + (size_t)(kt) * 8192 + kc0 * 8); rk1 = *(const uint4*)(Kg + (size_t)(kt) * 8192 + kc1 * 8); \
    rv0 = *(const uint4*)(vg0 + (kt) * 128); rv1 = *(const uint4*)(vg1 + (kt) * 128); } while (0)
#define ATT_STORE(buf) do { bf16_t* Ks_ = (bf16_t*)(sm + (buf) * 36864); bf16_t* Vs_ = Ks_ + 9216; \
    *(uint4*)(Ks_ + (kc0 >> 3) * 72 + (kc0 & 7) * 8) = rk0; *(uint4*)(Ks_ + (kc1 >> 3) * 72 + (kc1 & 7) * 8) = rk1; \
    *(uint4*)(Vs_ + vd0 * 136 + vk) = rv0; *(uint4*)(Vs_ + (vd0 + 32) * 136 + vk) = rv1; } while (0)
  ATT_LOAD(0);
  const int mq = ms + w * 16;
  bf16x8 qf[2];
#pragma unroll
  for (int s = 0; s < 2; ++s) qf[s] = *(const bf16x8*)(p.zf + (size_t)(mq + c15) * 1792 + h * 64 + s * 32 + q * 8);
  ATT_STORE(0);
  if (nkt > 1) ATT_LOAD(1);
  __syncthreads();
  f32x4 o[4];
  float mrow[4], lrow[4];
#pragma unroll
  for (int j = 0; j < 4; ++j) { o[j] = f32x4{0.f, 0.f, 0.f, 0.f}; mrow[j] = -1e30f; lrow[j] = 0.f; }
  for (int kt = 0; kt < nkt; ++kt) {
    const int cur = kt & 1;
    const bf16_t* Ks = (const bf16_t*)(sm + cur * 36864);
    const bf16_t* Vs = Ks + 9216;
    f32x4 s4[8];
#pragma unroll
    for (int jn = 0; jn < 8; ++jn) {
      s4[jn] = f32x4{0.f, 0.f, 0.f, 0.f};
#pragma unroll
      for (int s = 0; s < 2; ++s) {
        const bf16x8 kb = *(const bf16x8*)(Ks + (jn * 16 + c15) * 72 + s * 32 + q * 8);
        s4[jn] = mfma16(qf[s], kb, s4[jn]);
      }
    }
#pragma unroll
    for (int r = 0; r < 4; ++r) {
      float mx = fmaxf(fmaxf(fmaxf(s4[0][r], s4[1][r]), fmaxf(s4[2][r], s4[3][r])), fmaxf(fmaxf(s4[4][r], s4[5][r]), fmaxf(s4[6][r], s4[7][r])));
      mx = fmaxf(mx, __shfl_xor(mx, 1)); mx = fmaxf(mx, __shfl_xor(mx, 2)); mx = fmaxf(mx, __shfl_xor(mx, 4)); mx = fmaxf(mx, __shfl_xor(mx, 8));
      const float mnew = fmaxf(mrow[r], mx);
      const float alpha = __builtin_amdgcn_exp2f(mrow[r] - mnew);
      mrow[r] = mnew;
      float ls = lrow[r] * alpha;
#pragma unroll
      for (int jn = 0; jn < 4; ++jn) o[jn][r] *= alpha;
#pragma unroll
      for (int jn = 0; jn < 8; jn += 2) {
        const float p0 = __builtin_amdgcn_exp2f(s4[jn][r] - mnew), p1 = __builtin_amdgcn_exp2f(s4[jn + 1][r] - mnew);
        ls += p0 + p1;
        const unsigned pk = pack2(p0, p1);
        Pw[(q * 4 + r) * 136 + jn * 16 + c15] = (bf16_t)(pk & 0xffffu);
        Pw[(q * 4 + r) * 136 + (jn + 1) * 16 + c15] = (bf16_t)(pk >> 16);
      }
      lrow[r] = ls;
    }
    __builtin_amdgcn_wave_barrier();
    bf16x8 pf[4];
#pragma unroll
    for (int s = 0; s < 4; ++s) pf[s] = *(const bf16x8*)(Pw + c15 * 136 + s * 32 + q * 8);
#pragma unroll
    for (int jn = 0; jn < 4; ++jn)
#pragma unroll
      for (int s = 0; s < 4; ++s) {
        const bf16x8 vb = *(const bf16x8*)(Vs + (jn * 16 + c15) * 136 + s * 32 + q * 8);
        o[jn] = mfma16(pf[s], vb, o[jn]);
      }
    if (kt + 1 < nkt) {
      ATT_STORE(cur ^ 1);
      if (kt + 2 < nkt) ATT_LOAD(kt + 2);
    }
    __syncthreads();
  }
#undef ATT_LOAD
#undef ATT_STORE
#pragma unroll
  for (int r = 0; r < 4; ++r) {
    float lt = lrow[r];
    lt += __shfl_xor(lt, 1); lt += __shfl_xor(lt, 2); lt += __shfl_xor(lt, 4); lt += __shfl_xor(lt, 8);
    const float inv = 1.f / lt;
    const size_t m = mq + q * 4 + r;
#pragma unroll
    for (int jn = 0; jn < 4; ++jn) p.abuf[m * 1024 + h * 64 + jn * 16 + c15] = f2bf(o[jn][r] * inv);
  }
}

DEV void gmlp_item(const Params& p, int l, int it, char* smem) {
  const int tid = VTID, lane = tid & 63, w = tid >> 6, q = lane >> 4, c15 = lane & 15;
  const int chunk = it >> 2, g = it & 3, m0 = chunk * 128;
  bf16_t* vt = (bf16_t*)smem;
#pragma unroll
  for (int i = 0; i < 4; ++i) {
    const int id = tid + 256 * i, qq = id >> 3, cc = id & 7;
    U8 v; v.u = *(const uint4*)(p.zf + (size_t)(m0 + qq) * 1792 + 1536 + g * 64 + cc * 8);
#pragma unroll
    for (int j = 0; j < 8; ++j) vt[(cc * 8 + j) * 136 + qq] = v.h[j];
  }
  __syncthreads();
  f32x4 acc[2][4];
#pragma unroll
  for (int i = 0; i < 2; ++i)
#pragma unroll
    for (int jn = 0; jn < 4; ++jn) acc[i][jn] = f32x4{0.f, 0.f, 0.f, 0.f};
  const float* wsg = p.mlp_ws + (size_t)(l * 4 + g) * 16384;
#pragma unroll
  for (int s = 0; s < 4; ++s) {
    U8 af[2];
#pragma unroll
    for (int i = 0; i < 2; ++i) {
      const float* ap = wsg + (w * 32 + i * 16 + c15) * 128 + s * 32 + q * 8;
      const float4 a0 = *(const float4*)ap, a1 = *(const float4*)(ap + 4);
      af[i].w[0] = pack2(a0.x, a0.y); af[i].w[1] = pack2(a0.z, a0.w); af[i].w[2] = pack2(a1.x, a1.y); af[i].w[3] = pack2(a1.z, a1.w);
    }
#pragma unroll
    for (int jn = 0; jn < 4; ++jn) {
      const bf16x8 bb = *(const bf16x8*)(vt + (jn * 16 + c15) * 136 + s * 32 + q * 8);
#pragma unroll
      for (int i = 0; i < 2; ++i) acc[i][jn] = mfma16(af[i].v, bb, acc[i][jn]);
    }
  }
#pragma unroll
  for (int i = 0; i < 2; ++i)
#pragma unroll
    for (int r = 0; r < 4; ++r) {
      const int pp = w * 32 + i * 16 + q * 4 + r;
      const size_t m = m0 + pp;
      const float bsv = p.mlp_bs[(l * 4 + g) * 128 + pp];
#pragma unroll
      for (int jn = 0; jn < 4; ++jn) {
        const int c = jn * 16 + c15;
        const float uu = bf2f(p.zf[m * 1792 + 1280 + g * 64 + c]);
        p.abuf[m * 1024 + 768 + g * 64 + c] = f2bf(uu * (acc[i][jn][r] + bsv));
      }
    }
  __syncthreads();
}

DEV void lru_apply_item(const Params& p, int l, int ti) {
  const int C = VTID;
  const int m0 = ti * 64;
  int ms, L, b; bool lat = m0 >= 8192;
  if (!lat) { ms = m0 & ~255; L = 256; b = m0 >> 8; } else { ms = 8192 + ((m0 - 8192) & ~1023); L = 1024; b = (m0 - 8192) >> 10; }
  const int k = (m0 - ms) >> 6, nt = L >> 6;
  const float* PCf = p.au; const float* HLf = p.au + (size_t)MT * 256;
  const float* PCb = p.au + (size_t)2 * MT * 256; const float* HLb = p.au + (size_t)3 * MT * 256;
  float cf = lat ? p.state_lru[((size_t)(b * 2 + l) * 2 + 0) * 256 + C] : 0.f;
  float cb = lat ? p.state_lru[((size_t)(b * 2 + l) * 2 + 1) * 256 + C] : 0.f;
  {
    float pc[15], hl[15];
#pragma unroll
    for (int i = 0; i < 15; ++i) {
      const bool act = i < k;
      const size_t e = (size_t)(ms + 64 * i + 63) * 256 + C;
      pc[i] = act ? PCf[e] : 1.f; hl[i] = act ? HLf[e] : 0.f;
    }
#pragma unroll
    for (int i = 0; i < 15; ++i) cf = pc[i] * cf + hl[i];
  }
  {
    float pc[15], hl[15];
#pragma unroll
    for (int i = 0; i < 15; ++i) {
      const int tix = nt - 1 - i;
      const bool act = tix > k;
      const size_t e = (size_t)(ms + 64 * tix) * 256 + C;
      pc[i] = act ? PCb[e] : 1.f; hl[i] = act ? HLb[e] : 0.f;
    }
#pragma unroll
    for (int i = 0; i < 15; ++i) cb = pc[i] * cb + hl[i];
  }
  float hf_last = 0.f, hb_first = 0.f;
#pragma unroll 8
  for (int t = 0; t < 64; ++t) {
    const size_t m = m0 + t;
    const float hf = PCf[m * 256 + C] * cf + HLf[m * 256 + C];
    const float hb = PCb[m * 256 + C] * cb + HLb[m * 256 + C];
    const float g = bf2f(p.zf[m * 1792 + 1024 + C]);
    p.abuf[m * 1024 + 512 + C] = f2bf((hf + hb) * g);
    if (t == 0) hb_first = hb;
    if (t == 63) hf_last = hf;
  }
  if (!lat) {
    if (k == nt - 1) p.out[OFF_ST + ((size_t)(b * 2 + l) * 2 + 0) * 256 + C] = hf_last;
    if (k == 0) p.out[OFF_ST + ((size_t)(b * 2 + l) * 2 + 1) * 256 + C] = hb_first;
  }
}

DEV void mixer_phase(const Params& p, int l, char* smem_raw, char* smem) {
  for (int it = blockIdx.x; it < 1024; it += gridDim.x) attn_item(p, l, it, smem_raw);
  const int NITEMS = 256 + 512;
  for (int it = VBID; it < NITEMS; it += VNB) {
    if (it < 256) lru_apply_item(p, l, it);
    else gmlp_item(p, l, it - 256, smem);
  }
}

DEV void prep_phase_full(const Params& p, int l, char* smem) {
  const int NITEMS = 1024 + 4096;
  for (int it = VBID; it < NITEMS; it += VNB) {
    if (it < 1024) lru_gate_item(p, l, it, smem);
    else prep_token_row(p, l, (it - 1024) * 4 + (VTID >> 6), VTID & 63);
  }
}


#define XB_TMO      128
#define XB_XCNT(j)  (256  + 64 * (j))
#define XB_XSUB(j)  (1280 + 64 * (j))
#define XB_XGEN(j)  (2304 + 64 * (j))
#define XB_TOP      3328
#define XB_TOPGEN   3392
#define XCD_BAR_WORDS 3456
#define XB_SPIN_CAP (1u << 18)
#define LAS __attribute__((address_space(3)))
DEV unsigned xb_ld(unsigned* p) { return __hip_atomic_load(p, __ATOMIC_RELAXED, __HIP_MEMORY_SCOPE_AGENT); }
DEV unsigned xb_add(unsigned* p, unsigned v) { return __hip_atomic_fetch_add(p, v, __ATOMIC_RELAXED, __HIP_MEMORY_SCOPE_AGENT); }
DEV unsigned xb_xcc_id() { return (unsigned)__builtin_amdgcn_s_getreg((3 << 11) | 20) & 0xFu; }
#define XB_SPIN(cond, bar) do { unsigned _sp = 0; while (cond) { __builtin_amdgcn_s_sleep(1); \
    if ((++_sp & 255u) == 0u) { if (xb_ld(&(bar)[XB_TMO])) break; if (_sp > XB_SPIN_CAP) { atomicAdd(&(bar)[XB_TMO], 1u); break; } } } } while (0)
struct XcdBarrier { unsigned* bar; unsigned x; volatile LAS unsigned* st; };
DEV XcdBarrier xcd_barrier_post(unsigned* bar, volatile LAS unsigned* st) {
  XcdBarrier b; b.bar = bar; b.x = xb_xcc_id(); b.st = st;
  if (threadIdx.x == 0) (void)xb_add(&bar[XB_XCNT(b.x)], 1u);
  return b;
}
DEV void xcd_barrier_complete(unsigned* bar, unsigned x, unsigned& nloc, unsigned& nx) {
  const unsigned G = gridDim.x * gridDim.y * gridDim.z;
  unsigned sum, cnt, mine, sp = 0u;
  for (;;) {
    sum = 0u; cnt = 0u; mine = 0u;
#pragma unroll
    for (unsigned j = 0; j < 16; ++j) { const unsigned c = xb_ld(&bar[XB_XCNT(j)]); sum += c; cnt += (c > 0u) ? 1u : 0u; mine = (j == x) ? c : mine; }
    if (sum == G) break;
    __builtin_amdgcn_s_sleep(1);
    if ((++sp & 255u) == 0u) { if (xb_ld(&bar[XB_TMO])) break; if (sp > XB_SPIN_CAP) { atomicAdd(&bar[XB_TMO], 1u); break; } }
  }
  nloc = mine > 0u ? mine : 1u; nx = cnt > 0u ? cnt : 1u;
}
DEV void xcd_barrier(const XcdBarrier& b) {
  asm volatile("s_waitcnt vmcnt(0)" ::: "memory");
  __syncthreads();
  if (threadIdx.x == 0) {
    unsigned* bar = b.bar;
    __builtin_amdgcn_s_waitcnt(0);
    unsigned nloc = b.st[0], nx = b.st[1];
    if (nloc == 0u) { xcd_barrier_complete(bar, b.x, nloc, nx); b.st[0] = nloc; b.st[1] = nx; }
    const unsigned old = xb_add(&bar[XB_XSUB(b.x)], 1u);
    const unsigned gen = old / nloc;
    if (old + 1u == (gen + 1u) * nloc) {
      __builtin_amdgcn_fence(__ATOMIC_RELEASE, "agent");
      asm volatile("s_waitcnt vmcnt(0)" ::: "memory");
      const unsigned og = xb_add(&bar[XB_TOP], 1u);
      const unsigned tg = og / nx;
      if (og + 1u == (tg + 1u) * nx) xb_add(&bar[XB_TOPGEN], 1u);
      else XB_SPIN(xb_ld(&bar[XB_TOPGEN]) == tg, bar);
      __builtin_amdgcn_fence(__ATOMIC_ACQUIRE, "agent");
      xb_add(&bar[XB_XGEN(b.x)], 1u);
      asm volatile("s_waitcnt vmcnt(0)" ::: "memory");
    } else {
      XB_SPIN(xb_ld(&bar[XB_XGEN(b.x)]) == gen, bar);
      __builtin_amdgcn_fence(__ATOMIC_ACQUIRE, "agent");
      asm volatile("s_waitcnt vmcnt(0)" ::: "memory");
    }
  }
  __syncthreads();
}

#define PH(i, call) if (ph_lo <= (i) && (i) < ph_hi) { if ((i) > ph_lo) xcd_barrier(xb); call; }
#define LAYER(l, b) \
  PH(b + 0, ln_mod_phase(p, l, l == 0 ? 0 : 1)) \
  PH(b + 1, gemm_phase<1>(p, l, p.abuf, p.wt_in + (size_t)l * 1792 * 1024, 1792, 1024, (LAS3 unsigned char*)smem_raw)) \
  PH(b + 2, prep_phase_full(p, l, smem)) \
  PH(b + 3, mixer_phase(p, l, smem_raw, smem)) \
  PH(b + 4, gemm_phase<2>(p, l, p.abuf, p.wt_out + (size_t)l * 1024 * 1024, 1024, 1024, (LAS3 unsigned char*)smem_raw)) \
  PH(b + 5, ln_mod_phase(p, l, 2)) \
  PH(b + 6, gemm_phase<3>(p, l, p.abuf, p.wt_ff1 + (size_t)l * 4096 * 1024, 4096, 1024, (LAS3 unsigned char*)smem_raw)) \
  PH(b + 7, gemm_phase<4>(p, l, p.zf, p.wt_ff2 + (size_t)l * 1024 * 4096, 1024, 4096, (LAS3 unsigned char*)smem_raw))

__global__ void __launch_bounds__(512, 2) mega_kernel(Params p, int ph_lo, int ph_hi) {
  extern __shared__ __attribute__((aligned(16))) char smem_raw[];
  char* smem = smem_raw + (threadIdx.x >> 8) * 65536;
  __shared__ uint4 xb_words;
  if (threadIdx.x == 0) xb_words = make_uint4(0u, 0u, 0u, 0u);
  __syncthreads();
  XcdBarrier xb = xcd_barrier_post(p.bar, (volatile LAS unsigned*)&xb_words);
  if (ph_hi > 1000) { cg::grid_group grid = cg::this_grid(); grid.sync(); }
  PH(0, phase0(p, smem))
  LAYER(0, 1)
  LAYER(1, 9)
  PH(17, ln_mod_phase(p, 1, 3))
}

extern "C" void kernel_launch(void* const* d_in, const int* in_sizes, int n_in, void* d_out, int out_size, void* d_ws, size_t ws_size,
                              hipStream_t stream) {
  static int grid_blocks = 0;
  if (!grid_blocks) {
    int dev = 0, cus = 0, per_cu = 0;
    hipGetDevice(&dev);
    hipDeviceGetAttribute(&cus, hipDeviceAttributeMultiprocessorCount, dev);
    hipFuncSetAttribute((const void*)mega_kernel, hipFuncAttributeMaxDynamicSharedMemorySize, SMEM_BYTES);
    hipOccupancyMaxActiveBlocksPerMultiprocessor(&per_cu, (const void*)mega_kernel, 512, SMEM_BYTES);
    if (per_cu < 1) per_cu = 1;
    if (per_cu > 1) per_cu = 1;
    grid_blocks = cus * per_cu;
  }
  Params p{};
  const float** pin = (const float**)&p;
  for (int i = 0; i < 32; ++i) pin[i] = (const float*)d_in[i];
  p.out = (float*)d_out;
  char* ws = (char*)d_ws;
  size_t off = 0;
  p.bar = (unsigned*)(ws + off); off += 16384;
  p.kb_lat = (bf16_t*)(ws + off); off += (size_t)2 * 8 * 2 * 1280 * 64 * 2;
  p.vt_lat = (bf16_t*)(ws + off); off += (size_t)2 * 8 * 2 * 1280 * 64 * 2;
  p.kb_ctx = (bf16_t*)(ws + off); off += (size_t)32 * 2 * 256 * 64 * 2;
  p.vt_ctx = (bf16_t*)(ws + off); off += (size_t)32 * 2 * 256 * 64 * 2;
  p.wt_in = (bf16_t*)(ws + off); off += (size_t)2 * 1792 * 1024 * 2;
  p.wt_out = (bf16_t*)(ws + off); off += (size_t)2 * 1024 * 1024 * 2;
  p.wt_ff1 = (bf16_t*)(ws + off); off += (size_t)2 * 4096 * 1024 * 2;
  p.wt_ff2 = (bf16_t*)(ws + off); off += (size_t)2 * 4096 * 1024 * 2;
  p.wt_lru = (bf16_t*)(ws + off); off += (size_t)64 * 4096 * 2;
  p.mod = (float*)(ws + off); off += (size_t)2 * 9 * 6144 * 4;
  p.rope = (float*)(ws + off); off += (size_t)2048 * 4;
  p.abuf = (bf16_t*)(ws + off); off += (size_t)MT * 1024 * 2;
  p.zf = (bf16_t*)(ws + off);
  p.au = (float*)(ws + off + (size_t)MT * 1792 * 2);
  off += (size_t)MT * 4096 * 2;
  if (off > ws_size) { fprintf(stderr, "workspace too small: need %zu have %zu\n", off, ws_size); return; }
  (void)hipMemsetAsync(p.bar, 0, XCD_BAR_WORDS * 4, stream);
#if MULTI_LAUNCH
  for (int ph = 0; ph < NPHASE; ++ph) {
    hipLaunchKernelGGL(mega_kernel, dim3(grid_blocks), dim3(512), SMEM_BYTES, stream, p, ph, ph + 1);
  }
#else
  int lo = 0, hi = NPHASE;
  void* args[] = {&p, &lo, &hi};
  hipError_t e = hipLaunchCooperativeKernel((void*)mega_kernel, dim3(grid_blocks), dim3(512), args, SMEM_BYTES, stream);
  if (e != hipSuccess) fprintf(stderr, "cooperative launch failed: %s (grid %d)\n", hipGetErrorString(e), grid_blocks);
#endif
}
```

```cpp
#include <hip/hip_runtime.h>
#include <hip/hip_cooperative_groups.h>
#include <cstdio>
#include <cstdint>
namespace cg = cooperative_groups;

#ifndef MULTI_LAUNCH
#define MULTI_LAUNCH 0
#endif

typedef unsigned short bf16_t;
using bf16x8 = __attribute__((ext_vector_type(8))) short;
using f32x4 = __attribute__((ext_vector_type(4))) float;
#define DEV __device__ __forceinline__
#define VTID ((int)(threadIdx.x & 255))
#define VBID ((int)(blockIdx.x * 2 + (threadIdx.x >> 8)))
#define VNB ((int)(gridDim.x * 2))

constexpr int MT = 16384;
constexpr int NPHASE = 18;
constexpr size_t OFF_YK = 16777216, OFF_YV = OFF_YK + 2097152, OFF_ST = OFF_YV + 2097152;
constexpr float ALPHA = 1.41421356237f;
constexpr float QSCALE = 0.125f * 1.4426950408889634f;
constexpr int SMEM_BYTES = 131072;

struct Params {
  const float *x_prompt, *x_sample, *c, *cache_k, *cache_v, *state_lru, *c_ctx, *w_ada, *b_ada, *w_in,
      *q_g, *k_g, *conv_w, *conv_b, *lru_wa, *lru_ba, *lru_wx, *lru_bx, *lru_lam, *mlp_g, *mlp_b, *mlp_ws, *mlp_bs,
      *w_out, *ln1_g, *ln1_b, *w_ff1, *b_ff1, *w_ff2, *b_ff2, *ln2_g, *ln2_b;
  float* out;
  bf16_t *wt_in, *wt_out, *wt_ff1, *wt_ff2, *wt_lru;
  float *mod, *rope;
  bf16_t *abuf;
  bf16_t *zf;
  float *au;
  bf16_t *kb_lat, *vt_lat;
  bf16_t *kb_ctx, *vt_ctx;
  unsigned *bar;
};

union U8 { uint4 u; bf16x8 v; bf16_t h[8]; unsigned w[4]; };

DEV float bf2f(bf16_t h) { return __uint_as_float(((unsigned)h) << 16); }
DEV bf16_t f2bf(float f) { unsigned u = __float_as_uint(f); u += 0x7fffu + ((u >> 16) & 1u); return (bf16_t)(u >> 16); }
DEV unsigned pack2(float a, float b) { unsigned r; asm volatile("v_cvt_pk_bf16_f32 %0, %1, %2" : "=v"(r) : "v"(a), "v"(b)); return r; }
DEV float gelu_t(float x) { float y = 0.7978845608028654f * (x + 0.044715f * x * x * x); float t = 1.f - 2.f * __builtin_amdgcn_rcpf(1.f + __expf(2.f * y)); return 0.5f * x * (1.f + t); }
DEV float sigmoidf_(float x) { return __builtin_amdgcn_rcpf(1.f + __expf(-x)); }
DEV int cond_of(int m) { return m < 8192 ? 0 : 1 + ((m - 8192) >> 10); }
DEV f32x4 mfma16(bf16x8 a, bf16x8 b, f32x4 c) { return __builtin_amdgcn_mfma_f32_16x16x32_bf16(a, b, c, 0, 0, 0); }
DEV float wave_sum(float v) {
#pragma unroll
  for (int o = 32; o >= 1; o >>= 1) v += __shfl_xor(v, o);
  return v;
}

DEV void transpose_tile(const float* __restrict__ src, bf16_t* __restrict__ dst, int lds_, int ldd, char* smem) {
  float* T = (float*)smem;
  const int tid = VTID;
#pragma unroll
  for (int i = 0; i < 4; ++i) {
    int k = (tid >> 4) + 16 * i, n4 = (tid & 15) * 4;
    float4 v = *(const float4*)(src + (size_t)k * lds_ + n4);
    T[k * 65 + n4 + 0] = v.x; T[k * 65 + n4 + 1] = v.y; T[k * 65 + n4 + 2] = v.z; T[k * 65 + n4 + 3] = v.w;
  }
  __syncthreads();
#pragma unroll
  for (int i = 0; i < 2; ++i) {
    int n = (tid >> 3) + 32 * i, k8 = (tid & 7) * 8;
    U8 o;
#pragma unroll
    for (int j = 0; j < 4; ++j) o.w[j] = pack2(T[(k8 + 2 * j) * 65 + n], T[(k8 + 2 * j + 1) * 65 + n]);
    *(uint4*)(dst + (size_t)n * ldd + k8) = o.u;
  }
  __syncthreads();
}
DEV void transpose_w(const float* __restrict__ W, bf16_t* __restrict__ Wt, int K, int N, int tk, int tn, char* smem) {
  transpose_tile(W + (size_t)(tk * 64) * N + tn * 64, Wt + (size_t)(tn * 64) * K + tk * 64, N, K, smem);
}

DEV void phase0(const Params& p, char* smem) {
  const int tid = VTID;
  const int NT0 = 192 + 2 * 2768, NITEMS = NT0 + 128 + 64 + 2;
  for (int it = VBID; it < NITEMS; it += VNB) {
    if (it < 192) {
      const int l = it / 96, n0 = (it % 96) * 64;
      float* s = (float*)smem;
      float* red = s + 9 * 1024;
      for (int idx = tid; idx < 9 * 1024; idx += 256) {
        int c = idx >> 10, k = idx & 1023;
        float v = (c == 0) ? p.c_ctx[k] : p.c[(c - 1) * 1024 + k];
        s[idx] = v / (1.f + __expf(-v));
      }
      __syncthreads();
      const int w = tid >> 6, lane = tid & 63, cq = lane & 15, ks = lane >> 4;
      const int kbase = (w * 4 + ks) * 64;
      float acc[9][4];
#pragma unroll
      for (int c = 0; c < 9; ++c) { acc[c][0] = 0.f; acc[c][1] = 0.f; acc[c][2] = 0.f; acc[c][3] = 0.f; }
      const float* wp = p.w_ada + ((size_t)l * 1024 + kbase) * 6144 + n0 + cq * 4;
      for (int kb = 0; kb < 64; kb += 16) {
        float4 wv[16];
#pragma unroll
        for (int j = 0; j < 16; ++j) wv[j] = *(const float4*)(wp + (size_t)(kb + j) * 6144);
#pragma unroll
        for (int j = 0; j < 16; ++j)
#pragma unroll
          for (int c = 0; c < 9; ++c) {
            const float sv = s[c * 1024 + kbase + kb + j];
            acc[c][0] += sv * wv[j].x; acc[c][1] += sv * wv[j].y; acc[c][2] += sv * wv[j].z; acc[c][3] += sv * wv[j].w;
          }
      }
#pragma unroll
      for (int c = 0; c < 9; ++c)
#pragma unroll
        for (int e = 0; e < 4; ++e) {
          float a = acc[c][e];
          a += __shfl_xor(a, 16); a += __shfl_xor(a, 32);
          if (ks == 0) red[(w * 9 + c) * 64 + cq * 4 + e] = a;
        }
      __syncthreads();
      for (int idx = tid; idx < 576; idx += 256) {
        int c = idx >> 6, nn = idx & 63;
        float v = red[(0 * 9 + c) * 64 + nn] + red[(1 * 9 + c) * 64 + nn] + red[(2 * 9 + c) * 64 + nn] + red[(3 * 9 + c) * 64 + nn] +
                  p.b_ada[l * 6144 + n0 + nn];
        p.mod[((size_t)l * 9 + c) * 6144 + n0 + nn] = v;
      }
      __syncthreads();
    } else if (it >= NT0 && it < NT0 + 128) {
      const int j = it - NT0, tt = j & 3, kvh = (j >> 2) & 1, l = (j >> 3) & 1, b = j >> 4;
      transpose_tile(p.cache_v + ((size_t)(b * 2 + l) * 256 + tt * 64) * 128 + kvh * 64, p.vt_lat + ((size_t)((l * 8 + b) * 2 + kvh) * 64) * 1280 + tt * 64, 128, 1280, smem);
    } else if (it >= NT0 + 128 && it < NT0 + 192) {
      const int j = it - NT0 - 128;
#pragma unroll
      for (int i = 0; i < 4; ++i) {
        const int e = (j * 1024 + i * 256 + tid) * 8;
        const int d = e & 63, kvh = (e >> 6) & 1, t = (e >> 7) & 255, l = (e >> 15) & 1, b = e >> 16;
        const float4 a0 = *(const float4*)(p.cache_k + e), a1 = *(const float4*)(p.cache_k + e + 4);
        U8 o; o.w[0] = pack2(a0.x, a0.y); o.w[1] = pack2(a0.z, a0.w); o.w[2] = pack2(a1.x, a1.y); o.w[3] = pack2(a1.z, a1.w);
        *(uint4*)(p.kb_lat + ((size_t)((l * 8 + b) * 2 + kvh) * 1280 + t) * 64 + d) = o.u;
      }
    } else if (it >= NT0 + 192) {
      if (it == NT0 + 192)
      for (int idx = tid; idx < 1024; idx += 256) {
        int pp = idx >> 4, f = idx & 15;
        float inv = powf(10000.f, -(float)f / 16.f);
        float ang = (float)pp * inv;
        float nrev = rintf(ang * 0.15915494309189535f);
        float r = fmaf(-nrev, 6.28125f, ang);
        r = fmaf(-nrev, 0.0019353071795864769f, r);
        p.rope[idx * 2 + 0] = __cosf(r);
        p.rope[idx * 2 + 1] = __sinf(r);
      }
    } else {
      int t = it - 192;
      const int l = t / 2768, r = t % 2768;
      if (r < 448) transpose_w(p.w_in + (size_t)l * 1024 * 1792, p.wt_in + (size_t)l * 1792 * 1024, 1024, 1792, r / 28, r % 28, smem);
      else if (r < 704) { int i = r - 448; transpose_w(p.w_out + (size_t)l * 1024 * 1024, p.wt_out + (size_t)l * 1024 * 1024, 1024, 1024, i / 16, i % 16, smem); }
      else if (r < 1728) { int i = r - 704; transpose_w(p.w_ff1 + (size_t)l * 1024 * 4096, p.wt_ff1 + (size_t)l * 4096 * 1024, 1024, 4096, i / 64, i % 64, smem); }
      else if (r < 2752) { int i = r - 1728; transpose_w(p.w_ff2 + (size_t)l * 4096 * 1024, p.wt_ff2 + (size_t)l * 1024 * 4096, 4096, 1024, i / 16, i % 16, smem); }
      else {
        int idx = r - 2752;
        int dir = idx >> 3, blk = (idx >> 1) & 3, mat = idx & 1;
        const float* src = (mat == 0 ? p.lru_wa : p.lru_wx) + (size_t)(((l * 2 + dir) * 4 + blk)) * 4096;
        bf16_t* dst = p.wt_lru + (size_t)((((l * 2 + dir) * 4 + blk) * 2 + mat)) * 4096;
        transpose_tile(src, dst, 64, 64, smem);
      }
    }
  }
}

DEV void ln_mod_phase(const Params& p, int l, int mode) {
  const int lane = threadIdx.x & 63, w = threadIdx.x >> 6;
  const float* lg = nullptr; const float* lb = nullptr;
  if (mode == 1) { lg = p.ln2_g + (l - 1) * 1024; lb = p.ln2_b + (l - 1) * 1024; }
  else if (mode == 2) { lg = p.ln1_g + l * 1024; lb = p.ln1_b + l * 1024; }
  else if (mode == 3) { lg = p.ln2_g + l * 1024; lb = p.ln2_b + l * 1024; }
  const int shoff = (mode == 2) ? 3072 : 0;
  const int mstride = gridDim.x * 8;
  float4 nv[4];
  {
    const int m = blockIdx.x * 8 + w;
    const float* src = (mode == 0) ? ((m < 8192) ? p.x_prompt + (size_t)m * 1024 : p.x_sample + (size_t)(m - 8192) * 1024) : p.out + (size_t)m * 1024;
#pragma unroll
    for (int i = 0; i < 4; ++i) nv[i] = *(const float4*)(src + i * 256 + lane * 4);
  }
  for (int m = blockIdx.x * 8 + w; m < MT; m += mstride) {
    float4 v[4];
#pragma unroll
    for (int i = 0; i < 4; ++i) v[i] = nv[i];
    {
      const int mn = (m + mstride < MT) ? m + mstride : m;
      const float* src = (mode == 0) ? ((mn < 8192) ? p.x_prompt + (size_t)mn * 1024 : p.x_sample + (size_t)(mn - 8192) * 1024) : p.out + (size_t)mn * 1024;
#pragma unroll
      for (int i = 0; i < 4; ++i) nv[i] = *(const float4*)(src + i * 256 + lane * 4);
    }
    if (mode != 0) {
      float s = 0.f;
#pragma unroll
      for (int i = 0; i < 4; ++i) s += v[i].x + v[i].y + v[i].z + v[i].w;
      const float mean = wave_sum(s) * (1.f / 1024.f);
      float s2 = 0.f;
#pragma unroll
      for (int i = 0; i < 4; ++i) { float a = v[i].x - mean, b = v[i].y - mean, c = v[i].z - mean, d = v[i].w - mean; s2 += a * a + b * b + c * c + d * d; }
      const float rstd = rsqrtf(wave_sum(s2) * (1.f / 1024.f) + 1e-6f);
#pragma unroll
      for (int i = 0; i < 4; ++i) {
        float4 g = *(const float4*)(lg + i * 256 + lane * 4), b = *(const float4*)(lb + i * 256 + lane * 4);
        v[i].x = (v[i].x - mean) * rstd * g.x + b.x; v[i].y = (v[i].y - mean) * rstd * g.y + b.y;
        v[i].z = (v[i].z - mean) * rstd * g.z + b.z; v[i].w = (v[i].w - mean) * rstd * g.w + b.w;
        *(float4*)(p.out + (size_t)m * 1024 + i * 256 + lane * 4) = v[i];
      }
    }
    if (mode != 3) {
      const float* md = p.mod + ((size_t)l * 9 + cond_of(m)) * 6144 + shoff;
#pragma unroll
      for (int i = 0; i < 4; ++i) {
        float4 sh = *(const float4*)(md + i * 256 + lane * 4), sc = *(const float4*)(md + 1024 + i * 256 + lane * 4);
        uint2 o;
        o.x = pack2(v[i].x * (1.f + sc.x) + sh.x, v[i].y * (1.f + sc.y) + sh.y);
        o.y = pack2(v[i].z * (1.f + sc.z) + sh.z, v[i].w * (1.f + sc.w) + sh.w);
        *(uint2*)(p.abuf + (size_t)m * 1024 + i * 256 + lane * 4) = o;
      }
    }
  }
}

#define LAS3 __attribute__((address_space(3)))
namespace g8 {
constexpr int BM = 256, BK = 64, HALF = 128, HTB = HALF * BK * 2, NXCD = 8, WGM = 8;
DEV int lds_byte(int r, int c) { const int st = (r >> 4) * 2 + (c >> 5), rr = r & 15, cc = c & 31, ob = rr * 64 + cc * 2; return st * 1024 + (ob ^ (((ob >> 9) & 1) << 5)); }
DEV void stage_rc(int b, int& R, int& C) { const int st = b / 1024, sb = b % 1024, swz = sb ^ (((sb >> 9) & 1) << 5); R = (st >> 1) * 16 + swz / 64; C = (st & 1) * 32 + (swz % 64) / 2; }
DEV bool unit_of(int i, int nM, int nN, int& pm, int& pn) {
  const int nwg = nM * nN;
  const long L = (long)i * gridDim.x + blockIdx.x; if (L >= nwg) return false;
  int wgid = (int)L; { const int q = nwg / NXCD, r = nwg % NXCD, xcd = wgid % NXCD, off = wgid / NXCD; wgid = (xcd < r ? xcd * (q + 1) : r * (q + 1) + (xcd - r) * q) + off; }
  const int nig = WGM * nN, gid = wgid / nig, fm = gid * WGM, gsz = (nM - fm) < WGM ? (nM - fm) : WGM;
  pm = fm + ((wgid % nig) % gsz); pn = (wgid % nig) / gsz; return true;
}
}

template <int EPI>
DEV void gemm_epilogue(const Params& p, int l, f32x4 (&acc)[2][2][4][2], int pm, int pn, int wr, int wc, int fr, int fq) {
  const int brow = pm * 256, bcol = pn * 256;
  const float* md = p.mod + ((size_t)l * 9 + cond_of(brow)) * 6144;
#pragma unroll
  for (int bj = 0; bj < 2; ++bj)
#pragma unroll
    for (int n = 0; n < 2; ++n) {
      const int col = bcol + bj * 128 + wc * 32 + n * 16 + fq * 4;
      float4 gate = make_float4(0.f, 0.f, 0.f, 0.f), bias = make_float4(0.f, 0.f, 0.f, 0.f);
      if (EPI == 2) gate = *(const float4*)(md + 2048 + col);
      if (EPI == 3) bias = *(const float4*)(p.b_ff1 + l * 4096 + col);
      if (EPI == 4) { gate = *(const float4*)(md + 5120 + col); bias = *(const float4*)(p.b_ff2 + l * 1024 + col); }
#pragma unroll
      for (int ai = 0; ai < 2; ++ai)
#pragma unroll
        for (int m = 0; m < 4; ++m) {
          const int row = brow + ai * 128 + wr * 64 + m * 16 + fr;
          const f32x4 v = acc[ai][bj][m][n];
          if (EPI == 1) {
            uint2 o; o.x = pack2(v[0], v[1]); o.y = pack2(v[2], v[3]);
            *(uint2*)(p.zf + (size_t)row * 1792 + col) = o;
          } else if (EPI == 2) {
            const float* xs = (l == 0) ? ((row < 8192) ? p.x_prompt + (size_t)row * 1024 : p.x_sample + (size_t)(row - 8192) * 1024) : p.out + (size_t)row * 1024;
            const float4 x = *(const float4*)(xs + col);
            *(float4*)(p.out + (size_t)row * 1024 + col) = make_float4(ALPHA * x.x + gate.x * v[0], ALPHA * x.y + gate.y * v[1], ALPHA * x.z + gate.z * v[2], ALPHA * x.w + gate.w * v[3]);
          } else if (EPI == 3) {
            const float t0 = fmaxf(v[0] + bias.x, 0.f), t1 = fmaxf(v[1] + bias.y, 0.f), t2 = fmaxf(v[2] + bias.z, 0.f), t3 = fmaxf(v[3] + bias.w, 0.f);
            uint2 o; o.x = pack2(t0 * t0, t1 * t1); o.y = pack2(t2 * t2, t3 * t3);
            *(uint2*)(p.zf + (size_t)row * 4096 + col) = o;
          } else {
            float* xo = p.out + (size_t)row * 1024 + col;
            const float4 x = *(const float4*)xo;
            *(float4*)xo = make_float4(ALPHA * x.x + gate.x * (v[0] + bias.x), ALPHA * x.y + gate.y * (v[1] + bias.y), ALPHA * x.z + gate.z * (v[2] + bias.z), ALPHA * x.w + gate.w * (v[3] + bias.w));
          }
        }
    }
}

template <int EPI>
DEV void gemm_phase(const Params& p, int l, const bf16_t* Ag, const bf16_t* Btg, int N, int K, LAS3 unsigned char* lds) {
  using namespace g8;
  const int tid = threadIdx.x, wid = __builtin_amdgcn_readfirstlane(tid >> 6), lane = tid & 63, wr = wid >> 2, wc = wid & 3, fr = lane & 15, fq = lane >> 4;
  const int nt = K / BK, nM = MT / BM, nN = N / BM;
  unsigned voff[2];
#pragma unroll
  for (int i = 0; i < 2; ++i) { int R, C; stage_rc(tid * 16 + i * 8192, R, C); voff[i] = (unsigned)(R * K + C) * 2u; }
  const size_t kstep = (size_t)(BK * 2);
  const size_t hstep = (size_t)HALF * K * 2;
  const size_t tstep = 2 * hstep;
  const unsigned ldsw = (unsigned)wid * 1024u;
  const int aoff = lds_byte(wr * 64 + fr, fq * 8), boff = lds_byte(wc * 32 + fr, fq * 8);
#define PG8_SA(b, h) (((b) * 2 + (h)) * HTB)
#define PG8_SB(b, h) ((4 + (b) * 2 + (h)) * HTB)
#define PG8_STAGE(bufoff, gbase) do { _Pragma("unroll") for (int _i = 0; _i < 2; ++_i) \
    __builtin_amdgcn_global_load_lds((const unsigned*)((const char*)(gbase) + voff[_i]), (LAS3 unsigned*)(lds + (bufoff) + ldsw + _i * 8192), 16, 0, 0); } while (0)
#define PG8_LDA(dst, b, h) do { _Pragma("unroll") for (int m = 0; m < 4; ++m) _Pragma("unroll") for (int k = 0; k < 2; ++k) dst[m][k] = *(const LAS3 bf16x8*)(lds + PG8_SA(b, h) + aoff + m * 2048 + k * 1024); } while (0)
#define PG8_LDB(dst, b, h) do { _Pragma("unroll") for (int n = 0; n < 2; ++n) _Pragma("unroll") for (int k = 0; k < 2; ++k) dst[n][k] = *(const LAS3 bf16x8*)(lds + PG8_SB(b, h) + boff + n * 2048 + k * 1024); } while (0)
#define PG8_MMA(ai, bj, At_, Bt_) do { __builtin_amdgcn_s_setprio(1); _Pragma("unroll") for (int m = 0; m < 4; ++m) _Pragma("unroll") for (int n = 0; n < 2; ++n) _Pragma("unroll") for (int k = 0; k < 2; ++k) \
    acc[ai][bj][m][n] = __builtin_amdgcn_mfma_f32_16x16x32_bf16(Bt_[n][k], At_[m][k], acc[ai][bj][m][n], 0, 0, 0); __builtin_amdgcn_s_setprio(0); } while (0)
#define PG8_WAIT_V(n) asm volatile("s_waitcnt vmcnt(" #n ")" ::: "memory")
#define PG8_WAIT_L(n) asm volatile("s_waitcnt lgkmcnt(" #n ")" ::: "memory")
#define PG8_BAR __builtin_amdgcn_s_barrier()
#define PG8_SCHED __builtin_amdgcn_sched_barrier(0)
  int cpm, cpn, npm = 0, npn = 0, ui = 0;
  if (!unit_of(0, nM, nN, cpm, cpn)) return;
  f32x4 acc[2][2][4][2];
#pragma unroll
  for (int a = 0; a < 2; ++a)
#pragma unroll
    for (int b = 0; b < 2; ++b)
#pragma unroll
      for (int m = 0; m < 4; ++m)
#pragma unroll
        for (int n = 0; n < 2; ++n) acc[a][b][m][n] = (f32x4){0.f, 0.f, 0.f, 0.f};
  bf16x8 At[4][2], B0[2][2], B1[2][2];
  const char* cA = (const char*)Ag + (size_t)cpm * tstep; const char* cB = (const char*)Btg + (size_t)cpn * tstep;
  PG8_STAGE(PG8_SB(0, 0), cB); PG8_STAGE(PG8_SA(0, 0), cA); PG8_STAGE(PG8_SB(0, 1), cB + hstep); PG8_STAGE(PG8_SA(0, 1), cA + hstep);
  if (wr == 1) PG8_BAR;
  PG8_WAIT_V(4); PG8_BAR;
  PG8_STAGE(PG8_SB(1, 0), cB + kstep); PG8_STAGE(PG8_SA(1, 0), cA + kstep); PG8_STAGE(PG8_SB(1, 1), cB + hstep + kstep);
  PG8_WAIT_V(6); PG8_BAR;
  for (;;) {
    const bool has_next = unit_of(ui + 1, nM, nN, npm, npn);
    const char* nA = has_next ? (const char*)Ag + (size_t)npm * tstep : cA; const char* nB = has_next ? (const char*)Btg + (size_t)npn * tstep : cB;
    for (int t = 0; t < nt; t += 2) {
      const bool last = (t == nt - 2);
      const char* a1 = cA + (size_t)(t + 1) * kstep;
      const char* a2 = last ? nA : cA + (size_t)(t + 2) * kstep; const char* b2 = last ? nB : cB + (size_t)(t + 2) * kstep;
      const char* a3 = a2 + kstep; const char* b3 = b2 + kstep;
      PG8_LDB(B0, 0, 0); PG8_SCHED; PG8_LDA(At, 0, 0); PG8_STAGE(PG8_SA(1, 1), a1 + hstep);
      PG8_WAIT_L(8); PG8_BAR; PG8_WAIT_L(0); PG8_MMA(0, 0, At, B0); PG8_BAR; PG8_SCHED;
      PG8_LDB(B1, 0, 1); PG8_STAGE(PG8_SB(0, 0), b2);
      PG8_BAR; PG8_WAIT_L(0); PG8_MMA(0, 1, At, B1); PG8_BAR;
      PG8_LDA(At, 0, 1); PG8_STAGE(PG8_SA(0, 0), a2);
      PG8_BAR; PG8_WAIT_L(0); PG8_MMA(1, 0, At, B0); PG8_BAR; PG8_SCHED;
      PG8_STAGE(PG8_SB(0, 1), b2 + hstep);
      PG8_WAIT_V(6); PG8_BAR; PG8_MMA(1, 1, At, B1); PG8_BAR;
      PG8_LDB(B0, 1, 0); PG8_SCHED; PG8_LDA(At, 1, 0); PG8_STAGE(PG8_SA(0, 1), a2 + hstep);
      PG8_WAIT_L(8); PG8_BAR; PG8_WAIT_L(0); PG8_MMA(0, 0, At, B0); PG8_BAR; PG8_SCHED;
      PG8_LDB(B1, 1, 1); PG8_STAGE(PG8_SB(1, 0), b3);
      PG8_BAR; PG8_WAIT_L(0); PG8_MMA(0, 1, At, B1); PG8_BAR;
      PG8_LDA(At, 1, 1); PG8_STAGE(PG8_SA(1, 0), a3);
      PG8_BAR; PG8_WAIT_L(0); PG8_MMA(1, 0, At, B0); PG8_BAR; PG8_SCHED;
      PG8_STAGE(PG8_SB(1, 1), b3 + hstep);
      PG8_WAIT_V(6); PG8_BAR; PG8_MMA(1, 1, At, B1); PG8_BAR;
    }
    gemm_epilogue<EPI>(p, l, acc, cpm, cpn, wr, wc, fr, fq);
    if (!has_next) break;
#pragma unroll
    for (int a = 0; a < 2; ++a)
#pragma unroll
      for (int b = 0; b < 2; ++b)
#pragma unroll
        for (int m = 0; m < 4; ++m)
#pragma unroll
          for (int n = 0; n < 2; ++n) acc[a][b][m][n] = (f32x4){0.f, 0.f, 0.f, 0.f};
    cpm = npm; cpn = npn; cA = nA; cB = nB; ++ui;
  }
  PG8_WAIT_V(0);
  if (wr == 0) PG8_BAR;
  PG8_BAR;
#undef PG8_SA
#undef PG8_SB
#undef PG8_STAGE
#undef PG8_LDA
#undef PG8_LDB
#undef PG8_MMA
#undef PG8_WAIT_V
#undef PG8_WAIT_L
#undef PG8_BAR
#undef PG8_SCHED
}

DEV void rope8(float (&v)[8], int d0, int prow, int pcol, const float* __restrict__ rope) {
  const int pp = (d0 < 32) ? prow : pcol;
#pragma unroll
  for (int i = 0; i < 4; ++i) {
    const int f = ((d0 >> 1) + i) & 15;
    const float cs = rope[(pp * 16 + f) * 2], sn = rope[(pp * 16 + f) * 2 + 1];
    const float x1 = v[2 * i], x2 = v[2 * i + 1];
    v[2 * i] = x1 * cs - x2 * sn; v[2 * i + 1] = x1 * sn + x2 * cs;
  }
}

DEV void prep_token_row(const Params& p, int l, int m, int lane, uint4 c1, uint4 c2, uint4 c3) {
  bf16_t* zr = p.zf + (size_t)m * 1792;
  const bool lat = m >= 8192;
  const int pos = lat ? ((m - 8192) & 1023) : (m & 255);
  const int prow = pos >> 6, pcol = pos & 63;
  const int d0 = (lane & 7) * 8;
  {
    U8 u; u.u = c1;
    float v[8]; float ss = 0.f;
#pragma unroll
    for (int j = 0; j < 8; ++j) { v[j] = bf2f(u.h[j]); ss += v[j] * v[j]; }
    ss += __shfl_xor(ss, 1); ss += __shfl_xor(ss, 2); ss += __shfl_xor(ss, 4);
    const float rinv = rsqrtf(ss * (1.f / 64.f) + 1e-6f);
#pragma unroll
    for (int j = 0; j < 8; ++j) v[j] = v[j] * rinv * p.q_g[l * 64 + d0 + j];
    if (lat) rope8(v, d0, prow, pcol, p.rope);
#pragma unroll
    for (int j = 0; j < 4; ++j) u.w[j] = pack2(v[2 * j] * QSCALE, v[2 * j + 1] * QSCALE);
    *(uint4*)(zr + lane * 8) = u.u;
  }
  {
    const int col = lane < 32 ? 512 + lane * 8 : 1024 + (lane - 32) * 8;
    U8 u; u.u = c2;
    float v[8]; float ss = 0.f;
#pragma unroll
    for (int j = 0; j < 8; ++j) { v[j] = bf2f(u.h[j]); ss += v[j] * v[j]; }
    ss += __shfl_xor(ss, 1); ss += __shfl_xor(ss, 2); ss += __shfl_xor(ss, 4);
    if (lane < 16) {
      const float rinv = rsqrtf(ss * (1.f / 64.f) + 1e-6f);
#pragma unroll
      for (int j = 0; j < 8; ++j) v[j] = v[j] * rinv * p.k_g[l * 64 + d0 + j];
      if (!lat) {
        float* o = p.out + OFF_YK + ((((size_t)(m >> 8)) * 2 + l) * 256 + pos) * 128 + lane * 8;
        *(float4*)o = make_float4(v[0], v[1], v[2], v[3]); *(float4*)(o + 4) = make_float4(v[4], v[5], v[6], v[7]);
      } else rope8(v, d0, prow, pcol, p.rope);
#pragma unroll
      for (int j = 0; j < 4; ++j) u.w[j] = pack2(v[2 * j], v[2 * j + 1]);
      const int kvh = lane >> 3;
      bf16_t* kd = lat ? p.kb_lat + ((size_t)((l * 8 + ((m - 8192) >> 10)) * 2 + kvh) * 1280 + 256 + pos) * 64 + d0
                       : p.kb_ctx + ((size_t)((m >> 8) * 2 + kvh) * 256 + pos) * 64 + d0;
      *(uint4*)kd = u.u;
    } else if (lane < 32) {
      if (!lat) {
        float* o = p.out + OFF_YV + ((((size_t)(m >> 8)) * 2 + l) * 256 + pos) * 128 + (lane - 16) * 8;
        *(float4*)o = make_float4(v[0], v[1], v[2], v[3]); *(float4*)(o + 4) = make_float4(v[4], v[5], v[6], v[7]);
      }
      const int kvh = (lane - 16) >> 3;
      bf16_t* vd; int T;
      if (lat) { T = 1280; vd = p.vt_lat + ((size_t)((l * 8 + ((m - 8192) >> 10)) * 2 + kvh) * 64 + d0) * 1280 + 256 + pos; }
      else { T = 256; vd = p.vt_ctx + ((size_t)((m >> 8) * 2 + kvh) * 64 + d0) * 256 + pos; }
#pragma unroll
      for (int j = 0; j < 8; ++j) vd[(size_t)j * T] = u.h[j];
    } else {
#pragma unroll
      for (int j = 0; j < 4; ++j) u.w[j] = pack2(gelu_t(v[2 * j]), gelu_t(v[2 * j + 1]));
      *(uint4*)(zr + col) = u.u;
    }
  }
  {
    const int col = 1280 + lane * 8;
    U8 u; u.u = c3;
    float v[8]; float s = 0.f;
#pragma unroll
    for (int j = 0; j < 8; ++j) { v[j] = gelu_t(bf2f(u.h[j])); s += v[j]; }
#pragma unroll
    for (int o = 1; o <= 16; o <<= 1) s += __shfl_xor(s, o);
    const float mean = s * (1.f / 256.f);
    float s2 = 0.f;
#pragma unroll
    for (int j = 0; j < 8; ++j) { float d = v[j] - mean; s2 += d * d; }
#pragma unroll
    for (int o = 1; o <= 16; o <<= 1) s2 += __shfl_xor(s2, o);
    if (lane >= 32) {
      const float rstd = rsqrtf(s2 * (1.f / 256.f) + 1e-6f);
      const int ch = (lane - 32) * 8;
#pragma unroll
      for (int j = 0; j < 8; ++j) v[j] = (v[j] - mean) * rstd * p.mlp_g[l * 256 + ch + j] + p.mlp_b[l * 256 + ch + j];
    }
#pragma unroll
    for (int j = 0; j < 4; ++j) u.w[j] = pack2(v[2 * j], v[2 * j + 1]);
    *(uint4*)(zr + col) = u.u;
  }
}

template <bool REV>
DEV void tile_scan(float (&a)[4][4], float (&u)[4][4], int lane) {
  const int q = lane >> 4;
  float C = 0.f, CP = 1.f;
  const int src1 = (REV ? lane + 16 : lane - 16) & 63;
  const int src2 = (REV ? lane + 32 : lane - 32) & 63;
  const int srcT = (lane & 15) + (REV ? 0 : 48);
  const bool c1 = REV ? (q <= 2) : (q >= 1);
  const bool c2 = REV ? (q <= 1) : (q >= 2);
  const bool first = REV ? (q == 3) : (q == 0);
#pragma unroll
  for (int mi = 0; mi < 4; ++mi) {
    const int mt = REV ? 3 - mi : mi;
    float P = 1.f, H = 0.f, pl[4], hl[4];
#pragma unroll
    for (int ri = 0; ri < 4; ++ri) {
      const int r = REV ? 3 - ri : ri;
      H = a[mt][r] * H + u[mt][r]; P *= a[mt][r]; pl[r] = P; hl[r] = H;
    }
    float Pi = P, Hi = H;
    float Pp = __shfl(Pi, src1), Hp = __shfl(Hi, src1);
    if (c1) { Hi = Pi * Hp + Hi; Pi = Pi * Pp; }
    Pp = __shfl(Pi, src2); Hp = __shfl(Hi, src2);
    if (c2) { Hi = Pi * Hp + Hi; Pi = Pi * Pp; }
    float Pe = __shfl(Pi, src1), He = __shfl(Hi, src1);
    if (first) { Pe = 1.f; He = 0.f; }
    const float hin = Pe * C + He, pin = Pe * CP;
#pragma unroll
    for (int r = 0; r < 4; ++r) { u[mt][r] = pl[r] * hin + hl[r]; a[mt][r] = pl[r] * pin; }
    const float Pt = __shfl(Pi, srcT), Ht = __shfl(Hi, srcT);
    C = Pt * C + Ht; CP = Pt * CP;
  }
}

DEV void lru_gate_item(const Params& p, int l, int item, char* smem) {
  const int tid = VTID, lane = tid & 63, w = tid >> 6;
  const int tile = item >> 2, blk = item & 3;
  const int m0 = tile * 64;
  int ms, L;
  if (m0 < 8192) { ms = m0 & ~255; L = 256; } else { ms = 8192 + ((m0 - 8192) & ~1023); L = 1024; }
  float* xs = (float*)smem;
  float* xcf = xs + 67 * 64;
  bf16_t* xcb = (bf16_t*)(xcf + 64 * 64);
  for (int idx = tid; idx < 67 * 8; idx += 256) {
    const int rr = idx >> 3, cc = idx & 7;
    const int m = m0 - 1 + rr;
    float v[8];
    if (m >= ms && m < ms + L) {
      U8 u; u.u = *(const uint4*)(p.zf + (size_t)m * 1792 + 768 + blk * 64 + cc * 8);
#pragma unroll
      for (int j = 0; j < 8; ++j) v[j] = bf2f(u.h[j]);
    } else {
#pragma unroll
      for (int j = 0; j < 8; ++j) v[j] = 0.f;
    }
#pragma unroll
    for (int j = 0; j < 8; ++j) xs[rr * 64 + cc * 8 + j] = v[j];
  }
  __syncthreads();
  {
    const int ch = tid & 63, Cg = blk * 64 + ch;
    const float w0 = p.conv_w[(l * 4 + 0) * 256 + Cg], w1 = p.conv_w[(l * 4 + 1) * 256 + Cg], w2 = p.conv_w[(l * 4 + 2) * 256 + Cg],
                w3 = p.conv_w[(l * 4 + 3) * 256 + Cg], cb = p.conv_b[l * 256 + Cg];
#pragma unroll 4
    for (int tt = 0; tt < 16; ++tt) {
      const int t = (tid >> 6) * 16 + tt;
      const float v = cb + w0 * xs[t * 64 + ch] + w1 * xs[(t + 1) * 64 + ch] + w2 * xs[(t + 2) * 64 + ch] + w3 * xs[(t + 3) * 64 + ch];
      xcf[t * 64 + ch] = v; xcb[t * 72 + ch] = f2bf(v);
    }
  }
  __syncthreads();
  const int dir = w >> 1, half = w & 1, q = lane >> 4, c15 = lane & 15;
  const bf16_t* wt = p.wt_lru + (size_t)((((l * 2 + dir) * 4 + blk) * 2)) * 4096;
  bf16x8 bfr[2][2][2];
#pragma unroll
  for (int mat = 0; mat < 2; ++mat)
#pragma unroll
    for (int j = 0; j < 2; ++j)
#pragma unroll
      for (int s = 0; s < 2; ++s) bfr[mat][j][s] = *(const bf16x8*)(wt + mat * 4096 + (half * 32 + j * 16 + c15) * 64 + s * 32 + q * 8);
  f32x4 acc[2][4][2];
#pragma unroll
  for (int mat = 0; mat < 2; ++mat)
#pragma unroll
    for (int mt = 0; mt < 4; ++mt)
#pragma unroll
      for (int j = 0; j < 2; ++j) acc[mat][mt][j] = f32x4{0.f, 0.f, 0.f, 0.f};
#pragma unroll
  for (int mt = 0; mt < 4; ++mt)
#pragma unroll
    for (int s = 0; s < 2; ++s) {
      const bf16x8 af = *(const bf16x8*)(xcb + (mt * 16 + c15) * 72 + s * 32 + q * 8);
#pragma unroll
      for (int mat = 0; mat < 2; ++mat)
#pragma unroll
        for (int j = 0; j < 2; ++j) acc[mat][mt][j] = mfma16(af, bfr[mat][j][s], acc[mat][mt][j]);
    }
  float* PCp = p.au + (size_t)(dir * 2 + 0) * MT * 256;
  float* HLp = p.au + (size_t)(dir * 2 + 1) * MT * 256;
#pragma unroll
  for (int j = 0; j < 2; ++j) {
    const int ch = half * 32 + j * 16 + c15, Cg = blk * 64 + ch, pidx = (l * 2 + dir) * 256 + Cg;
    const float ba = p.lru_ba[pidx], bx = p.lru_bx[pidx], lam = p.lru_lam[pidx];
    const float xn = -lam;
    const float sp = fmaxf(xn, 0.f) + log1pf(expf(-fabsf(xn)));
    const float cdec = -8.f * sp;
    float a[4][4], u[4][4];
#pragma unroll
    for (int mt = 0; mt < 4; ++mt)
#pragma unroll
      for (int r = 0; r < 4; ++r) {
        const int t = mt * 16 + q * 4 + r;
        const float rg = sigmoidf_(acc[0][mt][j][r] + ba), ig = sigmoidf_(acc[1][mt][j][r] + bx);
        const float la = cdec * rg;
        a[mt][r] = __expf(la);
        u[mt][r] = sqrtf(-expm1f(2.f * la)) * ig * xcf[t * 64 + ch];
      }
    if (dir == 0) tile_scan<false>(a, u, lane); else tile_scan<true>(a, u, lane);
#pragma unroll
    for (int mt = 0; mt < 4; ++mt)
#pragma unroll
      for (int r = 0; r < 4; ++r) {
        const size_t m = m0 + mt * 16 + q * 4 + r;
        PCp[m * 256 + Cg] = a[mt][r]; HLp[m * 256 + Cg] = u[mt][r];
      }
  }
  __syncthreads();
}

DEV void attn_item(const Params& p, int l, int it, char* sm) {
  const int tid = threadIdx.x, lane = tid & 63, w = tid >> 6, q = lane >> 4, c15 = lane & 15;
  int h, ms, nkt, T; const bf16_t* Kg; const bf16_t* Vg;
  if (it < 512) {
    const int b = it >> 6, qb = it & 7; h = (it >> 3) & 7; ms = 8192 + b * 1024 + qb * 128; nkt = 10; T = 1280;
    Kg = p.kb_lat + (size_t)((l * 8 + b) * 2 + (h >> 2)) * 1280 * 64; Vg = p.vt_lat + (size_t)((l * 8 + b) * 2 + (h >> 2)) * 64 * 1280;
  } else {
    const int i2 = it - 512, b = i2 >> 4, qb = i2 & 1; h = (i2 >> 1) & 7; ms = b * 256 + qb * 128; nkt = 2; T = 256;
    Kg = p.kb_ctx + (size_t)(b * 2 + (h >> 2)) * 256 * 64; Vg = p.vt_ctx + (size_t)(b * 2 + (h >> 2)) * 64 * 256;
  }
  const int kc0 = tid, kc1 = tid + 512;
  const int vd0 = tid >> 4, vk = (tid & 15) * 8;
  const bf16_t* vg0 = Vg + (size_t)vd0 * T + vk;
  const bf16_t* vg1 = Vg + (size_t)(vd0 + 32) * T + vk;
  uint4 rk0, rk1, rv0, rv1;
#define ATT_LOAD(kt) do { rk0 = *(const uint4*)(Kg + (size_t)(kt) * 8192 + kc0 * 8); rk1 = *(const uint4*)(Kg + (size_t)(kt) * 8192 + kc1 * 8); \
    rv0 = *(const uint4*)(vg0 + (kt) * 128); rv1 = *(const uint4*)(vg1 + (kt) * 128); } while (0)
#define ATT_STORE(buf) do { bf16_t* Ks_ = (bf16_t*)(sm + (buf) * 36864); bf16_t* Vs_ = Ks_ + 9216; \
    *(uint4*)(Ks_ + (kc0 >> 3) * 72 + (kc0 & 7) * 8) = rk0; *(uint4*)(Ks_ + (kc1 >> 3) * 72 + (kc1 & 7) * 8) = rk1; \
    *(uint4*)(Vs_ + vd0 * 136 + vk) = rv0; *(uint4*)(Vs_ + (vd0 + 32) * 136 + vk) = rv1; } while (0)
  ATT_LOAD(0);
  const int mq = ms + w * 16;
  bf16x8 qf[2];
#pragma unroll
  for (int s = 0; s < 2; ++s) qf[s] = *(const bf16x8*)(p.zf + (size_t)(mq + c15) * 1792 + h * 64 + s * 32 + q * 8);
  ATT_STORE(0);
  if (nkt > 1) ATT_LOAD(1);
  __syncthreads();
  f32x4 o[4];
  float mrow = -1e30f, lrow = 0.f;
#pragma unroll
  for (int j = 0; j < 4; ++j) o[j] = f32x4{0.f, 0.f, 0.f, 0.f};
  for (int kt = 0; kt < nkt; ++kt) {
    const int cur = kt & 1;
    const bf16_t* Ks = (const bf16_t*)(sm + cur * 36864);
    const bf16_t* Vs = Ks + 9216;
    f32x4 s4[8];
#pragma unroll
    for (int jn = 0; jn < 8; ++jn) {
      s4[jn] = f32x4{0.f, 0.f, 0.f, 0.f};
#pragma unroll
      for (int s = 0; s < 2; ++s) {
        const bf16x8 kb = *(const bf16x8*)(Ks + (jn * 16 + c15) * 72 + s * 32 + q * 8);
        s4[jn] = mfma16(kb, qf[s], s4[jn]);
      }
    }
    float mx = s4[0][0];
#pragma unroll
    for (int jn = 0; jn < 8; ++jn)
#pragma unroll
      for (int r = 0; r < 4; ++r) mx = fmaxf(mx, s4[jn][r]);
    mx = fmaxf(mx, __shfl_xor(mx, 16)); mx = fmaxf(mx, __shfl_xor(mx, 32));
    const float mnew = fmaxf(mrow, mx);
    const float alpha = __builtin_amdgcn_exp2f(mrow - mnew);
    mrow = mnew;
    float ls = 0.f;
#pragma unroll
    for (int jn = 0; jn < 8; ++jn)
#pragma unroll
      for (int r = 0; r < 4; ++r) { const float pv = __builtin_amdgcn_exp2f(s4[jn][r] - mnew); s4[jn][r] = pv; ls += pv; }
    lrow = lrow * alpha + ls;
#pragma unroll
    for (int jn = 0; jn < 4; ++jn) { o[jn][0] *= alpha; o[jn][1] *= alpha; o[jn][2] *= alpha; o[jn][3] *= alpha; }
    U8 pb[4];
#pragma unroll
    for (int ks = 0; ks < 4; ++ks) {
      pb[ks].w[0] = pack2(s4[2 * ks][0], s4[2 * ks][1]); pb[ks].w[1] = pack2(s4[2 * ks][2], s4[2 * ks][3]);
      pb[ks].w[2] = pack2(s4[2 * ks + 1][0], s4[2 * ks + 1][1]); pb[ks].w[3] = pack2(s4[2 * ks + 1][2], s4[2 * ks + 1][3]);
    }
#pragma unroll
    for (int jn = 0; jn < 4; ++jn)
#pragma unroll
      for (int ks = 0; ks < 4; ++ks) {
        const bf16_t* vp = Vs + (jn * 16 + c15) * 136 + ks * 32 + q * 4;
        const uint2 lo = *(const uint2*)vp, hi = *(const uint2*)(vp + 16);
        U8 va; va.w[0] = lo.x; va.w[1] = lo.y; va.w[2] = hi.x; va.w[3] = hi.y;
        o[jn] = mfma16(va.v, pb[ks].v, o[jn]);
      }
    if (kt + 1 < nkt) {
      ATT_STORE(cur ^ 1);
      if (kt + 2 < nkt) ATT_LOAD(kt + 2);
    }
    __syncthreads();
  }
#undef ATT_LOAD
#undef ATT_STORE
  float lt = lrow;
  lt += __shfl_xor(lt, 16); lt += __shfl_xor(lt, 32);
  const float inv = 1.f / lt;
  bf16_t* orow = p.abuf + (size_t)(mq + c15) * 1024 + h * 64 + q * 4;
#pragma unroll
  for (int jn = 0; jn < 4; ++jn) {
    uint2 ov; ov.x = pack2(o[jn][0] * inv, o[jn][1] * inv); ov.y = pack2(o[jn][2] * inv, o[jn][3] * inv);
    *(uint2*)(orow + jn * 16) = ov;
  }
}

DEV void gmlp_item(const Params& p, int l, int it, char* smem) {
  const int tid = VTID, lane = tid & 63, w = tid >> 6, q = lane >> 4, c15 = lane & 15;
  const int chunk = it >> 2, g = it & 3, m0 = chunk * 128;
  bf16_t* vt = (bf16_t*)smem;
#pragma unroll
  for (int i = 0; i < 4; ++i) {
    const int id = tid + 256 * i, qq = id >> 3, cc = id & 7;
    U8 v; v.u = *(const uint4*)(p.zf + (size_t)(m0 + qq) * 1792 + 1536 + g * 64 + cc * 8);
#pragma unroll
    for (int j = 0; j < 8; ++j) vt[(cc * 8 + j) * 136 + qq] = v.h[j];
  }
  __syncthreads();
  f32x4 acc[2][4];
#pragma unroll
  for (int i = 0; i < 2; ++i)
#pragma unroll
    for (int jn = 0; jn < 4; ++jn) acc[i][jn] = f32x4{0.f, 0.f, 0.f, 0.f};
  const float* wsg = p.mlp_ws + (size_t)(l * 4 + g) * 16384;
#pragma unroll
  for (int s = 0; s < 4; ++s) {
    U8 af[2];
#pragma unroll
    for (int i = 0; i < 2; ++i) {
      const float* ap = wsg + (w * 32 + i * 16 + c15) * 128 + s * 32 + q * 8;
      const float4 a0 = *(const float4*)ap, a1 = *(const float4*)(ap + 4);
      af[i].w[0] = pack2(a0.x, a0.y); af[i].w[1] = pack2(a0.z, a0.w); af[i].w[2] = pack2(a1.x, a1.y); af[i].w[3] = pack2(a1.z, a1.w);
    }
#pragma unroll
    for (int jn = 0; jn < 4; ++jn) {
      const bf16x8 bb = *(const bf16x8*)(vt + (jn * 16 + c15) * 136 + s * 32 + q * 8);
#pragma unroll
      for (int i = 0; i < 2; ++i) acc[i][jn] = mfma16(af[i].v, bb, acc[i][jn]);
    }
  }
#pragma unroll
  for (int i = 0; i < 2; ++i)
#pragma unroll
    for (int r = 0; r < 4; ++r) {
      const int pp = w * 32 + i * 16 + q * 4 + r;
      const size_t m = m0 + pp;
      const float bsv = p.mlp_bs[(l * 4 + g) * 128 + pp];
#pragma unroll
      for (int jn = 0; jn < 4; ++jn) {
        const int c = jn * 16 + c15;
        const float uu = bf2f(p.zf[m * 1792 + 1280 + g * 64 + c]);
        p.abuf[m * 1024 + 768 + g * 64 + c] = f2bf(uu * (acc[i][jn][r] + bsv));
      }
    }
  __syncthreads();
}

DEV void lru_apply_item(const Params& p, int l, int ti2) {
  const int C = VTID;
  const int ti = ti2 >> 1, th = (ti2 & 1) * 32;
  const int m0 = ti * 64;
  int ms, L, b; bool lat = m0 >= 8192;
  if (!lat) { ms = m0 & ~255; L = 256; b = m0 >> 8; } else { ms = 8192 + ((m0 - 8192) & ~1023); L = 1024; b = (m0 - 8192) >> 10; }
  const int k = (m0 - ms) >> 6, nt = L >> 6;
  const float* PCf = p.au; const float* HLf = p.au + (size_t)MT * 256;
  const float* PCb = p.au + (size_t)2 * MT * 256; const float* HLb = p.au + (size_t)3 * MT * 256;
  float cf = lat ? p.state_lru[((size_t)(b * 2 + l) * 2 + 0) * 256 + C] : 0.f;
  float cb = lat ? p.state_lru[((size_t)(b * 2 + l) * 2 + 1) * 256 + C] : 0.f;
  {
    float pc[15], hl[15];
#pragma unroll
    for (int i = 0; i < 15; ++i) {
      const bool act = i < k;
      const size_t e = (size_t)(ms + 64 * i + 63) * 256 + C;
      pc[i] = act ? PCf[e] : 1.f; hl[i] = act ? HLf[e] : 0.f;
    }
#pragma unroll
    for (int i = 0; i < 15; ++i) cf = pc[i] * cf + hl[i];
  }
  {
    float pc[15], hl[15];
#pragma unroll
    for (int i = 0; i < 15; ++i) {
      const int tix = nt - 1 - i;
      const bool act = tix > k;
      const size_t e = (size_t)(ms + 64 * tix) * 256 + C;
      pc[i] = act ? PCb[e] : 1.f; hl[i] = act ? HLb[e] : 0.f;
    }
#pragma unroll
    for (int i = 0; i < 15; ++i) cb = pc[i] * cb + hl[i];
  }
  float hf_last = 0.f, hb_first = 0.f;
#pragma unroll 16
  for (int t = th; t < th + 32; ++t) {
    const size_t m = m0 + t;
    const float hf = PCf[m * 256 + C] * cf + HLf[m * 256 + C];
    const float hb = PCb[m * 256 + C] * cb + HLb[m * 256 + C];
    const float g = bf2f(p.zf[m * 1792 + 1024 + C]);
    p.abuf[m * 1024 + 512 + C] = f2bf((hf + hb) * g);
    if (t == 0) hb_first = hb;
    if (t == 63) hf_last = hf;
  }
  if (!lat) {
    if (k == nt - 1 && th == 32) p.out[OFF_ST + ((size_t)(b * 2 + l) * 2 + 0) * 256 + C] = hf_last;
    if (k == 0 && th == 0) p.out[OFF_ST + ((size_t)(b * 2 + l) * 2 + 1) * 256 + C] = hb_first;
  }
}

DEV void mixer_phase(const Params& p, int l, char* smem_raw, char* smem) {
  for (int it = blockIdx.x; it < 1024; it += gridDim.x) attn_item(p, l, it, smem_raw);
  const int NITEMS = 512 + 512;
  for (int it = VBID; it < NITEMS; it += VNB) {
    if (it < 512) lru_apply_item(p, l, it);
    else gmlp_item(p, l, it - 512, smem);
  }
}

DEV void prep_phase_full(const Params& p, int l, char* smem) {
  for (int it = VBID; it < 1024; it += VNB) lru_gate_item(p, l, it, smem);
  const int lane = threadIdx.x & 63, mstride = gridDim.x * 8;
  int m = blockIdx.x * 8 + (threadIdx.x >> 6);
  const int c2off = lane < 32 ? 512 + lane * 8 : 1024 + (lane - 32) * 8;
  uint4 n1, n2, n3;
  { const bf16_t* zr = p.zf + (size_t)m * 1792; n1 = *(const uint4*)(zr + lane * 8); n2 = *(const uint4*)(zr + c2off); n3 = *(const uint4*)(zr + 1280 + lane * 8); }
  for (; m < MT; m += mstride) {
    const uint4 c1 = n1, c2 = n2, c3 = n3;
    const int mn = (m + mstride < MT) ? m + mstride : m;
    { const bf16_t* zr = p.zf + (size_t)mn * 1792; n1 = *(const uint4*)(zr + lane * 8); n2 = *(const uint4*)(zr + c2off); n3 = *(const uint4*)(zr + 1280 + lane * 8); }
    prep_token_row(p, l, m, lane, c1, c2, c3);
  }
}


#define XB_TMO      128
#define XB_XCNT(j)  (256  + 64 * (j))
#define XB_XSUB(j)  (1280 + 64 * (j))
#define XB_XGEN(j)  (2304 + 64 * (j))
#define XB_TOP      3328
#define XB_TOPGEN   3392
#define XCD_BAR_WORDS 3456
#define XB_SPIN_CAP (1u << 18)
#define LAS __attribute__((address_space(3)))
DEV unsigned xb_ld(unsigned* p) { return __hip_atomic_load(p, __ATOMIC_RELAXED, __HIP_MEMORY_SCOPE_AGENT); }
DEV unsigned xb_add(unsigned* p, unsigned v) { return __hip_atomic_fetch_add(p, v, __ATOMIC_RELAXED, __HIP_MEMORY_SCOPE_AGENT); }
DEV unsigned xb_xcc_id() { return (unsigned)__builtin_amdgcn_s_getreg((3 << 11) | 20) & 0xFu; }
#define XB_SPIN(cond, bar) do { unsigned _sp = 0; while (cond) { __builtin_amdgcn_s_sleep(1); \
    if ((++_sp & 255u) == 0u) { if (xb_ld(&(bar)[XB_TMO])) break; if (_sp > XB_SPIN_CAP) { atomicAdd(&(bar)[XB_TMO], 1u); break; } } } } while (0)
struct XcdBarrier { unsigned* bar; unsigned x; volatile LAS unsigned* st; };
DEV XcdBarrier xcd_barrier_post(unsigned* bar, volatile LAS unsigned* st) {
  XcdBarrier b; b.bar = bar; b.x = xb_xcc_id(); b.st = st;
  if (threadIdx.x == 0) (void)xb_add(&bar[XB_XCNT(b.x)], 1u);
  return b;
}
DEV void xcd_barrier_complete(unsigned* bar, unsigned x, unsigned& nloc, unsigned& nx) {
  const unsigned G = gridDim.x * gridDim.y * gridDim.z;
  unsigned sum, cnt, mine, sp = 0u;
  for (;;) {
    sum = 0u; cnt = 0u; mine = 0u;
#pragma unroll
    for (unsigned j = 0; j < 16; ++j) { const unsigned c = xb_ld(&bar[XB_XCNT(j)]); sum += c; cnt += (c > 0u) ? 1u : 0u; mine = (j == x) ? c : mine; }
    if (sum == G) break;
    __builtin_amdgcn_s_sleep(1);
    if ((++sp & 255u) == 0u) { if (xb_ld(&bar[XB_TMO])) break; if (sp > XB_SPIN_CAP) { atomicAdd(&bar[XB_TMO], 1u); break; } }
  }
  nloc = mine > 0u ? mine : 1u; nx = cnt > 0u ? cnt : 1u;
}
DEV void xcd_barrier(const XcdBarrier& b) {
  asm volatile("s_waitcnt vmcnt(0)" ::: "memory");
  __syncthreads();
  if (threadIdx.x == 0) {
    unsigned* bar = b.bar;
    __builtin_amdgcn_s_waitcnt(0);
    unsigned nloc = b.st[0], nx = b.st[1];
    if (nloc == 0u) { xcd_barrier_complete(bar, b.x, nloc, nx); b.st[0] = nloc; b.st[1] = nx; }
    const unsigned old = xb_add(&bar[XB_XSUB(b.x)], 1u);
    const unsigned gen = old / nloc;
    if (old + 1u == (gen + 1u) * nloc) {
      __builtin_amdgcn_fence(__ATOMIC_RELEASE, "agent");
      asm volatile("s_waitcnt vmcnt(0)" ::: "memory");
      const unsigned og = xb_add(&bar[XB_TOP], 1u);
      const unsigned tg = og / nx;
      if (og + 1u == (tg + 1u) * nx) xb_add(&bar[XB_TOPGEN], 1u);
      else XB_SPIN(xb_ld(&bar[XB_TOPGEN]) == tg, bar);
      __builtin_amdgcn_fence(__ATOMIC_ACQUIRE, "agent");
      xb_add(&bar[XB_XGEN(b.x)], 1u);
      asm volatile("s_waitcnt vmcnt(0)" ::: "memory");
    } else {
      XB_SPIN(xb_ld(&bar[XB_XGEN(b.x)]) == gen, bar);
      __builtin_amdgcn_fence(__ATOMIC_ACQUIRE, "agent");
      asm volatile("s_waitcnt vmcnt(0)" ::: "memory");
    }
  }
  __syncthreads();
}

#define PH(i, call) if (ph_lo <= (i) && (i) < ph_hi) { if ((i) > ph_lo) xcd_barrier(xb); call; }
#define LAYER(l, b) \
  PH(b + 0, ln_mod_phase(p, l, l == 0 ? 0 : 1)) \
  PH(b + 1, gemm_phase<1>(p, l, p.abuf, p.wt_in + (size_t)l * 1792 * 1024, 1792, 1024, (LAS3 unsigned char*)smem_raw)) \
  PH(b + 2, prep_phase_full(p, l, smem)) \
  PH(b + 3, mixer_phase(p, l, smem_raw, smem)) \
  PH(b + 4, gemm_phase<2>(p, l, p.abuf, p.wt_out + (size_t)l * 1024 * 1024, 1024, 1024, (LAS3 unsigned char*)smem_raw)) \
  PH(b + 5, ln_mod_phase(p, l, 2)) \
  PH(b + 6, gemm_phase<3>(p, l, p.abuf, p.wt_ff1 + (size_t)l * 4096 * 1024, 4096, 1024, (LAS3 unsigned char*)smem_raw)) \
  PH(b + 7, gemm_phase<4>(p, l, p.zf, p.wt_ff2 + (size_t)l * 1024 * 4096, 1024, 4096, (LAS3 unsigned char*)smem_raw))

__global__ void __launch_bounds__(512, 2) mega_kernel(Params p, int ph_lo, int ph_hi) {
  extern __shared__ __attribute__((aligned(16))) char smem_raw[];
  char* smem = smem_raw + (threadIdx.x >> 8) * 65536;
  __shared__ uint4 xb_words;
  if (threadIdx.x == 0) xb_words = make_uint4(0u, 0u, 0u, 0u);
  __syncthreads();
  XcdBarrier xb = xcd_barrier_post(p.bar, (volatile LAS unsigned*)&xb_words);
  if (ph_hi > 1000) { cg::grid_group grid = cg::this_grid(); grid.sync(); }
  PH(0, phase0(p, smem))
  LAYER(0, 1)
  LAYER(1, 9)
  PH(17, ln_mod_phase(p, 1, 3))
}

extern "C" void kernel_launch(void* const* d_in, const int* in_sizes, int n_in, void* d_out, int out_size, void* d_ws, size_t ws_size,
                              hipStream_t stream) {
  static int grid_blocks = 0;
  if (!grid_blocks) {
    int dev = 0, cus = 0, per_cu = 0;
    hipGetDevice(&dev);
    hipDeviceGetAttribute(&cus, hipDeviceAttributeMultiprocessorCount, dev);
    hipFuncSetAttribute((const void*)mega_kernel, hipFuncAttributeMaxDynamicSharedMemorySize, SMEM_BYTES);
    hipOccupancyMaxActiveBlocksPerMultiprocessor(&per_cu, (const void*)mega_kernel, 512, SMEM_BYTES);
    if (per_cu < 1) per_cu = 1;
    if (per_cu > 1) per_cu = 1;
    grid_blocks = cus * per_cu;
  }
  Params p{};
  const float** pin = (const float**)&p;
  for (int i = 0; i < 32; ++i) pin[i] = (const float*)d_in[i];
  p.out = (float*)d_out;
  char* ws = (char*)d_ws;
  size_t off = 0;
  p.bar = (unsigned*)(ws + off); off += 16384;
  p.kb_lat = (bf16_t*)(ws + off); off += (size_t)2 * 8 * 2 * 1280 * 64 * 2;
  p.vt_lat = (bf16_t*)(ws + off); off += (size_t)2 * 8 * 2 * 1280 * 64 * 2;
  p.kb_ctx = (bf16_t*)(ws + off); off += (size_t)32 * 2 * 256 * 64 * 2;
  p.vt_ctx = (bf16_t*)(ws + off); off += (size_t)32 * 2 * 256 * 64 * 2;
  p.wt_in = (bf16_t*)(ws + off); off += (size_t)2 * 1792 * 1024 * 2;
  p.wt_out = (bf16_t*)(ws + off); off += (size_t)2 * 1024 * 1024 * 2;
  p.wt_ff1 = (bf16_t*)(ws + off); off += (size_t)2 * 4096 * 1024 * 2;
  p.wt_ff2 = (bf16_t*)(ws + off); off += (size_t)2 * 4096 * 1024 * 2;
  p.wt_lru = (bf16_t*)(ws + off); off += (size_t)64 * 4096 * 2;
  p.mod = (float*)(ws + off); off += (size_t)2 * 9 * 6144 * 4;
  p.rope = (float*)(ws + off); off += (size_t)2048 * 4;
  p.abuf = (bf16_t*)(ws + off); off += (size_t)MT * 1024 * 2;
  p.zf = (bf16_t*)(ws + off);
  p.au = (float*)(ws + off + (size_t)MT * 1792 * 2);
  off += (size_t)MT * 4096 * 2;
  if (off > ws_size) { fprintf(stderr, "workspace too small: need %zu have %zu\n", off, ws_size); return; }
  (void)hipMemsetAsync(p.bar, 0, XCD_BAR_WORDS * 4, stream);
#if MULTI_LAUNCH
  for (int ph = 0; ph < NPHASE; ++ph) {
    hipLaunchKernelGGL(mega_kernel, dim3(grid_blocks), dim3(512), SMEM_BYTES, stream, p, ph, ph + 1);
  }
#else
  int lo = 0, hi = NPHASE;
  void* args[] = {&p, &lo, &hi};
  hipError_t e = hipLaunchCooperativeKernel((void*)mega_kernel, dim3(grid_blocks), dim3(512), args, SMEM_BYTES, stream);
  if (e != hipSuccess) fprintf(stderr, "cooperative launch failed: %s (grid %d)\n", hipGetErrorString(e), grid_blocks);
#endif
}
```

```cpp
#include <hip/hip_runtime.h>
#include <hip/hip_cooperative_groups.h>
#include <cstdio>
#include <cstdint>
namespace cg = cooperative_groups;

#ifndef MULTI_LAUNCH
#define MULTI_LAUNCH 0
#endif

typedef unsigned short bf16_t;
using bf16x8 = __attribute__((ext_vector_type(8))) short;
using f32x4 = __attribute__((ext_vector_type(4))) float;
#define DEV __device__ __forceinline__
#define VTID ((int)(threadIdx.x & 255))
#define VBID ((int)(blockIdx.x * 2 + (threadIdx.x >> 8)))
#define VNB ((int)(gridDim.x * 2))

constexpr int MT = 16384;
constexpr int NPHASE = 18;
constexpr size_t OFF_YK = 16777216, OFF_YV = OFF_YK + 2097152, OFF_ST = OFF_YV + 2097152;
constexpr float ALPHA = 1.41421356237f;
constexpr float QSCALE = 0.125f * 1.4426950408889634f;
constexpr int SMEM_BYTES = 131072;

struct Params {
  const float *x_prompt, *x_sample, *c, *cache_k, *cache_v, *state_lru, *c_ctx, *w_ada, *b_ada, *w_in,
      *q_g, *k_g, *conv_w, *conv_b, *lru_wa, *lru_ba, *lru_wx, *lru_bx, *lru_lam, *mlp_g, *mlp_b, *mlp_ws, *mlp_bs,
      *w_out, *ln1_g, *ln1_b, *w_ff1, *b_ff1, *w_ff2, *b_ff2, *ln2_g, *ln2_b;
  float* out;
  bf16_t *wt_in, *wt_out, *wt_ff1, *wt_ff2, *wt_lru;
  float *mod, *rope;
  bf16_t *abuf;
  bf16_t *zf;
  float *au;
  bf16_t *kb_lat, *vt_lat;
  bf16_t *kb_ctx, *vt_ctx;
  unsigned *bar;
};

union U8 { uint4 u; bf16x8 v; bf16_t h[8]; unsigned w[4]; };

DEV float bf2f(bf16_t h) { return __uint_as_float(((unsigned)h) << 16); }
DEV bf16_t f2bf(float f) { unsigned u = __float_as_uint(f); u += 0x7fffu + ((u >> 16) & 1u); return (bf16_t)(u >> 16); }
DEV unsigned pack2(float a, float b) { unsigned r; asm volatile("v_cvt_pk_bf16_f32 %0, %1, %2" : "=v"(r) : "v"(a), "v"(b)); return r; }
DEV float gelu_t(float x) { float y = 0.7978845608028654f * (x + 0.044715f * x * x * x); float t = 1.f - 2.f * __builtin_amdgcn_rcpf(1.f + __expf(2.f * y)); return 0.5f * x * (1.f + t); }
DEV float sigmoidf_(float x) { return __builtin_amdgcn_rcpf(1.f + __expf(-x)); }
DEV int cond_of(int m) { return m < 8192 ? 0 : 1 + ((m - 8192) >> 10); }
DEV f32x4 mfma16(bf16x8 a, bf16x8 b, f32x4 c) { return __builtin_amdgcn_mfma_f32_16x16x32_bf16(a, b, c, 0, 0, 0); }
DEV float wave_sum(float v) {
#pragma unroll
  for (int o = 32; o >= 1; o >>= 1) v += __shfl_xor(v, o);
  return v;
}

DEV void transpose_tile(const float* __restrict__ src, bf16_t* __restrict__ dst, int lds_, int ldd, char* smem) {
  float* T = (float*)smem;
  const int tid = VTID;
#pragma unroll
  for (int i = 0; i < 4; ++i) {
    int k = (tid >> 4) + 16 * i, n4 = (tid & 15) * 4;
    float4 v = *(const float4*)(src + (size_t)k * lds_ + n4);
    T[k * 65 + n4 + 0] = v.x; T[k * 65 + n4 + 1] = v.y; T[k * 65 + n4 + 2] = v.z; T[k * 65 + n4 + 3] = v.w;
  }
  __syncthreads();
#pragma unroll
  for (int i = 0; i < 2; ++i) {
    int n = (tid >> 3) + 32 * i, k8 = (tid & 7) * 8;
    U8 o;
#pragma unroll
    for (int j = 0; j < 4; ++j) o.w[j] = pack2(T[(k8 + 2 * j) * 65 + n], T[(k8 + 2 * j + 1) * 65 + n]);
    *(uint4*)(dst + (size_t)n * ldd + k8) = o.u;
  }
  __syncthreads();
}
DEV void transpose_w(const float* __restrict__ W, bf16_t* __restrict__ Wt, int K, int N, int tk, int tn, char* smem) {
  transpose_tile(W + (size_t)(tk * 64) * N + tn * 64, Wt + (size_t)(tn * 64) * K + tk * 64, N, K, smem);
}

DEV void phase0(const Params& p, char* smem) {
  const int tid = VTID;
  const int NT0 = 192 + 2 * 2768, NITEMS = NT0 + 128 + 64 + 2;
  for (int it = VBID; it < NITEMS; it += VNB) {
    if (it < 192) {
      const int l = it / 96, n0 = (it % 96) * 64;
      float* s = (float*)smem;
      float* red = s + 9 * 1024;
      for (int idx = tid; idx < 9 * 1024; idx += 256) {
        int c = idx >> 10, k = idx & 1023;
        float v = (c == 0) ? p.c_ctx[k] : p.c[(c - 1) * 1024 + k];
        s[idx] = v / (1.f + __expf(-v));
      }
      __syncthreads();
      const int w = tid >> 6, lane = tid & 63, cq = lane & 15, ks = lane >> 4;
      const int kbase = (w * 4 + ks) * 64;
      float acc[9][4];
#pragma unroll
      for (int c = 0; c < 9; ++c) { acc[c][0] = 0.f; acc[c][1] = 0.f; acc[c][2] = 0.f; acc[c][3] = 0.f; }
      const float* wp = p.w_ada + ((size_t)l * 1024 + kbase) * 6144 + n0 + cq * 4;
      for (int kb = 0; kb < 64; kb += 16) {
        float4 wv[16];
#pragma unroll
        for (int j = 0; j < 16; ++j) wv[j] = *(const float4*)(wp + (size_t)(kb + j) * 6144);
#pragma unroll
        for (int j = 0; j < 16; ++j)
#pragma unroll
          for (int c = 0; c < 9; ++c) {
            const float sv = s[c * 1024 + kbase + kb + j];
            acc[c][0] += sv * wv[j].x; acc[c][1] += sv * wv[j].y; acc[c][2] += sv * wv[j].z; acc[c][3] += sv * wv[j].w;
          }
      }
#pragma unroll
      for (int c = 0; c < 9; ++c)
#pragma unroll
        for (int e = 0; e < 4; ++e) {
          float a = acc[c][e];
          a += __shfl_xor(a, 16); a += __shfl_xor(a, 32);
          if (ks == 0) red[(w * 9 + c) * 64 + cq * 4 + e] = a;
        }
      __syncthreads();
      for (int idx = tid; idx < 576; idx += 256) {
        int c = idx >> 6, nn = idx & 63;
        float v = red[(0 * 9 + c) * 64 + nn] + red[(1 * 9 + c) * 64 + nn] + red[(2 * 9 + c) * 64 + nn] + red[(3 * 9 + c) * 64 + nn] +
                  p.b_ada[l * 6144 + n0 + nn];
        p.mod[((size_t)l * 9 + c) * 6144 + n0 + nn] = v;
      }
      __syncthreads();
    } else if (it >= NT0 && it < NT0 + 128) {
      const int j = it - NT0, tt = j & 3, kvh = (j >> 2) & 1, l = (j >> 3) & 1, b = j >> 4;
      transpose_tile(p.cache_v + ((size_t)(b * 2 + l) * 256 + tt * 64) * 128 + kvh * 64, p.vt_lat + ((size_t)((l * 8 + b) * 2 + kvh) * 64) * 1280 + tt * 64, 128, 1280, smem);
    } else if (it >= NT0 + 128 && it < NT0 + 192) {
      const int j = it - NT0 - 128;
#pragma unroll
      for (int i = 0; i < 4; ++i) {
        const int e = (j * 1024 + i * 256 + tid) * 8;
        const int d = e & 63, kvh = (e >> 6) & 1, t = (e >> 7) & 255, l = (e >> 15) & 1, b = e >> 16;
        const float4 a0 = *(const float4*)(p.cache_k + e), a1 = *(const float4*)(p.cache_k + e + 4);
        U8 o; o.w[0] = pack2(a0.x, a0.y); o.w[1] = pack2(a0.z, a0.w); o.w[2] = pack2(a1.x, a1.y); o.w[3] = pack2(a1.z, a1.w);
        *(uint4*)(p.kb_lat + ((size_t)((l * 8 + b) * 2 + kvh) * 1280 + t) * 64 + d) = o.u;
      }
    } else if (it >= NT0 + 192) {
      if (it == NT0 + 192)
      for (int idx = tid; idx < 1024; idx += 256) {
        int pp = idx >> 4, f = idx & 15;
        float inv = powf(10000.f, -(float)f / 16.f);
        float ang = (float)pp * inv;
        float nrev = rintf(ang * 0.15915494309189535f);
        float r = fmaf(-nrev, 6.28125f, ang);
        r = fmaf(-nrev, 0.0019353071795864769f, r);
        p.rope[idx * 2 + 0] = __cosf(r);
        p.rope[idx * 2 + 1] = __sinf(r);
      }
    } else {
      int t = it - 192;
      const int l = t / 2768, r = t % 2768;
      if (r < 448) transpose_w(p.w_in + (size_t)l * 1024 * 1792, p.wt_in + (size_t)l * 1792 * 1024, 1024, 1792, r / 28, r % 28, smem);
      else if (r < 704) { int i = r - 448; transpose_w(p.w_out + (size_t)l * 1024 * 1024, p.wt_out + (size_t)l * 1024 * 1024, 1024, 1024, i / 16, i % 16, smem); }
      else if (r < 1728) { int i = r - 704; transpose_w(p.w_ff1 + (size_t)l * 1024 * 4096, p.wt_ff1 + (size_t)l * 4096 * 1024, 1024, 4096, i / 64, i % 64, smem); }
      else if (r < 2752) { int i = r - 1728; transpose_w(p.w_ff2 + (size_t)l * 4096 * 1024, p.wt_ff2 + (size_t)l * 1024 * 4096, 4096, 1024, i / 16, i % 16, smem); }
      else {
        int idx = r - 2752;
        int dir = idx >> 3, blk = (idx >> 1) & 3, mat = idx & 1;
        const float* src = (mat == 0 ? p.lru_wa : p.lru_wx) + (size_t)(((l * 2 + dir) * 4 + blk)) * 4096;
        bf16_t* dst = p.wt_lru + (size_t)((((l * 2 + dir) * 4 + blk) * 2 + mat)) * 4096;
        transpose_tile(src, dst, 64, 64, smem);
      }
    }
  }
}

DEV void ln_mod_phase(const Params& p, int l, int mode) {
  const int lane = threadIdx.x & 63, w = threadIdx.x >> 6;
  const float* lg = nullptr; const float* lb = nullptr;
  if (mode == 1) { lg = p.ln2_g + (l - 1) * 1024; lb = p.ln2_b + (l - 1) * 1024; }
  else if (mode == 2) { lg = p.ln1_g + l * 1024; lb = p.ln1_b + l * 1024; }
  else if (mode == 3) { lg = p.ln2_g + l * 1024; lb = p.ln2_b + l * 1024; }
  const int shoff = (mode == 2) ? 3072 : 0;
  const int mstride = gridDim.x * 8;
  float4 nv[4];
  {
    const int m = blockIdx.x * 8 + w;
    const float* src = (mode == 0) ? ((m < 8192) ? p.x_prompt + (size_t)m * 1024 : p.x_sample + (size_t)(m - 8192) * 1024) : p.out + (size_t)m * 1024;
#pragma unroll
    for (int i = 0; i < 4; ++i) nv[i] = *(const float4*)(src + i * 256 + lane * 4);
  }
  for (int m = blockIdx.x * 8 + w; m < MT; m += mstride) {
    float4 v[4];
#pragma unroll
    for (int i = 0; i < 4; ++i) v[i] = nv[i];
    {
      const int mn = (m + mstride < MT) ? m + mstride : m;
      const float* src = (mode == 0) ? ((mn < 8192) ? p.x_prompt + (size_t)mn * 1024 : p.x_sample + (size_t)(mn - 8192) * 1024) : p.out + (size_t)mn * 1024;
#pragma unroll
      for (int i = 0; i < 4; ++i) nv[i] = *(const float4*)(src + i * 256 + lane * 4);
    }
    if (mode != 0) {
      float s = 0.f;
#pragma unroll
      for (int i = 0; i < 4; ++i) s += v[i].x + v[i].y + v[i].z + v[i].w;
      const float mean = wave_sum(s) * (1.f / 1024.f);
      float s2 = 0.f;
#pragma unroll
      for (int i = 0; i < 4; ++i) { float a = v[i].x - mean, b = v[i].y - mean, c = v[i].z - mean, d = v[i].w - mean; s2 += a * a + b * b + c * c + d * d; }
      const float rstd = rsqrtf(wave_sum(s2) * (1.f / 1024.f) + 1e-6f);
#pragma unroll
      for (int i = 0; i < 4; ++i) {
        float4 g = *(const float4*)(lg + i * 256 + lane * 4), b = *(const float4*)(lb + i * 256 + lane * 4);
        v[i].x = (v[i].x - mean) * rstd * g.x + b.x; v[i].y = (v[i].y - mean) * rstd * g.y + b.y;
        v[i].z = (v[i].z - mean) * rstd * g.z + b.z; v[i].w = (v[i].w - mean) * rstd * g.w + b.w;
        *(float4*)(p.out + (size_t)m * 1024 + i * 256 + lane * 4) = v[i];
      }
    }
    if (mode != 3) {
      const float* md = p.mod + ((size_t)l * 9 + cond_of(m)) * 6144 + shoff;
#pragma unroll
      for (int i = 0; i < 4; ++i) {
        float4 sh = *(const float4*)(md + i * 256 + lane * 4), sc = *(const float4*)(md + 1024 + i * 256 + lane * 4);
        uint2 o;
        o.x = pack2(v[i].x * (1.f + sc.x) + sh.x, v[i].y * (1.f + sc.y) + sh.y);
        o.y = pack2(v[i].z * (1.f + sc.z) + sh.z, v[i].w * (1.f + sc.w) + sh.w);
        *(uint2*)(p.abuf + (size_t)m * 1024 + i * 256 + lane * 4) = o;
      }
    }
  }
}

#define LAS3 __attribute__((address_space(3)))
namespace g8 {
constexpr int BM = 256, BK = 64, HALF = 128, HTB = HALF * BK * 2, NXCD = 8, WGM = 8;
DEV int lds_byte(int r, int c) { const int st = (r >> 4) * 2 + (c >> 5), rr = r & 15, cc = c & 31, ob = rr * 64 + cc * 2; return st * 1024 + (ob ^ (((ob >> 9) & 1) << 5)); }
DEV void stage_rc(int b, int& R, int& C) { const int st = b / 1024, sb = b % 1024, swz = sb ^ (((sb >> 9) & 1) << 5); R = (st >> 1) * 16 + swz / 64; C = (st & 1) * 32 + (swz % 64) / 2; }
DEV bool unit_of(int i, int nM, int nN, int& pm, int& pn) {
  const int nwg = nM * nN;
  const long L = (long)i * gridDim.x + blockIdx.x; if (L >= nwg) return false;
  int wgid = (int)L; { const int q = nwg / NXCD, r = nwg % NXCD, xcd = wgid % NXCD, off = wgid / NXCD; wgid = (xcd < r ? xcd * (q + 1) : r * (q + 1) + (xcd - r) * q) + off; }
  const int nig = WGM * nN, gid = wgid / nig, fm = gid * WGM, gsz = (nM - fm) < WGM ? (nM - fm) : WGM;
  pm = fm + ((wgid % nig) % gsz); pn = (wgid % nig) / gsz; return true;
}
}

template <int EPI>
DEV void gemm_epilogue(const Params& p, int l, f32x4 (&acc)[2][2][4][2], int pm, int pn, int wr, int wc, int fr, int fq) {
  const int brow = pm * 256, bcol = pn * 256;
  const float* md = p.mod + ((size_t)l * 9 + cond_of(brow)) * 6144;
#pragma unroll
  for (int bj = 0; bj < 2; ++bj)
#pragma unroll
    for (int n = 0; n < 2; ++n) {
      const int col = bcol + bj * 128 + wc * 32 + n * 16 + fq * 4;
      float4 gate = make_float4(0.f, 0.f, 0.f, 0.f), bias = make_float4(0.f, 0.f, 0.f, 0.f);
      if (EPI == 2) gate = *(const float4*)(md + 2048 + col);
      if (EPI == 3) bias = *(const float4*)(p.b_ff1 + l * 4096 + col);
      if (EPI == 4) { gate = *(const float4*)(md + 5120 + col); bias = *(const float4*)(p.b_ff2 + l * 1024 + col); }
#pragma unroll
      for (int ai = 0; ai < 2; ++ai)
#pragma unroll
        for (int m = 0; m < 4; ++m) {
          const int row = brow + ai * 128 + wr * 64 + m * 16 + fr;
          const f32x4 v = acc[ai][bj][m][n];
          if (EPI == 1) {
            uint2 o; o.x = pack2(v[0], v[1]); o.y = pack2(v[2], v[3]);
            *(uint2*)(p.zf + (size_t)row * 1792 + col) = o;
          } else if (EPI == 2) {
            const float* xs = (l == 0) ? ((row < 8192) ? p.x_prompt + (size_t)row * 1024 : p.x_sample + (size_t)(row - 8192) * 1024) : p.out + (size_t)row * 1024;
            const float4 x = *(const float4*)(xs + col);
            *(float4*)(p.out + (size_t)row * 1024 + col) = make_float4(ALPHA * x.x + gate.x * v[0], ALPHA * x.y + gate.y * v[1], ALPHA * x.z + gate.z * v[2], ALPHA * x.w + gate.w * v[3]);
          } else if (EPI == 3) {
            const float t0 = fmaxf(v[0] + bias.x, 0.f), t1 = fmaxf(v[1] + bias.y, 0.f), t2 = fmaxf(v[2] + bias.z, 0.f), t3 = fmaxf(v[3] + bias.w, 0.f);
            uint2 o; o.x = pack2(t0 * t0, t1 * t1); o.y = pack2(t2 * t2, t3 * t3);
            *(uint2*)(p.zf + (size_t)row * 4096 + col) = o;
          } else {
            float* xo = p.out + (size_t)row * 1024 + col;
            const float4 x = *(const float4*)xo;
            *(float4*)xo = make_float4(ALPHA * x.x + gate.x * (v[0] + bias.x), ALPHA * x.y + gate.y * (v[1] + bias.y), ALPHA * x.z + gate.z * (v[2] + bias.z), ALPHA * x.w + gate.w * (v[3] + bias.w));
          }
        }
    }
}

template <int EPI>
DEV void gemm_phase(const Params& p, int l, const bf16_t* Ag, const bf16_t* Btg, int N, int K, LAS3 unsigned char* lds) {
  using namespace g8;
  const int tid = threadIdx.x, wid = __builtin_amdgcn_readfirstlane(tid >> 6), lane = tid & 63, wr = wid >> 2, wc = wid & 3, fr = lane & 15, fq = lane >> 4;
  const int nt = K / BK, nM = MT / BM, nN = N / BM;
  unsigned voff[2];
#pragma unroll
  for (int i = 0; i < 2; ++i) { int R, C; stage_rc(tid * 16 + i * 8192, R, C); voff[i] = (unsigned)(R * K + C) * 2u; }
  const size_t kstep = (size_t)(BK * 2);
  const size_t hstep = (size_t)HALF * K * 2;
  const size_t tstep = 2 * hstep;
  const unsigned ldsw = (unsigned)wid * 1024u;
  const int aoff = lds_byte(wr * 64 + fr, fq * 8), boff = lds_byte(wc * 32 + fr, fq * 8);
#define PG8_SA(b, h) (((b) * 2 + (h)) * HTB)
#define PG8_SB(b, h) ((4 + (b) * 2 + (h)) * HTB)
#define PG8_STAGE(bufoff, gbase) do { _Pragma("unroll") for (int _i = 0; _i < 2; ++_i) \
    __builtin_amdgcn_global_load_lds((const unsigned*)((const char*)(gbase) + voff[_i]), (LAS3 unsigned*)(lds + (bufoff) + ldsw + _i * 8192), 16, 0, 0); } while (0)
#define PG8_LDA(dst, b, h) do { _Pragma("unroll") for (int m = 0; m < 4; ++m) _Pragma("unroll") for (int k = 0; k < 2; ++k) dst[m][k] = *(const LAS3 bf16x8*)(lds + PG8_SA(b, h) + aoff + m * 2048 + k * 1024); } while (0)
#define PG8_LDB(dst, b, h) do { _Pragma("unroll") for (int n = 0; n < 2; ++n) _Pragma("unroll") for (int k = 0; k < 2; ++k) dst[n][k] = *(const LAS3 bf16x8*)(lds + PG8_SB(b, h) + boff + n * 2048 + k * 1024); } while (0)
#define PG8_MMA(ai, bj, At_, Bt_) do { __builtin_amdgcn_s_setprio(1); _Pragma("unroll") for (int m = 0; m < 4; ++m) _Pragma("unroll") for (int n = 0; n < 2; ++n) _Pragma("unroll") for (int k = 0; k < 2; ++k) \
    acc[ai][bj][m][n] = __builtin_amdgcn_mfma_f32_16x16x32_bf16(Bt_[n][k], At_[m][k], acc[ai][bj][m][n], 0, 0, 0); __builtin_amdgcn_s_setprio(0); } while (0)
#define PG8_WAIT_V(n) asm volatile("s_waitcnt vmcnt(" #n ")" ::: "memory")
#define PG8_WAIT_L(n) asm volatile("s_waitcnt lgkmcnt(" #n ")" ::: "memory")
#define PG8_BAR __builtin_amdgcn_s_barrier()
#define PG8_SCHED __builtin_amdgcn_sched_barrier(0)
  int cpm, cpn, npm = 0, npn = 0, ui = 0;
  if (!unit_of(0, nM, nN, cpm, cpn)) return;
  f32x4 acc[2][2][4][2];
#pragma unroll
  for (int a = 0; a < 2; ++a)
#pragma unroll
    for (int b = 0; b < 2; ++b)
#pragma unroll
      for (int m = 0; m < 4; ++m)
#pragma unroll
        for (int n = 0; n < 2; ++n) acc[a][b][m][n] = (f32x4){0.f, 0.f, 0.f, 0.f};
  bf16x8 At[4][2], B0[2][2], B1[2][2];
  const char* cA = (const char*)Ag + (size_t)cpm * tstep; const char* cB = (const char*)Btg + (size_t)cpn * tstep;
  PG8_STAGE(PG8_SB(0, 0), cB); PG8_STAGE(PG8_SA(0, 0), cA); PG8_STAGE(PG8_SB(0, 1), cB + hstep); PG8_STAGE(PG8_SA(0, 1), cA + hstep);
  if (wr == 1) PG8_BAR;
  PG8_WAIT_V(4); PG8_BAR;
  PG8_STAGE(PG8_SB(1, 0), cB + kstep); PG8_STAGE(PG8_SA(1, 0), cA + kstep); PG8_STAGE(PG8_SB(1, 1), cB + hstep + kstep);
  PG8_WAIT_V(6); PG8_BAR;
  for (;;) {
    const bool has_next = unit_of(ui + 1, nM, nN, npm, npn);
    const char* nA = has_next ? (const char*)Ag + (size_t)npm * tstep : cA; const char* nB = has_next ? (const char*)Btg + (size_t)npn * tstep : cB;
    for (int t = 0; t < nt; t += 2) {
      const bool last = (t == nt - 2);
      const char* a1 = cA + (size_t)(t + 1) * kstep;
      const char* a2 = last ? nA : cA + (size_t)(t + 2) * kstep; const char* b2 = last ? nB : cB + (size_t)(t + 2) * kstep;
      const char* a3 = a2 + kstep; const char* b3 = b2 + kstep;
      PG8_LDB(B0, 0, 0); PG8_SCHED; PG8_LDA(At, 0, 0); PG8_STAGE(PG8_SA(1, 1), a1 + hstep);
      PG8_WAIT_L(8); PG8_BAR; PG8_WAIT_L(0); PG8_MMA(0, 0, At, B0); PG8_BAR; PG8_SCHED;
      PG8_LDB(B1, 0, 1); PG8_STAGE(PG8_SB(0, 0), b2);
      PG8_BAR; PG8_WAIT_L(0); PG8_MMA(0, 1, At, B1); PG8_BAR;
      PG8_LDA(At, 0, 1); PG8_STAGE(PG8_SA(0, 0), a2);
      PG8_BAR; PG8_WAIT_L(0); PG8_MMA(1, 0, At, B0); PG8_BAR; PG8_SCHED;
      PG8_STAGE(PG8_SB(0, 1), b2 + hstep);
      PG8_WAIT_V(6); PG8_BAR; PG8_MMA(1, 1, At, B1); PG8_BAR;
      PG8_LDB(B0, 1, 0); PG8_SCHED; PG8_LDA(At, 1, 0); PG8_STAGE(PG8_SA(0, 1), a2 + hstep);
      PG8_WAIT_L(8); PG8_BAR; PG8_WAIT_L(0); PG8_MMA(0, 0, At, B0); PG8_BAR; PG8_SCHED;
      PG8_LDB(B1, 1, 1); PG8_STAGE(PG8_SB(1, 0), b3);
      PG8_BAR; PG8_WAIT_L(0); PG8_MMA(0, 1, At, B1); PG8_BAR;
      PG8_LDA(At, 1, 1); PG8_STAGE(PG8_SA(1, 0), a3);
      PG8_BAR; PG8_WAIT_L(0); PG8_MMA(1, 0, At, B0); PG8_BAR; PG8_SCHED;
      PG8_STAGE(PG8_SB(1, 1), b3 + hstep);
      PG8_WAIT_V(6); PG8_BAR; PG8_MMA(1, 1, At, B1); PG8_BAR;
    }
    gemm_epilogue<EPI>(p, l, acc, cpm, cpn, wr, wc, fr, fq);
    if (!has_next) break;
#pragma unroll
    for (int a = 0; a < 2; ++a)
#pragma unroll
      for (int b = 0; b < 2; ++b)
#pragma unroll
        for (int m = 0; m < 4; ++m)
#pragma unroll
          for (int n = 0; n < 2; ++n) acc[a][b][m][n] = (f32x4){0.f, 0.f, 0.f, 0.f};
    cpm = npm; cpn = npn; cA = nA; cB = nB; ++ui;
  }
  PG8_WAIT_V(0);
  if (wr == 0) PG8_BAR;
  PG8_BAR;
#undef PG8_SA
#undef PG8_SB
#undef PG8_STAGE
#undef PG8_LDA
#undef PG8_LDB
#undef PG8_MMA
#undef PG8_WAIT_V
#undef PG8_WAIT_L
#undef PG8_BAR
#undef PG8_SCHED
}

DEV void rope8(float (&v)[8], int d0, int prow, int pcol, const float* __restrict__ rope) {
  const int pp = (d0 < 32) ? prow : pcol;
#pragma unroll
  for (int i = 0; i < 4; ++i) {
    const int f = ((d0 >> 1) + i) & 15;
    const float cs = rope[(pp * 16 + f) * 2], sn = rope[(pp * 16 + f) * 2 + 1];
    const float x1 = v[2 * i], x2 = v[2 * i + 1];
    v[2 * i] = x1 * cs - x2 * sn; v[2 * i + 1] = x1 * sn + x2 * cs;
  }
}

DEV void prep_token_row(const Params& p, int l, int m, int lane, uint4 c1, uint4 c2, uint4 c3) {
  bf16_t* zr = p.zf + (size_t)m * 1792;
  const bool lat = m >= 8192;
  const int pos = lat ? ((m - 8192) & 1023) : (m & 255);
  const int prow = pos >> 6, pcol = pos & 63;
  const int d0 = (lane & 7) * 8;
  {
    U8 u; u.u = c1;
    float v[8]; float ss = 0.f;
#pragma unroll
    for (int j = 0; j < 8; ++j) { v[j] = bf2f(u.h[j]); ss += v[j] * v[j]; }
    ss += __shfl_xor(ss, 1); ss += __shfl_xor(ss, 2); ss += __shfl_xor(ss, 4);
    const float rinv = rsqrtf(ss * (1.f / 64.f) + 1e-6f);
#pragma unroll
    for (int j = 0; j < 8; ++j) v[j] = v[j] * rinv * p.q_g[l * 64 + d0 + j];
    if (lat) rope8(v, d0, prow, pcol, p.rope);
#pragma unroll
    for (int j = 0; j < 4; ++j) u.w[j] = pack2(v[2 * j] * QSCALE, v[2 * j + 1] * QSCALE);
    *(uint4*)(zr + lane * 8) = u.u;
  }
  {
    const int col = lane < 32 ? 512 + lane * 8 : 1024 + (lane - 32) * 8;
    U8 u; u.u = c2;
    float v[8]; float ss = 0.f;
#pragma unroll
    for (int j = 0; j < 8; ++j) { v[j] = bf2f(u.h[j]); ss += v[j] * v[j]; }
    ss += __shfl_xor(ss, 1); ss += __shfl_xor(ss, 2); ss += __shfl_xor(ss, 4);
    if (lane < 16) {
      const float rinv = rsqrtf(ss * (1.f / 64.f) + 1e-6f);
#pragma unroll
      for (int j = 0; j < 8; ++j) v[j] = v[j] * rinv * p.k_g[l * 64 + d0 + j];
      if (!lat) {
        float* o = p.out + OFF_YK + ((((size_t)(m >> 8)) * 2 + l) * 256 + pos) * 128 + lane * 8;
        *(float4*)o = make_float4(v[0], v[1], v[2], v[3]); *(float4*)(o + 4) = make_float4(v[4], v[5], v[6], v[7]);
      } else rope8(v, d0, prow, pcol, p.rope);
#pragma unroll
      for (int j = 0; j < 4; ++j) u.w[j] = pack2(v[2 * j], v[2 * j + 1]);
      const int kvh = lane >> 3;
      bf16_t* kd = lat ? p.kb_lat + ((size_t)((l * 8 + ((m - 8192) >> 10)) * 2 + kvh) * 1280 + 256 + pos) * 64 + d0
                       : p.kb_ctx + ((size_t)((m >> 8) * 2 + kvh) * 256 + pos) * 64 + d0;
      *(uint4*)kd = u.u;
    } else if (lane < 32) {
      if (!lat) {
        float* o = p.out + OFF_YV + ((((size_t)(m >> 8)) * 2 + l) * 256 + pos) * 128 + (lane - 16) * 8;
        *(float4*)o = make_float4(v[0], v[1], v[2], v[3]); *(float4*)(o + 4) = make_float4(v[4], v[5], v[6], v[7]);
      }
      const int kvh = (lane - 16) >> 3;
      bf16_t* vd; int T;
      if (lat) { T = 1280; vd = p.vt_lat + ((size_t)((l * 8 + ((m - 8192) >> 10)) * 2 + kvh) * 64 + d0) * 1280 + 256 + pos; }
      else { T = 256; vd = p.vt_ctx + ((size_t)((m >> 8) * 2 + kvh) * 64 + d0) * 256 + pos; }
#pragma unroll
      for (int j = 0; j < 8; ++j) vd[(size_t)j * T] = u.h[j];
    } else {
#pragma unroll
      for (int j = 0; j < 4; ++j) u.w[j] = pack2(gelu_t(v[2 * j]), gelu_t(v[2 * j + 1]));
      *(uint4*)(zr + col) = u.u;
    }
  }
  {
    const int col = 1280 + lane * 8;
    U8 u; u.u = c3;
    float v[8]; float s = 0.f;
#pragma unroll
    for (int j = 0; j < 8; ++j) { v[j] = gelu_t(bf2f(u.h[j])); s += v[j]; }
#pragma unroll
    for (int o = 1; o <= 16; o <<= 1) s += __shfl_xor(s, o);
    const float mean = s * (1.f / 256.f);
    float s2 = 0.f;
#pragma unroll
    for (int j = 0; j < 8; ++j) { float d = v[j] - mean; s2 += d * d; }
#pragma unroll
    for (int o = 1; o <= 16; o <<= 1) s2 += __shfl_xor(s2, o);
    if (lane >= 32) {
      const float rstd = rsqrtf(s2 * (1.f / 256.f) + 1e-6f);
      const int ch = (lane - 32) * 8;
#pragma unroll
      for (int j = 0; j < 8; ++j) v[j] = (v[j] - mean) * rstd * p.mlp_g[l * 256 + ch + j] + p.mlp_b[l * 256 + ch + j];
    }
#pragma unroll
    for (int j = 0; j < 4; ++j) u.w[j] = pack2(v[2 * j], v[2 * j + 1]);
    *(uint4*)(zr + col) = u.u;
  }
}

template <bool REV>
DEV void tile_scan(float (&a)[4][4], float (&u)[4][4], int lane) {
  const int q = lane >> 4;
  float C = 0.f, CP = 1.f;
  const int src1 = (REV ? lane + 16 : lane - 16) & 63;
  const int src2 = (REV ? lane + 32 : lane - 32) & 63;
  const int srcT = (lane & 15) + (REV ? 0 : 48);
  const bool c1 = REV ? (q <= 2) : (q >= 1);
  const bool c2 = REV ? (q <= 1) : (q >= 2);
  const bool first = REV ? (q == 3) : (q == 0);
#pragma unroll
  for (int mi = 0; mi < 4; ++mi) {
    const int mt = REV ? 3 - mi : mi;
    float P = 1.f, H = 0.f, pl[4], hl[4];
#pragma unroll
    for (int ri = 0; ri < 4; ++ri) {
      const int r = REV ? 3 - ri : ri;
      H = a[mt][r] * H + u[mt][r]; P *= a[mt][r]; pl[r] = P; hl[r] = H;
    }
    float Pi = P, Hi = H;
    float Pp = __shfl(Pi, src1), Hp = __shfl(Hi, src1);
    if (c1) { Hi = Pi * Hp + Hi; Pi = Pi * Pp; }
    Pp = __shfl(Pi, src2); Hp = __shfl(Hi, src2);
    if (c2) { Hi = Pi * Hp + Hi; Pi = Pi * Pp; }
    float Pe = __shfl(Pi, src1), He = __shfl(Hi, src1);
    if (first) { Pe = 1.f; He = 0.f; }
    const float hin = Pe * C + He, pin = Pe * CP;
#pragma unroll
    for (int r = 0; r < 4; ++r) { u[mt][r] = pl[r] * hin + hl[r]; a[mt][r] = pl[r] * pin; }
    const float Pt = __shfl(Pi, srcT), Ht = __shfl(Hi, srcT);
    C = Pt * C + Ht; CP = Pt * CP;
  }
}

DEV void lru_gate_item(const Params& p, int l, int item, char* smem) {
  const int tid = VTID, lane = tid & 63, w = tid >> 6;
  const int tile = item >> 2, blk = item & 3;
  const int m0 = tile * 64;
  int ms, L;
  if (m0 < 8192) { ms = m0 & ~255; L = 256; } else { ms = 8192 + ((m0 - 8192) & ~1023); L = 1024; }
  float* xs = (float*)smem;
  float* xcf = xs + 67 * 64;
  bf16_t* xcb = (bf16_t*)(xcf + 64 * 64);
  for (int idx = tid; idx < 67 * 8; idx += 256) {
    const int rr = idx >> 3, cc = idx & 7;
    const int m = m0 - 1 + rr;
    float v[8];
    if (m >= ms && m < ms + L) {
      U8 u; u.u = *(const uint4*)(p.zf + (size_t)m * 1792 + 768 + blk * 64 + cc * 8);
#pragma unroll
      for (int j = 0; j < 8; ++j) v[j] = bf2f(u.h[j]);
    } else {
#pragma unroll
      for (int j = 0; j < 8; ++j) v[j] = 0.f;
    }
#pragma unroll
    for (int j = 0; j < 8; ++j) xs[rr * 64 + cc * 8 + j] = v[j];
  }
  __syncthreads();
  {
    const int ch = tid & 63, Cg = blk * 64 + ch;
    const float w0 = p.conv_w[(l * 4 + 0) * 256 + Cg], w1 = p.conv_w[(l * 4 + 1) * 256 + Cg], w2 = p.conv_w[(l * 4 + 2) * 256 + Cg],
                w3 = p.conv_w[(l * 4 + 3) * 256 + Cg], cb = p.conv_b[l * 256 + Cg];
#pragma unroll 4
    for (int tt = 0; tt < 16; ++tt) {
      const int t = (tid >> 6) * 16 + tt;
      const float v = cb + w0 * xs[t * 64 + ch] + w1 * xs[(t + 1) * 64 + ch] + w2 * xs[(t + 2) * 64 + ch] + w3 * xs[(t + 3) * 64 + ch];
      xcf[t * 64 + ch] = v; xcb[t * 72 + ch] = f2bf(v);
    }
  }
  __syncthreads();
  const int dir = w >> 1, half = w & 1, q = lane >> 4, c15 = lane & 15;
  const bf16_t* wt = p.wt_lru + (size_t)((((l * 2 + dir) * 4 + blk) * 2)) * 4096;
  bf16x8 bfr[2][2][2];
#pragma unroll
  for (int mat = 0; mat < 2; ++mat)
#pragma unroll
    for (int j = 0; j < 2; ++j)
#pragma unroll
      for (int s = 0; s < 2; ++s) bfr[mat][j][s] = *(const bf16x8*)(wt + mat * 4096 + (half * 32 + j * 16 + c15) * 64 + s * 32 + q * 8);
  f32x4 acc[2][4][2];
#pragma unroll
  for (int mat = 0; mat < 2; ++mat)
#pragma unroll
    for (int mt = 0; mt < 4; ++mt)
#pragma unroll
      for (int j = 0; j < 2; ++j) acc[mat][mt][j] = f32x4{0.f, 0.f, 0.f, 0.f};
#pragma unroll
  for (int mt = 0; mt < 4; ++mt)
#pragma unroll
    for (int s = 0; s < 2; ++s) {
      const bf16x8 af = *(const bf16x8*)(xcb + (mt * 16 + c15) * 72 + s * 32 + q * 8);
#pragma unroll
      for (int mat = 0; mat < 2; ++mat)
#pragma unroll
        for (int j = 0; j < 2; ++j) acc[mat][mt][j] = mfma16(af, bfr[mat][j][s], acc[mat][mt][j]);
    }
  float* PCp = p.au + (size_t)(dir * 2 + 0) * MT * 256;
  float* HLp = p.au + (size_t)(dir * 2 + 1) * MT * 256;
#pragma unroll
  for (int j = 0; j < 2; ++j) {
    const int ch = half * 32 + j * 16 + c15, Cg = blk * 64 + ch, pidx = (l * 2 + dir) * 256 + Cg;
    const float ba = p.lru_ba[pidx], bx = p.lru_bx[pidx], lam = p.lru_lam[pidx];
    const float xn = -lam;
    const float sp = fmaxf(xn, 0.f) + log1pf(expf(-fabsf(xn)));
    const float cdec = -8.f * sp;
    float a[4][4], u[4][4];
#pragma unroll
    for (int mt = 0; mt < 4; ++mt)
#pragma unroll
      for (int r = 0; r < 4; ++r) {
        const int t = mt * 16 + q * 4 + r;
        const float rg = sigmoidf_(acc[0][mt][j][r] + ba), ig = sigmoidf_(acc[1][mt][j][r] + bx);
        const float la = cdec * rg;
        a[mt][r] = __expf(la);
        u[mt][r] = sqrtf(-expm1f(2.f * la)) * ig * xcf[t * 64 + ch];
      }
    if (dir == 0) tile_scan<false>(a, u, lane); else tile_scan<true>(a, u, lane);
#pragma unroll
    for (int mt = 0; mt < 4; ++mt)
#pragma unroll
      for (int r = 0; r < 4; ++r) {
        const size_t m = m0 + mt * 16 + q * 4 + r;
        PCp[m * 256 + Cg] = a[mt][r]; HLp[m * 256 + Cg] = u[mt][r];
      }
  }
  __syncthreads();
}

DEV void attn_item(const Params& p, int l, int it, char* sm) {
  const int tid = threadIdx.x, lane = tid & 63, w = tid >> 6, q = lane >> 4, c15 = lane & 15;
  int h, ms, nkt, T; const bf16_t* Kg; const bf16_t* Vg;
  if (it < 512) {
    const int b = it >> 6, qb = it & 7; h = (it >> 3) & 7; ms = 8192 + b * 1024 + qb * 128; nkt = 10; T = 1280;
    Kg = p.kb_lat + (size_t)((l * 8 + b) * 2 + (h >> 2)) * 1280 * 64; Vg = p.vt_lat + (size_t)((l * 8 + b) * 2 + (h >> 2)) * 64 * 1280;
  } else {
    const int i2 = it - 512, b = i2 >> 4, qb = i2 & 1; h = (i2 >> 1) & 7; ms = b * 256 + qb * 128; nkt = 2; T = 256;
    Kg = p.kb_ctx + (size_t)(b * 2 + (h >> 2)) * 256 * 64; Vg = p.vt_ctx + (size_t)(b * 2 + (h >> 2)) * 64 * 256;
  }
  const int kc0 = tid, kc1 = tid + 512;
  const int vd0 = tid >> 4, vk = (tid & 15) * 8;
  const int vpos = ((tid & 15) >> 2) * 32 + 16 * (tid & 1) + 4 * ((tid & 3) >> 1);
  const bf16_t* vg0 = Vg + (size_t)vd0 * T + vk;
  const bf16_t* vg1 = Vg + (size_t)(vd0 + 32) * T + vk;
  uint4 rk0, rk1, rv0, rv1;
#define ATT_LOAD(kt) do { rk0 = *(const uint4*)(Kg + (size_t)(kt) * 8192 + kc0 * 8); rk1 = *(const uint4*)(Kg + (size_t)(kt) * 8192 + kc1 * 8); \
    rv0 = *(const uint4*)(vg0 + (kt) * 128); rv1 = *(const uint4*)(vg1 + (kt) * 128); } while (0)
#define ATT_STORE(buf) do { bf16_t* Ks_ = (bf16_t*)(sm + (buf) * 36864); bf16_t* Vs_ = Ks_ + 9216; \
    *(uint4*)(Ks_ + (kc0 >> 3) * 72 + (kc0 & 7) * 8) = rk0; *(uint4*)(Ks_ + (kc1 >> 3) * 72 + (kc1 & 7) * 8) = rk1; \
    *(uint2*)(Vs_ + vd0 * 136 + vpos) = make_uint2(rv0.x, rv0.y); *(uint2*)(Vs_ + vd0 * 136 + vpos + 8) = make_uint2(rv0.z, rv0.w); \
    *(uint2*)(Vs_ + (vd0 + 32) * 136 + vpos) = make_uint2(rv1.x, rv1.y); *(uint2*)(Vs_ + (vd0 + 32) * 136 + vpos + 8) = make_uint2(rv1.z, rv1.w); } while (0)
  ATT_LOAD(0);
  const int mq = ms + w * 16;
  bf16x8 qf[2];
#pragma unroll
  for (int s = 0; s < 2; ++s) qf[s] = *(const bf16x8*)(p.zf + (size_t)(mq + c15) * 1792 + h * 64 + s * 32 + q * 8);
  ATT_STORE(0);
  if (nkt > 1) ATT_LOAD(1);
  __syncthreads();
  f32x4 o[4];
  float mrow = -1e30f, lrow = 0.f;
#pragma unroll
  for (int j = 0; j < 4; ++j) o[j] = f32x4{0.f, 0.f, 0.f, 0.f};
  for (int kt = 0; kt < nkt; ++kt) {
    const int cur = kt & 1;
    const bf16_t* Ks = (const bf16_t*)(sm + cur * 36864);
    const bf16_t* Vs = Ks + 9216;
    f32x4 s4[8];
    {
      bf16x8 kf[8][2];
#pragma unroll
      for (int jn = 0; jn < 8; ++jn)
#pragma unroll
        for (int s = 0; s < 2; ++s) kf[jn][s] = *(const bf16x8*)(Ks + (jn * 16 + c15) * 72 + s * 32 + q * 8);
      __builtin_amdgcn_sched_barrier(0);
#pragma unroll
      for (int jn = 0; jn < 8; ++jn) s4[jn] = mfma16(kf[jn][0], qf[0], f32x4{0.f, 0.f, 0.f, 0.f});
#pragma unroll
      for (int jn = 0; jn < 8; ++jn) s4[jn] = mfma16(kf[jn][1], qf[1], s4[jn]);
      __builtin_amdgcn_sched_barrier(0);
    }
    U8 vf[4][4];
#pragma unroll
    for (int jn = 0; jn < 4; ++jn)
#pragma unroll
      for (int ks = 0; ks < 4; ++ks) {
        vf[jn][ks].u = *(const uint4*)(Vs + (jn * 16 + c15) * 136 + ks * 32 + q * 8);
      }
    __builtin_amdgcn_sched_barrier(0);
    float mx = s4[0][0];
#pragma unroll
    for (int jn = 0; jn < 8; ++jn)
#pragma unroll
      for (int r = 0; r < 4; ++r) mx = fmaxf(mx, s4[jn][r]);
    mx = fmaxf(mx, __shfl_xor(mx, 16)); mx = fmaxf(mx, __shfl_xor(mx, 32));
    const float mnew = fmaxf(mrow, mx);
    const float alpha = __builtin_amdgcn_exp2f(mrow - mnew);
    mrow = mnew;
    float ls = 0.f;
#pragma unroll
    for (int jn = 0; jn < 8; ++jn)
#pragma unroll
      for (int r = 0; r < 4; ++r) { const float pv = __builtin_amdgcn_exp2f(s4[jn][r] - mnew); s4[jn][r] = pv; ls += pv; }
    lrow = lrow * alpha + ls;
#pragma unroll
    for (int jn = 0; jn < 4; ++jn) { o[jn][0] *= alpha; o[jn][1] *= alpha; o[jn][2] *= alpha; o[jn][3] *= alpha; }
    U8 pb[4];
#pragma unroll
    for (int ks = 0; ks < 4; ++ks) {
      pb[ks].w[0] = pack2(s4[2 * ks][0], s4[2 * ks][1]); pb[ks].w[1] = pack2(s4[2 * ks][2], s4[2 * ks][3]);
      pb[ks].w[2] = pack2(s4[2 * ks + 1][0], s4[2 * ks + 1][1]); pb[ks].w[3] = pack2(s4[2 * ks + 1][2], s4[2 * ks + 1][3]);
    }
#pragma unroll
    for (int ks = 0; ks < 4; ++ks)
#pragma unroll
      for (int jn = 0; jn < 4; ++jn) o[jn] = mfma16(vf[jn][ks].v, pb[ks].v, o[jn]);
    if (kt + 1 < nkt) {
      ATT_STORE(cur ^ 1);
      if (kt + 2 < nkt) ATT_LOAD(kt + 2);
    }
    __syncthreads();
  }
#undef ATT_LOAD
#undef ATT_STORE
  float lt = lrow;
  lt += __shfl_xor(lt, 16); lt += __shfl_xor(lt, 32);
  const float inv = 1.f / lt;
  bf16_t* orow = p.abuf + (size_t)(mq + c15) * 1024 + h * 64 + q * 4;
#pragma unroll
  for (int jn = 0; jn < 4; ++jn) {
    uint2 ov; ov.x = pack2(o[jn][0] * inv, o[jn][1] * inv); ov.y = pack2(o[jn][2] * inv, o[jn][3] * inv);
    *(uint2*)(orow + jn * 16) = ov;
  }
}

DEV void gmlp_item(const Params& p, int l, int it, char* smem) {
  const int tid = VTID, lane = tid & 63, w = tid >> 6, q = lane >> 4, c15 = lane & 15;
  const int chunk = it >> 2, g = it & 3, m0 = chunk * 128;
  bf16_t* vt = (bf16_t*)smem;
#pragma unroll
  for (int i = 0; i < 4; ++i) {
    const int id = tid + 256 * i, qq = id >> 3, cc = id & 7;
    U8 v; v.u = *(const uint4*)(p.zf + (size_t)(m0 + qq) * 1792 + 1536 + g * 64 + cc * 8);
#pragma unroll
    for (int j = 0; j < 8; ++j) vt[(cc * 8 + j) * 136 + qq] = v.h[j];
  }
  __syncthreads();
  f32x4 acc[2][4];
#pragma unroll
  for (int i = 0; i < 2; ++i)
#pragma unroll
    for (int jn = 0; jn < 4; ++jn) acc[i][jn] = f32x4{0.f, 0.f, 0.f, 0.f};
  const float* wsg = p.mlp_ws + (size_t)(l * 4 + g) * 16384;
#pragma unroll
  for (int s = 0; s < 4; ++s) {
    U8 af[2];
#pragma unroll
    for (int i = 0; i < 2; ++i) {
      const float* ap = wsg + (w * 32 + i * 16 + c15) * 128 + s * 32 + q * 8;
      const float4 a0 = *(const float4*)ap, a1 = *(const float4*)(ap + 4);
      af[i].w[0] = pack2(a0.x, a0.y); af[i].w[1] = pack2(a0.z, a0.w); af[i].w[2] = pack2(a1.x, a1.y); af[i].w[3] = pack2(a1.z, a1.w);
    }
#pragma unroll
    for (int jn = 0; jn < 4; ++jn) {
      const bf16x8 bb = *(const bf16x8*)(vt + (jn * 16 + c15) * 136 + s * 32 + q * 8);
#pragma unroll
      for (int i = 0; i < 2; ++i) acc[i][jn] = mfma16(af[i].v, bb, acc[i][jn]);
    }
  }
#pragma unroll
  for (int i = 0; i < 2; ++i)
#pragma unroll
    for (int r = 0; r < 4; ++r) {
      const int pp = w * 32 + i * 16 + q * 4 + r;
      const size_t m = m0 + pp;
      const float bsv = p.mlp_bs[(l * 4 + g) * 128 + pp];
#pragma unroll
      for (int jn = 0; jn < 4; ++jn) {
        const int c = jn * 16 + c15;
        const float uu = bf2f(p.zf[m * 1792 + 1280 + g * 64 + c]);
        p.abuf[m * 1024 + 768 + g * 64 + c] = f2bf(uu * (acc[i][jn][r] + bsv));
      }
    }
  __syncthreads();
}

DEV void lru_apply_item(const Params& p, int l, int ti2) {
  const int C = VTID;
  const int ti = ti2 >> 1, th = (ti2 & 1) * 32;
  const int m0 = ti * 64;
  int ms, L, b; bool lat = m0 >= 8192;
  if (!lat) { ms = m0 & ~255; L = 256; b = m0 >> 8; } else { ms = 8192 + ((m0 - 8192) & ~1023); L = 1024; b = (m0 - 8192) >> 10; }
  const int k = (m0 - ms) >> 6, nt = L >> 6;
  const float* PCf = p.au; const float* HLf = p.au + (size_t)MT * 256;
  const float* PCb = p.au + (size_t)2 * MT * 256; const float* HLb = p.au + (size_t)3 * MT * 256;
  float cf = lat ? p.state_lru[((size_t)(b * 2 + l) * 2 + 0) * 256 + C] : 0.f;
  float cb = lat ? p.state_lru[((size_t)(b * 2 + l) * 2 + 1) * 256 + C] : 0.f;
  {
    float pc[15], hl[15];
#pragma unroll
    for (int i = 0; i < 15; ++i) {
      const bool act = i < k;
      const size_t e = (size_t)(ms + 64 * i + 63) * 256 + C;
      pc[i] = act ? PCf[e] : 1.f; hl[i] = act ? HLf[e] : 0.f;
    }
#pragma unroll
    for (int i = 0; i < 15; ++i) cf = pc[i] * cf + hl[i];
  }
  {
    float pc[15], hl[15];
#pragma unroll
    for (int i = 0; i < 15; ++i) {
      const int tix = nt - 1 - i;
      const bool act = tix > k;
      const size_t e = (size_t)(ms + 64 * tix) * 256 + C;
      pc[i] = act ? PCb[e] : 1.f; hl[i] = act ? HLb[e] : 0.f;
    }
#pragma unroll
    for (int i = 0; i < 15; ++i) cb = pc[i] * cb + hl[i];
  }
  float hf_last = 0.f, hb_first = 0.f;
#pragma unroll 16
  for (int t = th; t < th + 32; ++t) {
    const size_t m = m0 + t;
    const float hf = PCf[m * 256 + C] * cf + HLf[m * 256 + C];
    const float hb = PCb[m * 256 + C] * cb + HLb[m * 256 + C];
    const float g = bf2f(p.zf[m * 1792 + 1024 + C]);
    p.abuf[m * 1024 + 512 + C] = f2bf((hf + hb) * g);
    if (t == 0) hb_first = hb;
    if (t == 63) hf_last = hf;
  }
  if (!lat) {
    if (k == nt - 1 && th == 32) p.out[OFF_ST + ((size_t)(b * 2 + l) * 2 + 0) * 256 + C] = hf_last;
    if (k == 0 && th == 0) p.out[OFF_ST + ((size_t)(b * 2 + l) * 2 + 1) * 256 + C] = hb_first;
  }
}

DEV void mixer_phase(const Params& p, int l, char* smem_raw, char* smem) {
  for (int it = blockIdx.x; it < 1024; it += gridDim.x) attn_item(p, l, it, smem_raw);
  const int NITEMS = 512 + 512;
  for (int it = VBID; it < NITEMS; it += VNB) {
    if (it < 512) lru_apply_item(p, l, it);
    else gmlp_item(p, l, it - 512, smem);
  }
}

DEV void prep_phase_full(const Params& p, int l, char* smem) {
  for (int it = VBID; it < 1024; it += VNB) lru_gate_item(p, l, it, smem);
  const int lane = threadIdx.x & 63, mstride = gridDim.x * 8;
  int m = blockIdx.x * 8 + (threadIdx.x >> 6);
  const int c2off = lane < 32 ? 512 + lane * 8 : 1024 + (lane - 32) * 8;
  uint4 n1, n2, n3;
  { const bf16_t* zr = p.zf + (size_t)m * 1792; n1 = *(const uint4*)(zr + lane * 8); n2 = *(const uint4*)(zr + c2off); n3 = *(const uint4*)(zr + 1280 + lane * 8); }
  for (; m < MT; m += mstride) {
    const uint4 c1 = n1, c2 = n2, c3 = n3;
    const int mn = (m + mstride < MT) ? m + mstride : m;
    { const bf16_t* zr = p.zf + (size_t)mn * 1792; n1 = *(const uint4*)(zr + lane * 8); n2 = *(const uint4*)(zr + c2off); n3 = *(const uint4*)(zr + 1280 + lane * 8); }
    prep_token_row(p, l, m, lane, c1, c2, c3);
  }
}


#define XB_TMO      128
#define XB_XCNT(j)  (256  + 64 * (j))
#define XB_XSUB(j)  (1280 + 64 * (j))
#define XB_XGEN(j)  (2304 + 64 * (j))
#define XB_TOP      3328
#define XB_TOPGEN   3392
#define XCD_BAR_WORDS 3456
#define XB_SPIN_CAP (1u << 18)
#define LAS __attribute__((address_space(3)))
DEV unsigned xb_ld(unsigned* p) { return __hip_atomic_load(p, __ATOMIC_RELAXED, __HIP_MEMORY_SCOPE_AGENT); }
DEV unsigned xb_add(unsigned* p, unsigned v) { return __hip_atomic_fetch_add(p, v, __ATOMIC_RELAXED, __HIP_MEMORY_SCOPE_AGENT); }
DEV unsigned xb_xcc_id() { return (unsigned)__builtin_amdgcn_s_getreg((3 << 11) | 20) & 0xFu; }
#define XB_SPIN(cond, bar) do { unsigned _sp = 0; while (cond) { __builtin_amdgcn_s_sleep(1); \
    if ((++_sp & 255u) == 0u) { if (xb_ld(&(bar)[XB_TMO])) break; if (_sp > XB_SPIN_CAP) { atomicAdd(&(bar)[XB_TMO], 1u); break; } } } } while (0)
struct XcdBarrier { unsigned* bar; unsigned x; volatile LAS unsigned* st; };
DEV XcdBarrier xcd_barrier_post(unsigned* bar, volatile LAS unsigned* st) {
  XcdBarrier b; b.bar = bar; b.x = xb_xcc_id(); b.st = st;
  if (threadIdx.x == 0) (void)xb_add(&bar[XB_XCNT(b.x)], 1u);
  return b;
}
DEV void xcd_barrier_complete(unsigned* bar, unsigned x, unsigned& nloc, unsigned& nx) {
  const unsigned G = gridDim.x * gridDim.y * gridDim.z;
  unsigned sum, cnt, mine, sp = 0u;
  for (;;) {
    sum = 0u; cnt = 0u; mine = 0u;
#pragma unroll
    for (unsigned j = 0; j < 16; ++j) { const unsigned c = xb_ld(&bar[XB_XCNT(j)]); sum += c; cnt += (c > 0u) ? 1u : 0u; mine = (j == x) ? c : mine; }
    if (sum == G) break;
    __builtin_amdgcn_s_sleep(1);
    if ((++sp & 255u) == 0u) { if (xb_ld(&bar[XB_TMO])) break; if (sp > XB_SPIN_CAP) { atomicAdd(&bar[XB_TMO], 1u); break; } }
  }
  nloc = mine > 0u ? mine : 1u; nx = cnt > 0u ? cnt : 1u;
}
DEV void xcd_barrier(const XcdBarrier& b) {
  asm volatile("s_waitcnt vmcnt(0)" ::: "memory");
  __syncthreads();
  if (threadIdx.x == 0) {
    unsigned* bar = b.bar;
    __builtin_amdgcn_s_waitcnt(0);
    unsigned nloc = b.st[0], nx = b.st[1];
    if (nloc == 0u) { xcd_barrier_complete(bar, b.x, nloc, nx); b.st[0] = nloc; b.st[1] = nx; }
    const unsigned old = xb_add(&bar[XB_XSUB(b.x)], 1u);
    const unsigned gen = old / nloc;
    if (old + 1u == (gen + 1u) * nloc) {
      __builtin_amdgcn_fence(__ATOMIC_RELEASE, "agent");
      asm volatile("s_waitcnt vmcnt(0)" ::: "memory");
      const unsigned og = xb_add(&bar[XB_TOP], 1u);
      const unsigned tg = og / nx;
      if (og + 1u == (tg + 1u) * nx) xb_add(&bar[XB_TOPGEN], 1u);
      else XB_SPIN(xb_ld(&bar[XB_TOPGEN]) == tg, bar);
      __builtin_amdgcn_fence(__ATOMIC_ACQUIRE, "agent");
      xb_add(&bar[XB_XGEN(b.x)], 1u);
      asm volatile("s_waitcnt vmcnt(0)" ::: "memory");
    } else {
      XB_SPIN(xb_ld(&bar[XB_XGEN(b.x)]) == gen, bar);
      __builtin_amdgcn_fence(__ATOMIC_ACQUIRE, "agent");
      asm volatile("s_waitcnt vmcnt(0)" ::: "memory");
    }
  }
  __syncthreads();
}

#define PH(i, call) if (ph_lo <= (i) && (i) < ph_hi) { if ((i) > ph_lo) xcd_barrier(xb); call; }
#define LAYER(l, b) \
  PH(b + 0, ln_mod_phase(p, l, l == 0 ? 0 : 1)) \
  PH(b + 1, gemm_phase<1>(p, l, p.abuf, p.wt_in + (size_t)l * 1792 * 1024, 1792, 1024, (LAS3 unsigned char*)smem_raw)) \
  PH(b + 2, prep_phase_full(p, l, smem)) \
  PH(b + 3, mixer_phase(p, l, smem_raw, smem)) \
  PH(b + 4, gemm_phase<2>(p, l, p.abuf, p.wt_out + (size_t)l * 1024 * 1024, 1024, 1024, (LAS3 unsigned char*)smem_raw)) \
  PH(b + 5, ln_mod_phase(p, l, 2)) \
  PH(b + 6, gemm_phase<3>(p, l, p.abuf, p.wt_ff1 + (size_t)l * 4096 * 1024, 4096, 1024, (LAS3 unsigned char*)smem_raw)) \
  PH(b + 7, gemm_phase<4>(p, l, p.zf, p.wt_ff2 + (size_t)l * 1024 * 4096, 1024, 4096, (LAS3 unsigned char*)smem_raw))

__global__ void __launch_bounds__(512, 2) mega_kernel(Params p, int ph_lo, int ph_hi) {
  extern __shared__ __attribute__((aligned(16))) char smem_raw[];
  char* smem = smem_raw + (threadIdx.x >> 8) * 65536;
  __shared__ uint4 xb_words;
  if (threadIdx.x == 0) xb_words = make_uint4(0u, 0u, 0u, 0u);
  __syncthreads();
  XcdBarrier xb = xcd_barrier_post(p.bar, (volatile LAS unsigned*)&xb_words);
  if (ph_hi > 1000) { cg::grid_group grid = cg::this_grid(); grid.sync(); }
  PH(0, phase0(p, smem))
  LAYER(0, 1)
  LAYER(1, 9)
  PH(17, ln_mod_phase(p, 1, 3))
}

extern "C" void kernel_launch(void* const* d_in, const int* in_sizes, int n_in, void* d_out, int out_size, void* d_ws, size_t ws_size,
                              hipStream_t stream) {
  static int grid_blocks = 0;
  if (!grid_blocks) {
    int dev = 0, cus = 0, per_cu = 0;
    hipGetDevice(&dev);
    hipDeviceGetAttribute(&cus, hipDeviceAttributeMultiprocessorCount, dev);
    hipFuncSetAttribute((const void*)mega_kernel, hipFuncAttributeMaxDynamicSharedMemorySize, SMEM_BYTES);
    hipOccupancyMaxActiveBlocksPerMultiprocessor(&per_cu, (const void*)mega_kernel, 512, SMEM_BYTES);
    if (per_cu < 1) per_cu = 1;
    if (per_cu > 1) per_cu = 1;
    grid_blocks = cus * per_cu;
  }
  Params p{};
  const float** pin = (const float**)&p;
  for (int i = 0; i < 32; ++i) pin[i] = (const float*)d_in[i];
  p.out = (float*)d_out;
  char* ws = (char*)d_ws;
  size_t off = 0;
  p.bar = (unsigned*)(ws + off); off += 16384;
  p.kb_lat = (bf16_t*)(ws + off); off += (size_t)2 * 8 * 2 * 1280 * 64 * 2;
  p.vt_lat = (bf16_t*)(ws + off); off += (size_t)2 * 8 * 2 * 1280 * 64 * 2;
  p.kb_ctx = (bf16_t*)(ws + off); off += (size_t)32 * 2 * 256 * 64 * 2;
  p.vt_ctx = (bf16_t*)(ws + off); off += (size_t)32 * 2 * 256 * 64 * 2;
  p.wt_in = (bf16_t*)(ws + off); off += (size_t)2 * 1792 * 1024 * 2;
  p.wt_out = (bf16_t*)(ws + off); off += (size_t)2 * 1024 * 1024 * 2;
  p.wt_ff1 = (bf16_t*)(ws + off); off += (size_t)2 * 4096 * 1024 * 2;
  p.wt_ff2 = (bf16_t*)(ws + off); off += (size_t)2 * 4096 * 1024 * 2;
  p.wt_lru = (bf16_t*)(ws + off); off += (size_t)64 * 4096 * 2;
  p.mod = (float*)(ws + off); off += (size_t)2 * 9 * 6144 * 4;
  p.rope = (float*)(ws + off); off += (size_t)2048 * 4;
  p.abuf = (bf16_t*)(ws + off); off += (size_t)MT * 1024 * 2;
  p.zf = (bf16_t*)(ws + off);
  p.au = (float*)(ws + off + (size_t)MT * 1792 * 2);
  off += (size_t)MT * 4096 * 2;
  if (off > ws_size) { fprintf(stderr, "workspace too small: need %zu have %zu\n", off, ws_size); return; }
  (void)hipMemsetAsync(p.bar, 0, XCD_BAR_WORDS * 4, stream);
#if MULTI_LAUNCH
  for (int ph = 0; ph < NPHASE; ++ph) {
    hipLaunchKernelGGL(mega_kernel, dim3(grid_blocks), dim3(512), SMEM_BYTES, stream, p, ph, ph + 1);
  }
#else
  int lo = 0, hi = NPHASE;
  void* args[] = {&p, &lo, &hi};
  hipError_t e = hipLaunchCooperativeKernel((void*)mega_kernel, dim3(grid_blocks), dim3(512), args, SMEM_BYTES, stream);
  if (e != hipSuccess) fprintf(stderr, "cooperative launch failed: %s (grid %d)\n", hipGetErrorString(e), grid_blocks);
#endif
}
```

```cpp
#include <hip/hip_runtime.h>
#include <hip/hip_cooperative_groups.h>
#include <cstdio>
#include <cstdint>
namespace cg = cooperative_groups;

#ifndef MULTI_LAUNCH
#define MULTI_LAUNCH 0
#endif

typedef unsigned short bf16_t;
using bf16x8 = __attribute__((ext_vector_type(8))) short;
using f32x4 = __attribute__((ext_vector_type(4))) float;
#define DEV __device__ __forceinline__
#define VTID ((int)(threadIdx.x & 255))
#define VBID ((int)(blockIdx.x * 2 + (threadIdx.x >> 8)))
#define VNB ((int)(gridDim.x * 2))

constexpr int MT = 16384;
constexpr int NPHASE = 18;
constexpr size_t OFF_YK = 16777216, OFF_YV = OFF_YK + 2097152, OFF_ST = OFF_YV + 2097152;
constexpr float ALPHA = 1.41421356237f;
constexpr float QSCALE = 0.125f * 1.4426950408889634f;
constexpr int SMEM_BYTES = 131072;

struct Params {
  const float *x_prompt, *x_sample, *c, *cache_k, *cache_v, *state_lru, *c_ctx, *w_ada, *b_ada, *w_in,
      *q_g, *k_g, *conv_w, *conv_b, *lru_wa, *lru_ba, *lru_wx, *lru_bx, *lru_lam, *mlp_g, *mlp_b, *mlp_ws, *mlp_bs,
      *w_out, *ln1_g, *ln1_b, *w_ff1, *b_ff1, *w_ff2, *b_ff2, *ln2_g, *ln2_b;
  float* out;
  bf16_t *wt_in, *wt_out, *wt_ff1, *wt_ff2, *wt_lru;
  float *mod, *rope, *cdec;
  bf16_t *abuf;
  bf16_t *zf;
  float *au;
  bf16_t *kb_lat, *vt_lat;
  bf16_t *kb_ctx, *vt_ctx;
  unsigned *bar;
  float *rstat;
};

union U8 { uint4 u; bf16x8 v; bf16_t h[8]; unsigned w[4]; };

DEV float bf2f(bf16_t h) { return __uint_as_float(((unsigned)h) << 16); }
DEV bf16_t f2bf(float f) { unsigned u = __float_as_uint(f); u += 0x7fffu + ((u >> 16) & 1u); return (bf16_t)(u >> 16); }
DEV unsigned pack2(float a, float b) { unsigned r; asm volatile("v_cvt_pk_bf16_f32 %0, %1, %2" : "=v"(r) : "v"(a), "v"(b)); return r; }
DEV float gelu_t(float x) { float y = 0.7978845608028654f * (x + 0.044715f * x * x * x); float t = 1.f - 2.f * __builtin_amdgcn_rcpf(1.f + __expf(2.f * y)); return 0.5f * x * (1.f + t); }
DEV float sigmoidf_(float x) { return __builtin_amdgcn_rcpf(1.f + __expf(-x)); }
DEV int cond_of(int m) { return m < 8192 ? 0 : 1 + ((m - 8192) >> 10); }
DEV f32x4 mfma16(bf16x8 a, bf16x8 b, f32x4 c) { return __builtin_amdgcn_mfma_f32_16x16x32_bf16(a, b, c, 0, 0, 0); }
DEV float wave_sum(float v) {
#pragma unroll
  for (int o = 32; o >= 1; o >>= 1) v += __shfl_xor(v, o);
  return v;
}

DEV void transpose_tile(const float* __restrict__ src, bf16_t* __restrict__ dst, int lds_, int ldd, char* smem) {
  float* T = (float*)smem;
  const int tid = VTID;
#pragma unroll
  for (int i = 0; i < 4; ++i) {
    int k = (tid >> 4) + 16 * i, n4 = (tid & 15) * 4;
    float4 v = *(const float4*)(src + (size_t)k * lds_ + n4);
    T[k * 65 + n4 + 0] = v.x; T[k * 65 + n4 + 1] = v.y; T[k * 65 + n4 + 2] = v.z; T[k * 65 + n4 + 3] = v.w;
  }
  __syncthreads();
#pragma unroll
  for (int i = 0; i < 2; ++i) {
    int n = (tid >> 3) + 32 * i, k8 = (tid & 7) * 8;
    U8 o;
#pragma unroll
    for (int j = 0; j < 4; ++j) o.w[j] = pack2(T[(k8 + 2 * j) * 65 + n], T[(k8 + 2 * j + 1) * 65 + n]);
    *(uint4*)(dst + (size_t)n * ldd + k8) = o.u;
  }
  __syncthreads();
}
DEV void transpose_w(const float* __restrict__ W, bf16_t* __restrict__ Wt, int K, int N, int tk, int tn, char* smem) {
  transpose_tile(W + (size_t)(tk * 64) * N + tn * 64, Wt + (size_t)(tn * 64) * K + tk * 64, N, K, smem);
}

DEV void phase0(const Params& p, char* smem) {
  const int tid = VTID;
  const int NT0 = 192 + 2 * 2768, NITEMS = NT0 + 128 + 64 + 2;
  for (int it = VBID; it < NITEMS; it += VNB) {
    if (it < 192) {
      const int l = it / 96, n0 = (it % 96) * 64;
      float* s = (float*)smem;
      float* red = s + 9 * 1024;
      for (int idx = tid; idx < 9 * 1024; idx += 256) {
        int c = idx >> 10, k = idx & 1023;
        float v = (c == 0) ? p.c_ctx[k] : p.c[(c - 1) * 1024 + k];
        s[idx] = v / (1.f + __expf(-v));
      }
      __syncthreads();
      const int w = tid >> 6, lane = tid & 63, cq = lane & 15, ks = lane >> 4;
      const int kbase = (w * 4 + ks) * 64;
      float acc[9][4];
#pragma unroll
      for (int c = 0; c < 9; ++c) { acc[c][0] = 0.f; acc[c][1] = 0.f; acc[c][2] = 0.f; acc[c][3] = 0.f; }
      const float* wp = p.w_ada + ((size_t)l * 1024 + kbase) * 6144 + n0 + cq * 4;
      for (int kb = 0; kb < 64; kb += 16) {
        float4 wv[16];
#pragma unroll
        for (int j = 0; j < 16; ++j) wv[j] = *(const float4*)(wp + (size_t)(kb + j) * 6144);
#pragma unroll
        for (int j = 0; j < 16; ++j)
#pragma unroll
          for (int c = 0; c < 9; ++c) {
            const float sv = s[c * 1024 + kbase + kb + j];
            acc[c][0] += sv * wv[j].x; acc[c][1] += sv * wv[j].y; acc[c][2] += sv * wv[j].z; acc[c][3] += sv * wv[j].w;
          }
      }
#pragma unroll
      for (int c = 0; c < 9; ++c)
#pragma unroll
        for (int e = 0; e < 4; ++e) {
          float a = acc[c][e];
          a += __shfl_xor(a, 16); a += __shfl_xor(a, 32);
          if (ks == 0) red[(w * 9 + c) * 64 + cq * 4 + e] = a;
        }
      __syncthreads();
      for (int idx = tid; idx < 576; idx += 256) {
        int c = idx >> 6, nn = idx & 63;
        float v = red[(0 * 9 + c) * 64 + nn] + red[(1 * 9 + c) * 64 + nn] + red[(2 * 9 + c) * 64 + nn] + red[(3 * 9 + c) * 64 + nn] +
                  p.b_ada[l * 6144 + n0 + nn];
        p.mod[((size_t)l * 9 + c) * 6144 + n0 + nn] = v;
      }
      __syncthreads();
    } else if (it >= NT0 && it < NT0 + 128) {
      const int j = it - NT0, tt = j & 3, kvh = (j >> 2) & 1, l = (j >> 3) & 1, b = j >> 4;
      transpose_tile(p.cache_v + ((size_t)(b * 2 + l) * 256 + tt * 64) * 128 + kvh * 64, p.vt_lat + ((size_t)((l * 8 + b) * 2 + kvh) * 64) * 1280 + tt * 64, 128, 1280, smem);
    } else if (it >= NT0 + 128 && it < NT0 + 192) {
      const int j = it - NT0 - 128;
#pragma unroll
      for (int i = 0; i < 4; ++i) {
        const int e = (j * 1024 + i * 256 + tid) * 8;
        const int d = e & 63, kvh = (e >> 6) & 1, t = (e >> 7) & 255, l = (e >> 15) & 1, b = e >> 16;
        const float4 a0 = *(const float4*)(p.cache_k + e), a1 = *(const float4*)(p.cache_k + e + 4);
        U8 o; o.w[0] = pack2(a0.x, a0.y); o.w[1] = pack2(a0.z, a0.w); o.w[2] = pack2(a1.x, a1.y); o.w[3] = pack2(a1.z, a1.w);
        *(uint4*)(p.kb_lat + ((size_t)((l * 8 + b) * 2 + kvh) * 1280 + t) * 64 + d) = o.u;
      }
    } else if (it >= NT0 + 192) {
      if (it == NT0 + 192)
      for (int idx = tid; idx < 1024; idx += 256) {
        int pp = idx >> 4, f = idx & 15;
        float inv = powf(10000.f, -(float)f / 16.f);
        float ang = (float)pp * inv;
        float nrev = rintf(ang * 0.15915494309189535f);
        float r = fmaf(-nrev, 6.28125f, ang);
        r = fmaf(-nrev, 0.0019353071795864769f, r);
        p.rope[idx * 2 + 0] = __cosf(r);
        p.rope[idx * 2 + 1] = __sinf(r);
      }
      if (it == NT0 + 192)
      for (int idx = tid; idx < 1024; idx += 256) {
        const float xn = -p.lru_lam[idx];
        p.cdec[idx] = -8.f * (fmaxf(xn, 0.f) + log1pf(expf(-fabsf(xn))));
      }
    } else {
      int t = it - 192;
      const int l = t / 2768, r = t % 2768;
      if (r < 448) transpose_w(p.w_in + (size_t)l * 1024 * 1792, p.wt_in + (size_t)l * 1792 * 1024, 1024, 1792, r / 28, r % 28, smem);
      else if (r < 704) { int i = r - 448; transpose_w(p.w_out + (size_t)l * 1024 * 1024, p.wt_out + (size_t)l * 1024 * 1024, 1024, 1024, i / 16, i % 16, smem); }
      else if (r < 1728) { int i = r - 704; transpose_w(p.w_ff1 + (size_t)l * 1024 * 4096, p.wt_ff1 + (size_t)l * 4096 * 1024, 1024, 4096, i / 64, i % 64, smem); }
      else if (r < 2752) { int i = r - 1728; transpose_w(p.w_ff2 + (size_t)l * 4096 * 1024, p.wt_ff2 + (size_t)l * 1024 * 4096, 4096, 1024, i / 16, i % 16, smem); }
      else {
        int idx = r - 2752;
        int dir = idx >> 3, blk = (idx >> 1) & 3, mat = idx & 1;
        const float* src = (mat == 0 ? p.lru_wa : p.lru_wx) + (size_t)(((l * 2 + dir) * 4 + blk)) * 4096;
        bf16_t* dst = p.wt_lru + (size_t)((((l * 2 + dir) * 4 + blk) * 2 + mat)) * 4096;
        transpose_tile(src, dst, 64, 64, smem);
      }
    }
  }
}

DEV void ln_mod_phase(const Params& p, int l, int mode) {
  const int lane = threadIdx.x & 63, w = threadIdx.x >> 6;
  const float* lg = nullptr; const float* lb = nullptr;
  if (mode == 1) { lg = p.ln2_g + (l - 1) * 1024; lb = p.ln2_b + (l - 1) * 1024; }
  else if (mode == 2) { lg = p.ln1_g + l * 1024; lb = p.ln1_b + l * 1024; }
  else if (mode == 3) { lg = p.ln2_g + l * 1024; lb = p.ln2_b + l * 1024; }
  const int shoff = (mode == 2) ? 3072 : 0;
  const int mstride = gridDim.x * 8;
  float4 nv[4];
  {
    const int m = blockIdx.x * 8 + w;
    const float* src = (mode == 0) ? ((m < 8192) ? p.x_prompt + (size_t)m * 1024 : p.x_sample + (size_t)(m - 8192) * 1024) : p.out + (size_t)m * 1024;
#pragma unroll
    for (int i = 0; i < 4; ++i) nv[i] = *(const float4*)(src + i * 256 + lane * 4);
  }
  for (int m = blockIdx.x * 8 + w; m < MT; m += mstride) {
    float4 v[4];
#pragma unroll
    for (int i = 0; i < 4; ++i) v[i] = nv[i];
    {
      const int mn = (m + mstride < MT) ? m + mstride : m;
      const float* src = (mode == 0) ? ((mn < 8192) ? p.x_prompt + (size_t)mn * 1024 : p.x_sample + (size_t)(mn - 8192) * 1024) : p.out + (size_t)mn * 1024;
#pragma unroll
      for (int i = 0; i < 4; ++i) nv[i] = *(const float4*)(src + i * 256 + lane * 4);
    }
    if (mode != 0) {
      float s = 0.f;
#pragma unroll
      for (int i = 0; i < 4; ++i) s += v[i].x + v[i].y + v[i].z + v[i].w;
      const float mean = wave_sum(s) * (1.f / 1024.f);
      float s2 = 0.f;
#pragma unroll
      for (int i = 0; i < 4; ++i) { float a = v[i].x - mean, b = v[i].y - mean, c = v[i].z - mean, d = v[i].w - mean; s2 += a * a + b * b + c * c + d * d; }
      const float rstd = rsqrtf(wave_sum(s2) * (1.f / 1024.f) + 1e-6f);
#pragma unroll
      for (int i = 0; i < 4; ++i) {
        float4 g = *(const float4*)(lg + i * 256 + lane * 4), b = *(const float4*)(lb + i * 256 + lane * 4);
        v[i].x = (v[i].x - mean) * rstd * g.x + b.x; v[i].y = (v[i].y - mean) * rstd * g.y + b.y;
        v[i].z = (v[i].z - mean) * rstd * g.z + b.z; v[i].w = (v[i].w - mean) * rstd * g.w + b.w;
        if (mode == 3) *(float4*)(p.out + (size_t)m * 1024 + i * 256 + lane * 4) = v[i];
      }
      if (mode != 3 && lane == 0) *(float2*)(p.rstat + (size_t)m * 2) = make_float2(mean, rstd);
    }
    if (mode != 3) {
      const float* md = p.mod + ((size_t)l * 9 + cond_of(m)) * 6144 + shoff;
#pragma unroll
      for (int i = 0; i < 4; ++i) {
        float4 sh = *(const float4*)(md + i * 256 + lane * 4), sc = *(const float4*)(md + 1024 + i * 256 + lane * 4);
        uint2 o;
        o.x = pack2(v[i].x * (1.f + sc.x) + sh.x, v[i].y * (1.f + sc.y) + sh.y);
        o.y = pack2(v[i].z * (1.f + sc.z) + sh.z, v[i].w * (1.f + sc.w) + sh.w);
        *(uint2*)(p.abuf + (size_t)m * 1024 + i * 256 + lane * 4) = o;
      }
    }
  }
}

#define LAS3 __attribute__((address_space(3)))
namespace g8 {
constexpr int BM = 256, BK = 64, HALF = 128, HTB = HALF * BK * 2, NXCD = 8, WGM = 8;
DEV int lds_byte(int r, int c) { const int st = (r >> 4) * 2 + (c >> 5), rr = r & 15, cc = c & 31, ob = rr * 64 + cc * 2; return st * 1024 + (ob ^ (((ob >> 9) & 1) << 5)); }
DEV void stage_rc(int b, int& R, int& C) { const int st = b / 1024, sb = b % 1024, swz = sb ^ (((sb >> 9) & 1) << 5); R = (st >> 1) * 16 + swz / 64; C = (st & 1) * 32 + (swz % 64) / 2; }
DEV bool unit_of(int i, int nM, int nN, int& pm, int& pn) {
  const int nwg = nM * nN;
  const long L = (long)i * gridDim.x + blockIdx.x; if (L >= nwg) return false;
  int wgid = (int)L; { const int q = nwg / NXCD, r = nwg % NXCD, xcd = wgid % NXCD, off = wgid / NXCD; wgid = (xcd < r ? xcd * (q + 1) : r * (q + 1) + (xcd - r) * q) + off; }
  const int nig = WGM * nN, gid = wgid / nig, fm = gid * WGM, gsz = (nM - fm) < WGM ? (nM - fm) : WGM;
  pm = fm + ((wgid % nig) % gsz); pn = (wgid % nig) / gsz; return true;
}
}

template <int EPI>
DEV void gemm_epilogue(const Params& p, int l, f32x4 (&acc)[2][2][4][2], int pm, int pn, int wr, int wc, int fr, int fq) {
  const int brow = pm * 256, bcol = pn * 256;
  const float* md = p.mod + ((size_t)l * 9 + cond_of(brow)) * 6144;
#pragma unroll
  for (int bj = 0; bj < 2; ++bj)
#pragma unroll
    for (int n = 0; n < 2; ++n) {
      const int col = bcol + bj * 128 + wc * 32 + n * 16 + fq * 4;
      float4 gate = make_float4(0.f, 0.f, 0.f, 0.f), bias = make_float4(0.f, 0.f, 0.f, 0.f);
      if (EPI == 2) gate = *(const float4*)(md + 2048 + col);
      if (EPI == 3) bias = *(const float4*)(p.b_ff1 + l * 4096 + col);
      if (EPI == 4) { gate = *(const float4*)(md + 5120 + col); bias = *(const float4*)(p.b_ff2 + l * 1024 + col); }
#pragma unroll
      for (int ai = 0; ai < 2; ++ai)
#pragma unroll
        for (int m = 0; m < 4; ++m) {
          const int row = brow + ai * 128 + wr * 64 + m * 16 + fr;
          const f32x4 v = acc[ai][bj][m][n];
          if (EPI == 1) {
            uint2 o; o.x = pack2(v[0], v[1]); o.y = pack2(v[2], v[3]);
            *(uint2*)(p.zf + (size_t)row * 1792 + col) = o;
          } else if (EPI == 2) {
            const float* xs = (l == 0) ? ((row < 8192) ? p.x_prompt + (size_t)row * 1024 : p.x_sample + (size_t)(row - 8192) * 1024) : p.out + (size_t)row * 1024;
            const float4 x = *(const float4*)(xs + col);
            *(float4*)(p.out + (size_t)row * 1024 + col) = make_float4(ALPHA * x.x + gate.x * v[0], ALPHA * x.y + gate.y * v[1], ALPHA * x.z + gate.z * v[2], ALPHA * x.w + gate.w * v[3]);
          } else if (EPI == 3) {
            const float t0 = fmaxf(v[0] + bias.x, 0.f), t1 = fmaxf(v[1] + bias.y, 0.f), t2 = fmaxf(v[2] + bias.z, 0.f), t3 = fmaxf(v[3] + bias.w, 0.f);
            uint2 o; o.x = pack2(t0 * t0, t1 * t1); o.y = pack2(t2 * t2, t3 * t3);
            *(uint2*)(p.zf + (size_t)row * 4096 + col) = o;
          } else {
            float* xo = p.out + (size_t)row * 1024 + col;
            const float4 x = *(const float4*)xo;
            *(float4*)xo = make_float4(ALPHA * x.x + gate.x * (v[0] + bias.x), ALPHA * x.y + gate.y * (v[1] + bias.y), ALPHA * x.z + gate.z * (v[2] + bias.z), ALPHA * x.w + gate.w * (v[3] + bias.w));
          }
        }
    }
}

template <int EPI>
DEV void gemm_epilogue_lnres(const Params& p, int l, f32x4 (&acc)[2][2][4][2], int pm, int pn, int wr, int wc, int fr, int fq) {
  const int brow = pm * 256, bcol = pn * 256;
  const float* md = p.mod + ((size_t)l * 9 + cond_of(brow)) * 6144;
  float mean[2][4], rstd[2][4];
  {
    const unsigned so = (unsigned)(brow + wr * 64 + fr) * 2u;
#pragma unroll
    for (int ai = 0; ai < 2; ++ai)
#pragma unroll
      for (int m = 0; m < 4; ++m) { const float2 t = *(const float2*)(p.rstat + (so + (unsigned)((ai * 128 + m * 16) * 2))); mean[ai][m] = t.x; rstd[ai][m] = t.y; }
  }
  const float* lg = (EPI == 2) ? p.ln2_g + (l - 1) * 1024 : p.ln1_g + l * 1024;
  const float* lb = (EPI == 2) ? p.ln2_b + (l - 1) * 1024 : p.ln1_b + l * 1024;
  const unsigned co = (unsigned)(bcol + wc * 32 + fq * 4);
  const unsigned ro = (unsigned)(brow + wr * 64 + fr) * 1024u + co;
#pragma unroll
  for (int bj = 0; bj < 2; ++bj)
#pragma unroll
    for (int n = 0; n < 2; ++n) {
      unsigned col = co + (unsigned)(bj * 128 + n * 16), rb = ro + (unsigned)(bj * 128 + n * 16);
      asm volatile("" : "+v"(col), "+v"(rb));
      float4 gate, bias = make_float4(0.f, 0.f, 0.f, 0.f);
      if (EPI == 2) gate = *(const float4*)(md + 2048 + col);
      else { gate = *(const float4*)(md + 5120 + col); bias = *(const float4*)(p.b_ff2 + l * 1024 + col); }
      const float4 g4 = *(const float4*)(lg + col), b4 = *(const float4*)(lb + col);
#pragma unroll
      for (int ai = 0; ai < 2; ++ai)
#pragma unroll
        for (int m = 0; m < 4; ++m) {
          float* xo = p.out + (rb + (unsigned)((ai * 128 + m * 16) * 1024));
          const float4 x = *(const float4*)xo;
          const float mu = mean[ai][m], rr = rstd[ai][m];
          const f32x4 v = acc[ai][bj][m][n];
          const float x0 = (x.x - mu) * rr * g4.x + b4.x, x1 = (x.y - mu) * rr * g4.y + b4.y, x2 = (x.z - mu) * rr * g4.z + b4.z, x3 = (x.w - mu) * rr * g4.w + b4.w;
          *(float4*)xo = make_float4(ALPHA * x0 + gate.x * (v[0] + bias.x), ALPHA * x1 + gate.y * (v[1] + bias.y), ALPHA * x2 + gate.z * (v[2] + bias.z), ALPHA * x3 + gate.w * (v[3] + bias.w));
        }
      __builtin_amdgcn_sched_barrier(0);
    }
}

template <int EPI>
DEV void gemm_phase(const Params& p, int l, const bf16_t* Ag, const bf16_t* Btg, int N, int K, LAS3 unsigned char* lds) {
  using namespace g8;
  const int tid = threadIdx.x, wid = __builtin_amdgcn_readfirstlane(tid >> 6), lane = tid & 63, wr = wid >> 2, wc = wid & 3, fr = lane & 15, fq = lane >> 4;
  const int nt = K / BK, nM = MT / BM, nN = N / BM;
  unsigned voff[2];
#pragma unroll
  for (int i = 0; i < 2; ++i) { int R, C; stage_rc(tid * 16 + i * 8192, R, C); voff[i] = (unsigned)(R * K + C) * 2u; }
  const size_t kstep = (size_t)(BK * 2);
  const size_t hstep = (size_t)HALF * K * 2;
  const size_t tstep = 2 * hstep;
  const unsigned ldsw = (unsigned)wid * 1024u;
  const int aoff = lds_byte(wr * 64 + fr, fq * 8), boff = lds_byte(wc * 32 + fr, fq * 8);
#define PG8_SA(b, h) (((b) * 2 + (h)) * HTB)
#define PG8_SB(b, h) ((4 + (b) * 2 + (h)) * HTB)
#define PG8_STAGE(bufoff, gbase) do { _Pragma("unroll") for (int _i = 0; _i < 2; ++_i) \
    __builtin_amdgcn_global_load_lds((const unsigned*)((const char*)(gbase) + voff[_i]), (LAS3 unsigned*)(lds + (bufoff) + ldsw + _i * 8192), 16, 0, 0); } while (0)
#define PG8_LDA(dst, b, h) do { _Pragma("unroll") for (int m = 0; m < 4; ++m) _Pragma("unroll") for (int k = 0; k < 2; ++k) dst[m][k] = *(const LAS3 bf16x8*)(lds + PG8_SA(b, h) + aoff + m * 2048 + k * 1024); } while (0)
#define PG8_LDB(dst, b, h) do { _Pragma("unroll") for (int n = 0; n < 2; ++n) _Pragma("unroll") for (int k = 0; k < 2; ++k) dst[n][k] = *(const LAS3 bf16x8*)(lds + PG8_SB(b, h) + boff + n * 2048 + k * 1024); } while (0)
#define PG8_MMA(ai, bj, At_, Bt_) do { __builtin_amdgcn_s_setprio(1); _Pragma("unroll") for (int m = 0; m < 4; ++m) _Pragma("unroll") for (int n = 0; n < 2; ++n) _Pragma("unroll") for (int k = 0; k < 2; ++k) \
    acc[ai][bj][m][n] = __builtin_amdgcn_mfma_f32_16x16x32_bf16(Bt_[n][k], At_[m][k], acc[ai][bj][m][n], 0, 0, 0); __builtin_amdgcn_s_setprio(0); } while (0)
#define PG8_WAIT_V(n) asm volatile("s_waitcnt vmcnt(" #n ")" ::: "memory")
#define PG8_WAIT_L(n) asm volatile("s_waitcnt lgkmcnt(" #n ")" ::: "memory")
#define PG8_BAR __builtin_amdgcn_s_barrier()
#define PG8_SCHED __builtin_amdgcn_sched_barrier(0)
  int cpm, cpn, npm = 0, npn = 0, ui = 0;
  if (!unit_of(0, nM, nN, cpm, cpn)) return;
  f32x4 acc[2][2][4][2];
#pragma unroll
  for (int a = 0; a < 2; ++a)
#pragma unroll
    for (int b = 0; b < 2; ++b)
#pragma unroll
      for (int m = 0; m < 4; ++m)
#pragma unroll
        for (int n = 0; n < 2; ++n) acc[a][b][m][n] = (f32x4){0.f, 0.f, 0.f, 0.f};
  bf16x8 At[4][2], B0[2][2], B1[2][2];
  const char* cA = (const char*)Ag + (size_t)cpm * tstep; const char* cB = (const char*)Btg + (size_t)cpn * tstep;
  PG8_STAGE(PG8_SB(0, 0), cB); PG8_STAGE(PG8_SA(0, 0), cA); PG8_STAGE(PG8_SB(0, 1), cB + hstep); PG8_STAGE(PG8_SA(0, 1), cA + hstep);
  if (wr == 1) PG8_BAR;
  PG8_WAIT_V(4); PG8_BAR;
  PG8_STAGE(PG8_SB(1, 0), cB + kstep); PG8_STAGE(PG8_SA(1, 0), cA + kstep); PG8_STAGE(PG8_SB(1, 1), cB + hstep + kstep);
  PG8_WAIT_V(6); PG8_BAR;
  for (;;) {
    const bool has_next = unit_of(ui + 1, nM, nN, npm, npn);
    const char* nA = has_next ? (const char*)Ag + (size_t)npm * tstep : cA; const char* nB = has_next ? (const char*)Btg + (size_t)npn * tstep : cB;
    for (int t = 0; t < nt; t += 2) {
      const bool last = (t == nt - 2);
      const char* a1 = cA + (size_t)(t + 1) * kstep;
      const char* a2 = last ? nA : cA + (size_t)(t + 2) * kstep; const char* b2 = last ? nB : cB + (size_t)(t + 2) * kstep;
      const char* a3 = a2 + kstep; const char* b3 = b2 + kstep;
      PG8_LDB(B0, 0, 0); PG8_SCHED; PG8_LDA(At, 0, 0); PG8_STAGE(PG8_SA(1, 1), a1 + hstep);
      PG8_WAIT_L(8); PG8_BAR; PG8_WAIT_L(0); PG8_MMA(0, 0, At, B0); PG8_BAR; PG8_SCHED;
      PG8_LDB(B1, 0, 1); PG8_STAGE(PG8_SB(0, 0), b2);
      PG8_BAR; PG8_WAIT_L(0); PG8_MMA(0, 1, At, B1); PG8_BAR;
      PG8_LDA(At, 0, 1); PG8_STAGE(PG8_SA(0, 0), a2);
      PG8_BAR; PG8_WAIT_L(0); PG8_MMA(1, 0, At, B0); PG8_BAR; PG8_SCHED;
      PG8_STAGE(PG8_SB(0, 1), b2 + hstep);
      PG8_WAIT_V(6); PG8_BAR; PG8_MMA(1, 1, At, B1); PG8_BAR;
      PG8_LDB(B0, 1, 0); PG8_SCHED; PG8_LDA(At, 1, 0); PG8_STAGE(PG8_SA(0, 1), a2 + hstep);
      PG8_WAIT_L(8); PG8_BAR; PG8_WAIT_L(0); PG8_MMA(0, 0, At, B0); PG8_BAR; PG8_SCHED;
      PG8_LDB(B1, 1, 1); PG8_STAGE(PG8_SB(1, 0), b3);
      PG8_BAR; PG8_WAIT_L(0); PG8_MMA(0, 1, At, B1); PG8_BAR;
      PG8_LDA(At, 1, 1); PG8_STAGE(PG8_SA(1, 0), a3);
      PG8_BAR; PG8_WAIT_L(0); PG8_MMA(1, 0, At, B0); PG8_BAR; PG8_SCHED;
      PG8_STAGE(PG8_SB(1, 1), b3 + hstep);
      PG8_WAIT_V(6); PG8_BAR; PG8_MMA(1, 1, At, B1); PG8_BAR;
    }
    if (EPI == 4 || (EPI == 2 && l > 0)) gemm_epilogue_lnres<EPI>(p, l, acc, cpm, cpn, wr, wc, fr, fq);
    else gemm_epilogue<EPI>(p, l, acc, cpm, cpn, wr, wc, fr, fq);
    if (!has_next) break;
#pragma unroll
    for (int a = 0; a < 2; ++a)
#pragma unroll
      for (int b = 0; b < 2; ++b)
#pragma unroll
        for (int m = 0; m < 4; ++m)
#pragma unroll
          for (int n = 0; n < 2; ++n) acc[a][b][m][n] = (f32x4){0.f, 0.f, 0.f, 0.f};
    cpm = npm; cpn = npn; cA = nA; cB = nB; ++ui;
  }
  PG8_WAIT_V(0);
  if (wr == 0) PG8_BAR;
  PG8_BAR;
#undef PG8_SA
#undef PG8_SB
#undef PG8_STAGE
#undef PG8_LDA
#undef PG8_LDB
#undef PG8_MMA
#undef PG8_WAIT_V
#undef PG8_WAIT_L
#undef PG8_BAR
#undef PG8_SCHED
}

DEV void rope8(float (&v)[8], int d0, int prow, int pcol, const float* __restrict__ rope) {
  const int pp = (d0 < 32) ? prow : pcol;
#pragma unroll
  for (int i = 0; i < 4; ++i) {
    const int f = ((d0 >> 1) + i) & 15;
    const float cs = rope[(pp * 16 + f) * 2], sn = rope[(pp * 16 + f) * 2 + 1];
    const float x1 = v[2 * i], x2 = v[2 * i + 1];
    v[2 * i] = x1 * cs - x2 * sn; v[2 * i + 1] = x1 * sn + x2 * cs;
  }
}

DEV void prep_token_row(const Params& p, int l, int m, int lane, uint4 c1, uint4 c2, uint4 c3) {
  bf16_t* zr = p.zf + (size_t)m * 1792;
  const bool lat = m >= 8192;
  const int pos = lat ? ((m - 8192) & 1023) : (m & 255);
  const int prow = pos >> 6, pcol = pos & 63;
  const int d0 = (lane & 7) * 8;
  {
    U8 u; u.u = c1;
    float v[8]; float ss = 0.f;
#pragma unroll
    for (int j = 0; j < 8; ++j) { v[j] = bf2f(u.h[j]); ss += v[j] * v[j]; }
    ss += __shfl_xor(ss, 1); ss += __shfl_xor(ss, 2); ss += __shfl_xor(ss, 4);
    const float rinv = rsqrtf(ss * (1.f / 64.f) + 1e-6f);
#pragma unroll
    for (int j = 0; j < 8; ++j) v[j] = v[j] * rinv * p.q_g[l * 64 + d0 + j];
    if (lat) rope8(v, d0, prow, pcol, p.rope);
#pragma unroll
    for (int j = 0; j < 4; ++j) u.w[j] = pack2(v[2 * j] * QSCALE, v[2 * j + 1] * QSCALE);
    *(uint4*)(zr + lane * 8) = u.u;
  }
  {
    const int col = lane < 32 ? 512 + lane * 8 : 1024 + (lane - 32) * 8;
    U8 u; u.u = c2;
    float v[8]; float ss = 0.f;
#pragma unroll
    for (int j = 0; j < 8; ++j) { v[j] = bf2f(u.h[j]); ss += v[j] * v[j]; }
    ss += __shfl_xor(ss, 1); ss += __shfl_xor(ss, 2); ss += __shfl_xor(ss, 4);
    if (lane < 16) {
      const float rinv = rsqrtf(ss * (1.f / 64.f) + 1e-6f);
#pragma unroll
      for (int j = 0; j < 8; ++j) v[j] = v[j] * rinv * p.k_g[l * 64 + d0 + j];
      if (!lat) {
        float* o = p.out + OFF_YK + ((((size_t)(m >> 8)) * 2 + l) * 256 + pos) * 128 + lane * 8;
        *(float4*)o = make_float4(v[0], v[1], v[2], v[3]); *(float4*)(o + 4) = make_float4(v[4], v[5], v[6], v[7]);
      } else rope8(v, d0, prow, pcol, p.rope);
#pragma unroll
      for (int j = 0; j < 4; ++j) u.w[j] = pack2(v[2 * j], v[2 * j + 1]);
      const int kvh = lane >> 3;
      bf16_t* kd = lat ? p.kb_lat + ((size_t)((l * 8 + ((m - 8192) >> 10)) * 2 + kvh) * 1280 + 256 + pos) * 64 + d0
                       : p.kb_ctx + ((size_t)((m >> 8) * 2 + kvh) * 256 + pos) * 64 + d0;
      *(uint4*)kd = u.u;
    } else if (lane < 32) {
      if (!lat) {
        float* o = p.out + OFF_YV + ((((size_t)(m >> 8)) * 2 + l) * 256 + pos) * 128 + (lane - 16) * 8;
        *(float4*)o = make_float4(v[0], v[1], v[2], v[3]); *(float4*)(o + 4) = make_float4(v[4], v[5], v[6], v[7]);
      }
      const int kvh = (lane - 16) >> 3;
      bf16_t* vd; int T;
      if (lat) { T = 1280; vd = p.vt_lat + ((size_t)((l * 8 + ((m - 8192) >> 10)) * 2 + kvh) * 64 + d0) * 1280 + 256 + pos; }
      else { T = 256; vd = p.vt_ctx + ((size_t)((m >> 8) * 2 + kvh) * 64 + d0) * 256 + pos; }
#pragma unroll
      for (int j = 0; j < 8; ++j) vd[(size_t)j * T] = u.h[j];
    } else {
#pragma unroll
      for (int j = 0; j < 4; ++j) u.w[j] = pack2(gelu_t(v[2 * j]), gelu_t(v[2 * j + 1]));
      *(uint4*)(zr + col) = u.u;
    }
  }
  {
    const int col = 1280 + lane * 8;
    U8 u; u.u = c3;
    float v[8]; float s = 0.f;
#pragma unroll
    for (int j = 0; j < 8; ++j) { v[j] = gelu_t(bf2f(u.h[j])); s += v[j]; }
#pragma unroll
    for (int o = 1; o <= 16; o <<= 1) s += __shfl_xor(s, o);
    const float mean = s * (1.f / 256.f);
    float s2 = 0.f;
#pragma unroll
    for (int j = 0; j < 8; ++j) { float d = v[j] - mean; s2 += d * d; }
#pragma unroll
    for (int o = 1; o <= 16; o <<= 1) s2 += __shfl_xor(s2, o);
    if (lane >= 32) {
      const float rstd = rsqrtf(s2 * (1.f / 256.f) + 1e-6f);
      const int ch = (lane - 32) * 8;
#pragma unroll
      for (int j = 0; j < 8; ++j) v[j] = (v[j] - mean) * rstd * p.mlp_g[l * 256 + ch + j] + p.mlp_b[l * 256 + ch + j];
    }
#pragma unroll
    for (int j = 0; j < 4; ++j) u.w[j] = pack2(v[2 * j], v[2 * j + 1]);
    *(uint4*)(zr + col) = u.u;
  }
}

template <bool REV>
DEV void tile_scan(float (&a)[4][4], float (&u)[4][4], int lane) {
  const int q = lane >> 4;
  float C = 0.f, CP = 1.f;
  const int src1 = (REV ? lane + 16 : lane - 16) & 63;
  const int src2 = (REV ? lane + 32 : lane - 32) & 63;
  const int srcT = (lane & 15) + (REV ? 0 : 48);
  const bool c1 = REV ? (q <= 2) : (q >= 1);
  const bool c2 = REV ? (q <= 1) : (q >= 2);
  const bool first = REV ? (q == 3) : (q == 0);
#pragma unroll
  for (int mi = 0; mi < 4; ++mi) {
    const int mt = REV ? 3 - mi : mi;
    float P = 1.f, H = 0.f, pl[4], hl[4];
#pragma unroll
    for (int ri = 0; ri < 4; ++ri) {
      const int r = REV ? 3 - ri : ri;
      H = a[mt][r] * H + u[mt][r]; P *= a[mt][r]; pl[r] = P; hl[r] = H;
    }
    float Pi = P, Hi = H;
    float Pp = __shfl(Pi, src1), Hp = __shfl(Hi, src1);
    if (c1) { Hi = Pi * Hp + Hi; Pi = Pi * Pp; }
    Pp = __shfl(Pi, src2); Hp = __shfl(Hi, src2);
    if (c2) { Hi = Pi * Hp + Hi; Pi = Pi * Pp; }
    float Pe = __shfl(Pi, src1), He = __shfl(Hi, src1);
    if (first) { Pe = 1.f; He = 0.f; }
    const float hin = Pe * C + He, pin = Pe * CP;
#pragma unroll
    for (int r = 0; r < 4; ++r) { u[mt][r] = pl[r] * hin + hl[r]; a[mt][r] = pl[r] * pin; }
    const float Pt = __shfl(Pi, srcT), Ht = __shfl(Hi, srcT);
    C = Pt * C + Ht; CP = Pt * CP;
  }
}

DEV void lru_gate_item(const Params& p, int l, int item, char* smem) {
  const int tid = VTID, lane = tid & 63, w = tid >> 6;
  const int tile = item >> 2, blk = item & 3;
  const int m0 = tile * 64;
  int ms, L;
  if (m0 < 8192) { ms = m0 & ~255; L = 256; } else { ms = 8192 + ((m0 - 8192) & ~1023); L = 1024; }
  const int dir = w >> 1, half = w & 1, q = lane >> 4, c15 = lane & 15;
  const bf16_t* wt = p.wt_lru + (size_t)((((l * 2 + dir) * 4 + blk) * 2)) * 4096;
  bf16x8 bfr[2][2][2];
#pragma unroll
  for (int mat = 0; mat < 2; ++mat)
#pragma unroll
    for (int j = 0; j < 2; ++j)
#pragma unroll
      for (int s = 0; s < 2; ++s) bfr[mat][j][s] = *(const bf16x8*)(wt + mat * 4096 + (half * 32 + j * 16 + c15) * 64 + s * 32 + q * 8);
  float* xs = (float*)smem;
  float* xcf = xs + 67 * 64;
  bf16_t* xcb = (bf16_t*)(xcf + 64 * 64);
  for (int idx = tid; idx < 67 * 8; idx += 256) {
    const int rr = idx >> 3, cc = idx & 7;
    const int m = m0 - 1 + rr;
    float v[8];
    if (m >= ms && m < ms + L) {
      U8 u; u.u = *(const uint4*)(p.zf + (size_t)m * 1792 + 768 + blk * 64 + cc * 8);
#pragma unroll
      for (int j = 0; j < 8; ++j) v[j] = bf2f(u.h[j]);
    } else {
#pragma unroll
      for (int j = 0; j < 8; ++j) v[j] = 0.f;
    }
#pragma unroll
    for (int j = 0; j < 8; ++j) xs[rr * 64 + cc * 8 + j] = v[j];
  }
  __syncthreads();
  {
    const int ch = tid & 63, Cg = blk * 64 + ch;
    const float w0 = p.conv_w[(l * 4 + 0) * 256 + Cg], w1 = p.conv_w[(l * 4 + 1) * 256 + Cg], w2 = p.conv_w[(l * 4 + 2) * 256 + Cg],
                w3 = p.conv_w[(l * 4 + 3) * 256 + Cg], cb = p.conv_b[l * 256 + Cg];
#pragma unroll 4
    for (int tt = 0; tt < 16; ++tt) {
      const int t = (tid >> 6) * 16 + tt;
      const float v = cb + w0 * xs[t * 64 + ch] + w1 * xs[(t + 1) * 64 + ch] + w2 * xs[(t + 2) * 64 + ch] + w3 * xs[(t + 3) * 64 + ch];
      xcf[t * 64 + ch] = v; xcb[t * 72 + ch] = f2bf(v);
    }
  }
  __syncthreads();
  f32x4 acc[2][4][2];
#pragma unroll
  for (int mat = 0; mat < 2; ++mat)
#pragma unroll
    for (int mt = 0; mt < 4; ++mt)
#pragma unroll
      for (int j = 0; j < 2; ++j) acc[mat][mt][j] = f32x4{0.f, 0.f, 0.f, 0.f};
#pragma unroll
  for (int mt = 0; mt < 4; ++mt)
#pragma unroll
    for (int s = 0; s < 2; ++s) {
      const bf16x8 af = *(const bf16x8*)(xcb + (mt * 16 + c15) * 72 + s * 32 + q * 8);
#pragma unroll
      for (int mat = 0; mat < 2; ++mat)
#pragma unroll
        for (int j = 0; j < 2; ++j) acc[mat][mt][j] = mfma16(af, bfr[mat][j][s], acc[mat][mt][j]);
    }
  float* PCp = p.au + (size_t)(dir * 2 + 0) * MT * 256;
  float* HLp = p.au + (size_t)(dir * 2 + 1) * MT * 256;
#pragma unroll
  for (int j = 0; j < 2; ++j) {
    const int ch = half * 32 + j * 16 + c15, Cg = blk * 64 + ch, pidx = (l * 2 + dir) * 256 + Cg;
    const float ba = p.lru_ba[pidx], bx = p.lru_bx[pidx];
    const float cdec = p.cdec[pidx];
    float a[4][4], u[4][4];
#pragma unroll
    for (int mt = 0; mt < 4; ++mt)
#pragma unroll
      for (int r = 0; r < 4; ++r) {
        const int t = mt * 16 + q * 4 + r;
        const float rg = sigmoidf_(acc[0][mt][j][r] + ba), ig = sigmoidf_(acc[1][mt][j][r] + bx);
        const float la = cdec * rg;
        a[mt][r] = __expf(la);
        const float x2 = 2.f * la;
        const float em = (x2 < -0.25f) ? 1.f - __expf(x2) : -x2 * (1.f + x2 * (0.5f + x2 * (1.f / 6.f + x2 * (1.f / 24.f + x2 * (1.f / 120.f + x2 * (1.f / 720.f))))));
        u[mt][r] = __builtin_amdgcn_sqrtf(em) * ig * xcf[t * 64 + ch];
      }
    if (dir == 0) tile_scan<false>(a, u, lane); else tile_scan<true>(a, u, lane);
#pragma unroll
    for (int mt = 0; mt < 4; ++mt)
#pragma unroll
      for (int r = 0; r < 4; ++r) {
        const size_t m = m0 + mt * 16 + q * 4 + r;
        PCp[m * 256 + Cg] = a[mt][r]; HLp[m * 256 + Cg] = u[mt][r];
      }
  }
  __syncthreads();
}

DEV void attn_item(const Params& p, int l, int it, char* sm) {
  const int tid = threadIdx.x, lane = tid & 63, w = tid >> 6, q = lane >> 4, c15 = lane & 15;
  int h, ms, nkt, T; const bf16_t* Kg; const bf16_t* Vg;
  if (it < 512) {
    const int b = it >> 6, qb = it & 7; h = (it >> 3) & 7; ms = 8192 + b * 1024 + qb * 128; nkt = 10; T = 1280;
    Kg = p.kb_lat + (size_t)((l * 8 + b) * 2 + (h >> 2)) * 1280 * 64; Vg = p.vt_lat + (size_t)((l * 8 + b) * 2 + (h >> 2)) * 64 * 1280;
  } else {
    const int i2 = it - 512, b = i2 >> 4, qb = i2 & 1; h = (i2 >> 1) & 7; ms = b * 256 + qb * 128; nkt = 2; T = 256;
    Kg = p.kb_ctx + (size_t)(b * 2 + (h >> 2)) * 256 * 64; Vg = p.vt_ctx + (size_t)(b * 2 + (h >> 2)) * 64 * 256;
  }
  const int kc0 = tid, kc1 = tid + 512;
  const int vd0 = tid >> 4, vk = (tid & 15) * 8;
  const int vpos = ((tid & 15) >> 2) * 32 + 16 * (tid & 1) + 4 * ((tid & 3) >> 1);
  const bf16_t* vg0 = Vg + (size_t)vd0 * T + vk;
  const bf16_t* vg1 = Vg + (size_t)(vd0 + 32) * T + vk;
  uint4 rk0, rk1, rv0, rv1;
#define ATT_LOAD(kt) do { rk0 = *(const uint4*)(Kg + (size_t)(kt) * 8192 + kc0 * 8); rk1 = *(const uint4*)(Kg + (size_t)(kt) * 8192 + kc1 * 8); \
    rv0 = *(const uint4*)(vg0 + (kt) * 128); rv1 = *(const uint4*)(vg1 + (kt) * 128); } while (0)
#define ATT_STORE(buf) do { bf16_t* Ks_ = (bf16_t*)(sm + (buf) * 36864); bf16_t* Vs_ = Ks_ + 9216; \
    *(uint4*)(Ks_ + (kc0 >> 3) * 72 + (kc0 & 7) * 8) = rk0; *(uint4*)(Ks_ + (kc1 >> 3) * 72 + (kc1 & 7) * 8) = rk1; \
    *(uint2*)(Vs_ + vd0 * 136 + vpos) = make_uint2(rv0.x, rv0.y); *(uint2*)(Vs_ + vd0 * 136 + vpos + 8) = make_uint2(rv0.z, rv0.w); \
    *(uint2*)(Vs_ + (vd0 + 32) * 136 + vpos) = make_uint2(rv1.x, rv1.y); *(uint2*)(Vs_ + (vd0 + 32) * 136 + vpos + 8) = make_uint2(rv1.z, rv1.w); } while (0)
  ATT_LOAD(0);
  const int mq = ms + w * 16;
  bf16x8 qf[2];
#pragma unroll
  for (int s = 0; s < 2; ++s) qf[s] = *(const bf16x8*)(p.zf + (size_t)(mq + c15) * 1792 + h * 64 + s * 32 + q * 8);
  ATT_STORE(0);
  if (nkt > 1) ATT_LOAD(1);
  __syncthreads();
  f32x4 o[4];
  float mrow = -1e30f, lrow = 0.f;
#pragma unroll
  for (int j = 0; j < 4; ++j) o[j] = f32x4{0.f, 0.f, 0.f, 0.f};
  for (int kt = 0; kt < nkt; ++kt) {
    const int cur = kt & 1;
    const bf16_t* Ks = (const bf16_t*)(sm + cur * 36864);
    const bf16_t* Vs = Ks + 9216;
    f32x4 s4[8];
    {
      bf16x8 kf[8][2];
#pragma unroll
      for (int jn = 0; jn < 8; ++jn)
#pragma unroll
        for (int s = 0; s < 2; ++s) kf[jn][s] = *(const bf16x8*)(Ks + (jn * 16 + c15) * 72 + s * 32 + q * 8);
      __builtin_amdgcn_sched_barrier(0);
#pragma unroll
      for (int jn = 0; jn < 8; ++jn) s4[jn] = mfma16(kf[jn][0], qf[0], f32x4{0.f, 0.f, 0.f, 0.f});
#pragma unroll
      for (int jn = 0; jn < 8; ++jn) s4[jn] = mfma16(kf[jn][1], qf[1], s4[jn]);
      __builtin_amdgcn_sched_barrier(0);
    }
    U8 vf[4][4];
#pragma unroll
    for (int jn = 0; jn < 4; ++jn)
#pragma unroll
      for (int ks = 0; ks < 4; ++ks) {
        vf[jn][ks].u = *(const uint4*)(Vs + (jn * 16 + c15) * 136 + ks * 32 + q * 8);
      }
    __builtin_amdgcn_sched_barrier(0);
    float mx = s4[0][0];
#pragma unroll
    for (int jn = 0; jn < 8; ++jn)
#pragma unroll
      for (int r = 0; r < 4; ++r) mx = fmaxf(mx, s4[jn][r]);
    mx = fmaxf(mx, __shfl_xor(mx, 16)); mx = fmaxf(mx, __shfl_xor(mx, 32));
    const float mnew = fmaxf(mrow, mx);
    const float alpha = __builtin_amdgcn_exp2f(mrow - mnew);
    mrow = mnew;
    float ls = 0.f;
#pragma unroll
    for (int jn = 0; jn < 8; ++jn)
#pragma unroll
      for (int r = 0; r < 4; ++r) { const float pv = __builtin_amdgcn_exp2f(s4[jn][r] - mnew); s4[jn][r] = pv; ls += pv; }
    lrow = lrow * alpha + ls;
#pragma unroll
    for (int jn = 0; jn < 4; ++jn) { o[jn][0] *= alpha; o[jn][1] *= alpha; o[jn][2] *= alpha; o[jn][3] *= alpha; }
    U8 pb[4];
#pragma unroll
    for (int ks = 0; ks < 4; ++ks) {
      pb[ks].w[0] = pack2(s4[2 * ks][0], s4[2 * ks][1]); pb[ks].w[1] = pack2(s4[2 * ks][2], s4[2 * ks][3]);
      pb[ks].w[2] = pack2(s4[2 * ks + 1][0], s4[2 * ks + 1][1]); pb[ks].w[3] = pack2(s4[2 * ks + 1][2], s4[2 * ks + 1][3]);
    }
#pragma unroll
    for (int ks = 0; ks < 4; ++ks)
#pragma unroll
      for (int jn = 0; jn < 4; ++jn) o[jn] = mfma16(vf[jn][ks].v, pb[ks].v, o[jn]);
    if (kt + 1 < nkt) {
      ATT_STORE(cur ^ 1);
      if (kt + 2 < nkt) ATT_LOAD(kt + 2);
    }
    __syncthreads();
  }
#undef ATT_LOAD
#undef ATT_STORE
  float lt = lrow;
  lt += __shfl_xor(lt, 16); lt += __shfl_xor(lt, 32);
  const float inv = 1.f / lt;
  bf16_t* orow = p.abuf + (size_t)(mq + c15) * 1024 + h * 64 + q * 4;
#pragma unroll
  for (int jn = 0; jn < 4; ++jn) {
    uint2 ov; ov.x = pack2(o[jn][0] * inv, o[jn][1] * inv); ov.y = pack2(o[jn][2] * inv, o[jn][3] * inv);
    *(uint2*)(orow + jn * 16) = ov;
  }
}

DEV void gmlp_item(const Params& p, int l, int it, char* smem) {
  const int tid = VTID, lane = tid & 63, w = tid >> 6, q = lane >> 4, c15 = lane & 15;
  const int chunk = it >> 2, g = it & 3, m0 = chunk * 128;
  bf16_t* vt = (bf16_t*)smem;
  const float* wsg = p.mlp_ws + (size_t)(l * 4 + g) * 16384;
  float4 wa[2][4][2];
#pragma unroll
  for (int nt = 0; nt < 2; ++nt)
#pragma unroll
    for (int s = 0; s < 4; ++s) {
      const float* ap = wsg + ((2 * w + nt) * 16 + c15) * 128 + s * 32 + q * 8;
      wa[nt][s][0] = *(const float4*)ap; wa[nt][s][1] = *(const float4*)(ap + 4);
    }
  uint4 vin[4];
#pragma unroll
  for (int i = 0; i < 4; ++i) { const int id = tid + 256 * i; vin[i] = *(const uint4*)(p.zf + (size_t)(m0 + (id >> 3)) * 1792 + 1536 + g * 64 + (id & 7) * 8); }
#pragma unroll
  for (int i = 0; i < 4; ++i) {
    const int id = tid + 256 * i, qq = id >> 3, cc = id & 7;
    U8 v; v.u = vin[i];
#pragma unroll
    for (int j = 0; j < 8; ++j) vt[(cc * 8 + j) * 136 + qq] = v.h[j];
  }
  __syncthreads();
  f32x4 acc[4][2];
#pragma unroll
  for (int mt = 0; mt < 4; ++mt)
#pragma unroll
    for (int nt = 0; nt < 2; ++nt) acc[mt][nt] = f32x4{0.f, 0.f, 0.f, 0.f};
#pragma unroll
  for (int s = 0; s < 4; ++s) {
    bf16x8 af[4];
#pragma unroll
    for (int mt = 0; mt < 4; ++mt) af[mt] = *(const bf16x8*)(vt + (mt * 16 + c15) * 136 + s * 32 + q * 8);
#pragma unroll
    for (int nt = 0; nt < 2; ++nt) {
      U8 bb;
      bb.w[0] = pack2(wa[nt][s][0].x, wa[nt][s][0].y); bb.w[1] = pack2(wa[nt][s][0].z, wa[nt][s][0].w);
      bb.w[2] = pack2(wa[nt][s][1].x, wa[nt][s][1].y); bb.w[3] = pack2(wa[nt][s][1].z, wa[nt][s][1].w);
#pragma unroll
      for (int mt = 0; mt < 4; ++mt) acc[mt][nt] = mfma16(af[mt], bb.v, acc[mt][nt]);
    }
  }
#pragma unroll
  for (int nt = 0; nt < 2; ++nt) {
    const int pp = (2 * w + nt) * 16 + c15;
    const size_t m = m0 + pp;
    const float bsv = p.mlp_bs[(l * 4 + g) * 128 + pp];
#pragma unroll
    for (int mt = 0; mt < 4; ++mt) {
      const int c = mt * 16 + q * 4;
      const uint2 uu = *(const uint2*)(p.zf + m * 1792 + 1280 + g * 64 + c);
      const float u0 = __uint_as_float(uu.x << 16), u1 = __uint_as_float(uu.x & 0xffff0000u), u2 = __uint_as_float(uu.y << 16), u3 = __uint_as_float(uu.y & 0xffff0000u);
      uint2 o; o.x = pack2(u0 * (acc[mt][nt][0] + bsv), u1 * (acc[mt][nt][1] + bsv)); o.y = pack2(u2 * (acc[mt][nt][2] + bsv), u3 * (acc[mt][nt][3] + bsv));
      *(uint2*)(p.abuf + m * 1024 + 768 + g * 64 + c) = o;
    }
  }
  __syncthreads();
}

DEV void lru_apply_item(const Params& p, int l, int ti2) {
  const int C = VTID;
  const int ti = ti2 >> 1, th = (ti2 & 1) * 32;
  const int m0 = ti * 64;
  int ms, L, b; bool lat = m0 >= 8192;
  if (!lat) { ms = m0 & ~255; L = 256; b = m0 >> 8; } else { ms = 8192 + ((m0 - 8192) & ~1023); L = 1024; b = (m0 - 8192) >> 10; }
  const int k = (m0 - ms) >> 6, nt = L >> 6;
  const float* PCf = p.au; const float* HLf = p.au + (size_t)MT * 256;
  const float* PCb = p.au + (size_t)2 * MT * 256; const float* HLb = p.au + (size_t)3 * MT * 256;
  float cf = lat ? p.state_lru[((size_t)(b * 2 + l) * 2 + 0) * 256 + C] : 0.f;
  float cb = lat ? p.state_lru[((size_t)(b * 2 + l) * 2 + 1) * 256 + C] : 0.f;
  {
    float pc[15], hl[15];
#pragma unroll
    for (int i = 0; i < 15; ++i) {
      const bool act = i < k;
      const size_t e = (size_t)(ms + 64 * i + 63) * 256 + C;
      pc[i] = act ? PCf[e] : 1.f; hl[i] = act ? HLf[e] : 0.f;
    }
#pragma unroll
    for (int i = 0; i < 15; ++i) cf = pc[i] * cf + hl[i];
  }
  {
    float pc[15], hl[15];
#pragma unroll
    for (int i = 0; i < 15; ++i) {
      const int tix = nt - 1 - i;
      const bool act = tix > k;
      const size_t e = (size_t)(ms + 64 * tix) * 256 + C;
      pc[i] = act ? PCb[e] : 1.f; hl[i] = act ? HLb[e] : 0.f;
    }
#pragma unroll
    for (int i = 0; i < 15; ++i) cb = pc[i] * cb + hl[i];
  }
  float hf_last = 0.f, hb_first = 0.f;
#pragma unroll 16
  for (int t = th; t < th + 32; ++t) {
    const size_t m = m0 + t;
    const float hf = PCf[m * 256 + C] * cf + HLf[m * 256 + C];
    const float hb = PCb[m * 256 + C] * cb + HLb[m * 256 + C];
    const float g = bf2f(p.zf[m * 1792 + 1024 + C]);
    p.abuf[m * 1024 + 512 + C] = f2bf((hf + hb) * g);
    if (t == 0) hb_first = hb;
    if (t == 63) hf_last = hf;
  }
  if (!lat) {
    if (k == nt - 1 && th == 32) p.out[OFF_ST + ((size_t)(b * 2 + l) * 2 + 0) * 256 + C] = hf_last;
    if (k == 0 && th == 0) p.out[OFF_ST + ((size_t)(b * 2 + l) * 2 + 1) * 256 + C] = hb_first;
  }
}

DEV void mixer_phase(const Params& p, int l, char* smem_raw, char* smem) {
  for (int it = blockIdx.x; it < 1024; it += gridDim.x) attn_item(p, l, it, smem_raw);
  const int NITEMS = 512 + 512;
  for (int it = VBID; it < NITEMS; it += VNB) {
    if (it < 512) lru_apply_item(p, l, it);
    else gmlp_item(p, l, it - 512, smem);
  }
}

DEV void prep_phase_full(const Params& p, int l, char* smem) {
  for (int it = VBID; it < 1024; it += VNB) lru_gate_item(p, l, it, smem);
  const int lane = threadIdx.x & 63, mstride = gridDim.x * 8;
  int m = blockIdx.x * 8 + (threadIdx.x >> 6);
  const int c2off = lane < 32 ? 512 + lane * 8 : 1024 + (lane - 32) * 8;
  uint4 n1, n2, n3;
  { const bf16_t* zr = p.zf + (size_t)m * 1792; n1 = *(const uint4*)(zr + lane * 8); n2 = *(const uint4*)(zr + c2off); n3 = *(const uint4*)(zr + 1280 + lane * 8); }
  for (; m < MT; m += mstride) {
    const uint4 c1 = n1, c2 = n2, c3 = n3;
    const int mn = (m + mstride < MT) ? m + mstride : m;
    { const bf16_t* zr = p.zf + (size_t)mn * 1792; n1 = *(const uint4*)(zr + lane * 8); n2 = *(const uint4*)(zr + c2off); n3 = *(const uint4*)(zr + 1280 + lane * 8); }
    prep_token_row(p, l, m, lane, c1, c2, c3);
  }
}


#define XB_TMO      128
#define XB_XCNT(j)  (256  + 64 * (j))
#define XB_XSUB(j)  (1280 + 64 * (j))
#define XB_XGEN(j)  (2304 + 64 * (j))
#define XB_TOP      3328
#define XB_TOPGEN   3392
#define XCD_BAR_WORDS 3456
#define XB_SPIN_CAP (1u << 18)
#define LAS __attribute__((address_space(3)))
DEV unsigned xb_ld(unsigned* p) { return __hip_atomic_load(p, __ATOMIC_RELAXED, __HIP_MEMORY_SCOPE_AGENT); }
DEV unsigned xb_add(unsigned* p, unsigned v) { return __hip_atomic_fetch_add(p, v, __ATOMIC_RELAXED, __HIP_MEMORY_SCOPE_AGENT); }
DEV unsigned xb_xcc_id() { return (unsigned)__builtin_amdgcn_s_getreg((3 << 11) | 20) & 0xFu; }
#define XB_SPIN(cond, bar) do { unsigned _sp = 0; while (cond) { __builtin_amdgcn_s_sleep(1); \
    if ((++_sp & 255u) == 0u) { if (xb_ld(&(bar)[XB_TMO])) break; if (_sp > XB_SPIN_CAP) { atomicAdd(&(bar)[XB_TMO], 1u); break; } } } } while (0)
struct XcdBarrier { unsigned* bar; unsigned x; volatile LAS unsigned* st; };
DEV XcdBarrier xcd_barrier_post(unsigned* bar, volatile LAS unsigned* st) {
  XcdBarrier b; b.bar = bar; b.x = xb_xcc_id(); b.st = st;
  if (threadIdx.x == 0) (void)xb_add(&bar[XB_XCNT(b.x)], 1u);
  return b;
}
DEV void xcd_barrier_complete(unsigned* bar, unsigned x, unsigned& nloc, unsigned& nx) {
  const unsigned G = gridDim.x * gridDim.y * gridDim.z;
  unsigned sum, cnt, mine, sp = 0u;
  for (;;) {
    sum = 0u; cnt = 0u; mine = 0u;
#pragma unroll
    for (unsigned j = 0; j < 16; ++j) { const unsigned c = xb_ld(&bar[XB_XCNT(j)]); sum += c; cnt += (c > 0u) ? 1u : 0u; mine = (j == x) ? c : mine; }
    if (sum == G) break;
    __builtin_amdgcn_s_sleep(1);
    if ((++sp & 255u) == 0u) { if (xb_ld(&bar[XB_TMO])) break; if (sp > XB_SPIN_CAP) { atomicAdd(&bar[XB_TMO], 1u); break; } }
  }
  nloc = mine > 0u ? mine : 1u; nx = cnt > 0u ? cnt : 1u;
}
DEV void xcd_barrier(const XcdBarrier& b) {
  asm volatile("s_waitcnt vmcnt(0)" ::: "memory");
  __syncthreads();
  if (threadIdx.x == 0) {
    unsigned* bar = b.bar;
    __builtin_amdgcn_s_waitcnt(0);
    unsigned nloc = b.st[0], nx = b.st[1];
    if (nloc == 0u) { xcd_barrier_complete(bar, b.x, nloc, nx); b.st[0] = nloc; b.st[1] = nx; }
    const unsigned old = xb_add(&bar[XB_XSUB(b.x)], 1u);
    const unsigned gen = old / nloc;
    if (old + 1u == (gen + 1u) * nloc) {
      __builtin_amdgcn_fence(__ATOMIC_RELEASE, "agent");
      asm volatile("s_waitcnt vmcnt(0)" ::: "memory");
      const unsigned og = xb_add(&bar[XB_TOP], 1u);
      const unsigned tg = og / nx;
      if (og + 1u == (tg + 1u) * nx) xb_add(&bar[XB_TOPGEN], 1u);
      else XB_SPIN(xb_ld(&bar[XB_TOPGEN]) == tg, bar);
      __builtin_amdgcn_fence(__ATOMIC_ACQUIRE, "agent");
      xb_add(&bar[XB_XGEN(b.x)], 1u);
      asm volatile("s_waitcnt vmcnt(0)" ::: "memory");
    } else {
      XB_SPIN(xb_ld(&bar[XB_XGEN(b.x)]) == gen, bar);
      __builtin_amdgcn_fence(__ATOMIC_ACQUIRE, "agent");
      asm volatile("s_waitcnt vmcnt(0)" ::: "memory");
    }
  }
  __syncthreads();
}

#define PH(i, call) if (ph_lo <= (i) && (i) < ph_hi) { if ((i) > ph_lo) xcd_barrier(xb); call; }
#define LAYER(l, b) \
  PH(b + 0, ln_mod_phase(p, l, l == 0 ? 0 : 1)) \
  PH(b + 1, gemm_phase<1>(p, l, p.abuf, p.wt_in + (size_t)l * 1792 * 1024, 1792, 1024, (LAS3 unsigned char*)smem_raw)) \
  PH(b + 2, prep_phase_full(p, l, smem)) \
  PH(b + 3, mixer_phase(p, l, smem_raw, smem)) \
  PH(b + 4, gemm_phase<2>(p, l, p.abuf, p.wt_out + (size_t)l * 1024 * 1024, 1024, 1024, (LAS3 unsigned char*)smem_raw)) \
  PH(b + 5, ln_mod_phase(p, l, 2)) \
  PH(b + 6, gemm_phase<3>(p, l, p.abuf, p.wt_ff1 + (size_t)l * 4096 * 1024, 4096, 1024, (LAS3 unsigned char*)smem_raw)) \
  PH(b + 7, gemm_phase<4>(p, l, p.zf, p.wt_ff2 + (size_t)l * 1024 * 4096, 1024, 4096, (LAS3 unsigned char*)smem_raw))

__global__ void __launch_bounds__(512, 2) mega_kernel(Params p, int ph_lo, int ph_hi) {
  extern __shared__ __attribute__((aligned(16))) char smem_raw[];
  char* smem = smem_raw + (threadIdx.x >> 8) * 65536;
  __shared__ uint4 xb_words;
  if (threadIdx.x == 0) xb_words = make_uint4(0u, 0u, 0u, 0u);
  __syncthreads();
  XcdBarrier xb = xcd_barrier_post(p.bar, (volatile LAS unsigned*)&xb_words);
  if (ph_hi > 1000) { cg::grid_group grid = cg::this_grid(); grid.sync(); }
  PH(0, phase0(p, smem))
  LAYER(0, 1)
  LAYER(1, 9)
  PH(17, ln_mod_phase(p, 1, 3))
}

extern "C" void kernel_launch(void* const* d_in, const int* in_sizes, int n_in, void* d_out, int out_size, void* d_ws, size_t ws_size,
                              hipStream_t stream) {
  static int grid_blocks = 0;
  if (!grid_blocks) {
    int dev = 0, cus = 0, per_cu = 0;
    hipGetDevice(&dev);
    hipDeviceGetAttribute(&cus, hipDeviceAttributeMultiprocessorCount, dev);
    hipFuncSetAttribute((const void*)mega_kernel, hipFuncAttributeMaxDynamicSharedMemorySize, SMEM_BYTES);
    hipOccupancyMaxActiveBlocksPerMultiprocessor(&per_cu, (const void*)mega_kernel, 512, SMEM_BYTES);
    if (per_cu < 1) per_cu = 1;
    if (per_cu > 1) per_cu = 1;
    grid_blocks = cus * per_cu;
  }
  Params p{};
  const float** pin = (const float**)&p;
  for (int i = 0; i < 32; ++i) pin[i] = (const float*)d_in[i];
  p.out = (float*)d_out;
  char* ws = (char*)d_ws;
  size_t off = 0;
  p.bar = (unsigned*)(ws + off); off += 16384;
  p.rstat = (float*)(ws + off); off += (size_t)MT * 2 * 4;
  p.kb_lat = (bf16_t*)(ws + off); off += (size_t)2 * 8 * 2 * 1280 * 64 * 2;
  p.vt_lat = (bf16_t*)(ws + off); off += (size_t)2 * 8 * 2 * 1280 * 64 * 2;
  p.kb_ctx = (bf16_t*)(ws + off); off += (size_t)32 * 2 * 256 * 64 * 2;
  p.vt_ctx = (bf16_t*)(ws + off); off += (size_t)32 * 2 * 256 * 64 * 2;
  p.wt_in = (bf16_t*)(ws + off); off += (size_t)2 * 1792 * 1024 * 2;
  p.wt_out = (bf16_t*)(ws + off); off += (size_t)2 * 1024 * 1024 * 2;
  p.wt_ff1 = (bf16_t*)(ws + off); off += (size_t)2 * 4096 * 1024 * 2;
  p.wt_ff2 = (bf16_t*)(ws + off); off += (size_t)2 * 4096 * 1024 * 2;
  p.wt_lru = (bf16_t*)(ws + off); off += (size_t)64 * 4096 * 2;
  p.mod = (float*)(ws + off); off += (size_t)2 * 9 * 6144 * 4;
  p.rope = (float*)(ws + off); off += (size_t)2048 * 4;
  p.cdec = (float*)(ws + off); off += (size_t)1024 * 4;
  p.abuf = (bf16_t*)(ws + off); off += (size_t)MT * 1024 * 2;
  p.zf = (bf16_t*)(ws + off);
  p.au = (float*)(ws + off + (size_t)MT * 1792 * 2);
  off += (size_t)MT * 4096 * 2;
  if (off > ws_size) { fprintf(stderr, "workspace too small: need %zu have %zu\n", off, ws_size); return; }
  (void)hipMemsetAsync(p.bar, 0, XCD_BAR_WORDS * 4, stream);
#if MULTI_LAUNCH
  for (int ph = 0; ph < NPHASE; ++ph) {
    hipLaunchKernelGGL(mega_kernel, dim3(grid_blocks), dim3(512), SMEM_BYTES, stream, p, ph, ph + 1);
  }
#else
  int lo = 0, hi = NPHASE;
  void* args[] = {&p, &lo, &hi};
  hipError_t e = hipLaunchCooperativeKernel((void*)mega_kernel, dim3(grid_blocks), dim3(512), args, SMEM_BYTES, stream);
  if (e != hipSuccess) fprintf(stderr, "cooperative launch failed: %s (grid %d)\n", hipGetErrorString(e), grid_blocks);
#endif
}
```

```cpp
#include <hip/hip_runtime.h>
#include <hip/hip_cooperative_groups.h>
#include <cstdio>
#include <cstdint>
namespace cg = cooperative_groups;

#ifndef MULTI_LAUNCH
#define MULTI_LAUNCH 0
#endif

typedef unsigned short bf16_t;
using bf16x8 = __attribute__((ext_vector_type(8))) short;
using f32x4 = __attribute__((ext_vector_type(4))) float;
#define DEV __device__ __forceinline__
#define VTID ((int)(threadIdx.x & 255))
#define VBID ((int)(blockIdx.x * 2 + (threadIdx.x >> 8)))
#define VNB ((int)(gridDim.x * 2))

constexpr int MT = 16384;
constexpr int NPHASE = 18;
constexpr size_t OFF_YK = 16777216, OFF_YV = OFF_YK + 2097152, OFF_ST = OFF_YV + 2097152;
constexpr float ALPHA = 1.41421356237f;
constexpr float QSCALE = 0.125f * 1.4426950408889634f;
constexpr int SMEM_BYTES = 131072;

struct Params {
  const float *x_prompt, *x_sample, *c, *cache_k, *cache_v, *state_lru, *c_ctx, *w_ada, *b_ada, *w_in,
      *q_g, *k_g, *conv_w, *conv_b, *lru_wa, *lru_ba, *lru_wx, *lru_bx, *lru_lam, *mlp_g, *mlp_b, *mlp_ws, *mlp_bs,
      *w_out, *ln1_g, *ln1_b, *w_ff1, *b_ff1, *w_ff2, *b_ff2, *ln2_g, *ln2_b;
  float* out;
  bf16_t *wt_in, *wt_out, *wt_ff1, *wt_ff2, *wt_lru;
  float *mod, *rope, *cdec;
  bf16_t *abuf;
  bf16_t *zf;
  float *au;
  bf16_t *kb_lat, *vt_lat;
  bf16_t *kb_ctx, *vt_ctx;
  unsigned *bar;
  float *rstat;
};

union U8 { uint4 u; bf16x8 v; bf16_t h[8]; unsigned w[4]; };

DEV float bf2f(bf16_t h) { return __uint_as_float(((unsigned)h) << 16); }
DEV bf16_t f2bf(float f) { unsigned u = __float_as_uint(f); u += 0x7fffu + ((u >> 16) & 1u); return (bf16_t)(u >> 16); }
DEV unsigned pack2(float a, float b) { unsigned r; asm volatile("v_cvt_pk_bf16_f32 %0, %1, %2" : "=v"(r) : "v"(a), "v"(b)); return r; }
DEV float gelu_t(float x) { float y = 0.7978845608028654f * (x + 0.044715f * x * x * x); float t = 1.f - 2.f * __builtin_amdgcn_rcpf(1.f + __expf(2.f * y)); return 0.5f * x * (1.f + t); }
DEV float sigmoidf_(float x) { return __builtin_amdgcn_rcpf(1.f + __expf(-x)); }
DEV int cond_of(int m) { return m < 8192 ? 0 : 1 + ((m - 8192) >> 10); }
DEV f32x4 mfma16(bf16x8 a, bf16x8 b, f32x4 c) { return __builtin_amdgcn_mfma_f32_16x16x32_bf16(a, b, c, 0, 0, 0); }
DEV float wave_sum(float v) {
#pragma unroll
  for (int o = 32; o >= 1; o >>= 1) v += __shfl_xor(v, o);
  return v;
}

DEV void transpose_tile(const float* __restrict__ src, bf16_t* __restrict__ dst, int lds_, int ldd, char* smem) {
  float* T = (float*)smem;
  const int tid = VTID;
#pragma unroll
  for (int i = 0; i < 4; ++i) {
    int k = (tid >> 4) + 16 * i, n4 = (tid & 15) * 4;
    float4 v = *(const float4*)(src + (size_t)k * lds_ + n4);
    T[k * 65 + n4 + 0] = v.x; T[k * 65 + n4 + 1] = v.y; T[k * 65 + n4 + 2] = v.z; T[k * 65 + n4 + 3] = v.w;
  }
  __syncthreads();
#pragma unroll
  for (int i = 0; i < 2; ++i) {
    int n = (tid >> 3) + 32 * i, k8 = (tid & 7) * 8;
    U8 o;
#pragma unroll
    for (int j = 0; j < 4; ++j) o.w[j] = pack2(T[(k8 + 2 * j) * 65 + n], T[(k8 + 2 * j + 1) * 65 + n]);
    *(uint4*)(dst + (size_t)n * ldd + k8) = o.u;
  }
  __syncthreads();
}
DEV void transpose_w(const float* __restrict__ W, bf16_t* __restrict__ Wt, int K, int N, int tk, int tn, char* smem) {
  transpose_tile(W + (size_t)(tk * 64) * N + tn * 64, Wt + (size_t)(tn * 64) * K + tk * 64, N, K, smem);
}

DEV void tr_desc(const Params& p, int t, const float*& src, int& lds_, bf16_t*& dst, int& ldd) {
  if (t < 2 * 2768) {
    const int l = t / 2768, r = t % 2768;
    const float* W; bf16_t* Wt; int K, N, tk, tn;
    if (r < 448) { W = p.w_in + (size_t)l * 1024 * 1792; Wt = p.wt_in + (size_t)l * 1792 * 1024; K = 1024; N = 1792; tk = r / 28; tn = r % 28; }
    else if (r < 704) { const int i = r - 448; W = p.w_out + (size_t)l * 1024 * 1024; Wt = p.wt_out + (size_t)l * 1024 * 1024; K = 1024; N = 1024; tk = i / 16; tn = i % 16; }
    else if (r < 1728) { const int i = r - 704; W = p.w_ff1 + (size_t)l * 1024 * 4096; Wt = p.wt_ff1 + (size_t)l * 4096 * 1024; K = 1024; N = 4096; tk = i / 64; tn = i % 64; }
    else if (r < 2752) { const int i = r - 1728; W = p.w_ff2 + (size_t)l * 4096 * 1024; Wt = p.wt_ff2 + (size_t)l * 1024 * 4096; K = 4096; N = 1024; tk = i / 16; tn = i % 16; }
    else {
      const int idx = r - 2752, dir = idx >> 3, blk = (idx >> 1) & 3, mat = idx & 1;
      src = (mat == 0 ? p.lru_wa : p.lru_wx) + (size_t)(((l * 2 + dir) * 4 + blk)) * 4096; lds_ = 64;
      dst = p.wt_lru + (size_t)((((l * 2 + dir) * 4 + blk) * 2 + mat)) * 4096; ldd = 64; return;
    }
    src = W + (size_t)(tk * 64) * N + tn * 64; lds_ = N; dst = Wt + (size_t)(tn * 64) * K + tk * 64; ldd = K;
  } else {
    const int j = t - 2 * 2768, tt = j & 3, kvh = (j >> 2) & 1, l = (j >> 3) & 1, b = j >> 4;
    src = p.cache_v + ((size_t)(b * 2 + l) * 256 + tt * 64) * 128 + kvh * 64; lds_ = 128;
    dst = p.vt_lat + ((size_t)((l * 8 + b) * 2 + kvh) * 64) * 1280 + tt * 64; ldd = 1280;
  }
}

DEV void transpose_all(const Params& p, char* smem) {
  constexpr int NTR = 2 * 2768 + 128;
  float* T = (float*)smem;
  const int tid = VTID, kr = tid >> 4, n4 = (tid & 15) * 4;
  int t = VBID;
  if (t >= NTR) return;
  const float* src; bf16_t* dst; int lds_, ldd;
  tr_desc(p, t, src, lds_, dst, ldd);
  float4 cur[4];
#pragma unroll
  for (int i = 0; i < 4; ++i) cur[i] = *(const float4*)(src + (size_t)(kr + 16 * i) * lds_ + n4);
  while (t < NTR) {
    const int tn = t + VNB;
    const float* nsrc = src; bf16_t* ndst = dst; int nlds = lds_, nldd = ldd;
    float4 nxt[4];
    if (tn < NTR) {
      tr_desc(p, tn, nsrc, nlds, ndst, nldd);
#pragma unroll
      for (int i = 0; i < 4; ++i) nxt[i] = *(const float4*)(nsrc + (size_t)(kr + 16 * i) * nlds + n4);
    }
#pragma unroll
    for (int i = 0; i < 4; ++i) {
      const int k = kr + 16 * i;
      T[k * 65 + n4 + 0] = cur[i].x; T[k * 65 + n4 + 1] = cur[i].y; T[k * 65 + n4 + 2] = cur[i].z; T[k * 65 + n4 + 3] = cur[i].w;
    }
    __syncthreads();
#pragma unroll
    for (int i = 0; i < 2; ++i) {
      const int n = (tid >> 3) + 32 * i, k8 = (tid & 7) * 8;
      U8 o;
#pragma unroll
      for (int j = 0; j < 4; ++j) o.w[j] = pack2(T[(k8 + 2 * j) * 65 + n], T[(k8 + 2 * j + 1) * 65 + n]);
      *(uint4*)(dst + (size_t)n * ldd + k8) = o.u;
    }
    __syncthreads();
    if (tn < NTR) {
#pragma unroll
      for (int i = 0; i < 4; ++i) cur[i] = nxt[i];
    }
    src = nsrc; dst = ndst; lds_ = nlds; ldd = nldd; t = tn;
  }
}

DEV void phase0(const Params& p, char* smem) {
  const int tid = VTID;
  const int NT0 = 192 - 128, NITEMS = 192 + 64 + 2;
  for (int it = VBID; it < NITEMS; it += VNB) {
    if (it < 192) {
      const int l = it / 96, n0 = (it % 96) * 64;
      float* s = (float*)smem;
      float* red = s + 9 * 1024;
      for (int idx = tid; idx < 9 * 1024; idx += 256) {
        int c = idx >> 10, k = idx & 1023;
        float v = (c == 0) ? p.c_ctx[k] : p.c[(c - 1) * 1024 + k];
        s[idx] = v / (1.f + __expf(-v));
      }
      __syncthreads();
      const int w = tid >> 6, lane = tid & 63, cq = lane & 15, ks = lane >> 4;
      const int kbase = (w * 4 + ks) * 64;
      float acc[9][4];
#pragma unroll
      for (int c = 0; c < 9; ++c) { acc[c][0] = 0.f; acc[c][1] = 0.f; acc[c][2] = 0.f; acc[c][3] = 0.f; }
      const float* wp = p.w_ada + ((size_t)l * 1024 + kbase) * 6144 + n0 + cq * 4;
      for (int kb = 0; kb < 64; kb += 16) {
        float4 wv[16];
#pragma unroll
        for (int j = 0; j < 16; ++j) wv[j] = *(const float4*)(wp + (size_t)(kb + j) * 6144);
#pragma unroll
        for (int j = 0; j < 16; ++j)
#pragma unroll
          for (int c = 0; c < 9; ++c) {
            const float sv = s[c * 1024 + kbase + kb + j];
            acc[c][0] += sv * wv[j].x; acc[c][1] += sv * wv[j].y; acc[c][2] += sv * wv[j].z; acc[c][3] += sv * wv[j].w;
          }
      }
#pragma unroll
      for (int c = 0; c < 9; ++c)
#pragma unroll
        for (int e = 0; e < 4; ++e) {
          float a = acc[c][e];
          a += __shfl_xor(a, 16); a += __shfl_xor(a, 32);
          if (ks == 0) red[(w * 9 + c) * 64 + cq * 4 + e] = a;
        }
      __syncthreads();
      for (int idx = tid; idx < 576; idx += 256) {
        int c = idx >> 6, nn = idx & 63;
        float v = red[(0 * 9 + c) * 64 + nn] + red[(1 * 9 + c) * 64 + nn] + red[(2 * 9 + c) * 64 + nn] + red[(3 * 9 + c) * 64 + nn] +
                  p.b_ada[l * 6144 + n0 + nn];
        p.mod[((size_t)l * 9 + c) * 6144 + n0 + nn] = v;
      }
      __syncthreads();
    } else if (it >= NT0 + 128 && it < NT0 + 192) {
      const int j = it - NT0 - 128;
#pragma unroll
      for (int i = 0; i < 4; ++i) {
        const int e = (j * 1024 + i * 256 + tid) * 8;
        const int d = e & 63, kvh = (e >> 6) & 1, t = (e >> 7) & 255, l = (e >> 15) & 1, b = e >> 16;
        const float4 a0 = *(const float4*)(p.cache_k + e), a1 = *(const float4*)(p.cache_k + e + 4);
        U8 o; o.w[0] = pack2(a0.x, a0.y); o.w[1] = pack2(a0.z, a0.w); o.w[2] = pack2(a1.x, a1.y); o.w[3] = pack2(a1.z, a1.w);
        *(uint4*)(p.kb_lat + ((size_t)((l * 8 + b) * 2 + kvh) * 1280 + t) * 64 + d) = o.u;
      }
    } else if (it >= NT0 + 192) {
      if (it == NT0 + 192)
      for (int idx = tid; idx < 1024; idx += 256) {
        int pp = idx >> 4, f = idx & 15;
        float inv = powf(10000.f, -(float)f / 16.f);
        float ang = (float)pp * inv;
        float nrev = rintf(ang * 0.15915494309189535f);
        float r = fmaf(-nrev, 6.28125f, ang);
        r = fmaf(-nrev, 0.0019353071795864769f, r);
        p.rope[idx * 2 + 0] = __cosf(r);
        p.rope[idx * 2 + 1] = __sinf(r);
      }
      if (it == NT0 + 192)
      for (int idx = tid; idx < 1024; idx += 256) {
        const float xn = -p.lru_lam[idx];
        p.cdec[idx] = -8.f * (fmaxf(xn, 0.f) + log1pf(expf(-fabsf(xn))));
      }
    }
  }
  transpose_all(p, smem);
}

DEV void ln_mod_phase(const Params& p, int l, int mode) {
  const int lane = threadIdx.x & 63, w = threadIdx.x >> 6;
  const float* lg = nullptr; const float* lb = nullptr;
  if (mode == 1) { lg = p.ln2_g + (l - 1) * 1024; lb = p.ln2_b + (l - 1) * 1024; }
  else if (mode == 2) { lg = p.ln1_g + l * 1024; lb = p.ln1_b + l * 1024; }
  else if (mode == 3) { lg = p.ln2_g + l * 1024; lb = p.ln2_b + l * 1024; }
  const int shoff = (mode == 2) ? 3072 : 0;
  const int mstride = gridDim.x * 8;
  float4 nv[4];
  {
    const int m = blockIdx.x * 8 + w;
    const float* src = (mode == 0) ? ((m < 8192) ? p.x_prompt + (size_t)m * 1024 : p.x_sample + (size_t)(m - 8192) * 1024) : p.out + (size_t)m * 1024;
#pragma unroll
    for (int i = 0; i < 4; ++i) nv[i] = *(const float4*)(src + i * 256 + lane * 4);
  }
  for (int m = blockIdx.x * 8 + w; m < MT; m += mstride) {
    float4 v[4];
#pragma unroll
    for (int i = 0; i < 4; ++i) v[i] = nv[i];
    {
      const int mn = (m + mstride < MT) ? m + mstride : m;
      const float* src = (mode == 0) ? ((mn < 8192) ? p.x_prompt + (size_t)mn * 1024 : p.x_sample + (size_t)(mn - 8192) * 1024) : p.out + (size_t)mn * 1024;
#pragma unroll
      for (int i = 0; i < 4; ++i) nv[i] = *(const float4*)(src + i * 256 + lane * 4);
    }
    if (mode != 0) {
      float s = 0.f;
#pragma unroll
      for (int i = 0; i < 4; ++i) s += v[i].x + v[i].y + v[i].z + v[i].w;
      const float mean = wave_sum(s) * (1.f / 1024.f);
      float s2 = 0.f;
#pragma unroll
      for (int i = 0; i < 4; ++i) { float a = v[i].x - mean, b = v[i].y - mean, c = v[i].z - mean, d = v[i].w - mean; s2 += a * a + b * b + c * c + d * d; }
      const float rstd = rsqrtf(wave_sum(s2) * (1.f / 1024.f) + 1e-6f);
#pragma unroll
      for (int i = 0; i < 4; ++i) {
        float4 g = *(const float4*)(lg + i * 256 + lane * 4), b = *(const float4*)(lb + i * 256 + lane * 4);
        v[i].x = (v[i].x - mean) * rstd * g.x + b.x; v[i].y = (v[i].y - mean) * rstd * g.y + b.y;
        v[i].z = (v[i].z - mean) * rstd * g.z + b.z; v[i].w = (v[i].w - mean) * rstd * g.w + b.w;
        if (mode == 3) *(float4*)(p.out + (size_t)m * 1024 + i * 256 + lane * 4) = v[i];
      }
      if (mode != 3 && lane == 0) *(float2*)(p.rstat + (size_t)m * 2) = make_float2(mean, rstd);
    }
    if (mode != 3) {
      const float* md = p.mod + ((size_t)l * 9 + cond_of(m)) * 6144 + shoff;
#pragma unroll
      for (int i = 0; i < 4; ++i) {
        float4 sh = *(const float4*)(md + i * 256 + lane * 4), sc = *(const float4*)(md + 1024 + i * 256 + lane * 4);
        uint2 o;
        o.x = pack2(v[i].x * (1.f + sc.x) + sh.x, v[i].y * (1.f + sc.y) + sh.y);
        o.y = pack2(v[i].z * (1.f + sc.z) + sh.z, v[i].w * (1.f + sc.w) + sh.w);
        *(uint2*)(p.abuf + (size_t)m * 1024 + i * 256 + lane * 4) = o;
      }
    }
  }
}

#define LAS3 __attribute__((address_space(3)))
namespace g8 {
constexpr int BM = 256, BK = 64, HALF = 128, HTB = HALF * BK * 2, NXCD = 8, WGM = 8;
DEV int lds_byte(int r, int c) { const int st = (r >> 4) * 2 + (c >> 5), rr = r & 15, cc = c & 31, ob = rr * 64 + cc * 2; return st * 1024 + (ob ^ (((ob >> 9) & 1) << 5)); }
DEV void stage_rc(int b, int& R, int& C) { const int st = b / 1024, sb = b % 1024, swz = sb ^ (((sb >> 9) & 1) << 5); R = (st >> 1) * 16 + swz / 64; C = (st & 1) * 32 + (swz % 64) / 2; }
DEV bool unit_of(int i, int nM, int nN, int& pm, int& pn) {
  const int nwg = nM * nN;
  const long L = (long)i * gridDim.x + blockIdx.x; if (L >= nwg) return false;
  int wgid = (int)L; { const int q = nwg / NXCD, r = nwg % NXCD, xcd = wgid % NXCD, off = wgid / NXCD; wgid = (xcd < r ? xcd * (q + 1) : r * (q + 1) + (xcd - r) * q) + off; }
  const int nig = WGM * nN, gid = wgid / nig, fm = gid * WGM, gsz = (nM - fm) < WGM ? (nM - fm) : WGM;
  pm = fm + ((wgid % nig) % gsz); pn = (wgid % nig) / gsz; return true;
}
}

template <int EPI>
DEV void gemm_epilogue(const Params& p, int l, f32x4 (&acc)[2][2][4][2], int pm, int pn, int wr, int wc, int fr, int fq) {
  const int brow = pm * 256, bcol = pn * 256;
  const float* md = p.mod + ((size_t)l * 9 + cond_of(brow)) * 6144;
#pragma unroll
  for (int bj = 0; bj < 2; ++bj)
#pragma unroll
    for (int n = 0; n < 2; ++n) {
      const int col = bcol + bj * 128 + wc * 32 + n * 16 + fq * 4;
      float4 gate = make_float4(0.f, 0.f, 0.f, 0.f), bias = make_float4(0.f, 0.f, 0.f, 0.f);
      if (EPI == 2) gate = *(const float4*)(md + 2048 + col);
      if (EPI == 3) bias = *(const float4*)(p.b_ff1 + l * 4096 + col);
      if (EPI == 4) { gate = *(const float4*)(md + 5120 + col); bias = *(const float4*)(p.b_ff2 + l * 1024 + col); }
#pragma unroll
      for (int ai = 0; ai < 2; ++ai)
#pragma unroll
        for (int m = 0; m < 4; ++m) {
          const int row = brow + ai * 128 + wr * 64 + m * 16 + fr;
          const f32x4 v = acc[ai][bj][m][n];
          if (EPI == 1) {
            uint2 o; o.x = pack2(v[0], v[1]); o.y = pack2(v[2], v[3]);
            *(uint2*)(p.zf + (size_t)row * 1792 + col) = o;
          } else if (EPI == 2) {
            const float* xs = (l == 0) ? ((row < 8192) ? p.x_prompt + (size_t)row * 1024 : p.x_sample + (size_t)(row - 8192) * 1024) : p.out + (size_t)row * 1024;
            const float4 x = *(const float4*)(xs + col);
            *(float4*)(p.out + (size_t)row * 1024 + col) = make_float4(ALPHA * x.x + gate.x * v[0], ALPHA * x.y + gate.y * v[1], ALPHA * x.z + gate.z * v[2], ALPHA * x.w + gate.w * v[3]);
          } else if (EPI == 3) {
            const float t0 = fmaxf(v[0] + bias.x, 0.f), t1 = fmaxf(v[1] + bias.y, 0.f), t2 = fmaxf(v[2] + bias.z, 0.f), t3 = fmaxf(v[3] + bias.w, 0.f);
            uint2 o; o.x = pack2(t0 * t0, t1 * t1); o.y = pack2(t2 * t2, t3 * t3);
            *(uint2*)(p.zf + (size_t)row * 4096 + col) = o;
          } else {
            float* xo = p.out + (size_t)row * 1024 + col;
            const float4 x = *(const float4*)xo;
            *(float4*)xo = make_float4(ALPHA * x.x + gate.x * (v[0] + bias.x), ALPHA * x.y + gate.y * (v[1] + bias.y), ALPHA * x.z + gate.z * (v[2] + bias.z), ALPHA * x.w + gate.w * (v[3] + bias.w));
          }
        }
    }
}

template <int EPI>
DEV void gemm_epilogue_lnres(const Params& p, int l, f32x4 (&acc)[2][2][4][2], int pm, int pn, int wr, int wc, int fr, int fq) {
  const int brow = pm * 256, bcol = pn * 256;
  const float* md = p.mod + ((size_t)l * 9 + cond_of(brow)) * 6144;
  float mean[2][4], rstd[2][4];
  {
    const unsigned so = (unsigned)(brow + wr * 64 + fr) * 2u;
#pragma unroll
    for (int ai = 0; ai < 2; ++ai)
#pragma unroll
      for (int m = 0; m < 4; ++m) { const float2 t = *(const float2*)(p.rstat + (so + (unsigned)((ai * 128 + m * 16) * 2))); mean[ai][m] = t.x; rstd[ai][m] = t.y; }
  }
  const float* lg = (EPI == 2) ? p.ln2_g + (l - 1) * 1024 : p.ln1_g + l * 1024;
  const float* lb = (EPI == 2) ? p.ln2_b + (l - 1) * 1024 : p.ln1_b + l * 1024;
  const unsigned co = (unsigned)(bcol + wc * 32 + fq * 4);
  const unsigned ro = (unsigned)(brow + wr * 64 + fr) * 1024u + co;
#pragma unroll
  for (int bj = 0; bj < 2; ++bj)
#pragma unroll
    for (int n = 0; n < 2; ++n) {
      unsigned col = co + (unsigned)(bj * 128 + n * 16), rb = ro + (unsigned)(bj * 128 + n * 16);
      asm volatile("" : "+v"(col), "+v"(rb));
      float4 gate, bias = make_float4(0.f, 0.f, 0.f, 0.f);
      if (EPI == 2) gate = *(const float4*)(md + 2048 + col);
      else { gate = *(const float4*)(md + 5120 + col); bias = *(const float4*)(p.b_ff2 + l * 1024 + col); }
      const float4 g4 = *(const float4*)(lg + col), b4 = *(const float4*)(lb + col);
#pragma unroll
      for (int ai = 0; ai < 2; ++ai)
#pragma unroll
        for (int m = 0; m < 4; ++m) {
          float* xo = p.out + (rb + (unsigned)((ai * 128 + m * 16) * 1024));
          const float4 x = *(const float4*)xo;
          const float mu = mean[ai][m], rr = rstd[ai][m];
          const f32x4 v = acc[ai][bj][m][n];
          const float x0 = (x.x - mu) * rr * g4.x + b4.x, x1 = (x.y - mu) * rr * g4.y + b4.y, x2 = (x.z - mu) * rr * g4.z + b4.z, x3 = (x.w - mu) * rr * g4.w + b4.w;
          *(float4*)xo = make_float4(ALPHA * x0 + gate.x * (v[0] + bias.x), ALPHA * x1 + gate.y * (v[1] + bias.y), ALPHA * x2 + gate.z * (v[2] + bias.z), ALPHA * x3 + gate.w * (v[3] + bias.w));
        }
    }
}

template <int EPI>
DEV void gemm_phase(const Params& p, int l, const bf16_t* Ag, const bf16_t* Btg, int N, int K, LAS3 unsigned char* lds) {
  using namespace g8;
  const int tid = threadIdx.x, wid = __builtin_amdgcn_readfirstlane(tid >> 6), lane = tid & 63, wr = wid >> 2, wc = wid & 3, fr = lane & 15, fq = lane >> 4;
  const int nt = K / BK, nM = MT / BM, nN = N / BM;
  unsigned voff[2];
#pragma unroll
  for (int i = 0; i < 2; ++i) { int R, C; stage_rc(tid * 16 + i * 8192, R, C); voff[i] = (unsigned)(R * K + C) * 2u; }
  const size_t kstep = (size_t)(BK * 2);
  const size_t hstep = (size_t)HALF * K * 2;
  const size_t tstep = 2 * hstep;
  const unsigned ldsw = (unsigned)wid * 1024u;
  const int aoff = lds_byte(wr * 64 + fr, fq * 8), boff = lds_byte(wc * 32 + fr, fq * 8);
#define PG8_SA(b, h) (((b) * 2 + (h)) * HTB)
#define PG8_SB(b, h) ((4 + (b) * 2 + (h)) * HTB)
#define PG8_STAGE(bufoff, gbase) do { _Pragma("unroll") for (int _i = 0; _i < 2; ++_i) \
    __builtin_amdgcn_global_load_lds((const unsigned*)((const char*)(gbase) + voff[_i]), (LAS3 unsigned*)(lds + (bufoff) + ldsw + _i * 8192), 16, 0, 0); } while (0)
#define PG8_LDA(dst, b, h) do { _Pragma("unroll") for (int m = 0; m < 4; ++m) _Pragma("unroll") for (int k = 0; k < 2; ++k) dst[m][k] = *(const LAS3 bf16x8*)(lds + PG8_SA(b, h) + aoff + m * 2048 + k * 1024); } while (0)
#define PG8_LDB(dst, b, h) do { _Pragma("unroll") for (int n = 0; n < 2; ++n) _Pragma("unroll") for (int k = 0; k < 2; ++k) dst[n][k] = *(const LAS3 bf16x8*)(lds + PG8_SB(b, h) + boff + n * 2048 + k * 1024); } while (0)
#define PG8_MMA(ai, bj, At_, Bt_) do { __builtin_amdgcn_s_setprio(1); _Pragma("unroll") for (int m = 0; m < 4; ++m) _Pragma("unroll") for (int n = 0; n < 2; ++n) _Pragma("unroll") for (int k = 0; k < 2; ++k) \
    acc[ai][bj][m][n] = __builtin_amdgcn_mfma_f32_16x16x32_bf16(Bt_[n][k], At_[m][k], acc[ai][bj][m][n], 0, 0, 0); __builtin_amdgcn_s_setprio(0); } while (0)
#define PG8_WAIT_V(n) asm volatile("s_waitcnt vmcnt(" #n ")" ::: "memory")
#define PG8_WAIT_L(n) asm volatile("s_waitcnt lgkmcnt(" #n ")" ::: "memory")
#define PG8_BAR __builtin_amdgcn_s_barrier()
#define PG8_SCHED __builtin_amdgcn_sched_barrier(0)
  int cpm, cpn, npm = 0, npn = 0, ui = 0;
  if (!unit_of(0, nM, nN, cpm, cpn)) return;
  f32x4 acc[2][2][4][2];
#pragma unroll
  for (int a = 0; a < 2; ++a)
#pragma unroll
    for (int b = 0; b < 2; ++b)
#pragma unroll
      for (int m = 0; m < 4; ++m)
#pragma unroll
        for (int n = 0; n < 2; ++n) acc[a][b][m][n] = (f32x4){0.f, 0.f, 0.f, 0.f};
  bf16x8 At[4][2], B0[2][2], B1[2][2];
  const char* cA = (const char*)Ag + (size_t)cpm * tstep; const char* cB = (const char*)Btg + (size_t)cpn * tstep;
  PG8_STAGE(PG8_SB(0, 0), cB); PG8_STAGE(PG8_SA(0, 0), cA); PG8_STAGE(PG8_SB(0, 1), cB + hstep); PG8_STAGE(PG8_SA(0, 1), cA + hstep);
  if (wr == 1) PG8_BAR;
  PG8_WAIT_V(4); PG8_BAR;
  PG8_STAGE(PG8_SB(1, 0), cB + kstep); PG8_STAGE(PG8_SA(1, 0), cA + kstep); PG8_STAGE(PG8_SB(1, 1), cB + hstep + kstep);
  PG8_WAIT_V(6); PG8_BAR;
  for (;;) {
    const bool has_next = unit_of(ui + 1, nM, nN, npm, npn);
    const char* nA = has_next ? (const char*)Ag + (size_t)npm * tstep : cA; const char* nB = has_next ? (const char*)Btg + (size_t)npn * tstep : cB;
    for (int t = 0; t < nt; t += 2) {
      const bool last = (t == nt - 2);
      const char* a1 = cA + (size_t)(t + 1) * kstep;
      const char* a2 = last ? nA : cA + (size_t)(t + 2) * kstep; const char* b2 = last ? nB : cB + (size_t)(t + 2) * kstep;
      const char* a3 = a2 + kstep; const char* b3 = b2 + kstep;
      PG8_LDB(B0, 0, 0); PG8_SCHED; PG8_LDA(At, 0, 0); PG8_STAGE(PG8_SA(1, 1), a1 + hstep);
      PG8_WAIT_L(8); PG8_BAR; PG8_WAIT_L(0); PG8_MMA(0, 0, At, B0); PG8_BAR; PG8_SCHED;
      PG8_LDB(B1, 0, 1); PG8_STAGE(PG8_SB(0, 0), b2);
      PG8_BAR; PG8_WAIT_L(0); PG8_MMA(0, 1, At, B1); PG8_BAR;
      PG8_LDA(At, 0, 1); PG8_STAGE(PG8_SA(0, 0), a2);
      PG8_BAR; PG8_WAIT_L(0); PG8_MMA(1, 0, At, B0); PG8_BAR; PG8_SCHED;
      PG8_STAGE(PG8_SB(0, 1), b2 + hstep);
      PG8_WAIT_V(6); PG8_BAR; PG8_MMA(1, 1, At, B1); PG8_BAR;
      PG8_LDB(B0, 1, 0); PG8_SCHED; PG8_LDA(At, 1, 0); PG8_STAGE(PG8_SA(0, 1), a2 + hstep);
      PG8_WAIT_L(8); PG8_BAR; PG8_WAIT_L(0); PG8_MMA(0, 0, At, B0); PG8_BAR; PG8_SCHED;
      PG8_LDB(B1, 1, 1); PG8_STAGE(PG8_SB(1, 0), b3);
      PG8_BAR; PG8_WAIT_L(0); PG8_MMA(0, 1, At, B1); PG8_BAR;
      PG8_LDA(At, 1, 1); PG8_STAGE(PG8_SA(1, 0), a3);
      PG8_BAR; PG8_WAIT_L(0); PG8_MMA(1, 0, At, B0); PG8_BAR; PG8_SCHED;
      PG8_STAGE(PG8_SB(1, 1), b3 + hstep);
      PG8_WAIT_V(6); PG8_BAR; PG8_MMA(1, 1, At, B1); PG8_BAR;
    }
    if (EPI == 4 || (EPI == 2 && l > 0)) gemm_epilogue_lnres<EPI>(p, l, acc, cpm, cpn, wr, wc, fr, fq);
    else gemm_epilogue<EPI>(p, l, acc, cpm, cpn, wr, wc, fr, fq);
    if (!has_next) break;
#pragma unroll
    for (int a = 0; a < 2; ++a)
#pragma unroll
      for (int b = 0; b < 2; ++b)
#pragma unroll
        for (int m = 0; m < 4; ++m)
#pragma unroll
          for (int n = 0; n < 2; ++n) acc[a][b][m][n] = (f32x4){0.f, 0.f, 0.f, 0.f};
    cpm = npm; cpn = npn; cA = nA; cB = nB; ++ui;
  }
  PG8_WAIT_V(0);
  if (wr == 0) PG8_BAR;
  PG8_BAR;
#undef PG8_SA
#undef PG8_SB
#undef PG8_STAGE
#undef PG8_LDA
#undef PG8_LDB
#undef PG8_MMA
#undef PG8_WAIT_V
#undef PG8_WAIT_L
#undef PG8_BAR
#undef PG8_SCHED
}

DEV void rope8(float (&v)[8], int d0, int prow, int pcol, const float* __restrict__ rope) {
  const int pp = (d0 < 32) ? prow : pcol;
#pragma unroll
  for (int i = 0; i < 4; ++i) {
    const int f = ((d0 >> 1) + i) & 15;
    const float cs = rope[(pp * 16 + f) * 2], sn = rope[(pp * 16 + f) * 2 + 1];
    const float x1 = v[2 * i], x2 = v[2 * i + 1];
    v[2 * i] = x1 * cs - x2 * sn; v[2 * i + 1] = x1 * sn + x2 * cs;
  }
}

DEV void prep_token_row(const Params& p, int l, int m, int lane, uint4 c) {
  bf16_t* zr = p.zf + (size_t)m * 1792;
  const bool lat = m >= 8192;
  const int pos = lat ? ((m - 8192) & 1023) : (m & 255);
  const int prow = pos >> 6, pcol = pos & 63;
  const int d0 = (lane & 7) * 8;
  U8 u; u.u = c;
  float v[8], gl[8]; float ss = 0.f, sg = 0.f;
#pragma unroll
  for (int j = 0; j < 8; ++j) { v[j] = bf2f(u.h[j]); ss += v[j] * v[j]; gl[j] = gelu_t(v[j]); sg += gl[j]; }
  ss += __shfl_xor(ss, 1); ss += __shfl_xor(ss, 2); ss += __shfl_xor(ss, 4);
#pragma unroll
  for (int o = 1; o <= 16; o <<= 1) sg += __shfl_xor(sg, o);
  const float mean = sg * (1.f / 256.f);
  float s2 = 0.f;
#pragma unroll
  for (int j = 0; j < 8; ++j) { const float d = gl[j] - mean; s2 += d * d; }
#pragma unroll
  for (int o = 1; o <= 16; o <<= 1) s2 += __shfl_xor(s2, o);
  if (lane < 16) {
    const float rinv = rsqrtf(ss * (1.f / 64.f) + 1e-6f);
#pragma unroll
    for (int j = 0; j < 8; ++j) v[j] = v[j] * rinv * p.k_g[l * 64 + d0 + j];
    if (!lat) {
      float* o = p.out + OFF_YK + ((((size_t)(m >> 8)) * 2 + l) * 256 + pos) * 128 + lane * 8;
      *(float4*)o = make_float4(v[0], v[1], v[2], v[3]); *(float4*)(o + 4) = make_float4(v[4], v[5], v[6], v[7]);
    } else rope8(v, d0, prow, pcol, p.rope);
#pragma unroll
    for (int j = 0; j < 4; ++j) u.w[j] = pack2(v[2 * j], v[2 * j + 1]);
    const int kvh = lane >> 3;
    bf16_t* kd = lat ? p.kb_lat + ((size_t)((l * 8 + ((m - 8192) >> 10)) * 2 + kvh) * 1280 + 256 + pos) * 64 + d0
                     : p.kb_ctx + ((size_t)((m >> 8) * 2 + kvh) * 256 + pos) * 64 + d0;
    *(uint4*)kd = u.u;
  } else if (lane < 32) {
    if (!lat) {
      float* o = p.out + OFF_YV + ((((size_t)(m >> 8)) * 2 + l) * 256 + pos) * 128 + (lane - 16) * 8;
      *(float4*)o = make_float4(v[0], v[1], v[2], v[3]); *(float4*)(o + 4) = make_float4(v[4], v[5], v[6], v[7]);
    }
    const int kvh = (lane - 16) >> 3;
    bf16_t* vd; int T;
    if (lat) { T = 1280; vd = p.vt_lat + ((size_t)((l * 8 + ((m - 8192) >> 10)) * 2 + kvh) * 64 + d0) * 1280 + 256 + pos; }
    else { T = 256; vd = p.vt_ctx + ((size_t)((m >> 8) * 2 + kvh) * 64 + d0) * 256 + pos; }
#pragma unroll
    for (int j = 0; j < 8; ++j) vd[(size_t)j * T] = u.h[j];
  } else {
    const float rstd = rsqrtf(s2 * (1.f / 256.f) + 1e-6f);
    const int ch = (lane - 32) * 8;
#pragma unroll
    for (int j = 0; j < 8; ++j) gl[j] = (gl[j] - mean) * rstd * p.mlp_g[l * 256 + ch + j] + p.mlp_b[l * 256 + ch + j];
#pragma unroll
    for (int j = 0; j < 4; ++j) u.w[j] = pack2(gl[2 * j], gl[2 * j + 1]);
    *(uint4*)(zr + 1536 + ch) = u.u;
  }
}

template <bool REV>
DEV void tile_scan(float (&a)[4][4], float (&u)[4][4], int lane) {
  const int q = lane >> 4;
  float C = 0.f, CP = 1.f;
  const int src1 = (REV ? lane + 16 : lane - 16) & 63;
  const int src2 = (REV ? lane + 32 : lane - 32) & 63;
  const int srcT = (lane & 15) + (REV ? 0 : 48);
  const bool c1 = REV ? (q <= 2) : (q >= 1);
  const bool c2 = REV ? (q <= 1) : (q >= 2);
  const bool first = REV ? (q == 3) : (q == 0);
#pragma unroll
  for (int mi = 0; mi < 4; ++mi) {
    const int mt = REV ? 3 - mi : mi;
    float P = 1.f, H = 0.f, pl[4], hl[4];
#pragma unroll
    for (int ri = 0; ri < 4; ++ri) {
      const int r = REV ? 3 - ri : ri;
      H = a[mt][r] * H + u[mt][r]; P *= a[mt][r]; pl[r] = P; hl[r] = H;
    }
    float Pi = P, Hi = H;
    float Pp = __shfl(Pi, src1), Hp = __shfl(Hi, src1);
    if (c1) { Hi = Pi * Hp + Hi; Pi = Pi * Pp; }
    Pp = __shfl(Pi, src2); Hp = __shfl(Hi, src2);
    if (c2) { Hi = Pi * Hp + Hi; Pi = Pi * Pp; }
    float Pe = __shfl(Pi, src1), He = __shfl(Hi, src1);
    if (first) { Pe = 1.f; He = 0.f; }
    const float hin = Pe * C + He, pin = Pe * CP;
#pragma unroll
    for (int r = 0; r < 4; ++r) { u[mt][r] = pl[r] * hin + hl[r]; a[mt][r] = pl[r] * pin; }
    const float Pt = __shfl(Pi, srcT), Ht = __shfl(Hi, srcT);
    C = Pt * C + Ht; CP = Pt * CP;
  }
}

DEV void lru_gate_item(const Params& p, int l, int item, char* smem) {
  const int tid = VTID, lane = tid & 63, w = tid >> 6;
  const int tile = item >> 2, blk = item & 3;
  const int m0 = tile * 64;
  int ms, L;
  if (m0 < 8192) { ms = m0 & ~255; L = 256; } else { ms = 8192 + ((m0 - 8192) & ~1023); L = 1024; }
  const int dir = w >> 1, half = w & 1, q = lane >> 4, c15 = lane & 15;
  const bf16_t* wt = p.wt_lru + (size_t)((((l * 2 + dir) * 4 + blk) * 2)) * 4096;
  bf16x8 bfr[2][2][2];
#pragma unroll
  for (int mat = 0; mat < 2; ++mat)
#pragma unroll
    for (int j = 0; j < 2; ++j)
#pragma unroll
      for (int s = 0; s < 2; ++s) bfr[mat][j][s] = *(const bf16x8*)(wt + mat * 4096 + (half * 32 + j * 16 + c15) * 64 + s * 32 + q * 8);
  float* xs = (float*)smem;
  float* xcf = xs + 67 * 64;
  bf16_t* xcb = (bf16_t*)(xcf + 64 * 64);
  for (int idx = tid; idx < 67 * 8; idx += 256) {
    const int rr = idx >> 3, cc = idx & 7;
    const int m = m0 - 1 + rr;
    float v[8];
    if (m >= ms && m < ms + L) {
      U8 u; u.u = *(const uint4*)(p.zf + (size_t)m * 1792 + 768 + blk * 64 + cc * 8);
#pragma unroll
      for (int j = 0; j < 8; ++j) v[j] = bf2f(u.h[j]);
    } else {
#pragma unroll
      for (int j = 0; j < 8; ++j) v[j] = 0.f;
    }
#pragma unroll
    for (int j = 0; j < 8; ++j) xs[rr * 64 + cc * 8 + j] = v[j];
  }
  __syncthreads();
  {
    const int ch = tid & 63, Cg = blk * 64 + ch;
    const float w0 = p.conv_w[(l * 4 + 0) * 256 + Cg], w1 = p.conv_w[(l * 4 + 1) * 256 + Cg], w2 = p.conv_w[(l * 4 + 2) * 256 + Cg],
                w3 = p.conv_w[(l * 4 + 3) * 256 + Cg], cb = p.conv_b[l * 256 + Cg];
#pragma unroll 4
    for (int tt = 0; tt < 16; ++tt) {
      const int t = (tid >> 6) * 16 + tt;
      const float v = cb + w0 * xs[t * 64 + ch] + w1 * xs[(t + 1) * 64 + ch] + w2 * xs[(t + 2) * 64 + ch] + w3 * xs[(t + 3) * 64 + ch];
      xcf[t * 64 + ch] = v; xcb[t * 72 + ch] = f2bf(v);
    }
  }
  __syncthreads();
  f32x4 acc[2][4][2];
#pragma unroll
  for (int mat = 0; mat < 2; ++mat)
#pragma unroll
    for (int mt = 0; mt < 4; ++mt)
#pragma unroll
      for (int j = 0; j < 2; ++j) acc[mat][mt][j] = f32x4{0.f, 0.f, 0.f, 0.f};
#pragma unroll
  for (int mt = 0; mt < 4; ++mt)
#pragma unroll
    for (int s = 0; s < 2; ++s) {
      const bf16x8 af = *(const bf16x8*)(xcb + (mt * 16 + c15) * 72 + s * 32 + q * 8);
#pragma unroll
      for (int mat = 0; mat < 2; ++mat)
#pragma unroll
        for (int j = 0; j < 2; ++j) acc[mat][mt][j] = mfma16(af, bfr[mat][j][s], acc[mat][mt][j]);
    }
  float* PCp = p.au + (size_t)(dir * 2 + 0) * MT * 256;
  float* HLp = p.au + (size_t)(dir * 2 + 1) * MT * 256;
#pragma unroll
  for (int j = 0; j < 2; ++j) {
    const int ch = half * 32 + j * 16 + c15, Cg = blk * 64 + ch, pidx = (l * 2 + dir) * 256 + Cg;
    const float ba = p.lru_ba[pidx], bx = p.lru_bx[pidx];
    const float cdec = p.cdec[pidx];
    float a[4][4], u[4][4];
#pragma unroll
    for (int mt = 0; mt < 4; ++mt)
#pragma unroll
      for (int r = 0; r < 4; ++r) {
        const int t = mt * 16 + q * 4 + r;
        const float rg = sigmoidf_(acc[0][mt][j][r] + ba), ig = sigmoidf_(acc[1][mt][j][r] + bx);
        const float la = cdec * rg;
        a[mt][r] = __expf(la);
        const float x2 = 2.f * la;
        const float em = (x2 < -0.25f) ? 1.f - __expf(x2) : -x2 * (1.f + x2 * (0.5f + x2 * (1.f / 6.f + x2 * (1.f / 24.f + x2 * (1.f / 120.f + x2 * (1.f / 720.f))))));
        u[mt][r] = __builtin_amdgcn_sqrtf(em) * ig * xcf[t * 64 + ch];
      }
    if (dir == 0) tile_scan<false>(a, u, lane); else tile_scan<true>(a, u, lane);
#pragma unroll
    for (int mt = 0; mt < 4; ++mt)
#pragma unroll
      for (int r = 0; r < 4; ++r) {
        const size_t m = m0 + mt * 16 + q * 4 + r;
        PCp[m * 256 + Cg] = a[mt][r]; HLp[m * 256 + Cg] = u[mt][r];
      }
  }
  __syncthreads();
}

DEV void attn_item(const Params& p, int l, int it, char* sm) {
  const int tid = threadIdx.x, lane = tid & 63, w = tid >> 6, q = lane >> 4, c15 = lane & 15;
  const int qg = w >> 1, kh = w & 1;
  int h, ms, nkt, T; const bf16_t* Kg; const bf16_t* Vg;
  if (it < 512) {
    const int b = it >> 6, qb = it & 7; h = (it >> 3) & 7; ms = 8192 + b * 1024 + qb * 128; nkt = 10; T = 1280;
    Kg = p.kb_lat + (size_t)((l * 8 + b) * 2 + (h >> 2)) * 1280 * 64; Vg = p.vt_lat + (size_t)((l * 8 + b) * 2 + (h >> 2)) * 64 * 1280;
  } else {
    const int i2 = it - 512, b = i2 >> 4, qb = i2 & 1; h = (i2 >> 1) & 7; ms = b * 256 + qb * 128; nkt = 2; T = 256;
    Kg = p.kb_ctx + (size_t)(b * 2 + (h >> 2)) * 256 * 64; Vg = p.vt_ctx + (size_t)(b * 2 + (h >> 2)) * 64 * 256;
  }
  const int kc0 = tid, kc1 = tid + 512;
  const int vd0 = tid >> 4, vk = (tid & 15) * 8;
  const int vpos = ((tid & 15) >> 2) * 32 + 16 * (tid & 1) + 4 * ((tid & 3) >> 1);
  const bf16_t* vg0 = Vg + (size_t)vd0 * T + vk;
  const bf16_t* vg1 = Vg + (size_t)(vd0 + 32) * T + vk;
  uint4 rk0, rk1, rv0, rv1;
#define ATT_LOAD(kt) do { rk0 = *(const uint4*)(Kg + (size_t)(kt) * 8192 + kc0 * 8); rk1 = *(const uint4*)(Kg + (size_t)(kt) * 8192 + kc1 * 8); \
    rv0 = *(const uint4*)(vg0 + (kt) * 128); rv1 = *(const uint4*)(vg1 + (kt) * 128); } while (0)
#define ATT_STORE(buf) do { bf16_t* Ks_ = (bf16_t*)(sm + (buf) * 36864); bf16_t* Vs_ = Ks_ + 9216; \
    *(uint4*)(Ks_ + (kc0 >> 3) * 72 + (kc0 & 7) * 8) = rk0; *(uint4*)(Ks_ + (kc1 >> 3) * 72 + (kc1 & 7) * 8) = rk1; \
    *(uint2*)(Vs_ + vd0 * 136 + vpos) = make_uint2(rv0.x, rv0.y); *(uint2*)(Vs_ + vd0 * 136 + vpos + 8) = make_uint2(rv0.z, rv0.w); \
    *(uint2*)(Vs_ + (vd0 + 32) * 136 + vpos) = make_uint2(rv1.x, rv1.y); *(uint2*)(Vs_ + (vd0 + 32) * 136 + vpos + 8) = make_uint2(rv1.z, rv1.w); } while (0)
  ATT_LOAD(0);
  const int mq = ms + qg * 32;
  bf16x8 qf[2][2];
#pragma unroll
  for (int t = 0; t < 2; ++t)
#pragma unroll
    for (int s = 0; s < 2; ++s) qf[t][s] = *(const bf16x8*)(p.zf + (size_t)(mq + t * 16 + c15) * 1792 + h * 64 + s * 32 + q * 8);
  ATT_STORE(0);
  if (nkt > 1) ATT_LOAD(1);
#pragma unroll
  for (int t = 0; t < 2; ++t) {
    float f[2][8]; float ss = 0.f;
#pragma unroll
    for (int s = 0; s < 2; ++s)
#pragma unroll
      for (int j = 0; j < 8; ++j) { f[s][j] = bf2f((bf16_t)qf[t][s][j]); ss += f[s][j] * f[s][j]; }
    ss += __shfl_xor(ss, 16); ss += __shfl_xor(ss, 32);
    const float rinv = rsqrtf(ss * (1.f / 64.f) + 1e-6f);
    const int mrow_ = mq + t * 16 + c15;
    const int pos = (mrow_ - 8192) & 1023;
#pragma unroll
    for (int s = 0; s < 2; ++s) {
      const int dd = s * 32 + q * 8;
#pragma unroll
      for (int j = 0; j < 8; ++j) f[s][j] = f[s][j] * rinv * p.q_g[l * 64 + dd + j];
      if (it < 512) rope8(f[s], dd, pos >> 6, pos & 63, p.rope);
      U8 pk;
#pragma unroll
      for (int j = 0; j < 4; ++j) pk.w[j] = pack2(f[s][2 * j] * QSCALE, f[s][2 * j + 1] * QSCALE);
      qf[t][s] = pk.v;
    }
  }
  __syncthreads();
  f32x4 o[2][4];
  float mrow[2], lrow[2];
#pragma unroll
  for (int t = 0; t < 2; ++t) { mrow[t] = -1e30f; lrow[t] = 0.f;
#pragma unroll
    for (int j = 0; j < 4; ++j) o[t][j] = f32x4{0.f, 0.f, 0.f, 0.f}; }
  for (int kt = 0; kt < nkt; ++kt) {
    const int cur = kt & 1;
    const bf16_t* Ks = (const bf16_t*)(sm + cur * 36864) + kh * 64 * 72;
    const bf16_t* Vs = (const bf16_t*)(sm + cur * 36864) + 9216 + kh * 64;
    f32x4 s4[2][4];
    {
      bf16x8 kf[4][2];
#pragma unroll
      for (int jn = 0; jn < 4; ++jn)
#pragma unroll
        for (int s = 0; s < 2; ++s) kf[jn][s] = *(const bf16x8*)(Ks + (jn * 16 + c15) * 72 + s * 32 + q * 8);
      __builtin_amdgcn_sched_barrier(0);
#pragma unroll
      for (int jn = 0; jn < 4; ++jn)
#pragma unroll
        for (int t = 0; t < 2; ++t) s4[t][jn] = mfma16(kf[jn][0], qf[t][0], f32x4{0.f, 0.f, 0.f, 0.f});
#pragma unroll
      for (int jn = 0; jn < 4; ++jn)
#pragma unroll
        for (int t = 0; t < 2; ++t) s4[t][jn] = mfma16(kf[jn][1], qf[t][1], s4[t][jn]);
      __builtin_amdgcn_sched_barrier(0);
    }
    U8 vf[4][2];
#pragma unroll
    for (int jn = 0; jn < 4; ++jn)
#pragma unroll
      for (int ks = 0; ks < 2; ++ks) vf[jn][ks].u = *(const uint4*)(Vs + (jn * 16 + c15) * 136 + ks * 32 + q * 8);
    __builtin_amdgcn_sched_barrier(0);
    U8 pb[2][2];
#pragma unroll
    for (int t = 0; t < 2; ++t) {
      float mx = s4[t][0][0];
#pragma unroll
      for (int jn = 0; jn < 4; ++jn)
#pragma unroll
        for (int r = 0; r < 4; ++r) mx = fmaxf(mx, s4[t][jn][r]);
      mx = fmaxf(mx, __shfl_xor(mx, 16)); mx = fmaxf(mx, __shfl_xor(mx, 32));
      const float mnew = fmaxf(mrow[t], mx);
      const float alpha = __builtin_amdgcn_exp2f(mrow[t] - mnew);
      mrow[t] = mnew;
      float ls = 0.f;
#pragma unroll
      for (int jn = 0; jn < 4; ++jn)
#pragma unroll
        for (int r = 0; r < 4; ++r) { const float pv = __builtin_amdgcn_exp2f(s4[t][jn][r] - mnew); s4[t][jn][r] = pv; ls += pv; }
      lrow[t] = lrow[t] * alpha + ls;
#pragma unroll
      for (int jn = 0; jn < 4; ++jn) { o[t][jn][0] *= alpha; o[t][jn][1] *= alpha; o[t][jn][2] *= alpha; o[t][jn][3] *= alpha; }
#pragma unroll
      for (int ks = 0; ks < 2; ++ks) {
        pb[t][ks].w[0] = pack2(s4[t][2 * ks][0], s4[t][2 * ks][1]); pb[t][ks].w[1] = pack2(s4[t][2 * ks][2], s4[t][2 * ks][3]);
        pb[t][ks].w[2] = pack2(s4[t][2 * ks + 1][0], s4[t][2 * ks + 1][1]); pb[t][ks].w[3] = pack2(s4[t][2 * ks + 1][2], s4[t][2 * ks + 1][3]);
      }
    }
#pragma unroll
    for (int ks = 0; ks < 2; ++ks)
#pragma unroll
      for (int jn = 0; jn < 4; ++jn)
#pragma unroll
        for (int t = 0; t < 2; ++t) o[t][jn] = mfma16(vf[jn][ks].v, pb[t][ks].v, o[t][jn]);
    if (kt + 1 < nkt) {
      ATT_STORE(cur ^ 1);
      if (kt + 2 < nkt) ATT_LOAD(kt + 2);
    }
    __syncthreads();
  }
#undef ATT_LOAD
#undef ATT_STORE
  float* mrg = (float*)(sm + 73728) + (size_t)(qg * 64 + lane) * 37;
  float lt[2];
#pragma unroll
  for (int t = 0; t < 2; ++t) { float a = lrow[t]; a += __shfl_xor(a, 16); a += __shfl_xor(a, 32); lt[t] = a; }
  if (kh == 1) {
#pragma unroll
    for (int t = 0; t < 2; ++t) {
      mrg[t * 18 + 0] = mrow[t]; mrg[t * 18 + 1] = lt[t];
#pragma unroll
      for (int jn = 0; jn < 4; ++jn)
#pragma unroll
        for (int r = 0; r < 4; ++r) mrg[t * 18 + 2 + jn * 4 + r] = o[t][jn][r];
    }
  }
  __syncthreads();
  if (kh == 0) {
#pragma unroll
    for (int t = 0; t < 2; ++t) {
      const float m1 = mrg[t * 18 + 0], l1 = mrg[t * 18 + 1];
      const float mm = fmaxf(mrow[t], m1);
      const float a0 = __builtin_amdgcn_exp2f(mrow[t] - mm), a1 = __builtin_amdgcn_exp2f(m1 - mm);
      const float inv = 1.f / (a0 * lt[t] + a1 * l1);
      const float c0 = a0 * inv, c1 = a1 * inv;
      bf16_t* orow = p.abuf + (size_t)(mq + t * 16 + c15) * 1024 + h * 64 + q * 4;
#pragma unroll
      for (int jn = 0; jn < 4; ++jn) {
        const float x0 = c0 * o[t][jn][0] + c1 * mrg[t * 18 + 2 + jn * 4 + 0], x1 = c0 * o[t][jn][1] + c1 * mrg[t * 18 + 2 + jn * 4 + 1];
        const float x2 = c0 * o[t][jn][2] + c1 * mrg[t * 18 + 2 + jn * 4 + 2], x3 = c0 * o[t][jn][3] + c1 * mrg[t * 18 + 2 + jn * 4 + 3];
        uint2 ov; ov.x = pack2(x0, x1); ov.y = pack2(x2, x3);
        *(uint2*)(orow + jn * 16) = ov;
      }
    }
  }
  __syncthreads();
}

DEV void gmlp_item(const Params& p, int l, int it, char* smem) {
  const int tid = VTID, lane = tid & 63, w = tid >> 6, q = lane >> 4, c15 = lane & 15;
  const int chunk = it >> 2, g = it & 3, m0 = chunk * 128;
  bf16_t* vt = (bf16_t*)smem;
  const float* wsg = p.mlp_ws + (size_t)(l * 4 + g) * 16384;
  float4 wa[2][4][2];
#pragma unroll
  for (int nt = 0; nt < 2; ++nt)
#pragma unroll
    for (int s = 0; s < 4; ++s) {
      const float* ap = wsg + ((2 * w + nt) * 16 + c15) * 128 + s * 32 + q * 8;
      wa[nt][s][0] = *(const float4*)ap; wa[nt][s][1] = *(const float4*)(ap + 4);
    }
  uint4 vin[4];
#pragma unroll
  for (int i = 0; i < 4; ++i) { const int id = tid + 256 * i; vin[i] = *(const uint4*)(p.zf + (size_t)(m0 + (id >> 3)) * 1792 + 1536 + g * 64 + (id & 7) * 8); }
#pragma unroll
  for (int i = 0; i < 4; ++i) {
    const int id = tid + 256 * i, qq = id >> 3, cc = id & 7;
    U8 v; v.u = vin[i];
#pragma unroll
    for (int j = 0; j < 8; ++j) vt[(cc * 8 + j) * 136 + qq] = v.h[j];
  }
  __syncthreads();
  f32x4 acc[4][2];
#pragma unroll
  for (int mt = 0; mt < 4; ++mt)
#pragma unroll
    for (int nt = 0; nt < 2; ++nt) acc[mt][nt] = f32x4{0.f, 0.f, 0.f, 0.f};
#pragma unroll
  for (int s = 0; s < 4; ++s) {
    bf16x8 af[4];
#pragma unroll
    for (int mt = 0; mt < 4; ++mt) af[mt] = *(const bf16x8*)(vt + (mt * 16 + c15) * 136 + s * 32 + q * 8);
#pragma unroll
    for (int nt = 0; nt < 2; ++nt) {
      U8 bb;
      bb.w[0] = pack2(wa[nt][s][0].x, wa[nt][s][0].y); bb.w[1] = pack2(wa[nt][s][0].z, wa[nt][s][0].w);
      bb.w[2] = pack2(wa[nt][s][1].x, wa[nt][s][1].y); bb.w[3] = pack2(wa[nt][s][1].z, wa[nt][s][1].w);
#pragma unroll
      for (int mt = 0; mt < 4; ++mt) acc[mt][nt] = mfma16(af[mt], bb.v, acc[mt][nt]);
    }
  }
#pragma unroll
  for (int nt = 0; nt < 2; ++nt) {
    const int pp = (2 * w + nt) * 16 + c15;
    const size_t m = m0 + pp;
    const float bsv = p.mlp_bs[(l * 4 + g) * 128 + pp];
#pragma unroll
    for (int mt = 0; mt < 4; ++mt) {
      const int c = mt * 16 + q * 4;
      const uint2 uu = *(const uint2*)(p.zf + m * 1792 + 1280 + g * 64 + c);
      const float u0 = gelu_t(__uint_as_float(uu.x << 16)), u1 = gelu_t(__uint_as_float(uu.x & 0xffff0000u)), u2 = gelu_t(__uint_as_float(uu.y << 16)), u3 = gelu_t(__uint_as_float(uu.y & 0xffff0000u));
      uint2 o; o.x = pack2(u0 * (acc[mt][nt][0] + bsv), u1 * (acc[mt][nt][1] + bsv)); o.y = pack2(u2 * (acc[mt][nt][2] + bsv), u3 * (acc[mt][nt][3] + bsv));
      *(uint2*)(p.abuf + m * 1024 + 768 + g * 64 + c) = o;
    }
  }
  __syncthreads();
}

DEV void lru_apply_item(const Params& p, int l, int ti2) {
  const int C = VTID;
  const int ti = ti2 >> 1, th = (ti2 & 1) * 32;
  const int m0 = ti * 64;
  int ms, L, b; bool lat = m0 >= 8192;
  if (!lat) { ms = m0 & ~255; L = 256; b = m0 >> 8; } else { ms = 8192 + ((m0 - 8192) & ~1023); L = 1024; b = (m0 - 8192) >> 10; }
  const int k = (m0 - ms) >> 6, nt = L >> 6;
  const float* PCf = p.au; const float* HLf = p.au + (size_t)MT * 256;
  const float* PCb = p.au + (size_t)2 * MT * 256; const float* HLb = p.au + (size_t)3 * MT * 256;
  float cf = lat ? p.state_lru[((size_t)(b * 2 + l) * 2 + 0) * 256 + C] : 0.f;
  float cb = lat ? p.state_lru[((size_t)(b * 2 + l) * 2 + 1) * 256 + C] : 0.f;
  {
    float pc[15], hl[15];
#pragma unroll
    for (int i = 0; i < 15; ++i) {
      const bool act = i < k;
      const size_t e = (size_t)(ms + 64 * i + 63) * 256 + C;
      pc[i] = act ? PCf[e] : 1.f; hl[i] = act ? HLf[e] : 0.f;
    }
#pragma unroll
    for (int i = 0; i < 15; ++i) cf = pc[i] * cf + hl[i];
  }
  {
    float pc[15], hl[15];
#pragma unroll
    for (int i = 0; i < 15; ++i) {
      const int tix = nt - 1 - i;
      const bool act = tix > k;
      const size_t e = (size_t)(ms + 64 * tix) * 256 + C;
      pc[i] = act ? PCb[e] : 1.f; hl[i] = act ? HLb[e] : 0.f;
    }
#pragma unroll
    for (int i = 0; i < 15; ++i) cb = pc[i] * cb + hl[i];
  }
  float hf_last = 0.f, hb_first = 0.f;
#pragma unroll 16
  for (int t = th; t < th + 32; ++t) {
    const size_t m = m0 + t;
    const float hf = PCf[m * 256 + C] * cf + HLf[m * 256 + C];
    const float hb = PCb[m * 256 + C] * cb + HLb[m * 256 + C];
    const float g = gelu_t(bf2f(p.zf[m * 1792 + 1024 + C]));
    p.abuf[m * 1024 + 512 + C] = f2bf((hf + hb) * g);
    if (t == 0) hb_first = hb;
    if (t == 63) hf_last = hf;
  }
  if (!lat) {
    if (k == nt - 1 && th == 32) p.out[OFF_ST + ((size_t)(b * 2 + l) * 2 + 0) * 256 + C] = hf_last;
    if (k == 0 && th == 0) p.out[OFF_ST + ((size_t)(b * 2 + l) * 2 + 1) * 256 + C] = hb_first;
  }
}

DEV void mixer_phase(const Params& p, int l, char* smem_raw, char* smem) {
  for (int it = blockIdx.x; it < 1024; it += gridDim.x) attn_item(p, l, it, smem_raw);
  const int NITEMS = 512 + 512;
  for (int it = VBID; it < NITEMS; it += VNB) {
    if (it < 512) lru_apply_item(p, l, it);
    else gmlp_item(p, l, it - 512, smem);
  }
}

DEV void prep_phase_full(const Params& p, int l, char* smem) {
  for (int it = VBID; it < 1024; it += VNB) lru_gate_item(p, l, it, smem);
  const int lane = threadIdx.x & 63, mstride = gridDim.x * 8;
  int m = blockIdx.x * 8 + (threadIdx.x >> 6);
  const int coff = lane < 32 ? 512 + lane * 8 : 1536 + (lane - 32) * 8;
  uint4 n1 = *(const uint4*)(p.zf + (size_t)m * 1792 + coff);
  uint4 n2 = *(const uint4*)(p.zf + (size_t)((m + mstride < MT) ? m + mstride : m) * 1792 + coff);
  for (; m < MT; m += mstride) {
    const uint4 c = n1; n1 = n2;
    const int mn = (m + 2 * mstride < MT) ? m + 2 * mstride : m;
    n2 = *(const uint4*)(p.zf + (size_t)mn * 1792 + coff);
    prep_token_row(p, l, m, lane, c);
  }
}


#define XB_TMO      128
#define XB_XCNT(j)  (256  + 64 * (j))
#define XB_XSUB(j)  (1280 + 64 * (j))
#define XB_XGEN(j)  (2304 + 64 * (j))
#define XB_TOP      3328
#define XB_TOPGEN   3392
#define XCD_BAR_WORDS 3456
#define XB_SPIN_CAP (1u << 18)
#define LAS __attribute__((address_space(3)))
DEV unsigned xb_ld(unsigned* p) { return __hip_atomic_load(p, __ATOMIC_RELAXED, __HIP_MEMORY_SCOPE_AGENT); }
DEV unsigned xb_add(unsigned* p, unsigned v) { return __hip_atomic_fetch_add(p, v, __ATOMIC_RELAXED, __HIP_MEMORY_SCOPE_AGENT); }
DEV unsigned xb_xcc_id() { return (unsigned)__builtin_amdgcn_s_getreg((3 << 11) | 20) & 0xFu; }
#define XB_SPIN(cond, bar) do { unsigned _sp = 0; while (cond) { __builtin_amdgcn_s_sleep(1); \
    if ((++_sp & 255u) == 0u) { if (xb_ld(&(bar)[XB_TMO])) break; if (_sp > XB_SPIN_CAP) { atomicAdd(&(bar)[XB_TMO], 1u); break; } } } } while (0)
struct XcdBarrier { unsigned* bar; unsigned x; volatile LAS unsigned* st; };
DEV XcdBarrier xcd_barrier_post(unsigned* bar, volatile LAS unsigned* st) {
  XcdBarrier b; b.bar = bar; b.x = xb_xcc_id(); b.st = st;
  if (threadIdx.x == 0) (void)xb_add(&bar[XB_XCNT(b.x)], 1u);
  return b;
}
DEV void xcd_barrier_complete(unsigned* bar, unsigned x, unsigned& nloc, unsigned& nx) {
  const unsigned G = gridDim.x * gridDim.y * gridDim.z;
  unsigned sum, cnt, mine, sp = 0u;
  for (;;) {
    sum = 0u; cnt = 0u; mine = 0u;
#pragma unroll
    for (unsigned j = 0; j < 16; ++j) { const unsigned c = xb_ld(&bar[XB_XCNT(j)]); sum += c; cnt += (c > 0u) ? 1u : 0u; mine = (j == x) ? c : mine; }
    if (sum == G) break;
    __builtin_amdgcn_s_sleep(1);
    if ((++sp & 255u) == 0u) { if (xb_ld(&bar[XB_TMO])) break; if (sp > XB_SPIN_CAP) { atomicAdd(&bar[XB_TMO], 1u); break; } }
  }
  nloc = mine > 0u ? mine : 1u; nx = cnt > 0u ? cnt : 1u;
}
DEV void xcd_barrier(const XcdBarrier& b) {
  asm volatile("s_waitcnt vmcnt(0)" ::: "memory");
  __syncthreads();
  if (threadIdx.x == 0) {
    unsigned* bar = b.bar;
    __builtin_amdgcn_s_waitcnt(0);
    unsigned nloc = b.st[0], nx = b.st[1];
    if (nloc == 0u) { xcd_barrier_complete(bar, b.x, nloc, nx); b.st[0] = nloc; b.st[1] = nx; }
    const unsigned old = xb_add(&bar[XB_XSUB(b.x)], 1u);
    const unsigned gen = old / nloc;
    if (old + 1u == (gen + 1u) * nloc) {
      __builtin_amdgcn_fence(__ATOMIC_RELEASE, "agent");
      asm volatile("s_waitcnt vmcnt(0)" ::: "memory");
      const unsigned og = xb_add(&bar[XB_TOP], 1u);
      const unsigned tg = og / nx;
      if (og + 1u == (tg + 1u) * nx) xb_add(&bar[XB_TOPGEN], 1u);
      else XB_SPIN(xb_ld(&bar[XB_TOPGEN]) == tg, bar);
      __builtin_amdgcn_fence(__ATOMIC_ACQUIRE, "agent");
      xb_add(&bar[XB_XGEN(b.x)], 1u);
      asm volatile("s_waitcnt vmcnt(0)" ::: "memory");
    } else {
      XB_SPIN(xb_ld(&bar[XB_XGEN(b.x)]) == gen, bar);
      __builtin_amdgcn_fence(__ATOMIC_ACQUIRE, "agent");
      asm volatile("s_waitcnt vmcnt(0)" ::: "memory");
    }
  }
  __syncthreads();
}

#define PH(i, call) if (ph_lo <= (i) && (i) < ph_hi) { if ((i) > ph_lo) xcd_barrier(xb); call; }
#define LAYER(l, b) \
  PH(b + 0, ln_mod_phase(p, l, l == 0 ? 0 : 1)) \
  PH(b + 1, gemm_phase<1>(p, l, p.abuf, p.wt_in + (size_t)l * 1792 * 1024, 1792, 1024, (LAS3 unsigned char*)smem_raw)) \
  PH(b + 2, prep_phase_full(p, l, smem)) \
  PH(b + 3, mixer_phase(p, l, smem_raw, smem)) \
  PH(b + 4, gemm_phase<2>(p, l, p.abuf, p.wt_out + (size_t)l * 1024 * 1024, 1024, 1024, (LAS3 unsigned char*)smem_raw)) \
  PH(b + 5, ln_mod_phase(p, l, 2)) \
  PH(b + 6, gemm_phase<3>(p, l, p.abuf, p.wt_ff1 + (size_t)l * 4096 * 1024, 4096, 1024, (LAS3 unsigned char*)smem_raw)) \
  PH(b + 7, gemm_phase<4>(p, l, p.zf, p.wt_ff2 + (size_t)l * 1024 * 4096, 1024, 4096, (LAS3 unsigned char*)smem_raw))

__global__ void __launch_bounds__(512, 2) mega_kernel(Params p, int ph_lo, int ph_hi) {
  extern __shared__ __attribute__((aligned(16))) char smem_raw[];
  char* smem = smem_raw + (threadIdx.x >> 8) * 65536;
  __shared__ uint4 xb_words;
  if (threadIdx.x == 0) xb_words = make_uint4(0u, 0u, 0u, 0u);
  __syncthreads();
  XcdBarrier xb = xcd_barrier_post(p.bar, (volatile LAS unsigned*)&xb_words);
  if (ph_hi > 1000) { cg::grid_group grid = cg::this_grid(); grid.sync(); }
  PH(0, phase0(p, smem))
  LAYER(0, 1)
  LAYER(1, 9)
  PH(17, ln_mod_phase(p, 1, 3))
}

extern "C" void kernel_launch(void* const* d_in, const int* in_sizes, int n_in, void* d_out, int out_size, void* d_ws, size_t ws_size,
                              hipStream_t stream) {
  static int grid_blocks = 0;
  if (!grid_blocks) {
    int dev = 0, cus = 0, per_cu = 0;
    hipGetDevice(&dev);
    hipDeviceGetAttribute(&cus, hipDeviceAttributeMultiprocessorCount, dev);
    hipFuncSetAttribute((const void*)mega_kernel, hipFuncAttributeMaxDynamicSharedMemorySize, SMEM_BYTES);
    hipOccupancyMaxActiveBlocksPerMultiprocessor(&per_cu, (const void*)mega_kernel, 512, SMEM_BYTES);
    if (per_cu < 1) per_cu = 1;
    if (per_cu > 1) per_cu = 1;
    grid_blocks = cus * per_cu;
  }
  Params p{};
  const float** pin = (const float**)&p;
  for (int i = 0; i < 32; ++i) pin[i] = (const float*)d_in[i];
  p.out = (float*)d_out;
  char* ws = (char*)d_ws;
  size_t off = 0;
  p.bar = (unsigned*)(ws + off); off += 16384;
  p.rstat = (float*)(ws + off); off += (size_t)MT * 2 * 4;
  p.kb_lat = (bf16_t*)(ws + off); off += (size_t)2 * 8 * 2 * 1280 * 64 * 2;
  p.vt_lat = (bf16_t*)(ws + off); off += (size_t)2 * 8 * 2 * 1280 * 64 * 2;
  p.kb_ctx = (bf16_t*)(ws + off); off += (size_t)32 * 2 * 256 * 64 * 2;
  p.vt_ctx = (bf16_t*)(ws + off); off += (size_t)32 * 2 * 256 * 64 * 2;
  p.wt_in = (bf16_t*)(ws + off); off += (size_t)2 * 1792 * 1024 * 2;
  p.wt_out = (bf16_t*)(ws + off); off += (size_t)2 * 1024 * 1024 * 2;
  p.wt_ff1 = (bf16_t*)(ws + off); off += (size_t)2 * 4096 * 1024 * 2;
  p.wt_ff2 = (bf16_t*)(ws + off); off += (size_t)2 * 4096 * 1024 * 2;
  p.wt_lru = (bf16_t*)(ws + off); off += (size_t)64 * 4096 * 2;
  p.mod = (float*)(ws + off); off += (size_t)2 * 9 * 6144 * 4;
  p.rope = (float*)(ws + off); off += (size_t)2048 * 4;
  p.cdec = (float*)(ws + off); off += (size_t)1024 * 4;
  p.abuf = (bf16_t*)(ws + off); off += (size_t)MT * 1024 * 2;
  p.zf = (bf16_t*)(ws + off);
  p.au = (float*)(ws + off + (size_t)MT * 1792 * 2);
  off += (size_t)MT * 4096 * 2;
  if (off > ws_size) { fprintf(stderr, "workspace too small: need %zu have %zu\n", off, ws_size); return; }
  (void)hipMemsetAsync(p.bar, 0, XCD_BAR_WORDS * 4, stream);
#if MULTI_LAUNCH
  for (int ph = 0; ph < NPHASE; ++ph) {
    hipLaunchKernelGGL(mega_kernel, dim3(grid_blocks), dim3(512), SMEM_BYTES, stream, p, ph, ph + 1);
  }
#else
  int lo = 0, hi = NPHASE;
  void* args[] = {&p, &lo, &hi};
  hipError_t e = hipLaunchCooperativeKernel((void*)mega_kernel, dim3(grid_blocks), dim3(512), args, SMEM_BYTES, stream);
  if (e != hipSuccess) fprintf(stderr, "cooperative launch failed: %s (grid %d)\n", hipGetErrorString(e), grid_blocks);
#endif
}
```

```cpp
#include <hip/hip_runtime.h>
#include <hip/hip_cooperative_groups.h>
#include <cstdio>
#include <cstdint>
namespace cg = cooperative_groups;

#ifndef MULTI_LAUNCH
#define MULTI_LAUNCH 0
#endif

typedef unsigned short bf16_t;
using bf16x8 = __attribute__((ext_vector_type(8))) short;
using f32x4 = __attribute__((ext_vector_type(4))) float;
#define DEV __device__ __forceinline__
#define VTID ((int)(threadIdx.x & 255))
#define VBID ((int)(blockIdx.x * 2 + (threadIdx.x >> 8)))
#define VNB ((int)(gridDim.x * 2))

constexpr int MT = 16384;
constexpr int NPHASE = 18;
constexpr size_t OFF_YK = 16777216, OFF_YV = OFF_YK + 2097152, OFF_ST = OFF_YV + 2097152;
constexpr float ALPHA = 1.41421356237f;
constexpr float QSCALE = 0.125f * 1.4426950408889634f;
constexpr int SMEM_BYTES = 131072;

struct Params {
  const float *x_prompt, *x_sample, *c, *cache_k, *cache_v, *state_lru, *c_ctx, *w_ada, *b_ada, *w_in,
      *q_g, *k_g, *conv_w, *conv_b, *lru_wa, *lru_ba, *lru_wx, *lru_bx, *lru_lam, *mlp_g, *mlp_b, *mlp_ws, *mlp_bs,
      *w_out, *ln1_g, *ln1_b, *w_ff1, *b_ff1, *w_ff2, *b_ff2, *ln2_g, *ln2_b;
  float* out;
  bf16_t *wt_in, *wt_out, *wt_ff1, *wt_ff2, *wt_lru;
  float *mod, *rope, *cdec;
  bf16_t *abuf;
  bf16_t *zf;
  float *au;
  bf16_t *kb_lat, *vt_lat;
  bf16_t *kb_ctx, *vt_ctx;
  unsigned *bar;
  float *rstat;
};

union U8 { uint4 u; bf16x8 v; bf16_t h[8]; unsigned w[4]; };

DEV float bf2f(bf16_t h) { return __uint_as_float(((unsigned)h) << 16); }
DEV bf16_t f2bf(float f) { unsigned u = __float_as_uint(f); u += 0x7fffu + ((u >> 16) & 1u); return (bf16_t)(u >> 16); }
DEV unsigned pack2(float a, float b) { unsigned r; asm volatile("v_cvt_pk_bf16_f32 %0, %1, %2" : "=v"(r) : "v"(a), "v"(b)); return r; }
DEV float gelu_t(float x) { float y = 0.7978845608028654f * (x + 0.044715f * x * x * x); float t = 1.f - 2.f * __builtin_amdgcn_rcpf(1.f + __expf(2.f * y)); return 0.5f * x * (1.f + t); }
DEV float sigmoidf_(float x) { return __builtin_amdgcn_rcpf(1.f + __expf(-x)); }
DEV int cond_of(int m) { return m < 8192 ? 0 : 1 + ((m - 8192) >> 10); }
DEV f32x4 mfma16(bf16x8 a, bf16x8 b, f32x4 c) { return __builtin_amdgcn_mfma_f32_16x16x32_bf16(a, b, c, 0, 0, 0); }
DEV float wave_sum(float v) {
#pragma unroll
  for (int o = 32; o >= 1; o >>= 1) v += __shfl_xor(v, o);
  return v;
}

DEV void transpose_tile(const float* __restrict__ src, bf16_t* __restrict__ dst, int lds_, int ldd, char* smem) {
  float* T = (float*)smem;
  const int tid = VTID;
#pragma unroll
  for (int i = 0; i < 4; ++i) {
    int k = (tid >> 4) + 16 * i, n4 = (tid & 15) * 4;
    float4 v = *(const float4*)(src + (size_t)k * lds_ + n4);
    T[k * 65 + n4 + 0] = v.x; T[k * 65 + n4 + 1] = v.y; T[k * 65 + n4 + 2] = v.z; T[k * 65 + n4 + 3] = v.w;
  }
  __syncthreads();
#pragma unroll
  for (int i = 0; i < 2; ++i) {
    int n = (tid >> 3) + 32 * i, k8 = (tid & 7) * 8;
    U8 o;
#pragma unroll
    for (int j = 0; j < 4; ++j) o.w[j] = pack2(T[(k8 + 2 * j) * 65 + n], T[(k8 + 2 * j + 1) * 65 + n]);
    *(uint4*)(dst + (size_t)n * ldd + k8) = o.u;
  }
  __syncthreads();
}
DEV void transpose_w(const float* __restrict__ W, bf16_t* __restrict__ Wt, int K, int N, int tk, int tn, char* smem) {
  transpose_tile(W + (size_t)(tk * 64) * N + tn * 64, Wt + (size_t)(tn * 64) * K + tk * 64, N, K, smem);
}

DEV void tr_desc(const Params& p, int t, const float*& src, int& lds_, bf16_t*& dst, int& ldd) {
  if (t < 2 * 2768) {
    const int l = t / 2768, r = t % 2768;
    const float* W; bf16_t* Wt; int K, N, tk, tn;
    if (r < 448) { W = p.w_in + (size_t)l * 1024 * 1792; Wt = p.wt_in + (size_t)l * 1792 * 1024; K = 1024; N = 1792; tk = r / 28; tn = r % 28; }
    else if (r < 704) { const int i = r - 448; W = p.w_out + (size_t)l * 1024 * 1024; Wt = p.wt_out + (size_t)l * 1024 * 1024; K = 1024; N = 1024; tk = i / 16; tn = i % 16; }
    else if (r < 1728) { const int i = r - 704; W = p.w_ff1 + (size_t)l * 1024 * 4096; Wt = p.wt_ff1 + (size_t)l * 4096 * 1024; K = 1024; N = 4096; tk = i / 64; tn = i % 64; }
    else if (r < 2752) { const int i = r - 1728; W = p.w_ff2 + (size_t)l * 4096 * 1024; Wt = p.wt_ff2 + (size_t)l * 1024 * 4096; K = 4096; N = 1024; tk = i / 16; tn = i % 16; }
    else {
      const int idx = r - 2752, dir = idx >> 3, blk = (idx >> 1) & 3, mat = idx & 1;
      src = (mat == 0 ? p.lru_wa : p.lru_wx) + (size_t)(((l * 2 + dir) * 4 + blk)) * 4096; lds_ = 64;
      dst = p.wt_lru + (size_t)((((l * 2 + dir) * 4 + blk) * 2 + mat)) * 4096; ldd = 64; return;
    }
    src = W + (size_t)(tk * 64) * N + tn * 64; lds_ = N; dst = Wt + (size_t)(tn * 64) * K + tk * 64; ldd = K;
  } else {
    const int j = t - 2 * 2768, tt = j & 3, kvh = (j >> 2) & 1, l = (j >> 3) & 1, b = j >> 4;
    src = p.cache_v + ((size_t)(b * 2 + l) * 256 + tt * 64) * 128 + kvh * 64; lds_ = 128;
    dst = p.vt_lat + ((size_t)((l * 8 + b) * 2 + kvh) * 64) * 1280 + tt * 64; ldd = 1280;
  }
}

DEV void transpose_all(const Params& p, char* smem) {
  constexpr int NTR = 2 * 2768 + 128;
  float* T = (float*)smem;
  const int tid = VTID, kr = tid >> 4, n4 = (tid & 15) * 4;
  int t = VBID;
  if (t >= NTR) return;
  const float* src; bf16_t* dst; int lds_, ldd;
  tr_desc(p, t, src, lds_, dst, ldd);
  float4 cur[4];
#pragma unroll
  for (int i = 0; i < 4; ++i) cur[i] = *(const float4*)(src + (size_t)(kr + 16 * i) * lds_ + n4);
  while (t < NTR) {
    const int tn = t + VNB;
    const float* nsrc = src; bf16_t* ndst = dst; int nlds = lds_, nldd = ldd;
    float4 nxt[4];
    if (tn < NTR) {
      tr_desc(p, tn, nsrc, nlds, ndst, nldd);
#pragma unroll
      for (int i = 0; i < 4; ++i) nxt[i] = *(const float4*)(nsrc + (size_t)(kr + 16 * i) * nlds + n4);
    }
#pragma unroll
    for (int i = 0; i < 4; ++i) {
      const int k = kr + 16 * i;
      T[k * 65 + n4 + 0] = cur[i].x; T[k * 65 + n4 + 1] = cur[i].y; T[k * 65 + n4 + 2] = cur[i].z; T[k * 65 + n4 + 3] = cur[i].w;
    }
    __syncthreads();
#pragma unroll
    for (int i = 0; i < 2; ++i) {
      const int n = (tid >> 3) + 32 * i, k8 = (tid & 7) * 8;
      U8 o;
#pragma unroll
      for (int j = 0; j < 4; ++j) o.w[j] = pack2(T[(k8 + 2 * j) * 65 + n], T[(k8 + 2 * j + 1) * 65 + n]);
      *(uint4*)(dst + (size_t)n * ldd + k8) = o.u;
    }
    __syncthreads();
    if (tn < NTR) {
#pragma unroll
      for (int i = 0; i < 4; ++i) cur[i] = nxt[i];
    }
    src = nsrc; dst = ndst; lds_ = nlds; ldd = nldd; t = tn;
  }
}

DEV void phase0(const Params& p, char* smem) {
  const int tid = VTID;
  const int NT0 = 192 - 128, NITEMS = 192 + 64 + 2;
  for (int it = VBID; it < NITEMS; it += VNB) {
    if (it < 192) {
      const int l = it / 96, n0 = (it % 96) * 64;
      float* s = (float*)smem;
      float* red = s + 9 * 1024;
      for (int idx = tid; idx < 9 * 1024; idx += 256) {
        int c = idx >> 10, k = idx & 1023;
        float v = (c == 0) ? p.c_ctx[k] : p.c[(c - 1) * 1024 + k];
        s[idx] = v / (1.f + __expf(-v));
      }
      __syncthreads();
      const int w = tid >> 6, lane = tid & 63, cq = lane & 15, ks = lane >> 4;
      const int kbase = (w * 4 + ks) * 64;
      float acc[9][4];
#pragma unroll
      for (int c = 0; c < 9; ++c) { acc[c][0] = 0.f; acc[c][1] = 0.f; acc[c][2] = 0.f; acc[c][3] = 0.f; }
      const float* wp = p.w_ada + ((size_t)l * 1024 + kbase) * 6144 + n0 + cq * 4;
      for (int kb = 0; kb < 64; kb += 16) {
        float4 wv[16];
#pragma unroll
        for (int j = 0; j < 16; ++j) wv[j] = *(const float4*)(wp + (size_t)(kb + j) * 6144);
#pragma unroll
        for (int j = 0; j < 16; ++j)
#pragma unroll
          for (int c = 0; c < 9; ++c) {
            const float sv = s[c * 1024 + kbase + kb + j];
            acc[c][0] += sv * wv[j].x; acc[c][1] += sv * wv[j].y; acc[c][2] += sv * wv[j].z; acc[c][3] += sv * wv[j].w;
          }
      }
#pragma unroll
      for (int c = 0; c < 9; ++c)
#pragma unroll
        for (int e = 0; e < 4; ++e) {
          float a = acc[c][e];
          a += __shfl_xor(a, 16); a += __shfl_xor(a, 32);
          if (ks == 0) red[(w * 9 + c) * 64 + cq * 4 + e] = a;
        }
      __syncthreads();
      for (int idx = tid; idx < 576; idx += 256) {
        int c = idx >> 6, nn = idx & 63;
        float v = red[(0 * 9 + c) * 64 + nn] + red[(1 * 9 + c) * 64 + nn] + red[(2 * 9 + c) * 64 + nn] + red[(3 * 9 + c) * 64 + nn] +
                  p.b_ada[l * 6144 + n0 + nn];
        p.mod[((size_t)l * 9 + c) * 6144 + n0 + nn] = v;
      }
      __syncthreads();
    } else if (it >= NT0 + 128 && it < NT0 + 192) {
      const int j = it - NT0 - 128;
#pragma unroll
      for (int i = 0; i < 4; ++i) {
        const int e = (j * 1024 + i * 256 + tid) * 8;
        const int d = e & 63, kvh = (e >> 6) & 1, t = (e >> 7) & 255, l = (e >> 15) & 1, b = e >> 16;
        const float4 a0 = *(const float4*)(p.cache_k + e), a1 = *(const float4*)(p.cache_k + e + 4);
        U8 o; o.w[0] = pack2(a0.x, a0.y); o.w[1] = pack2(a0.z, a0.w); o.w[2] = pack2(a1.x, a1.y); o.w[3] = pack2(a1.z, a1.w);
        *(uint4*)(p.kb_lat + ((size_t)((l * 8 + b) * 2 + kvh) * 1280 + t) * 64 + d) = o.u;
      }
    } else if (it >= NT0 + 192) {
      if (it == NT0 + 192)
      for (int idx = tid; idx < 1024; idx += 256) {
        int pp = idx >> 4, f = idx & 15;
        float inv = powf(10000.f, -(float)f / 16.f);
        float ang = (float)pp * inv;
        float nrev = rintf(ang * 0.15915494309189535f);
        float r = fmaf(-nrev, 6.28125f, ang);
        r = fmaf(-nrev, 0.0019353071795864769f, r);
        p.rope[idx * 2 + 0] = __cosf(r);
        p.rope[idx * 2 + 1] = __sinf(r);
      }
      if (it == NT0 + 192)
      for (int idx = tid; idx < 1024; idx += 256) {
        const float xn = -p.lru_lam[idx];
        p.cdec[idx] = -8.f * (fmaxf(xn, 0.f) + log1pf(expf(-fabsf(xn))));
      }
    }
  }
  transpose_all(p, smem);
}

DEV void ln_mod_phase(const Params& p, int l, int mode) {
  const int lane = threadIdx.x & 63, w = threadIdx.x >> 6;
  const float* lg = nullptr; const float* lb = nullptr;
  if (mode == 1) { lg = p.ln2_g + (l - 1) * 1024; lb = p.ln2_b + (l - 1) * 1024; }
  else if (mode == 2) { lg = p.ln1_g + l * 1024; lb = p.ln1_b + l * 1024; }
  else if (mode == 3) { lg = p.ln2_g + l * 1024; lb = p.ln2_b + l * 1024; }
  const int shoff = (mode == 2) ? 3072 : 0;
  const int mstride = gridDim.x * 8;
  float4 nv[4];
  {
    const int m = blockIdx.x * 8 + w;
    const float* src = (mode == 0) ? ((m < 8192) ? p.x_prompt + (size_t)m * 1024 : p.x_sample + (size_t)(m - 8192) * 1024) : p.out + (size_t)m * 1024;
#pragma unroll
    for (int i = 0; i < 4; ++i) nv[i] = *(const float4*)(src + i * 256 + lane * 4);
  }
  for (int m = blockIdx.x * 8 + w; m < MT; m += mstride) {
    float4 v[4];
#pragma unroll
    for (int i = 0; i < 4; ++i) v[i] = nv[i];
    {
      const int mn = (m + mstride < MT) ? m + mstride : m;
      const float* src = (mode == 0) ? ((mn < 8192) ? p.x_prompt + (size_t)mn * 1024 : p.x_sample + (size_t)(mn - 8192) * 1024) : p.out + (size_t)mn * 1024;
#pragma unroll
      for (int i = 0; i < 4; ++i) nv[i] = *(const float4*)(src + i * 256 + lane * 4);
    }
    if (mode != 0) {
      float s = 0.f;
#pragma unroll
      for (int i = 0; i < 4; ++i) s += v[i].x + v[i].y + v[i].z + v[i].w;
      const float mean = wave_sum(s) * (1.f / 1024.f);
      float s2 = 0.f;
#pragma unroll
      for (int i = 0; i < 4; ++i) { float a = v[i].x - mean, b = v[i].y - mean, c = v[i].z - mean, d = v[i].w - mean; s2 += a * a + b * b + c * c + d * d; }
      const float rstd = rsqrtf(wave_sum(s2) * (1.f / 1024.f) + 1e-6f);
#pragma unroll
      for (int i = 0; i < 4; ++i) {
        float4 g = *(const float4*)(lg + i * 256 + lane * 4), b = *(const float4*)(lb + i * 256 + lane * 4);
        v[i].x = (v[i].x - mean) * rstd * g.x + b.x; v[i].y = (v[i].y - mean) * rstd * g.y + b.y;
        v[i].z = (v[i].z - mean) * rstd * g.z + b.z; v[i].w = (v[i].w - mean) * rstd * g.w + b.w;
        if (mode == 3) *(float4*)(p.out + (size_t)m * 1024 + i * 256 + lane * 4) = v[i];
      }
      if (mode != 3 && lane == 0) *(float2*)(p.rstat + (size_t)m * 2) = make_float2(mean, rstd);
    }
    if (mode != 3) {
      const float* md = p.mod + ((size_t)l * 9 + cond_of(m)) * 6144 + shoff;
#pragma unroll
      for (int i = 0; i < 4; ++i) {
        float4 sh = *(const float4*)(md + i * 256 + lane * 4), sc = *(const float4*)(md + 1024 + i * 256 + lane * 4);
        uint2 o;
        o.x = pack2(v[i].x * (1.f + sc.x) + sh.x, v[i].y * (1.f + sc.y) + sh.y);
        o.y = pack2(v[i].z * (1.f + sc.z) + sh.z, v[i].w * (1.f + sc.w) + sh.w);
        *(uint2*)(p.abuf + (size_t)m * 1024 + i * 256 + lane * 4) = o;
      }
    }
  }
}

#define LAS3 __attribute__((address_space(3)))
namespace g8 {
constexpr int BM = 256, BK = 64, HALF = 128, HTB = HALF * BK * 2, NXCD = 8, WGM = 4;
DEV int lds_byte(int r, int c) { const int st = (r >> 4) * 2 + (c >> 5), rr = r & 15, cc = c & 31, ob = rr * 64 + cc * 2; return st * 1024 + (ob ^ (((ob >> 9) & 1) << 5)); }
DEV void stage_rc(int b, int& R, int& C) { const int st = b / 1024, sb = b % 1024, swz = sb ^ (((sb >> 9) & 1) << 5); R = (st >> 1) * 16 + swz / 64; C = (st & 1) * 32 + (swz % 64) / 2; }
DEV bool unit_of(int i, int nM, int nN, int& pm, int& pn) {
  const int nwg = nM * nN;
  const long L = (long)i * gridDim.x + blockIdx.x; if (L >= nwg) return false;
  int wgid = (int)L; { const int q = nwg / NXCD, r = nwg % NXCD, xcd = wgid % NXCD, off = wgid / NXCD; wgid = (xcd < r ? xcd * (q + 1) : r * (q + 1) + (xcd - r) * q) + off; }
  const int nig = WGM * nN, gid = wgid / nig, fm = gid * WGM, gsz = (nM - fm) < WGM ? (nM - fm) : WGM;
  pm = fm + ((wgid % nig) % gsz); pn = (wgid % nig) / gsz; return true;
}
}

template <int EPI>
DEV void gemm_epilogue(const Params& p, int l, f32x4 (&acc)[2][2][4][2], int pm, int pn, int wr, int wc, int fr, int fq) {
  const int brow = pm * 256, bcol = pn * 256;
  const float* md = p.mod + ((size_t)l * 9 + cond_of(brow)) * 6144;
#pragma unroll
  for (int bj = 0; bj < 2; ++bj)
#pragma unroll
    for (int n = 0; n < 2; ++n) {
      const int col = bcol + bj * 128 + wc * 32 + n * 16 + fq * 4;
      float4 gate = make_float4(0.f, 0.f, 0.f, 0.f), bias = make_float4(0.f, 0.f, 0.f, 0.f);
      if (EPI == 2) gate = *(const float4*)(md + 2048 + col);
      if (EPI == 3) bias = *(const float4*)(p.b_ff1 + l * 4096 + col);
      if (EPI == 4) { gate = *(const float4*)(md + 5120 + col); bias = *(const float4*)(p.b_ff2 + l * 1024 + col); }
#pragma unroll
      for (int ai = 0; ai < 2; ++ai)
#pragma unroll
        for (int m = 0; m < 4; ++m) {
          const int row = brow + ai * 128 + wr * 64 + m * 16 + fr;
          const f32x4 v = acc[ai][bj][m][n];
          if (EPI == 1) {
            uint2 o; o.x = pack2(v[0], v[1]); o.y = pack2(v[2], v[3]);
            *(uint2*)(p.zf + (size_t)row * 1792 + col) = o;
          } else if (EPI == 2) {
            const float* xs = (l == 0) ? ((row < 8192) ? p.x_prompt + (size_t)row * 1024 : p.x_sample + (size_t)(row - 8192) * 1024) : p.out + (size_t)row * 1024;
            const float4 x = *(const float4*)(xs + col);
            *(float4*)(p.out + (size_t)row * 1024 + col) = make_float4(ALPHA * x.x + gate.x * v[0], ALPHA * x.y + gate.y * v[1], ALPHA * x.z + gate.z * v[2], ALPHA * x.w + gate.w * v[3]);
          } else if (EPI == 3) {
            const float t0 = fmaxf(v[0] + bias.x, 0.f), t1 = fmaxf(v[1] + bias.y, 0.f), t2 = fmaxf(v[2] + bias.z, 0.f), t3 = fmaxf(v[3] + bias.w, 0.f);
            uint2 o; o.x = pack2(t0 * t0, t1 * t1); o.y = pack2(t2 * t2, t3 * t3);
            *(uint2*)(p.zf + (size_t)row * 4096 + col) = o;
          } else {
            float* xo = p.out + (size_t)row * 1024 + col;
            const float4 x = *(const float4*)xo;
            *(float4*)xo = make_float4(ALPHA * x.x + gate.x * (v[0] + bias.x), ALPHA * x.y + gate.y * (v[1] + bias.y), ALPHA * x.z + gate.z * (v[2] + bias.z), ALPHA * x.w + gate.w * (v[3] + bias.w));
          }
        }
    }
}

template <int EPI>
DEV void gemm_epilogue_lnres(const Params& p, int l, f32x4 (&acc)[2][2][4][2], int pm, int pn, int wr, int wc, int fr, int fq) {
  const int brow = pm * 256, bcol = pn * 256;
  const float* md = p.mod + ((size_t)l * 9 + cond_of(brow)) * 6144;
  float mean[2][4], rstd[2][4];
  {
    const unsigned so = (unsigned)(brow + wr * 64 + fr) * 2u;
#pragma unroll
    for (int ai = 0; ai < 2; ++ai)
#pragma unroll
      for (int m = 0; m < 4; ++m) { const float2 t = *(const float2*)(p.rstat + (so + (unsigned)((ai * 128 + m * 16) * 2))); mean[ai][m] = t.x; rstd[ai][m] = t.y; }
  }
  const float* lg = (EPI == 2) ? p.ln2_g + (l - 1) * 1024 : p.ln1_g + l * 1024;
  const float* lb = (EPI == 2) ? p.ln2_b + (l - 1) * 1024 : p.ln1_b + l * 1024;
  const unsigned co = (unsigned)(bcol + wc * 32 + fq * 4);
  const unsigned ro = (unsigned)(brow + wr * 64 + fr) * 1024u + co;
#pragma unroll
  for (int bj = 0; bj < 2; ++bj)
#pragma unroll
    for (int n = 0; n < 2; ++n) {
      unsigned col = co + (unsigned)(bj * 128 + n * 16), rb = ro + (unsigned)(bj * 128 + n * 16);
      asm volatile("" : "+v"(col), "+v"(rb));
      float4 gate, bias = make_float4(0.f, 0.f, 0.f, 0.f);
      if (EPI == 2) gate = *(const float4*)(md + 2048 + col);
      else { gate = *(const float4*)(md + 5120 + col); bias = *(const float4*)(p.b_ff2 + l * 1024 + col); }
      const float4 g4 = *(const float4*)(lg + col), b4 = *(const float4*)(lb + col);
#pragma unroll
      for (int ai = 0; ai < 2; ++ai)
#pragma unroll
        for (int m = 0; m < 4; ++m) {
          float* xo = p.out + (rb + (unsigned)((ai * 128 + m * 16) * 1024));
          const float4 x = *(const float4*)xo;
          const float mu = mean[ai][m], rr = rstd[ai][m];
          const f32x4 v = acc[ai][bj][m][n];
          const float x0 = (x.x - mu) * rr * g4.x + b4.x, x1 = (x.y - mu) * rr * g4.y + b4.y, x2 = (x.z - mu) * rr * g4.z + b4.z, x3 = (x.w - mu) * rr * g4.w + b4.w;
          *(float4*)xo = make_float4(ALPHA * x0 + gate.x * (v[0] + bias.x), ALPHA * x1 + gate.y * (v[1] + bias.y), ALPHA * x2 + gate.z * (v[2] + bias.z), ALPHA * x3 + gate.w * (v[3] + bias.w));
        }
    }
}

template <int EPI>
DEV void gemm_phase(const Params& p, int l, const bf16_t* Ag, const bf16_t* Btg, int N, int K, LAS3 unsigned char* lds) {
  using namespace g8;
  const int tid = threadIdx.x, wid = __builtin_amdgcn_readfirstlane(tid >> 6), lane = tid & 63, wr = wid >> 2, wc = wid & 3, fr = lane & 15, fq = lane >> 4;
  const int nt = K / BK, nM = MT / BM, nN = N / BM;
  unsigned voff[2];
#pragma unroll
  for (int i = 0; i < 2; ++i) { int R, C; stage_rc(tid * 16 + i * 8192, R, C); voff[i] = (unsigned)(R * K + C) * 2u; }
  const size_t kstep = (size_t)(BK * 2);
  const size_t hstep = (size_t)HALF * K * 2;
  const size_t tstep = 2 * hstep;
  const unsigned ldsw = (unsigned)wid * 1024u;
  const int aoff = lds_byte(wr * 64 + fr, fq * 8), boff = lds_byte(wc * 32 + fr, fq * 8);
#define PG8_SA(b, h) (((b) * 2 + (h)) * HTB)
#define PG8_SB(b, h) ((4 + (b) * 2 + (h)) * HTB)
#define PG8_STAGE(bufoff, gbase) do { _Pragma("unroll") for (int _i = 0; _i < 2; ++_i) \
    __builtin_amdgcn_global_load_lds((const unsigned*)((const char*)(gbase) + voff[_i]), (LAS3 unsigned*)(lds + (bufoff) + ldsw + _i * 8192), 16, 0, 0); } while (0)
#define PG8_LDA(dst, b, h) do { _Pragma("unroll") for (int m = 0; m < 4; ++m) _Pragma("unroll") for (int k = 0; k < 2; ++k) dst[m][k] = *(const LAS3 bf16x8*)(lds + PG8_SA(b, h) + aoff + m * 2048 + k * 1024); } while (0)
#define PG8_LDB(dst, b, h) do { _Pragma("unroll") for (int n = 0; n < 2; ++n) _Pragma("unroll") for (int k = 0; k < 2; ++k) dst[n][k] = *(const LAS3 bf16x8*)(lds + PG8_SB(b, h) + boff + n * 2048 + k * 1024); } while (0)
#define PG8_MMA(ai, bj, At_, Bt_) do { __builtin_amdgcn_s_setprio(1); _Pragma("unroll") for (int m = 0; m < 4; ++m) _Pragma("unroll") for (int n = 0; n < 2; ++n) _Pragma("unroll") for (int k = 0; k < 2; ++k) \
    acc[ai][bj][m][n] = __builtin_amdgcn_mfma_f32_16x16x32_bf16(Bt_[n][k], At_[m][k], acc[ai][bj][m][n], 0, 0, 0); __builtin_amdgcn_s_setprio(0); } while (0)
#define PG8_WAIT_V(n) asm volatile("s_waitcnt vmcnt(" #n ")" ::: "memory")
#define PG8_WAIT_L(n) asm volatile("s_waitcnt lgkmcnt(" #n ")" ::: "memory")
#define PG8_BAR __builtin_amdgcn_s_barrier()
#define PG8_SCHED __builtin_amdgcn_sched_barrier(0)
  int cpm, cpn, npm = 0, npn = 0, ui = 0;
  if (!unit_of(0, nM, nN, cpm, cpn)) return;
  f32x4 acc[2][2][4][2];
#pragma unroll
  for (int a = 0; a < 2; ++a)
#pragma unroll
    for (int b = 0; b < 2; ++b)
#pragma unroll
      for (int m = 0; m < 4; ++m)
#pragma unroll
        for (int n = 0; n < 2; ++n) acc[a][b][m][n] = (f32x4){0.f, 0.f, 0.f, 0.f};
  bf16x8 At[4][2], B0[2][2], B1[2][2];
  const char* cA = (const char*)Ag + (size_t)cpm * tstep; const char* cB = (const char*)Btg + (size_t)cpn * tstep;
  PG8_STAGE(PG8_SB(0, 0), cB); PG8_STAGE(PG8_SA(0, 0), cA); PG8_STAGE(PG8_SB(0, 1), cB + hstep); PG8_STAGE(PG8_SA(0, 1), cA + hstep);
  if (wr == 1) PG8_BAR;
  PG8_WAIT_V(4); PG8_BAR;
  PG8_STAGE(PG8_SB(1, 0), cB + kstep); PG8_STAGE(PG8_SA(1, 0), cA + kstep); PG8_STAGE(PG8_SB(1, 1), cB + hstep + kstep);
  PG8_WAIT_V(6); PG8_BAR;
  for (;;) {
    const bool has_next = unit_of(ui + 1, nM, nN, npm, npn);
    const char* nA = has_next ? (const char*)Ag + (size_t)npm * tstep : cA; const char* nB = has_next ? (const char*)Btg + (size_t)npn * tstep : cB;
    for (int t = 0; t < nt; t += 2) {
      const bool last = (t == nt - 2);
      const char* a1 = cA + (size_t)(t + 1) * kstep;
      const char* a2 = last ? nA : cA + (size_t)(t + 2) * kstep; const char* b2 = last ? nB : cB + (size_t)(t + 2) * kstep;
      const char* a3 = a2 + kstep; const char* b3 = b2 + kstep;
      PG8_LDB(B0, 0, 0); PG8_SCHED; PG8_LDA(At, 0, 0); PG8_STAGE(PG8_SA(1, 1), a1 + hstep);
      PG8_WAIT_L(8); PG8_BAR; PG8_WAIT_L(0); PG8_MMA(0, 0, At, B0); PG8_BAR; PG8_SCHED;
      PG8_LDB(B1, 0, 1); PG8_STAGE(PG8_SB(0, 0), b2);
      PG8_BAR; PG8_WAIT_L(0); PG8_MMA(0, 1, At, B1); PG8_BAR;
      PG8_LDA(At, 0, 1); PG8_STAGE(PG8_SA(0, 0), a2);
      PG8_BAR; PG8_WAIT_L(0); PG8_MMA(1, 0, At, B0); PG8_BAR; PG8_SCHED;
      PG8_STAGE(PG8_SB(0, 1), b2 + hstep);
      PG8_WAIT_V(6); PG8_BAR; PG8_MMA(1, 1, At, B1); PG8_BAR;
      PG8_LDB(B0, 1, 0); PG8_SCHED; PG8_LDA(At, 1, 0); PG8_STAGE(PG8_SA(0, 1), a2 + hstep);
      PG8_WAIT_L(8); PG8_BAR; PG8_WAIT_L(0); PG8_MMA(0, 0, At, B0); PG8_BAR; PG8_SCHED;
      PG8_LDB(B1, 1, 1); PG8_STAGE(PG8_SB(1, 0), b3);
      PG8_BAR; PG8_WAIT_L(0); PG8_MMA(0, 1, At, B1); PG8_BAR;
      PG8_LDA(At, 1, 1); PG8_STAGE(PG8_SA(1, 0), a3);
      PG8_BAR; PG8_WAIT_L(0); PG8_MMA(1, 0, At, B0); PG8_BAR; PG8_SCHED;
      PG8_STAGE(PG8_SB(1, 1), b3 + hstep);
      PG8_WAIT_V(6); PG8_BAR; PG8_MMA(1, 1, At, B1); PG8_BAR;
    }
    if (EPI == 4 || (EPI == 2 && l > 0)) gemm_epilogue_lnres<EPI>(p, l, acc, cpm, cpn, wr, wc, fr, fq);
    else gemm_epilogue<EPI>(p, l, acc, cpm, cpn, wr, wc, fr, fq);
    if (!has_next) break;
#pragma unroll
    for (int a = 0; a < 2; ++a)
#pragma unroll
      for (int b = 0; b < 2; ++b)
#pragma unroll
        for (int m = 0; m < 4; ++m)
#pragma unroll
          for (int n = 0; n < 2; ++n) acc[a][b][m][n] = (f32x4){0.f, 0.f, 0.f, 0.f};
    cpm = npm; cpn = npn; cA = nA; cB = nB; ++ui;
  }
  PG8_WAIT_V(0);
  if (wr == 0) PG8_BAR;
  PG8_BAR;
#undef PG8_SA
#undef PG8_SB
#undef PG8_STAGE
#undef PG8_LDA
#undef PG8_LDB
#undef PG8_MMA
#undef PG8_WAIT_V
#undef PG8_WAIT_L
#undef PG8_BAR
#undef PG8_SCHED
}

DEV void rope8(float (&v)[8], int d0, int prow, int pcol, const float* __restrict__ rope) {
  const int pp = (d0 < 32) ? prow : pcol;
#pragma unroll
  for (int i = 0; i < 4; ++i) {
    const int f = ((d0 >> 1) + i) & 15;
    const float cs = rope[(pp * 16 + f) * 2], sn = rope[(pp * 16 + f) * 2 + 1];
    const float x1 = v[2 * i], x2 = v[2 * i + 1];
    v[2 * i] = x1 * cs - x2 * sn; v[2 * i + 1] = x1 * sn + x2 * cs;
  }
}

DEV void prep_token_row(const Params& p, int l, int m, int lane, uint4 c) {
  bf16_t* zr = p.zf + (size_t)m * 1792;
  const bool lat = m >= 8192;
  const int pos = lat ? ((m - 8192) & 1023) : (m & 255);
  const int prow = pos >> 6, pcol = pos & 63;
  const int d0 = (lane & 7) * 8;
  U8 u; u.u = c;
  float v[8], gl[8]; float ss = 0.f, sg = 0.f;
#pragma unroll
  for (int j = 0; j < 8; ++j) { v[j] = bf2f(u.h[j]); ss += v[j] * v[j]; gl[j] = gelu_t(v[j]); sg += gl[j]; }
  ss += __shfl_xor(ss, 1); ss += __shfl_xor(ss, 2); ss += __shfl_xor(ss, 4);
#pragma unroll
  for (int o = 1; o <= 16; o <<= 1) sg += __shfl_xor(sg, o);
  const float mean = sg * (1.f / 256.f);
  float s2 = 0.f;
#pragma unroll
  for (int j = 0; j < 8; ++j) { const float d = gl[j] - mean; s2 += d * d; }
#pragma unroll
  for (int o = 1; o <= 16; o <<= 1) s2 += __shfl_xor(s2, o);
  if (lane < 16) {
    const float rinv = rsqrtf(ss * (1.f / 64.f) + 1e-6f);
#pragma unroll
    for (int j = 0; j < 8; ++j) v[j] = v[j] * rinv * p.k_g[l * 64 + d0 + j];
    if (!lat) {
      float* o = p.out + OFF_YK + ((((size_t)(m >> 8)) * 2 + l) * 256 + pos) * 128 + lane * 8;
      *(float4*)o = make_float4(v[0], v[1], v[2], v[3]); *(float4*)(o + 4) = make_float4(v[4], v[5], v[6], v[7]);
    } else rope8(v, d0, prow, pcol, p.rope);
#pragma unroll
    for (int j = 0; j < 4; ++j) u.w[j] = pack2(v[2 * j], v[2 * j + 1]);
    const int kvh = lane >> 3;
    bf16_t* kd = lat ? p.kb_lat + ((size_t)((l * 8 + ((m - 8192) >> 10)) * 2 + kvh) * 1280 + 256 + pos) * 64 + d0
                     : p.kb_ctx + ((size_t)((m >> 8) * 2 + kvh) * 256 + pos) * 64 + d0;
    *(uint4*)kd = u.u;
  } else if (lane < 32) {
    if (!lat) {
      float* o = p.out + OFF_YV + ((((size_t)(m >> 8)) * 2 + l) * 256 + pos) * 128 + (lane - 16) * 8;
      *(float4*)o = make_float4(v[0], v[1], v[2], v[3]); *(float4*)(o + 4) = make_float4(v[4], v[5], v[6], v[7]);
    }
    const int kvh = (lane - 16) >> 3;
    bf16_t* vd; int T;
    if (lat) { T = 1280; vd = p.vt_lat + ((size_t)((l * 8 + ((m - 8192) >> 10)) * 2 + kvh) * 64 + d0) * 1280 + 256 + pos; }
    else { T = 256; vd = p.vt_ctx + ((size_t)((m >> 8) * 2 + kvh) * 64 + d0) * 256 + pos; }
#pragma unroll
    for (int j = 0; j < 8; ++j) vd[(size_t)j * T] = u.h[j];
  } else {
    const float rstd = rsqrtf(s2 * (1.f / 256.f) + 1e-6f);
    const int ch = (lane - 32) * 8;
#pragma unroll
    for (int j = 0; j < 8; ++j) gl[j] = (gl[j] - mean) * rstd * p.mlp_g[l * 256 + ch + j] + p.mlp_b[l * 256 + ch + j];
#pragma unroll
    for (int j = 0; j < 4; ++j) u.w[j] = pack2(gl[2 * j], gl[2 * j + 1]);
    *(uint4*)(zr + 1536 + ch) = u.u;
  }
}

template <bool REV>
DEV void tile_scan(float (&a)[4][4], float (&u)[4][4], int lane) {
  const int q = lane >> 4;
  float C = 0.f, CP = 1.f;
  const int src1 = (REV ? lane + 16 : lane - 16) & 63;
  const int src2 = (REV ? lane + 32 : lane - 32) & 63;
  const int srcT = (lane & 15) + (REV ? 0 : 48);
  const bool c1 = REV ? (q <= 2) : (q >= 1);
  const bool c2 = REV ? (q <= 1) : (q >= 2);
  const bool first = REV ? (q == 3) : (q == 0);
#pragma unroll
  for (int mi = 0; mi < 4; ++mi) {
    const int mt = REV ? 3 - mi : mi;
    float P = 1.f, H = 0.f, pl[4], hl[4];
#pragma unroll
    for (int ri = 0; ri < 4; ++ri) {
      const int r = REV ? 3 - ri : ri;
      H = a[mt][r] * H + u[mt][r]; P *= a[mt][r]; pl[r] = P; hl[r] = H;
    }
    float Pi = P, Hi = H;
    float Pp = __shfl(Pi, src1), Hp = __shfl(Hi, src1);
    if (c1) { Hi = Pi * Hp + Hi; Pi = Pi * Pp; }
    Pp = __shfl(Pi, src2); Hp = __shfl(Hi, src2);
    if (c2) { Hi = Pi * Hp + Hi; Pi = Pi * Pp; }
    float Pe = __shfl(Pi, src1), He = __shfl(Hi, src1);
    if (first) { Pe = 1.f; He = 0.f; }
    const float hin = Pe * C + He, pin = Pe * CP;
#pragma unroll
    for (int r = 0; r < 4; ++r) { u[mt][r] = pl[r] * hin + hl[r]; a[mt][r] = pl[r] * pin; }
    const float Pt = __shfl(Pi, srcT), Ht = __shfl(Hi, srcT);
    C = Pt * C + Ht; CP = Pt * CP;
  }
}

DEV void lru_gate_item(const Params& p, int l, int item, char* smem) {
  const int tid = VTID, lane = tid & 63, w = tid >> 6;
  const int tile = item >> 2, blk = item & 3;
  const int m0 = tile * 64;
  int ms, L;
  if (m0 < 8192) { ms = m0 & ~255; L = 256; } else { ms = 8192 + ((m0 - 8192) & ~1023); L = 1024; }
  const int dir = w >> 1, half = w & 1, q = lane >> 4, c15 = lane & 15;
  const bf16_t* wt = p.wt_lru + (size_t)((((l * 2 + dir) * 4 + blk) * 2)) * 4096;
  bf16x8 bfr[2][2][2];
#pragma unroll
  for (int mat = 0; mat < 2; ++mat)
#pragma unroll
    for (int j = 0; j < 2; ++j)
#pragma unroll
      for (int s = 0; s < 2; ++s) bfr[mat][j][s] = *(const bf16x8*)(wt + mat * 4096 + (half * 32 + j * 16 + c15) * 64 + s * 32 + q * 8);
  float* xs = (float*)smem;
  float* xcf = xs + 67 * 64;
  bf16_t* xcb = (bf16_t*)(xcf + 64 * 64);
  for (int idx = tid; idx < 67 * 8; idx += 256) {
    const int rr = idx >> 3, cc = idx & 7;
    const int m = m0 - 1 + rr;
    float v[8];
    if (m >= ms && m < ms + L) {
      U8 u; u.u = *(const uint4*)(p.zf + (size_t)m * 1792 + 768 + blk * 64 + cc * 8);
#pragma unroll
      for (int j = 0; j < 8; ++j) v[j] = bf2f(u.h[j]);
    } else {
#pragma unroll
      for (int j = 0; j < 8; ++j) v[j] = 0.f;
    }
#pragma unroll
    for (int j = 0; j < 8; ++j) xs[rr * 64 + cc * 8 + j] = v[j];
  }
  __syncthreads();
  {
    const int ch = tid & 63, Cg = blk * 64 + ch;
    const float w0 = p.conv_w[(l * 4 + 0) * 256 + Cg], w1 = p.conv_w[(l * 4 + 1) * 256 + Cg], w2 = p.conv_w[(l * 4 + 2) * 256 + Cg],
                w3 = p.conv_w[(l * 4 + 3) * 256 + Cg], cb = p.conv_b[l * 256 + Cg];
#pragma unroll 4
    for (int tt = 0; tt < 16; ++tt) {
      const int t = (tid >> 6) * 16 + tt;
      const float v = cb + w0 * xs[t * 64 + ch] + w1 * xs[(t + 1) * 64 + ch] + w2 * xs[(t + 2) * 64 + ch] + w3 * xs[(t + 3) * 64 + ch];
      xcf[t * 64 + ch] = v; xcb[t * 72 + ch] = f2bf(v);
    }
  }
  __syncthreads();
  f32x4 acc[2][4][2];
#pragma unroll
  for (int mat = 0; mat < 2; ++mat)
#pragma unroll
    for (int mt = 0; mt < 4; ++mt)
#pragma unroll
      for (int j = 0; j < 2; ++j) acc[mat][mt][j] = f32x4{0.f, 0.f, 0.f, 0.f};
#pragma unroll
  for (int mt = 0; mt < 4; ++mt)
#pragma unroll
    for (int s = 0; s < 2; ++s) {
      const bf16x8 af = *(const bf16x8*)(xcb + (mt * 16 + c15) * 72 + s * 32 + q * 8);
#pragma unroll
      for (int mat = 0; mat < 2; ++mat)
#pragma unroll
        for (int j = 0; j < 2; ++j) acc[mat][mt][j] = mfma16(af, bfr[mat][j][s], acc[mat][mt][j]);
    }
  float* PCp = p.au + (size_t)(dir * 2 + 0) * MT * 256;
  float* HLp = p.au + (size_t)(dir * 2 + 1) * MT * 256;
#pragma unroll
  for (int j = 0; j < 2; ++j) {
    const int ch = half * 32 + j * 16 + c15, Cg = blk * 64 + ch, pidx = (l * 2 + dir) * 256 + Cg;
    const float ba = p.lru_ba[pidx], bx = p.lru_bx[pidx];
    const float cdec = p.cdec[pidx];
    float a[4][4], u[4][4];
#pragma unroll
    for (int mt = 0; mt < 4; ++mt)
#pragma unroll
      for (int r = 0; r < 4; ++r) {
        const int t = mt * 16 + q * 4 + r;
        const float rg = sigmoidf_(acc[0][mt][j][r] + ba), ig = sigmoidf_(acc[1][mt][j][r] + bx);
        const float la = cdec * rg;
        a[mt][r] = __expf(la);
        const float x2 = 2.f * la;
        const float em = (x2 < -0.25f) ? 1.f - __expf(x2) : -x2 * (1.f + x2 * (0.5f + x2 * (1.f / 6.f + x2 * (1.f / 24.f + x2 * (1.f / 120.f + x2 * (1.f / 720.f))))));
        u[mt][r] = __builtin_amdgcn_sqrtf(em) * ig * xcf[t * 64 + ch];
      }
    if (dir == 0) tile_scan<false>(a, u, lane); else tile_scan<true>(a, u, lane);
#pragma unroll
    for (int mt = 0; mt < 4; ++mt)
#pragma unroll
      for (int r = 0; r < 4; ++r) {
        const size_t m = m0 + mt * 16 + q * 4 + r;
        PCp[m * 256 + Cg] = a[mt][r]; HLp[m * 256 + Cg] = u[mt][r];
      }
  }
  __syncthreads();
}

DEV void attn_item(const Params& p, int l, int it, char* sm) {
  const int tid = threadIdx.x, lane = tid & 63, w = tid >> 6, q = lane >> 4, c15 = lane & 15;
  const int qg = w >> 1, kh = w & 1;
  int h, ms, nkt, T; const bf16_t* Kg; const bf16_t* Vg;
  if (it < 512) {
    const int b = it >> 6, qb = it & 7; h = (it >> 3) & 7; ms = 8192 + b * 1024 + qb * 128; nkt = 10; T = 1280;
    Kg = p.kb_lat + (size_t)((l * 8 + b) * 2 + (h >> 2)) * 1280 * 64; Vg = p.vt_lat + (size_t)((l * 8 + b) * 2 + (h >> 2)) * 64 * 1280;
  } else {
    const int i2 = it - 512, b = i2 >> 4, qb = i2 & 1; h = (i2 >> 1) & 7; ms = b * 256 + qb * 128; nkt = 2; T = 256;
    Kg = p.kb_ctx + (size_t)(b * 2 + (h >> 2)) * 256 * 64; Vg = p.vt_ctx + (size_t)(b * 2 + (h >> 2)) * 64 * 256;
  }
  const int kc0 = tid, kc1 = tid + 512;
  const int vd0 = tid >> 4, vk = (tid & 15) * 8;
  const int vpos = ((tid & 15) >> 2) * 32 + 16 * (tid & 1) + 4 * ((tid & 3) >> 1);
  const bf16_t* vg0 = Vg + (size_t)vd0 * T + vk;
  const bf16_t* vg1 = Vg + (size_t)(vd0 + 32) * T + vk;
  uint4 rk0, rk1, rv0, rv1;
#define ATT_LOAD(kt) do { rk0 = *(const uint4*)(Kg + (size_t)(kt) * 8192 + kc0 * 8); rk1 = *(const uint4*)(Kg + (size_t)(kt) * 8192 + kc1 * 8); \
    rv0 = *(const uint4*)(vg0 + (kt) * 128); rv1 = *(const uint4*)(vg1 + (kt) * 128); } while (0)
#define ATT_STORE(buf) do { bf16_t* Ks_ = (bf16_t*)(sm + (buf) * 36864); bf16_t* Vs_ = Ks_ + 9216; \
    *(uint4*)(Ks_ + (kc0 >> 3) * 72 + (kc0 & 7) * 8) = rk0; *(uint4*)(Ks_ + (kc1 >> 3) * 72 + (kc1 & 7) * 8) = rk1; \
    *(uint2*)(Vs_ + vd0 * 136 + vpos) = make_uint2(rv0.x, rv0.y); *(uint2*)(Vs_ + vd0 * 136 + vpos + 8) = make_uint2(rv0.z, rv0.w); \
    *(uint2*)(Vs_ + (vd0 + 32) * 136 + vpos) = make_uint2(rv1.x, rv1.y); *(uint2*)(Vs_ + (vd0 + 32) * 136 + vpos + 8) = make_uint2(rv1.z, rv1.w); } while (0)
  ATT_LOAD(0);
  const int mq = ms + qg * 32;
  bf16x8 qf[2][2];
#pragma unroll
  for (int t = 0; t < 2; ++t)
#pragma unroll
    for (int s = 0; s < 2; ++s) qf[t][s] = *(const bf16x8*)(p.zf + (size_t)(mq + t * 16 + c15) * 1792 + h * 64 + s * 32 + q * 8);
  ATT_STORE(0);
  if (nkt > 1) ATT_LOAD(1);
#pragma unroll
  for (int t = 0; t < 2; ++t) {
    float f[2][8]; float ss = 0.f;
#pragma unroll
    for (int s = 0; s < 2; ++s)
#pragma unroll
      for (int j = 0; j < 8; ++j) { f[s][j] = bf2f((bf16_t)qf[t][s][j]); ss += f[s][j] * f[s][j]; }
    ss += __shfl_xor(ss, 16); ss += __shfl_xor(ss, 32);
    const float rinv = rsqrtf(ss * (1.f / 64.f) + 1e-6f);
    const int mrow_ = mq + t * 16 + c15;
    const int pos = (mrow_ - 8192) & 1023;
#pragma unroll
    for (int s = 0; s < 2; ++s) {
      const int dd = s * 32 + q * 8;
#pragma unroll
      for (int j = 0; j < 8; ++j) f[s][j] = f[s][j] * rinv * p.q_g[l * 64 + dd + j];
      if (it < 512) rope8(f[s], dd, pos >> 6, pos & 63, p.rope);
      U8 pk;
#pragma unroll
      for (int j = 0; j < 4; ++j) pk.w[j] = pack2(f[s][2 * j] * QSCALE, f[s][2 * j + 1] * QSCALE);
      qf[t][s] = pk.v;
    }
  }
  __syncthreads();
  f32x4 o[2][4];
  float mrow[2], lrow[2];
#pragma unroll
  for (int t = 0; t < 2; ++t) { mrow[t] = -1e30f; lrow[t] = 0.f;
#pragma unroll
    for (int j = 0; j < 4; ++j) o[t][j] = f32x4{0.f, 0.f, 0.f, 0.f}; }
  for (int kt = 0; kt < nkt; ++kt) {
    const int cur = kt & 1;
    const bf16_t* Ks = (const bf16_t*)(sm + cur * 36864) + kh * 64 * 72;
    const bf16_t* Vs = (const bf16_t*)(sm + cur * 36864) + 9216 + kh * 64;
    f32x4 s4[2][4];
    {
      bf16x8 kf[4][2];
#pragma unroll
      for (int jn = 0; jn < 4; ++jn)
#pragma unroll
        for (int s = 0; s < 2; ++s) kf[jn][s] = *(const bf16x8*)(Ks + (jn * 16 + c15) * 72 + s * 32 + q * 8);
      __builtin_amdgcn_sched_barrier(0);
#pragma unroll
      for (int jn = 0; jn < 4; ++jn)
#pragma unroll
        for (int t = 0; t < 2; ++t) s4[t][jn] = mfma16(kf[jn][0], qf[t][0], f32x4{0.f, 0.f, 0.f, 0.f});
#pragma unroll
      for (int jn = 0; jn < 4; ++jn)
#pragma unroll
        for (int t = 0; t < 2; ++t) s4[t][jn] = mfma16(kf[jn][1], qf[t][1], s4[t][jn]);
      __builtin_amdgcn_sched_barrier(0);
    }
    U8 vf[4][2];
#pragma unroll
    for (int jn = 0; jn < 4; ++jn)
#pragma unroll
      for (int ks = 0; ks < 2; ++ks) vf[jn][ks].u = *(const uint4*)(Vs + (jn * 16 + c15) * 136 + ks * 32 + q * 8);
    __builtin_amdgcn_sched_barrier(0);
    U8 pb[2][2];
#pragma unroll
    for (int t = 0; t < 2; ++t) {
      float mx = s4[t][0][0];
#pragma unroll
      for (int jn = 0; jn < 4; ++jn)
#pragma unroll
        for (int r = 0; r < 4; ++r) mx = fmaxf(mx, s4[t][jn][r]);
      mx = fmaxf(mx, __shfl_xor(mx, 16)); mx = fmaxf(mx, __shfl_xor(mx, 32));
      const float mnew = fmaxf(mrow[t], mx);
      const float alpha = __builtin_amdgcn_exp2f(mrow[t] - mnew);
      mrow[t] = mnew;
      float ls = 0.f;
#pragma unroll
      for (int jn = 0; jn < 4; ++jn)
#pragma unroll
        for (int r = 0; r < 4; ++r) { const float pv = __builtin_amdgcn_exp2f(s4[t][jn][r] - mnew); s4[t][jn][r] = pv; ls += pv; }
      lrow[t] = lrow[t] * alpha + ls;
#pragma unroll
      for (int jn = 0; jn < 4; ++jn) { o[t][jn][0] *= alpha; o[t][jn][1] *= alpha; o[t][jn][2] *= alpha; o[t][jn][3] *= alpha; }
#pragma unroll
      for (int ks = 0; ks < 2; ++ks) {
        pb[t][ks].w[0] = pack2(s4[t][2 * ks][0], s4[t][2 * ks][1]); pb[t][ks].w[1] = pack2(s4[t][2 * ks][2], s4[t][2 * ks][3]);
        pb[t][ks].w[2] = pack2(s4[t][2 * ks + 1][0], s4[t][2 * ks + 1][1]); pb[t][ks].w[3] = pack2(s4[t][2 * ks + 1][2], s4[t][2 * ks + 1][3]);
      }
    }
#pragma unroll
    for (int ks = 0; ks < 2; ++ks)
#pragma unroll
      for (int jn = 0; jn < 4; ++jn)
#pragma unroll
        for (int t = 0; t < 2; ++t) o[t][jn] = mfma16(vf[jn][ks].v, pb[t][ks].v, o[t][jn]);
    if (kt + 1 < nkt) {
      ATT_STORE(cur ^ 1);
      if (kt + 2 < nkt) ATT_LOAD(kt + 2);
    }
    __syncthreads();
  }
#undef ATT_LOAD
#undef ATT_STORE
  float* mrg = (float*)(sm + 73728) + (size_t)(qg * 64 + lane) * 37;
  float lt[2];
#pragma unroll
  for (int t = 0; t < 2; ++t) { float a = lrow[t]; a += __shfl_xor(a, 16); a += __shfl_xor(a, 32); lt[t] = a; }
  if (kh == 1) {
#pragma unroll
    for (int t = 0; t < 2; ++t) {
      mrg[t * 18 + 0] = mrow[t]; mrg[t * 18 + 1] = lt[t];
#pragma unroll
      for (int jn = 0; jn < 4; ++jn)
#pragma unroll
        for (int r = 0; r < 4; ++r) mrg[t * 18 + 2 + jn * 4 + r] = o[t][jn][r];
    }
  }
  __syncthreads();
  if (kh == 0) {
#pragma unroll
    for (int t = 0; t < 2; ++t) {
      const float m1 = mrg[t * 18 + 0], l1 = mrg[t * 18 + 1];
      const float mm = fmaxf(mrow[t], m1);
      const float a0 = __builtin_amdgcn_exp2f(mrow[t] - mm), a1 = __builtin_amdgcn_exp2f(m1 - mm);
      const float inv = 1.f / (a0 * lt[t] + a1 * l1);
      const float c0 = a0 * inv, c1 = a1 * inv;
      bf16_t* orow = p.abuf + (size_t)(mq + t * 16 + c15) * 1024 + h * 64 + q * 4;
#pragma unroll
      for (int jn = 0; jn < 4; ++jn) {
        const float x0 = c0 * o[t][jn][0] + c1 * mrg[t * 18 + 2 + jn * 4 + 0], x1 = c0 * o[t][jn][1] + c1 * mrg[t * 18 + 2 + jn * 4 + 1];
        const float x2 = c0 * o[t][jn][2] + c1 * mrg[t * 18 + 2 + jn * 4 + 2], x3 = c0 * o[t][jn][3] + c1 * mrg[t * 18 + 2 + jn * 4 + 3];
        uint2 ov; ov.x = pack2(x0, x1); ov.y = pack2(x2, x3);
        *(uint2*)(orow + jn * 16) = ov;
      }
    }
  }
  __syncthreads();
}

DEV void gmlp_item(const Params& p, int l, int it, char* smem) {
  const int tid = VTID, lane = tid & 63, w = tid >> 6, q = lane >> 4, c15 = lane & 15;
  const int chunk = it >> 2, g = it & 3, m0 = chunk * 128;
  bf16_t* vt = (bf16_t*)smem;
  const float* wsg = p.mlp_ws + (size_t)(l * 4 + g) * 16384;
  float4 wa[2][4][2];
#pragma unroll
  for (int nt = 0; nt < 2; ++nt)
#pragma unroll
    for (int s = 0; s < 4; ++s) {
      const float* ap = wsg + ((2 * w + nt) * 16 + c15) * 128 + s * 32 + q * 8;
      wa[nt][s][0] = *(const float4*)ap; wa[nt][s][1] = *(const float4*)(ap + 4);
    }
  uint4 vin[4];
#pragma unroll
  for (int i = 0; i < 4; ++i) { const int id = tid + 256 * i; vin[i] = *(const uint4*)(p.zf + (size_t)(m0 + (id >> 3)) * 1792 + 1536 + g * 64 + (id & 7) * 8); }
#pragma unroll
  for (int i = 0; i < 4; ++i) {
    const int id = tid + 256 * i, qq = id >> 3, cc = id & 7;
    U8 v; v.u = vin[i];
#pragma unroll
    for (int j = 0; j < 8; ++j) vt[(cc * 8 + j) * 136 + qq] = v.h[j];
  }
  __syncthreads();
  f32x4 acc[4][2];
#pragma unroll
  for (int mt = 0; mt < 4; ++mt)
#pragma unroll
    for (int nt = 0; nt < 2; ++nt) acc[mt][nt] = f32x4{0.f, 0.f, 0.f, 0.f};
#pragma unroll
  for (int s = 0; s < 4; ++s) {
    bf16x8 af[4];
#pragma unroll
    for (int mt = 0; mt < 4; ++mt) af[mt] = *(const bf16x8*)(vt + (mt * 16 + c15) * 136 + s * 32 + q * 8);
#pragma unroll
    for (int nt = 0; nt < 2; ++nt) {
      U8 bb;
      bb.w[0] = pack2(wa[nt][s][0].x, wa[nt][s][0].y); bb.w[1] = pack2(wa[nt][s][0].z, wa[nt][s][0].w);
      bb.w[2] = pack2(wa[nt][s][1].x, wa[nt][s][1].y); bb.w[3] = pack2(wa[nt][s][1].z, wa[nt][s][1].w);
#pragma unroll
      for (int mt = 0; mt < 4; ++mt) acc[mt][nt] = mfma16(af[mt], bb.v, acc[mt][nt]);
    }
  }
#pragma unroll
  for (int nt = 0; nt < 2; ++nt) {
    const int pp = (2 * w + nt) * 16 + c15;
    const size_t m = m0 + pp;
    const float bsv = p.mlp_bs[(l * 4 + g) * 128 + pp];
#pragma unroll
    for (int mt = 0; mt < 4; ++mt) {
      const int c = mt * 16 + q * 4;
      const uint2 uu = *(const uint2*)(p.zf + m * 1792 + 1280 + g * 64 + c);
      const float u0 = gelu_t(__uint_as_float(uu.x << 16)), u1 = gelu_t(__uint_as_float(uu.x & 0xffff0000u)), u2 = gelu_t(__uint_as_float(uu.y << 16)), u3 = gelu_t(__uint_as_float(uu.y & 0xffff0000u));
      uint2 o; o.x = pack2(u0 * (acc[mt][nt][0] + bsv), u1 * (acc[mt][nt][1] + bsv)); o.y = pack2(u2 * (acc[mt][nt][2] + bsv), u3 * (acc[mt][nt][3] + bsv));
      *(uint2*)(p.abuf + m * 1024 + 768 + g * 64 + c) = o;
    }
  }
  __syncthreads();
}

DEV void lru_apply_item(const Params& p, int l, int ti2) {
  const int C = VTID;
  const int ti = ti2 >> 1, th = (ti2 & 1) * 32;
  const int m0 = ti * 64;
  int ms, L, b; bool lat = m0 >= 8192;
  if (!lat) { ms = m0 & ~255; L = 256; b = m0 >> 8; } else { ms = 8192 + ((m0 - 8192) & ~1023); L = 1024; b = (m0 - 8192) >> 10; }
  const int k = (m0 - ms) >> 6, nt = L >> 6;
  const float* PCf = p.au; const float* HLf = p.au + (size_t)MT * 256;
  const float* PCb = p.au + (size_t)2 * MT * 256; const float* HLb = p.au + (size_t)3 * MT * 256;
  float cf = lat ? p.state_lru[((size_t)(b * 2 + l) * 2 + 0) * 256 + C] : 0.f;
  float cb = lat ? p.state_lru[((size_t)(b * 2 + l) * 2 + 1) * 256 + C] : 0.f;
  {
    float pc[15], hl[15];
#pragma unroll
    for (int i = 0; i < 15; ++i) {
      const bool act = i < k;
      const size_t e = (size_t)(ms + 64 * i + 63) * 256 + C;
      pc[i] = act ? PCf[e] : 1.f; hl[i] = act ? HLf[e] : 0.f;
    }
#pragma unroll
    for (int i = 0; i < 15; ++i) cf = pc[i] * cf + hl[i];
  }
  {
    float pc[15], hl[15];
#pragma unroll
    for (int i = 0; i < 15; ++i) {
      const int tix = nt - 1 - i;
      const bool act = tix > k;
      const size_t e = (size_t)(ms + 64 * tix) * 256 + C;
      pc[i] = act ? PCb[e] : 1.f; hl[i] = act ? HLb[e] : 0.f;
    }
#pragma unroll
    for (int i = 0; i < 15; ++i) cb = pc[i] * cb + hl[i];
  }
  float hf_last = 0.f, hb_first = 0.f;
#pragma unroll 16
  for (int t = th; t < th + 32; ++t) {
    const size_t m = m0 + t;
    const float hf = PCf[m * 256 + C] * cf + HLf[m * 256 + C];
    const float hb = PCb[m * 256 + C] * cb + HLb[m * 256 + C];
    const float g = gelu_t(bf2f(p.zf[m * 1792 + 1024 + C]));
    p.abuf[m * 1024 + 512 + C] = f2bf((hf + hb) * g);
    if (t == 0) hb_first = hb;
    if (t == 63) hf_last = hf;
  }
  if (!lat) {
    if (k == nt - 1 && th == 32) p.out[OFF_ST + ((size_t)(b * 2 + l) * 2 + 0) * 256 + C] = hf_last;
    if (k == 0 && th == 0) p.out[OFF_ST + ((size_t)(b * 2 + l) * 2 + 1) * 256 + C] = hb_first;
  }
}

DEV void mixer_phase(const Params& p, int l, char* smem_raw, char* smem) {
  for (int it = blockIdx.x; it < 1024; it += gridDim.x) attn_item(p, l, it, smem_raw);
  const int NITEMS = 512 + 512;
  for (int it = VBID; it < NITEMS; it += VNB) {
    if (it < 512) lru_apply_item(p, l, it);
    else gmlp_item(p, l, it - 512, smem);
  }
}

DEV void prep_phase_full(const Params& p, int l, char* smem) {
  for (int it = VBID; it < 1024; it += VNB) lru_gate_item(p, l, it, smem);
  const int lane = threadIdx.x & 63, mstride = gridDim.x * 8;
  int m = blockIdx.x * 8 + (threadIdx.x >> 6);
  const int coff = lane < 32 ? 512 + lane * 8 : 1536 + (lane - 32) * 8;
  uint4 n1 = *(const uint4*)(p.zf + (size_t)m * 1792 + coff);
  uint4 n2 = *(const uint4*)(p.zf + (size_t)((m + mstride < MT) ? m + mstride : m) * 1792 + coff);
  for (; m < MT; m += mstride) {
    const uint4 c = n1; n1 = n2;
    const int mn = (m + 2 * mstride < MT) ? m + 2 * mstride : m;
    n2 = *(const uint4*)(p.zf + (size_t)mn * 1792 + coff);
    prep_token_row(p, l, m, lane, c);
  }
}


#define XB_TMO      128
#define XB_XCNT(j)  (256  + 64 * (j))
#define XB_XSUB(j)  (1280 + 64 * (j))
#define XB_XGEN(j)  (2304 + 64 * (j))
#define XB_TOP      3328
#define XB_TOPGEN   3392
#define XCD_BAR_WORDS 3456
#define XB_SPIN_CAP (1u << 18)
#define LAS __attribute__((address_space(3)))
DEV unsigned xb_ld(unsigned* p) { return __hip_atomic_load(p, __ATOMIC_RELAXED, __HIP_MEMORY_SCOPE_AGENT); }
DEV unsigned xb_add(unsigned* p, unsigned v) { return __hip_atomic_fetch_add(p, v, __ATOMIC_RELAXED, __HIP_MEMORY_SCOPE_AGENT); }
DEV unsigned xb_xcc_id() { return (unsigned)__builtin_amdgcn_s_getreg((3 << 11) | 20) & 0xFu; }
#define XB_SPIN(cond, bar) do { unsigned _sp = 0; while (cond) { __builtin_amdgcn_s_sleep(1); \
    if ((++_sp & 255u) == 0u) { if (xb_ld(&(bar)[XB_TMO])) break; if (_sp > XB_SPIN_CAP) { atomicAdd(&(bar)[XB_TMO], 1u); break; } } } } while (0)
struct XcdBarrier { unsigned* bar; unsigned x; volatile LAS unsigned* st; };
DEV XcdBarrier xcd_barrier_post(unsigned* bar, volatile LAS unsigned* st) {
  XcdBarrier b; b.bar = bar; b.x = xb_xcc_id(); b.st = st;
  if (threadIdx.x == 0) (void)xb_add(&bar[XB_XCNT(b.x)], 1u);
  return b;
}
DEV void xcd_barrier_complete(unsigned* bar, unsigned x, unsigned& nloc, unsigned& nx) {
  const unsigned G = gridDim.x * gridDim.y * gridDim.z;
  unsigned sum, cnt, mine, sp = 0u;
  for (;;) {
    sum = 0u; cnt = 0u; mine = 0u;
#pragma unroll
    for (unsigned j = 0; j < 16; ++j) { const unsigned c = xb_ld(&bar[XB_XCNT(j)]); sum += c; cnt += (c > 0u) ? 1u : 0u; mine = (j == x) ? c : mine; }
    if (sum == G) break;
    __builtin_amdgcn_s_sleep(1);
    if ((++sp & 255u) == 0u) { if (xb_ld(&bar[XB_TMO])) break; if (sp > XB_SPIN_CAP) { atomicAdd(&bar[XB_TMO], 1u); break; } }
  }
  nloc = mine > 0u ? mine : 1u; nx = cnt > 0u ? cnt : 1u;
}
DEV void xcd_barrier(const XcdBarrier& b) {
  asm volatile("s_waitcnt vmcnt(0)" ::: "memory");
  __syncthreads();
  if (threadIdx.x == 0) {
    unsigned* bar = b.bar;
    __builtin_amdgcn_s_waitcnt(0);
    unsigned nloc = b.st[0], nx = b.st[1];
    if (nloc == 0u) { xcd_barrier_complete(bar, b.x, nloc, nx); b.st[0] = nloc; b.st[1] = nx; }
    const unsigned old = xb_add(&bar[XB_XSUB(b.x)], 1u);
    const unsigned gen = old / nloc;
    if (old + 1u == (gen + 1u) * nloc) {
      __builtin_amdgcn_fence(__ATOMIC_RELEASE, "agent");
      asm volatile("s_waitcnt vmcnt(0)" ::: "memory");
      const unsigned og = xb_add(&bar[XB_TOP], 1u);
      const unsigned tg = og / nx;
      if (og + 1u == (tg + 1u) * nx) xb_add(&bar[XB_TOPGEN], 1u);
      else XB_SPIN(xb_ld(&bar[XB_TOPGEN]) == tg, bar);
      __builtin_amdgcn_fence(__ATOMIC_ACQUIRE, "agent");
      xb_add(&bar[XB_XGEN(b.x)], 1u);
      asm volatile("s_waitcnt vmcnt(0)" ::: "memory");
    } else {
      XB_SPIN(xb_ld(&bar[XB_XGEN(b.x)]) == gen, bar);
      __builtin_amdgcn_fence(__ATOMIC_ACQUIRE, "agent");
      asm volatile("s_waitcnt vmcnt(0)" ::: "memory");
    }
  }
  __syncthreads();
}

#define PH(i, call) if (ph_lo <= (i) && (i) < ph_hi) { if ((i) > ph_lo) xcd_barrier(xb); call; }
#define LAYER(l, b) \
  PH(b + 0, ln_mod_phase(p, l, l == 0 ? 0 : 1)) \
  PH(b + 1, gemm_phase<1>(p, l, p.abuf, p.wt_in + (size_t)l * 1792 * 1024, 1792, 1024, (LAS3 unsigned char*)smem_raw)) \
  PH(b + 2, prep_phase_full(p, l, smem)) \
  PH(b + 3, mixer_phase(p, l, smem_raw, smem)) \
  PH(b + 4, gemm_phase<2>(p, l, p.abuf, p.wt_out + (size_t)l * 1024 * 1024, 1024, 1024, (LAS3 unsigned char*)smem_raw)) \
  PH(b + 5, ln_mod_phase(p, l, 2)) \
  PH(b + 6, gemm_phase<3>(p, l, p.abuf, p.wt_ff1 + (size_t)l * 4096 * 1024, 4096, 1024, (LAS3 unsigned char*)smem_raw)) \
  PH(b + 7, gemm_phase<4>(p, l, p.zf, p.wt_ff2 + (size_t)l * 1024 * 4096, 1024, 4096, (LAS3 unsigned char*)smem_raw))

__global__ void __launch_bounds__(512, 2) mega_kernel(Params p, int ph_lo, int ph_hi) {
  extern __shared__ __attribute__((aligned(16))) char smem_raw[];
  char* smem = smem_raw + (threadIdx.x >> 8) * 65536;
  __shared__ uint4 xb_words;
  if (threadIdx.x == 0) xb_words = make_uint4(0u, 0u, 0u, 0u);
  __syncthreads();
  XcdBarrier xb = xcd_barrier_post(p.bar, (volatile LAS unsigned*)&xb_words);
  if (ph_hi > 1000) { cg::grid_group grid = cg::this_grid(); grid.sync(); }
  PH(0, phase0(p, smem))
  LAYER(0, 1)
  LAYER(1, 9)
  PH(17, ln_mod_phase(p, 1, 3))
}

extern "C" void kernel_launch(void* const* d_in, const int* in_sizes, int n_in, void* d_out, int out_size, void* d_ws, size_t ws_size,
                              hipStream_t stream) {
  static int grid_blocks = 0;
  if (!grid_blocks) {
    int dev = 0, cus = 0, per_cu = 0;
    hipGetDevice(&dev);
    hipDeviceGetAttribute(&cus, hipDeviceAttributeMultiprocessorCount, dev);
    hipFuncSetAttribute((const void*)mega_kernel, hipFuncAttributeMaxDynamicSharedMemorySize, SMEM_BYTES);
    hipOccupancyMaxActiveBlocksPerMultiprocessor(&per_cu, (const void*)mega_kernel, 512, SMEM_BYTES);
    if (per_cu < 1) per_cu = 1;
    if (per_cu > 1) per_cu = 1;
    grid_blocks = cus * per_cu;
  }
  Params p{};
  const float** pin = (const float**)&p;
  for (int i = 0; i < 32; ++i) pin[i] = (const float*)d_in[i];
  p.out = (float*)d_out;
  char* ws = (char*)d_ws;
  size_t off = 0;
  p.bar = (unsigned*)(ws + off); off += 16384;
  p.rstat = (float*)(ws + off); off += (size_t)MT * 2 * 4;
  p.kb_lat = (bf16_t*)(ws + off); off += (size_t)2 * 8 * 2 * 1280 * 64 * 2;
  p.vt_lat = (bf16_t*)(ws + off); off += (size_t)2 * 8 * 2 * 1280 * 64 * 2;
  p.kb_ctx = (bf16_t*)(ws + off); off += (size_t)32 * 2 * 256 * 64 * 2;
  p.vt_ctx = (bf16_t*)(ws + off); off += (size_t)32 * 2 * 256 * 64 * 2;
  p.wt_in = (bf16_t*)(ws + off); off += (size_t)2 * 1792 * 1024 * 2;
  p.wt_out = (bf16_t*)(ws + off); off += (size_t)2 * 1024 * 1024 * 2;
  p.wt_ff1 = (bf16_t*)(ws + off); off += (size_t)2 * 4096 * 1024 * 2;
  p.wt_ff2 = (bf16_t*)(ws + off); off += (size_t)2 * 4096 * 1024 * 2;
  p.wt_lru = (bf16_t*)(ws + off); off += (size_t)64 * 4096 * 2;
  p.mod = (float*)(ws + off); off += (size_t)2 * 9 * 6144 * 4;
  p.rope = (float*)(ws + off); off += (size_t)2048 * 4;
  p.cdec = (float*)(ws + off); off += (size_t)1024 * 4;
  p.abuf = (bf16_t*)(ws + off); off += (size_t)MT * 1024 * 2;
  p.zf = (bf16_t*)(ws + off);
  p.au = (float*)(ws + off + (size_t)MT * 1792 * 2);
  off += (size_t)MT * 4096 * 2;
  if (off > ws_size) { fprintf(stderr, "workspace too small: need %zu have %zu\n", off, ws_size); return; }
  (void)hipMemsetAsync(p.bar, 0, XCD_BAR_WORDS * 4, stream);
#if MULTI_LAUNCH
  for (int ph = 0; ph < NPHASE; ++ph) {
    hipLaunchKernelGGL(mega_kernel, dim3(grid_blocks), dim3(512), SMEM_BYTES, stream, p, ph, ph + 1);
  }
#else
  int lo = 0, hi = NPHASE;
  void* args[] = {&p, &lo, &hi};
  hipError_t e = hipLaunchCooperativeKernel((void*)mega_kernel, dim3(grid_blocks), dim3(512), args, SMEM_BYTES, stream);
  if (e != hipSuccess) fprintf(stderr, "cooperative launch failed: %s (grid %d)\n", hipGetErrorString(e), grid_blocks);
#endif
}
```

```cpp
#include <hip/hip_runtime.h>
#include <hip/hip_cooperative_groups.h>
#include <cstdio>
#include <cstdint>
namespace cg = cooperative_groups;

#ifndef MULTI_LAUNCH
#define MULTI_LAUNCH 0
#endif

typedef unsigned short bf16_t;
using bf16x8 = __attribute__((ext_vector_type(8))) short;
using f32x4 = __attribute__((ext_vector_type(4))) float;
#define DEV __device__ __forceinline__
#define VTID ((int)(threadIdx.x & 255))
#define VBID ((int)(blockIdx.x * 2 + (threadIdx.x >> 8)))
#define VNB ((int)(gridDim.x * 2))

constexpr int MT = 16384;
constexpr int NPHASE = 18;
constexpr size_t OFF_YK = 16777216, OFF_YV = OFF_YK + 2097152, OFF_ST = OFF_YV + 2097152;
constexpr float ALPHA = 1.41421356237f;
constexpr float QSCALE = 0.125f * 1.4426950408889634f;
constexpr int SMEM_BYTES = 131072;

struct Params {
  const float *x_prompt, *x_sample, *c, *cache_k, *cache_v, *state_lru, *c_ctx, *w_ada, *b_ada, *w_in,
      *q_g, *k_g, *conv_w, *conv_b, *lru_wa, *lru_ba, *lru_wx, *lru_bx, *lru_lam, *mlp_g, *mlp_b, *mlp_ws, *mlp_bs,
      *w_out, *ln1_g, *ln1_b, *w_ff1, *b_ff1, *w_ff2, *b_ff2, *ln2_g, *ln2_b;
  float* out;
  bf16_t *wt_in, *wt_out, *wt_ff1, *wt_ff2, *wt_lru;
  float *mod, *rope, *cdec;
  bf16_t *abuf;
  bf16_t *zf;
  float *au;
  bf16_t *kb_lat, *vt_lat;
  bf16_t *kb_ctx, *vt_ctx;
  unsigned *bar;
  float *rstat;
};

union U8 { uint4 u; bf16x8 v; bf16_t h[8]; unsigned w[4]; };

DEV float bf2f(bf16_t h) { return __uint_as_float(((unsigned)h) << 16); }
DEV bf16_t f2bf(float f) { unsigned u = __float_as_uint(f); u += 0x7fffu + ((u >> 16) & 1u); return (bf16_t)(u >> 16); }
DEV unsigned pack2(float a, float b) { unsigned r; asm volatile("v_cvt_pk_bf16_f32 %0, %1, %2" : "=v"(r) : "v"(a), "v"(b)); return r; }
DEV float gelu_t(float x) { float y = 0.7978845608028654f * (x + 0.044715f * x * x * x); float t = 1.f - 2.f * __builtin_amdgcn_rcpf(1.f + __expf(2.f * y)); return 0.5f * x * (1.f + t); }
DEV float sigmoidf_(float x) { return __builtin_amdgcn_rcpf(1.f + __expf(-x)); }
DEV int xrow(int vm) { const int k = vm >> 11, c = (vm & 2047) >> 3, w = vm & 7; return ((c & 7) << 11) + (k << 8) + ((c >> 3) << 3) + w; }
DEV int cond_of(int m) { return m < 8192 ? 0 : 1 + ((m - 8192) >> 10); }
DEV f32x4 mfma16(bf16x8 a, bf16x8 b, f32x4 c) { return __builtin_amdgcn_mfma_f32_16x16x32_bf16(a, b, c, 0, 0, 0); }
DEV float wave_sum(float v) {
#pragma unroll
  for (int o = 32; o >= 1; o >>= 1) v += __shfl_xor(v, o);
  return v;
}

DEV void transpose_tile(const float* __restrict__ src, bf16_t* __restrict__ dst, int lds_, int ldd, char* smem) {
  float* T = (float*)smem;
  const int tid = VTID;
#pragma unroll
  for (int i = 0; i < 4; ++i) {
    int k = (tid >> 4) + 16 * i, n4 = (tid & 15) * 4;
    float4 v = *(const float4*)(src + (size_t)k * lds_ + n4);
    T[k * 65 + n4 + 0] = v.x; T[k * 65 + n4 + 1] = v.y; T[k * 65 + n4 + 2] = v.z; T[k * 65 + n4 + 3] = v.w;
  }
  __syncthreads();
#pragma unroll
  for (int i = 0; i < 2; ++i) {
    int n = (tid >> 3) + 32 * i, k8 = (tid & 7) * 8;
    U8 o;
#pragma unroll
    for (int j = 0; j < 4; ++j) o.w[j] = pack2(T[(k8 + 2 * j) * 65 + n], T[(k8 + 2 * j + 1) * 65 + n]);
    *(uint4*)(dst + (size_t)n * ldd + k8) = o.u;
  }
  __syncthreads();
}
DEV void transpose_w(const float* __restrict__ W, bf16_t* __restrict__ Wt, int K, int N, int tk, int tn, char* smem) {
  transpose_tile(W + (size_t)(tk * 64) * N + tn * 64, Wt + (size_t)(tn * 64) * K + tk * 64, N, K, smem);
}

DEV void tr_desc(const Params& p, int t, const float*& src, int& lds_, bf16_t*& dst, int& ldd) {
  if (t < 2 * 2768) {
    const int l = t / 2768, r = t % 2768;
    const float* W; bf16_t* Wt; int K, N, tk, tn;
    if (r < 448) { W = p.w_in + (size_t)l * 1024 * 1792; Wt = p.wt_in + (size_t)l * 1792 * 1024; K = 1024; N = 1792; tk = r / 28; tn = r % 28; }
    else if (r < 704) { const int i = r - 448; W = p.w_out + (size_t)l * 1024 * 1024; Wt = p.wt_out + (size_t)l * 1024 * 1024; K = 1024; N = 1024; tk = i / 16; tn = i % 16; }
    else if (r < 1728) { const int i = r - 704; W = p.w_ff1 + (size_t)l * 1024 * 4096; Wt = p.wt_ff1 + (size_t)l * 4096 * 1024; K = 1024; N = 4096; tk = i / 64; tn = i % 64; }
    else if (r < 2752) { const int i = r - 1728; W = p.w_ff2 + (size_t)l * 4096 * 1024; Wt = p.wt_ff2 + (size_t)l * 1024 * 4096; K = 4096; N = 1024; tk = i / 16; tn = i % 16; }
    else {
      const int idx = r - 2752, dir = idx >> 3, blk = (idx >> 1) & 3, mat = idx & 1;
      src = (mat == 0 ? p.lru_wa : p.lru_wx) + (size_t)(((l * 2 + dir) * 4 + blk)) * 4096; lds_ = 64;
      dst = p.wt_lru + (size_t)((((l * 2 + dir) * 4 + blk) * 2 + mat)) * 4096; ldd = 64; return;
    }
    src = W + (size_t)(tk * 64) * N + tn * 64; lds_ = N; dst = Wt + (size_t)(tn * 64) * K + tk * 64; ldd = K;
  } else {
    const int j = t - 2 * 2768, tt = j & 3, kvh = (j >> 2) & 1, l = (j >> 3) & 1, b = j >> 4;
    src = p.cache_v + ((size_t)(b * 2 + l) * 256 + tt * 64) * 128 + kvh * 64; lds_ = 128;
    dst = p.vt_lat + ((size_t)((l * 8 + b) * 2 + kvh) * 64) * 1280 + tt * 64; ldd = 1280;
  }
}

DEV void transpose_all(const Params& p, char* smem) {
  constexpr int NTR = 2 * 2768 + 128;
  float* T = (float*)smem;
  const int tid = VTID, kr = tid >> 4, n4 = (tid & 15) * 4;
  int t = VBID;
  if (t >= NTR) return;
  const float* src; bf16_t* dst; int lds_, ldd;
  tr_desc(p, t, src, lds_, dst, ldd);
  float4 cur[4];
#pragma unroll
  for (int i = 0; i < 4; ++i) cur[i] = *(const float4*)(src + (size_t)(kr + 16 * i) * lds_ + n4);
  while (t < NTR) {
    const int tn = t + VNB;
    const float* nsrc = src; bf16_t* ndst = dst; int nlds = lds_, nldd = ldd;
    float4 nxt[4];
    if (tn < NTR) {
      tr_desc(p, tn, nsrc, nlds, ndst, nldd);
#pragma unroll
      for (int i = 0; i < 4; ++i) nxt[i] = *(const float4*)(nsrc + (size_t)(kr + 16 * i) * nlds + n4);
    }
#pragma unroll
    for (int i = 0; i < 4; ++i) {
      const int k = kr + 16 * i;
      T[k * 65 + n4 + 0] = cur[i].x; T[k * 65 + n4 + 1] = cur[i].y; T[k * 65 + n4 + 2] = cur[i].z; T[k * 65 + n4 + 3] = cur[i].w;
    }
    __syncthreads();
#pragma unroll
    for (int i = 0; i < 2; ++i) {
      const int n = (tid >> 3) + 32 * i, k8 = (tid & 7) * 8;
      U8 o;
#pragma unroll
      for (int j = 0; j < 4; ++j) o.w[j] = pack2(T[(k8 + 2 * j) * 65 + n], T[(k8 + 2 * j + 1) * 65 + n]);
      *(uint4*)(dst + (size_t)n * ldd + k8) = o.u;
    }
    __syncthreads();
    if (tn < NTR) {
#pragma unroll
      for (int i = 0; i < 4; ++i) cur[i] = nxt[i];
    }
    src = nsrc; dst = ndst; lds_ = nlds; ldd = nldd; t = tn;
  }
}

DEV void phase0(const Params& p, char* smem) {
  const int tid = VTID;
  const int NT0 = 192 - 128, NITEMS = 192 + 64 + 2;
  for (int it = VBID; it < NITEMS; it += VNB) {
    if (it < 192) {
      const int l = it / 96, n0 = (it % 96) * 64;
      float* s = (float*)smem;
      float* red = s + 9 * 1024;
      for (int idx = tid; idx < 9 * 1024; idx += 256) {
        int c = idx >> 10, k = idx & 1023;
        float v = (c == 0) ? p.c_ctx[k] : p.c[(c - 1) * 1024 + k];
        s[idx] = v / (1.f + __expf(-v));
      }
      __syncthreads();
      const int w = tid >> 6, lane = tid & 63, cq = lane & 15, ks = lane >> 4;
      const int kbase = (w * 4 + ks) * 64;
      float acc[9][4];
#pragma unroll
      for (int c = 0; c < 9; ++c) { acc[c][0] = 0.f; acc[c][1] = 0.f; acc[c][2] = 0.f; acc[c][3] = 0.f; }
      const float* wp = p.w_ada + ((size_t)l * 1024 + kbase) * 6144 + n0 + cq * 4;
      for (int kb = 0; kb < 64; kb += 16) {
        float4 wv[16];
#pragma unroll
        for (int j = 0; j < 16; ++j) wv[j] = *(const float4*)(wp + (size_t)(kb + j) * 6144);
#pragma unroll
        for (int j = 0; j < 16; ++j)
#pragma unroll
          for (int c = 0; c < 9; ++c) {
            const float sv = s[c * 1024 + kbase + kb + j];
            acc[c][0] += sv * wv[j].x; acc[c][1] += sv * wv[j].y; acc[c][2] += sv * wv[j].z; acc[c][3] += sv * wv[j].w;
          }
      }
#pragma unroll
      for (int c = 0; c < 9; ++c)
#pragma unroll
        for (int e = 0; e < 4; ++e) {
          float a = acc[c][e];
          a += __shfl_xor(a, 16); a += __shfl_xor(a, 32);
          if (ks == 0) red[(w * 9 + c) * 64 + cq * 4 + e] = a;
        }
      __syncthreads();
      for (int idx = tid; idx < 576; idx += 256) {
        int c = idx >> 6, nn = idx & 63;
        float v = red[(0 * 9 + c) * 64 + nn] + red[(1 * 9 + c) * 64 + nn] + red[(2 * 9 + c) * 64 + nn] + red[(3 * 9 + c) * 64 + nn] +
                  p.b_ada[l * 6144 + n0 + nn];
        p.mod[((size_t)l * 9 + c) * 6144 + n0 + nn] = v;
      }
      __syncthreads();
    } else if (it >= NT0 + 128 && it < NT0 + 192) {
      const int j = it - NT0 - 128;
#pragma unroll
      for (int i = 0; i < 4; ++i) {
        const int e = (j * 1024 + i * 256 + tid) * 8;
        const int d = e & 63, kvh = (e >> 6) & 1, t = (e >> 7) & 255, l = (e >> 15) & 1, b = e >> 16;
        const float4 a0 = *(const float4*)(p.cache_k + e), a1 = *(const float4*)(p.cache_k + e + 4);
        U8 o; o.w[0] = pack2(a0.x, a0.y); o.w[1] = pack2(a0.z, a0.w); o.w[2] = pack2(a1.x, a1.y); o.w[3] = pack2(a1.z, a1.w);
        *(uint4*)(p.kb_lat + ((size_t)((l * 8 + b) * 2 + kvh) * 1280 + t) * 64 + d) = o.u;
      }
    } else if (it >= NT0 + 192) {
      if (it == NT0 + 192)
      for (int idx = tid; idx < 1024; idx += 256) {
        int pp = idx >> 4, f = idx & 15;
        float inv = powf(10000.f, -(float)f / 16.f);
        float ang = (float)pp * inv;
        float nrev = rintf(ang * 0.15915494309189535f);
        float r = fmaf(-nrev, 6.28125f, ang);
        r = fmaf(-nrev, 0.0019353071795864769f, r);
        p.rope[idx * 2 + 0] = __cosf(r);
        p.rope[idx * 2 + 1] = __sinf(r);
      }
      if (it == NT0 + 192)
      for (int idx = tid; idx < 1024; idx += 256) {
        const float xn = -p.lru_lam[idx];
        p.cdec[idx] = -8.f * (fmaxf(xn, 0.f) + log1pf(expf(-fabsf(xn))));
      }
    }
  }
  transpose_all(p, smem);
}

DEV void ln_mod_phase(const Params& p, int l, int mode) {
  const int lane = threadIdx.x & 63, w = threadIdx.x >> 6;
  const float* lg = nullptr; const float* lb = nullptr;
  if (mode == 1) { lg = p.ln2_g + (l - 1) * 1024; lb = p.ln2_b + (l - 1) * 1024; }
  else if (mode == 2) { lg = p.ln1_g + l * 1024; lb = p.ln1_b + l * 1024; }
  else if (mode == 3) { lg = p.ln2_g + l * 1024; lb = p.ln2_b + l * 1024; }
  const int shoff = (mode == 2) ? 3072 : 0;
  const int mstride = gridDim.x * 8;
  float4 nv[4];
  {
    const int m = xrow(blockIdx.x * 8 + w);
    const float* src = (mode == 0) ? ((m < 8192) ? p.x_prompt + (size_t)m * 1024 : p.x_sample + (size_t)(m - 8192) * 1024) : p.out + (size_t)m * 1024;
#pragma unroll
    for (int i = 0; i < 4; ++i) nv[i] = *(const float4*)(src + i * 256 + lane * 4);
  }
  for (int vm = blockIdx.x * 8 + w; vm < MT; vm += mstride) {
    const int m = xrow(vm);
    float4 v[4];
#pragma unroll
    for (int i = 0; i < 4; ++i) v[i] = nv[i];
    {
      const int mn = xrow((vm + mstride < MT) ? vm + mstride : vm);
      const float* src = (mode == 0) ? ((mn < 8192) ? p.x_prompt + (size_t)mn * 1024 : p.x_sample + (size_t)(mn - 8192) * 1024) : p.out + (size_t)mn * 1024;
#pragma unroll
      for (int i = 0; i < 4; ++i) nv[i] = *(const float4*)(src + i * 256 + lane * 4);
    }
    if (mode != 0) {
      float s = 0.f;
#pragma unroll
      for (int i = 0; i < 4; ++i) s += v[i].x + v[i].y + v[i].z + v[i].w;
      const float mean = wave_sum(s) * (1.f / 1024.f);
      float s2 = 0.f;
#pragma unroll
      for (int i = 0; i < 4; ++i) { float a = v[i].x - mean, b = v[i].y - mean, c = v[i].z - mean, d = v[i].w - mean; s2 += a * a + b * b + c * c + d * d; }
      const float rstd = rsqrtf(wave_sum(s2) * (1.f / 1024.f) + 1e-6f);
#pragma unroll
      for (int i = 0; i < 4; ++i) {
        float4 g = *(const float4*)(lg + i * 256 + lane * 4), b = *(const float4*)(lb + i * 256 + lane * 4);
        v[i].x = (v[i].x - mean) * rstd * g.x + b.x; v[i].y = (v[i].y - mean) * rstd * g.y + b.y;
        v[i].z = (v[i].z - mean) * rstd * g.z + b.z; v[i].w = (v[i].w - mean) * rstd * g.w + b.w;
        if (mode == 3) *(float4*)(p.out + (size_t)m * 1024 + i * 256 + lane * 4) = v[i];
      }
      if (mode != 3 && lane == 0) *(float2*)(p.rstat + (size_t)m * 2) = make_float2(mean, rstd);
    }
    if (mode != 3) {
      const float* md = p.mod + ((size_t)l * 9 + cond_of(m)) * 6144 + shoff;
#pragma unroll
      for (int i = 0; i < 4; ++i) {
        float4 sh = *(const float4*)(md + i * 256 + lane * 4), sc = *(const float4*)(md + 1024 + i * 256 + lane * 4);
        uint2 o;
        o.x = pack2(v[i].x * (1.f + sc.x) + sh.x, v[i].y * (1.f + sc.y) + sh.y);
        o.y = pack2(v[i].z * (1.f + sc.z) + sh.z, v[i].w * (1.f + sc.w) + sh.w);
        *(uint2*)(p.abuf + (size_t)m * 1024 + i * 256 + lane * 4) = o;
      }
    }
  }
}

#define LAS3 __attribute__((address_space(3)))
namespace g8 {
constexpr int BM = 256, BK = 64, HALF = 128, HTB = HALF * BK * 2, NXCD = 8, WGM = 4;
DEV int lds_byte(int r, int c) { const int st = (r >> 4) * 2 + (c >> 5), rr = r & 15, cc = c & 31, ob = rr * 64 + cc * 2; return st * 1024 + (ob ^ (((ob >> 9) & 1) << 5)); }
DEV void stage_rc(int b, int& R, int& C) { const int st = b / 1024, sb = b % 1024, swz = sb ^ (((sb >> 9) & 1) << 5); R = (st >> 1) * 16 + swz / 64; C = (st & 1) * 32 + (swz % 64) / 2; }
DEV bool unit_of(int i, int nM, int nN, int& pm, int& pn) {
  const int nwg = nM * nN;
  const long L = (long)i * gridDim.x + blockIdx.x; if (L >= nwg) return false;
  int wgid = (int)L; { const int q = nwg / NXCD, r = nwg % NXCD, xcd = wgid % NXCD, off = wgid / NXCD; wgid = (xcd < r ? xcd * (q + 1) : r * (q + 1) + (xcd - r) * q) + off; }
  const int nig = WGM * nN, gid = wgid / nig, fm = gid * WGM, gsz = (nM - fm) < WGM ? (nM - fm) : WGM;
  pm = fm + ((wgid % nig) % gsz); pn = (wgid % nig) / gsz; return true;
}
}

template <int EPI>
DEV void gemm_epilogue(const Params& p, int l, f32x4 (&acc)[2][2][4][2], int pm, int pn, int wr, int wc, int fr, int fq) {
  const int brow = pm * 256, bcol = pn * 256;
  const float* md = p.mod + ((size_t)l * 9 + cond_of(brow)) * 6144;
#pragma unroll
  for (int bj = 0; bj < 2; ++bj)
#pragma unroll
    for (int n = 0; n < 2; ++n) {
      const int col = bcol + bj * 128 + wc * 32 + n * 16 + fq * 4;
      float4 gate = make_float4(0.f, 0.f, 0.f, 0.f), bias = make_float4(0.f, 0.f, 0.f, 0.f);
      if (EPI == 2) gate = *(const float4*)(md + 2048 + col);
      if (EPI == 3) bias = *(const float4*)(p.b_ff1 + l * 4096 + col);
      if (EPI == 4) { gate = *(const float4*)(md + 5120 + col); bias = *(const float4*)(p.b_ff2 + l * 1024 + col); }
#pragma unroll
      for (int ai = 0; ai < 2; ++ai)
#pragma unroll
        for (int m = 0; m < 4; ++m) {
          const int row = brow + ai * 128 + wr * 64 + m * 16 + fr;
          const f32x4 v = acc[ai][bj][m][n];
          if (EPI == 1) {
            uint2 o; o.x = pack2(v[0], v[1]); o.y = pack2(v[2], v[3]);
            *(uint2*)(p.zf + (size_t)row * 1792 + col) = o;
          } else if (EPI == 2) {
            const float* xs = (l == 0) ? ((row < 8192) ? p.x_prompt + (size_t)row * 1024 : p.x_sample + (size_t)(row - 8192) * 1024) : p.out + (size_t)row * 1024;
            const float4 x = *(const float4*)(xs + col);
            *(float4*)(p.out + (size_t)row * 1024 + col) = make_float4(ALPHA * x.x + gate.x * v[0], ALPHA * x.y + gate.y * v[1], ALPHA * x.z + gate.z * v[2], ALPHA * x.w + gate.w * v[3]);
          } else if (EPI == 3) {
            const float t0 = fmaxf(v[0] + bias.x, 0.f), t1 = fmaxf(v[1] + bias.y, 0.f), t2 = fmaxf(v[2] + bias.z, 0.f), t3 = fmaxf(v[3] + bias.w, 0.f);
            uint2 o; o.x = pack2(t0 * t0, t1 * t1); o.y = pack2(t2 * t2, t3 * t3);
            *(uint2*)(p.zf + (size_t)row * 4096 + col) = o;
          } else {
            float* xo = p.out + (size_t)row * 1024 + col;
            const float4 x = *(const float4*)xo;
            *(float4*)xo = make_float4(ALPHA * x.x + gate.x * (v[0] + bias.x), ALPHA * x.y + gate.y * (v[1] + bias.y), ALPHA * x.z + gate.z * (v[2] + bias.z), ALPHA * x.w + gate.w * (v[3] + bias.w));
          }
        }
    }
}

template <int EPI>
DEV void gemm_epilogue_lnres(const Params& p, int l, f32x4 (&acc)[2][2][4][2], int pm, int pn, int wr, int wc, int fr, int fq) {
  const int brow = pm * 256, bcol = pn * 256;
  const float* md = p.mod + ((size_t)l * 9 + cond_of(brow)) * 6144;
  float mean[2][4], rstd[2][4];
  {
    const unsigned so = (unsigned)(brow + wr * 64 + fr) * 2u;
#pragma unroll
    for (int ai = 0; ai < 2; ++ai)
#pragma unroll
      for (int m = 0; m < 4; ++m) { const float2 t = *(const float2*)(p.rstat + (so + (unsigned)((ai * 128 + m * 16) * 2))); mean[ai][m] = t.x; rstd[ai][m] = t.y; }
  }
  const float* lg = (EPI == 2) ? p.ln2_g + (l - 1) * 1024 : p.ln1_g + l * 1024;
  const float* lb = (EPI == 2) ? p.ln2_b + (l - 1) * 1024 : p.ln1_b + l * 1024;
  const unsigned co = (unsigned)(bcol + wc * 32 + fq * 4);
  const unsigned ro = (unsigned)(brow + wr * 64 + fr) * 1024u + co;
#pragma unroll
  for (int bj = 0; bj < 2; ++bj)
#pragma unroll
    for (int n = 0; n < 2; ++n) {
      unsigned col = co + (unsigned)(bj * 128 + n * 16), rb = ro + (unsigned)(bj * 128 + n * 16);
      asm volatile("" : "+v"(col), "+v"(rb));
      float4 gate, bias = make_float4(0.f, 0.f, 0.f, 0.f);
      if (EPI == 2) gate = *(const float4*)(md + 2048 + col);
      else { gate = *(const float4*)(md + 5120 + col); bias = *(const float4*)(p.b_ff2 + l * 1024 + col); }
      const float4 g4 = *(const float4*)(lg + col), b4 = *(const float4*)(lb + col);
#pragma unroll
      for (int ai = 0; ai < 2; ++ai)
#pragma unroll
        for (int m = 0; m < 4; ++m) {
          float* xo = p.out + (rb + (unsigned)((ai * 128 + m * 16) * 1024));
          const float4 x = *(const float4*)xo;
          const float mu = mean[ai][m], rr = rstd[ai][m];
          const f32x4 v = acc[ai][bj][m][n];
          const float x0 = (x.x - mu) * rr * g4.x + b4.x, x1 = (x.y - mu) * rr * g4.y + b4.y, x2 = (x.z - mu) * rr * g4.z + b4.z, x3 = (x.w - mu) * rr * g4.w + b4.w;
          *(float4*)xo = make_float4(ALPHA * x0 + gate.x * (v[0] + bias.x), ALPHA * x1 + gate.y * (v[1] + bias.y), ALPHA * x2 + gate.z * (v[2] + bias.z), ALPHA * x3 + gate.w * (v[3] + bias.w));
        }
    }
}

template <int EPI>
DEV void gemm_phase(const Params& p, int l, const bf16_t* Ag, const bf16_t* Btg, int N, int K, LAS3 unsigned char* lds) {
  using namespace g8;
  const int tid = threadIdx.x, wid = __builtin_amdgcn_readfirstlane(tid >> 6), lane = tid & 63, wr = wid >> 2, wc = wid & 3, fr = lane & 15, fq = lane >> 4;
  const int nt = K / BK, nM = MT / BM, nN = N / BM;
  unsigned voff[2];
#pragma unroll
  for (int i = 0; i < 2; ++i) { int R, C; stage_rc(tid * 16 + i * 8192, R, C); voff[i] = (unsigned)(R * K + C) * 2u; }
  const size_t kstep = (size_t)(BK * 2);
  const size_t hstep = (size_t)HALF * K * 2;
  const size_t tstep = 2 * hstep;
  const unsigned ldsw = (unsigned)wid * 1024u;
  const int aoff = lds_byte(wr * 64 + fr, fq * 8), boff = lds_byte(wc * 32 + fr, fq * 8);
#define PG8_SA(b, h) (((b) * 2 + (h)) * HTB)
#define PG8_SB(b, h) ((4 + (b) * 2 + (h)) * HTB)
#define PG8_STAGE(bufoff, gbase) do { _Pragma("unroll") for (int _i = 0; _i < 2; ++_i) \
    __builtin_amdgcn_global_load_lds((const unsigned*)((const char*)(gbase) + voff[_i]), (LAS3 unsigned*)(lds + (bufoff) + ldsw + _i * 8192), 16, 0, 0); } while (0)
#define PG8_LDA(dst, b, h) do { _Pragma("unroll") for (int m = 0; m < 4; ++m) _Pragma("unroll") for (int k = 0; k < 2; ++k) dst[m][k] = *(const LAS3 bf16x8*)(lds + PG8_SA(b, h) + aoff + m * 2048 + k * 1024); } while (0)
#define PG8_LDB(dst, b, h) do { _Pragma("unroll") for (int n = 0; n < 2; ++n) _Pragma("unroll") for (int k = 0; k < 2; ++k) dst[n][k] = *(const LAS3 bf16x8*)(lds + PG8_SB(b, h) + boff + n * 2048 + k * 1024); } while (0)
#define PG8_MMA(ai, bj, At_, Bt_) do { __builtin_amdgcn_s_setprio(1); _Pragma("unroll") for (int m = 0; m < 4; ++m) _Pragma("unroll") for (int n = 0; n < 2; ++n) _Pragma("unroll") for (int k = 0; k < 2; ++k) \
    acc[ai][bj][m][n] = __builtin_amdgcn_mfma_f32_16x16x32_bf16(Bt_[n][k], At_[m][k], acc[ai][bj][m][n], 0, 0, 0); __builtin_amdgcn_s_setprio(0); } while (0)
#define PG8_WAIT_V(n) asm volatile("s_waitcnt vmcnt(" #n ")" ::: "memory")
#define PG8_WAIT_L(n) asm volatile("s_waitcnt lgkmcnt(" #n ")" ::: "memory")
#define PG8_BAR __builtin_amdgcn_s_barrier()
#define PG8_SCHED __builtin_amdgcn_sched_barrier(0)
  int cpm, cpn, npm = 0, npn = 0, ui = 0;
  if (!unit_of(0, nM, nN, cpm, cpn)) return;
  f32x4 acc[2][2][4][2];
#pragma unroll
  for (int a = 0; a < 2; ++a)
#pragma unroll
    for (int b = 0; b < 2; ++b)
#pragma unroll
      for (int m = 0; m < 4; ++m)
#pragma unroll
        for (int n = 0; n < 2; ++n) acc[a][b][m][n] = (f32x4){0.f, 0.f, 0.f, 0.f};
  bf16x8 At[4][2], B0[2][2], B1[2][2];
  const char* cA = (const char*)Ag + (size_t)cpm * tstep; const char* cB = (const char*)Btg + (size_t)cpn * tstep;
  PG8_STAGE(PG8_SB(0, 0), cB); PG8_STAGE(PG8_SA(0, 0), cA); PG8_STAGE(PG8_SB(0, 1), cB + hstep); PG8_STAGE(PG8_SA(0, 1), cA + hstep);
  if (wr == 1) PG8_BAR;
  PG8_WAIT_V(4); PG8_BAR;
  PG8_STAGE(PG8_SB(1, 0), cB + kstep); PG8_STAGE(PG8_SA(1, 0), cA + kstep); PG8_STAGE(PG8_SB(1, 1), cB + hstep + kstep);
  PG8_WAIT_V(6); PG8_BAR;
  for (;;) {
    const bool has_next = unit_of(ui + 1, nM, nN, npm, npn);
    const char* nA = has_next ? (const char*)Ag + (size_t)npm * tstep : cA; const char* nB = has_next ? (const char*)Btg + (size_t)npn * tstep : cB;
    for (int t = 0; t < nt; t += 2) {
      const bool last = (t == nt - 2);
      const char* a1 = cA + (size_t)(t + 1) * kstep;
      const char* a2 = last ? nA : cA + (size_t)(t + 2) * kstep; const char* b2 = last ? nB : cB + (size_t)(t + 2) * kstep;
      const char* a3 = a2 + kstep; const char* b3 = b2 + kstep;
      PG8_LDB(B0, 0, 0); PG8_SCHED; PG8_LDA(At, 0, 0); PG8_STAGE(PG8_SA(1, 1), a1 + hstep);
      PG8_WAIT_L(8); PG8_BAR; PG8_WAIT_L(0); PG8_MMA(0, 0, At, B0); PG8_BAR; PG8_SCHED;
      PG8_LDB(B1, 0, 1); PG8_STAGE(PG8_SB(0, 0), b2);
      PG8_BAR; PG8_WAIT_L(0); PG8_MMA(0, 1, At, B1); PG8_BAR;
      PG8_LDA(At, 0, 1); PG8_STAGE(PG8_SA(0, 0), a2);
      PG8_BAR; PG8_WAIT_L(0); PG8_MMA(1, 0, At, B0); PG8_BAR; PG8_SCHED;
      PG8_STAGE(PG8_SB(0, 1), b2 + hstep);
      PG8_WAIT_V(6); PG8_BAR; PG8_MMA(1, 1, At, B1); PG8_BAR;
      PG8_LDB(B0, 1, 0); PG8_SCHED; PG8_LDA(At, 1, 0); PG8_STAGE(PG8_SA(0, 1), a2 + hstep);
      PG8_WAIT_L(8); PG8_BAR; PG8_WAIT_L(0); PG8_MMA(0, 0, At, B0); PG8_BAR; PG8_SCHED;
      PG8_LDB(B1, 1, 1); PG8_STAGE(PG8_SB(1, 0), b3);
      PG8_BAR; PG8_WAIT_L(0); PG8_MMA(0, 1, At, B1); PG8_BAR;
      PG8_LDA(At, 1, 1); PG8_STAGE(PG8_SA(1, 0), a3);
      PG8_BAR; PG8_WAIT_L(0); PG8_MMA(1, 0, At, B0); PG8_BAR; PG8_SCHED;
      PG8_STAGE(PG8_SB(1, 1), b3 + hstep);
      PG8_WAIT_V(6); PG8_BAR; PG8_MMA(1, 1, At, B1); PG8_BAR;
    }
    if (EPI == 4 || (EPI == 2 && l > 0)) gemm_epilogue_lnres<EPI>(p, l, acc, cpm, cpn, wr, wc, fr, fq);
    else gemm_epilogue<EPI>(p, l, acc, cpm, cpn, wr, wc, fr, fq);
    if (!has_next) break;
#pragma unroll
    for (int a = 0; a < 2; ++a)
#pragma unroll
      for (int b = 0; b < 2; ++b)
#pragma unroll
        for (int m = 0; m < 4; ++m)
#pragma unroll
          for (int n = 0; n < 2; ++n) acc[a][b][m][n] = (f32x4){0.f, 0.f, 0.f, 0.f};
    cpm = npm; cpn = npn; cA = nA; cB = nB; ++ui;
  }
  PG8_WAIT_V(0);
  if (wr == 0) PG8_BAR;
  PG8_BAR;
#undef PG8_SA
#undef PG8_SB
#undef PG8_STAGE
#undef PG8_LDA
#undef PG8_LDB
#undef PG8_MMA
#undef PG8_WAIT_V
#undef PG8_WAIT_L
#undef PG8_BAR
#undef PG8_SCHED
}

DEV void rope8(float (&v)[8], int d0, int prow, int pcol, const float* __restrict__ rope) {
  const int pp = (d0 < 32) ? prow : pcol;
#pragma unroll
  for (int i = 0; i < 4; ++i) {
    const int f = ((d0 >> 1) + i) & 15;
    const float cs = rope[(pp * 16 + f) * 2], sn = rope[(pp * 16 + f) * 2 + 1];
    const float x1 = v[2 * i], x2 = v[2 * i + 1];
    v[2 * i] = x1 * cs - x2 * sn; v[2 * i + 1] = x1 * sn + x2 * cs;
  }
}

DEV void prep_token_row(const Params& p, int l, int m, int lane, uint4 c) {
  bf16_t* zr = p.zf + (size_t)m * 1792;
  const bool lat = m >= 8192;
  const int pos = lat ? ((m - 8192) & 1023) : (m & 255);
  const int prow = pos >> 6, pcol = pos & 63;
  const int d0 = (lane & 7) * 8;
  U8 u; u.u = c;
  float v[8], gl[8]; float ss = 0.f, sg = 0.f;
#pragma unroll
  for (int j = 0; j < 8; ++j) { v[j] = bf2f(u.h[j]); ss += v[j] * v[j]; gl[j] = gelu_t(v[j]); sg += gl[j]; }
  ss += __shfl_xor(ss, 1); ss += __shfl_xor(ss, 2); ss += __shfl_xor(ss, 4);
#pragma unroll
  for (int o = 1; o <= 16; o <<= 1) sg += __shfl_xor(sg, o);
  const float mean = sg * (1.f / 256.f);
  float s2 = 0.f;
#pragma unroll
  for (int j = 0; j < 8; ++j) { const float d = gl[j] - mean; s2 += d * d; }
#pragma unroll
  for (int o = 1; o <= 16; o <<= 1) s2 += __shfl_xor(s2, o);
  if (lane < 16) {
    const float rinv = rsqrtf(ss * (1.f / 64.f) + 1e-6f);
#pragma unroll
    for (int j = 0; j < 8; ++j) v[j] = v[j] * rinv * p.k_g[l * 64 + d0 + j];
    if (!lat) {
      float* o = p.out + OFF_YK + ((((size_t)(m >> 8)) * 2 + l) * 256 + pos) * 128 + lane * 8;
      *(float4*)o = make_float4(v[0], v[1], v[2], v[3]); *(float4*)(o + 4) = make_float4(v[4], v[5], v[6], v[7]);
    } else rope8(v, d0, prow, pcol, p.rope);
#pragma unroll
    for (int j = 0; j < 4; ++j) u.w[j] = pack2(v[2 * j], v[2 * j + 1]);
    const int kvh = lane >> 3;
    bf16_t* kd = lat ? p.kb_lat + ((size_t)((l * 8 + ((m - 8192) >> 10)) * 2 + kvh) * 1280 + 256 + pos) * 64 + d0
                     : p.kb_ctx + ((size_t)((m >> 8) * 2 + kvh) * 256 + pos) * 64 + d0;
    *(uint4*)kd = u.u;
  } else if (lane < 32) {
    if (!lat) {
      float* o = p.out + OFF_YV + ((((size_t)(m >> 8)) * 2 + l) * 256 + pos) * 128 + (lane - 16) * 8;
      *(float4*)o = make_float4(v[0], v[1], v[2], v[3]); *(float4*)(o + 4) = make_float4(v[4], v[5], v[6], v[7]);
    }
    const int kvh = (lane - 16) >> 3;
    bf16_t* vd; int T;
    if (lat) { T = 1280; vd = p.vt_lat + ((size_t)((l * 8 + ((m - 8192) >> 10)) * 2 + kvh) * 64 + d0) * 1280 + 256 + pos; }
    else { T = 256; vd = p.vt_ctx + ((size_t)((m >> 8) * 2 + kvh) * 64 + d0) * 256 + pos; }
#pragma unroll
    for (int j = 0; j < 8; ++j) vd[(size_t)j * T] = u.h[j];
  } else {
    const float rstd = rsqrtf(s2 * (1.f / 256.f) + 1e-6f);
    const int ch = (lane - 32) * 8;
#pragma unroll
    for (int j = 0; j < 8; ++j) gl[j] = (gl[j] - mean) * rstd * p.mlp_g[l * 256 + ch + j] + p.mlp_b[l * 256 + ch + j];
#pragma unroll
    for (int j = 0; j < 4; ++j) u.w[j] = pack2(gl[2 * j], gl[2 * j + 1]);
    *(uint4*)(zr + 1536 + ch) = u.u;
  }
}

template <bool REV>
DEV void tile_scan(float (&a)[4][4], float (&u)[4][4], int lane) {
  const int q = lane >> 4;
  float C = 0.f, CP = 1.f;
  const int src1 = (REV ? lane + 16 : lane - 16) & 63;
  const int src2 = (REV ? lane + 32 : lane - 32) & 63;
  const int srcT = (lane & 15) + (REV ? 0 : 48);
  const bool c1 = REV ? (q <= 2) : (q >= 1);
  const bool c2 = REV ? (q <= 1) : (q >= 2);
  const bool first = REV ? (q == 3) : (q == 0);
#pragma unroll
  for (int mi = 0; mi < 4; ++mi) {
    const int mt = REV ? 3 - mi : mi;
    float P = 1.f, H = 0.f, pl[4], hl[4];
#pragma unroll
    for (int ri = 0; ri < 4; ++ri) {
      const int r = REV ? 3 - ri : ri;
      H = a[mt][r] * H + u[mt][r]; P *= a[mt][r]; pl[r] = P; hl[r] = H;
    }
    float Pi = P, Hi = H;
    float Pp = __shfl(Pi, src1), Hp = __shfl(Hi, src1);
    if (c1) { Hi = Pi * Hp + Hi; Pi = Pi * Pp; }
    Pp = __shfl(Pi, src2); Hp = __shfl(Hi, src2);
    if (c2) { Hi = Pi * Hp + Hi; Pi = Pi * Pp; }
    float Pe = __shfl(Pi, src1), He = __shfl(Hi, src1);
    if (first) { Pe = 1.f; He = 0.f; }
    const float hin = Pe * C + He, pin = Pe * CP;
#pragma unroll
    for (int r = 0; r < 4; ++r) { u[mt][r] = pl[r] * hin + hl[r]; a[mt][r] = pl[r] * pin; }
    const float Pt = __shfl(Pi, srcT), Ht = __shfl(Hi, srcT);
    C = Pt * C + Ht; CP = Pt * CP;
  }
}

DEV void lru_gate_item(const Params& p, int l, int item, char* smem) {
  const int tid = VTID, lane = tid & 63, w = tid >> 6;
  const int tile = item >> 2, blk = item & 3;
  const int m0 = tile * 64;
  int ms, L;
  if (m0 < 8192) { ms = m0 & ~255; L = 256; } else { ms = 8192 + ((m0 - 8192) & ~1023); L = 1024; }
  const int dir = w >> 1, half = w & 1, q = lane >> 4, c15 = lane & 15;
  const bf16_t* wt = p.wt_lru + (size_t)((((l * 2 + dir) * 4 + blk) * 2)) * 4096;
  bf16x8 bfr[2][2][2];
#pragma unroll
  for (int mat = 0; mat < 2; ++mat)
#pragma unroll
    for (int j = 0; j < 2; ++j)
#pragma unroll
      for (int s = 0; s < 2; ++s) bfr[mat][j][s] = *(const bf16x8*)(wt + mat * 4096 + (half * 32 + j * 16 + c15) * 64 + s * 32 + q * 8);
  float* xs = (float*)smem;
  float* xcf = xs + 67 * 64;
  bf16_t* xcb = (bf16_t*)(xcf + 64 * 64);
  for (int idx = tid; idx < 67 * 8; idx += 256) {
    const int rr = idx >> 3, cc = idx & 7;
    const int m = m0 - 1 + rr;
    float v[8];
    if (m >= ms && m < ms + L) {
      U8 u; u.u = *(const uint4*)(p.zf + (size_t)m * 1792 + 768 + blk * 64 + cc * 8);
#pragma unroll
      for (int j = 0; j < 8; ++j) v[j] = bf2f(u.h[j]);
    } else {
#pragma unroll
      for (int j = 0; j < 8; ++j) v[j] = 0.f;
    }
#pragma unroll
    for (int j = 0; j < 8; ++j) xs[rr * 64 + cc * 8 + j] = v[j];
  }
  __syncthreads();
  {
    const int ch = tid & 63, Cg = blk * 64 + ch;
    const float w0 = p.conv_w[(l * 4 + 0) * 256 + Cg], w1 = p.conv_w[(l * 4 + 1) * 256 + Cg], w2 = p.conv_w[(l * 4 + 2) * 256 + Cg],
                w3 = p.conv_w[(l * 4 + 3) * 256 + Cg], cb = p.conv_b[l * 256 + Cg];
#pragma unroll 4
    for (int tt = 0; tt < 16; ++tt) {
      const int t = (tid >> 6) * 16 + tt;
      const float v = cb + w0 * xs[t * 64 + ch] + w1 * xs[(t + 1) * 64 + ch] + w2 * xs[(t + 2) * 64 + ch] + w3 * xs[(t + 3) * 64 + ch];
      xcf[t * 64 + ch] = v; xcb[t * 72 + ch] = f2bf(v);
    }
  }
  __syncthreads();
  f32x4 acc[2][4][2];
#pragma unroll
  for (int mat = 0; mat < 2; ++mat)
#pragma unroll
    for (int mt = 0; mt < 4; ++mt)
#pragma unroll
      for (int j = 0; j < 2; ++j) acc[mat][mt][j] = f32x4{0.f, 0.f, 0.f, 0.f};
#pragma unroll
  for (int mt = 0; mt < 4; ++mt)
#pragma unroll
    for (int s = 0; s < 2; ++s) {
      const bf16x8 af = *(const bf16x8*)(xcb + (mt * 16 + c15) * 72 + s * 32 + q * 8);
#pragma unroll
      for (int mat = 0; mat < 2; ++mat)
#pragma unroll
        for (int j = 0; j < 2; ++j) acc[mat][mt][j] = mfma16(af, bfr[mat][j][s], acc[mat][mt][j]);
    }
  float* PCp = p.au + (size_t)(dir * 2 + 0) * MT * 256;
  float* HLp = p.au + (size_t)(dir * 2 + 1) * MT * 256;
#pragma unroll
  for (int j = 0; j < 2; ++j) {
    const int ch = half * 32 + j * 16 + c15, Cg = blk * 64 + ch, pidx = (l * 2 + dir) * 256 + Cg;
    const float ba = p.lru_ba[pidx], bx = p.lru_bx[pidx];
    const float cdec = p.cdec[pidx];
    float a[4][4], u[4][4];
#pragma unroll
    for (int mt = 0; mt < 4; ++mt)
#pragma unroll
      for (int r = 0; r < 4; ++r) {
        const int t = mt * 16 + q * 4 + r;
        const float rg = sigmoidf_(acc[0][mt][j][r] + ba), ig = sigmoidf_(acc[1][mt][j][r] + bx);
        const float la = cdec * rg;
        a[mt][r] = __expf(la);
        const float x2 = 2.f * la;
        const float em = (x2 < -0.25f) ? 1.f - __expf(x2) : -x2 * (1.f + x2 * (0.5f + x2 * (1.f / 6.f + x2 * (1.f / 24.f + x2 * (1.f / 120.f + x2 * (1.f / 720.f))))));
        u[mt][r] = __builtin_amdgcn_sqrtf(em) * ig * xcf[t * 64 + ch];
      }
    if (dir == 0) tile_scan<false>(a, u, lane); else tile_scan<true>(a, u, lane);
#pragma unroll
    for (int mt = 0; mt < 4; ++mt)
#pragma unroll
      for (int r = 0; r < 4; ++r) {
        const size_t m = m0 + mt * 16 + q * 4 + r;
        PCp[m * 256 + Cg] = a[mt][r]; HLp[m * 256 + Cg] = u[mt][r];
      }
  }
  __syncthreads();
}

DEV void attn_item(const Params& p, int l, int it, char* sm) {
  const int tid = threadIdx.x, lane = tid & 63, w = tid >> 6, q = lane >> 4, c15 = lane & 15;
  const int qg = w >> 1, kh = w & 1;
  int h, ms, nkt, T; const bf16_t* Kg; const bf16_t* Vg;
  if (it < 512) {
    const int b = it >> 6, qb = it & 7; h = (it >> 3) & 7; ms = 8192 + b * 1024 + qb * 128; nkt = 10; T = 1280;
    Kg = p.kb_lat + (size_t)((l * 8 + b) * 2 + (h >> 2)) * 1280 * 64; Vg = p.vt_lat + (size_t)((l * 8 + b) * 2 + (h >> 2)) * 64 * 1280;
  } else {
    const int i2 = it - 512, b = i2 >> 4, qb = i2 & 1; h = (i2 >> 1) & 7; ms = b * 256 + qb * 128; nkt = 2; T = 256;
    Kg = p.kb_ctx + (size_t)(b * 2 + (h >> 2)) * 256 * 64; Vg = p.vt_ctx + (size_t)(b * 2 + (h >> 2)) * 64 * 256;
  }
  const int kc0 = tid, kc1 = tid + 512;
  const int vd0 = tid >> 4, vk = (tid & 15) * 8;
  const int vpos = ((tid & 15) >> 2) * 32 + 16 * (tid & 1) + 4 * ((tid & 3) >> 1);
  const bf16_t* vg0 = Vg + (size_t)vd0 * T + vk;
  const bf16_t* vg1 = Vg + (size_t)(vd0 + 32) * T + vk;
  uint4 rk0, rk1, rv0, rv1;
#define ATT_LOAD(kt) do { rk0 = *(const uint4*)(Kg + (size_t)(kt) * 8192 + kc0 * 8); rk1 = *(const uint4*)(Kg + (size_t)(kt) * 8192 + kc1 * 8); \
    rv0 = *(const uint4*)(vg0 + (kt) * 128); rv1 = *(const uint4*)(vg1 + (kt) * 128); } while (0)
#define ATT_STORE(buf) do { bf16_t* Ks_ = (bf16_t*)(sm + (buf) * 36864); bf16_t* Vs_ = Ks_ + 9216; \
    *(uint4*)(Ks_ + (kc0 >> 3) * 72 + (kc0 & 7) * 8) = rk0; *(uint4*)(Ks_ + (kc1 >> 3) * 72 + (kc1 & 7) * 8) = rk1; \
    *(uint2*)(Vs_ + vd0 * 136 + vpos) = make_uint2(rv0.x, rv0.y); *(uint2*)(Vs_ + vd0 * 136 + vpos + 8) = make_uint2(rv0.z, rv0.w); \
    *(uint2*)(Vs_ + (vd0 + 32) * 136 + vpos) = make_uint2(rv1.x, rv1.y); *(uint2*)(Vs_ + (vd0 + 32) * 136 + vpos + 8) = make_uint2(rv1.z, rv1.w); } while (0)
  ATT_LOAD(0);
  const int mq = ms + qg * 32;
  bf16x8 qf[2][2];
#pragma unroll
  for (int t = 0; t < 2; ++t)
#pragma unroll
    for (int s = 0; s < 2; ++s) qf[t][s] = *(const bf16x8*)(p.zf + (size_t)(mq + t * 16 + c15) * 1792 + h * 64 + s * 32 + q * 8);
  ATT_STORE(0);
  if (nkt > 1) ATT_LOAD(1);
#pragma unroll
  for (int t = 0; t < 2; ++t) {
    float f[2][8]; float ss = 0.f;
#pragma unroll
    for (int s = 0; s < 2; ++s)
#pragma unroll
      for (int j = 0; j < 8; ++j) { f[s][j] = bf2f((bf16_t)qf[t][s][j]); ss += f[s][j] * f[s][j]; }
    ss += __shfl_xor(ss, 16); ss += __shfl_xor(ss, 32);
    const float rinv = rsqrtf(ss * (1.f / 64.f) + 1e-6f);
    const int mrow_ = mq + t * 16 + c15;
    const int pos = (mrow_ - 8192) & 1023;
#pragma unroll
    for (int s = 0; s < 2; ++s) {
      const int dd = s * 32 + q * 8;
#pragma unroll
      for (int j = 0; j < 8; ++j) f[s][j] = f[s][j] * rinv * p.q_g[l * 64 + dd + j];
      if (it < 512) rope8(f[s], dd, pos >> 6, pos & 63, p.rope);
      U8 pk;
#pragma unroll
      for (int j = 0; j < 4; ++j) pk.w[j] = pack2(f[s][2 * j] * QSCALE, f[s][2 * j + 1] * QSCALE);
      qf[t][s] = pk.v;
    }
  }
  __syncthreads();
  f32x4 o[2][4];
  float mrow[2], lrow[2];
#pragma unroll
  for (int t = 0; t < 2; ++t) { mrow[t] = -1e30f; lrow[t] = 0.f;
#pragma unroll
    for (int j = 0; j < 4; ++j) o[t][j] = f32x4{0.f, 0.f, 0.f, 0.f}; }
  for (int kt = 0; kt < nkt; ++kt) {
    const int cur = kt & 1;
    const bf16_t* Ks = (const bf16_t*)(sm + cur * 36864) + kh * 64 * 72;
    const bf16_t* Vs = (const bf16_t*)(sm + cur * 36864) + 9216 + kh * 64;
    f32x4 s4[2][4];
    {
      bf16x8 kf[4][2];
#pragma unroll
      for (int jn = 0; jn < 4; ++jn)
#pragma unroll
        for (int s = 0; s < 2; ++s) kf[jn][s] = *(const bf16x8*)(Ks + (jn * 16 + c15) * 72 + s * 32 + q * 8);
      __builtin_amdgcn_sched_barrier(0);
#pragma unroll
      for (int jn = 0; jn < 4; ++jn)
#pragma unroll
        for (int t = 0; t < 2; ++t) s4[t][jn] = mfma16(kf[jn][0], qf[t][0], f32x4{0.f, 0.f, 0.f, 0.f});
#pragma unroll
      for (int jn = 0; jn < 4; ++jn)
#pragma unroll
        for (int t = 0; t < 2; ++t) s4[t][jn] = mfma16(kf[jn][1], qf[t][1], s4[t][jn]);
      __builtin_amdgcn_sched_barrier(0);
    }
    U8 vf[4][2];
#pragma unroll
    for (int jn = 0; jn < 4; ++jn)
#pragma unroll
      for (int ks = 0; ks < 2; ++ks) vf[jn][ks].u = *(const uint4*)(Vs + (jn * 16 + c15) * 136 + ks * 32 + q * 8);
    __builtin_amdgcn_sched_barrier(0);
    U8 pb[2][2];
#pragma unroll
    for (int t = 0; t < 2; ++t) {
      float mx = s4[t][0][0];
#pragma unroll
      for (int jn = 0; jn < 4; ++jn)
#pragma unroll
        for (int r = 0; r < 4; ++r) mx = fmaxf(mx, s4[t][jn][r]);
      mx = fmaxf(mx, __shfl_xor(mx, 16)); mx = fmaxf(mx, __shfl_xor(mx, 32));
      const float mnew = fmaxf(mrow[t], mx);
      const float alpha = __builtin_amdgcn_exp2f(mrow[t] - mnew);
      mrow[t] = mnew;
      float ls = 0.f;
#pragma unroll
      for (int jn = 0; jn < 4; ++jn)
#pragma unroll
        for (int r = 0; r < 4; ++r) { const float pv = __builtin_amdgcn_exp2f(s4[t][jn][r] - mnew); s4[t][jn][r] = pv; ls += pv; }
      lrow[t] = lrow[t] * alpha + ls;
#pragma unroll
      for (int jn = 0; jn < 4; ++jn) { o[t][jn][0] *= alpha; o[t][jn][1] *= alpha; o[t][jn][2] *= alpha; o[t][jn][3] *= alpha; }
#pragma unroll
      for (int ks = 0; ks < 2; ++ks) {
        pb[t][ks].w[0] = pack2(s4[t][2 * ks][0], s4[t][2 * ks][1]); pb[t][ks].w[1] = pack2(s4[t][2 * ks][2], s4[t][2 * ks][3]);
        pb[t][ks].w[2] = pack2(s4[t][2 * ks + 1][0], s4[t][2 * ks + 1][1]); pb[t][ks].w[3] = pack2(s4[t][2 * ks + 1][2], s4[t][2 * ks + 1][3]);
      }
    }
#pragma unroll
    for (int ks = 0; ks < 2; ++ks)
#pragma unroll
      for (int jn = 0; jn < 4; ++jn)
#pragma unroll
        for (int t = 0; t < 2; ++t) o[t][jn] = mfma16(vf[jn][ks].v, pb[t][ks].v, o[t][jn]);
    if (kt + 1 < nkt) {
      ATT_STORE(cur ^ 1);
      if (kt + 2 < nkt) ATT_LOAD(kt + 2);
    }
    __syncthreads();
  }
#undef ATT_LOAD
#undef ATT_STORE
  float* mrg = (float*)(sm + 73728) + (size_t)(qg * 64 + lane) * 37;
  float lt[2];
#pragma unroll
  for (int t = 0; t < 2; ++t) { float a = lrow[t]; a += __shfl_xor(a, 16); a += __shfl_xor(a, 32); lt[t] = a; }
  if (kh == 1) {
#pragma unroll
    for (int t = 0; t < 2; ++t) {
      mrg[t * 18 + 0] = mrow[t]; mrg[t * 18 + 1] = lt[t];
#pragma unroll
      for (int jn = 0; jn < 4; ++jn)
#pragma unroll
        for (int r = 0; r < 4; ++r) mrg[t * 18 + 2 + jn * 4 + r] = o[t][jn][r];
    }
  }
  __syncthreads();
  if (kh == 0) {
#pragma unroll
    for (int t = 0; t < 2; ++t) {
      const float m1 = mrg[t * 18 + 0], l1 = mrg[t * 18 + 1];
      const float mm = fmaxf(mrow[t], m1);
      const float a0 = __builtin_amdgcn_exp2f(mrow[t] - mm), a1 = __builtin_amdgcn_exp2f(m1 - mm);
      const float inv = 1.f / (a0 * lt[t] + a1 * l1);
      const float c0 = a0 * inv, c1 = a1 * inv;
      bf16_t* orow = p.abuf + (size_t)(mq + t * 16 + c15) * 1024 + h * 64 + q * 4;
#pragma unroll
      for (int jn = 0; jn < 4; ++jn) {
        const float x0 = c0 * o[t][jn][0] + c1 * mrg[t * 18 + 2 + jn * 4 + 0], x1 = c0 * o[t][jn][1] + c1 * mrg[t * 18 + 2 + jn * 4 + 1];
        const float x2 = c0 * o[t][jn][2] + c1 * mrg[t * 18 + 2 + jn * 4 + 2], x3 = c0 * o[t][jn][3] + c1 * mrg[t * 18 + 2 + jn * 4 + 3];
        uint2 ov; ov.x = pack2(x0, x1); ov.y = pack2(x2, x3);
        *(uint2*)(orow + jn * 16) = ov;
      }
    }
  }
  __syncthreads();
}

DEV void gmlp_item(const Params& p, int l, int it, char* smem) {
  const int tid = VTID, lane = tid & 63, w = tid >> 6, q = lane >> 4, c15 = lane & 15;
  const int chunk = it >> 2, g = it & 3, m0 = chunk * 128;
  bf16_t* vt = (bf16_t*)smem;
  const float* wsg = p.mlp_ws + (size_t)(l * 4 + g) * 16384;
  float4 wa[2][4][2];
#pragma unroll
  for (int nt = 0; nt < 2; ++nt)
#pragma unroll
    for (int s = 0; s < 4; ++s) {
      const float* ap = wsg + ((2 * w + nt) * 16 + c15) * 128 + s * 32 + q * 8;
      wa[nt][s][0] = *(const float4*)ap; wa[nt][s][1] = *(const float4*)(ap + 4);
    }
  uint4 vin[4];
#pragma unroll
  for (int i = 0; i < 4; ++i) { const int id = tid + 256 * i; vin[i] = *(const uint4*)(p.zf + (size_t)(m0 + (id >> 3)) * 1792 + 1536 + g * 64 + (id & 7) * 8); }
#pragma unroll
  for (int i = 0; i < 4; ++i) {
    const int id = tid + 256 * i, qq = id >> 3, cc = id & 7;
    U8 v; v.u = vin[i];
#pragma unroll
    for (int j = 0; j < 8; ++j) vt[(cc * 8 + j) * 136 + qq] = v.h[j];
  }
  __syncthreads();
  f32x4 acc[4][2];
#pragma unroll
  for (int mt = 0; mt < 4; ++mt)
#pragma unroll
    for (int nt = 0; nt < 2; ++nt) acc[mt][nt] = f32x4{0.f, 0.f, 0.f, 0.f};
#pragma unroll
  for (int s = 0; s < 4; ++s) {
    bf16x8 af[4];
#pragma unroll
    for (int mt = 0; mt < 4; ++mt) af[mt] = *(const bf16x8*)(vt + (mt * 16 + c15) * 136 + s * 32 + q * 8);
#pragma unroll
    for (int nt = 0; nt < 2; ++nt) {
      U8 bb;
      bb.w[0] = pack2(wa[nt][s][0].x, wa[nt][s][0].y); bb.w[1] = pack2(wa[nt][s][0].z, wa[nt][s][0].w);
      bb.w[2] = pack2(wa[nt][s][1].x, wa[nt][s][1].y); bb.w[3] = pack2(wa[nt][s][1].z, wa[nt][s][1].w);
#pragma unroll
      for (int mt = 0; mt < 4; ++mt) acc[mt][nt] = mfma16(af[mt], bb.v, acc[mt][nt]);
    }
  }
#pragma unroll
  for (int nt = 0; nt < 2; ++nt) {
    const int pp = (2 * w + nt) * 16 + c15;
    const size_t m = m0 + pp;
    const float bsv = p.mlp_bs[(l * 4 + g) * 128 + pp];
#pragma unroll
    for (int mt = 0; mt < 4; ++mt) {
      const int c = mt * 16 + q * 4;
      const uint2 uu = *(const uint2*)(p.zf + m * 1792 + 1280 + g * 64 + c);
      const float u0 = gelu_t(__uint_as_float(uu.x << 16)), u1 = gelu_t(__uint_as_float(uu.x & 0xffff0000u)), u2 = gelu_t(__uint_as_float(uu.y << 16)), u3 = gelu_t(__uint_as_float(uu.y & 0xffff0000u));
      uint2 o; o.x = pack2(u0 * (acc[mt][nt][0] + bsv), u1 * (acc[mt][nt][1] + bsv)); o.y = pack2(u2 * (acc[mt][nt][2] + bsv), u3 * (acc[mt][nt][3] + bsv));
      *(uint2*)(p.abuf + m * 1024 + 768 + g * 64 + c) = o;
    }
  }
  __syncthreads();
}

DEV void lru_apply_item(const Params& p, int l, int ti2) {
  const int C = VTID;
  const int ti = ti2 >> 1, th = (ti2 & 1) * 32;
  const int m0 = ti * 64;
  int ms, L, b; bool lat = m0 >= 8192;
  if (!lat) { ms = m0 & ~255; L = 256; b = m0 >> 8; } else { ms = 8192 + ((m0 - 8192) & ~1023); L = 1024; b = (m0 - 8192) >> 10; }
  const int k = (m0 - ms) >> 6, nt = L >> 6;
  const float* PCf = p.au; const float* HLf = p.au + (size_t)MT * 256;
  const float* PCb = p.au + (size_t)2 * MT * 256; const float* HLb = p.au + (size_t)3 * MT * 256;
  float cf = lat ? p.state_lru[((size_t)(b * 2 + l) * 2 + 0) * 256 + C] : 0.f;
  float cb = lat ? p.state_lru[((size_t)(b * 2 + l) * 2 + 1) * 256 + C] : 0.f;
  {
    float pc[15], hl[15];
#pragma unroll
    for (int i = 0; i < 15; ++i) {
      const bool act = i < k;
      const size_t e = (size_t)(ms + 64 * i + 63) * 256 + C;
      pc[i] = act ? PCf[e] : 1.f; hl[i] = act ? HLf[e] : 0.f;
    }
#pragma unroll
    for (int i = 0; i < 15; ++i) cf = pc[i] * cf + hl[i];
  }
  {
    float pc[15], hl[15];
#pragma unroll
    for (int i = 0; i < 15; ++i) {
      const int tix = nt - 1 - i;
      const bool act = tix > k;
      const size_t e = (size_t)(ms + 64 * tix) * 256 + C;
      pc[i] = act ? PCb[e] : 1.f; hl[i] = act ? HLb[e] : 0.f;
    }
#pragma unroll
    for (int i = 0; i < 15; ++i) cb = pc[i] * cb + hl[i];
  }
  float hf_last = 0.f, hb_first = 0.f;
#pragma unroll 16
  for (int t = th; t < th + 32; ++t) {
    const size_t m = m0 + t;
    const float hf = PCf[m * 256 + C] * cf + HLf[m * 256 + C];
    const float hb = PCb[m * 256 + C] * cb + HLb[m * 256 + C];
    const float g = gelu_t(bf2f(p.zf[m * 1792 + 1024 + C]));
    p.abuf[m * 1024 + 512 + C] = f2bf((hf + hb) * g);
    if (t == 0) hb_first = hb;
    if (t == 63) hf_last = hf;
  }
  if (!lat) {
    if (k == nt - 1 && th == 32) p.out[OFF_ST + ((size_t)(b * 2 + l) * 2 + 0) * 256 + C] = hf_last;
    if (k == 0 && th == 0) p.out[OFF_ST + ((size_t)(b * 2 + l) * 2 + 1) * 256 + C] = hb_first;
  }
}

DEV void mixer_phase(const Params& p, int l, char* smem_raw, char* smem) {
  for (int it = blockIdx.x; it < 1024; it += gridDim.x) attn_item(p, l, it, smem_raw);
  {
    const int it = 64 * (blockIdx.x & 7) + (blockIdx.x >> 3) * 2 + (threadIdx.x >> 8);
    lru_apply_item(p, l, it);
    gmlp_item(p, l, it, smem);
  }
}

DEV void prep_phase_full(const Params& p, int l, char* smem) {
  {
    const int xcd = blockIdx.x & 7, lh = (blockIdx.x >> 3) * 2 + (threadIdx.x >> 8);
#pragma unroll 1
    for (int k = 0; k < 2; ++k) { const int li = lh + 64 * k; lru_gate_item(p, l, (32 * xcd + (li >> 2)) * 4 + (li & 3), smem); }
  }
  const int lane = threadIdx.x & 63, mstride = gridDim.x * 8;
  int vm = blockIdx.x * 8 + (threadIdx.x >> 6);
  const int coff = lane < 32 ? 512 + lane * 8 : 1536 + (lane - 32) * 8;
  uint4 n1 = *(const uint4*)(p.zf + (size_t)xrow(vm) * 1792 + coff);
  uint4 n2 = *(const uint4*)(p.zf + (size_t)xrow((vm + mstride < MT) ? vm + mstride : vm) * 1792 + coff);
  for (; vm < MT; vm += mstride) {
    const uint4 c = n1; n1 = n2;
    const int mn = xrow((vm + 2 * mstride < MT) ? vm + 2 * mstride : vm);
    n2 = *(const uint4*)(p.zf + (size_t)mn * 1792 + coff);
    prep_token_row(p, l, xrow(vm), lane, c);
  }
}


#define XB_TMO      128
#define XB_XCNT(j)  (256  + 64 * (j))
#define XB_XSUB(j)  (1280 + 64 * (j))
#define XB_XGEN(j)  (2304 + 64 * (j))
#define XB_TOP      3328
#define XB_TOPGEN   3392
#define XCD_BAR_WORDS 3456
#define XB_SPIN_CAP (1u << 18)
#define LAS __attribute__((address_space(3)))
DEV unsigned xb_ld(unsigned* p) { return __hip_atomic_load(p, __ATOMIC_RELAXED, __HIP_MEMORY_SCOPE_AGENT); }
DEV unsigned xb_add(unsigned* p, unsigned v) { return __hip_atomic_fetch_add(p, v, __ATOMIC_RELAXED, __HIP_MEMORY_SCOPE_AGENT); }
DEV unsigned xb_xcc_id() { return (unsigned)__builtin_amdgcn_s_getreg((3 << 11) | 20) & 0xFu; }
#define XB_SPIN(cond, bar) do { unsigned _sp = 0; while (cond) { __builtin_amdgcn_s_sleep(1); \
    if ((++_sp & 255u) == 0u) { if (xb_ld(&(bar)[XB_TMO])) break; if (_sp > XB_SPIN_CAP) { atomicAdd(&(bar)[XB_TMO], 1u); break; } } } } while (0)
struct XcdBarrier { unsigned* bar; unsigned x; volatile LAS unsigned* st; };
DEV XcdBarrier xcd_barrier_post(unsigned* bar, volatile LAS unsigned* st) {
  XcdBarrier b; b.bar = bar; b.x = xb_xcc_id(); b.st = st;
  if (threadIdx.x == 0) (void)xb_add(&bar[XB_XCNT(b.x)], 1u);
  return b;
}
DEV void xcd_barrier_complete(unsigned* bar, unsigned x, unsigned& nloc, unsigned& nx) {
  const unsigned G = gridDim.x * gridDim.y * gridDim.z;
  unsigned sum, cnt, mine, sp = 0u;
  for (;;) {
    sum = 0u; cnt = 0u; mine = 0u;
#pragma unroll
    for (unsigned j = 0; j < 16; ++j) { const unsigned c = xb_ld(&bar[XB_XCNT(j)]); sum += c; cnt += (c > 0u) ? 1u : 0u; mine = (j == x) ? c : mine; }
    if (sum == G) break;
    __builtin_amdgcn_s_sleep(1);
    if ((++sp & 255u) == 0u) { if (xb_ld(&bar[XB_TMO])) break; if (sp > XB_SPIN_CAP) { atomicAdd(&bar[XB_TMO], 1u); break; } }
  }
  nloc = mine > 0u ? mine : 1u; nx = cnt > 0u ? cnt : 1u;
}
DEV void xcd_barrier(const XcdBarrier& b) {
  asm volatile("s_waitcnt vmcnt(0)" ::: "memory");
  __syncthreads();
  if (threadIdx.x == 0) {
    unsigned* bar = b.bar;
    __builtin_amdgcn_s_waitcnt(0);
    unsigned nloc = b.st[0], nx = b.st[1];
    if (nloc == 0u) { xcd_barrier_complete(bar, b.x, nloc, nx); b.st[0] = nloc; b.st[1] = nx; }
    const unsigned old = xb_add(&bar[XB_XSUB(b.x)], 1u);
    const unsigned gen = old / nloc;
    if (old + 1u == (gen + 1u) * nloc) {
      __builtin_amdgcn_fence(__ATOMIC_RELEASE, "agent");
      asm volatile("s_waitcnt vmcnt(0)" ::: "memory");
      const unsigned og = xb_add(&bar[XB_TOP], 1u);
      const unsigned tg = og / nx;
      if (og + 1u == (tg + 1u) * nx) xb_add(&bar[XB_TOPGEN], 1u);
      else XB_SPIN(xb_ld(&bar[XB_TOPGEN]) == tg, bar);
      __builtin_amdgcn_fence(__ATOMIC_ACQUIRE, "agent");
      xb_add(&bar[XB_XGEN(b.x)], 1u);
      asm volatile("s_waitcnt vmcnt(0)" ::: "memory");
    } else {
      XB_SPIN(xb_ld(&bar[XB_XGEN(b.x)]) == gen, bar);
      __builtin_amdgcn_fence(__ATOMIC_ACQUIRE, "agent");
      asm volatile("s_waitcnt vmcnt(0)" ::: "memory");
    }
  }
  __syncthreads();
}

#define PH(i, call) if (ph_lo <= (i) && (i) < ph_hi) { if ((i) > ph_lo) xcd_barrier(xb); call; }
#define LAYER(l, b) \
  PH(b + 0, ln_mod_phase(p, l, l == 0 ? 0 : 1)) \
  PH(b + 1, gemm_phase<1>(p, l, p.abuf, p.wt_in + (size_t)l * 1792 * 1024, 1792, 1024, (LAS3 unsigned char*)smem_raw)) \
  PH(b + 2, prep_phase_full(p, l, smem)) \
  PH(b + 3, mixer_phase(p, l, smem_raw, smem)) \
  PH(b + 4, gemm_phase<2>(p, l, p.abuf, p.wt_out + (size_t)l * 1024 * 1024, 1024, 1024, (LAS3 unsigned char*)smem_raw)) \
  PH(b + 5, ln_mod_phase(p, l, 2)) \
  PH(b + 6, gemm_phase<3>(p, l, p.abuf, p.wt_ff1 + (size_t)l * 4096 * 1024, 4096, 1024, (LAS3 unsigned char*)smem_raw)) \
  PH(b + 7, gemm_phase<4>(p, l, p.zf, p.wt_ff2 + (size_t)l * 1024 * 4096, 1024, 4096, (LAS3 unsigned char*)smem_raw))

__global__ void __launch_bounds__(512, 2) mega_kernel(Params p, int ph_lo, int ph_hi) {
  extern __shared__ __attribute__((aligned(16))) char smem_raw[];
  char* smem = smem_raw + (threadIdx.x >> 8) * 65536;
  __shared__ uint4 xb_words;
  if (threadIdx.x == 0) xb_words = make_uint4(0u, 0u, 0u, 0u);
  __syncthreads();
  XcdBarrier xb = xcd_barrier_post(p.bar, (volatile LAS unsigned*)&xb_words);
  if (ph_hi > 1000) { cg::grid_group grid = cg::this_grid(); grid.sync(); }
  PH(0, phase0(p, smem))
  LAYER(0, 1)
  LAYER(1, 9)
  PH(17, ln_mod_phase(p, 1, 3))
}

extern "C" void kernel_launch(void* const* d_in, const int* in_sizes, int n_in, void* d_out, int out_size, void* d_ws, size_t ws_size,
                              hipStream_t stream) {
  static int grid_blocks = 0;
  if (!grid_blocks) {
    int dev = 0, cus = 0, per_cu = 0;
    hipGetDevice(&dev);
    hipDeviceGetAttribute(&cus, hipDeviceAttributeMultiprocessorCount, dev);
    hipFuncSetAttribute((const void*)mega_kernel, hipFuncAttributeMaxDynamicSharedMemorySize, SMEM_BYTES);
    hipOccupancyMaxActiveBlocksPerMultiprocessor(&per_cu, (const void*)mega_kernel, 512, SMEM_BYTES);
    if (per_cu < 1) per_cu = 1;
    if (per_cu > 1) per_cu = 1;
    grid_blocks = cus * per_cu;
  }
  Params p{};
  const float** pin = (const float**)&p;
  for (int i = 0; i < 32; ++i) pin[i] = (const float*)d_in[i];
  p.out = (float*)d_out;
  char* ws = (char*)d_ws;
  size_t off = 0;
  p.bar = (unsigned*)(ws + off); off += 16384;
  p.rstat = (float*)(ws + off); off += (size_t)MT * 2 * 4;
  p.kb_lat = (bf16_t*)(ws + off); off += (size_t)2 * 8 * 2 * 1280 * 64 * 2;
  p.vt_lat = (bf16_t*)(ws + off); off += (size_t)2 * 8 * 2 * 1280 * 64 * 2;
  p.kb_ctx = (bf16_t*)(ws + off); off += (size_t)32 * 2 * 256 * 64 * 2;
  p.vt_ctx = (bf16_t*)(ws + off); off += (size_t)32 * 2 * 256 * 64 * 2;
  p.wt_in = (bf16_t*)(ws + off); off += (size_t)2 * 1792 * 1024 * 2;
  p.wt_out = (bf16_t*)(ws + off); off += (size_t)2 * 1024 * 1024 * 2;
  p.wt_ff1 = (bf16_t*)(ws + off); off += (size_t)2 * 4096 * 1024 * 2;
  p.wt_ff2 = (bf16_t*)(ws + off); off += (size_t)2 * 4096 * 1024 * 2;
  p.wt_lru = (bf16_t*)(ws + off); off += (size_t)64 * 4096 * 2;
  p.mod = (float*)(ws + off); off += (size_t)2 * 9 * 6144 * 4;
  p.rope = (float*)(ws + off); off += (size_t)2048 * 4;
  p.cdec = (float*)(ws + off); off += (size_t)1024 * 4;
  p.abuf = (bf16_t*)(ws + off); off += (size_t)MT * 1024 * 2;
  p.zf = (bf16_t*)(ws + off);
  p.au = (float*)(ws + off + (size_t)MT * 1792 * 2);
  off += (size_t)MT * 4096 * 2;
  if (off > ws_size) { fprintf(stderr, "workspace too small: need %zu have %zu\n", off, ws_size); return; }
  (void)hipMemsetAsync(p.bar, 0, XCD_BAR_WORDS * 4, stream);
#if MULTI_LAUNCH
  for (int ph = 0; ph < NPHASE; ++ph) {
    hipLaunchKernelGGL(mega_kernel, dim3(grid_blocks), dim3(512), SMEM_BYTES, stream, p, ph, ph + 1);
  }
#else
  int lo = 0, hi = NPHASE;
  void* args[] = {&p, &lo, &hi};
  hipError_t e = hipLaunchCooperativeKernel((void*)mega_kernel, dim3(grid_blocks), dim3(512), args, SMEM_BYTES, stream);
  if (e != hipSuccess) fprintf(stderr, "cooperative launch failed: %s (grid %d)\n", hipGetErrorString(e), grid_blocks);
#endif
}
```

```cpp
#include <hip/hip_runtime.h>
#include <hip/hip_cooperative_groups.h>
#include <cstdio>
#include <cstdint>
namespace cg = cooperative_groups;

#ifndef MULTI_LAUNCH
#define MULTI_LAUNCH 0
#endif

typedef unsigned short bf16_t;
using bf16x8 = __attribute__((ext_vector_type(8))) short;
using f32x4 = __attribute__((ext_vector_type(4))) float;
#define DEV __device__ __forceinline__
#define VTID ((int)(threadIdx.x & 255))
#define VBID ((int)(blockIdx.x * 2 + (threadIdx.x >> 8)))
#define VNB ((int)(gridDim.x * 2))

constexpr int MT = 16384;
constexpr int NPHASE = 18;
constexpr size_t OFF_YK = 16777216, OFF_YV = OFF_YK + 2097152, OFF_ST = OFF_YV + 2097152;
constexpr float ALPHA = 1.41421356237f;
constexpr float QSCALE = 0.125f * 1.4426950408889634f;
constexpr int SMEM_BYTES = 131072;

struct Params {
  const float *x_prompt, *x_sample, *c, *cache_k, *cache_v, *state_lru, *c_ctx, *w_ada, *b_ada, *w_in,
      *q_g, *k_g, *conv_w, *conv_b, *lru_wa, *lru_ba, *lru_wx, *lru_bx, *lru_lam, *mlp_g, *mlp_b, *mlp_ws, *mlp_bs,
      *w_out, *ln1_g, *ln1_b, *w_ff1, *b_ff1, *w_ff2, *b_ff2, *ln2_g, *ln2_b;
  float* out;
  bf16_t *wt_in, *wt_out, *wt_ff1, *wt_ff2, *wt_lru;
  float *mod, *rope, *cdec;
  bf16_t *abuf;
  bf16_t *zf;
  float *au;
  bf16_t *kb_lat, *vt_lat;
  bf16_t *kb_ctx, *vt_ctx;
  unsigned *bar;
  float *rstat;
};

union U8 { uint4 u; bf16x8 v; bf16_t h[8]; unsigned w[4]; };

DEV float bf2f(bf16_t h) { return __uint_as_float(((unsigned)h) << 16); }
DEV bf16_t f2bf(float f) { unsigned u = __float_as_uint(f); u += 0x7fffu + ((u >> 16) & 1u); return (bf16_t)(u >> 16); }
DEV unsigned pack2(float a, float b) { unsigned r; asm volatile("v_cvt_pk_bf16_f32 %0, %1, %2" : "=v"(r) : "v"(a), "v"(b)); return r; }
DEV float gelu_t(float x) { float y = 0.7978845608028654f * (x + 0.044715f * x * x * x); float t = 1.f - 2.f * __builtin_amdgcn_rcpf(1.f + __expf(2.f * y)); return 0.5f * x * (1.f + t); }
DEV float sigmoidf_(float x) { return __builtin_amdgcn_rcpf(1.f + __expf(-x)); }
DEV int own_row(int x, int r) { return r < 1024 ? (x << 10) + r : 8192 + (x << 10) + (r - 1024); }
DEV int own_panel(int vp) { const int x = vp >> 3, lp = vp & 7; return lp < 4 ? 4 * x + lp : 32 + 4 * x + (lp - 4); }
DEV int xrow(int vm) { const int k = vm >> 11, c = (vm & 2047) >> 3, w = vm & 7; return own_row(c & 7, (k << 8) + ((c >> 3) << 3) + w); }
DEV int cond_of(int m) { return m < 8192 ? 0 : 1 + ((m - 8192) >> 10); }
DEV f32x4 mfma16(bf16x8 a, bf16x8 b, f32x4 c) { return __builtin_amdgcn_mfma_f32_16x16x32_bf16(a, b, c, 0, 0, 0); }
DEV float wave_sum(float v) {
#pragma unroll
  for (int o = 32; o >= 1; o >>= 1) v += __shfl_xor(v, o);
  return v;
}

DEV void transpose_tile(const float* __restrict__ src, bf16_t* __restrict__ dst, int lds_, int ldd, char* smem) {
  float* T = (float*)smem;
  const int tid = VTID;
#pragma unroll
  for (int i = 0; i < 4; ++i) {
    int k = (tid >> 4) + 16 * i, n4 = (tid & 15) * 4;
    float4 v = *(const float4*)(src + (size_t)k * lds_ + n4);
    T[k * 65 + n4 + 0] = v.x; T[k * 65 + n4 + 1] = v.y; T[k * 65 + n4 + 2] = v.z; T[k * 65 + n4 + 3] = v.w;
  }
  __syncthreads();
#pragma unroll
  for (int i = 0; i < 2; ++i) {
    int n = (tid >> 3) + 32 * i, k8 = (tid & 7) * 8;
    U8 o;
#pragma unroll
    for (int j = 0; j < 4; ++j) o.w[j] = pack2(T[(k8 + 2 * j) * 65 + n], T[(k8 + 2 * j + 1) * 65 + n]);
    *(uint4*)(dst + (size_t)n * ldd + k8) = o.u;
  }
  __syncthreads();
}
DEV void transpose_w(const float* __restrict__ W, bf16_t* __restrict__ Wt, int K, int N, int tk, int tn, char* smem) {
  transpose_tile(W + (size_t)(tk * 64) * N + tn * 64, Wt + (size_t)(tn * 64) * K + tk * 64, N, K, smem);
}

DEV void tr_desc(const Params& p, int t, const float*& src, int& lds_, bf16_t*& dst, int& ldd) {
  if (t < 2 * 2768) {
    const int l = t / 2768, r = t % 2768;
    const float* W; bf16_t* Wt; int K, N, tk, tn;
    if (r < 448) { W = p.w_in + (size_t)l * 1024 * 1792; Wt = p.wt_in + (size_t)l * 1792 * 1024; K = 1024; N = 1792; tk = r / 28; tn = r % 28; }
    else if (r < 704) { const int i = r - 448; W = p.w_out + (size_t)l * 1024 * 1024; Wt = p.wt_out + (size_t)l * 1024 * 1024; K = 1024; N = 1024; tk = i / 16; tn = i % 16; }
    else if (r < 1728) { const int i = r - 704; W = p.w_ff1 + (size_t)l * 1024 * 4096; Wt = p.wt_ff1 + (size_t)l * 4096 * 1024; K = 1024; N = 4096; tk = i / 64; tn = i % 64; }
    else if (r < 2752) { const int i = r - 1728; W = p.w_ff2 + (size_t)l * 4096 * 1024; Wt = p.wt_ff2 + (size_t)l * 1024 * 4096; K = 4096; N = 1024; tk = i / 16; tn = i % 16; }
    else {
      const int idx = r - 2752, dir = idx >> 3, blk = (idx >> 1) & 3, mat = idx & 1;
      src = (mat == 0 ? p.lru_wa : p.lru_wx) + (size_t)(((l * 2 + dir) * 4 + blk)) * 4096; lds_ = 64;
      dst = p.wt_lru + (size_t)((((l * 2 + dir) * 4 + blk) * 2 + mat)) * 4096; ldd = 64; return;
    }
    src = W + (size_t)(tk * 64) * N + tn * 64; lds_ = N; dst = Wt + (size_t)(tn * 64) * K + tk * 64; ldd = K;
  } else {
    const int j = t - 2 * 2768, tt = j & 3, kvh = (j >> 2) & 1, l = (j >> 3) & 1, b = j >> 4;
    src = p.cache_v + ((size_t)(b * 2 + l) * 256 + tt * 64) * 128 + kvh * 64; lds_ = 128;
    dst = p.vt_lat + ((size_t)((l * 8 + b) * 2 + kvh) * 64) * 1280 + tt * 64; ldd = 1280;
  }
}

DEV void transpose_all(const Params& p, char* smem) {
  constexpr int NTR = 2 * 2768 + 128;
  float* T = (float*)smem;
  const int tid = VTID, kr = tid >> 4, n4 = (tid & 15) * 4;
  int t = VBID;
  if (t >= NTR) return;
  const float* src; bf16_t* dst; int lds_, ldd;
  tr_desc(p, t, src, lds_, dst, ldd);
  float4 cur[4];
#pragma unroll
  for (int i = 0; i < 4; ++i) cur[i] = *(const float4*)(src + (size_t)(kr + 16 * i) * lds_ + n4);
  while (t < NTR) {
    const int tn = t + VNB;
    const float* nsrc = src; bf16_t* ndst = dst; int nlds = lds_, nldd = ldd;
    float4 nxt[4];
    if (tn < NTR) {
      tr_desc(p, tn, nsrc, nlds, ndst, nldd);
#pragma unroll
      for (int i = 0; i < 4; ++i) nxt[i] = *(const float4*)(nsrc + (size_t)(kr + 16 * i) * nlds + n4);
    }
#pragma unroll
    for (int i = 0; i < 4; ++i) {
      const int k = kr + 16 * i;
      T[k * 65 + n4 + 0] = cur[i].x; T[k * 65 + n4 + 1] = cur[i].y; T[k * 65 + n4 + 2] = cur[i].z; T[k * 65 + n4 + 3] = cur[i].w;
    }
    __syncthreads();
#pragma unroll
    for (int i = 0; i < 2; ++i) {
      const int n = (tid >> 3) + 32 * i, k8 = (tid & 7) * 8;
      U8 o;
#pragma unroll
      for (int j = 0; j < 4; ++j) o.w[j] = pack2(T[(k8 + 2 * j) * 65 + n], T[(k8 + 2 * j + 1) * 65 + n]);
      *(uint4*)(dst + (size_t)n * ldd + k8) = o.u;
    }
    __syncthreads();
    if (tn < NTR) {
#pragma unroll
      for (int i = 0; i < 4; ++i) cur[i] = nxt[i];
    }
    src = nsrc; dst = ndst; lds_ = nlds; ldd = nldd; t = tn;
  }
}

DEV void phase0(const Params& p, char* smem) {
  const int tid = VTID;
  const int NT0 = 192 - 128, NITEMS = 192 + 64 + 2;
  for (int it = VBID; it < NITEMS; it += VNB) {
    if (it < 192) {
      const int l = it / 96, n0 = (it % 96) * 64;
      float* s = (float*)smem;
      float* red = s + 9 * 1024;
      for (int idx = tid; idx < 9 * 1024; idx += 256) {
        int c = idx >> 10, k = idx & 1023;
        float v = (c == 0) ? p.c_ctx[k] : p.c[(c - 1) * 1024 + k];
        s[idx] = v / (1.f + __expf(-v));
      }
      __syncthreads();
      const int w = tid >> 6, lane = tid & 63, cq = lane & 15, ks = lane >> 4;
      const int kbase = (w * 4 + ks) * 64;
      float acc[9][4];
#pragma unroll
      for (int c = 0; c < 9; ++c) { acc[c][0] = 0.f; acc[c][1] = 0.f; acc[c][2] = 0.f; acc[c][3] = 0.f; }
      const float* wp = p.w_ada + ((size_t)l * 1024 + kbase) * 6144 + n0 + cq * 4;
      for (int kb = 0; kb < 64; kb += 16) {
        float4 wv[16];
#pragma unroll
        for (int j = 0; j < 16; ++j) wv[j] = *(const float4*)(wp + (size_t)(kb + j) * 6144);
#pragma unroll
        for (int j = 0; j < 16; ++j)
#pragma unroll
          for (int c = 0; c < 9; ++c) {
            const float sv = s[c * 1024 + kbase + kb + j];
            acc[c][0] += sv * wv[j].x; acc[c][1] += sv * wv[j].y; acc[c][2] += sv * wv[j].z; acc[c][3] += sv * wv[j].w;
          }
      }
#pragma unroll
      for (int c = 0; c < 9; ++c)
#pragma unroll
        for (int e = 0; e < 4; ++e) {
          float a = acc[c][e];
          a += __shfl_xor(a, 16); a += __shfl_xor(a, 32);
          if (ks == 0) red[(w * 9 + c) * 64 + cq * 4 + e] = a;
        }
      __syncthreads();
      for (int idx = tid; idx < 576; idx += 256) {
        int c = idx >> 6, nn = idx & 63;
        float v = red[(0 * 9 + c) * 64 + nn] + red[(1 * 9 + c) * 64 + nn] + red[(2 * 9 + c) * 64 + nn] + red[(3 * 9 + c) * 64 + nn] +
                  p.b_ada[l * 6144 + n0 + nn];
        p.mod[((size_t)l * 9 + c) * 6144 + n0 + nn] = v;
      }
      __syncthreads();
    } else if (it >= NT0 + 128 && it < NT0 + 192) {
      const int j = it - NT0 - 128;
#pragma unroll
      for (int i = 0; i < 4; ++i) {
        const int e = (j * 1024 + i * 256 + tid) * 8;
        const int d = e & 63, kvh = (e >> 6) & 1, t = (e >> 7) & 255, l = (e >> 15) & 1, b = e >> 16;
        const float4 a0 = *(const float4*)(p.cache_k + e), a1 = *(const float4*)(p.cache_k + e + 4);
        U8 o; o.w[0] = pack2(a0.x, a0.y); o.w[1] = pack2(a0.z, a0.w); o.w[2] = pack2(a1.x, a1.y); o.w[3] = pack2(a1.z, a1.w);
        *(uint4*)(p.kb_lat + ((size_t)((l * 8 + b) * 2 + kvh) * 1280 + t) * 64 + d) = o.u;
      }
    } else if (it >= NT0 + 192) {
      if (it == NT0 + 192)
      for (int idx = tid; idx < 1024; idx += 256) {
        int pp = idx >> 4, f = idx & 15;
        float inv = powf(10000.f, -(float)f / 16.f);
        float ang = (float)pp * inv;
        float nrev = rintf(ang * 0.15915494309189535f);
        float r = fmaf(-nrev, 6.28125f, ang);
        r = fmaf(-nrev, 0.0019353071795864769f, r);
        p.rope[idx * 2 + 0] = __cosf(r);
        p.rope[idx * 2 + 1] = __sinf(r);
      }
      if (it == NT0 + 192)
      for (int idx = tid; idx < 1024; idx += 256) {
        const float xn = -p.lru_lam[idx];
        p.cdec[idx] = -8.f * (fmaxf(xn, 0.f) + log1pf(expf(-fabsf(xn))));
      }
    }
  }
  transpose_all(p, smem);
}

DEV void ln_mod_phase(const Params& p, int l, int mode) {
  const int lane = threadIdx.x & 63, w = threadIdx.x >> 6;
  const float* lg = nullptr; const float* lb = nullptr;
  if (mode == 1) { lg = p.ln2_g + (l - 1) * 1024; lb = p.ln2_b + (l - 1) * 1024; }
  else if (mode == 2) { lg = p.ln1_g + l * 1024; lb = p.ln1_b + l * 1024; }
  else if (mode == 3) { lg = p.ln2_g + l * 1024; lb = p.ln2_b + l * 1024; }
  const int shoff = (mode == 2) ? 3072 : 0;
  const int mstride = gridDim.x * 8;
  float4 nv[4];
  {
    const int m = xrow(blockIdx.x * 8 + w);
    const float* src = (mode == 0) ? ((m < 8192) ? p.x_prompt + (size_t)m * 1024 : p.x_sample + (size_t)(m - 8192) * 1024) : p.out + (size_t)m * 1024;
#pragma unroll
    for (int i = 0; i < 4; ++i) nv[i] = *(const float4*)(src + i * 256 + lane * 4);
  }
  for (int vm = blockIdx.x * 8 + w; vm < MT; vm += mstride) {
    const int m = xrow(vm);
    float4 v[4];
#pragma unroll
    for (int i = 0; i < 4; ++i) v[i] = nv[i];
    {
      const int mn = xrow((vm + mstride < MT) ? vm + mstride : vm);
      const float* src = (mode == 0) ? ((mn < 8192) ? p.x_prompt + (size_t)mn * 1024 : p.x_sample + (size_t)(mn - 8192) * 1024) : p.out + (size_t)mn * 1024;
#pragma unroll
      for (int i = 0; i < 4; ++i) nv[i] = *(const float4*)(src + i * 256 + lane * 4);
    }
    if (mode != 0) {
      float s = 0.f;
#pragma unroll
      for (int i = 0; i < 4; ++i) s += v[i].x + v[i].y + v[i].z + v[i].w;
      const float mean = wave_sum(s) * (1.f / 1024.f);
      float s2 = 0.f;
#pragma unroll
      for (int i = 0; i < 4; ++i) { float a = v[i].x - mean, b = v[i].y - mean, c = v[i].z - mean, d = v[i].w - mean; s2 += a * a + b * b + c * c + d * d; }
      const float rstd = rsqrtf(wave_sum(s2) * (1.f / 1024.f) + 1e-6f);
#pragma unroll
      for (int i = 0; i < 4; ++i) {
        float4 g = *(const float4*)(lg + i * 256 + lane * 4), b = *(const float4*)(lb + i * 256 + lane * 4);
        v[i].x = (v[i].x - mean) * rstd * g.x + b.x; v[i].y = (v[i].y - mean) * rstd * g.y + b.y;
        v[i].z = (v[i].z - mean) * rstd * g.z + b.z; v[i].w = (v[i].w - mean) * rstd * g.w + b.w;
        if (mode == 3) *(float4*)(p.out + (size_t)m * 1024 + i * 256 + lane * 4) = v[i];
      }
      if (mode != 3 && lane == 0) *(float2*)(p.rstat + (size_t)m * 2) = make_float2(mean, rstd);
    }
    if (mode != 3) {
      const float* md = p.mod + ((size_t)l * 9 + cond_of(m)) * 6144 + shoff;
#pragma unroll
      for (int i = 0; i < 4; ++i) {
        float4 sh = *(const float4*)(md + i * 256 + lane * 4), sc = *(const float4*)(md + 1024 + i * 256 + lane * 4);
        uint2 o;
        o.x = pack2(v[i].x * (1.f + sc.x) + sh.x, v[i].y * (1.f + sc.y) + sh.y);
        o.y = pack2(v[i].z * (1.f + sc.z) + sh.z, v[i].w * (1.f + sc.w) + sh.w);
        *(uint2*)(p.abuf + (size_t)m * 1024 + i * 256 + lane * 4) = o;
      }
    }
  }
}

#define LAS3 __attribute__((address_space(3)))
namespace g8 {
constexpr int BM = 256, BK = 64, HALF = 128, HTB = HALF * BK * 2, NXCD = 8, WGM = 4;
DEV int lds_byte(int r, int c) { const int st = (r >> 4) * 2 + (c >> 5), rr = r & 15, cc = c & 31, ob = rr * 64 + cc * 2; return st * 1024 + (ob ^ (((ob >> 9) & 1) << 5)); }
DEV void stage_rc(int b, int& R, int& C) { const int st = b / 1024, sb = b % 1024, swz = sb ^ (((sb >> 9) & 1) << 5); R = (st >> 1) * 16 + swz / 64; C = (st & 1) * 32 + (swz % 64) / 2; }
DEV bool unit_of(int i, int nM, int nN, int& pm, int& pn) {
  const int nwg = nM * nN;
  const long L = (long)i * gridDim.x + blockIdx.x; if (L >= nwg) return false;
  int wgid = (int)L; { const int q = nwg / NXCD, r = nwg % NXCD, xcd = wgid % NXCD, off = wgid / NXCD; wgid = (xcd < r ? xcd * (q + 1) : r * (q + 1) + (xcd - r) * q) + off; }
  const int nig = WGM * nN, gid = wgid / nig, fm = gid * WGM, gsz = (nM - fm) < WGM ? (nM - fm) : WGM;
  pm = own_panel(fm + ((wgid % nig) % gsz)); pn = (wgid % nig) / gsz; return true;
}
}

template <int EPI>
DEV void gemm_epilogue(const Params& p, int l, f32x4 (&acc)[2][2][4][2], int pm, int pn, int wr, int wc, int fr, int fq) {
  const int brow = pm * 256, bcol = pn * 256;
  const float* md = p.mod + ((size_t)l * 9 + cond_of(brow)) * 6144;
#pragma unroll
  for (int bj = 0; bj < 2; ++bj)
#pragma unroll
    for (int n = 0; n < 2; ++n) {
      const int col = bcol + bj * 128 + wc * 32 + n * 16 + fq * 4;
      float4 gate = make_float4(0.f, 0.f, 0.f, 0.f), bias = make_float4(0.f, 0.f, 0.f, 0.f);
      if (EPI == 2) gate = *(const float4*)(md + 2048 + col);
      if (EPI == 3) bias = *(const float4*)(p.b_ff1 + l * 4096 + col);
      if (EPI == 4) { gate = *(const float4*)(md + 5120 + col); bias = *(const float4*)(p.b_ff2 + l * 1024 + col); }
#pragma unroll
      for (int ai = 0; ai < 2; ++ai)
#pragma unroll
        for (int m = 0; m < 4; ++m) {
          const int row = brow + ai * 128 + wr * 64 + m * 16 + fr;
          const f32x4 v = acc[ai][bj][m][n];
          if (EPI == 1) {
            uint2 o; o.x = pack2(v[0], v[1]); o.y = pack2(v[2], v[3]);
            *(uint2*)(p.zf + (size_t)row * 1792 + col) = o;
          } else if (EPI == 2) {
            const float* xs = (l == 0) ? ((row < 8192) ? p.x_prompt + (size_t)row * 1024 : p.x_sample + (size_t)(row - 8192) * 1024) : p.out + (size_t)row * 1024;
            const float4 x = *(const float4*)(xs + col);
            *(float4*)(p.out + (size_t)row * 1024 + col) = make_float4(ALPHA * x.x + gate.x * v[0], ALPHA * x.y + gate.y * v[1], ALPHA * x.z + gate.z * v[2], ALPHA * x.w + gate.w * v[3]);
          } else if (EPI == 3) {
            const float t0 = fmaxf(v[0] + bias.x, 0.f), t1 = fmaxf(v[1] + bias.y, 0.f), t2 = fmaxf(v[2] + bias.z, 0.f), t3 = fmaxf(v[3] + bias.w, 0.f);
            uint2 o; o.x = pack2(t0 * t0, t1 * t1); o.y = pack2(t2 * t2, t3 * t3);
            *(uint2*)(p.zf + (size_t)row * 4096 + col) = o;
          } else {
            float* xo = p.out + (size_t)row * 1024 + col;
            const float4 x = *(const float4*)xo;
            *(float4*)xo = make_float4(ALPHA * x.x + gate.x * (v[0] + bias.x), ALPHA * x.y + gate.y * (v[1] + bias.y), ALPHA * x.z + gate.z * (v[2] + bias.z), ALPHA * x.w + gate.w * (v[3] + bias.w));
          }
        }
    }
}

template <int EPI>
DEV void gemm_epilogue_lnres(const Params& p, int l, f32x4 (&acc)[2][2][4][2], int pm, int pn, int wr, int wc, int fr, int fq) {
  const int brow = pm * 256, bcol = pn * 256;
  const float* md = p.mod + ((size_t)l * 9 + cond_of(brow)) * 6144;
  float mean[2][4], rstd[2][4];
  {
    const unsigned so = (unsigned)(brow + wr * 64 + fr) * 2u;
#pragma unroll
    for (int ai = 0; ai < 2; ++ai)
#pragma unroll
      for (int m = 0; m < 4; ++m) { const float2 t = *(const float2*)(p.rstat + (so + (unsigned)((ai * 128 + m * 16) * 2))); mean[ai][m] = t.x; rstd[ai][m] = t.y; }
  }
  const float* lg = (EPI == 2) ? p.ln2_g + (l - 1) * 1024 : p.ln1_g + l * 1024;
  const float* lb = (EPI == 2) ? p.ln2_b + (l - 1) * 1024 : p.ln1_b + l * 1024;
  const unsigned co = (unsigned)(bcol + wc * 32 + fq * 4);
  const unsigned ro = (unsigned)(brow + wr * 64 + fr) * 1024u + co;
#pragma unroll
  for (int bj = 0; bj < 2; ++bj)
#pragma unroll
    for (int n = 0; n < 2; ++n) {
      unsigned col = co + (unsigned)(bj * 128 + n * 16), rb = ro + (unsigned)(bj * 128 + n * 16);
      asm volatile("" : "+v"(col), "+v"(rb));
      float4 gate, bias = make_float4(0.f, 0.f, 0.f, 0.f);
      if (EPI == 2) gate = *(const float4*)(md + 2048 + col);
      else { gate = *(const float4*)(md + 5120 + col); bias = *(const float4*)(p.b_ff2 + l * 1024 + col); }
      const float4 g4 = *(const float4*)(lg + col), b4 = *(const float4*)(lb + col);
#pragma unroll
      for (int ai = 0; ai < 2; ++ai)
#pragma unroll
        for (int m = 0; m < 4; ++m) {
          float* xo = p.out + (rb + (unsigned)((ai * 128 + m * 16) * 1024));
          const float4 x = *(const float4*)xo;
          const float mu = mean[ai][m], rr = rstd[ai][m];
          const f32x4 v = acc[ai][bj][m][n];
          const float x0 = (x.x - mu) * rr * g4.x + b4.x, x1 = (x.y - mu) * rr * g4.y + b4.y, x2 = (x.z - mu) * rr * g4.z + b4.z, x3 = (x.w - mu) * rr * g4.w + b4.w;
          *(float4*)xo = make_float4(ALPHA * x0 + gate.x * (v[0] + bias.x), ALPHA * x1 + gate.y * (v[1] + bias.y), ALPHA * x2 + gate.z * (v[2] + bias.z), ALPHA * x3 + gate.w * (v[3] + bias.w));
        }
    }
}

template <int EPI>
DEV void gemm_phase(const Params& p, int l, const bf16_t* Ag, const bf16_t* Btg, int N, int K, LAS3 unsigned char* lds) {
  using namespace g8;
  const int tid = threadIdx.x, wid = __builtin_amdgcn_readfirstlane(tid >> 6), lane = tid & 63, wr = wid >> 2, wc = wid & 3, fr = lane & 15, fq = lane >> 4;
  const int nt = K / BK, nM = MT / BM, nN = N / BM;
  unsigned voff[2];
#pragma unroll
  for (int i = 0; i < 2; ++i) { int R, C; stage_rc(tid * 16 + i * 8192, R, C); voff[i] = (unsigned)(R * K + C) * 2u; }
  const size_t kstep = (size_t)(BK * 2);
  const size_t hstep = (size_t)HALF * K * 2;
  const size_t tstep = 2 * hstep;
  const unsigned ldsw = (unsigned)wid * 1024u;
  const int aoff = lds_byte(wr * 64 + fr, fq * 8), boff = lds_byte(wc * 32 + fr, fq * 8);
#define PG8_SA(b, h) (((b) * 2 + (h)) * HTB)
#define PG8_SB(b, h) ((4 + (b) * 2 + (h)) * HTB)
#define PG8_STAGE(bufoff, gbase) do { _Pragma("unroll") for (int _i = 0; _i < 2; ++_i) \
    __builtin_amdgcn_global_load_lds((const unsigned*)((const char*)(gbase) + voff[_i]), (LAS3 unsigned*)(lds + (bufoff) + ldsw + _i * 8192), 16, 0, 0); } while (0)
#define PG8_LDA(dst, b, h) do { _Pragma("unroll") for (int m = 0; m < 4; ++m) _Pragma("unroll") for (int k = 0; k < 2; ++k) dst[m][k] = *(const LAS3 bf16x8*)(lds + PG8_SA(b, h) + aoff + m * 2048 + k * 1024); } while (0)
#define PG8_LDB(dst, b, h) do { _Pragma("unroll") for (int n = 0; n < 2; ++n) _Pragma("unroll") for (int k = 0; k < 2; ++k) dst[n][k] = *(const LAS3 bf16x8*)(lds + PG8_SB(b, h) + boff + n * 2048 + k * 1024); } while (0)
#define PG8_MMA(ai, bj, At_, Bt_) do { __builtin_amdgcn_s_setprio(1); _Pragma("unroll") for (int m = 0; m < 4; ++m) _Pragma("unroll") for (int n = 0; n < 2; ++n) _Pragma("unroll") for (int k = 0; k < 2; ++k) \
    acc[ai][bj][m][n] = __builtin_amdgcn_mfma_f32_16x16x32_bf16(Bt_[n][k], At_[m][k], acc[ai][bj][m][n], 0, 0, 0); __builtin_amdgcn_s_setprio(0); } while (0)
#define PG8_WAIT_V(n) asm volatile("s_waitcnt vmcnt(" #n ")" ::: "memory")
#define PG8_WAIT_L(n) asm volatile("s_waitcnt lgkmcnt(" #n ")" ::: "memory")
#define PG8_BAR __builtin_amdgcn_s_barrier()
#define PG8_SCHED __builtin_amdgcn_sched_barrier(0)
  int cpm, cpn, npm = 0, npn = 0, ui = 0;
  if (!unit_of(0, nM, nN, cpm, cpn)) return;
  f32x4 acc[2][2][4][2];
#pragma unroll
  for (int a = 0; a < 2; ++a)
#pragma unroll
    for (int b = 0; b < 2; ++b)
#pragma unroll
      for (int m = 0; m < 4; ++m)
#pragma unroll
        for (int n = 0; n < 2; ++n) acc[a][b][m][n] = (f32x4){0.f, 0.f, 0.f, 0.f};
  bf16x8 At[4][2], B0[2][2], B1[2][2];
  const char* cA = (const char*)Ag + (size_t)cpm * tstep; const char* cB = (const char*)Btg + (size_t)cpn * tstep;
  PG8_STAGE(PG8_SB(0, 0), cB); PG8_STAGE(PG8_SA(0, 0), cA); PG8_STAGE(PG8_SB(0, 1), cB + hstep); PG8_STAGE(PG8_SA(0, 1), cA + hstep);
  if (wr == 1) PG8_BAR;
  PG8_WAIT_V(4); PG8_BAR;
  PG8_STAGE(PG8_SB(1, 0), cB + kstep); PG8_STAGE(PG8_SA(1, 0), cA + kstep); PG8_STAGE(PG8_SB(1, 1), cB + hstep + kstep);
  PG8_WAIT_V(6); PG8_BAR;
  for (;;) {
    const bool has_next = unit_of(ui + 1, nM, nN, npm, npn);
    const char* nA = has_next ? (const char*)Ag + (size_t)npm * tstep : cA; const char* nB = has_next ? (const char*)Btg + (size_t)npn * tstep : cB;
    for (int t = 0; t < nt; t += 2) {
      const bool last = (t == nt - 2);
      const char* a1 = cA + (size_t)(t + 1) * kstep;
      const char* a2 = last ? nA : cA + (size_t)(t + 2) * kstep; const char* b2 = last ? nB : cB + (size_t)(t + 2) * kstep;
      const char* a3 = a2 + kstep; const char* b3 = b2 + kstep;
      PG8_LDB(B0, 0, 0); PG8_SCHED; PG8_LDA(At, 0, 0); PG8_STAGE(PG8_SA(1, 1), a1 + hstep);
      PG8_WAIT_L(8); PG8_BAR; PG8_WAIT_L(0); PG8_MMA(0, 0, At, B0); PG8_BAR; PG8_SCHED;
      PG8_LDB(B1, 0, 1); PG8_STAGE(PG8_SB(0, 0), b2);
      PG8_BAR; PG8_WAIT_L(0); PG8_MMA(0, 1, At, B1); PG8_BAR;
      PG8_LDA(At, 0, 1); PG8_STAGE(PG8_SA(0, 0), a2);
      PG8_BAR; PG8_WAIT_L(0); PG8_MMA(1, 0, At, B0); PG8_BAR; PG8_SCHED;
      PG8_STAGE(PG8_SB(0, 1), b2 + hstep);
      PG8_WAIT_V(6); PG8_BAR; PG8_MMA(1, 1, At, B1); PG8_BAR;
      PG8_LDB(B0, 1, 0); PG8_SCHED; PG8_LDA(At, 1, 0); PG8_STAGE(PG8_SA(0, 1), a2 + hstep);
      PG8_WAIT_L(8); PG8_BAR; PG8_WAIT_L(0); PG8_MMA(0, 0, At, B0); PG8_BAR; PG8_SCHED;
      PG8_LDB(B1, 1, 1); PG8_STAGE(PG8_SB(1, 0), b3);
      PG8_BAR; PG8_WAIT_L(0); PG8_MMA(0, 1, At, B1); PG8_BAR;
      PG8_LDA(At, 1, 1); PG8_STAGE(PG8_SA(1, 0), a3);
      PG8_BAR; PG8_WAIT_L(0); PG8_MMA(1, 0, At, B0); PG8_BAR; PG8_SCHED;
      PG8_STAGE(PG8_SB(1, 1), b3 + hstep);
      PG8_WAIT_V(6); PG8_BAR; PG8_MMA(1, 1, At, B1); PG8_BAR;
    }
    if (EPI == 4 || (EPI == 2 && l > 0)) gemm_epilogue_lnres<EPI>(p, l, acc, cpm, cpn, wr, wc, fr, fq);
    else gemm_epilogue<EPI>(p, l, acc, cpm, cpn, wr, wc, fr, fq);
    if (!has_next) break;
#pragma unroll
    for (int a = 0; a < 2; ++a)
#pragma unroll
      for (int b = 0; b < 2; ++b)
#pragma unroll
        for (int m = 0; m < 4; ++m)
#pragma unroll
          for (int n = 0; n < 2; ++n) acc[a][b][m][n] = (f32x4){0.f, 0.f, 0.f, 0.f};
    cpm = npm; cpn = npn; cA = nA; cB = nB; ++ui;
  }
  PG8_WAIT_V(0);
  if (wr == 0) PG8_BAR;
  PG8_BAR;
#undef PG8_SA
#undef PG8_SB
#undef PG8_STAGE
#undef PG8_LDA
#undef PG8_LDB
#undef PG8_MMA
#undef PG8_WAIT_V
#undef PG8_WAIT_L
#undef PG8_BAR
#undef PG8_SCHED
}

DEV void rope8(float (&v)[8], int d0, int prow, int pcol, const float* __restrict__ rope) {
  const int pp = (d0 < 32) ? prow : pcol;
#pragma unroll
  for (int i = 0; i < 4; ++i) {
    const int f = ((d0 >> 1) + i) & 15;
    const float cs = rope[(pp * 16 + f) * 2], sn = rope[(pp * 16 + f) * 2 + 1];
    const float x1 = v[2 * i], x2 = v[2 * i + 1];
    v[2 * i] = x1 * cs - x2 * sn; v[2 * i + 1] = x1 * sn + x2 * cs;
  }
}

DEV void prep_token_row(const Params& p, int l, int m, int lane, uint4 c) {
  bf16_t* zr = p.zf + (size_t)m * 1792;
  const bool lat = m >= 8192;
  const int pos = lat ? ((m - 8192) & 1023) : (m & 255);
  const int prow = pos >> 6, pcol = pos & 63;
  const int d0 = (lane & 7) * 8;
  U8 u; u.u = c;
  float v[8], gl[8]; float ss = 0.f, sg = 0.f;
#pragma unroll
  for (int j = 0; j < 8; ++j) { v[j] = bf2f(u.h[j]); ss += v[j] * v[j]; gl[j] = gelu_t(v[j]); sg += gl[j]; }
  ss += __shfl_xor(ss, 1); ss += __shfl_xor(ss, 2); ss += __shfl_xor(ss, 4);
#pragma unroll
  for (int o = 1; o <= 16; o <<= 1) sg += __shfl_xor(sg, o);
  const float mean = sg * (1.f / 256.f);
  float s2 = 0.f;
#pragma unroll
  for (int j = 0; j < 8; ++j) { const float d = gl[j] - mean; s2 += d * d; }
#pragma unroll
  for (int o = 1; o <= 16; o <<= 1) s2 += __shfl_xor(s2, o);
  if (lane < 16) {
    const float rinv = rsqrtf(ss * (1.f / 64.f) + 1e-6f);
#pragma unroll
    for (int j = 0; j < 8; ++j) v[j] = v[j] * rinv * p.k_g[l * 64 + d0 + j];
    if (!lat) {
      float* o = p.out + OFF_YK + ((((size_t)(m >> 8)) * 2 + l) * 256 + pos) * 128 + lane * 8;
      *(float4*)o = make_float4(v[0], v[1], v[2], v[3]); *(float4*)(o + 4) = make_float4(v[4], v[5], v[6], v[7]);
    } else rope8(v, d0, prow, pcol, p.rope);
#pragma unroll
    for (int j = 0; j < 4; ++j) u.w[j] = pack2(v[2 * j], v[2 * j + 1]);
    const int kvh = lane >> 3;
    bf16_t* kd = lat ? p.kb_lat + ((size_t)((l * 8 + ((m - 8192) >> 10)) * 2 + kvh) * 1280 + 256 + pos) * 64 + d0
                     : p.kb_ctx + ((size_t)((m >> 8) * 2 + kvh) * 256 + pos) * 64 + d0;
    *(uint4*)kd = u.u;
  } else if (lane < 32) {
    if (!lat) {
      float* o = p.out + OFF_YV + ((((size_t)(m >> 8)) * 2 + l) * 256 + pos) * 128 + (lane - 16) * 8;
      *(float4*)o = make_float4(v[0], v[1], v[2], v[3]); *(float4*)(o + 4) = make_float4(v[4], v[5], v[6], v[7]);
    }
    const int kvh = (lane - 16) >> 3;
    bf16_t* vd; int T;
    if (lat) { T = 1280; vd = p.vt_lat + ((size_t)((l * 8 + ((m - 8192) >> 10)) * 2 + kvh) * 64 + d0) * 1280 + 256 + pos; }
    else { T = 256; vd = p.vt_ctx + ((size_t)((m >> 8) * 2 + kvh) * 64 + d0) * 256 + pos; }
#pragma unroll
    for (int j = 0; j < 8; ++j) vd[(size_t)j * T] = u.h[j];
  } else {
    const float rstd = rsqrtf(s2 * (1.f / 256.f) + 1e-6f);
    const int ch = (lane - 32) * 8;
#pragma unroll
    for (int j = 0; j < 8; ++j) gl[j] = (gl[j] - mean) * rstd * p.mlp_g[l * 256 + ch + j] + p.mlp_b[l * 256 + ch + j];
#pragma unroll
    for (int j = 0; j < 4; ++j) u.w[j] = pack2(gl[2 * j], gl[2 * j + 1]);
    *(uint4*)(zr + 1536 + ch) = u.u;
  }
}

template <bool REV>
DEV void tile_scan(float (&a)[4][4], float (&u)[4][4], int lane) {
  const int q = lane >> 4;
  float C = 0.f, CP = 1.f;
  const int src1 = (REV ? lane + 16 : lane - 16) & 63;
  const int src2 = (REV ? lane + 32 : lane - 32) & 63;
  const int srcT = (lane & 15) + (REV ? 0 : 48);
  const bool c1 = REV ? (q <= 2) : (q >= 1);
  const bool c2 = REV ? (q <= 1) : (q >= 2);
  const bool first = REV ? (q == 3) : (q == 0);
#pragma unroll
  for (int mi = 0; mi < 4; ++mi) {
    const int mt = REV ? 3 - mi : mi;
    float P = 1.f, H = 0.f, pl[4], hl[4];
#pragma unroll
    for (int ri = 0; ri < 4; ++ri) {
      const int r = REV ? 3 - ri : ri;
      H = a[mt][r] * H + u[mt][r]; P *= a[mt][r]; pl[r] = P; hl[r] = H;
    }
    float Pi = P, Hi = H;
    float Pp = __shfl(Pi, src1), Hp = __shfl(Hi, src1);
    if (c1) { Hi = Pi * Hp + Hi; Pi = Pi * Pp; }
    Pp = __shfl(Pi, src2); Hp = __shfl(Hi, src2);
    if (c2) { Hi = Pi * Hp + Hi; Pi = Pi * Pp; }
    float Pe = __shfl(Pi, src1), He = __shfl(Hi, src1);
    if (first) { Pe = 1.f; He = 0.f; }
    const float hin = Pe * C + He, pin = Pe * CP;
#pragma unroll
    for (int r = 0; r < 4; ++r) { u[mt][r] = pl[r] * hin + hl[r]; a[mt][r] = pl[r] * pin; }
    const float Pt = __shfl(Pi, srcT), Ht = __shfl(Hi, srcT);
    C = Pt * C + Ht; CP = Pt * CP;
  }
}

DEV void lru_gate_item(const Params& p, int l, int item, char* smem) {
  const int tid = VTID, lane = tid & 63, w = tid >> 6;
  const int tile = item >> 2, blk = item & 3;
  const int m0 = tile * 64;
  int ms, L;
  if (m0 < 8192) { ms = m0 & ~255; L = 256; } else { ms = 8192 + ((m0 - 8192) & ~1023); L = 1024; }
  const int dir = w >> 1, half = w & 1, q = lane >> 4, c15 = lane & 15;
  const bf16_t* wt = p.wt_lru + (size_t)((((l * 2 + dir) * 4 + blk) * 2)) * 4096;
  bf16x8 bfr[2][2][2];
#pragma unroll
  for (int mat = 0; mat < 2; ++mat)
#pragma unroll
    for (int j = 0; j < 2; ++j)
#pragma unroll
      for (int s = 0; s < 2; ++s) bfr[mat][j][s] = *(const bf16x8*)(wt + mat * 4096 + (half * 32 + j * 16 + c15) * 64 + s * 32 + q * 8);
  float* xs = (float*)smem;
  float* xcf = xs + 67 * 64;
  bf16_t* xcb = (bf16_t*)(xcf + 64 * 64);
  for (int idx = tid; idx < 67 * 8; idx += 256) {
    const int rr = idx >> 3, cc = idx & 7;
    const int m = m0 - 1 + rr;
    float v[8];
    if (m >= ms && m < ms + L) {
      U8 u; u.u = *(const uint4*)(p.zf + (size_t)m * 1792 + 768 + blk * 64 + cc * 8);
#pragma unroll
      for (int j = 0; j < 8; ++j) v[j] = bf2f(u.h[j]);
    } else {
#pragma unroll
      for (int j = 0; j < 8; ++j) v[j] = 0.f;
    }
#pragma unroll
    for (int j = 0; j < 8; ++j) xs[rr * 64 + cc * 8 + j] = v[j];
  }
  __syncthreads();
  {
    const int ch = tid & 63, Cg = blk * 64 + ch;
    const float w0 = p.conv_w[(l * 4 + 0) * 256 + Cg], w1 = p.conv_w[(l * 4 + 1) * 256 + Cg], w2 = p.conv_w[(l * 4 + 2) * 256 + Cg],
                w3 = p.conv_w[(l * 4 + 3) * 256 + Cg], cb = p.conv_b[l * 256 + Cg];
#pragma unroll 4
    for (int tt = 0; tt < 16; ++tt) {
      const int t = (tid >> 6) * 16 + tt;
      const float v = cb + w0 * xs[t * 64 + ch] + w1 * xs[(t + 1) * 64 + ch] + w2 * xs[(t + 2) * 64 + ch] + w3 * xs[(t + 3) * 64 + ch];
      xcf[t * 64 + ch] = v; xcb[t * 72 + ch] = f2bf(v);
    }
  }
  __syncthreads();
  f32x4 acc[2][4][2];
#pragma unroll
  for (int mat = 0; mat < 2; ++mat)
#pragma unroll
    for (int mt = 0; mt < 4; ++mt)
#pragma unroll
      for (int j = 0; j < 2; ++j) acc[mat][mt][j] = f32x4{0.f, 0.f, 0.f, 0.f};
#pragma unroll
  for (int mt = 0; mt < 4; ++mt)
#pragma unroll
    for (int s = 0; s < 2; ++s) {
      const bf16x8 af = *(const bf16x8*)(xcb + (mt * 16 + c15) * 72 + s * 32 + q * 8);
#pragma unroll
      for (int mat = 0; mat < 2; ++mat)
#pragma unroll
        for (int j = 0; j < 2; ++j) acc[mat][mt][j] = mfma16(af, bfr[mat][j][s], acc[mat][mt][j]);
    }
  float* PCp = p.au + (size_t)(dir * 2 + 0) * MT * 256;
  float* HLp = p.au + (size_t)(dir * 2 + 1) * MT * 256;
#pragma unroll
  for (int j = 0; j < 2; ++j) {
    const int ch = half * 32 + j * 16 + c15, Cg = blk * 64 + ch, pidx = (l * 2 + dir) * 256 + Cg;
    const float ba = p.lru_ba[pidx], bx = p.lru_bx[pidx];
    const float cdec = p.cdec[pidx];
    float a[4][4], u[4][4];
#pragma unroll
    for (int mt = 0; mt < 4; ++mt)
#pragma unroll
      for (int r = 0; r < 4; ++r) {
        const int t = mt * 16 + q * 4 + r;
        const float rg = sigmoidf_(acc[0][mt][j][r] + ba), ig = sigmoidf_(acc[1][mt][j][r] + bx);
        const float la = cdec * rg;
        a[mt][r] = __expf(la);
        const float x2 = 2.f * la;
        const float em = (x2 < -0.25f) ? 1.f - __expf(x2) : -x2 * (1.f + x2 * (0.5f + x2 * (1.f / 6.f + x2 * (1.f / 24.f + x2 * (1.f / 120.f + x2 * (1.f / 720.f))))));
        u[mt][r] = __builtin_amdgcn_sqrtf(em) * ig * xcf[t * 64 + ch];
      }
    if (dir == 0) tile_scan<false>(a, u, lane); else tile_scan<true>(a, u, lane);
#pragma unroll
    for (int mt = 0; mt < 4; ++mt)
#pragma unroll
      for (int r = 0; r < 4; ++r) {
        const size_t m = m0 + mt * 16 + q * 4 + r;
        PCp[m * 256 + Cg] = a[mt][r]; HLp[m * 256 + Cg] = u[mt][r];
      }
  }
  __syncthreads();
}

DEV void attn_item(const Params& p, int l, int it, char* sm) {
  const int tid = threadIdx.x, lane = tid & 63, w = tid >> 6, q = lane >> 4, c15 = lane & 15;
  const int qg = w >> 1, kh = w & 1;
  int h, ms, nkt, T; const bf16_t* Kg; const bf16_t* Vg;
  if (it < 512) {
    const int b = it >> 6, qb = it & 7; h = (it >> 3) & 7; ms = 8192 + b * 1024 + qb * 128; nkt = 10; T = 1280;
    Kg = p.kb_lat + (size_t)((l * 8 + b) * 2 + (h >> 2)) * 1280 * 64; Vg = p.vt_lat + (size_t)((l * 8 + b) * 2 + (h >> 2)) * 64 * 1280;
  } else {
    const int i2 = it - 512, b = i2 >> 4, qb = i2 & 1; h = (i2 >> 1) & 7; ms = b * 256 + qb * 128; nkt = 2; T = 256;
    Kg = p.kb_ctx + (size_t)(b * 2 + (h >> 2)) * 256 * 64; Vg = p.vt_ctx + (size_t)(b * 2 + (h >> 2)) * 64 * 256;
  }
  const int kc0 = tid, kc1 = tid + 512;
  const int vd0 = tid >> 4, vk = (tid & 15) * 8;
  const int vpos = ((tid & 15) >> 2) * 32 + 16 * (tid & 1) + 4 * ((tid & 3) >> 1);
  const bf16_t* vg0 = Vg + (size_t)vd0 * T + vk;
  const bf16_t* vg1 = Vg + (size_t)(vd0 + 32) * T + vk;
  uint4 rk0, rk1, rv0, rv1;
#define ATT_LOAD(kt) do { rk0 = *(const uint4*)(Kg + (size_t)(kt) * 8192 + kc0 * 8); rk1 = *(const uint4*)(Kg + (size_t)(kt) * 8192 + kc1 * 8); \
    rv0 = *(const uint4*)(vg0 + (kt) * 128); rv1 = *(const uint4*)(vg1 + (kt) * 128); } while (0)
#define ATT_STORE(buf) do { bf16_t* Ks_ = (bf16_t*)(sm + (buf) * 36864); bf16_t* Vs_ = Ks_ + 9216; \
    *(uint4*)(Ks_ + (kc0 >> 3) * 72 + (kc0 & 7) * 8) = rk0; *(uint4*)(Ks_ + (kc1 >> 3) * 72 + (kc1 & 7) * 8) = rk1; \
    *(uint2*)(Vs_ + vd0 * 136 + vpos) = make_uint2(rv0.x, rv0.y); *(uint2*)(Vs_ + vd0 * 136 + vpos + 8) = make_uint2(rv0.z, rv0.w); \
    *(uint2*)(Vs_ + (vd0 + 32) * 136 + vpos) = make_uint2(rv1.x, rv1.y); *(uint2*)(Vs_ + (vd0 + 32) * 136 + vpos + 8) = make_uint2(rv1.z, rv1.w); } while (0)
  ATT_LOAD(0);
  const int mq = ms + qg * 32;
  bf16x8 qf[2][2];
#pragma unroll
  for (int t = 0; t < 2; ++t)
#pragma unroll
    for (int s = 0; s < 2; ++s) qf[t][s] = *(const bf16x8*)(p.zf + (size_t)(mq + t * 16 + c15) * 1792 + h * 64 + s * 32 + q * 8);
  ATT_STORE(0);
  if (nkt > 1) ATT_LOAD(1);
#pragma unroll
  for (int t = 0; t < 2; ++t) {
    float f[2][8]; float ss = 0.f;
#pragma unroll
    for (int s = 0; s < 2; ++s)
#pragma unroll
      for (int j = 0; j < 8; ++j) { f[s][j] = bf2f((bf16_t)qf[t][s][j]); ss += f[s][j] * f[s][j]; }
    ss += __shfl_xor(ss, 16); ss += __shfl_xor(ss, 32);
    const float rinv = rsqrtf(ss * (1.f / 64.f) + 1e-6f);
    const int mrow_ = mq + t * 16 + c15;
    const int pos = (mrow_ - 8192) & 1023;
#pragma unroll
    for (int s = 0; s < 2; ++s) {
      const int dd = s * 32 + q * 8;
#pragma unroll
      for (int j = 0; j < 8; ++j) f[s][j] = f[s][j] * rinv * p.q_g[l * 64 + dd + j];
      if (it < 512) rope8(f[s], dd, pos >> 6, pos & 63, p.rope);
      U8 pk;
#pragma unroll
      for (int j = 0; j < 4; ++j) pk.w[j] = pack2(f[s][2 * j] * QSCALE, f[s][2 * j + 1] * QSCALE);
      qf[t][s] = pk.v;
    }
  }
  __syncthreads();
  f32x4 o[2][4];
  float mrow[2], lrow[2];
#pragma unroll
  for (int t = 0; t < 2; ++t) { mrow[t] = -1e30f; lrow[t] = 0.f;
#pragma unroll
    for (int j = 0; j < 4; ++j) o[t][j] = f32x4{0.f, 0.f, 0.f, 0.f}; }
  for (int kt = 0; kt < nkt; ++kt) {
    const int cur = kt & 1;
    const bf16_t* Ks = (const bf16_t*)(sm + cur * 36864) + kh * 64 * 72;
    const bf16_t* Vs = (const bf16_t*)(sm + cur * 36864) + 9216 + kh * 64;
    f32x4 s4[2][4];
    {
      bf16x8 kf[4][2];
#pragma unroll
      for (int jn = 0; jn < 4; ++jn)
#pragma unroll
        for (int s = 0; s < 2; ++s) kf[jn][s] = *(const bf16x8*)(Ks + (jn * 16 + c15) * 72 + s * 32 + q * 8);
      __builtin_amdgcn_sched_barrier(0);
#pragma unroll
      for (int jn = 0; jn < 4; ++jn)
#pragma unroll
        for (int t = 0; t < 2; ++t) s4[t][jn] = mfma16(kf[jn][0], qf[t][0], f32x4{0.f, 0.f, 0.f, 0.f});
#pragma unroll
      for (int jn = 0; jn < 4; ++jn)
#pragma unroll
        for (int t = 0; t < 2; ++t) s4[t][jn] = mfma16(kf[jn][1], qf[t][1], s4[t][jn]);
      __builtin_amdgcn_sched_barrier(0);
    }
    U8 vf[4][2];
#pragma unroll
    for (int jn = 0; jn < 4; ++jn)
#pragma unroll
      for (int ks = 0; ks < 2; ++ks) vf[jn][ks].u = *(const uint4*)(Vs + (jn * 16 + c15) * 136 + ks * 32 + q * 8);
    __builtin_amdgcn_sched_barrier(0);
    U8 pb[2][2];
#pragma unroll
    for (int t = 0; t < 2; ++t) {
      float mx = s4[t][0][0];
#pragma unroll
      for (int jn = 0; jn < 4; ++jn)
#pragma unroll
        for (int r = 0; r < 4; ++r) mx = fmaxf(mx, s4[t][jn][r]);
      mx = fmaxf(mx, __shfl_xor(mx, 16)); mx = fmaxf(mx, __shfl_xor(mx, 32));
      const float mnew = fmaxf(mrow[t], mx);
      const float alpha = __builtin_amdgcn_exp2f(mrow[t] - mnew);
      mrow[t] = mnew;
      float ls = 0.f;
#pragma unroll
      for (int jn = 0; jn < 4; ++jn)
#pragma unroll
        for (int r = 0; r < 4; ++r) { const float pv = __builtin_amdgcn_exp2f(s4[t][jn][r] - mnew); s4[t][jn][r] = pv; ls += pv; }
      lrow[t] = lrow[t] * alpha + ls;
#pragma unroll
      for (int jn = 0; jn < 4; ++jn) { o[t][jn][0] *= alpha; o[t][jn][1] *= alpha; o[t][jn][2] *= alpha; o[t][jn][3] *= alpha; }
#pragma unroll
      for (int ks = 0; ks < 2; ++ks) {
        pb[t][ks].w[0] = pack2(s4[t][2 * ks][0], s4[t][2 * ks][1]); pb[t][ks].w[1] = pack2(s4[t][2 * ks][2], s4[t][2 * ks][3]);
        pb[t][ks].w[2] = pack2(s4[t][2 * ks + 1][0], s4[t][2 * ks + 1][1]); pb[t][ks].w[3] = pack2(s4[t][2 * ks + 1][2], s4[t][2 * ks + 1][3]);
      }
    }
#pragma unroll
    for (int ks = 0; ks < 2; ++ks)
#pragma unroll
      for (int jn = 0; jn < 4; ++jn)
#pragma unroll
        for (int t = 0; t < 2; ++t) o[t][jn] = mfma16(vf[jn][ks].v, pb[t][ks].v, o[t][jn]);
    if (kt + 1 < nkt) {
      ATT_STORE(cur ^ 1);
      if (kt + 2 < nkt) ATT_LOAD(kt + 2);
    }
    __syncthreads();
  }
#undef ATT_LOAD
#undef ATT_STORE
  float* mrg = (float*)(sm + 73728) + (size_t)(qg * 64 + lane) * 37;
  float lt[2];
#pragma unroll
  for (int t = 0; t < 2; ++t) { float a = lrow[t]; a += __shfl_xor(a, 16); a += __shfl_xor(a, 32); lt[t] = a; }
  if (kh == 1) {
#pragma unroll
    for (int t = 0; t < 2; ++t) {
      mrg[t * 18 + 0] = mrow[t]; mrg[t * 18 + 1] = lt[t];
#pragma unroll
      for (int jn = 0; jn < 4; ++jn)
#pragma unroll
        for (int r = 0; r < 4; ++r) mrg[t * 18 + 2 + jn * 4 + r] = o[t][jn][r];
    }
  }
  __syncthreads();
  if (kh == 0) {
#pragma unroll
    for (int t = 0; t < 2; ++t) {
      const float m1 = mrg[t * 18 + 0], l1 = mrg[t * 18 + 1];
      const float mm = fmaxf(mrow[t], m1);
      const float a0 = __builtin_amdgcn_exp2f(mrow[t] - mm), a1 = __builtin_amdgcn_exp2f(m1 - mm);
      const float inv = 1.f / (a0 * lt[t] + a1 * l1);
      const float c0 = a0 * inv, c1 = a1 * inv;
      bf16_t* orow = p.abuf + (size_t)(mq + t * 16 + c15) * 1024 + h * 64 + q * 4;
#pragma unroll
      for (int jn = 0; jn < 4; ++jn) {
        const float x0 = c0 * o[t][jn][0] + c1 * mrg[t * 18 + 2 + jn * 4 + 0], x1 = c0 * o[t][jn][1] + c1 * mrg[t * 18 + 2 + jn * 4 + 1];
        const float x2 = c0 * o[t][jn][2] + c1 * mrg[t * 18 + 2 + jn * 4 + 2], x3 = c0 * o[t][jn][3] + c1 * mrg[t * 18 + 2 + jn * 4 + 3];
        uint2 ov; ov.x = pack2(x0, x1); ov.y = pack2(x2, x3);
        *(uint2*)(orow + jn * 16) = ov;
      }
    }
  }
  __syncthreads();
}

DEV void gmlp_item(const Params& p, int l, int it, char* smem) {
  const int tid = VTID, lane = tid & 63, w = tid >> 6, q = lane >> 4, c15 = lane & 15;
  const int chunk = it >> 2, g = it & 3, m0 = chunk * 128;
  bf16_t* vt = (bf16_t*)smem;
  const float* wsg = p.mlp_ws + (size_t)(l * 4 + g) * 16384;
  float4 wa[2][4][2];
#pragma unroll
  for (int nt = 0; nt < 2; ++nt)
#pragma unroll
    for (int s = 0; s < 4; ++s) {
      const float* ap = wsg + ((2 * w + nt) * 16 + c15) * 128 + s * 32 + q * 8;
      wa[nt][s][0] = *(const float4*)ap; wa[nt][s][1] = *(const float4*)(ap + 4);
    }
  uint4 vin[4];
#pragma unroll
  for (int i = 0; i < 4; ++i) { const int id = tid + 256 * i; vin[i] = *(const uint4*)(p.zf + (size_t)(m0 + (id >> 3)) * 1792 + 1536 + g * 64 + (id & 7) * 8); }
#pragma unroll
  for (int i = 0; i < 4; ++i) {
    const int id = tid + 256 * i, qq = id >> 3, cc = id & 7;
    U8 v; v.u = vin[i];
#pragma unroll
    for (int j = 0; j < 8; ++j) vt[(cc * 8 + j) * 136 + qq] = v.h[j];
  }
  __syncthreads();
  f32x4 acc[4][2];
#pragma unroll
  for (int mt = 0; mt < 4; ++mt)
#pragma unroll
    for (int nt = 0; nt < 2; ++nt) acc[mt][nt] = f32x4{0.f, 0.f, 0.f, 0.f};
#pragma unroll
  for (int s = 0; s < 4; ++s) {
    bf16x8 af[4];
#pragma unroll
    for (int mt = 0; mt < 4; ++mt) af[mt] = *(const bf16x8*)(vt + (mt * 16 + c15) * 136 + s * 32 + q * 8);
#pragma unroll
    for (int nt = 0; nt < 2; ++nt) {
      U8 bb;
      bb.w[0] = pack2(wa[nt][s][0].x, wa[nt][s][0].y); bb.w[1] = pack2(wa[nt][s][0].z, wa[nt][s][0].w);
      bb.w[2] = pack2(wa[nt][s][1].x, wa[nt][s][1].y); bb.w[3] = pack2(wa[nt][s][1].z, wa[nt][s][1].w);
#pragma unroll
      for (int mt = 0; mt < 4; ++mt) acc[mt][nt] = mfma16(af[mt], bb.v, acc[mt][nt]);
    }
  }
#pragma unroll
  for (int nt = 0; nt < 2; ++nt) {
    const int pp = (2 * w + nt) * 16 + c15;
    const size_t m = m0 + pp;
    const float bsv = p.mlp_bs[(l * 4 + g) * 128 + pp];
#pragma unroll
    for (int mt = 0; mt < 4; ++mt) {
      const int c = mt * 16 + q * 4;
      const uint2 uu = *(const uint2*)(p.zf + m * 1792 + 1280 + g * 64 + c);
      const float u0 = gelu_t(__uint_as_float(uu.x << 16)), u1 = gelu_t(__uint_as_float(uu.x & 0xffff0000u)), u2 = gelu_t(__uint_as_float(uu.y << 16)), u3 = gelu_t(__uint_as_float(uu.y & 0xffff0000u));
      uint2 o; o.x = pack2(u0 * (acc[mt][nt][0] + bsv), u1 * (acc[mt][nt][1] + bsv)); o.y = pack2(u2 * (acc[mt][nt][2] + bsv), u3 * (acc[mt][nt][3] + bsv));
      *(uint2*)(p.abuf + m * 1024 + 768 + g * 64 + c) = o;
    }
  }
  __syncthreads();
}

DEV void lru_apply_item(const Params& p, int l, int ti2) {
  const int C = VTID;
  const int ti = ti2 >> 1, th = (ti2 & 1) * 32;
  const int m0 = ti * 64;
  int ms, L, b; bool lat = m0 >= 8192;
  if (!lat) { ms = m0 & ~255; L = 256; b = m0 >> 8; } else { ms = 8192 + ((m0 - 8192) & ~1023); L = 1024; b = (m0 - 8192) >> 10; }
  const int k = (m0 - ms) >> 6, nt = L >> 6;
  const float* PCf = p.au; const float* HLf = p.au + (size_t)MT * 256;
  const float* PCb = p.au + (size_t)2 * MT * 256; const float* HLb = p.au + (size_t)3 * MT * 256;
  float cf = lat ? p.state_lru[((size_t)(b * 2 + l) * 2 + 0) * 256 + C] : 0.f;
  float cb = lat ? p.state_lru[((size_t)(b * 2 + l) * 2 + 1) * 256 + C] : 0.f;
  {
    float pc[15], hl[15];
#pragma unroll
    for (int i = 0; i < 15; ++i) {
      const bool act = i < k;
      const size_t e = (size_t)(ms + 64 * i + 63) * 256 + C;
      pc[i] = act ? PCf[e] : 1.f; hl[i] = act ? HLf[e] : 0.f;
    }
#pragma unroll
    for (int i = 0; i < 15; ++i) cf = pc[i] * cf + hl[i];
  }
  {
    float pc[15], hl[15];
#pragma unroll
    for (int i = 0; i < 15; ++i) {
      const int tix = nt - 1 - i;
      const bool act = tix > k;
      const size_t e = (size_t)(ms + 64 * tix) * 256 + C;
      pc[i] = act ? PCb[e] : 1.f; hl[i] = act ? HLb[e] : 0.f;
    }
#pragma unroll
    for (int i = 0; i < 15; ++i) cb = pc[i] * cb + hl[i];
  }
  float hf_last = 0.f, hb_first = 0.f;
#pragma unroll 16
  for (int t = th; t < th + 32; ++t) {
    const size_t m = m0 + t;
    const float hf = PCf[m * 256 + C] * cf + HLf[m * 256 + C];
    const float hb = PCb[m * 256 + C] * cb + HLb[m * 256 + C];
    const float g = gelu_t(bf2f(p.zf[m * 1792 + 1024 + C]));
    p.abuf[m * 1024 + 512 + C] = f2bf((hf + hb) * g);
    if (t == 0) hb_first = hb;
    if (t == 63) hf_last = hf;
  }
  if (!lat) {
    if (k == nt - 1 && th == 32) p.out[OFF_ST + ((size_t)(b * 2 + l) * 2 + 0) * 256 + C] = hf_last;
    if (k == 0 && th == 0) p.out[OFF_ST + ((size_t)(b * 2 + l) * 2 + 1) * 256 + C] = hb_first;
  }
}

DEV void mixer_phase(const Params& p, int l, char* smem_raw, char* smem) {
  {
    const int x = blockIdx.x & 7, j = blockIdx.x >> 3;
#pragma unroll 1
    for (int k = 0; k < 4; ++k) attn_item(p, l, ((k >> 1) << 9) + 64 * x + j + 32 * (k & 1), smem_raw);
  }
  {
    const int x = blockIdx.x & 7, lh = (blockIdx.x >> 3) * 2 + (threadIdx.x >> 8);
    lru_apply_item(p, l, (own_row(x, (lh >> 1) * 64) >> 6) * 2 + (lh & 1));
    gmlp_item(p, l, (own_row(x, (lh >> 2) * 128) >> 7) * 4 + (lh & 3), smem);
  }
}

DEV void prep_phase_full(const Params& p, int l, char* smem) {
  {
    const int xcd = blockIdx.x & 7, lh = (blockIdx.x >> 3) * 2 + (threadIdx.x >> 8);
#pragma unroll 1
    for (int k = 0; k < 2; ++k) { const int li = lh + 64 * k; lru_gate_item(p, l, (own_row(xcd, (li >> 2) * 64) >> 6) * 4 + (li & 3), smem); }
  }
  const int lane = threadIdx.x & 63, mstride = gridDim.x * 8;
  int vm = blockIdx.x * 8 + (threadIdx.x >> 6);
  const int coff = lane < 32 ? 512 + lane * 8 : 1536 + (lane - 32) * 8;
  uint4 n1 = *(const uint4*)(p.zf + (size_t)xrow(vm) * 1792 + coff);
  uint4 n2 = *(const uint4*)(p.zf + (size_t)xrow((vm + mstride < MT) ? vm + mstride : vm) * 1792 + coff);
  for (; vm < MT; vm += mstride) {
    const uint4 c = n1; n1 = n2;
    const int mn = xrow((vm + 2 * mstride < MT) ? vm + 2 * mstride : vm);
    n2 = *(const uint4*)(p.zf + (size_t)mn * 1792 + coff);
    prep_token_row(p, l, xrow(vm), lane, c);
  }
}


#define XB_TMO      128
#define XB_XCNT(j)  (256  + 64 * (j))
#define XB_XSUB(j)  (1280 + 64 * (j))
#define XB_XGEN(j)  (2304 + 64 * (j))
#define XB_TOP      3328
#define XB_TOPGEN   3392
#define XCD_BAR_WORDS 3456
#define XB_SPIN_CAP (1u << 18)
#define LAS __attribute__((address_space(3)))
DEV unsigned xb_ld(unsigned* p) { return __hip_atomic_load(p, __ATOMIC_RELAXED, __HIP_MEMORY_SCOPE_AGENT); }
DEV unsigned xb_add(unsigned* p, unsigned v) { return __hip_atomic_fetch_add(p, v, __ATOMIC_RELAXED, __HIP_MEMORY_SCOPE_AGENT); }
DEV unsigned xb_xcc_id() { return (unsigned)__builtin_amdgcn_s_getreg((3 << 11) | 20) & 0xFu; }
#define XB_SPIN(cond, bar) do { unsigned _sp = 0; while (cond) { __builtin_amdgcn_s_sleep(1); \
    if ((++_sp & 255u) == 0u) { if (xb_ld(&(bar)[XB_TMO])) break; if (_sp > XB_SPIN_CAP) { atomicAdd(&(bar)[XB_TMO], 1u); break; } } } } while (0)
struct XcdBarrier { unsigned* bar; unsigned x; volatile LAS unsigned* st; };
DEV XcdBarrier xcd_barrier_post(unsigned* bar, volatile LAS unsigned* st) {
  XcdBarrier b; b.bar = bar; b.x = xb_xcc_id(); b.st = st;
  if (threadIdx.x == 0) (void)xb_add(&bar[XB_XCNT(b.x)], 1u);
  return b;
}
DEV void xcd_barrier_complete(unsigned* bar, unsigned x, unsigned& nloc, unsigned& nx) {
  const unsigned G = gridDim.x * gridDim.y * gridDim.z;
  unsigned sum, cnt, mine, sp = 0u;
  for (;;) {
    sum = 0u; cnt = 0u; mine = 0u;
#pragma unroll
    for (unsigned j = 0; j < 16; ++j) { const unsigned c = xb_ld(&bar[XB_XCNT(j)]); sum += c; cnt += (c > 0u) ? 1u : 0u; mine = (j == x) ? c : mine; }
    if (sum == G) break;
    __builtin_amdgcn_s_sleep(1);
    if ((++sp & 255u) == 0u) { if (xb_ld(&bar[XB_TMO])) break; if (sp > XB_SPIN_CAP) { atomicAdd(&bar[XB_TMO], 1u); break; } }
  }
  nloc = mine > 0u ? mine : 1u; nx = cnt > 0u ? cnt : 1u;
}
DEV void xcd_barrier(const XcdBarrier& b) {
  asm volatile("s_waitcnt vmcnt(0)" ::: "memory");
  __syncthreads();
  if (threadIdx.x == 0) {
    unsigned* bar = b.bar;
    __builtin_amdgcn_s_waitcnt(0);
    unsigned nloc = b.st[0], nx = b.st[1];
    if (nloc == 0u) { xcd_barrier_complete(bar, b.x, nloc, nx); b.st[0] = nloc; b.st[1] = nx; }
    const unsigned old = xb_add(&bar[XB_XSUB(b.x)], 1u);
    const unsigned gen = old / nloc;
    if (old + 1u == (gen + 1u) * nloc) {
      __builtin_amdgcn_fence(__ATOMIC_RELEASE, "agent");
      asm volatile("s_waitcnt vmcnt(0)" ::: "memory");
      const unsigned og = xb_add(&bar[XB_TOP], 1u);
      const unsigned tg = og / nx;
      if (og + 1u == (tg + 1u) * nx) xb_add(&bar[XB_TOPGEN], 1u);
      else XB_SPIN(xb_ld(&bar[XB_TOPGEN]) == tg, bar);
      __builtin_amdgcn_fence(__ATOMIC_ACQUIRE, "agent");
      xb_add(&bar[XB_XGEN(b.x)], 1u);
      asm volatile("s_waitcnt vmcnt(0)" ::: "memory");
    } else {
      XB_SPIN(xb_ld(&bar[XB_XGEN(b.x)]) == gen, bar);
      __builtin_amdgcn_fence(__ATOMIC_ACQUIRE, "agent");
      asm volatile("s_waitcnt vmcnt(0)" ::: "memory");
    }
  }
  __syncthreads();
}

#define PH(i, call) if (ph_lo <= (i) && (i) < ph_hi) { if ((i) > ph_lo) xcd_barrier(xb); call; }
#define LAYER(l, b) \
  PH(b + 0, ln_mod_phase(p, l, l == 0 ? 0 : 1)) \
  PH(b + 1, gemm_phase<1>(p, l, p.abuf, p.wt_in + (size_t)l * 1792 * 1024, 1792, 1024, (LAS3 unsigned char*)smem_raw)) \
  PH(b + 2, prep_phase_full(p, l, smem)) \
  PH(b + 3, mixer_phase(p, l, smem_raw, smem)) \
  PH(b + 4, gemm_phase<2>(p, l, p.abuf, p.wt_out + (size_t)l * 1024 * 1024, 1024, 1024, (LAS3 unsigned char*)smem_raw)) \
  PH(b + 5, ln_mod_phase(p, l, 2)) \
  PH(b + 6, gemm_phase<3>(p, l, p.abuf, p.wt_ff1 + (size_t)l * 4096 * 1024, 4096, 1024, (LAS3 unsigned char*)smem_raw)) \
  PH(b + 7, gemm_phase<4>(p, l, p.zf, p.wt_ff2 + (size_t)l * 1024 * 4096, 1024, 4096, (LAS3 unsigned char*)smem_raw))

__global__ void __launch_bounds__(512, 2) mega_kernel(Params p, int ph_lo, int ph_hi) {
  extern __shared__ __attribute__((aligned(16))) char smem_raw[];
  char* smem = smem_raw + (threadIdx.x >> 8) * 65536;
  __shared__ uint4 xb_words;
  if (threadIdx.x == 0) xb_words = make_uint4(0u, 0u, 0u, 0u);
  __syncthreads();
  XcdBarrier xb = xcd_barrier_post(p.bar, (volatile LAS unsigned*)&xb_words);
  if (ph_hi > 1000) { cg::grid_group grid = cg::this_grid(); grid.sync(); }
  PH(0, phase0(p, smem))
  LAYER(0, 1)
  LAYER(1, 9)
  PH(17, ln_mod_phase(p, 1, 3))
}

extern "C" void kernel_launch(void* const* d_in, const int* in_sizes, int n_in, void* d_out, int out_size, void* d_ws, size_t ws_size,
                              hipStream_t stream) {
  static int grid_blocks = 0;
  if (!grid_blocks) {
    int dev = 0, cus = 0, per_cu = 0;
    hipGetDevice(&dev);
    hipDeviceGetAttribute(&cus, hipDeviceAttributeMultiprocessorCount, dev);
    hipFuncSetAttribute((const void*)mega_kernel, hipFuncAttributeMaxDynamicSharedMemorySize, SMEM_BYTES);
    hipOccupancyMaxActiveBlocksPerMultiprocessor(&per_cu, (const void*)mega_kernel, 512, SMEM_BYTES);
    if (per_cu < 1) per_cu = 1;
    if (per_cu > 1) per_cu = 1;
    grid_blocks = cus * per_cu;
  }
  Params p{};
  const float** pin = (const float**)&p;
  for (int i = 0; i < 32; ++i) pin[i] = (const float*)d_in[i];
  p.out = (float*)d_out;
  char* ws = (char*)d_ws;
  size_t off = 0;
  p.bar = (unsigned*)(ws + off); off += 16384;
  p.rstat = (float*)(ws + off); off += (size_t)MT * 2 * 4;
  p.kb_lat = (bf16_t*)(ws + off); off += (size_t)2 * 8 * 2 * 1280 * 64 * 2;
  p.vt_lat = (bf16_t*)(ws + off); off += (size_t)2 * 8 * 2 * 1280 * 64 * 2;
  p.kb_ctx = (bf16_t*)(ws + off); off += (size_t)32 * 2 * 256 * 64 * 2;
  p.vt_ctx = (bf16_t*)(ws + off); off += (size_t)32 * 2 * 256 * 64 * 2;
  p.wt_in = (bf16_t*)(ws + off); off += (size_t)2 * 1792 * 1024 * 2;
  p.wt_out = (bf16_t*)(ws + off); off += (size_t)2 * 1024 * 1024 * 2;
  p.wt_ff1 = (bf16_t*)(ws + off); off += (size_t)2 * 4096 * 1024 * 2;
  p.wt_ff2 = (bf16_t*)(ws + off); off += (size_t)2 * 4096 * 1024 * 2;
  p.wt_lru = (bf16_t*)(ws + off); off += (size_t)64 * 4096 * 2;
  p.mod = (float*)(ws + off); off += (size_t)2 * 9 * 6144 * 4;
  p.rope = (float*)(ws + off); off += (size_t)2048 * 4;
  p.cdec = (float*)(ws + off); off += (size_t)1024 * 4;
  p.abuf = (bf16_t*)(ws + off); off += (size_t)MT * 1024 * 2;
  p.zf = (bf16_t*)(ws + off);
  p.au = (float*)(ws + off + (size_t)MT * 1792 * 2);
  off += (size_t)MT * 4096 * 2;
  if (off > ws_size) { fprintf(stderr, "workspace too small: need %zu have %zu\n", off, ws_size); return; }
  (void)hipMemsetAsync(p.bar, 0, XCD_BAR_WORDS * 4, stream);
#if MULTI_LAUNCH
  for (int ph = 0; ph < NPHASE; ++ph) {
    hipLaunchKernelGGL(mega_kernel, dim3(grid_blocks), dim3(512), SMEM_BYTES, stream, p, ph, ph + 1);
  }
#else
  int lo = 0, hi = NPHASE;
  void* args[] = {&p, &lo, &hi};
  hipError_t e = hipLaunchCooperativeKernel((void*)mega_kernel, dim3(grid_blocks), dim3(512), args, SMEM_BYTES, stream);
  if (e != hipSuccess) fprintf(stderr, "cooperative launch failed: %s (grid %d)\n", hipGetErrorString(e), grid_blocks);
#endif
}
```

```cpp
#include <hip/hip_runtime.h>
#include <hip/hip_cooperative_groups.h>
#include <cstdio>
#include <cstdint>
namespace cg = cooperative_groups;

#ifndef MULTI_LAUNCH
#define MULTI_LAUNCH 0
#endif

typedef unsigned short bf16_t;
using bf16x8 = __attribute__((ext_vector_type(8))) short;
using f32x4 = __attribute__((ext_vector_type(4))) float;
#define DEV __device__ __forceinline__
#define VTID ((int)(threadIdx.x & 255))
#define VBID ((int)(blockIdx.x * 2 + (threadIdx.x >> 8)))
#define VNB ((int)(gridDim.x * 2))

constexpr int MT = 16384;
constexpr int NPHASE = 18;
constexpr size_t OFF_YK = 16777216, OFF_YV = OFF_YK + 2097152, OFF_ST = OFF_YV + 2097152;
constexpr float ALPHA = 1.41421356237f;
constexpr float QSCALE = 0.125f * 1.4426950408889634f;
constexpr int SMEM_BYTES = 131072;

struct Params {
  const float *x_prompt, *x_sample, *c, *cache_k, *cache_v, *state_lru, *c_ctx, *w_ada, *b_ada, *w_in,
      *q_g, *k_g, *conv_w, *conv_b, *lru_wa, *lru_ba, *lru_wx, *lru_bx, *lru_lam, *mlp_g, *mlp_b, *mlp_ws, *mlp_bs,
      *w_out, *ln1_g, *ln1_b, *w_ff1, *b_ff1, *w_ff2, *b_ff2, *ln2_g, *ln2_b;
  float* out;
  bf16_t *wt_in, *wt_out, *wt_ff1, *wt_ff2, *wt_lru;
  float *mod, *rope, *cdec;
  bf16_t *abuf;
  bf16_t *zf;
  float *au;
  bf16_t *kb_lat, *vt_lat;
  bf16_t *kb_ctx, *vt_ctx;
  unsigned *bar;
  float *rstat;
};

union U8 { uint4 u; bf16x8 v; bf16_t h[8]; unsigned w[4]; };

DEV float bf2f(bf16_t h) { return __uint_as_float(((unsigned)h) << 16); }
DEV bf16_t f2bf(float f) { unsigned u = __float_as_uint(f); u += 0x7fffu + ((u >> 16) & 1u); return (bf16_t)(u >> 16); }
DEV unsigned pack2(float a, float b) { unsigned r; asm volatile("v_cvt_pk_bf16_f32 %0, %1, %2" : "=v"(r) : "v"(a), "v"(b)); return r; }
DEV float gelu_t(float x) { float y = 0.7978845608028654f * (x + 0.044715f * x * x * x); float t = 1.f - 2.f * __builtin_amdgcn_rcpf(1.f + __expf(2.f * y)); return 0.5f * x * (1.f + t); }
DEV float sigmoidf_(float x) { return __builtin_amdgcn_rcpf(1.f + __expf(-x)); }
DEV int own_row(int x, int r) { return r < 1024 ? (x << 10) + r : 8192 + (x << 10) + (r - 1024); }
DEV int own_panel(int vp) { const int x = vp >> 3, lp = vp & 7; return lp < 4 ? 4 * x + lp : 32 + 4 * x + (lp - 4); }
DEV int xrow(int vm) { const int k = vm >> 11, c = (vm & 2047) >> 3, w = vm & 7; return own_row(c & 7, (k << 8) + ((c >> 3) << 3) + w); }
DEV int cond_of(int m) { return m < 8192 ? 0 : 1 + ((m - 8192) >> 10); }
DEV f32x4 mfma16(bf16x8 a, bf16x8 b, f32x4 c) { return __builtin_amdgcn_mfma_f32_16x16x32_bf16(a, b, c, 0, 0, 0); }
DEV float wave_sum(float v) {
#pragma unroll
  for (int o = 32; o >= 1; o >>= 1) v += __shfl_xor(v, o);
  return v;
}

DEV void transpose_tile(const float* __restrict__ src, bf16_t* __restrict__ dst, int lds_, int ldd, char* smem) {
  float* T = (float*)smem;
  const int tid = VTID;
#pragma unroll
  for (int i = 0; i < 4; ++i) {
    int k = (tid >> 4) + 16 * i, n4 = (tid & 15) * 4;
    float4 v = *(const float4*)(src + (size_t)k * lds_ + n4);
    T[k * 65 + n4 + 0] = v.x; T[k * 65 + n4 + 1] = v.y; T[k * 65 + n4 + 2] = v.z; T[k * 65 + n4 + 3] = v.w;
  }
  __syncthreads();
#pragma unroll
  for (int i = 0; i < 2; ++i) {
    int n = (tid >> 3) + 32 * i, k8 = (tid & 7) * 8;
    U8 o;
#pragma unroll
    for (int j = 0; j < 4; ++j) o.w[j] = pack2(T[(k8 + 2 * j) * 65 + n], T[(k8 + 2 * j + 1) * 65 + n]);
    *(uint4*)(dst + (size_t)n * ldd + k8) = o.u;
  }
  __syncthreads();
}
DEV void transpose_w(const float* __restrict__ W, bf16_t* __restrict__ Wt, int K, int N, int tk, int tn, char* smem) {
  transpose_tile(W + (size_t)(tk * 64) * N + tn * 64, Wt + (size_t)(tn * 64) * K + tk * 64, N, K, smem);
}

DEV void tr_desc(const Params& p, int t, const float*& src, int& lds_, bf16_t*& dst, int& ldd) {
  if (t < 2 * 2768) {
    const int l = t / 2768, r = t % 2768;
    const float* W; bf16_t* Wt; int K, N, tk, tn;
    if (r < 448) { W = p.w_in + (size_t)l * 1024 * 1792; Wt = p.wt_in + (size_t)l * 1792 * 1024; K = 1024; N = 1792; tk = r / 28; tn = r % 28; }
    else if (r < 704) { const int i = r - 448; W = p.w_out + (size_t)l * 1024 * 1024; Wt = p.wt_out + (size_t)l * 1024 * 1024; K = 1024; N = 1024; tk = i / 16; tn = i % 16; }
    else if (r < 1728) { const int i = r - 704; W = p.w_ff1 + (size_t)l * 1024 * 4096; Wt = p.wt_ff1 + (size_t)l * 4096 * 1024; K = 1024; N = 4096; tk = i / 64; tn = i % 64; }
    else if (r < 2752) { const int i = r - 1728; W = p.w_ff2 + (size_t)l * 4096 * 1024; Wt = p.wt_ff2 + (size_t)l * 1024 * 4096; K = 4096; N = 1024; tk = i / 16; tn = i % 16; }
    else {
      const int idx = r - 2752, dir = idx >> 3, blk = (idx >> 1) & 3, mat = idx & 1;
      src = (mat == 0 ? p.lru_wa : p.lru_wx) + (size_t)(((l * 2 + dir) * 4 + blk)) * 4096; lds_ = 64;
      dst = p.wt_lru + (size_t)((((l * 2 + dir) * 4 + blk) * 2 + mat)) * 4096; ldd = 64; return;
    }
    src = W + (size_t)(tk * 64) * N + tn * 64; lds_ = N; dst = Wt + (size_t)(tn * 64) * K + tk * 64; ldd = K;
  } else {
    const int j = t - 2 * 2768, tt = j & 3, kvh = (j >> 2) & 1, l = (j >> 3) & 1, b = j >> 4;
    src = p.cache_v + ((size_t)(b * 2 + l) * 256 + tt * 64) * 128 + kvh * 64; lds_ = 128;
    dst = p.vt_lat + ((size_t)((l * 8 + b) * 2 + kvh) * 64) * 1280 + tt * 64; ldd = 1280;
  }
}

DEV void transpose_all(const Params& p, char* smem) {
  constexpr int NTR = 2 * 2768 + 128;
  float* T = (float*)smem;
  const int tid = VTID, kr = tid >> 4, n4 = (tid & 15) * 4;
  int t = VBID;
  if (t >= NTR) return;
  const float* src; bf16_t* dst; int lds_, ldd;
  tr_desc(p, t, src, lds_, dst, ldd);
  float4 cur[4];
#pragma unroll
  for (int i = 0; i < 4; ++i) cur[i] = *(const float4*)(src + (size_t)(kr + 16 * i) * lds_ + n4);
  while (t < NTR) {
    const int tn = t + VNB;
    const float* nsrc = src; bf16_t* ndst = dst; int nlds = lds_, nldd = ldd;
    float4 nxt[4];
    if (tn < NTR) {
      tr_desc(p, tn, nsrc, nlds, ndst, nldd);
#pragma unroll
      for (int i = 0; i < 4; ++i) nxt[i] = *(const float4*)(nsrc + (size_t)(kr + 16 * i) * nlds + n4);
    }
#pragma unroll
    for (int i = 0; i < 4; ++i) {
      const int k = kr + 16 * i;
      T[k * 65 + n4 + 0] = cur[i].x; T[k * 65 + n4 + 1] = cur[i].y; T[k * 65 + n4 + 2] = cur[i].z; T[k * 65 + n4 + 3] = cur[i].w;
    }
    __syncthreads();
#pragma unroll
    for (int i = 0; i < 2; ++i) {
      const int n = (tid >> 3) + 32 * i, k8 = (tid & 7) * 8;
      U8 o;
#pragma unroll
      for (int j = 0; j < 4; ++j) o.w[j] = pack2(T[(k8 + 2 * j) * 65 + n], T[(k8 + 2 * j + 1) * 65 + n]);
      *(uint4*)(dst + (size_t)n * ldd + k8) = o.u;
    }
    __syncthreads();
    if (tn < NTR) {
#pragma unroll
      for (int i = 0; i < 4; ++i) cur[i] = nxt[i];
    }
    src = nsrc; dst = ndst; lds_ = nlds; ldd = nldd; t = tn;
  }
}

DEV void phase0(const Params& p, char* smem) {
  const int tid = VTID;
  const int NT0 = 192 - 128, NITEMS = 192 + 64 + 2;
  for (int it = VBID; it < NITEMS; it += VNB) {
    if (it < 192) {
      const int l = it / 96, n0 = (it % 96) * 64;
      float* s = (float*)smem;
      float* red = s + 9 * 1024;
      for (int idx = tid; idx < 9 * 1024; idx += 256) {
        int c = idx >> 10, k = idx & 1023;
        float v = (c == 0) ? p.c_ctx[k] : p.c[(c - 1) * 1024 + k];
        s[idx] = v / (1.f + __expf(-v));
      }
      __syncthreads();
      const int w = tid >> 6, lane = tid & 63, cq = lane & 15, ks = lane >> 4;
      const int kbase = (w * 4 + ks) * 64;
      float acc[9][4];
#pragma unroll
      for (int c = 0; c < 9; ++c) { acc[c][0] = 0.f; acc[c][1] = 0.f; acc[c][2] = 0.f; acc[c][3] = 0.f; }
      const float* wp = p.w_ada + ((size_t)l * 1024 + kbase) * 6144 + n0 + cq * 4;
      for (int kb = 0; kb < 64; kb += 16) {
        float4 wv[16];
#pragma unroll
        for (int j = 0; j < 16; ++j) wv[j] = *(const float4*)(wp + (size_t)(kb + j) * 6144);
#pragma unroll
        for (int j = 0; j < 16; ++j)
#pragma unroll
          for (int c = 0; c < 9; ++c) {
            const float sv = s[c * 1024 + kbase + kb + j];
            acc[c][0] += sv * wv[j].x; acc[c][1] += sv * wv[j].y; acc[c][2] += sv * wv[j].z; acc[c][3] += sv * wv[j].w;
          }
      }
#pragma unroll
      for (int c = 0; c < 9; ++c)
#pragma unroll
        for (int e = 0; e < 4; ++e) {
          float a = acc[c][e];
          a += __shfl_xor(a, 16); a += __shfl_xor(a, 32);
          if (ks == 0) red[(w * 9 + c) * 64 + cq * 4 + e] = a;
        }
      __syncthreads();
      for (int idx = tid; idx < 576; idx += 256) {
        int c = idx >> 6, nn = idx & 63;
        float v = red[(0 * 9 + c) * 64 + nn] + red[(1 * 9 + c) * 64 + nn] + red[(2 * 9 + c) * 64 + nn] + red[(3 * 9 + c) * 64 + nn] +
                  p.b_ada[l * 6144 + n0 + nn];
        p.mod[((size_t)l * 9 + c) * 6144 + n0 + nn] = v;
      }
      __syncthreads();
    } else if (it >= NT0 + 128 && it < NT0 + 192) {
      const int j = it - NT0 - 128;
#pragma unroll
      for (int i = 0; i < 4; ++i) {
        const int e = (j * 1024 + i * 256 + tid) * 8;
        const int d = e & 63, kvh = (e >> 6) & 1, t = (e >> 7) & 255, l = (e >> 15) & 1, b = e >> 16;
        const float4 a0 = *(const float4*)(p.cache_k + e), a1 = *(const float4*)(p.cache_k + e + 4);
        U8 o; o.w[0] = pack2(a0.x, a0.y); o.w[1] = pack2(a0.z, a0.w); o.w[2] = pack2(a1.x, a1.y); o.w[3] = pack2(a1.z, a1.w);
        *(uint4*)(p.kb_lat + ((size_t)((l * 8 + b) * 2 + kvh) * 1280 + t) * 64 + d) = o.u;
      }
    } else if (it >= NT0 + 192) {
      if (it == NT0 + 192)
      for (int idx = tid; idx < 1024; idx += 256) {
        int pp = idx >> 4, f = idx & 15;
        float inv = powf(10000.f, -(float)f / 16.f);
        float ang = (float)pp * inv;
        float nrev = rintf(ang * 0.15915494309189535f);
        float r = fmaf(-nrev, 6.28125f, ang);
        r = fmaf(-nrev, 0.0019353071795864769f, r);
        p.rope[idx * 2 + 0] = __cosf(r);
        p.rope[idx * 2 + 1] = __sinf(r);
      }
      if (it == NT0 + 192)
      for (int idx = tid; idx < 1024; idx += 256) {
        const float xn = -p.lru_lam[idx];
        p.cdec[idx] = -8.f * (fmaxf(xn, 0.f) + log1pf(expf(-fabsf(xn))));
      }
    }
  }
  transpose_all(p, smem);
}

DEV void ln_mod_phase(const Params& p, int l, int mode) {
  const int lane = threadIdx.x & 63, w = threadIdx.x >> 6;
  const float* lg = nullptr; const float* lb = nullptr;
  if (mode == 1) { lg = p.ln2_g + (l - 1) * 1024; lb = p.ln2_b + (l - 1) * 1024; }
  else if (mode == 2) { lg = p.ln1_g + l * 1024; lb = p.ln1_b + l * 1024; }
  else if (mode == 3) { lg = p.ln2_g + l * 1024; lb = p.ln2_b + l * 1024; }
  const int shoff = (mode == 2) ? 3072 : 0;
  const int mstride = gridDim.x * 8;
  float4 nv[4];
  {
    const int m = xrow(blockIdx.x * 8 + w);
    const float* src = (mode == 0) ? ((m < 8192) ? p.x_prompt + (size_t)m * 1024 : p.x_sample + (size_t)(m - 8192) * 1024) : p.out + (size_t)m * 1024;
#pragma unroll
    for (int i = 0; i < 4; ++i) nv[i] = *(const float4*)(src + i * 256 + lane * 4);
  }
  for (int vm = blockIdx.x * 8 + w; vm < MT; vm += mstride) {
    const int m = xrow(vm);
    float4 v[4];
#pragma unroll
    for (int i = 0; i < 4; ++i) v[i] = nv[i];
    {
      const int mn = xrow((vm + mstride < MT) ? vm + mstride : vm);
      const float* src = (mode == 0) ? ((mn < 8192) ? p.x_prompt + (size_t)mn * 1024 : p.x_sample + (size_t)(mn - 8192) * 1024) : p.out + (size_t)mn * 1024;
#pragma unroll
      for (int i = 0; i < 4; ++i) nv[i] = *(const float4*)(src + i * 256 + lane * 4);
    }
    if (mode != 0) {
      float s = 0.f;
#pragma unroll
      for (int i = 0; i < 4; ++i) s += v[i].x + v[i].y + v[i].z + v[i].w;
      const float mean = wave_sum(s) * (1.f / 1024.f);
      float s2 = 0.f;
#pragma unroll
      for (int i = 0; i < 4; ++i) { float a = v[i].x - mean, b = v[i].y - mean, c = v[i].z - mean, d = v[i].w - mean; s2 += a * a + b * b + c * c + d * d; }
      const float rstd = rsqrtf(wave_sum(s2) * (1.f / 1024.f) + 1e-6f);
#pragma unroll
      for (int i = 0; i < 4; ++i) {
        float4 g = *(const float4*)(lg + i * 256 + lane * 4), b = *(const float4*)(lb + i * 256 + lane * 4);
        v[i].x = (v[i].x - mean) * rstd * g.x + b.x; v[i].y = (v[i].y - mean) * rstd * g.y + b.y;
        v[i].z = (v[i].z - mean) * rstd * g.z + b.z; v[i].w = (v[i].w - mean) * rstd * g.w + b.w;
        if (mode == 3) *(float4*)(p.out + (size_t)m * 1024 + i * 256 + lane * 4) = v[i];
      }
      if (mode != 3 && lane == 0) *(float2*)(p.rstat + (size_t)m * 2) = make_float2(mean, rstd);
    }
    if (mode != 3) {
      const float* md = p.mod + ((size_t)l * 9 + cond_of(m)) * 6144 + shoff;
#pragma unroll
      for (int i = 0; i < 4; ++i) {
        float4 sh = *(const float4*)(md + i * 256 + lane * 4), sc = *(const float4*)(md + 1024 + i * 256 + lane * 4);
        uint2 o;
        o.x = pack2(v[i].x * (1.f + sc.x) + sh.x, v[i].y * (1.f + sc.y) + sh.y);
        o.y = pack2(v[i].z * (1.f + sc.z) + sh.z, v[i].w * (1.f + sc.w) + sh.w);
        *(uint2*)(p.abuf + (size_t)m * 1024 + i * 256 + lane * 4) = o;
      }
    }
  }
}

#define LAS3 __attribute__((address_space(3)))
namespace g8 {
constexpr int BM = 256, BK = 64, HALF = 128, HTB = HALF * BK * 2, NXCD = 8, WGM = 4;
DEV int lds_byte(int r, int c) { const int st = (r >> 4) * 2 + (c >> 5), rr = r & 15, cc = c & 31, ob = rr * 64 + cc * 2; return st * 1024 + (ob ^ (((ob >> 9) & 1) << 5)); }
DEV void stage_rc(int b, int& R, int& C) { const int st = b / 1024, sb = b % 1024, swz = sb ^ (((sb >> 9) & 1) << 5); R = (st >> 1) * 16 + swz / 64; C = (st & 1) * 32 + (swz % 64) / 2; }
DEV bool unit_of(int i, int nM, int nN, int& pm, int& pn) {
  const int nwg = nM * nN;
  const long L = (long)i * gridDim.x + blockIdx.x; if (L >= nwg) return false;
  int wgid = (int)L; { const int q = nwg / NXCD, r = nwg % NXCD, xcd = wgid % NXCD, off = wgid / NXCD; wgid = (xcd < r ? xcd * (q + 1) : r * (q + 1) + (xcd - r) * q) + off; }
  const int nig = WGM * nN, gid = wgid / nig, fm = gid * WGM, gsz = (nM - fm) < WGM ? (nM - fm) : WGM;
  pm = own_panel(fm + ((wgid % nig) % gsz)); pn = (wgid % nig) / gsz; return true;
}
}

template <int EPI>
DEV void gemm_epilogue(const Params& p, int l, f32x4 (&acc)[2][2][4][2], int pm, int pn, int wr, int wc, int fr, int fq) {
  const int brow = pm * 256, bcol = pn * 256;
  const float* md = p.mod + ((size_t)l * 9 + cond_of(brow)) * 6144;
#pragma unroll
  for (int bj = 0; bj < 2; ++bj)
#pragma unroll
    for (int n = 0; n < 2; ++n) {
      const int col = bcol + bj * 128 + wc * 32 + n * 16 + fq * 4;
      float4 gate = make_float4(0.f, 0.f, 0.f, 0.f), bias = make_float4(0.f, 0.f, 0.f, 0.f);
      if (EPI == 2) gate = *(const float4*)(md + 2048 + col);
      if (EPI == 3) bias = *(const float4*)(p.b_ff1 + l * 4096 + col);
      if (EPI == 4) { gate = *(const float4*)(md + 5120 + col); bias = *(const float4*)(p.b_ff2 + l * 1024 + col); }
#pragma unroll
      for (int ai = 0; ai < 2; ++ai)
#pragma unroll
        for (int m = 0; m < 4; ++m) {
          const int row = brow + ai * 128 + wr * 64 + m * 16 + fr;
          const f32x4 v = acc[ai][bj][m][n];
          if (EPI == 1) {
            uint2 o; o.x = pack2(v[0], v[1]); o.y = pack2(v[2], v[3]);
            *(uint2*)(p.zf + (size_t)row * 1792 + col) = o;
          } else if (EPI == 2) {
            const float* xs = (l == 0) ? ((row < 8192) ? p.x_prompt + (size_t)row * 1024 : p.x_sample + (size_t)(row - 8192) * 1024) : p.out + (size_t)row * 1024;
            const float4 x = *(const float4*)(xs + col);
            *(float4*)(p.out + (size_t)row * 1024 + col) = make_float4(ALPHA * x.x + gate.x * v[0], ALPHA * x.y + gate.y * v[1], ALPHA * x.z + gate.z * v[2], ALPHA * x.w + gate.w * v[3]);
          } else if (EPI == 3) {
            const float t0 = fmaxf(v[0] + bias.x, 0.f), t1 = fmaxf(v[1] + bias.y, 0.f), t2 = fmaxf(v[2] + bias.z, 0.f), t3 = fmaxf(v[3] + bias.w, 0.f);
            uint2 o; o.x = pack2(t0 * t0, t1 * t1); o.y = pack2(t2 * t2, t3 * t3);
            *(uint2*)(p.zf + (size_t)row * 4096 + col) = o;
          } else {
            float* xo = p.out + (size_t)row * 1024 + col;
            const float4 x = *(const float4*)xo;
            *(float4*)xo = make_float4(ALPHA * x.x + gate.x * (v[0] + bias.x), ALPHA * x.y + gate.y * (v[1] + bias.y), ALPHA * x.z + gate.z * (v[2] + bias.z), ALPHA * x.w + gate.w * (v[3] + bias.w));
          }
        }
    }
}

template <int EPI>
DEV void gemm_epilogue_lnres(const Params& p, int l, f32x4 (&acc)[2][2][4][2], int pm, int pn, int wr, int wc, int fr, int fq) {
  const int brow = pm * 256, bcol = pn * 256;
  const float* md = p.mod + ((size_t)l * 9 + cond_of(brow)) * 6144;
  float mean[2][4], rstd[2][4];
  {
    const unsigned so = (unsigned)(brow + wr * 64 + fr) * 2u;
#pragma unroll
    for (int ai = 0; ai < 2; ++ai)
#pragma unroll
      for (int m = 0; m < 4; ++m) { const float2 t = *(const float2*)(p.rstat + (so + (unsigned)((ai * 128 + m * 16) * 2))); mean[ai][m] = t.x; rstd[ai][m] = t.y; }
  }
  const float* lg = (EPI == 2) ? p.ln2_g + (l - 1) * 1024 : p.ln1_g + l * 1024;
  const float* lb = (EPI == 2) ? p.ln2_b + (l - 1) * 1024 : p.ln1_b + l * 1024;
  const unsigned co = (unsigned)(bcol + wc * 32 + fq * 4);
  const unsigned ro = (unsigned)(brow + wr * 64 + fr) * 1024u + co;
#pragma unroll
  for (int bj = 0; bj < 2; ++bj)
#pragma unroll
    for (int n = 0; n < 2; ++n) {
      unsigned col = co + (unsigned)(bj * 128 + n * 16), rb = ro + (unsigned)(bj * 128 + n * 16);
      asm volatile("" : "+v"(col), "+v"(rb));
      float4 gate, bias = make_float4(0.f, 0.f, 0.f, 0.f);
      if (EPI == 2) gate = *(const float4*)(md + 2048 + col);
      else { gate = *(const float4*)(md + 5120 + col); bias = *(const float4*)(p.b_ff2 + l * 1024 + col); }
      const float4 g4 = *(const float4*)(lg + col), b4 = *(const float4*)(lb + col);
#pragma unroll
      for (int ai = 0; ai < 2; ++ai)
#pragma unroll
        for (int m = 0; m < 4; ++m) {
          float* xo = p.out + (rb + (unsigned)((ai * 128 + m * 16) * 1024));
          const float4 x = *(const float4*)xo;
          const float mu = mean[ai][m], rr = rstd[ai][m];
          const f32x4 v = acc[ai][bj][m][n];
          const float x0 = (x.x - mu) * rr * g4.x + b4.x, x1 = (x.y - mu) * rr * g4.y + b4.y, x2 = (x.z - mu) * rr * g4.z + b4.z, x3 = (x.w - mu) * rr * g4.w + b4.w;
          *(float4*)xo = make_float4(ALPHA * x0 + gate.x * (v[0] + bias.x), ALPHA * x1 + gate.y * (v[1] + bias.y), ALPHA * x2 + gate.z * (v[2] + bias.z), ALPHA * x3 + gate.w * (v[3] + bias.w));
        }
    }
}

template <int EPI>
DEV void gemm_phase(const Params& p, int l, const bf16_t* Ag, const bf16_t* Btg, int N, int K, LAS3 unsigned char* lds) {
  using namespace g8;
  const int tid = threadIdx.x, wid = __builtin_amdgcn_readfirstlane(tid >> 6), lane = tid & 63, wr = wid >> 2, wc = wid & 3, fr = lane & 15, fq = lane >> 4;
  const int nt = K / BK, nM = MT / BM, nN = N / BM;
  unsigned voff[2];
#pragma unroll
  for (int i = 0; i < 2; ++i) { int R, C; stage_rc(tid * 16 + i * 8192, R, C); voff[i] = (unsigned)(R * K + C) * 2u; }
  const size_t kstep = (size_t)(BK * 2);
  const size_t hstep = (size_t)HALF * K * 2;
  const size_t tstep = 2 * hstep;
  const unsigned ldsw = (unsigned)wid * 1024u;
  const int aoff = lds_byte(wr * 64 + fr, fq * 8), boff = lds_byte(wc * 32 + fr, fq * 8);
#define PG8_SA(b, h) (((b) * 2 + (h)) * HTB)
#define PG8_SB(b, h) ((4 + (b) * 2 + (h)) * HTB)
#define PG8_STAGE(bufoff, gbase) do { _Pragma("unroll") for (int _i = 0; _i < 2; ++_i) \
    __builtin_amdgcn_global_load_lds((const unsigned*)((const char*)(gbase) + voff[_i]), (LAS3 unsigned*)(lds + (bufoff) + ldsw + _i * 8192), 16, 0, 0); } while (0)
#define PG8_LDA(dst, b, h) do { _Pragma("unroll") for (int m = 0; m < 4; ++m) _Pragma("unroll") for (int k = 0; k < 2; ++k) dst[m][k] = *(const LAS3 bf16x8*)(lds + PG8_SA(b, h) + aoff + m * 2048 + k * 1024); } while (0)
#define PG8_LDB(dst, b, h) do { _Pragma("unroll") for (int n = 0; n < 2; ++n) _Pragma("unroll") for (int k = 0; k < 2; ++k) dst[n][k] = *(const LAS3 bf16x8*)(lds + PG8_SB(b, h) + boff + n * 2048 + k * 1024); } while (0)
#define PG8_MMA(ai, bj, At_, Bt_) do { __builtin_amdgcn_s_setprio(1); _Pragma("unroll") for (int m = 0; m < 4; ++m) _Pragma("unroll") for (int n = 0; n < 2; ++n) _Pragma("unroll") for (int k = 0; k < 2; ++k) \
    acc[ai][bj][m][n] = __builtin_amdgcn_mfma_f32_16x16x32_bf16(Bt_[n][k], At_[m][k], acc[ai][bj][m][n], 0, 0, 0); __builtin_amdgcn_s_setprio(0); } while (0)
#define PG8_WAIT_V(n) asm volatile("s_waitcnt vmcnt(" #n ")" ::: "memory")
#define PG8_WAIT_L(n) asm volatile("s_waitcnt lgkmcnt(" #n ")" ::: "memory")
#define PG8_BAR __builtin_amdgcn_s_barrier()
#define PG8_SCHED __builtin_amdgcn_sched_barrier(0)
  int cpm, cpn, npm = 0, npn = 0, ui = 0;
  if (!unit_of(0, nM, nN, cpm, cpn)) return;
  f32x4 acc[2][2][4][2];
#pragma unroll
  for (int a = 0; a < 2; ++a)
#pragma unroll
    for (int b = 0; b < 2; ++b)
#pragma unroll
      for (int m = 0; m < 4; ++m)
#pragma unroll
        for (int n = 0; n < 2; ++n) acc[a][b][m][n] = (f32x4){0.f, 0.f, 0.f, 0.f};
  bf16x8 At[4][2], B0[2][2], B1[2][2];
  const char* cA = (const char*)Ag + (size_t)cpm * tstep; const char* cB = (const char*)Btg + (size_t)cpn * tstep;
  PG8_STAGE(PG8_SB(0, 0), cB); PG8_STAGE(PG8_SA(0, 0), cA); PG8_STAGE(PG8_SB(0, 1), cB + hstep); PG8_STAGE(PG8_SA(0, 1), cA + hstep);
  if (wr == 1) PG8_BAR;
  PG8_WAIT_V(4); PG8_BAR;
  PG8_STAGE(PG8_SB(1, 0), cB + kstep); PG8_STAGE(PG8_SA(1, 0), cA + kstep); PG8_STAGE(PG8_SB(1, 1), cB + hstep + kstep);
  PG8_WAIT_V(6); PG8_BAR;
  for (;;) {
    const bool has_next = unit_of(ui + 1, nM, nN, npm, npn);
    const char* nA = has_next ? (const char*)Ag + (size_t)npm * tstep : cA; const char* nB = has_next ? (const char*)Btg + (size_t)npn * tstep : cB;
    for (int t = 0; t < nt; t += 2) {
      const bool last = (t == nt - 2);
      const char* a1 = cA + (size_t)(t + 1) * kstep;
      const char* a2 = last ? nA : cA + (size_t)(t + 2) * kstep; const char* b2 = last ? nB : cB + (size_t)(t + 2) * kstep;
      const char* a3 = a2 + kstep; const char* b3 = b2 + kstep;
      PG8_LDB(B0, 0, 0); PG8_SCHED; PG8_LDA(At, 0, 0); PG8_STAGE(PG8_SA(1, 1), a1 + hstep);
      PG8_WAIT_L(8); PG8_BAR; PG8_WAIT_L(0); PG8_MMA(0, 0, At, B0); PG8_BAR; PG8_SCHED;
      PG8_LDB(B1, 0, 1); PG8_STAGE(PG8_SB(0, 0), b2);
      PG8_BAR; PG8_WAIT_L(0); PG8_MMA(0, 1, At, B1); PG8_BAR;
      PG8_LDA(At, 0, 1); PG8_STAGE(PG8_SA(0, 0), a2);
      PG8_BAR; PG8_WAIT_L(0); PG8_MMA(1, 0, At, B0); PG8_BAR; PG8_SCHED;
      PG8_STAGE(PG8_SB(0, 1), b2 + hstep);
      PG8_WAIT_V(6); PG8_BAR; PG8_MMA(1, 1, At, B1); PG8_BAR;
      PG8_LDB(B0, 1, 0); PG8_SCHED; PG8_LDA(At, 1, 0); PG8_STAGE(PG8_SA(0, 1), a2 + hstep);
      PG8_WAIT_L(8); PG8_BAR; PG8_WAIT_L(0); PG8_MMA(0, 0, At, B0); PG8_BAR; PG8_SCHED;
      PG8_LDB(B1, 1, 1); PG8_STAGE(PG8_SB(1, 0), b3);
      PG8_BAR; PG8_WAIT_L(0); PG8_MMA(0, 1, At, B1); PG8_BAR;
      PG8_LDA(At, 1, 1); PG8_STAGE(PG8_SA(1, 0), a3);
      PG8_BAR; PG8_WAIT_L(0); PG8_MMA(1, 0, At, B0); PG8_BAR; PG8_SCHED;
      PG8_STAGE(PG8_SB(1, 1), b3 + hstep);
      PG8_WAIT_V(6); PG8_BAR; PG8_MMA(1, 1, At, B1); PG8_BAR;
    }
    if (EPI == 4 || (EPI == 2 && l > 0)) gemm_epilogue_lnres<EPI>(p, l, acc, cpm, cpn, wr, wc, fr, fq);
    else gemm_epilogue<EPI>(p, l, acc, cpm, cpn, wr, wc, fr, fq);
    if (!has_next) break;
#pragma unroll
    for (int a = 0; a < 2; ++a)
#pragma unroll
      for (int b = 0; b < 2; ++b)
#pragma unroll
        for (int m = 0; m < 4; ++m)
#pragma unroll
          for (int n = 0; n < 2; ++n) acc[a][b][m][n] = (f32x4){0.f, 0.f, 0.f, 0.f};
    cpm = npm; cpn = npn; cA = nA; cB = nB; ++ui;
  }
  PG8_WAIT_V(0);
  if (wr == 0) PG8_BAR;
  PG8_BAR;
#undef PG8_SA
#undef PG8_SB
#undef PG8_STAGE
#undef PG8_LDA
#undef PG8_LDB
#undef PG8_MMA
#undef PG8_WAIT_V
#undef PG8_WAIT_L
#undef PG8_BAR
#undef PG8_SCHED
}

DEV void rope8(float (&v)[8], int d0, int prow, int pcol, const float* __restrict__ rope) {
  const int pp = (d0 < 32) ? prow : pcol;
#pragma unroll
  for (int i = 0; i < 4; ++i) {
    const int f = ((d0 >> 1) + i) & 15;
    const float cs = rope[(pp * 16 + f) * 2], sn = rope[(pp * 16 + f) * 2 + 1];
    const float x1 = v[2 * i], x2 = v[2 * i + 1];
    v[2 * i] = x1 * cs - x2 * sn; v[2 * i + 1] = x1 * sn + x2 * cs;
  }
}

DEV void prep_token_row(const Params& p, int l, int m, int lane, uint4 c) {
  bf16_t* zr = p.zf + (size_t)m * 1792;
  const bool lat = m >= 8192;
  const int pos = lat ? ((m - 8192) & 1023) : (m & 255);
  const int prow = pos >> 6, pcol = pos & 63;
  const int d0 = (lane & 7) * 8;
  U8 u; u.u = c;
  float v[8], gl[8]; float ss = 0.f, sg = 0.f;
#pragma unroll
  for (int j = 0; j < 8; ++j) { v[j] = bf2f(u.h[j]); ss += v[j] * v[j]; gl[j] = gelu_t(v[j]); sg += gl[j]; }
  ss += __shfl_xor(ss, 1); ss += __shfl_xor(ss, 2); ss += __shfl_xor(ss, 4);
#pragma unroll
  for (int o = 1; o <= 16; o <<= 1) sg += __shfl_xor(sg, o);
  const float mean = sg * (1.f / 256.f);
  float s2 = 0.f;
#pragma unroll
  for (int j = 0; j < 8; ++j) { const float d = gl[j] - mean; s2 += d * d; }
#pragma unroll
  for (int o = 1; o <= 16; o <<= 1) s2 += __shfl_xor(s2, o);
  if (lane < 16) {
    const float rinv = rsqrtf(ss * (1.f / 64.f) + 1e-6f);
#pragma unroll
    for (int j = 0; j < 8; ++j) v[j] = v[j] * rinv * p.k_g[l * 64 + d0 + j];
    if (!lat) {
      float* o = p.out + OFF_YK + ((((size_t)(m >> 8)) * 2 + l) * 256 + pos) * 128 + lane * 8;
      *(float4*)o = make_float4(v[0], v[1], v[2], v[3]); *(float4*)(o + 4) = make_float4(v[4], v[5], v[6], v[7]);
    } else rope8(v, d0, prow, pcol, p.rope);
#pragma unroll
    for (int j = 0; j < 4; ++j) u.w[j] = pack2(v[2 * j], v[2 * j + 1]);
    const int kvh = lane >> 3;
    bf16_t* kd = lat ? p.kb_lat + ((size_t)((l * 8 + ((m - 8192) >> 10)) * 2 + kvh) * 1280 + 256 + pos) * 64 + d0
                     : p.kb_ctx + ((size_t)((m >> 8) * 2 + kvh) * 256 + pos) * 64 + d0;
    *(uint4*)kd = u.u;
  } else if (lane < 32) {
    if (!lat) {
      float* o = p.out + OFF_YV + ((((size_t)(m >> 8)) * 2 + l) * 256 + pos) * 128 + (lane - 16) * 8;
      *(float4*)o = make_float4(v[0], v[1], v[2], v[3]); *(float4*)(o + 4) = make_float4(v[4], v[5], v[6], v[7]);
    }
    const int kvh = (lane - 16) >> 3;
    bf16_t* vd; int T;
    if (lat) { T = 1280; vd = p.vt_lat + ((size_t)((l * 8 + ((m - 8192) >> 10)) * 2 + kvh) * 64 + d0) * 1280 + 256 + pos; }
    else { T = 256; vd = p.vt_ctx + ((size_t)((m >> 8) * 2 + kvh) * 64 + d0) * 256 + pos; }
#pragma unroll
    for (int j = 0; j < 8; ++j) vd[(size_t)j * T] = u.h[j];
  } else {
    const float rstd = rsqrtf(s2 * (1.f / 256.f) + 1e-6f);
    const int ch = (lane - 32) * 8;
#pragma unroll
    for (int j = 0; j < 8; ++j) gl[j] = (gl[j] - mean) * rstd * p.mlp_g[l * 256 + ch + j] + p.mlp_b[l * 256 + ch + j];
#pragma unroll
    for (int j = 0; j < 4; ++j) u.w[j] = pack2(gl[2 * j], gl[2 * j + 1]);
    *(uint4*)(zr + 1536 + ch) = u.u;
  }
}

template <bool REV>
DEV void tile_scan(float (&a)[4][4], float (&u)[4][4], int lane) {
  const int q = lane >> 4;
  float C = 0.f, CP = 1.f;
  const int src1 = (REV ? lane + 16 : lane - 16) & 63;
  const int src2 = (REV ? lane + 32 : lane - 32) & 63;
  const int srcT = (lane & 15) + (REV ? 0 : 48);
  const bool c1 = REV ? (q <= 2) : (q >= 1);
  const bool c2 = REV ? (q <= 1) : (q >= 2);
  const bool first = REV ? (q == 3) : (q == 0);
#pragma unroll
  for (int mi = 0; mi < 4; ++mi) {
    const int mt = REV ? 3 - mi : mi;
    float P = 1.f, H = 0.f, pl[4], hl[4];
#pragma unroll
    for (int ri = 0; ri < 4; ++ri) {
      const int r = REV ? 3 - ri : ri;
      H = a[mt][r] * H + u[mt][r]; P *= a[mt][r]; pl[r] = P; hl[r] = H;
    }
    float Pi = P, Hi = H;
    float Pp = __shfl(Pi, src1), Hp = __shfl(Hi, src1);
    if (c1) { Hi = Pi * Hp + Hi; Pi = Pi * Pp; }
    Pp = __shfl(Pi, src2); Hp = __shfl(Hi, src2);
    if (c2) { Hi = Pi * Hp + Hi; Pi = Pi * Pp; }
    float Pe = __shfl(Pi, src1), He = __shfl(Hi, src1);
    if (first) { Pe = 1.f; He = 0.f; }
    const float hin = Pe * C + He, pin = Pe * CP;
#pragma unroll
    for (int r = 0; r < 4; ++r) { u[mt][r] = pl[r] * hin + hl[r]; a[mt][r] = pl[r] * pin; }
    const float Pt = __shfl(Pi, srcT), Ht = __shfl(Hi, srcT);
    C = Pt * C + Ht; CP = Pt * CP;
  }
}

DEV void lru_gate_item(const Params& p, int l, int item, char* smem) {
  const int tid = VTID, lane = tid & 63, w = tid >> 6;
  const int tile = item >> 2, blk = item & 3;
  const int m0 = tile * 64;
  int ms, L;
  if (m0 < 8192) { ms = m0 & ~255; L = 256; } else { ms = 8192 + ((m0 - 8192) & ~1023); L = 1024; }
  const int dir = w >> 1, half = w & 1, q = lane >> 4, c15 = lane & 15;
  const bf16_t* wt = p.wt_lru + (size_t)((((l * 2 + dir) * 4 + blk) * 2)) * 4096;
  bf16x8 bfr[2][2][2];
#pragma unroll
  for (int mat = 0; mat < 2; ++mat)
#pragma unroll
    for (int j = 0; j < 2; ++j)
#pragma unroll
      for (int s = 0; s < 2; ++s) bfr[mat][j][s] = *(const bf16x8*)(wt + mat * 4096 + (half * 32 + j * 16 + c15) * 64 + s * 32 + q * 8);
  float* xs = (float*)smem;
  float* xcf = xs + 67 * 64;
  bf16_t* xcb = (bf16_t*)(xcf + 64 * 64);
  for (int idx = tid; idx < 67 * 8; idx += 256) {
    const int rr = idx >> 3, cc = idx & 7;
    const int m = m0 - 1 + rr;
    float v[8];
    if (m >= ms && m < ms + L) {
      U8 u; u.u = *(const uint4*)(p.zf + (size_t)m * 1792 + 768 + blk * 64 + cc * 8);
#pragma unroll
      for (int j = 0; j < 8; ++j) v[j] = bf2f(u.h[j]);
    } else {
#pragma unroll
      for (int j = 0; j < 8; ++j) v[j] = 0.f;
    }
#pragma unroll
    for (int j = 0; j < 8; ++j) xs[rr * 64 + cc * 8 + j] = v[j];
  }
  __syncthreads();
  {
    const int ch = tid & 63, Cg = blk * 64 + ch;
    const float w0 = p.conv_w[(l * 4 + 0) * 256 + Cg], w1 = p.conv_w[(l * 4 + 1) * 256 + Cg], w2 = p.conv_w[(l * 4 + 2) * 256 + Cg],
                w3 = p.conv_w[(l * 4 + 3) * 256 + Cg], cb = p.conv_b[l * 256 + Cg];
#pragma unroll 4
    for (int tt = 0; tt < 16; ++tt) {
      const int t = (tid >> 6) * 16 + tt;
      const float v = cb + w0 * xs[t * 64 + ch] + w1 * xs[(t + 1) * 64 + ch] + w2 * xs[(t + 2) * 64 + ch] + w3 * xs[(t + 3) * 64 + ch];
      xcf[t * 64 + ch] = v; xcb[t * 72 + ch] = f2bf(v);
    }
  }
  __syncthreads();
  f32x4 acc[2][4][2];
#pragma unroll
  for (int mat = 0; mat < 2; ++mat)
#pragma unroll
    for (int mt = 0; mt < 4; ++mt)
#pragma unroll
      for (int j = 0; j < 2; ++j) acc[mat][mt][j] = f32x4{0.f, 0.f, 0.f, 0.f};
#pragma unroll
  for (int mt = 0; mt < 4; ++mt)
#pragma unroll
    for (int s = 0; s < 2; ++s) {
      const bf16x8 af = *(const bf16x8*)(xcb + (mt * 16 + c15) * 72 + s * 32 + q * 8);
#pragma unroll
      for (int mat = 0; mat < 2; ++mat)
#pragma unroll
        for (int j = 0; j < 2; ++j) acc[mat][mt][j] = mfma16(af, bfr[mat][j][s], acc[mat][mt][j]);
    }
  float* PCp = p.au + (size_t)(dir * 2 + 0) * MT * 256;
  float* HLp = p.au + (size_t)(dir * 2 + 1) * MT * 256;
#pragma unroll
  for (int j = 0; j < 2; ++j) {
    const int ch = half * 32 + j * 16 + c15, Cg = blk * 64 + ch, pidx = (l * 2 + dir) * 256 + Cg;
    const float ba = p.lru_ba[pidx], bx = p.lru_bx[pidx];
    const float cdec = p.cdec[pidx];
    float a[4][4], u[4][4];
#pragma unroll
    for (int mt = 0; mt < 4; ++mt)
#pragma unroll
      for (int r = 0; r < 4; ++r) {
        const int t = mt * 16 + q * 4 + r;
        const float rg = sigmoidf_(acc[0][mt][j][r] + ba), ig = sigmoidf_(acc[1][mt][j][r] + bx);
        const float la = cdec * rg;
        a[mt][r] = __expf(la);
        const float x2 = 2.f * la;
        const float em = (x2 < -0.25f) ? 1.f - __expf(x2) : -x2 * (1.f + x2 * (0.5f + x2 * (1.f / 6.f + x2 * (1.f / 24.f + x2 * (1.f / 120.f + x2 * (1.f / 720.f))))));
        u[mt][r] = __builtin_amdgcn_sqrtf(em) * ig * xcf[t * 64 + ch];
      }
    if (dir == 0) tile_scan<false>(a, u, lane); else tile_scan<true>(a, u, lane);
#pragma unroll
    for (int mt = 0; mt < 4; ++mt)
#pragma unroll
      for (int r = 0; r < 4; ++r) {
        const size_t m = m0 + mt * 16 + q * 4 + r;
        PCp[m * 256 + Cg] = a[mt][r]; HLp[m * 256 + Cg] = u[mt][r];
      }
  }
  __syncthreads();
}

DEV void attn_item(const Params& p, int l, int it, char* sm) {
  const int tid = threadIdx.x, lane = tid & 63, w = tid >> 6, q = lane >> 4, c15 = lane & 15;
  const int qg = w >> 1, kh = w & 1;
  int h, ms, nkt, T; const bf16_t* Kg; const bf16_t* Vg;
  if (it < 512) {
    const int b = it >> 6, qb = it & 7; h = (it >> 3) & 7; ms = 8192 + b * 1024 + qb * 128; nkt = 10; T = 1280;
    Kg = p.kb_lat + (size_t)((l * 8 + b) * 2 + (h >> 2)) * 1280 * 64; Vg = p.vt_lat + (size_t)((l * 8 + b) * 2 + (h >> 2)) * 64 * 1280;
  } else {
    const int i2 = it - 512, b = i2 >> 4, qb = i2 & 1; h = (i2 >> 1) & 7; ms = b * 256 + qb * 128; nkt = 2; T = 256;
    Kg = p.kb_ctx + (size_t)(b * 2 + (h >> 2)) * 256 * 64; Vg = p.vt_ctx + (size_t)(b * 2 + (h >> 2)) * 64 * 256;
  }
  const int kc0 = tid, kc1 = tid + 512;
  const int vd0 = tid >> 4, vk = (tid & 15) * 8;
  const int vpos = ((tid & 15) >> 2) * 32 + 16 * (tid & 1) + 4 * ((tid & 3) >> 1);
  const bf16_t* vg0 = Vg + (size_t)vd0 * T + vk;
  const bf16_t* vg1 = Vg + (size_t)(vd0 + 32) * T + vk;
  uint4 rk0, rk1, rv0, rv1;
#define ATT_LOAD(kt) do { rk0 = *(const uint4*)(Kg + (size_t)(kt) * 8192 + kc0 * 8); rk1 = *(const uint4*)(Kg + (size_t)(kt) * 8192 + kc1 * 8); \
    rv0 = *(const uint4*)(vg0 + (kt) * 128); rv1 = *(const uint4*)(vg1 + (kt) * 128); } while (0)
#define ATT_STORE(buf) do { bf16_t* Ks_ = (bf16_t*)(sm + (buf) * 36864); bf16_t* Vs_ = Ks_ + 9216; \
    *(uint4*)(Ks_ + (kc0 >> 3) * 72 + (kc0 & 7) * 8) = rk0; *(uint4*)(Ks_ + (kc1 >> 3) * 72 + (kc1 & 7) * 8) = rk1; \
    *(uint2*)(Vs_ + vd0 * 136 + vpos) = make_uint2(rv0.x, rv0.y); *(uint2*)(Vs_ + vd0 * 136 + vpos + 8) = make_uint2(rv0.z, rv0.w); \
    *(uint2*)(Vs_ + (vd0 + 32) * 136 + vpos) = make_uint2(rv1.x, rv1.y); *(uint2*)(Vs_ + (vd0 + 32) * 136 + vpos + 8) = make_uint2(rv1.z, rv1.w); } while (0)
  ATT_LOAD(0);
  const int mq = ms + qg * 32;
  bf16x8 qf[2][2];
#pragma unroll
  for (int t = 0; t < 2; ++t)
#pragma unroll
    for (int s = 0; s < 2; ++s) qf[t][s] = *(const bf16x8*)(p.zf + (size_t)(mq + t * 16 + c15) * 1792 + h * 64 + s * 32 + q * 8);
  ATT_STORE(0);
  if (nkt > 1) ATT_LOAD(1);
#pragma unroll
  for (int t = 0; t < 2; ++t) {
    float f[2][8]; float ss = 0.f;
#pragma unroll
    for (int s = 0; s < 2; ++s)
#pragma unroll
      for (int j = 0; j < 8; ++j) { f[s][j] = bf2f((bf16_t)qf[t][s][j]); ss += f[s][j] * f[s][j]; }
    ss += __shfl_xor(ss, 16); ss += __shfl_xor(ss, 32);
    const float rinv = rsqrtf(ss * (1.f / 64.f) + 1e-6f);
    const int mrow_ = mq + t * 16 + c15;
    const int pos = (mrow_ - 8192) & 1023;
#pragma unroll
    for (int s = 0; s < 2; ++s) {
      const int dd = s * 32 + q * 8;
#pragma unroll
      for (int j = 0; j < 8; ++j) f[s][j] = f[s][j] * rinv * p.q_g[l * 64 + dd + j];
      if (it < 512) rope8(f[s], dd, pos >> 6, pos & 63, p.rope);
      U8 pk;
#pragma unroll
      for (int j = 0; j < 4; ++j) pk.w[j] = pack2(f[s][2 * j] * QSCALE, f[s][2 * j + 1] * QSCALE);
      qf[t][s] = pk.v;
    }
  }
  __syncthreads();
  f32x4 o[2][4];
  float mrow[2], lrow[2];
#pragma unroll
  for (int t = 0; t < 2; ++t) { mrow[t] = -1e30f; lrow[t] = 0.f;
#pragma unroll
    for (int j = 0; j < 4; ++j) o[t][j] = f32x4{0.f, 0.f, 0.f, 0.f}; }
  for (int kt = 0; kt < nkt; ++kt) {
    const int cur = kt & 1;
    const bf16_t* Ks = (const bf16_t*)(sm + cur * 36864) + kh * 64 * 72;
    const bf16_t* Vs = (const bf16_t*)(sm + cur * 36864) + 9216 + kh * 64;
    f32x4 s4[2][4];
    {
      bf16x8 kf[4][2];
#pragma unroll
      for (int jn = 0; jn < 4; ++jn)
#pragma unroll
        for (int s = 0; s < 2; ++s) kf[jn][s] = *(const bf16x8*)(Ks + (jn * 16 + c15) * 72 + s * 32 + q * 8);
      __builtin_amdgcn_sched_barrier(0);
#pragma unroll
      for (int jn = 0; jn < 4; ++jn)
#pragma unroll
        for (int t = 0; t < 2; ++t) s4[t][jn] = mfma16(kf[jn][0], qf[t][0], f32x4{0.f, 0.f, 0.f, 0.f});
#pragma unroll
      for (int jn = 0; jn < 4; ++jn)
#pragma unroll
        for (int t = 0; t < 2; ++t) s4[t][jn] = mfma16(kf[jn][1], qf[t][1], s4[t][jn]);
      __builtin_amdgcn_sched_barrier(0);
    }
    U8 vf[4][2];
#pragma unroll
    for (int jn = 0; jn < 4; ++jn)
#pragma unroll
      for (int ks = 0; ks < 2; ++ks) vf[jn][ks].u = *(const uint4*)(Vs + (jn * 16 + c15) * 136 + ks * 32 + q * 8);
    __builtin_amdgcn_sched_barrier(0);
    U8 pb[2][2];
#pragma unroll
    for (int t = 0; t < 2; ++t) {
      float mx = s4[t][0][0];
#pragma unroll
      for (int jn = 0; jn < 4; ++jn)
#pragma unroll
        for (int r = 0; r < 4; ++r) mx = fmaxf(mx, s4[t][jn][r]);
      mx = fmaxf(mx, __shfl_xor(mx, 16)); mx = fmaxf(mx, __shfl_xor(mx, 32));
      const float mnew = fmaxf(mrow[t], mx);
      const float alpha = __builtin_amdgcn_exp2f(mrow[t] - mnew);
      mrow[t] = mnew;
      float ls = 0.f;
#pragma unroll
      for (int jn = 0; jn < 4; ++jn)
#pragma unroll
        for (int r = 0; r < 4; ++r) { const float pv = __builtin_amdgcn_exp2f(s4[t][jn][r] - mnew); s4[t][jn][r] = pv; ls += pv; }
      lrow[t] = lrow[t] * alpha + ls;
#pragma unroll
      for (int jn = 0; jn < 4; ++jn) { o[t][jn][0] *= alpha; o[t][jn][1] *= alpha; o[t][jn][2] *= alpha; o[t][jn][3] *= alpha; }
#pragma unroll
      for (int ks = 0; ks < 2; ++ks) {
        pb[t][ks].w[0] = pack2(s4[t][2 * ks][0], s4[t][2 * ks][1]); pb[t][ks].w[1] = pack2(s4[t][2 * ks][2], s4[t][2 * ks][3]);
        pb[t][ks].w[2] = pack2(s4[t][2 * ks + 1][0], s4[t][2 * ks + 1][1]); pb[t][ks].w[3] = pack2(s4[t][2 * ks + 1][2], s4[t][2 * ks + 1][3]);
      }
    }
#pragma unroll
    for (int ks = 0; ks < 2; ++ks)
#pragma unroll
      for (int jn = 0; jn < 4; ++jn)
#pragma unroll
        for (int t = 0; t < 2; ++t) o[t][jn] = mfma16(vf[jn][ks].v, pb[t][ks].v, o[t][jn]);
    if (kt + 1 < nkt) {
      ATT_STORE(cur ^ 1);
      if (kt + 2 < nkt) ATT_LOAD(kt + 2);
    }
    __syncthreads();
  }
#undef ATT_LOAD
#undef ATT_STORE
  float* mrg = (float*)(sm + 73728) + (size_t)(qg * 64 + lane) * 37;
  float lt[2];
#pragma unroll
  for (int t = 0; t < 2; ++t) { float a = lrow[t]; a += __shfl_xor(a, 16); a += __shfl_xor(a, 32); lt[t] = a; }
  if (kh == 1) {
#pragma unroll
    for (int t = 0; t < 2; ++t) {
      mrg[t * 18 + 0] = mrow[t]; mrg[t * 18 + 1] = lt[t];
#pragma unroll
      for (int jn = 0; jn < 4; ++jn)
#pragma unroll
        for (int r = 0; r < 4; ++r) mrg[t * 18 + 2 + jn * 4 + r] = o[t][jn][r];
    }
  }
  __syncthreads();
  if (kh == 0) {
#pragma unroll
    for (int t = 0; t < 2; ++t) {
      const float m1 = mrg[t * 18 + 0], l1 = mrg[t * 18 + 1];
      const float mm = fmaxf(mrow[t], m1);
      const float a0 = __builtin_amdgcn_exp2f(mrow[t] - mm), a1 = __builtin_amdgcn_exp2f(m1 - mm);
      const float inv = 1.f / (a0 * lt[t] + a1 * l1);
      const float c0 = a0 * inv, c1 = a1 * inv;
      bf16_t* orow = p.abuf + (size_t)(mq + t * 16 + c15) * 1024 + h * 64 + q * 4;
#pragma unroll
      for (int jn = 0; jn < 4; ++jn) {
        const float x0 = c0 * o[t][jn][0] + c1 * mrg[t * 18 + 2 + jn * 4 + 0], x1 = c0 * o[t][jn][1] + c1 * mrg[t * 18 + 2 + jn * 4 + 1];
        const float x2 = c0 * o[t][jn][2] + c1 * mrg[t * 18 + 2 + jn * 4 + 2], x3 = c0 * o[t][jn][3] + c1 * mrg[t * 18 + 2 + jn * 4 + 3];
        uint2 ov; ov.x = pack2(x0, x1); ov.y = pack2(x2, x3);
        *(uint2*)(orow + jn * 16) = ov;
      }
    }
  }
  __syncthreads();
}

DEV void gmlp_item(const Params& p, int l, int it, char* smem) {
  const int tid = VTID, lane = tid & 63, w = tid >> 6, q = lane >> 4, c15 = lane & 15;
  const int chunk = it >> 2, g = it & 3, m0 = chunk * 128;
  bf16_t* vt = (bf16_t*)smem;
  const float* wsg = p.mlp_ws + (size_t)(l * 4 + g) * 16384;
  float4 wa[2][4][2];
#pragma unroll
  for (int nt = 0; nt < 2; ++nt)
#pragma unroll
    for (int s = 0; s < 4; ++s) {
      const float* ap = wsg + ((2 * w + nt) * 16 + c15) * 128 + s * 32 + q * 8;
      wa[nt][s][0] = *(const float4*)ap; wa[nt][s][1] = *(const float4*)(ap + 4);
    }
  uint4 vin[4];
#pragma unroll
  for (int i = 0; i < 4; ++i) { const int id = tid + 256 * i; vin[i] = *(const uint4*)(p.zf + (size_t)(m0 + (id >> 3)) * 1792 + 1536 + g * 64 + (id & 7) * 8); }
#pragma unroll
  for (int i = 0; i < 4; ++i) {
    const int id = tid + 256 * i, qq = id >> 3, cc = id & 7;
    U8 v; v.u = vin[i];
#pragma unroll
    for (int j = 0; j < 8; ++j) vt[(cc * 8 + j) * 136 + qq] = v.h[j];
  }
  __syncthreads();
  f32x4 acc[4][2];
#pragma unroll
  for (int mt = 0; mt < 4; ++mt)
#pragma unroll
    for (int nt = 0; nt < 2; ++nt) acc[mt][nt] = f32x4{0.f, 0.f, 0.f, 0.f};
#pragma unroll
  for (int s = 0; s < 4; ++s) {
    bf16x8 af[4];
#pragma unroll
    for (int mt = 0; mt < 4; ++mt) af[mt] = *(const bf16x8*)(vt + (mt * 16 + c15) * 136 + s * 32 + q * 8);
#pragma unroll
    for (int nt = 0; nt < 2; ++nt) {
      U8 bb;
      bb.w[0] = pack2(wa[nt][s][0].x, wa[nt][s][0].y); bb.w[1] = pack2(wa[nt][s][0].z, wa[nt][s][0].w);
      bb.w[2] = pack2(wa[nt][s][1].x, wa[nt][s][1].y); bb.w[3] = pack2(wa[nt][s][1].z, wa[nt][s][1].w);
#pragma unroll
      for (int mt = 0; mt < 4; ++mt) acc[mt][nt] = mfma16(af[mt], bb.v, acc[mt][nt]);
    }
  }
#pragma unroll
  for (int nt = 0; nt < 2; ++nt) {
    const int pp = (2 * w + nt) * 16 + c15;
    const size_t m = m0 + pp;
    const float bsv = p.mlp_bs[(l * 4 + g) * 128 + pp];
#pragma unroll
    for (int mt = 0; mt < 4; ++mt) {
      const int c = mt * 16 + q * 4;
      const uint2 uu = *(const uint2*)(p.zf + m * 1792 + 1280 + g * 64 + c);
      const float u0 = gelu_t(__uint_as_float(uu.x << 16)), u1 = gelu_t(__uint_as_float(uu.x & 0xffff0000u)), u2 = gelu_t(__uint_as_float(uu.y << 16)), u3 = gelu_t(__uint_as_float(uu.y & 0xffff0000u));
      uint2 o; o.x = pack2(u0 * (acc[mt][nt][0] + bsv), u1 * (acc[mt][nt][1] + bsv)); o.y = pack2(u2 * (acc[mt][nt][2] + bsv), u3 * (acc[mt][nt][3] + bsv));
      *(uint2*)(p.abuf + m * 1024 + 768 + g * 64 + c) = o;
    }
  }
  __syncthreads();
}

DEV void lru_apply_item(const Params& p, int l, int ti2) {
  const int C = VTID;
  const int ti = ti2 >> 1, th = (ti2 & 1) * 32;
  const int m0 = ti * 64;
  int ms, L, b; bool lat = m0 >= 8192;
  if (!lat) { ms = m0 & ~255; L = 256; b = m0 >> 8; } else { ms = 8192 + ((m0 - 8192) & ~1023); L = 1024; b = (m0 - 8192) >> 10; }
  const int k = (m0 - ms) >> 6, nt = L >> 6;
  const float* PCf = p.au; const float* HLf = p.au + (size_t)MT * 256;
  const float* PCb = p.au + (size_t)2 * MT * 256; const float* HLb = p.au + (size_t)3 * MT * 256;
  float cf = lat ? p.state_lru[((size_t)(b * 2 + l) * 2 + 0) * 256 + C] : 0.f;
  float cb = lat ? p.state_lru[((size_t)(b * 2 + l) * 2 + 1) * 256 + C] : 0.f;
  {
    float pc[15], hl[15];
#pragma unroll
    for (int i = 0; i < 15; ++i) {
      const bool act = i < k;
      const size_t e = (size_t)(ms + 64 * i + 63) * 256 + C;
      pc[i] = act ? PCf[e] : 1.f; hl[i] = act ? HLf[e] : 0.f;
    }
#pragma unroll
    for (int i = 0; i < 15; ++i) cf = pc[i] * cf + hl[i];
  }
  {
    float pc[15], hl[15];
#pragma unroll
    for (int i = 0; i < 15; ++i) {
      const int tix = nt - 1 - i;
      const bool act = tix > k;
      const size_t e = (size_t)(ms + 64 * tix) * 256 + C;
      pc[i] = act ? PCb[e] : 1.f; hl[i] = act ? HLb[e] : 0.f;
    }
#pragma unroll
    for (int i = 0; i < 15; ++i) cb = pc[i] * cb + hl[i];
  }
  float hf_last = 0.f, hb_first = 0.f;
#pragma unroll 16
  for (int t = th; t < th + 32; ++t) {
    const size_t m = m0 + t;
    const float hf = PCf[m * 256 + C] * cf + HLf[m * 256 + C];
    const float hb = PCb[m * 256 + C] * cb + HLb[m * 256 + C];
    const float g = gelu_t(bf2f(p.zf[m * 1792 + 1024 + C]));
    p.abuf[m * 1024 + 512 + C] = f2bf((hf + hb) * g);
    if (t == 0) hb_first = hb;
    if (t == 63) hf_last = hf;
  }
  if (!lat) {
    if (k == nt - 1 && th == 32) p.out[OFF_ST + ((size_t)(b * 2 + l) * 2 + 0) * 256 + C] = hf_last;
    if (k == 0 && th == 0) p.out[OFF_ST + ((size_t)(b * 2 + l) * 2 + 1) * 256 + C] = hb_first;
  }
}

DEV void mixer_phase(const Params& p, int l, char* smem_raw, char* smem) {
  {
    const int x = blockIdx.x & 7, j = blockIdx.x >> 3;
#pragma unroll 1
    for (int k = 0; k < 4; ++k) attn_item(p, l, ((k >> 1) << 9) + 64 * x + j + 32 * (k & 1), smem_raw);
  }
  {
    const int x = blockIdx.x & 7, lh = (blockIdx.x >> 3) * 2 + (threadIdx.x >> 8);
    lru_apply_item(p, l, (own_row(x, (lh >> 1) * 64) >> 6) * 2 + (lh & 1));
    gmlp_item(p, l, (own_row(x, (lh >> 2) * 128) >> 7) * 4 + (lh & 3), smem);
  }
}

DEV void prep_phase_full(const Params& p, int l, char* smem) {
  {
    const int xcd = blockIdx.x & 7, lh = (blockIdx.x >> 3) * 2 + (threadIdx.x >> 8);
#pragma unroll 1
    for (int k = 0; k < 2; ++k) { const int li = lh + 64 * k; lru_gate_item(p, l, (own_row(xcd, (li >> 2) * 64) >> 6) * 4 + (li & 3), smem); }
  }
  const int lane = threadIdx.x & 63, mstride = gridDim.x * 8;
  int vm = blockIdx.x * 8 + (threadIdx.x >> 6);
  const int coff = lane < 32 ? 512 + lane * 8 : 1536 + (lane - 32) * 8;
  uint4 n1 = *(const uint4*)(p.zf + (size_t)xrow(vm) * 1792 + coff);
  uint4 n2 = *(const uint4*)(p.zf + (size_t)xrow((vm + mstride < MT) ? vm + mstride : vm) * 1792 + coff);
  for (; vm < MT; vm += mstride) {
    const uint4 c = n1; n1 = n2;
    const int mn = xrow((vm + 2 * mstride < MT) ? vm + 2 * mstride : vm);
    n2 = *(const uint4*)(p.zf + (size_t)mn * 1792 + coff);
    prep_token_row(p, l, xrow(vm), lane, c);
  }
}


#define XB_TMO      128
#define XB_XCNT(j)  (256  + 64 * (j))
#define XB_XSUB(j)  (1280 + 64 * (j))
#define XB_XGEN(j)  (2304 + 64 * (j))
#define XB_TOP      3328
#define XB_TOPGEN   3392
#define XCD_BAR_WORDS 3456
#define XB_SPIN_CAP (1u << 18)
#define LAS __attribute__((address_space(3)))
DEV unsigned xb_ld(unsigned* p) { return __hip_atomic_load(p, __ATOMIC_RELAXED, __HIP_MEMORY_SCOPE_AGENT); }
DEV unsigned xb_add(unsigned* p, unsigned v) { return __hip_atomic_fetch_add(p, v, __ATOMIC_RELAXED, __HIP_MEMORY_SCOPE_AGENT); }
DEV unsigned xb_xcc_id() { return (unsigned)__builtin_amdgcn_s_getreg((3 << 11) | 20) & 0xFu; }
#define XB_SPIN(cond, bar) do { unsigned _sp = 0; while (cond) { __builtin_amdgcn_s_sleep(1); \
    if ((++_sp & 255u) == 0u) { if (xb_ld(&(bar)[XB_TMO])) break; if (_sp > XB_SPIN_CAP) { atomicAdd(&(bar)[XB_TMO], 1u); break; } } } } while (0)
struct XcdBarrier { unsigned* bar; unsigned x; volatile LAS unsigned* st; };
DEV XcdBarrier xcd_barrier_post(unsigned* bar, volatile LAS unsigned* st) {
  XcdBarrier b; b.bar = bar; b.x = xb_xcc_id(); b.st = st;
  if (threadIdx.x == 0) (void)xb_add(&bar[XB_XCNT(b.x)], 1u);
  return b;
}
DEV void xcd_barrier_complete(unsigned* bar, unsigned x, unsigned& nloc, unsigned& nx) {
  const unsigned G = gridDim.x * gridDim.y * gridDim.z;
  unsigned sum, cnt, mine, sp = 0u;
  for (;;) {
    sum = 0u; cnt = 0u; mine = 0u;
#pragma unroll
    for (unsigned j = 0; j < 16; ++j) { const unsigned c = xb_ld(&bar[XB_XCNT(j)]); sum += c; cnt += (c > 0u) ? 1u : 0u; mine = (j == x) ? c : mine; }
    if (sum == G) break;
    __builtin_amdgcn_s_sleep(1);
    if ((++sp & 255u) == 0u) { if (xb_ld(&bar[XB_TMO])) break; if (sp > XB_SPIN_CAP) { atomicAdd(&bar[XB_TMO], 1u); break; } }
  }
  nloc = mine > 0u ? mine : 1u; nx = cnt > 0u ? cnt : 1u;
}
DEV void xcd_barrier(const XcdBarrier& b) {
  asm volatile("s_waitcnt vmcnt(0)" ::: "memory");
  __syncthreads();
  if (threadIdx.x == 0) {
    unsigned* bar = b.bar;
    __builtin_amdgcn_s_waitcnt(0);
    unsigned nloc = b.st[0], nx = b.st[1];
    if (nloc == 0u) { xcd_barrier_complete(bar, b.x, nloc, nx); b.st[0] = nloc; b.st[1] = nx; }
    const unsigned old = xb_add(&bar[XB_XSUB(b.x)], 1u);
    const unsigned gen = old / nloc;
    if (old + 1u == (gen + 1u) * nloc) {
      __builtin_amdgcn_fence(__ATOMIC_RELEASE, "agent");
      asm volatile("s_waitcnt vmcnt(0)" ::: "memory");
      const unsigned og = xb_add(&bar[XB_TOP], 1u);
      const unsigned tg = og / nx;
      if (og + 1u == (tg + 1u) * nx) xb_add(&bar[XB_TOPGEN], 1u);
      else XB_SPIN(xb_ld(&bar[XB_TOPGEN]) == tg, bar);
      __builtin_amdgcn_fence(__ATOMIC_ACQUIRE, "agent");
      xb_add(&bar[XB_XGEN(b.x)], 1u);
      asm volatile("s_waitcnt vmcnt(0)" ::: "memory");
    } else {
      XB_SPIN(xb_ld(&bar[XB_XGEN(b.x)]) == gen, bar);
      __builtin_amdgcn_fence(__ATOMIC_ACQUIRE, "agent");
      asm volatile("s_waitcnt vmcnt(0)" ::: "memory");
    }
  }
  __syncthreads();
}

#define XB_MISMATCH 160
DEV void xcd_barrier_local(const XcdBarrier& b) {
  asm volatile("s_waitcnt vmcnt(0)" ::: "memory");
  __syncthreads();
  if (threadIdx.x == 0) {
    unsigned* bar = b.bar;
    __builtin_amdgcn_s_waitcnt(0);
    const unsigned nloc = b.st[0];
    const unsigned old = xb_add(&bar[XB_XSUB(b.x)], 1u);
    const unsigned gen = old / nloc;
    if (old + 1u == (gen + 1u) * nloc) xb_add(&bar[XB_XGEN(b.x)], 1u);
    else XB_SPIN(xb_ld(&bar[XB_XGEN(b.x)]) == gen, bar);
    __builtin_amdgcn_fence(__ATOMIC_ACQUIRE, "agent");
    asm volatile("s_waitcnt vmcnt(0)" ::: "memory");
  }
  __syncthreads();
}

#define PH(i, call) if (ph_lo <= (i) && (i) < ph_hi) { if ((i) > ph_lo) { if ((i) >= 2 && xcd_local) xcd_barrier_local(xb); else xcd_barrier(xb); } call; }
#define LAYER_REST(l, b) \
  PH(b + 1, gemm_phase<1>(p, l, p.abuf, p.wt_in + (size_t)l * 1792 * 1024, 1792, 1024, (LAS3 unsigned char*)smem_raw)) \
  PH(b + 2, prep_phase_full(p, l, smem)) \
  PH(b + 3, mixer_phase(p, l, smem_raw, smem)) \
  PH(b + 4, gemm_phase<2>(p, l, p.abuf, p.wt_out + (size_t)l * 1024 * 1024, 1024, 1024, (LAS3 unsigned char*)smem_raw)) \
  PH(b + 5, ln_mod_phase(p, l, 2)) \
  PH(b + 6, gemm_phase<3>(p, l, p.abuf, p.wt_ff1 + (size_t)l * 4096 * 1024, 4096, 1024, (LAS3 unsigned char*)smem_raw)) \
  PH(b + 7, gemm_phase<4>(p, l, p.zf, p.wt_ff2 + (size_t)l * 1024 * 4096, 1024, 4096, (LAS3 unsigned char*)smem_raw))

__global__ void __launch_bounds__(512, 2) mega_kernel(Params p, int ph_lo, int ph_hi) {
  extern __shared__ __attribute__((aligned(16))) char smem_raw[];
  char* smem = smem_raw + (threadIdx.x >> 8) * 65536;
  __shared__ uint4 xb_words;
  if (threadIdx.x == 0) xb_words = make_uint4(0u, 0u, 0u, 0u);
  __syncthreads();
  XcdBarrier xb = xcd_barrier_post(p.bar, (volatile LAS unsigned*)&xb_words);
  if (threadIdx.x == 0) atomicOr(&p.bar[XB_MISMATCH + (blockIdx.x & 7u)], 1u << xb.x);
  if (ph_hi > 1000) { cg::grid_group grid = cg::this_grid(); grid.sync(); }
  bool xcd_local = false;
  PH(0, phase0(p, smem))
  PH(1, { unsigned all = 0u; bool one = true;
          for (int c = 0; c < 8; ++c) { const unsigned m = xb_ld(&p.bar[XB_MISMATCH + c]); one = one && (__builtin_popcount(m) == 1); all |= m; }
          xcd_local = one && all == 0xFFu && gridDim.x == 256; }
        ln_mod_phase(p, 0, 0))
#undef LAYER0_P1
  LAYER_REST(0, 1)
  PH(9, ln_mod_phase(p, 1, 1))
  LAYER_REST(1, 9)
  PH(17, ln_mod_phase(p, 1, 3))
}

extern "C" void kernel_launch(void* const* d_in, const int* in_sizes, int n_in, void* d_out, int out_size, void* d_ws, size_t ws_size,
                              hipStream_t stream) {
  static int grid_blocks = 0;
  if (!grid_blocks) {
    int dev = 0, cus = 0, per_cu = 0;
    hipGetDevice(&dev);
    hipDeviceGetAttribute(&cus, hipDeviceAttributeMultiprocessorCount, dev);
    hipFuncSetAttribute((const void*)mega_kernel, hipFuncAttributeMaxDynamicSharedMemorySize, SMEM_BYTES);
    hipOccupancyMaxActiveBlocksPerMultiprocessor(&per_cu, (const void*)mega_kernel, 512, SMEM_BYTES);
    if (per_cu < 1) per_cu = 1;
    if (per_cu > 1) per_cu = 1;
    grid_blocks = cus * per_cu;
  }
  Params p{};
  const float** pin = (const float**)&p;
  for (int i = 0; i < 32; ++i) pin[i] = (const float*)d_in[i];
  p.out = (float*)d_out;
  char* ws = (char*)d_ws;
  size_t off = 0;
  p.bar = (unsigned*)(ws + off); off += 16384;
  p.rstat = (float*)(ws + off); off += (size_t)MT * 2 * 4;
  p.kb_lat = (bf16_t*)(ws + off); off += (size_t)2 * 8 * 2 * 1280 * 64 * 2;
  p.vt_lat = (bf16_t*)(ws + off); off += (size_t)2 * 8 * 2 * 1280 * 64 * 2;
  p.kb_ctx = (bf16_t*)(ws + off); off += (size_t)32 * 2 * 256 * 64 * 2;
  p.vt_ctx = (bf16_t*)(ws + off); off += (size_t)32 * 2 * 256 * 64 * 2;
  p.wt_in = (bf16_t*)(ws + off); off += (size_t)2 * 1792 * 1024 * 2;
  p.wt_out = (bf16_t*)(ws + off); off += (size_t)2 * 1024 * 1024 * 2;
  p.wt_ff1 = (bf16_t*)(ws + off); off += (size_t)2 * 4096 * 1024 * 2;
  p.wt_ff2 = (bf16_t*)(ws + off); off += (size_t)2 * 4096 * 1024 * 2;
  p.wt_lru = (bf16_t*)(ws + off); off += (size_t)64 * 4096 * 2;
  p.mod = (float*)(ws + off); off += (size_t)2 * 9 * 6144 * 4;
  p.rope = (float*)(ws + off); off += (size_t)2048 * 4;
  p.cdec = (float*)(ws + off); off += (size_t)1024 * 4;
  p.abuf = (bf16_t*)(ws + off); off += (size_t)MT * 1024 * 2;
  p.zf = (bf16_t*)(ws + off);
  p.au = (float*)(ws + off + (size_t)MT * 1792 * 2);
  off += (size_t)MT * 4096 * 2;
  if (off > ws_size) { fprintf(stderr, "workspace too small: need %zu have %zu\n", off, ws_size); return; }
  (void)hipMemsetAsync(p.bar, 0, XCD_BAR_WORDS * 4, stream);
#if MULTI_LAUNCH
  for (int ph = 0; ph < NPHASE; ++ph) {
    hipLaunchKernelGGL(mega_kernel, dim3(grid_blocks), dim3(512), SMEM_BYTES, stream, p, ph, ph + 1);
  }
#else
  int lo = 0, hi = NPHASE;
  void* args[] = {&p, &lo, &hi};
  hipError_t e = hipLaunchCooperativeKernel((void*)mega_kernel, dim3(grid_blocks), dim3(512), args, SMEM_BYTES, stream);
  if (e != hipSuccess) fprintf(stderr, "cooperative launch failed: %s (grid %d)\n", hipGetErrorString(e), grid_blocks);
#endif
}
```

```cpp
#include <hip/hip_runtime.h>
#include <hip/hip_cooperative_groups.h>
#include <cstdio>
#include <cstdint>
namespace cg = cooperative_groups;

#ifndef MULTI_LAUNCH
#define MULTI_LAUNCH 0
#endif

typedef unsigned short bf16_t;
using bf16x8 = __attribute__((ext_vector_type(8))) short;
using f32x4 = __attribute__((ext_vector_type(4))) float;
#define DEV __device__ __forceinline__
#define VTID ((int)(threadIdx.x & 255))
#define VBID ((int)(blockIdx.x * 2 + (threadIdx.x >> 8)))
#define VNB ((int)(gridDim.x * 2))

constexpr int MT = 16384;
constexpr int NPHASE = 18;
constexpr size_t OFF_YK = 16777216, OFF_YV = OFF_YK + 2097152, OFF_ST = OFF_YV + 2097152;
constexpr float ALPHA = 1.41421356237f;
constexpr float QSCALE = 0.125f * 1.4426950408889634f;
constexpr int SMEM_BYTES = 131072;

struct Params {
  const float *x_prompt, *x_sample, *c, *cache_k, *cache_v, *state_lru, *c_ctx, *w_ada, *b_ada, *w_in,
      *q_g, *k_g, *conv_w, *conv_b, *lru_wa, *lru_ba, *lru_wx, *lru_bx, *lru_lam, *mlp_g, *mlp_b, *mlp_ws, *mlp_bs,
      *w_out, *ln1_g, *ln1_b, *w_ff1, *b_ff1, *w_ff2, *b_ff2, *ln2_g, *ln2_b;
  float* out;
  bf16_t *wt_in, *wt_out, *wt_ff1, *wt_ff2, *wt_lru;
  float *mod, *rope, *cdec;
  bf16_t *abuf;
  bf16_t *zf;
  float *au;
  bf16_t *kb_lat, *vt_lat;
  bf16_t *kb_ctx, *vt_ctx;
  unsigned *bar;
  float *rstat;
};

union U8 { uint4 u; bf16x8 v; bf16_t h[8]; unsigned w[4]; };

DEV float bf2f(bf16_t h) { return __uint_as_float(((unsigned)h) << 16); }
DEV bf16_t f2bf(float f) { unsigned u = __float_as_uint(f); u += 0x7fffu + ((u >> 16) & 1u); return (bf16_t)(u >> 16); }
DEV unsigned pack2(float a, float b) { unsigned r; asm volatile("v_cvt_pk_bf16_f32 %0, %1, %2" : "=v"(r) : "v"(a), "v"(b)); return r; }
DEV float gelu_t(float x) { float y = 0.7978845608028654f * (x + 0.044715f * x * x * x); float t = 1.f - 2.f * __builtin_amdgcn_rcpf(1.f + __expf(2.f * y)); return 0.5f * x * (1.f + t); }
DEV float sigmoidf_(float x) { return __builtin_amdgcn_rcpf(1.f + __expf(-x)); }
DEV int own_row(int x, int r) { return r < 1024 ? (x << 10) + r : 8192 + (x << 10) + (r - 1024); }
DEV int own_panel(int vp) { const int x = vp >> 3, lp = vp & 7; return lp < 4 ? 4 * x + lp : 32 + 4 * x + (lp - 4); }
DEV int xrow(int vm) { const int k = vm >> 11, c = (vm & 2047) >> 3, w = vm & 7; return own_row(c & 7, (k << 8) + ((c >> 3) << 3) + w); }
DEV int cond_of(int m) { return m < 8192 ? 0 : 1 + ((m - 8192) >> 10); }
DEV f32x4 mfma16(bf16x8 a, bf16x8 b, f32x4 c) { return __builtin_amdgcn_mfma_f32_16x16x32_bf16(a, b, c, 0, 0, 0); }
DEV float wave_sum(float v) {
#pragma unroll
  for (int o = 32; o >= 1; o >>= 1) v += __shfl_xor(v, o);
  return v;
}

DEV void transpose_tile(const float* __restrict__ src, bf16_t* __restrict__ dst, int lds_, int ldd, char* smem) {
  float* T = (float*)smem;
  const int tid = VTID;
#pragma unroll
  for (int i = 0; i < 4; ++i) {
    int k = (tid >> 4) + 16 * i, n4 = (tid & 15) * 4;
    float4 v = *(const float4*)(src + (size_t)k * lds_ + n4);
    T[k * 65 + n4 + 0] = v.x; T[k * 65 + n4 + 1] = v.y; T[k * 65 + n4 + 2] = v.z; T[k * 65 + n4 + 3] = v.w;
  }
  __syncthreads();
#pragma unroll
  for (int i = 0; i < 2; ++i) {
    int n = (tid >> 3) + 32 * i, k8 = (tid & 7) * 8;
    U8 o;
#pragma unroll
    for (int j = 0; j < 4; ++j) o.w[j] = pack2(T[(k8 + 2 * j) * 65 + n], T[(k8 + 2 * j + 1) * 65 + n]);
    *(uint4*)(dst + (size_t)n * ldd + k8) = o.u;
  }
  __syncthreads();
}
DEV void transpose_w(const float* __restrict__ W, bf16_t* __restrict__ Wt, int K, int N, int tk, int tn, char* smem) {
  transpose_tile(W + (size_t)(tk * 64) * N + tn * 64, Wt + (size_t)(tn * 64) * K + tk * 64, N, K, smem);
}

DEV void tr_desc(const Params& p, int t, const float*& src, int& lds_, bf16_t*& dst, int& ldd) {
  if (t < 2 * 2768) {
    const int l = t / 2768, r = t % 2768;
    const float* W; bf16_t* Wt; int K, N, tk, tn;
    if (r < 448) { W = p.w_in + (size_t)l * 1024 * 1792; Wt = p.wt_in + (size_t)l * 1792 * 1024; K = 1024; N = 1792; tk = r / 28; tn = r % 28; }
    else if (r < 704) { const int i = r - 448; W = p.w_out + (size_t)l * 1024 * 1024; Wt = p.wt_out + (size_t)l * 1024 * 1024; K = 1024; N = 1024; tk = i / 16; tn = i % 16; }
    else if (r < 1728) { const int i = r - 704; W = p.w_ff1 + (size_t)l * 1024 * 4096; Wt = p.wt_ff1 + (size_t)l * 4096 * 1024; K = 1024; N = 4096; tk = i / 64; tn = i % 64; }
    else if (r < 2752) { const int i = r - 1728; W = p.w_ff2 + (size_t)l * 4096 * 1024; Wt = p.wt_ff2 + (size_t)l * 1024 * 4096; K = 4096; N = 1024; tk = i / 16; tn = i % 16; }
    else {
      const int idx = r - 2752, dir = idx >> 3, blk = (idx >> 1) & 3, mat = idx & 1;
      src = (mat == 0 ? p.lru_wa : p.lru_wx) + (size_t)(((l * 2 + dir) * 4 + blk)) * 4096; lds_ = 64;
      dst = p.wt_lru + (size_t)((((l * 2 + dir) * 4 + blk) * 2 + mat)) * 4096; ldd = 64; return;
    }
    src = W + (size_t)(tk * 64) * N + tn * 64; lds_ = N; dst = Wt + (size_t)(tn * 64) * K + tk * 64; ldd = K;
  } else {
    const int j = t - 2 * 2768, tt = j & 3, kvh = (j >> 2) & 1, l = (j >> 3) & 1, b = j >> 4;
    src = p.cache_v + ((size_t)(b * 2 + l) * 256 + tt * 64) * 128 + kvh * 64; lds_ = 128;
    dst = p.vt_lat + ((size_t)((l * 8 + b) * 2 + kvh) * 64) * 1280 + tt * 64; ldd = 1280;
  }
}

DEV int tr_map(int list, int idx) {
  if (list == 0) return idx < 448 ? idx : (idx < 464 ? 2752 + (idx - 448) : (idx < 480 ? 5520 + (idx - 464) : 5536 + (idx - 480)));
  return idx < 2304 ? 448 + idx : 2768 + (idx - 2304);
}
DEV void transpose_all(const Params& p, char* smem, int list, int hb, int nhb) {
  const int NTR = list == 0 ? 608 : 5056;
  float* T = (float*)smem;
  const int tid = VTID, kr = tid >> 4, n4 = (tid & 15) * 4;
  int t = hb;
  if (t >= NTR) return;
  const float* src; bf16_t* dst; int lds_, ldd;
  tr_desc(p, tr_map(list, t), src, lds_, dst, ldd);
  float4 cur[4];
#pragma unroll
  for (int i = 0; i < 4; ++i) cur[i] = *(const float4*)(src + (size_t)(kr + 16 * i) * lds_ + n4);
  while (t < NTR) {
    const int tn = t + nhb;
    const float* nsrc = src; bf16_t* ndst = dst; int nlds = lds_, nldd = ldd;
    float4 nxt[4];
    if (tn < NTR) {
      tr_desc(p, tr_map(list, tn), nsrc, nlds, ndst, nldd);
#pragma unroll
      for (int i = 0; i < 4; ++i) nxt[i] = *(const float4*)(nsrc + (size_t)(kr + 16 * i) * nlds + n4);
    }
#pragma unroll
    for (int i = 0; i < 4; ++i) {
      const int k = kr + 16 * i;
      T[k * 65 + n4 + 0] = cur[i].x; T[k * 65 + n4 + 1] = cur[i].y; T[k * 65 + n4 + 2] = cur[i].z; T[k * 65 + n4 + 3] = cur[i].w;
    }
    __syncthreads();
#pragma unroll
    for (int i = 0; i < 2; ++i) {
      const int n = (tid >> 3) + 32 * i, k8 = (tid & 7) * 8;
      U8 o;
#pragma unroll
      for (int j = 0; j < 4; ++j) o.w[j] = pack2(T[(k8 + 2 * j) * 65 + n], T[(k8 + 2 * j + 1) * 65 + n]);
      *(uint4*)(dst + (size_t)n * ldd + k8) = o.u;
    }
    __syncthreads();
    if (tn < NTR) {
#pragma unroll
      for (int i = 0; i < 4; ++i) cur[i] = nxt[i];
    }
    src = nsrc; dst = ndst; lds_ = nlds; ldd = nldd; t = tn;
  }
}

DEV void phase0(const Params& p, char* smem) {
  const int tid = VTID;
  const int NT0 = 192 - 128, NITEMS = 192 + 64 + 2;
  for (int it = VBID; it < NITEMS; it += VNB) {
    if (it < 192) {
      const int l = it / 96, n0 = (it % 96) * 64;
      float* s = (float*)smem;
      float* red = s + 9 * 1024;
      for (int idx = tid; idx < 9 * 1024; idx += 256) {
        int c = idx >> 10, k = idx & 1023;
        float v = (c == 0) ? p.c_ctx[k] : p.c[(c - 1) * 1024 + k];
        s[idx] = v / (1.f + __expf(-v));
      }
      __syncthreads();
      const int w = tid >> 6, lane = tid & 63, cq = lane & 15, ks = lane >> 4;
      const int kbase = (w * 4 + ks) * 64;
      float acc[9][4];
#pragma unroll
      for (int c = 0; c < 9; ++c) { acc[c][0] = 0.f; acc[c][1] = 0.f; acc[c][2] = 0.f; acc[c][3] = 0.f; }
      const float* wp = p.w_ada + ((size_t)l * 1024 + kbase) * 6144 + n0 + cq * 4;
      for (int kb = 0; kb < 64; kb += 16) {
        float4 wv[16];
#pragma unroll
        for (int j = 0; j < 16; ++j) wv[j] = *(const float4*)(wp + (size_t)(kb + j) * 6144);
#pragma unroll
        for (int j = 0; j < 16; ++j)
#pragma unroll
          for (int c = 0; c < 9; ++c) {
            const float sv = s[c * 1024 + kbase + kb + j];
            acc[c][0] += sv * wv[j].x; acc[c][1] += sv * wv[j].y; acc[c][2] += sv * wv[j].z; acc[c][3] += sv * wv[j].w;
          }
      }
#pragma unroll
      for (int c = 0; c < 9; ++c)
#pragma unroll
        for (int e = 0; e < 4; ++e) {
          float a = acc[c][e];
          a += __shfl_xor(a, 16); a += __shfl_xor(a, 32);
          if (ks == 0) red[(w * 9 + c) * 64 + cq * 4 + e] = a;
        }
      __syncthreads();
      for (int idx = tid; idx < 576; idx += 256) {
        int c = idx >> 6, nn = idx & 63;
        float v = red[(0 * 9 + c) * 64 + nn] + red[(1 * 9 + c) * 64 + nn] + red[(2 * 9 + c) * 64 + nn] + red[(3 * 9 + c) * 64 + nn] +
                  p.b_ada[l * 6144 + n0 + nn];
        p.mod[((size_t)l * 9 + c) * 6144 + n0 + nn] = v;
      }
      __syncthreads();
    } else if (it >= NT0 + 128 && it < NT0 + 192) {
      const int j = it - NT0 - 128;
#pragma unroll
      for (int i = 0; i < 4; ++i) {
        const int e = (j * 1024 + i * 256 + tid) * 8;
        const int d = e & 63, kvh = (e >> 6) & 1, t = (e >> 7) & 255, l = (e >> 15) & 1, b = e >> 16;
        const float4 a0 = *(const float4*)(p.cache_k + e), a1 = *(const float4*)(p.cache_k + e + 4);
        U8 o; o.w[0] = pack2(a0.x, a0.y); o.w[1] = pack2(a0.z, a0.w); o.w[2] = pack2(a1.x, a1.y); o.w[3] = pack2(a1.z, a1.w);
        *(uint4*)(p.kb_lat + ((size_t)((l * 8 + b) * 2 + kvh) * 1280 + t) * 64 + d) = o.u;
      }
    } else if (it >= NT0 + 192) {
      if (it == NT0 + 192)
      for (int idx = tid; idx < 1024; idx += 256) {
        int pp = idx >> 4, f = idx & 15;
        float inv = powf(10000.f, -(float)f / 16.f);
        float ang = (float)pp * inv;
        float nrev = rintf(ang * 0.15915494309189535f);
        float r = fmaf(-nrev, 6.28125f, ang);
        r = fmaf(-nrev, 0.0019353071795864769f, r);
        p.rope[idx * 2 + 0] = __cosf(r);
        p.rope[idx * 2 + 1] = __sinf(r);
      }
      if (it == NT0 + 192)
      for (int idx = tid; idx < 1024; idx += 256) {
        const float xn = -p.lru_lam[idx];
        p.cdec[idx] = -8.f * (fmaxf(xn, 0.f) + log1pf(expf(-fabsf(xn))));
      }
    }
  }
  transpose_all(p, smem, 0, VBID, VNB);
}

DEV void ln_mod_phase(const Params& p, int l, int mode) {
  const int lane = threadIdx.x & 63, w = threadIdx.x >> 6;
  const float* lg = nullptr; const float* lb = nullptr;
  if (mode == 1) { lg = p.ln2_g + (l - 1) * 1024; lb = p.ln2_b + (l - 1) * 1024; }
  else if (mode == 2) { lg = p.ln1_g + l * 1024; lb = p.ln1_b + l * 1024; }
  else if (mode == 3) { lg = p.ln2_g + l * 1024; lb = p.ln2_b + l * 1024; }
  const int shoff = (mode == 2) ? 3072 : 0;
  const int mstride = gridDim.x * 8;
  float4 nv[4];
  {
    const int m = xrow(blockIdx.x * 8 + w);
    const float* src = (mode == 0) ? ((m < 8192) ? p.x_prompt + (size_t)m * 1024 : p.x_sample + (size_t)(m - 8192) * 1024) : p.out + (size_t)m * 1024;
#pragma unroll
    for (int i = 0; i < 4; ++i) nv[i] = *(const float4*)(src + i * 256 + lane * 4);
  }
  for (int vm = blockIdx.x * 8 + w; vm < MT; vm += mstride) {
    const int m = xrow(vm);
    float4 v[4];
#pragma unroll
    for (int i = 0; i < 4; ++i) v[i] = nv[i];
    {
      const int mn = xrow((vm + mstride < MT) ? vm + mstride : vm);
      const float* src = (mode == 0) ? ((mn < 8192) ? p.x_prompt + (size_t)mn * 1024 : p.x_sample + (size_t)(mn - 8192) * 1024) : p.out + (size_t)mn * 1024;
#pragma unroll
      for (int i = 0; i < 4; ++i) nv[i] = *(const float4*)(src + i * 256 + lane * 4);
    }
    if (mode != 0) {
      float s = 0.f;
#pragma unroll
      for (int i = 0; i < 4; ++i) s += v[i].x + v[i].y + v[i].z + v[i].w;
      const float mean = wave_sum(s) * (1.f / 1024.f);
      float s2 = 0.f;
#pragma unroll
      for (int i = 0; i < 4; ++i) { float a = v[i].x - mean, b = v[i].y - mean, c = v[i].z - mean, d = v[i].w - mean; s2 += a * a + b * b + c * c + d * d; }
      const float rstd = rsqrtf(wave_sum(s2) * (1.f / 1024.f) + 1e-6f);
#pragma unroll
      for (int i = 0; i < 4; ++i) {
        float4 g = *(const float4*)(lg + i * 256 + lane * 4), b = *(const float4*)(lb + i * 256 + lane * 4);
        v[i].x = (v[i].x - mean) * rstd * g.x + b.x; v[i].y = (v[i].y - mean) * rstd * g.y + b.y;
        v[i].z = (v[i].z - mean) * rstd * g.z + b.z; v[i].w = (v[i].w - mean) * rstd * g.w + b.w;
        if (mode == 3) *(float4*)(p.out + (size_t)m * 1024 + i * 256 + lane * 4) = v[i];
      }
      if (mode != 3 && lane == 0) *(float2*)(p.rstat + (size_t)m * 2) = make_float2(mean, rstd);
    }
    if (mode != 3) {
      const float* md = p.mod + ((size_t)l * 9 + cond_of(m)) * 6144 + shoff;
#pragma unroll
      for (int i = 0; i < 4; ++i) {
        float4 sh = *(const float4*)(md + i * 256 + lane * 4), sc = *(const float4*)(md + 1024 + i * 256 + lane * 4);
        uint2 o;
        o.x = pack2(v[i].x * (1.f + sc.x) + sh.x, v[i].y * (1.f + sc.y) + sh.y);
        o.y = pack2(v[i].z * (1.f + sc.z) + sh.z, v[i].w * (1.f + sc.w) + sh.w);
        *(uint2*)(p.abuf + (size_t)m * 1024 + i * 256 + lane * 4) = o;
      }
    }
  }
}

#define LAS3 __attribute__((address_space(3)))
namespace g8 {
constexpr int BM = 256, BK = 64, HALF = 128, HTB = HALF * BK * 2, NXCD = 8, WGM = 4;
DEV int lds_byte(int r, int c) { const int st = (r >> 4) * 2 + (c >> 5), rr = r & 15, cc = c & 31, ob = rr * 64 + cc * 2; return st * 1024 + (ob ^ (((ob >> 9) & 1) << 5)); }
DEV void stage_rc(int b, int& R, int& C) { const int st = b / 1024, sb = b % 1024, swz = sb ^ (((sb >> 9) & 1) << 5); R = (st >> 1) * 16 + swz / 64; C = (st & 1) * 32 + (swz % 64) / 2; }
DEV bool unit_of(int i, int nM, int nN, int& pm, int& pn) {
  const int nwg = nM * nN;
  const long L = (long)i * gridDim.x + blockIdx.x; if (L >= nwg) return false;
  int wgid = (int)L; { const int q = nwg / NXCD, r = nwg % NXCD, xcd = wgid % NXCD, off = wgid / NXCD; wgid = (xcd < r ? xcd * (q + 1) : r * (q + 1) + (xcd - r) * q) + off; }
  const int nig = WGM * nN, gid = wgid / nig, fm = gid * WGM, gsz = (nM - fm) < WGM ? (nM - fm) : WGM;
  pm = own_panel(fm + ((wgid % nig) % gsz)); pn = (wgid % nig) / gsz; return true;
}
}

template <int EPI>
DEV void gemm_epilogue(const Params& p, int l, f32x4 (&acc)[2][2][4][2], int pm, int pn, int wr, int wc, int fr, int fq) {
  const int brow = pm * 256, bcol = pn * 256;
  const float* md = p.mod + ((size_t)l * 9 + cond_of(brow)) * 6144;
#pragma unroll
  for (int bj = 0; bj < 2; ++bj)
#pragma unroll
    for (int n = 0; n < 2; ++n) {
      const int col = bcol + bj * 128 + wc * 32 + n * 16 + fq * 4;
      float4 gate = make_float4(0.f, 0.f, 0.f, 0.f), bias = make_float4(0.f, 0.f, 0.f, 0.f);
      if (EPI == 2) gate = *(const float4*)(md + 2048 + col);
      if (EPI == 3) bias = *(const float4*)(p.b_ff1 + l * 4096 + col);
      if (EPI == 4) { gate = *(const float4*)(md + 5120 + col); bias = *(const float4*)(p.b_ff2 + l * 1024 + col); }
#pragma unroll
      for (int ai = 0; ai < 2; ++ai)
#pragma unroll
        for (int m = 0; m < 4; ++m) {
          const int row = brow + ai * 128 + wr * 64 + m * 16 + fr;
          const f32x4 v = acc[ai][bj][m][n];
          if (EPI == 1) {
            uint2 o; o.x = pack2(v[0], v[1]); o.y = pack2(v[2], v[3]);
            *(uint2*)(p.zf + (size_t)row * 1792 + col) = o;
          } else if (EPI == 2) {
            const float* xs = (l == 0) ? ((row < 8192) ? p.x_prompt + (size_t)row * 1024 : p.x_sample + (size_t)(row - 8192) * 1024) : p.out + (size_t)row * 1024;
            const float4 x = *(const float4*)(xs + col);
            *(float4*)(p.out + (size_t)row * 1024 + col) = make_float4(ALPHA * x.x + gate.x * v[0], ALPHA * x.y + gate.y * v[1], ALPHA * x.z + gate.z * v[2], ALPHA * x.w + gate.w * v[3]);
          } else if (EPI == 3) {
            const float t0 = fmaxf(v[0] + bias.x, 0.f), t1 = fmaxf(v[1] + bias.y, 0.f), t2 = fmaxf(v[2] + bias.z, 0.f), t3 = fmaxf(v[3] + bias.w, 0.f);
            uint2 o; o.x = pack2(t0 * t0, t1 * t1); o.y = pack2(t2 * t2, t3 * t3);
            *(uint2*)(p.zf + (size_t)row * 4096 + col) = o;
          } else {
            float* xo = p.out + (size_t)row * 1024 + col;
            const float4 x = *(const float4*)xo;
            *(float4*)xo = make_float4(ALPHA * x.x + gate.x * (v[0] + bias.x), ALPHA * x.y + gate.y * (v[1] + bias.y), ALPHA * x.z + gate.z * (v[2] + bias.z), ALPHA * x.w + gate.w * (v[3] + bias.w));
          }
        }
    }
}

template <int EPI>
DEV void gemm_epilogue_lnres(const Params& p, int l, f32x4 (&acc)[2][2][4][2], int pm, int pn, int wr, int wc, int fr, int fq) {
  const int brow = pm * 256, bcol = pn * 256;
  const float* md = p.mod + ((size_t)l * 9 + cond_of(brow)) * 6144;
  float mean[2][4], rstd[2][4];
  {
    const unsigned so = (unsigned)(brow + wr * 64 + fr) * 2u;
#pragma unroll
    for (int ai = 0; ai < 2; ++ai)
#pragma unroll
      for (int m = 0; m < 4; ++m) { const float2 t = *(const float2*)(p.rstat + (so + (unsigned)((ai * 128 + m * 16) * 2))); mean[ai][m] = t.x; rstd[ai][m] = t.y; }
  }
  const float* lg = (EPI == 2) ? p.ln2_g + (l - 1) * 1024 : p.ln1_g + l * 1024;
  const float* lb = (EPI == 2) ? p.ln2_b + (l - 1) * 1024 : p.ln1_b + l * 1024;
  const unsigned co = (unsigned)(bcol + wc * 32 + fq * 4);
  const unsigned ro = (unsigned)(brow + wr * 64 + fr) * 1024u + co;
#pragma unroll
  for (int bj = 0; bj < 2; ++bj)
#pragma unroll
    for (int n = 0; n < 2; ++n) {
      unsigned col = co + (unsigned)(bj * 128 + n * 16), rb = ro + (unsigned)(bj * 128 + n * 16);
      asm volatile("" : "+v"(col), "+v"(rb));
      float4 gate, bias = make_float4(0.f, 0.f, 0.f, 0.f);
      if (EPI == 2) gate = *(const float4*)(md + 2048 + col);
      else { gate = *(const float4*)(md + 5120 + col); bias = *(const float4*)(p.b_ff2 + l * 1024 + col); }
      const float4 g4 = *(const float4*)(lg + col), b4 = *(const float4*)(lb + col);
#pragma unroll
      for (int ai = 0; ai < 2; ++ai)
#pragma unroll
        for (int m = 0; m < 4; ++m) {
          float* xo = p.out + (rb + (unsigned)((ai * 128 + m * 16) * 1024));
          const float4 x = *(const float4*)xo;
          const float mu = mean[ai][m], rr = rstd[ai][m];
          const f32x4 v = acc[ai][bj][m][n];
          const float x0 = (x.x - mu) * rr * g4.x + b4.x, x1 = (x.y - mu) * rr * g4.y + b4.y, x2 = (x.z - mu) * rr * g4.z + b4.z, x3 = (x.w - mu) * rr * g4.w + b4.w;
          *(float4*)xo = make_float4(ALPHA * x0 + gate.x * (v[0] + bias.x), ALPHA * x1 + gate.y * (v[1] + bias.y), ALPHA * x2 + gate.z * (v[2] + bias.z), ALPHA * x3 + gate.w * (v[3] + bias.w));
        }
    }
}

template <int EPI>
DEV void gemm_phase(const Params& p, int l, const bf16_t* Ag, const bf16_t* Btg, int N, int K, LAS3 unsigned char* lds) {
  using namespace g8;
  const int tid = threadIdx.x, wid = __builtin_amdgcn_readfirstlane(tid >> 6), lane = tid & 63, wr = wid >> 2, wc = wid & 3, fr = lane & 15, fq = lane >> 4;
  const int nt = K / BK, nM = MT / BM, nN = N / BM;
  unsigned voff[2];
#pragma unroll
  for (int i = 0; i < 2; ++i) { int R, C; stage_rc(tid * 16 + i * 8192, R, C); voff[i] = (unsigned)(R * K + C) * 2u; }
  const size_t kstep = (size_t)(BK * 2);
  const size_t hstep = (size_t)HALF * K * 2;
  const size_t tstep = 2 * hstep;
  const unsigned ldsw = (unsigned)wid * 1024u;
  const int aoff = lds_byte(wr * 64 + fr, fq * 8), boff = lds_byte(wc * 32 + fr, fq * 8);
#define PG8_SA(b, h) (((b) * 2 + (h)) * HTB)
#define PG8_SB(b, h) ((4 + (b) * 2 + (h)) * HTB)
#define PG8_STAGE(bufoff, gbase) do { _Pragma("unroll") for (int _i = 0; _i < 2; ++_i) \
    __builtin_amdgcn_global_load_lds((const unsigned*)((const char*)(gbase) + voff[_i]), (LAS3 unsigned*)(lds + (bufoff) + ldsw + _i * 8192), 16, 0, 0); } while (0)
#define PG8_LDA(dst, b, h) do { _Pragma("unroll") for (int m = 0; m < 4; ++m) _Pragma("unroll") for (int k = 0; k < 2; ++k) dst[m][k] = *(const LAS3 bf16x8*)(lds + PG8_SA(b, h) + aoff + m * 2048 + k * 1024); } while (0)
#define PG8_LDB(dst, b, h) do { _Pragma("unroll") for (int n = 0; n < 2; ++n) _Pragma("unroll") for (int k = 0; k < 2; ++k) dst[n][k] = *(const LAS3 bf16x8*)(lds + PG8_SB(b, h) + boff + n * 2048 + k * 1024); } while (0)
#define PG8_MMA(ai, bj, At_, Bt_) do { __builtin_amdgcn_s_setprio(1); _Pragma("unroll") for (int m = 0; m < 4; ++m) _Pragma("unroll") for (int n = 0; n < 2; ++n) _Pragma("unroll") for (int k = 0; k < 2; ++k) \
    acc[ai][bj][m][n] = __builtin_amdgcn_mfma_f32_16x16x32_bf16(Bt_[n][k], At_[m][k], acc[ai][bj][m][n], 0, 0, 0); __builtin_amdgcn_s_setprio(0); } while (0)
#define PG8_WAIT_V(n) asm volatile("s_waitcnt vmcnt(" #n ")" ::: "memory")
#define PG8_WAIT_L(n) asm volatile("s_waitcnt lgkmcnt(" #n ")" ::: "memory")
#define PG8_BAR __builtin_amdgcn_s_barrier()
#define PG8_SCHED __builtin_amdgcn_sched_barrier(0)
  int cpm, cpn, npm = 0, npn = 0, ui = 0;
  if (!unit_of(0, nM, nN, cpm, cpn)) return;
  f32x4 acc[2][2][4][2];
#pragma unroll
  for (int a = 0; a < 2; ++a)
#pragma unroll
    for (int b = 0; b < 2; ++b)
#pragma unroll
      for (int m = 0; m < 4; ++m)
#pragma unroll
        for (int n = 0; n < 2; ++n) acc[a][b][m][n] = (f32x4){0.f, 0.f, 0.f, 0.f};
  bf16x8 At[4][2], B0[2][2], B1[2][2];
  const char* cA = (const char*)Ag + (size_t)cpm * tstep; const char* cB = (const char*)Btg + (size_t)cpn * tstep;
  PG8_STAGE(PG8_SB(0, 0), cB); PG8_STAGE(PG8_SA(0, 0), cA); PG8_STAGE(PG8_SB(0, 1), cB + hstep); PG8_STAGE(PG8_SA(0, 1), cA + hstep);
  if (wr == 1) PG8_BAR;
  PG8_WAIT_V(4); PG8_BAR;
  PG8_STAGE(PG8_SB(1, 0), cB + kstep); PG8_STAGE(PG8_SA(1, 0), cA + kstep); PG8_STAGE(PG8_SB(1, 1), cB + hstep + kstep);
  PG8_WAIT_V(6); PG8_BAR;
  for (;;) {
    const bool has_next = unit_of(ui + 1, nM, nN, npm, npn);
    const char* nA = has_next ? (const char*)Ag + (size_t)npm * tstep : cA; const char* nB = has_next ? (const char*)Btg + (size_t)npn * tstep : cB;
    for (int t = 0; t < nt; t += 2) {
      const bool last = (t == nt - 2);
      const char* a1 = cA + (size_t)(t + 1) * kstep;
      const char* a2 = last ? nA : cA + (size_t)(t + 2) * kstep; const char* b2 = last ? nB : cB + (size_t)(t + 2) * kstep;
      const char* a3 = a2 + kstep; const char* b3 = b2 + kstep;
      PG8_LDB(B0, 0, 0); PG8_SCHED; PG8_LDA(At, 0, 0); PG8_STAGE(PG8_SA(1, 1), a1 + hstep);
      PG8_WAIT_L(8); PG8_BAR; PG8_WAIT_L(0); PG8_MMA(0, 0, At, B0); PG8_BAR; PG8_SCHED;
      PG8_LDB(B1, 0, 1); PG8_STAGE(PG8_SB(0, 0), b2);
      PG8_BAR; PG8_WAIT_L(0); PG8_MMA(0, 1, At, B1); PG8_BAR;
      PG8_LDA(At, 0, 1); PG8_STAGE(PG8_SA(0, 0), a2);
      PG8_BAR; PG8_WAIT_L(0); PG8_MMA(1, 0, At, B0); PG8_BAR; PG8_SCHED;
      PG8_STAGE(PG8_SB(0, 1), b2 + hstep);
      PG8_WAIT_V(6); PG8_BAR; PG8_MMA(1, 1, At, B1); PG8_BAR;
      PG8_LDB(B0, 1, 0); PG8_SCHED; PG8_LDA(At, 1, 0); PG8_STAGE(PG8_SA(0, 1), a2 + hstep);
      PG8_WAIT_L(8); PG8_BAR; PG8_WAIT_L(0); PG8_MMA(0, 0, At, B0); PG8_BAR; PG8_SCHED;
      PG8_LDB(B1, 1, 1); PG8_STAGE(PG8_SB(1, 0), b3);
      PG8_BAR; PG8_WAIT_L(0); PG8_MMA(0, 1, At, B1); PG8_BAR;
      PG8_LDA(At, 1, 1); PG8_STAGE(PG8_SA(1, 0), a3);
      PG8_BAR; PG8_WAIT_L(0); PG8_MMA(1, 0, At, B0); PG8_BAR; PG8_SCHED;
      PG8_STAGE(PG8_SB(1, 1), b3 + hstep);
      PG8_WAIT_V(6); PG8_BAR; PG8_MMA(1, 1, At, B1); PG8_BAR;
    }
    if (EPI == 4 || (EPI == 2 && l > 0)) gemm_epilogue_lnres<EPI>(p, l, acc, cpm, cpn, wr, wc, fr, fq);
    else gemm_epilogue<EPI>(p, l, acc, cpm, cpn, wr, wc, fr, fq);
    if (!has_next) break;
#pragma unroll
    for (int a = 0; a < 2; ++a)
#pragma unroll
      for (int b = 0; b < 2; ++b)
#pragma unroll
        for (int m = 0; m < 4; ++m)
#pragma unroll
          for (int n = 0; n < 2; ++n) acc[a][b][m][n] = (f32x4){0.f, 0.f, 0.f, 0.f};
    cpm = npm; cpn = npn; cA = nA; cB = nB; ++ui;
  }
  PG8_WAIT_V(0);
  if (wr == 0) PG8_BAR;
  PG8_BAR;
#undef PG8_SA
#undef PG8_SB
#undef PG8_STAGE
#undef PG8_LDA
#undef PG8_LDB
#undef PG8_MMA
#undef PG8_WAIT_V
#undef PG8_WAIT_L
#undef PG8_BAR
#undef PG8_SCHED
}

DEV void rope8(float (&v)[8], int d0, int prow, int pcol, const float* __restrict__ rope) {
  const int pp = (d0 < 32) ? prow : pcol;
#pragma unroll
  for (int i = 0; i < 4; ++i) {
    const int f = ((d0 >> 1) + i) & 15;
    const float cs = rope[(pp * 16 + f) * 2], sn = rope[(pp * 16 + f) * 2 + 1];
    const float x1 = v[2 * i], x2 = v[2 * i + 1];
    v[2 * i] = x1 * cs - x2 * sn; v[2 * i + 1] = x1 * sn + x2 * cs;
  }
}

DEV void prep_token_row(const Params& p, int l, int m, int lane, uint4 c) {
  bf16_t* zr = p.zf + (size_t)m * 1792;
  const bool lat = m >= 8192;
  const int pos = lat ? ((m - 8192) & 1023) : (m & 255);
  const int prow = pos >> 6, pcol = pos & 63;
  const int d0 = (lane & 7) * 8;
  U8 u; u.u = c;
  float v[8], gl[8]; float ss = 0.f, sg = 0.f;
#pragma unroll
  for (int j = 0; j < 8; ++j) { v[j] = bf2f(u.h[j]); ss += v[j] * v[j]; gl[j] = gelu_t(v[j]); sg += gl[j]; }
  ss += __shfl_xor(ss, 1); ss += __shfl_xor(ss, 2); ss += __shfl_xor(ss, 4);
#pragma unroll
  for (int o = 1; o <= 16; o <<= 1) sg += __shfl_xor(sg, o);
  const float mean = sg * (1.f / 256.f);
  float s2 = 0.f;
#pragma unroll
  for (int j = 0; j < 8; ++j) { const float d = gl[j] - mean; s2 += d * d; }
#pragma unroll
  for (int o = 1; o <= 16; o <<= 1) s2 += __shfl_xor(s2, o);
  if (lane < 16) {
    const float rinv = rsqrtf(ss * (1.f / 64.f) + 1e-6f);
#pragma unroll
    for (int j = 0; j < 8; ++j) v[j] = v[j] * rinv * p.k_g[l * 64 + d0 + j];
    if (!lat) {
      float* o = p.out + OFF_YK + ((((size_t)(m >> 8)) * 2 + l) * 256 + pos) * 128 + lane * 8;
      *(float4*)o = make_float4(v[0], v[1], v[2], v[3]); *(float4*)(o + 4) = make_float4(v[4], v[5], v[6], v[7]);
    } else rope8(v, d0, prow, pcol, p.rope);
#pragma unroll
    for (int j = 0; j < 4; ++j) u.w[j] = pack2(v[2 * j], v[2 * j + 1]);
    const int kvh = lane >> 3;
    bf16_t* kd = lat ? p.kb_lat + ((size_t)((l * 8 + ((m - 8192) >> 10)) * 2 + kvh) * 1280 + 256 + pos) * 64 + d0
                     : p.kb_ctx + ((size_t)((m >> 8) * 2 + kvh) * 256 + pos) * 64 + d0;
    *(uint4*)kd = u.u;
  } else if (lane < 32) {
    if (!lat) {
      float* o = p.out + OFF_YV + ((((size_t)(m >> 8)) * 2 + l) * 256 + pos) * 128 + (lane - 16) * 8;
      *(float4*)o = make_float4(v[0], v[1], v[2], v[3]); *(float4*)(o + 4) = make_float4(v[4], v[5], v[6], v[7]);
    }
    const int kvh = (lane - 16) >> 3;
    bf16_t* vd; int T;
    if (lat) { T = 1280; vd = p.vt_lat + ((size_t)((l * 8 + ((m - 8192) >> 10)) * 2 + kvh) * 64 + d0) * 1280 + 256 + pos; }
    else { T = 256; vd = p.vt_ctx + ((size_t)((m >> 8) * 2 + kvh) * 64 + d0) * 256 + pos; }
#pragma unroll
    for (int j = 0; j < 8; ++j) vd[(size_t)j * T] = u.h[j];
  } else {
    const float rstd = rsqrtf(s2 * (1.f / 256.f) + 1e-6f);
    const int ch = (lane - 32) * 8;
#pragma unroll
    for (int j = 0; j < 8; ++j) gl[j] = (gl[j] - mean) * rstd * p.mlp_g[l * 256 + ch + j] + p.mlp_b[l * 256 + ch + j];
#pragma unroll
    for (int j = 0; j < 4; ++j) u.w[j] = pack2(gl[2 * j], gl[2 * j + 1]);
    *(uint4*)(zr + 1536 + ch) = u.u;
  }
}

template <bool REV>
DEV void tile_scan(float (&a)[4][4], float (&u)[4][4], int lane) {
  const int q = lane >> 4;
  float C = 0.f, CP = 1.f;
  const int src1 = (REV ? lane + 16 : lane - 16) & 63;
  const int src2 = (REV ? lane + 32 : lane - 32) & 63;
  const int srcT = (lane & 15) + (REV ? 0 : 48);
  const bool c1 = REV ? (q <= 2) : (q >= 1);
  const bool c2 = REV ? (q <= 1) : (q >= 2);
  const bool first = REV ? (q == 3) : (q == 0);
#pragma unroll
  for (int mi = 0; mi < 4; ++mi) {
    const int mt = REV ? 3 - mi : mi;
    float P = 1.f, H = 0.f, pl[4], hl[4];
#pragma unroll
    for (int ri = 0; ri < 4; ++ri) {
      const int r = REV ? 3 - ri : ri;
      H = a[mt][r] * H + u[mt][r]; P *= a[mt][r]; pl[r] = P; hl[r] = H;
    }
    float Pi = P, Hi = H;
    float Pp = __shfl(Pi, src1), Hp = __shfl(Hi, src1);
    if (c1) { Hi = Pi * Hp + Hi; Pi = Pi * Pp; }
    Pp = __shfl(Pi, src2); Hp = __shfl(Hi, src2);
    if (c2) { Hi = Pi * Hp + Hi; Pi = Pi * Pp; }
    float Pe = __shfl(Pi, src1), He = __shfl(Hi, src1);
    if (first) { Pe = 1.f; He = 0.f; }
    const float hin = Pe * C + He, pin = Pe * CP;
#pragma unroll
    for (int r = 0; r < 4; ++r) { u[mt][r] = pl[r] * hin + hl[r]; a[mt][r] = pl[r] * pin; }
    const float Pt = __shfl(Pi, srcT), Ht = __shfl(Hi, srcT);
    C = Pt * C + Ht; CP = Pt * CP;
  }
}

DEV void lru_gate_item(const Params& p, int l, int item, char* smem) {
  const int tid = VTID, lane = tid & 63, w = tid >> 6;
  const int tile = item >> 2, blk = item & 3;
  const int m0 = tile * 64;
  int ms, L;
  if (m0 < 8192) { ms = m0 & ~255; L = 256; } else { ms = 8192 + ((m0 - 8192) & ~1023); L = 1024; }
  const int dir = w >> 1, half = w & 1, q = lane >> 4, c15 = lane & 15;
  const bf16_t* wt = p.wt_lru + (size_t)((((l * 2 + dir) * 4 + blk) * 2)) * 4096;
  bf16x8 bfr[2][2][2];
#pragma unroll
  for (int mat = 0; mat < 2; ++mat)
#pragma unroll
    for (int j = 0; j < 2; ++j)
#pragma unroll
      for (int s = 0; s < 2; ++s) bfr[mat][j][s] = *(const bf16x8*)(wt + mat * 4096 + (half * 32 + j * 16 + c15) * 64 + s * 32 + q * 8);
  float* xs = (float*)smem;
  float* xcf = xs + 67 * 64;
  bf16_t* xcb = (bf16_t*)(xcf + 64 * 64);
  for (int idx = tid; idx < 67 * 8; idx += 256) {
    const int rr = idx >> 3, cc = idx & 7;
    const int m = m0 - 1 + rr;
    float v[8];
    if (m >= ms && m < ms + L) {
      U8 u; u.u = *(const uint4*)(p.zf + (size_t)m * 1792 + 768 + blk * 64 + cc * 8);
#pragma unroll
      for (int j = 0; j < 8; ++j) v[j] = bf2f(u.h[j]);
    } else {
#pragma unroll
      for (int j = 0; j < 8; ++j) v[j] = 0.f;
    }
#pragma unroll
    for (int j = 0; j < 8; ++j) xs[rr * 64 + cc * 8 + j] = v[j];
  }
  __syncthreads();
  {
    const int ch = tid & 63, Cg = blk * 64 + ch;
    const float w0 = p.conv_w[(l * 4 + 0) * 256 + Cg], w1 = p.conv_w[(l * 4 + 1) * 256 + Cg], w2 = p.conv_w[(l * 4 + 2) * 256 + Cg],
                w3 = p.conv_w[(l * 4 + 3) * 256 + Cg], cb = p.conv_b[l * 256 + Cg];
#pragma unroll 4
    for (int tt = 0; tt < 16; ++tt) {
      const int t = (tid >> 6) * 16 + tt;
      const float v = cb + w0 * xs[t * 64 + ch] + w1 * xs[(t + 1) * 64 + ch] + w2 * xs[(t + 2) * 64 + ch] + w3 * xs[(t + 3) * 64 + ch];
      xcf[t * 64 + ch] = v; xcb[t * 72 + ch] = f2bf(v);
    }
  }
  __syncthreads();
  f32x4 acc[2][4][2];
#pragma unroll
  for (int mat = 0; mat < 2; ++mat)
#pragma unroll
    for (int mt = 0; mt < 4; ++mt)
#pragma unroll
      for (int j = 0; j < 2; ++j) acc[mat][mt][j] = f32x4{0.f, 0.f, 0.f, 0.f};
#pragma unroll
  for (int mt = 0; mt < 4; ++mt)
#pragma unroll
    for (int s = 0; s < 2; ++s) {
      const bf16x8 af = *(const bf16x8*)(xcb + (mt * 16 + c15) * 72 + s * 32 + q * 8);
#pragma unroll
      for (int mat = 0; mat < 2; ++mat)
#pragma unroll
        for (int j = 0; j < 2; ++j) acc[mat][mt][j] = mfma16(af, bfr[mat][j][s], acc[mat][mt][j]);
    }
  float* PCp = p.au + (size_t)(dir * 2 + 0) * MT * 256;
  float* HLp = p.au + (size_t)(dir * 2 + 1) * MT * 256;
#pragma unroll
  for (int j = 0; j < 2; ++j) {
    const int ch = half * 32 + j * 16 + c15, Cg = blk * 64 + ch, pidx = (l * 2 + dir) * 256 + Cg;
    const float ba = p.lru_ba[pidx], bx = p.lru_bx[pidx];
    const float cdec = p.cdec[pidx];
    float a[4][4], u[4][4];
#pragma unroll
    for (int mt = 0; mt < 4; ++mt)
#pragma unroll
      for (int r = 0; r < 4; ++r) {
        const int t = mt * 16 + q * 4 + r;
        const float rg = sigmoidf_(acc[0][mt][j][r] + ba), ig = sigmoidf_(acc[1][mt][j][r] + bx);
        const float la = cdec * rg;
        a[mt][r] = __expf(la);
        const float x2 = 2.f * la;
        const float em = (x2 < -0.25f) ? 1.f - __expf(x2) : -x2 * (1.f + x2 * (0.5f + x2 * (1.f / 6.f + x2 * (1.f / 24.f + x2 * (1.f / 120.f + x2 * (1.f / 720.f))))));
        u[mt][r] = __builtin_amdgcn_sqrtf(em) * ig * xcf[t * 64 + ch];
      }
    if (dir == 0) tile_scan<false>(a, u, lane); else tile_scan<true>(a, u, lane);
#pragma unroll
    for (int mt = 0; mt < 4; ++mt)
#pragma unroll
      for (int r = 0; r < 4; ++r) {
        const size_t m = m0 + mt * 16 + q * 4 + r;
        PCp[m * 256 + Cg] = a[mt][r]; HLp[m * 256 + Cg] = u[mt][r];
      }
  }
  __syncthreads();
}

DEV void attn_item(const Params& p, int l, int it, char* sm) {
  const int tid = threadIdx.x, lane = tid & 63, w = tid >> 6, q = lane >> 4, c15 = lane & 15;
  const int qg = w >> 1, kh = w & 1;
  int h, ms, nkt, T; const bf16_t* Kg; const bf16_t* Vg;
  if (it < 512) {
    const int b = it >> 6, qb = it & 7; h = (it >> 3) & 7; ms = 8192 + b * 1024 + qb * 128; nkt = 10; T = 1280;
    Kg = p.kb_lat + (size_t)((l * 8 + b) * 2 + (h >> 2)) * 1280 * 64; Vg = p.vt_lat + (size_t)((l * 8 + b) * 2 + (h >> 2)) * 64 * 1280;
  } else {
    const int i2 = it - 512, b = i2 >> 4, qb = i2 & 1; h = (i2 >> 1) & 7; ms = b * 256 + qb * 128; nkt = 2; T = 256;
    Kg = p.kb_ctx + (size_t)(b * 2 + (h >> 2)) * 256 * 64; Vg = p.vt_ctx + (size_t)(b * 2 + (h >> 2)) * 64 * 256;
  }
  const int kc0 = tid, kc1 = tid + 512;
  const int vd0 = tid >> 4, vk = (tid & 15) * 8;
  const int vpos = ((tid & 15) >> 2) * 32 + 16 * (tid & 1) + 4 * ((tid & 3) >> 1);
  const bf16_t* vg0 = Vg + (size_t)vd0 * T + vk;
  const bf16_t* vg1 = Vg + (size_t)(vd0 + 32) * T + vk;
  uint4 rk0, rk1, rv0, rv1;
#define ATT_LOAD(kt) do { rk0 = *(const uint4*)(Kg + (size_t)(kt) * 8192 + kc0 * 8); rk1 = *(const uint4*)(Kg + (size_t)(kt) * 8192 + kc1 * 8); \
    rv0 = *(const uint4*)(vg0 + (kt) * 128); rv1 = *(const uint4*)(vg1 + (kt) * 128); } while (0)
#define ATT_STORE(buf) do { bf16_t* Ks_ = (bf16_t*)(sm + (buf) * 36864); bf16_t* Vs_ = Ks_ + 9216; \
    *(uint4*)(Ks_ + (kc0 >> 3) * 72 + (kc0 & 7) * 8) = rk0; *(uint4*)(Ks_ + (kc1 >> 3) * 72 + (kc1 & 7) * 8) = rk1; \
    *(uint2*)(Vs_ + vd0 * 136 + vpos) = make_uint2(rv0.x, rv0.y); *(uint2*)(Vs_ + vd0 * 136 + vpos + 8) = make_uint2(rv0.z, rv0.w); \
    *(uint2*)(Vs_ + (vd0 + 32) * 136 + vpos) = make_uint2(rv1.x, rv1.y); *(uint2*)(Vs_ + (vd0 + 32) * 136 + vpos + 8) = make_uint2(rv1.z, rv1.w); } while (0)
  ATT_LOAD(0);
  const int mq = ms + qg * 32;
  bf16x8 qf[2][2];
#pragma unroll
  for (int t = 0; t < 2; ++t)
#pragma unroll
    for (int s = 0; s < 2; ++s) qf[t][s] = *(const bf16x8*)(p.zf + (size_t)(mq + t * 16 + c15) * 1792 + h * 64 + s * 32 + q * 8);
  ATT_STORE(0);
  if (nkt > 1) ATT_LOAD(1);
#pragma unroll
  for (int t = 0; t < 2; ++t) {
    float f[2][8]; float ss = 0.f;
#pragma unroll
    for (int s = 0; s < 2; ++s)
#pragma unroll
      for (int j = 0; j < 8; ++j) { f[s][j] = bf2f((bf16_t)qf[t][s][j]); ss += f[s][j] * f[s][j]; }
    ss += __shfl_xor(ss, 16); ss += __shfl_xor(ss, 32);
    const float rinv = rsqrtf(ss * (1.f / 64.f) + 1e-6f);
    const int mrow_ = mq + t * 16 + c15;
    const int pos = (mrow_ - 8192) & 1023;
#pragma unroll
    for (int s = 0; s < 2; ++s) {
      const int dd = s * 32 + q * 8;
#pragma unroll
      for (int j = 0; j < 8; ++j) f[s][j] = f[s][j] * rinv * p.q_g[l * 64 + dd + j];
      if (it < 512) rope8(f[s], dd, pos >> 6, pos & 63, p.rope);
      U8 pk;
#pragma unroll
      for (int j = 0; j < 4; ++j) pk.w[j] = pack2(f[s][2 * j] * QSCALE, f[s][2 * j + 1] * QSCALE);
      qf[t][s] = pk.v;
    }
  }
  __syncthreads();
  f32x4 o[2][4];
  float mrow[2], lrow[2];
#pragma unroll
  for (int t = 0; t < 2; ++t) { mrow[t] = -1e30f; lrow[t] = 0.f;
#pragma unroll
    for (int j = 0; j < 4; ++j) o[t][j] = f32x4{0.f, 0.f, 0.f, 0.f}; }
  for (int kt = 0; kt < nkt; ++kt) {
    const int cur = kt & 1;
    const bf16_t* Ks = (const bf16_t*)(sm + cur * 36864) + kh * 64 * 72;
    const bf16_t* Vs = (const bf16_t*)(sm + cur * 36864) + 9216 + kh * 64;
    f32x4 s4[2][4];
    {
      bf16x8 kf[4][2];
#pragma unroll
      for (int jn = 0; jn < 4; ++jn)
#pragma unroll
        for (int s = 0; s < 2; ++s) kf[jn][s] = *(const bf16x8*)(Ks + (jn * 16 + c15) * 72 + s * 32 + q * 8);
      __builtin_amdgcn_sched_barrier(0);
#pragma unroll
      for (int jn = 0; jn < 4; ++jn)
#pragma unroll
        for (int t = 0; t < 2; ++t) s4[t][jn] = mfma16(kf[jn][0], qf[t][0], f32x4{0.f, 0.f, 0.f, 0.f});
#pragma unroll
      for (int jn = 0; jn < 4; ++jn)
#pragma unroll
        for (int t = 0; t < 2; ++t) s4[t][jn] = mfma16(kf[jn][1], qf[t][1], s4[t][jn]);
      __builtin_amdgcn_sched_barrier(0);
    }
    U8 vf[4][2];
#pragma unroll
    for (int jn = 0; jn < 4; ++jn)
#pragma unroll
      for (int ks = 0; ks < 2; ++ks) vf[jn][ks].u = *(const uint4*)(Vs + (jn * 16 + c15) * 136 + ks * 32 + q * 8);
    __builtin_amdgcn_sched_barrier(0);
    U8 pb[2][2];
#pragma unroll
    for (int t = 0; t < 2; ++t) {
      float mx = s4[t][0][0];
#pragma unroll
      for (int jn = 0; jn < 4; ++jn)
#pragma unroll
        for (int r = 0; r < 4; ++r) mx = fmaxf(mx, s4[t][jn][r]);
      mx = fmaxf(mx, __shfl_xor(mx, 16)); mx = fmaxf(mx, __shfl_xor(mx, 32));
      const float mnew = fmaxf(mrow[t], mx);
      const float alpha = __builtin_amdgcn_exp2f(mrow[t] - mnew);
      mrow[t] = mnew;
      float ls = 0.f;
#pragma unroll
      for (int jn = 0; jn < 4; ++jn)
#pragma unroll
        for (int r = 0; r < 4; ++r) { const float pv = __builtin_amdgcn_exp2f(s4[t][jn][r] - mnew); s4[t][jn][r] = pv; ls += pv; }
      lrow[t] = lrow[t] * alpha + ls;
#pragma unroll
      for (int jn = 0; jn < 4; ++jn) { o[t][jn][0] *= alpha; o[t][jn][1] *= alpha; o[t][jn][2] *= alpha; o[t][jn][3] *= alpha; }
#pragma unroll
      for (int ks = 0; ks < 2; ++ks) {
        pb[t][ks].w[0] = pack2(s4[t][2 * ks][0], s4[t][2 * ks][1]); pb[t][ks].w[1] = pack2(s4[t][2 * ks][2], s4[t][2 * ks][3]);
        pb[t][ks].w[2] = pack2(s4[t][2 * ks + 1][0], s4[t][2 * ks + 1][1]); pb[t][ks].w[3] = pack2(s4[t][2 * ks + 1][2], s4[t][2 * ks + 1][3]);
      }
    }
#pragma unroll
    for (int ks = 0; ks < 2; ++ks)
#pragma unroll
      for (int jn = 0; jn < 4; ++jn)
#pragma unroll
        for (int t = 0; t < 2; ++t) o[t][jn] = mfma16(vf[jn][ks].v, pb[t][ks].v, o[t][jn]);
    if (kt + 1 < nkt) {
      ATT_STORE(cur ^ 1);
      if (kt + 2 < nkt) ATT_LOAD(kt + 2);
    }
    __syncthreads();
  }
#undef ATT_LOAD
#undef ATT_STORE
  float* mrg = (float*)(sm + 73728) + (size_t)(qg * 64 + lane) * 37;
  float lt[2];
#pragma unroll
  for (int t = 0; t < 2; ++t) { float a = lrow[t]; a += __shfl_xor(a, 16); a += __shfl_xor(a, 32); lt[t] = a; }
  if (kh == 1) {
#pragma unroll
    for (int t = 0; t < 2; ++t) {
      mrg[t * 18 + 0] = mrow[t]; mrg[t * 18 + 1] = lt[t];
#pragma unroll
      for (int jn = 0; jn < 4; ++jn)
#pragma unroll
        for (int r = 0; r < 4; ++r) mrg[t * 18 + 2 + jn * 4 + r] = o[t][jn][r];
    }
  }
  __syncthreads();
  if (kh == 0) {
#pragma unroll
    for (int t = 0; t < 2; ++t) {
      const float m1 = mrg[t * 18 + 0], l1 = mrg[t * 18 + 1];
      const float mm = fmaxf(mrow[t], m1);
      const float a0 = __builtin_amdgcn_exp2f(mrow[t] - mm), a1 = __builtin_amdgcn_exp2f(m1 - mm);
      const float inv = 1.f / (a0 * lt[t] + a1 * l1);
      const float c0 = a0 * inv, c1 = a1 * inv;
      bf16_t* orow = p.abuf + (size_t)(mq + t * 16 + c15) * 1024 + h * 64 + q * 4;
#pragma unroll
      for (int jn = 0; jn < 4; ++jn) {
        const float x0 = c0 * o[t][jn][0] + c1 * mrg[t * 18 + 2 + jn * 4 + 0], x1 = c0 * o[t][jn][1] + c1 * mrg[t * 18 + 2 + jn * 4 + 1];
        const float x2 = c0 * o[t][jn][2] + c1 * mrg[t * 18 + 2 + jn * 4 + 2], x3 = c0 * o[t][jn][3] + c1 * mrg[t * 18 + 2 + jn * 4 + 3];
        uint2 ov; ov.x = pack2(x0, x1); ov.y = pack2(x2, x3);
        *(uint2*)(orow + jn * 16) = ov;
      }
    }
  }
  __syncthreads();
}

DEV void gmlp_item(const Params& p, int l, int it, char* smem) {
  const int tid = VTID, lane = tid & 63, w = tid >> 6, q = lane >> 4, c15 = lane & 15;
  const int chunk = it >> 2, g = it & 3, m0 = chunk * 128;
  bf16_t* vt = (bf16_t*)smem;
  const float* wsg = p.mlp_ws + (size_t)(l * 4 + g) * 16384;
  float4 wa[2][4][2];
#pragma unroll
  for (int nt = 0; nt < 2; ++nt)
#pragma unroll
    for (int s = 0; s < 4; ++s) {
      const float* ap = wsg + ((2 * w + nt) * 16 + c15) * 128 + s * 32 + q * 8;
      wa[nt][s][0] = *(const float4*)ap; wa[nt][s][1] = *(const float4*)(ap + 4);
    }
  uint4 vin[4];
#pragma unroll
  for (int i = 0; i < 4; ++i) { const int id = tid + 256 * i; vin[i] = *(const uint4*)(p.zf + (size_t)(m0 + (id >> 3)) * 1792 + 1536 + g * 64 + (id & 7) * 8); }
#pragma unroll
  for (int i = 0; i < 4; ++i) {
    const int id = tid + 256 * i, qq = id >> 3, cc = id & 7;
    U8 v; v.u = vin[i];
#pragma unroll
    for (int j = 0; j < 8; ++j) vt[(cc * 8 + j) * 136 + qq] = v.h[j];
  }
  __syncthreads();
  f32x4 acc[4][2];
#pragma unroll
  for (int mt = 0; mt < 4; ++mt)
#pragma unroll
    for (int nt = 0; nt < 2; ++nt) acc[mt][nt] = f32x4{0.f, 0.f, 0.f, 0.f};
#pragma unroll
  for (int s = 0; s < 4; ++s) {
    bf16x8 af[4];
#pragma unroll
    for (int mt = 0; mt < 4; ++mt) af[mt] = *(const bf16x8*)(vt + (mt * 16 + c15) * 136 + s * 32 + q * 8);
#pragma unroll
    for (int nt = 0; nt < 2; ++nt) {
      U8 bb;
      bb.w[0] = pack2(wa[nt][s][0].x, wa[nt][s][0].y); bb.w[1] = pack2(wa[nt][s][0].z, wa[nt][s][0].w);
      bb.w[2] = pack2(wa[nt][s][1].x, wa[nt][s][1].y); bb.w[3] = pack2(wa[nt][s][1].z, wa[nt][s][1].w);
#pragma unroll
      for (int mt = 0; mt < 4; ++mt) acc[mt][nt] = mfma16(af[mt], bb.v, acc[mt][nt]);
    }
  }
#pragma unroll
  for (int nt = 0; nt < 2; ++nt) {
    const int pp = (2 * w + nt) * 16 + c15;
    const size_t m = m0 + pp;
    const float bsv = p.mlp_bs[(l * 4 + g) * 128 + pp];
#pragma unroll
    for (int mt = 0; mt < 4; ++mt) {
      const int c = mt * 16 + q * 4;
      const uint2 uu = *(const uint2*)(p.zf + m * 1792 + 1280 + g * 64 + c);
      const float u0 = gelu_t(__uint_as_float(uu.x << 16)), u1 = gelu_t(__uint_as_float(uu.x & 0xffff0000u)), u2 = gelu_t(__uint_as_float(uu.y << 16)), u3 = gelu_t(__uint_as_float(uu.y & 0xffff0000u));
      uint2 o; o.x = pack2(u0 * (acc[mt][nt][0] + bsv), u1 * (acc[mt][nt][1] + bsv)); o.y = pack2(u2 * (acc[mt][nt][2] + bsv), u3 * (acc[mt][nt][3] + bsv));
      *(uint2*)(p.abuf + m * 1024 + 768 + g * 64 + c) = o;
    }
  }
  __syncthreads();
}

DEV void lru_apply_item(const Params& p, int l, int ti2) {
  const int C = VTID;
  const int ti = ti2 >> 1, th = (ti2 & 1) * 32;
  const int m0 = ti * 64;
  int ms, L, b; bool lat = m0 >= 8192;
  if (!lat) { ms = m0 & ~255; L = 256; b = m0 >> 8; } else { ms = 8192 + ((m0 - 8192) & ~1023); L = 1024; b = (m0 - 8192) >> 10; }
  const int k = (m0 - ms) >> 6, nt = L >> 6;
  const float* PCf = p.au; const float* HLf = p.au + (size_t)MT * 256;
  const float* PCb = p.au + (size_t)2 * MT * 256; const float* HLb = p.au + (size_t)3 * MT * 256;
  float cf = lat ? p.state_lru[((size_t)(b * 2 + l) * 2 + 0) * 256 + C] : 0.f;
  float cb = lat ? p.state_lru[((size_t)(b * 2 + l) * 2 + 1) * 256 + C] : 0.f;
  {
    float pc[15], hl[15];
#pragma unroll
    for (int i = 0; i < 15; ++i) {
      const bool act = i < k;
      const size_t e = (size_t)(ms + 64 * i + 63) * 256 + C;
      pc[i] = act ? PCf[e] : 1.f; hl[i] = act ? HLf[e] : 0.f;
    }
#pragma unroll
    for (int i = 0; i < 15; ++i) cf = pc[i] * cf + hl[i];
  }
  {
    float pc[15], hl[15];
#pragma unroll
    for (int i = 0; i < 15; ++i) {
      const int tix = nt - 1 - i;
      const bool act = tix > k;
      const size_t e = (size_t)(ms + 64 * tix) * 256 + C;
      pc[i] = act ? PCb[e] : 1.f; hl[i] = act ? HLb[e] : 0.f;
    }
#pragma unroll
    for (int i = 0; i < 15; ++i) cb = pc[i] * cb + hl[i];
  }
  float hf_last = 0.f, hb_first = 0.f;
#pragma unroll 16
  for (int t = th; t < th + 32; ++t) {
    const size_t m = m0 + t;
    const float hf = PCf[m * 256 + C] * cf + HLf[m * 256 + C];
    const float hb = PCb[m * 256 + C] * cb + HLb[m * 256 + C];
    const float g = gelu_t(bf2f(p.zf[m * 1792 + 1024 + C]));
    p.abuf[m * 1024 + 512 + C] = f2bf((hf + hb) * g);
    if (t == 0) hb_first = hb;
    if (t == 63) hf_last = hf;
  }
  if (!lat) {
    if (k == nt - 1 && th == 32) p.out[OFF_ST + ((size_t)(b * 2 + l) * 2 + 0) * 256 + C] = hf_last;
    if (k == 0 && th == 0) p.out[OFF_ST + ((size_t)(b * 2 + l) * 2 + 1) * 256 + C] = hb_first;
  }
}

DEV void mixer_phase(const Params& p, int l, char* smem_raw, char* smem) {
  {
    const int x = blockIdx.x & 7, j = blockIdx.x >> 3;
#pragma unroll 1
    for (int k = 0; k < 4; ++k) attn_item(p, l, ((k >> 1) << 9) + 64 * x + j + 32 * (k & 1), smem_raw);
  }
  {
    const int x = blockIdx.x & 7, lh = (blockIdx.x >> 3) * 2 + (threadIdx.x >> 8);
    lru_apply_item(p, l, (own_row(x, (lh >> 1) * 64) >> 6) * 2 + (lh & 1));
    gmlp_item(p, l, (own_row(x, (lh >> 2) * 128) >> 7) * 4 + (lh & 3), smem);
  }
}

DEV void prep_phase_full(const Params& p, int l, char* smem) {
  {
    const int xcd = blockIdx.x & 7, lh = (blockIdx.x >> 3) * 2 + (threadIdx.x >> 8);
#pragma unroll 1
    for (int k = 0; k < 2; ++k) { const int li = lh + 64 * k; lru_gate_item(p, l, (own_row(xcd, (li >> 2) * 64) >> 6) * 4 + (li & 3), smem); }
  }
  const int lane = threadIdx.x & 63, mstride = gridDim.x * 8;
  int vm = blockIdx.x * 8 + (threadIdx.x >> 6);
  const int coff = lane < 32 ? 512 + lane * 8 : 1536 + (lane - 32) * 8;
  uint4 n1 = *(const uint4*)(p.zf + (size_t)xrow(vm) * 1792 + coff);
  uint4 n2 = *(const uint4*)(p.zf + (size_t)xrow((vm + mstride < MT) ? vm + mstride : vm) * 1792 + coff);
  for (; vm < MT; vm += mstride) {
    const uint4 c = n1; n1 = n2;
    const int mn = xrow((vm + 2 * mstride < MT) ? vm + 2 * mstride : vm);
    n2 = *(const uint4*)(p.zf + (size_t)mn * 1792 + coff);
    prep_token_row(p, l, xrow(vm), lane, c);
  }
}


#define XB_TMO      128
#define XB_XCNT(j)  (256  + 64 * (j))
#define XB_XSUB(j)  (1280 + 64 * (j))
#define XB_XGEN(j)  (2304 + 64 * (j))
#define XB_TOP      3328
#define XB_TOPGEN   3392
#define XCD_BAR_WORDS 3456
#define XB_SPIN_CAP (1u << 18)
#define LAS __attribute__((address_space(3)))
DEV unsigned xb_ld(unsigned* p) { return __hip_atomic_load(p, __ATOMIC_RELAXED, __HIP_MEMORY_SCOPE_AGENT); }
DEV unsigned xb_add(unsigned* p, unsigned v) { return __hip_atomic_fetch_add(p, v, __ATOMIC_RELAXED, __HIP_MEMORY_SCOPE_AGENT); }
DEV unsigned xb_xcc_id() { return (unsigned)__builtin_amdgcn_s_getreg((3 << 11) | 20) & 0xFu; }
#define XB_SPIN(cond, bar) do { unsigned _sp = 0; while (cond) { __builtin_amdgcn_s_sleep(1); \
    if ((++_sp & 255u) == 0u) { if (xb_ld(&(bar)[XB_TMO])) break; if (_sp > XB_SPIN_CAP) { atomicAdd(&(bar)[XB_TMO], 1u); break; } } } } while (0)
struct XcdBarrier { unsigned* bar; unsigned x; volatile LAS unsigned* st; };
DEV XcdBarrier xcd_barrier_post(unsigned* bar, volatile LAS unsigned* st) {
  XcdBarrier b; b.bar = bar; b.x = xb_xcc_id(); b.st = st;
  if (threadIdx.x == 0) (void)xb_add(&bar[XB_XCNT(b.x)], 1u);
  return b;
}
DEV void xcd_barrier_complete(unsigned* bar, unsigned x, unsigned& nloc, unsigned& nx) {
  const unsigned G = gridDim.x * gridDim.y * gridDim.z;
  unsigned sum, cnt, mine, sp = 0u;
  for (;;) {
    sum = 0u; cnt = 0u; mine = 0u;
#pragma unroll
    for (unsigned j = 0; j < 16; ++j) { const unsigned c = xb_ld(&bar[XB_XCNT(j)]); sum += c; cnt += (c > 0u) ? 1u : 0u; mine = (j == x) ? c : mine; }
    if (sum == G) break;
    __builtin_amdgcn_s_sleep(1);
    if ((++sp & 255u) == 0u) { if (xb_ld(&bar[XB_TMO])) break; if (sp > XB_SPIN_CAP) { atomicAdd(&bar[XB_TMO], 1u); break; } }
  }
  nloc = mine > 0u ? mine : 1u; nx = cnt > 0u ? cnt : 1u;
}
DEV void xcd_barrier(const XcdBarrier& b) {
  asm volatile("s_waitcnt vmcnt(0)" ::: "memory");
  __syncthreads();
  if (threadIdx.x == 0) {
    unsigned* bar = b.bar;
    __builtin_amdgcn_s_waitcnt(0);
    unsigned nloc = b.st[0], nx = b.st[1];
    if (nloc == 0u) { xcd_barrier_complete(bar, b.x, nloc, nx); b.st[0] = nloc; b.st[1] = nx; }
    const unsigned old = xb_add(&bar[XB_XSUB(b.x)], 1u);
    const unsigned gen = old / nloc;
    if (old + 1u == (gen + 1u) * nloc) {
      __builtin_amdgcn_fence(__ATOMIC_RELEASE, "agent");
      asm volatile("s_waitcnt vmcnt(0)" ::: "memory");
      const unsigned og = xb_add(&bar[XB_TOP], 1u);
      const unsigned tg = og / nx;
      if (og + 1u == (tg + 1u) * nx) xb_add(&bar[XB_TOPGEN], 1u);
      else XB_SPIN(xb_ld(&bar[XB_TOPGEN]) == tg, bar);
      __builtin_amdgcn_fence(__ATOMIC_ACQUIRE, "agent");
      xb_add(&bar[XB_XGEN(b.x)], 1u);
      asm volatile("s_waitcnt vmcnt(0)" ::: "memory");
    } else {
      XB_SPIN(xb_ld(&bar[XB_XGEN(b.x)]) == gen, bar);
      __builtin_amdgcn_fence(__ATOMIC_ACQUIRE, "agent");
      asm volatile("s_waitcnt vmcnt(0)" ::: "memory");
    }
  }
  __syncthreads();
}

#define XB_MISMATCH 160
#define XB_WREADY 192
DEV void xcd_barrier_local(const XcdBarrier& b) {
  asm volatile("s_waitcnt vmcnt(0)" ::: "memory");
  __syncthreads();
  if (threadIdx.x == 0) {
    unsigned* bar = b.bar;
    __builtin_amdgcn_s_waitcnt(0);
    const unsigned nloc = b.st[0];
    const unsigned old = xb_add(&bar[XB_XSUB(b.x)], 1u);
    const unsigned gen = old / nloc;
    if (old + 1u == (gen + 1u) * nloc) xb_add(&bar[XB_XGEN(b.x)], 1u);
    else XB_SPIN(xb_ld(&bar[XB_XGEN(b.x)]) == gen, bar);
    __builtin_amdgcn_fence(__ATOMIC_ACQUIRE, "agent");
    asm volatile("s_waitcnt vmcnt(0)" ::: "memory");
  }
  __syncthreads();
}

#define PH(i, call) if (ph_lo <= (i) && (i) < ph_hi) { if ((i) > ph_lo) { if ((i) >= 2 && xcd_local) xcd_barrier_local(xb); else xcd_barrier(xb); } call; }
#define LAYER_REST(l, b) \
  PH(b + 1, gemm_phase<1>(p, l, p.abuf, p.wt_in + (size_t)l * 1792 * 1024, 1792, 1024, (LAS3 unsigned char*)smem_raw)) \
  PH(b + 2, prep_phase_full(p, l, smem)) \
  PH(b + 3, mixer_phase(p, l, smem_raw, smem)) \
  PH(b + 4, if (l == 0 && xcd_local) { if (threadIdx.x == 0) { XB_SPIN(xb_ld(&p.bar[XB_WREADY]) < 128u, p.bar); __builtin_amdgcn_fence(__ATOMIC_ACQUIRE, "agent"); asm volatile("s_waitcnt vmcnt(0)" ::: "memory"); } __syncthreads(); } \
            gemm_phase<2>(p, l, p.abuf, p.wt_out + (size_t)l * 1024 * 1024, 1024, 1024, (LAS3 unsigned char*)smem_raw)) \
  PH(b + 5, ln_mod_phase(p, l, 2)) \
  PH(b + 6, gemm_phase<3>(p, l, p.abuf, p.wt_ff1 + (size_t)l * 4096 * 1024, 4096, 1024, (LAS3 unsigned char*)smem_raw)) \
  PH(b + 7, gemm_phase<4>(p, l, p.zf, p.wt_ff2 + (size_t)l * 1024 * 4096, 1024, 4096, (LAS3 unsigned char*)smem_raw))

__global__ void __launch_bounds__(512, 2) mega_kernel(Params p, int ph_lo, int ph_hi) {
  extern __shared__ __attribute__((aligned(16))) char smem_raw[];
  char* smem = smem_raw + (threadIdx.x >> 8) * 65536;
  __shared__ uint4 xb_words;
  if (threadIdx.x == 0) xb_words = make_uint4(0u, 0u, 0u, 0u);
  __syncthreads();
  XcdBarrier xb = xcd_barrier_post(p.bar, (volatile LAS unsigned*)&xb_words);
  if (threadIdx.x == 0) atomicOr(&p.bar[XB_MISMATCH + (blockIdx.x & 7u)], 1u << xb.x);
  if (ph_hi > 1000) { cg::grid_group grid = cg::this_grid(); grid.sync(); }
  bool xcd_local = false;
  PH(0, phase0(p, smem))
  PH(1, { unsigned all = 0u; bool one = true;
          for (int c = 0; c < 8; ++c) { const unsigned m = xb_ld(&p.bar[XB_MISMATCH + c]); one = one && (__builtin_popcount(m) == 1); all |= m; }
          xcd_local = one && all == 0xFFu && gridDim.x == 256; }
        if (xcd_local) {
          if (blockIdx.x & 4u) {
            transpose_all(p, smem, 1, ((int)(blockIdx.x & 3u) + 4 * (int)(blockIdx.x >> 3)) * 2 + (int)(threadIdx.x >> 8), 256);
            asm volatile("s_waitcnt vmcnt(0)" ::: "memory");
            __syncthreads();
            if (threadIdx.x == 0) { __builtin_amdgcn_fence(__ATOMIC_RELEASE, "agent"); asm volatile("s_waitcnt vmcnt(0)" ::: "memory"); xb_add(&p.bar[XB_WREADY], 1u); }
          }
        } else { transpose_all(p, smem, 1, VBID, VNB); xcd_barrier(xb); }
        ln_mod_phase(p, 0, 0))
#undef LAYER0_P1
  LAYER_REST(0, 1)
  PH(9, ln_mod_phase(p, 1, 1))
  LAYER_REST(1, 9)
  PH(17, ln_mod_phase(p, 1, 3))
}

extern "C" void kernel_launch(void* const* d_in, const int* in_sizes, int n_in, void* d_out, int out_size, void* d_ws, size_t ws_size,
                              hipStream_t stream) {
  static int grid_blocks = 0;
  if (!grid_blocks) {
    int dev = 0, cus = 0, per_cu = 0;
    hipGetDevice(&dev);
    hipDeviceGetAttribute(&cus, hipDeviceAttributeMultiprocessorCount, dev);
    hipFuncSetAttribute((const void*)mega_kernel, hipFuncAttributeMaxDynamicSharedMemorySize, SMEM_BYTES);
    hipOccupancyMaxActiveBlocksPerMultiprocessor(&per_cu, (const void*)mega_kernel, 512, SMEM_BYTES);
    if (per_cu < 1) per_cu = 1;
    if (per_cu > 1) per_cu = 1;
    grid_blocks = cus * per_cu;
  }
  Params p{};
  const float** pin = (const float**)&p;
  for (int i = 0; i < 32; ++i) pin[i] = (const float*)d_in[i];
  p.out = (float*)d_out;
  char* ws = (char*)d_ws;
  size_t off = 0;
  p.bar = (unsigned*)(ws + off); off += 16384;
  p.rstat = (float*)(ws + off); off += (size_t)MT * 2 * 4;
  p.kb_lat = (bf16_t*)(ws + off); off += (size_t)2 * 8 * 2 * 1280 * 64 * 2;
  p.vt_lat = (bf16_t*)(ws + off); off += (size_t)2 * 8 * 2 * 1280 * 64 * 2;
  p.kb_ctx = (bf16_t*)(ws + off); off += (size_t)32 * 2 * 256 * 64 * 2;
  p.vt_ctx = (bf16_t*)(ws + off); off += (size_t)32 * 2 * 256 * 64 * 2;
  p.wt_in = (bf16_t*)(ws + off); off += (size_t)2 * 1792 * 1024 * 2;
  p.wt_out = (bf16_t*)(ws + off); off += (size_t)2 * 1024 * 1024 * 2;
  p.wt_ff1 = (bf16_t*)(ws + off); off += (size_t)2 * 4096 * 1024 * 2;
  p.wt_ff2 = (bf16_t*)(ws + off); off += (size_t)2 * 4096 * 1024 * 2;
  p.wt_lru = (bf16_t*)(ws + off); off += (size_t)64 * 4096 * 2;
  p.mod = (float*)(ws + off); off += (size_t)2 * 9 * 6144 * 4;
  p.rope = (float*)(ws + off); off += (size_t)2048 * 4;
  p.cdec = (float*)(ws + off); off += (size_t)1024 * 4;
  p.abuf = (bf16_t*)(ws + off); off += (size_t)MT * 1024 * 2;
  p.zf = (bf16_t*)(ws + off);
  p.au = (float*)(ws + off + (size_t)MT * 1792 * 2);
  off += (size_t)MT * 4096 * 2;
  if (off > ws_size) { fprintf(stderr, "workspace too small: need %zu have %zu\n", off, ws_size); return; }
  (void)hipMemsetAsync(p.bar, 0, XCD_BAR_WORDS * 4, stream);
#if MULTI_LAUNCH
  for (int ph = 0; ph < NPHASE; ++ph) {
    hipLaunchKernelGGL(mega_kernel, dim3(grid_blocks), dim3(512), SMEM_BYTES, stream, p, ph, ph + 1);
  }
#else
  int lo = 0, hi = NPHASE;
  void* args[] = {&p, &lo, &hi};
  hipError_t e = hipLaunchCooperativeKernel((void*)mega_kernel, dim3(grid_blocks), dim3(512), args, SMEM_BYTES, stream);
  if (e != hipSuccess) fprintf(stderr, "cooperative launch failed: %s (grid %d)\n", hipGetErrorString(e), grid_blocks);
#endif
}
```

```cpp
#include <hip/hip_runtime.h>
#include <hip/hip_cooperative_groups.h>
#include <cstdio>
#include <cstdint>
namespace cg = cooperative_groups;

#ifndef MULTI_LAUNCH
#define MULTI_LAUNCH 0
#endif

typedef unsigned short bf16_t;
using bf16x8 = __attribute__((ext_vector_type(8))) short;
using f32x4 = __attribute__((ext_vector_type(4))) float;
#define DEV __device__ __forceinline__
#define VTID ((int)(threadIdx.x & 255))
#define VBID ((int)(blockIdx.x * 2 + (threadIdx.x >> 8)))
#define VNB ((int)(gridDim.x * 2))

constexpr int MT = 16384;
constexpr int NPHASE = 18;
constexpr size_t OFF_YK = 16777216, OFF_YV = OFF_YK + 2097152, OFF_ST = OFF_YV + 2097152;
constexpr float ALPHA = 1.41421356237f;
constexpr float QSCALE = 0.125f * 1.4426950408889634f;
constexpr int SMEM_BYTES = 131072;

struct Params {
  const float *x_prompt, *x_sample, *c, *cache_k, *cache_v, *state_lru, *c_ctx, *w_ada, *b_ada, *w_in,
      *q_g, *k_g, *conv_w, *conv_b, *lru_wa, *lru_ba, *lru_wx, *lru_bx, *lru_lam, *mlp_g, *mlp_b, *mlp_ws, *mlp_bs,
      *w_out, *ln1_g, *ln1_b, *w_ff1, *b_ff1, *w_ff2, *b_ff2, *ln2_g, *ln2_b;
  float* out;
  bf16_t *wt_in, *wt_out, *wt_ff1, *wt_ff2, *wt_lru;
  float *mod, *rope, *cdec;
  bf16_t *abuf;
  bf16_t *zf;
  float *au;
  bf16_t *kb_lat, *vt_lat;
  bf16_t *kb_ctx, *vt_ctx;
  unsigned *bar;
  float *rstat;
};

union U8 { uint4 u; bf16x8 v; bf16_t h[8]; unsigned w[4]; };

DEV float bf2f(bf16_t h) { return __uint_as_float(((unsigned)h) << 16); }
DEV bf16_t f2bf(float f) { unsigned u = __float_as_uint(f); u += 0x7fffu + ((u >> 16) & 1u); return (bf16_t)(u >> 16); }
DEV unsigned pack2(float a, float b) { unsigned r; asm volatile("v_cvt_pk_bf16_f32 %0, %1, %2" : "=v"(r) : "v"(a), "v"(b)); return r; }
DEV float gelu_t(float x) { float y = 0.7978845608028654f * (x + 0.044715f * x * x * x); float t = 1.f - 2.f * __builtin_amdgcn_rcpf(1.f + __expf(2.f * y)); return 0.5f * x * (1.f + t); }
DEV float sigmoidf_(float x) { return __builtin_amdgcn_rcpf(1.f + __expf(-x)); }
DEV int own_row(int x, int r) { return r < 1024 ? (x << 10) + r : 8192 + (x << 10) + (r - 1024); }
DEV int own_panel(int vp) { const int x = vp >> 3, lp = vp & 7; return lp < 4 ? 4 * x + lp : 32 + 4 * x + (lp - 4); }
DEV int xrow(int vm) { const int k = vm >> 11, c = (vm & 2047) >> 3, w = vm & 7; return own_row(c & 7, (k << 8) + ((c >> 3) << 3) + w); }
DEV int cond_of(int m) { return m < 8192 ? 0 : 1 + ((m - 8192) >> 10); }
DEV f32x4 mfma16(bf16x8 a, bf16x8 b, f32x4 c) { return __builtin_amdgcn_mfma_f32_16x16x32_bf16(a, b, c, 0, 0, 0); }
DEV float wave_sum(float v) {
#pragma unroll
  for (int o = 32; o >= 1; o >>= 1) v += __shfl_xor(v, o);
  return v;
}

DEV void transpose_tile(const float* __restrict__ src, bf16_t* __restrict__ dst, int lds_, int ldd, char* smem) {
  float* T = (float*)smem;
  const int tid = VTID;
#pragma unroll
  for (int i = 0; i < 4; ++i) {
    int k = (tid >> 4) + 16 * i, n4 = (tid & 15) * 4;
    float4 v = *(const float4*)(src + (size_t)k * lds_ + n4);
    T[k * 65 + n4 + 0] = v.x; T[k * 65 + n4 + 1] = v.y; T[k * 65 + n4 + 2] = v.z; T[k * 65 + n4 + 3] = v.w;
  }
  __syncthreads();
#pragma unroll
  for (int i = 0; i < 2; ++i) {
    int n = (tid >> 3) + 32 * i, k8 = (tid & 7) * 8;
    U8 o;
#pragma unroll
    for (int j = 0; j < 4; ++j) o.w[j] = pack2(T[(k8 + 2 * j) * 65 + n], T[(k8 + 2 * j + 1) * 65 + n]);
    *(uint4*)(dst + (size_t)n * ldd + k8) = o.u;
  }
  __syncthreads();
}
DEV void transpose_w(const float* __restrict__ W, bf16_t* __restrict__ Wt, int K, int N, int tk, int tn, char* smem) {
  transpose_tile(W + (size_t)(tk * 64) * N + tn * 64, Wt + (size_t)(tn * 64) * K + tk * 64, N, K, smem);
}

DEV void tr_desc(const Params& p, int t, const float*& src, int& lds_, bf16_t*& dst, int& ldd) {
  if (t < 2 * 2768) {
    const int l = t / 2768, r = t % 2768;
    const float* W; bf16_t* Wt; int K, N, tk, tn;
    if (r < 448) { W = p.w_in + (size_t)l * 1024 * 1792; Wt = p.wt_in + (size_t)l * 1792 * 1024; K = 1024; N = 1792; tk = r / 28; tn = r % 28; }
    else if (r < 704) { const int i = r - 448; W = p.w_out + (size_t)l * 1024 * 1024; Wt = p.wt_out + (size_t)l * 1024 * 1024; K = 1024; N = 1024; tk = i / 16; tn = i % 16; }
    else if (r < 1728) { const int i = r - 704; W = p.w_ff1 + (size_t)l * 1024 * 4096; Wt = p.wt_ff1 + (size_t)l * 4096 * 1024; K = 1024; N = 4096; tk = i / 64; tn = i % 64; }
    else if (r < 2752) { const int i = r - 1728; W = p.w_ff2 + (size_t)l * 4096 * 1024; Wt = p.wt_ff2 + (size_t)l * 1024 * 4096; K = 4096; N = 1024; tk = i / 16; tn = i % 16; }
    else {
      const int idx = r - 2752, dir = idx >> 3, blk = (idx >> 1) & 3, mat = idx & 1;
      src = (mat == 0 ? p.lru_wa : p.lru_wx) + (size_t)(((l * 2 + dir) * 4 + blk)) * 4096; lds_ = 64;
      dst = p.wt_lru + (size_t)((((l * 2 + dir) * 4 + blk) * 2 + mat)) * 4096; ldd = 64; return;
    }
    src = W + (size_t)(tk * 64) * N + tn * 64; lds_ = N; dst = Wt + (size_t)(tn * 64) * K + tk * 64; ldd = K;
  } else {
    const int j = t - 2 * 2768, tt = j & 3, kvh = (j >> 2) & 1, l = (j >> 3) & 1, b = j >> 4;
    src = p.cache_v + ((size_t)(b * 2 + l) * 256 + tt * 64) * 128 + kvh * 64; lds_ = 128;
    dst = p.vt_lat + ((size_t)((l * 8 + b) * 2 + kvh) * 64) * 1280 + tt * 64; ldd = 1280;
  }
}

DEV int tr_map(int list, int idx) {
  if (list == 0) return idx < 448 ? idx : (idx < 464 ? 2752 + (idx - 448) : (idx < 480 ? 5520 + (idx - 464) : 5536 + (idx - 480)));
  return idx < 2304 ? 448 + idx : 2768 + (idx - 2304);
}
DEV void transpose_all(const Params& p, char* smem, int list, int hb, int nhb) {
  const int NTR = list == 0 ? 608 : 5056;
  float* T = (float*)smem;
  const int tid = VTID, kr = tid >> 4, n4 = (tid & 15) * 4;
  int t = hb;
  if (t >= NTR) return;
  const float* src; bf16_t* dst; int lds_, ldd;
  tr_desc(p, tr_map(list, t), src, lds_, dst, ldd);
  float4 cur[4];
#pragma unroll
  for (int i = 0; i < 4; ++i) cur[i] = *(const float4*)(src + (size_t)(kr + 16 * i) * lds_ + n4);
  while (t < NTR) {
    const int tn = t + nhb;
    const float* nsrc = src; bf16_t* ndst = dst; int nlds = lds_, nldd = ldd;
    float4 nxt[4];
    if (tn < NTR) {
      tr_desc(p, tr_map(list, tn), nsrc, nlds, ndst, nldd);
#pragma unroll
      for (int i = 0; i < 4; ++i) nxt[i] = *(const float4*)(nsrc + (size_t)(kr + 16 * i) * nlds + n4);
    }
#pragma unroll
    for (int i = 0; i < 4; ++i) {
      const int k = kr + 16 * i;
      T[k * 65 + n4 + 0] = cur[i].x; T[k * 65 + n4 + 1] = cur[i].y; T[k * 65 + n4 + 2] = cur[i].z; T[k * 65 + n4 + 3] = cur[i].w;
    }
    __syncthreads();
#pragma unroll
    for (int i = 0; i < 2; ++i) {
      const int n = (tid >> 3) + 32 * i, k8 = (tid & 7) * 8;
      U8 o;
#pragma unroll
      for (int j = 0; j < 4; ++j) o.w[j] = pack2(T[(k8 + 2 * j) * 65 + n], T[(k8 + 2 * j + 1) * 65 + n]);
      *(uint4*)(dst + (size_t)n * ldd + k8) = o.u;
    }
    __syncthreads();
    if (tn < NTR) {
#pragma unroll
      for (int i = 0; i < 4; ++i) cur[i] = nxt[i];
    }
    src = nsrc; dst = ndst; lds_ = nlds; ldd = nldd; t = tn;
  }
}

DEV void phase0(const Params& p, char* smem) {
  const int tid = VTID;
  const int NT0 = 192 - 128, NITEMS = 192 + 64 + 2;
  for (int it = VBID; it < NITEMS; it += VNB) {
    if (it < 192) {
      const int l = it / 96, n0 = (it % 96) * 64;
      float* s = (float*)smem;
      float* red = s + 9 * 1024;
      for (int idx = tid; idx < 9 * 1024; idx += 256) {
        int c = idx >> 10, k = idx & 1023;
        float v = (c == 0) ? p.c_ctx[k] : p.c[(c - 1) * 1024 + k];
        s[idx] = v / (1.f + __expf(-v));
      }
      __syncthreads();
      const int w = tid >> 6, lane = tid & 63, cq = lane & 15, ks = lane >> 4;
      const int kbase = (w * 4 + ks) * 64;
      float acc[9][4];
#pragma unroll
      for (int c = 0; c < 9; ++c) { acc[c][0] = 0.f; acc[c][1] = 0.f; acc[c][2] = 0.f; acc[c][3] = 0.f; }
      const float* wp = p.w_ada + ((size_t)l * 1024 + kbase) * 6144 + n0 + cq * 4;
      for (int kb = 0; kb < 64; kb += 16) {
        float4 wv[16];
#pragma unroll
        for (int j = 0; j < 16; ++j) wv[j] = *(const float4*)(wp + (size_t)(kb + j) * 6144);
#pragma unroll
        for (int j = 0; j < 16; ++j)
#pragma unroll
          for (int c = 0; c < 9; ++c) {
            const float sv = s[c * 1024 + kbase + kb + j];
            acc[c][0] += sv * wv[j].x; acc[c][1] += sv * wv[j].y; acc[c][2] += sv * wv[j].z; acc[c][3] += sv * wv[j].w;
          }
      }
#pragma unroll
      for (int c = 0; c < 9; ++c)
#pragma unroll
        for (int e = 0; e < 4; ++e) {
          float a = acc[c][e];
          a += __shfl_xor(a, 16); a += __shfl_xor(a, 32);
          if (ks == 0) red[(w * 9 + c) * 64 + cq * 4 + e] = a;
        }
      __syncthreads();
      for (int idx = tid; idx < 576; idx += 256) {
        int c = idx >> 6, nn = idx & 63;
        float v = red[(0 * 9 + c) * 64 + nn] + red[(1 * 9 + c) * 64 + nn] + red[(2 * 9 + c) * 64 + nn] + red[(3 * 9 + c) * 64 + nn] +
                  p.b_ada[l * 6144 + n0 + nn];
        p.mod[((size_t)l * 9 + c) * 6144 + n0 + nn] = v;
      }
      __syncthreads();
    } else if (it >= NT0 + 128 && it < NT0 + 192) {
      const int j = it - NT0 - 128;
#pragma unroll
      for (int i = 0; i < 4; ++i) {
        const int e = (j * 1024 + i * 256 + tid) * 8;
        const int d = e & 63, kvh = (e >> 6) & 1, t = (e >> 7) & 255, l = (e >> 15) & 1, b = e >> 16;
        const float4 a0 = *(const float4*)(p.cache_k + e), a1 = *(const float4*)(p.cache_k + e + 4);
        U8 o; o.w[0] = pack2(a0.x, a0.y); o.w[1] = pack2(a0.z, a0.w); o.w[2] = pack2(a1.x, a1.y); o.w[3] = pack2(a1.z, a1.w);
        *(uint4*)(p.kb_lat + ((size_t)((l * 8 + b) * 2 + kvh) * 1280 + t) * 64 + d) = o.u;
      }
    } else if (it >= NT0 + 192) {
      if (it == NT0 + 192)
      for (int idx = tid; idx < 1024; idx += 256) {
        int pp = idx >> 4, f = idx & 15;
        float inv = powf(10000.f, -(float)f / 16.f);
        float ang = (float)pp * inv;
        float nrev = rintf(ang * 0.15915494309189535f);
        float r = fmaf(-nrev, 6.28125f, ang);
        r = fmaf(-nrev, 0.0019353071795864769f, r);
        p.rope[idx * 2 + 0] = __cosf(r);
        p.rope[idx * 2 + 1] = __sinf(r);
      }
      if (it == NT0 + 192)
      for (int idx = tid; idx < 1024; idx += 256) {
        const float xn = -p.lru_lam[idx];
        p.cdec[idx] = -8.f * (fmaxf(xn, 0.f) + log1pf(expf(-fabsf(xn))));
      }
    }
  }
  transpose_all(p, smem, 0, VBID, VNB);
}

DEV void ln_mod_phase(const Params& p, int l, int mode, int team_base = -1) {
  const int lane = threadIdx.x & 63, w = threadIdx.x >> 6;
  const float* lg = nullptr; const float* lb = nullptr;
  if (mode == 1) { lg = p.ln2_g + (l - 1) * 1024; lb = p.ln2_b + (l - 1) * 1024; }
  else if (mode == 2) { lg = p.ln1_g + l * 1024; lb = p.ln1_b + l * 1024; }
  else if (mode == 3) { lg = p.ln2_g + l * 1024; lb = p.ln2_b + l * 1024; }
  const int shoff = (mode == 2) ? 3072 : 0;
  const int mstride = gridDim.x * 8;
  float4 nv[4];
#define LNM_ROW(vm_) (team_base >= 0 ? team_base + w + 8 * ((vm_) >> 11) : xrow(vm_))
  {
    const int m = LNM_ROW(blockIdx.x * 8 + w);
    const float* src = (mode == 0) ? ((m < 8192) ? p.x_prompt + (size_t)m * 1024 : p.x_sample + (size_t)(m - 8192) * 1024) : p.out + (size_t)m * 1024;
#pragma unroll
    for (int i = 0; i < 4; ++i) nv[i] = *(const float4*)(src + i * 256 + lane * 4);
  }
  for (int vm = blockIdx.x * 8 + w; vm < MT; vm += mstride) {
    const int m = LNM_ROW(vm);
    float4 v[4];
#pragma unroll
    for (int i = 0; i < 4; ++i) v[i] = nv[i];
    {
      const int mn = LNM_ROW((vm + mstride < MT) ? vm + mstride : vm);
      const float* src = (mode == 0) ? ((mn < 8192) ? p.x_prompt + (size_t)mn * 1024 : p.x_sample + (size_t)(mn - 8192) * 1024) : p.out + (size_t)mn * 1024;
#pragma unroll
      for (int i = 0; i < 4; ++i) nv[i] = *(const float4*)(src + i * 256 + lane * 4);
    }
    if (mode != 0) {
      float s = 0.f;
#pragma unroll
      for (int i = 0; i < 4; ++i) s += v[i].x + v[i].y + v[i].z + v[i].w;
      const float mean = wave_sum(s) * (1.f / 1024.f);
      float s2 = 0.f;
#pragma unroll
      for (int i = 0; i < 4; ++i) { float a = v[i].x - mean, b = v[i].y - mean, c = v[i].z - mean, d = v[i].w - mean; s2 += a * a + b * b + c * c + d * d; }
      const float rstd = rsqrtf(wave_sum(s2) * (1.f / 1024.f) + 1e-6f);
#pragma unroll
      for (int i = 0; i < 4; ++i) {
        float4 g = *(const float4*)(lg + i * 256 + lane * 4), b = *(const float4*)(lb + i * 256 + lane * 4);
        v[i].x = (v[i].x - mean) * rstd * g.x + b.x; v[i].y = (v[i].y - mean) * rstd * g.y + b.y;
        v[i].z = (v[i].z - mean) * rstd * g.z + b.z; v[i].w = (v[i].w - mean) * rstd * g.w + b.w;
        if (mode == 3) *(float4*)(p.out + (size_t)m * 1024 + i * 256 + lane * 4) = v[i];
      }
      if (mode != 3 && lane == 0) *(float2*)(p.rstat + (size_t)m * 2) = make_float2(mean, rstd);
    }
    if (mode != 3) {
      const float* md = p.mod + ((size_t)l * 9 + cond_of(m)) * 6144 + shoff;
#pragma unroll
      for (int i = 0; i < 4; ++i) {
        float4 sh = *(const float4*)(md + i * 256 + lane * 4), sc = *(const float4*)(md + 1024 + i * 256 + lane * 4);
        uint2 o;
        o.x = pack2(v[i].x * (1.f + sc.x) + sh.x, v[i].y * (1.f + sc.y) + sh.y);
        o.y = pack2(v[i].z * (1.f + sc.z) + sh.z, v[i].w * (1.f + sc.w) + sh.w);
        *(uint2*)(p.abuf + (size_t)m * 1024 + i * 256 + lane * 4) = o;
      }
    }
  }
}

#define LAS3 __attribute__((address_space(3)))
namespace g8 {
constexpr int BM = 256, BK = 64, HALF = 128, HTB = HALF * BK * 2, NXCD = 8, WGM = 4;
DEV int lds_byte(int r, int c) { const int st = (r >> 4) * 2 + (c >> 5), rr = r & 15, cc = c & 31, ob = rr * 64 + cc * 2; return st * 1024 + (ob ^ (((ob >> 9) & 1) << 5)); }
DEV void stage_rc(int b, int& R, int& C) { const int st = b / 1024, sb = b % 1024, swz = sb ^ (((sb >> 9) & 1) << 5); R = (st >> 1) * 16 + swz / 64; C = (st & 1) * 32 + (swz % 64) / 2; }
DEV bool unit_of(int i, int nM, int nN, int& pm, int& pn) {
  const int nwg = nM * nN;
  const long L = (long)i * gridDim.x + blockIdx.x; if (L >= nwg) return false;
  int wgid = (int)L; { const int q = nwg / NXCD, r = nwg % NXCD, xcd = wgid % NXCD, off = wgid / NXCD; wgid = (xcd < r ? xcd * (q + 1) : r * (q + 1) + (xcd - r) * q) + off; }
  const int nig = WGM * nN, gid = wgid / nig, fm = gid * WGM, gsz = (nM - fm) < WGM ? (nM - fm) : WGM;
  pm = own_panel(fm + ((wgid % nig) % gsz)); pn = (wgid % nig) / gsz; return true;
}
}

template <int EPI>
DEV void gemm_epilogue(const Params& p, int l, f32x4 (&acc)[2][2][4][2], int pm, int pn, int wr, int wc, int fr, int fq) {
  const int brow = pm * 256, bcol = pn * 256;
  const float* md = p.mod + ((size_t)l * 9 + cond_of(brow)) * 6144;
#pragma unroll
  for (int bj = 0; bj < 2; ++bj)
#pragma unroll
    for (int n = 0; n < 2; ++n) {
      const int col = bcol + bj * 128 + wc * 32 + n * 16 + fq * 4;
      float4 gate = make_float4(0.f, 0.f, 0.f, 0.f), bias = make_float4(0.f, 0.f, 0.f, 0.f);
      if (EPI == 2) gate = *(const float4*)(md + 2048 + col);
      if (EPI == 3) bias = *(const float4*)(p.b_ff1 + l * 4096 + col);
      if (EPI == 4) { gate = *(const float4*)(md + 5120 + col); bias = *(const float4*)(p.b_ff2 + l * 1024 + col); }
#pragma unroll
      for (int ai = 0; ai < 2; ++ai)
#pragma unroll
        for (int m = 0; m < 4; ++m) {
          const int row = brow + ai * 128 + wr * 64 + m * 16 + fr;
          const f32x4 v = acc[ai][bj][m][n];
          if (EPI == 1) {
            uint2 o; o.x = pack2(v[0], v[1]); o.y = pack2(v[2], v[3]);
            *(uint2*)(p.zf + (size_t)row * 1792 + col) = o;
          } else if (EPI == 2) {
            const float* xs = (l == 0) ? ((row < 8192) ? p.x_prompt + (size_t)row * 1024 : p.x_sample + (size_t)(row - 8192) * 1024) : p.out + (size_t)row * 1024;
            const float4 x = *(const float4*)(xs + col);
            *(float4*)(p.out + (size_t)row * 1024 + col) = make_float4(ALPHA * x.x + gate.x * v[0], ALPHA * x.y + gate.y * v[1], ALPHA * x.z + gate.z * v[2], ALPHA * x.w + gate.w * v[3]);
          } else if (EPI == 3) {
            const float t0 = fmaxf(v[0] + bias.x, 0.f), t1 = fmaxf(v[1] + bias.y, 0.f), t2 = fmaxf(v[2] + bias.z, 0.f), t3 = fmaxf(v[3] + bias.w, 0.f);
            uint2 o; o.x = pack2(t0 * t0, t1 * t1); o.y = pack2(t2 * t2, t3 * t3);
            *(uint2*)(p.zf + (size_t)row * 4096 + col) = o;
          } else {
            float* xo = p.out + (size_t)row * 1024 + col;
            const float4 x = *(const float4*)xo;
            *(float4*)xo = make_float4(ALPHA * x.x + gate.x * (v[0] + bias.x), ALPHA * x.y + gate.y * (v[1] + bias.y), ALPHA * x.z + gate.z * (v[2] + bias.z), ALPHA * x.w + gate.w * (v[3] + bias.w));
          }
        }
    }
}

template <int EPI>
DEV void gemm_epilogue_lnres(const Params& p, int l, f32x4 (&acc)[2][2][4][2], int pm, int pn, int wr, int wc, int fr, int fq) {
  const int brow = pm * 256, bcol = pn * 256;
  const float* md = p.mod + ((size_t)l * 9 + cond_of(brow)) * 6144;
  float mean[2][4], rstd[2][4];
  {
    const unsigned so = (unsigned)(brow + wr * 64 + fr) * 2u;
#pragma unroll
    for (int ai = 0; ai < 2; ++ai)
#pragma unroll
      for (int m = 0; m < 4; ++m) { const float2 t = *(const float2*)(p.rstat + (so + (unsigned)((ai * 128 + m * 16) * 2))); mean[ai][m] = t.x; rstd[ai][m] = t.y; }
  }
  const float* lg = (EPI == 2) ? p.ln2_g + (l - 1) * 1024 : p.ln1_g + l * 1024;
  const float* lb = (EPI == 2) ? p.ln2_b + (l - 1) * 1024 : p.ln1_b + l * 1024;
  const unsigned co = (unsigned)(bcol + wc * 32 + fq * 4);
  const unsigned ro = (unsigned)(brow + wr * 64 + fr) * 1024u + co;
#pragma unroll
  for (int bj = 0; bj < 2; ++bj)
#pragma unroll
    for (int n = 0; n < 2; ++n) {
      unsigned col = co + (unsigned)(bj * 128 + n * 16), rb = ro + (unsigned)(bj * 128 + n * 16);
      asm volatile("" : "+v"(col), "+v"(rb));
      float4 gate, bias = make_float4(0.f, 0.f, 0.f, 0.f);
      if (EPI == 2) gate = *(const float4*)(md + 2048 + col);
      else { gate = *(const float4*)(md + 5120 + col); bias = *(const float4*)(p.b_ff2 + l * 1024 + col); }
      const float4 g4 = *(const float4*)(lg + col), b4 = *(const float4*)(lb + col);
#pragma unroll
      for (int ai = 0; ai < 2; ++ai)
#pragma unroll
        for (int m = 0; m < 4; ++m) {
          float* xo = p.out + (rb + (unsigned)((ai * 128 + m * 16) * 1024));
          const float4 x = *(const float4*)xo;
          const float mu = mean[ai][m], rr = rstd[ai][m];
          const f32x4 v = acc[ai][bj][m][n];
          const float x0 = (x.x - mu) * rr * g4.x + b4.x, x1 = (x.y - mu) * rr * g4.y + b4.y, x2 = (x.z - mu) * rr * g4.z + b4.z, x3 = (x.w - mu) * rr * g4.w + b4.w;
          *(float4*)xo = make_float4(ALPHA * x0 + gate.x * (v[0] + bias.x), ALPHA * x1 + gate.y * (v[1] + bias.y), ALPHA * x2 + gate.z * (v[2] + bias.z), ALPHA * x3 + gate.w * (v[3] + bias.w));
        }
    }
}

template <int EPI>
DEV void gemm_phase(const Params& p, int l, const bf16_t* Ag, const bf16_t* Btg, int N, int K, LAS3 unsigned char* lds) {
  using namespace g8;
  const int tid = threadIdx.x, wid = __builtin_amdgcn_readfirstlane(tid >> 6), lane = tid & 63, wr = wid >> 2, wc = wid & 3, fr = lane & 15, fq = lane >> 4;
  const int nt = K / BK, nM = MT / BM, nN = N / BM;
  unsigned voff[2];
#pragma unroll
  for (int i = 0; i < 2; ++i) { int R, C; stage_rc(tid * 16 + i * 8192, R, C); voff[i] = (unsigned)(R * K + C) * 2u; }
  const size_t kstep = (size_t)(BK * 2);
  const size_t hstep = (size_t)HALF * K * 2;
  const size_t tstep = 2 * hstep;
  const unsigned ldsw = (unsigned)wid * 1024u;
  const int aoff = lds_byte(wr * 64 + fr, fq * 8), boff = lds_byte(wc * 32 + fr, fq * 8);
#define PG8_SA(b, h) (((b) * 2 + (h)) * HTB)
#define PG8_SB(b, h) ((4 + (b) * 2 + (h)) * HTB)
#define PG8_STAGE(bufoff, gbase) do { _Pragma("unroll") for (int _i = 0; _i < 2; ++_i) \
    __builtin_amdgcn_global_load_lds((const unsigned*)((const char*)(gbase) + voff[_i]), (LAS3 unsigned*)(lds + (bufoff) + ldsw + _i * 8192), 16, 0, 0); } while (0)
#define PG8_LDA(dst, b, h) do { _Pragma("unroll") for (int m = 0; m < 4; ++m) _Pragma("unroll") for (int k = 0; k < 2; ++k) dst[m][k] = *(const LAS3 bf16x8*)(lds + PG8_SA(b, h) + aoff + m * 2048 + k * 1024); } while (0)
#define PG8_LDB(dst, b, h) do { _Pragma("unroll") for (int n = 0; n < 2; ++n) _Pragma("unroll") for (int k = 0; k < 2; ++k) dst[n][k] = *(const LAS3 bf16x8*)(lds + PG8_SB(b, h) + boff + n * 2048 + k * 1024); } while (0)
#define PG8_MMA(ai, bj, At_, Bt_) do { __builtin_amdgcn_s_setprio(1); _Pragma("unroll") for (int m = 0; m < 4; ++m) _Pragma("unroll") for (int n = 0; n < 2; ++n) _Pragma("unroll") for (int k = 0; k < 2; ++k) \
    acc[ai][bj][m][n] = __builtin_amdgcn_mfma_f32_16x16x32_bf16(Bt_[n][k], At_[m][k], acc[ai][bj][m][n], 0, 0, 0); __builtin_amdgcn_s_setprio(0); } while (0)
#define PG8_WAIT_V(n) asm volatile("s_waitcnt vmcnt(" #n ")" ::: "memory")
#define PG8_WAIT_L(n) asm volatile("s_waitcnt lgkmcnt(" #n ")" ::: "memory")
#define PG8_BAR __builtin_amdgcn_s_barrier()
#define PG8_SCHED __builtin_amdgcn_sched_barrier(0)
  int cpm, cpn, npm = 0, npn = 0, ui = 0;
  if (!unit_of(0, nM, nN, cpm, cpn)) return;
  f32x4 acc[2][2][4][2];
#pragma unroll
  for (int a = 0; a < 2; ++a)
#pragma unroll
    for (int b = 0; b < 2; ++b)
#pragma unroll
      for (int m = 0; m < 4; ++m)
#pragma unroll
        for (int n = 0; n < 2; ++n) acc[a][b][m][n] = (f32x4){0.f, 0.f, 0.f, 0.f};
  bf16x8 At[4][2], B0[2][2], B1[2][2];
  const char* cA = (const char*)Ag + (size_t)cpm * tstep; const char* cB = (const char*)Btg + (size_t)cpn * tstep;
  PG8_STAGE(PG8_SB(0, 0), cB); PG8_STAGE(PG8_SA(0, 0), cA); PG8_STAGE(PG8_SB(0, 1), cB + hstep); PG8_STAGE(PG8_SA(0, 1), cA + hstep);
  if (wr == 1) PG8_BAR;
  PG8_WAIT_V(4); PG8_BAR;
  PG8_STAGE(PG8_SB(1, 0), cB + kstep); PG8_STAGE(PG8_SA(1, 0), cA + kstep); PG8_STAGE(PG8_SB(1, 1), cB + hstep + kstep);
  PG8_WAIT_V(6); PG8_BAR;
  for (;;) {
    const bool has_next = unit_of(ui + 1, nM, nN, npm, npn);
    const char* nA = has_next ? (const char*)Ag + (size_t)npm * tstep : cA; const char* nB = has_next ? (const char*)Btg + (size_t)npn * tstep : cB;
    for (int t = 0; t < nt; t += 2) {
      const bool last = (t == nt - 2);
      const char* a1 = cA + (size_t)(t + 1) * kstep;
      const char* a2 = last ? nA : cA + (size_t)(t + 2) * kstep; const char* b2 = last ? nB : cB + (size_t)(t + 2) * kstep;
      const char* a3 = a2 + kstep; const char* b3 = b2 + kstep;
      PG8_LDB(B0, 0, 0); PG8_SCHED; PG8_LDA(At, 0, 0); PG8_STAGE(PG8_SA(1, 1), a1 + hstep);
      PG8_WAIT_L(8); PG8_BAR; PG8_WAIT_L(0); PG8_MMA(0, 0, At, B0); PG8_BAR; PG8_SCHED;
      PG8_LDB(B1, 0, 1); PG8_STAGE(PG8_SB(0, 0), b2);
      PG8_BAR; PG8_WAIT_L(0); PG8_MMA(0, 1, At, B1); PG8_BAR;
      PG8_LDA(At, 0, 1); PG8_STAGE(PG8_SA(0, 0), a2);
      PG8_BAR; PG8_WAIT_L(0); PG8_MMA(1, 0, At, B0); PG8_BAR; PG8_SCHED;
      PG8_STAGE(PG8_SB(0, 1), b2 + hstep);
      PG8_WAIT_V(6); PG8_BAR; PG8_MMA(1, 1, At, B1); PG8_BAR;
      PG8_LDB(B0, 1, 0); PG8_SCHED; PG8_LDA(At, 1, 0); PG8_STAGE(PG8_SA(0, 1), a2 + hstep);
      PG8_WAIT_L(8); PG8_BAR; PG8_WAIT_L(0); PG8_MMA(0, 0, At, B0); PG8_BAR; PG8_SCHED;
      PG8_LDB(B1, 1, 1); PG8_STAGE(PG8_SB(1, 0), b3);
      PG8_BAR; PG8_WAIT_L(0); PG8_MMA(0, 1, At, B1); PG8_BAR;
      PG8_LDA(At, 1, 1); PG8_STAGE(PG8_SA(1, 0), a3);
      PG8_BAR; PG8_WAIT_L(0); PG8_MMA(1, 0, At, B0); PG8_BAR; PG8_SCHED;
      PG8_STAGE(PG8_SB(1, 1), b3 + hstep);
      PG8_WAIT_V(6); PG8_BAR; PG8_MMA(1, 1, At, B1); PG8_BAR;
    }
    if (EPI == 4 || (EPI == 2 && l > 0)) gemm_epilogue_lnres<EPI>(p, l, acc, cpm, cpn, wr, wc, fr, fq);
    else gemm_epilogue<EPI>(p, l, acc, cpm, cpn, wr, wc, fr, fq);
    if (!has_next) break;
#pragma unroll
    for (int a = 0; a < 2; ++a)
#pragma unroll
      for (int b = 0; b < 2; ++b)
#pragma unroll
        for (int m = 0; m < 4; ++m)
#pragma unroll
          for (int n = 0; n < 2; ++n) acc[a][b][m][n] = (f32x4){0.f, 0.f, 0.f, 0.f};
    cpm = npm; cpn = npn; cA = nA; cB = nB; ++ui;
  }
  PG8_WAIT_V(0);
  if (wr == 0) PG8_BAR;
  PG8_BAR;
#undef PG8_SA
#undef PG8_SB
#undef PG8_STAGE
#undef PG8_LDA
#undef PG8_LDB
#undef PG8_MMA
#undef PG8_WAIT_V
#undef PG8_WAIT_L
#undef PG8_BAR
#undef PG8_SCHED
}

DEV void rope8(float (&v)[8], int d0, int prow, int pcol, const float* __restrict__ rope) {
  const int pp = (d0 < 32) ? prow : pcol;
#pragma unroll
  for (int i = 0; i < 4; ++i) {
    const int f = ((d0 >> 1) + i) & 15;
    const float cs = rope[(pp * 16 + f) * 2], sn = rope[(pp * 16 + f) * 2 + 1];
    const float x1 = v[2 * i], x2 = v[2 * i + 1];
    v[2 * i] = x1 * cs - x2 * sn; v[2 * i + 1] = x1 * sn + x2 * cs;
  }
}

DEV void prep_token_row(const Params& p, int l, int m, int lane, uint4 c) {
  bf16_t* zr = p.zf + (size_t)m * 1792;
  const bool lat = m >= 8192;
  const int pos = lat ? ((m - 8192) & 1023) : (m & 255);
  const int prow = pos >> 6, pcol = pos & 63;
  const int d0 = (lane & 7) * 8;
  U8 u; u.u = c;
  float v[8], gl[8]; float ss = 0.f, sg = 0.f;
#pragma unroll
  for (int j = 0; j < 8; ++j) { v[j] = bf2f(u.h[j]); ss += v[j] * v[j]; gl[j] = gelu_t(v[j]); sg += gl[j]; }
  ss += __shfl_xor(ss, 1); ss += __shfl_xor(ss, 2); ss += __shfl_xor(ss, 4);
#pragma unroll
  for (int o = 1; o <= 16; o <<= 1) sg += __shfl_xor(sg, o);
  const float mean = sg * (1.f / 256.f);
  float s2 = 0.f;
#pragma unroll
  for (int j = 0; j < 8; ++j) { const float d = gl[j] - mean; s2 += d * d; }
#pragma unroll
  for (int o = 1; o <= 16; o <<= 1) s2 += __shfl_xor(s2, o);
  if (lane < 16) {
    const float rinv = rsqrtf(ss * (1.f / 64.f) + 1e-6f);
#pragma unroll
    for (int j = 0; j < 8; ++j) v[j] = v[j] * rinv * p.k_g[l * 64 + d0 + j];
    if (!lat) {
      float* o = p.out + OFF_YK + ((((size_t)(m >> 8)) * 2 + l) * 256 + pos) * 128 + lane * 8;
      *(float4*)o = make_float4(v[0], v[1], v[2], v[3]); *(float4*)(o + 4) = make_float4(v[4], v[5], v[6], v[7]);
    } else rope8(v, d0, prow, pcol, p.rope);
#pragma unroll
    for (int j = 0; j < 4; ++j) u.w[j] = pack2(v[2 * j], v[2 * j + 1]);
    const int kvh = lane >> 3;
    bf16_t* kd = lat ? p.kb_lat + ((size_t)((l * 8 + ((m - 8192) >> 10)) * 2 + kvh) * 1280 + 256 + pos) * 64 + d0
                     : p.kb_ctx + ((size_t)((m >> 8) * 2 + kvh) * 256 + pos) * 64 + d0;
    *(uint4*)kd = u.u;
  } else if (lane < 32) {
    if (!lat) {
      float* o = p.out + OFF_YV + ((((size_t)(m >> 8)) * 2 + l) * 256 + pos) * 128 + (lane - 16) * 8;
      *(float4*)o = make_float4(v[0], v[1], v[2], v[3]); *(float4*)(o + 4) = make_float4(v[4], v[5], v[6], v[7]);
    }
    const int kvh = (lane - 16) >> 3;
    bf16_t* vd; int T;
    if (lat) { T = 1280; vd = p.vt_lat + ((size_t)((l * 8 + ((m - 8192) >> 10)) * 2 + kvh) * 64 + d0) * 1280 + 256 + pos; }
    else { T = 256; vd = p.vt_ctx + ((size_t)((m >> 8) * 2 + kvh) * 64 + d0) * 256 + pos; }
#pragma unroll
    for (int j = 0; j < 8; ++j) vd[(size_t)j * T] = u.h[j];
  } else {
    const float rstd = rsqrtf(s2 * (1.f / 256.f) + 1e-6f);
    const int ch = (lane - 32) * 8;
#pragma unroll
    for (int j = 0; j < 8; ++j) gl[j] = (gl[j] - mean) * rstd * p.mlp_g[l * 256 + ch + j] + p.mlp_b[l * 256 + ch + j];
#pragma unroll
    for (int j = 0; j < 4; ++j) u.w[j] = pack2(gl[2 * j], gl[2 * j + 1]);
    *(uint4*)(zr + 1536 + ch) = u.u;
  }
}

template <bool REV>
DEV void tile_scan(float (&a)[4][4], float (&u)[4][4], int lane) {
  const int q = lane >> 4;
  float C = 0.f, CP = 1.f;
  const int src1 = (REV ? lane + 16 : lane - 16) & 63;
  const int src2 = (REV ? lane + 32 : lane - 32) & 63;
  const int srcT = (lane & 15) + (REV ? 0 : 48);
  const bool c1 = REV ? (q <= 2) : (q >= 1);
  const bool c2 = REV ? (q <= 1) : (q >= 2);
  const bool first = REV ? (q == 3) : (q == 0);
#pragma unroll
  for (int mi = 0; mi < 4; ++mi) {
    const int mt = REV ? 3 - mi : mi;
    float P = 1.f, H = 0.f, pl[4], hl[4];
#pragma unroll
    for (int ri = 0; ri < 4; ++ri) {
      const int r = REV ? 3 - ri : ri;
      H = a[mt][r] * H + u[mt][r]; P *= a[mt][r]; pl[r] = P; hl[r] = H;
    }
    float Pi = P, Hi = H;
    float Pp = __shfl(Pi, src1), Hp = __shfl(Hi, src1);
    if (c1) { Hi = Pi * Hp + Hi; Pi = Pi * Pp; }
    Pp = __shfl(Pi, src2); Hp = __shfl(Hi, src2);
    if (c2) { Hi = Pi * Hp + Hi; Pi = Pi * Pp; }
    float Pe = __shfl(Pi, src1), He = __shfl(Hi, src1);
    if (first) { Pe = 1.f; He = 0.f; }
    const float hin = Pe * C + He, pin = Pe * CP;
#pragma unroll
    for (int r = 0; r < 4; ++r) { u[mt][r] = pl[r] * hin + hl[r]; a[mt][r] = pl[r] * pin; }
    const float Pt = __shfl(Pi, srcT), Ht = __shfl(Hi, srcT);
    C = Pt * C + Ht; CP = Pt * CP;
  }
}

DEV void lru_gate_item(const Params& p, int l, int item, char* smem) {
  const int tid = VTID, lane = tid & 63, w = tid >> 6;
  const int tile = item >> 2, blk = item & 3;
  const int m0 = tile * 64;
  int ms, L;
  if (m0 < 8192) { ms = m0 & ~255; L = 256; } else { ms = 8192 + ((m0 - 8192) & ~1023); L = 1024; }
  const int dir = w >> 1, half = w & 1, q = lane >> 4, c15 = lane & 15;
  const bf16_t* wt = p.wt_lru + (size_t)((((l * 2 + dir) * 4 + blk) * 2)) * 4096;
  bf16x8 bfr[2][2][2];
#pragma unroll
  for (int mat = 0; mat < 2; ++mat)
#pragma unroll
    for (int j = 0; j < 2; ++j)
#pragma unroll
      for (int s = 0; s < 2; ++s) bfr[mat][j][s] = *(const bf16x8*)(wt + mat * 4096 + (half * 32 + j * 16 + c15) * 64 + s * 32 + q * 8);
  float* xs = (float*)smem;
  float* xcf = xs + 67 * 64;
  bf16_t* xcb = (bf16_t*)(xcf + 64 * 64);
  for (int idx = tid; idx < 67 * 8; idx += 256) {
    const int rr = idx >> 3, cc = idx & 7;
    const int m = m0 - 1 + rr;
    float v[8];
    if (m >= ms && m < ms + L) {
      U8 u; u.u = *(const uint4*)(p.zf + (size_t)m * 1792 + 768 + blk * 64 + cc * 8);
#pragma unroll
      for (int j = 0; j < 8; ++j) v[j] = bf2f(u.h[j]);
    } else {
#pragma unroll
      for (int j = 0; j < 8; ++j) v[j] = 0.f;
    }
#pragma unroll
    for (int j = 0; j < 8; ++j) xs[rr * 64 + cc * 8 + j] = v[j];
  }
  __syncthreads();
  {
    const int ch = tid & 63, Cg = blk * 64 + ch;
    const float w0 = p.conv_w[(l * 4 + 0) * 256 + Cg], w1 = p.conv_w[(l * 4 + 1) * 256 + Cg], w2 = p.conv_w[(l * 4 + 2) * 256 + Cg],
                w3 = p.conv_w[(l * 4 + 3) * 256 + Cg], cb = p.conv_b[l * 256 + Cg];
#pragma unroll 4
    for (int tt = 0; tt < 16; ++tt) {
      const int t = (tid >> 6) * 16 + tt;
      const float v = cb + w0 * xs[t * 64 + ch] + w1 * xs[(t + 1) * 64 + ch] + w2 * xs[(t + 2) * 64 + ch] + w3 * xs[(t + 3) * 64 + ch];
      xcf[t * 64 + ch] = v; xcb[t * 72 + ch] = f2bf(v);
    }
  }
  __syncthreads();
  f32x4 acc[2][4][2];
#pragma unroll
  for (int mat = 0; mat < 2; ++mat)
#pragma unroll
    for (int mt = 0; mt < 4; ++mt)
#pragma unroll
      for (int j = 0; j < 2; ++j) acc[mat][mt][j] = f32x4{0.f, 0.f, 0.f, 0.f};
#pragma unroll
  for (int mt = 0; mt < 4; ++mt)
#pragma unroll
    for (int s = 0; s < 2; ++s) {
      const bf16x8 af = *(const bf16x8*)(xcb + (mt * 16 + c15) * 72 + s * 32 + q * 8);
#pragma unroll
      for (int mat = 0; mat < 2; ++mat)
#pragma unroll
        for (int j = 0; j < 2; ++j) acc[mat][mt][j] = mfma16(af, bfr[mat][j][s], acc[mat][mt][j]);
    }
  float* PCp = p.au + (size_t)(dir * 2 + 0) * MT * 256;
  float* HLp = p.au + (size_t)(dir * 2 + 1) * MT * 256;
#pragma unroll
  for (int j = 0; j < 2; ++j) {
    const int ch = half * 32 + j * 16 + c15, Cg = blk * 64 + ch, pidx = (l * 2 + dir) * 256 + Cg;
    const float ba = p.lru_ba[pidx], bx = p.lru_bx[pidx];
    const float cdec = p.cdec[pidx];
    float a[4][4], u[4][4];
#pragma unroll
    for (int mt = 0; mt < 4; ++mt)
#pragma unroll
      for (int r = 0; r < 4; ++r) {
        const int t = mt * 16 + q * 4 + r;
        const float rg = sigmoidf_(acc[0][mt][j][r] + ba), ig = sigmoidf_(acc[1][mt][j][r] + bx);
        const float la = cdec * rg;
        a[mt][r] = __expf(la);
        const float x2 = 2.f * la;
        const float em = (x2 < -0.25f) ? 1.f - __expf(x2) : -x2 * (1.f + x2 * (0.5f + x2 * (1.f / 6.f + x2 * (1.f / 24.f + x2 * (1.f / 120.f + x2 * (1.f / 720.f))))));
        u[mt][r] = __builtin_amdgcn_sqrtf(em) * ig * xcf[t * 64 + ch];
      }
    if (dir == 0) tile_scan<false>(a, u, lane); else tile_scan<true>(a, u, lane);
#pragma unroll
    for (int mt = 0; mt < 4; ++mt)
#pragma unroll
      for (int r = 0; r < 4; ++r) {
        const size_t m = m0 + mt * 16 + q * 4 + r;
        PCp[m * 256 + Cg] = a[mt][r]; HLp[m * 256 + Cg] = u[mt][r];
      }
  }
  __syncthreads();
}

DEV void attn_item(const Params& p, int l, int it, char* sm) {
  const int tid = threadIdx.x, lane = tid & 63, w = tid >> 6, q = lane >> 4, c15 = lane & 15;
  const int qg = w >> 1, kh = w & 1;
  int h, ms, nkt, T; const bf16_t* Kg; const bf16_t* Vg;
  if (it < 512) {
    const int b = it >> 6, qb = it & 7; h = (it >> 3) & 7; ms = 8192 + b * 1024 + qb * 128; nkt = 10; T = 1280;
    Kg = p.kb_lat + (size_t)((l * 8 + b) * 2 + (h >> 2)) * 1280 * 64; Vg = p.vt_lat + (size_t)((l * 8 + b) * 2 + (h >> 2)) * 64 * 1280;
  } else {
    const int i2 = it - 512, b = i2 >> 4, qb = i2 & 1; h = (i2 >> 1) & 7; ms = b * 256 + qb * 128; nkt = 2; T = 256;
    Kg = p.kb_ctx + (size_t)(b * 2 + (h >> 2)) * 256 * 64; Vg = p.vt_ctx + (size_t)(b * 2 + (h >> 2)) * 64 * 256;
  }
  const int kc0 = tid, kc1 = tid + 512;
  const int vd0 = tid >> 4, vk = (tid & 15) * 8;
  const int vpos = ((tid & 15) >> 2) * 32 + 16 * (tid & 1) + 4 * ((tid & 3) >> 1);
  const bf16_t* vg0 = Vg + (size_t)vd0 * T + vk;
  const bf16_t* vg1 = Vg + (size_t)(vd0 + 32) * T + vk;
  uint4 rk0, rk1, rv0, rv1;
#define ATT_LOAD(kt) do { rk0 = *(const uint4*)(Kg + (size_t)(kt) * 8192 + kc0 * 8); rk1 = *(const uint4*)(Kg + (size_t)(kt) * 8192 + kc1 * 8); \
    rv0 = *(const uint4*)(vg0 + (kt) * 128); rv1 = *(const uint4*)(vg1 + (kt) * 128); } while (0)
#define ATT_STORE(buf) do { bf16_t* Ks_ = (bf16_t*)(sm + (buf) * 36864); bf16_t* Vs_ = Ks_ + 9216; \
    *(uint4*)(Ks_ + (kc0 >> 3) * 72 + (kc0 & 7) * 8) = rk0; *(uint4*)(Ks_ + (kc1 >> 3) * 72 + (kc1 & 7) * 8) = rk1; \
    *(uint2*)(Vs_ + vd0 * 136 + vpos) = make_uint2(rv0.x, rv0.y); *(uint2*)(Vs_ + vd0 * 136 + vpos + 8) = make_uint2(rv0.z, rv0.w); \
    *(uint2*)(Vs_ + (vd0 + 32) * 136 + vpos) = make_uint2(rv1.x, rv1.y); *(uint2*)(Vs_ + (vd0 + 32) * 136 + vpos + 8) = make_uint2(rv1.z, rv1.w); } while (0)
  ATT_LOAD(0);
  const int mq = ms + qg * 32;
  bf16x8 qf[2][2];
#pragma unroll
  for (int t = 0; t < 2; ++t)
#pragma unroll
    for (int s = 0; s < 2; ++s) qf[t][s] = *(const bf16x8*)(p.zf + (size_t)(mq + t * 16 + c15) * 1792 + h * 64 + s * 32 + q * 8);
  ATT_STORE(0);
  if (nkt > 1) ATT_LOAD(1);
#pragma unroll
  for (int t = 0; t < 2; ++t) {
    float f[2][8]; float ss = 0.f;
#pragma unroll
    for (int s = 0; s < 2; ++s)
#pragma unroll
      for (int j = 0; j < 8; ++j) { f[s][j] = bf2f((bf16_t)qf[t][s][j]); ss += f[s][j] * f[s][j]; }
    ss += __shfl_xor(ss, 16); ss += __shfl_xor(ss, 32);
    const float rinv = rsqrtf(ss * (1.f / 64.f) + 1e-6f);
    const int mrow_ = mq + t * 16 + c15;
    const int pos = (mrow_ - 8192) & 1023;
#pragma unroll
    for (int s = 0; s < 2; ++s) {
      const int dd = s * 32 + q * 8;
#pragma unroll
      for (int j = 0; j < 8; ++j) f[s][j] = f[s][j] * rinv * p.q_g[l * 64 + dd + j];
      if (it < 512) rope8(f[s], dd, pos >> 6, pos & 63, p.rope);
      U8 pk;
#pragma unroll
      for (int j = 0; j < 4; ++j) pk.w[j] = pack2(f[s][2 * j] * QSCALE, f[s][2 * j + 1] * QSCALE);
      qf[t][s] = pk.v;
    }
  }
  __syncthreads();
  f32x4 o[2][4];
  float mrow[2], lrow[2];
#pragma unroll
  for (int t = 0; t < 2; ++t) { mrow[t] = -1e30f; lrow[t] = 0.f;
#pragma unroll
    for (int j = 0; j < 4; ++j) o[t][j] = f32x4{0.f, 0.f, 0.f, 0.f}; }
  for (int kt = 0; kt < nkt; ++kt) {
    const int cur = kt & 1;
    const bf16_t* Ks = (const bf16_t*)(sm + cur * 36864) + kh * 64 * 72;
    const bf16_t* Vs = (const bf16_t*)(sm + cur * 36864) + 9216 + kh * 64;
    f32x4 s4[2][4];
    {
      bf16x8 kf[4][2];
#pragma unroll
      for (int jn = 0; jn < 4; ++jn)
#pragma unroll
        for (int s = 0; s < 2; ++s) kf[jn][s] = *(const bf16x8*)(Ks + (jn * 16 + c15) * 72 + s * 32 + q * 8);
      __builtin_amdgcn_sched_barrier(0);
#pragma unroll
      for (int jn = 0; jn < 4; ++jn)
#pragma unroll
        for (int t = 0; t < 2; ++t) s4[t][jn] = mfma16(kf[jn][0], qf[t][0], f32x4{0.f, 0.f, 0.f, 0.f});
#pragma unroll
      for (int jn = 0; jn < 4; ++jn)
#pragma unroll
        for (int t = 0; t < 2; ++t) s4[t][jn] = mfma16(kf[jn][1], qf[t][1], s4[t][jn]);
      __builtin_amdgcn_sched_barrier(0);
    }
    U8 vf[4][2];
#pragma unroll
    for (int jn = 0; jn < 4; ++jn)
#pragma unroll
      for (int ks = 0; ks < 2; ++ks) vf[jn][ks].u = *(const uint4*)(Vs + (jn * 16 + c15) * 136 + ks * 32 + q * 8);
    __builtin_amdgcn_sched_barrier(0);
    U8 pb[2][2];
#pragma unroll
    for (int t = 0; t < 2; ++t) {
      float mx = s4[t][0][0];
#pragma unroll
      for (int jn = 0; jn < 4; ++jn)
#pragma unroll
        for (int r = 0; r < 4; ++r) mx = fmaxf(mx, s4[t][jn][r]);
      mx = fmaxf(mx, __shfl_xor(mx, 16)); mx = fmaxf(mx, __shfl_xor(mx, 32));
      const float mnew = fmaxf(mrow[t], mx);
      const float alpha = __builtin_amdgcn_exp2f(mrow[t] - mnew);
      mrow[t] = mnew;
      float ls = 0.f;
#pragma unroll
      for (int jn = 0; jn < 4; ++jn)
#pragma unroll
        for (int r = 0; r < 4; ++r) { const float pv = __builtin_amdgcn_exp2f(s4[t][jn][r] - mnew); s4[t][jn][r] = pv; ls += pv; }
      lrow[t] = lrow[t] * alpha + ls;
#pragma unroll
      for (int jn = 0; jn < 4; ++jn) { o[t][jn][0] *= alpha; o[t][jn][1] *= alpha; o[t][jn][2] *= alpha; o[t][jn][3] *= alpha; }
#pragma unroll
      for (int ks = 0; ks < 2; ++ks) {
        pb[t][ks].w[0] = pack2(s4[t][2 * ks][0], s4[t][2 * ks][1]); pb[t][ks].w[1] = pack2(s4[t][2 * ks][2], s4[t][2 * ks][3]);
        pb[t][ks].w[2] = pack2(s4[t][2 * ks + 1][0], s4[t][2 * ks + 1][1]); pb[t][ks].w[3] = pack2(s4[t][2 * ks + 1][2], s4[t][2 * ks + 1][3]);
      }
    }
#pragma unroll
    for (int ks = 0; ks < 2; ++ks)
#pragma unroll
      for (int jn = 0; jn < 4; ++jn)
#pragma unroll
        for (int t = 0; t < 2; ++t) o[t][jn] = mfma16(vf[jn][ks].v, pb[t][ks].v, o[t][jn]);
    if (kt + 1 < nkt) {
      ATT_STORE(cur ^ 1);
      if (kt + 2 < nkt) ATT_LOAD(kt + 2);
    }
    __syncthreads();
  }
#undef ATT_LOAD
#undef ATT_STORE
  float* mrg = (float*)(sm + 73728) + (size_t)(qg * 64 + lane) * 37;
  float lt[2];
#pragma unroll
  for (int t = 0; t < 2; ++t) { float a = lrow[t]; a += __shfl_xor(a, 16); a += __shfl_xor(a, 32); lt[t] = a; }
  if (kh == 1) {
#pragma unroll
    for (int t = 0; t < 2; ++t) {
      mrg[t * 18 + 0] = mrow[t]; mrg[t * 18 + 1] = lt[t];
#pragma unroll
      for (int jn = 0; jn < 4; ++jn)
#pragma unroll
        for (int r = 0; r < 4; ++r) mrg[t * 18 + 2 + jn * 4 + r] = o[t][jn][r];
    }
  }
  __syncthreads();
  if (kh == 0) {
#pragma unroll
    for (int t = 0; t < 2; ++t) {
      const float m1 = mrg[t * 18 + 0], l1 = mrg[t * 18 + 1];
      const float mm = fmaxf(mrow[t], m1);
      const float a0 = __builtin_amdgcn_exp2f(mrow[t] - mm), a1 = __builtin_amdgcn_exp2f(m1 - mm);
      const float inv = 1.f / (a0 * lt[t] + a1 * l1);
      const float c0 = a0 * inv, c1 = a1 * inv;
      bf16_t* orow = p.abuf + (size_t)(mq + t * 16 + c15) * 1024 + h * 64 + q * 4;
#pragma unroll
      for (int jn = 0; jn < 4; ++jn) {
        const float x0 = c0 * o[t][jn][0] + c1 * mrg[t * 18 + 2 + jn * 4 + 0], x1 = c0 * o[t][jn][1] + c1 * mrg[t * 18 + 2 + jn * 4 + 1];
        const float x2 = c0 * o[t][jn][2] + c1 * mrg[t * 18 + 2 + jn * 4 + 2], x3 = c0 * o[t][jn][3] + c1 * mrg[t * 18 + 2 + jn * 4 + 3];
        uint2 ov; ov.x = pack2(x0, x1); ov.y = pack2(x2, x3);
        *(uint2*)(orow + jn * 16) = ov;
      }
    }
  }
  __syncthreads();
}

DEV void gmlp_item(const Params& p, int l, int it, char* smem) {
  const int tid = VTID, lane = tid & 63, w = tid >> 6, q = lane >> 4, c15 = lane & 15;
  const int chunk = it >> 2, g = it & 3, m0 = chunk * 128;
  bf16_t* vt = (bf16_t*)smem;
  const float* wsg = p.mlp_ws + (size_t)(l * 4 + g) * 16384;
  float4 wa[2][4][2];
#pragma unroll
  for (int nt = 0; nt < 2; ++nt)
#pragma unroll
    for (int s = 0; s < 4; ++s) {
      const float* ap = wsg + ((2 * w + nt) * 16 + c15) * 128 + s * 32 + q * 8;
      wa[nt][s][0] = *(const float4*)ap; wa[nt][s][1] = *(const float4*)(ap + 4);
    }
  uint4 vin[4];
#pragma unroll
  for (int i = 0; i < 4; ++i) { const int id = tid + 256 * i; vin[i] = *(const uint4*)(p.zf + (size_t)(m0 + (id >> 3)) * 1792 + 1536 + g * 64 + (id & 7) * 8); }
#pragma unroll
  for (int i = 0; i < 4; ++i) {
    const int id = tid + 256 * i, qq = id >> 3, cc = id & 7;
    U8 v; v.u = vin[i];
#pragma unroll
    for (int j = 0; j < 8; ++j) vt[(cc * 8 + j) * 136 + qq] = v.h[j];
  }
  __syncthreads();
  f32x4 acc[4][2];
#pragma unroll
  for (int mt = 0; mt < 4; ++mt)
#pragma unroll
    for (int nt = 0; nt < 2; ++nt) acc[mt][nt] = f32x4{0.f, 0.f, 0.f, 0.f};
#pragma unroll
  for (int s = 0; s < 4; ++s) {
    bf16x8 af[4];
#pragma unroll
    for (int mt = 0; mt < 4; ++mt) af[mt] = *(const bf16x8*)(vt + (mt * 16 + c15) * 136 + s * 32 + q * 8);
#pragma unroll
    for (int nt = 0; nt < 2; ++nt) {
      U8 bb;
      bb.w[0] = pack2(wa[nt][s][0].x, wa[nt][s][0].y); bb.w[1] = pack2(wa[nt][s][0].z, wa[nt][s][0].w);
      bb.w[2] = pack2(wa[nt][s][1].x, wa[nt][s][1].y); bb.w[3] = pack2(wa[nt][s][1].z, wa[nt][s][1].w);
#pragma unroll
      for (int mt = 0; mt < 4; ++mt) acc[mt][nt] = mfma16(af[mt], bb.v, acc[mt][nt]);
    }
  }
#pragma unroll
  for (int nt = 0; nt < 2; ++nt) {
    const int pp = (2 * w + nt) * 16 + c15;
    const size_t m = m0 + pp;
    const float bsv = p.mlp_bs[(l * 4 + g) * 128 + pp];
#pragma unroll
    for (int mt = 0; mt < 4; ++mt) {
      const int c = mt * 16 + q * 4;
      const uint2 uu = *(const uint2*)(p.zf + m * 1792 + 1280 + g * 64 + c);
      const float u0 = gelu_t(__uint_as_float(uu.x << 16)), u1 = gelu_t(__uint_as_float(uu.x & 0xffff0000u)), u2 = gelu_t(__uint_as_float(uu.y << 16)), u3 = gelu_t(__uint_as_float(uu.y & 0xffff0000u));
      uint2 o; o.x = pack2(u0 * (acc[mt][nt][0] + bsv), u1 * (acc[mt][nt][1] + bsv)); o.y = pack2(u2 * (acc[mt][nt][2] + bsv), u3 * (acc[mt][nt][3] + bsv));
      *(uint2*)(p.abuf + m * 1024 + 768 + g * 64 + c) = o;
    }
  }
  __syncthreads();
}

DEV void lru_apply_item(const Params& p, int l, int ti2) {
  const int C = VTID;
  const int ti = ti2 >> 1, th = (ti2 & 1) * 32;
  const int m0 = ti * 64;
  int ms, L, b; bool lat = m0 >= 8192;
  if (!lat) { ms = m0 & ~255; L = 256; b = m0 >> 8; } else { ms = 8192 + ((m0 - 8192) & ~1023); L = 1024; b = (m0 - 8192) >> 10; }
  const int k = (m0 - ms) >> 6, nt = L >> 6;
  const float* PCf = p.au; const float* HLf = p.au + (size_t)MT * 256;
  const float* PCb = p.au + (size_t)2 * MT * 256; const float* HLb = p.au + (size_t)3 * MT * 256;
  float cf = lat ? p.state_lru[((size_t)(b * 2 + l) * 2 + 0) * 256 + C] : 0.f;
  float cb = lat ? p.state_lru[((size_t)(b * 2 + l) * 2 + 1) * 256 + C] : 0.f;
  {
    float pc[15], hl[15];
#pragma unroll
    for (int i = 0; i < 15; ++i) {
      const bool act = i < k;
      const size_t e = (size_t)(ms + 64 * i + 63) * 256 + C;
      pc[i] = act ? PCf[e] : 1.f; hl[i] = act ? HLf[e] : 0.f;
    }
#pragma unroll
    for (int i = 0; i < 15; ++i) cf = pc[i] * cf + hl[i];
  }
  {
    float pc[15], hl[15];
#pragma unroll
    for (int i = 0; i < 15; ++i) {
      const int tix = nt - 1 - i;
      const bool act = tix > k;
      const size_t e = (size_t)(ms + 64 * tix) * 256 + C;
      pc[i] = act ? PCb[e] : 1.f; hl[i] = act ? HLb[e] : 0.f;
    }
#pragma unroll
    for (int i = 0; i < 15; ++i) cb = pc[i] * cb + hl[i];
  }
  float hf_last = 0.f, hb_first = 0.f;
#pragma unroll 16
  for (int t = th; t < th + 32; ++t) {
    const size_t m = m0 + t;
    const float hf = PCf[m * 256 + C] * cf + HLf[m * 256 + C];
    const float hb = PCb[m * 256 + C] * cb + HLb[m * 256 + C];
    const float g = gelu_t(bf2f(p.zf[m * 1792 + 1024 + C]));
    p.abuf[m * 1024 + 512 + C] = f2bf((hf + hb) * g);
    if (t == 0) hb_first = hb;
    if (t == 63) hf_last = hf;
  }
  if (!lat) {
    if (k == nt - 1 && th == 32) p.out[OFF_ST + ((size_t)(b * 2 + l) * 2 + 0) * 256 + C] = hf_last;
    if (k == 0 && th == 0) p.out[OFF_ST + ((size_t)(b * 2 + l) * 2 + 1) * 256 + C] = hb_first;
  }
}

DEV void mixer_phase(const Params& p, int l, char* smem_raw, char* smem) {
  {
    const int x = blockIdx.x & 7, j = blockIdx.x >> 3;
#pragma unroll 1
    for (int k = 0; k < 4; ++k) attn_item(p, l, ((k >> 1) << 9) + 64 * x + j + 32 * (k & 1), smem_raw);
  }
  {
    const int x = blockIdx.x & 7, lh = (blockIdx.x >> 3) * 2 + (threadIdx.x >> 8);
    lru_apply_item(p, l, (own_row(x, (lh >> 1) * 64) >> 6) * 2 + (lh & 1));
    gmlp_item(p, l, (own_row(x, (lh >> 2) * 128) >> 7) * 4 + (lh & 3), smem);
  }
}

DEV void prep_phase_full(const Params& p, int l, char* smem) {
  {
    const int xcd = blockIdx.x & 7, lh = (blockIdx.x >> 3) * 2 + (threadIdx.x >> 8);
#pragma unroll 1
    for (int k = 0; k < 2; ++k) { const int li = lh + 64 * k; lru_gate_item(p, l, (own_row(xcd, (li >> 2) * 64) >> 6) * 4 + (li & 3), smem); }
  }
  const int lane = threadIdx.x & 63, mstride = gridDim.x * 8;
  int vm = blockIdx.x * 8 + (threadIdx.x >> 6);
  const int coff = lane < 32 ? 512 + lane * 8 : 1536 + (lane - 32) * 8;
  uint4 n1 = *(const uint4*)(p.zf + (size_t)xrow(vm) * 1792 + coff);
  uint4 n2 = *(const uint4*)(p.zf + (size_t)xrow((vm + mstride < MT) ? vm + mstride : vm) * 1792 + coff);
  for (; vm < MT; vm += mstride) {
    const uint4 c = n1; n1 = n2;
    const int mn = xrow((vm + 2 * mstride < MT) ? vm + 2 * mstride : vm);
    n2 = *(const uint4*)(p.zf + (size_t)mn * 1792 + coff);
    prep_token_row(p, l, xrow(vm), lane, c);
  }
}


#define XB_TMO      128
#define XB_XCNT(j)  (256  + 64 * (j))
#define XB_XSUB(j)  (1280 + 64 * (j))
#define XB_XGEN(j)  (2304 + 64 * (j))
#define XB_TOP      3328
#define XB_TOPGEN   3392
#define XCD_BAR_WORDS 3456
#define XB_SPIN_CAP (1u << 18)
#define LAS __attribute__((address_space(3)))
DEV unsigned xb_ld(unsigned* p) { return __hip_atomic_load(p, __ATOMIC_RELAXED, __HIP_MEMORY_SCOPE_AGENT); }
DEV unsigned xb_add(unsigned* p, unsigned v) { return __hip_atomic_fetch_add(p, v, __ATOMIC_RELAXED, __HIP_MEMORY_SCOPE_AGENT); }
DEV unsigned xb_xcc_id() { return (unsigned)__builtin_amdgcn_s_getreg((3 << 11) | 20) & 0xFu; }
#define XB_SPIN(cond, bar) do { unsigned _sp = 0; while (cond) { __builtin_amdgcn_s_sleep(1); \
    if ((++_sp & 255u) == 0u) { if (xb_ld(&(bar)[XB_TMO])) break; if (_sp > XB_SPIN_CAP) { atomicAdd(&(bar)[XB_TMO], 1u); break; } } } } while (0)
struct XcdBarrier { unsigned* bar; unsigned x; volatile LAS unsigned* st; };
DEV XcdBarrier xcd_barrier_post(unsigned* bar, volatile LAS unsigned* st) {
  XcdBarrier b; b.bar = bar; b.x = xb_xcc_id(); b.st = st;
  if (threadIdx.x == 0) (void)xb_add(&bar[XB_XCNT(b.x)], 1u);
  return b;
}
DEV void xcd_barrier_complete(unsigned* bar, unsigned x, unsigned& nloc, unsigned& nx) {
  const unsigned G = gridDim.x * gridDim.y * gridDim.z;
  unsigned sum, cnt, mine, sp = 0u;
  for (;;) {
    sum = 0u; cnt = 0u; mine = 0u;
#pragma unroll
    for (unsigned j = 0; j < 16; ++j) { const unsigned c = xb_ld(&bar[XB_XCNT(j)]); sum += c; cnt += (c > 0u) ? 1u : 0u; mine = (j == x) ? c : mine; }
    if (sum == G) break;
    __builtin_amdgcn_s_sleep(1);
    if ((++sp & 255u) == 0u) { if (xb_ld(&bar[XB_TMO])) break; if (sp > XB_SPIN_CAP) { atomicAdd(&bar[XB_TMO], 1u); break; } }
  }
  nloc = mine > 0u ? mine : 1u; nx = cnt > 0u ? cnt : 1u;
}
DEV void xcd_barrier(const XcdBarrier& b) {
  asm volatile("s_waitcnt vmcnt(0)" ::: "memory");
  __syncthreads();
  if (threadIdx.x == 0) {
    unsigned* bar = b.bar;
    __builtin_amdgcn_s_waitcnt(0);
    unsigned nloc = b.st[0], nx = b.st[1];
    if (nloc == 0u) { xcd_barrier_complete(bar, b.x, nloc, nx); b.st[0] = nloc; b.st[1] = nx; }
    const unsigned old = xb_add(&bar[XB_XSUB(b.x)], 1u);
    const unsigned gen = old / nloc;
    if (old + 1u == (gen + 1u) * nloc) {
      __builtin_amdgcn_fence(__ATOMIC_RELEASE, "agent");
      asm volatile("s_waitcnt vmcnt(0)" ::: "memory");
      const unsigned og = xb_add(&bar[XB_TOP], 1u);
      const unsigned tg = og / nx;
      if (og + 1u == (tg + 1u) * nx) xb_add(&bar[XB_TOPGEN], 1u);
      else XB_SPIN(xb_ld(&bar[XB_TOPGEN]) == tg, bar);
      __builtin_amdgcn_fence(__ATOMIC_ACQUIRE, "agent");
      xb_add(&bar[XB_XGEN(b.x)], 1u);
      asm volatile("s_waitcnt vmcnt(0)" ::: "memory");
    } else {
      XB_SPIN(xb_ld(&bar[XB_XGEN(b.x)]) == gen, bar);
      __builtin_amdgcn_fence(__ATOMIC_ACQUIRE, "agent");
      asm volatile("s_waitcnt vmcnt(0)" ::: "memory");
    }
  }
  __syncthreads();
}

#define XB_MISMATCH 160
#define XB_WREADY 192
DEV void xcd_barrier_local(const XcdBarrier& b) {
  asm volatile("s_waitcnt vmcnt(0)" ::: "memory");
  __syncthreads();
  if (threadIdx.x == 0) {
    unsigned* bar = b.bar;
    __builtin_amdgcn_s_waitcnt(0);
    const unsigned nloc = b.st[0];
    const unsigned old = xb_add(&bar[XB_XSUB(b.x)], 1u);
    const unsigned gen = old / nloc;
    if (old + 1u == (gen + 1u) * nloc) xb_add(&bar[XB_XGEN(b.x)], 1u);
    else XB_SPIN(xb_ld(&bar[XB_XGEN(b.x)]) == gen, bar);
    __builtin_amdgcn_fence(__ATOMIC_ACQUIRE, "agent");
    asm volatile("s_waitcnt vmcnt(0)" ::: "memory");
  }
  __syncthreads();
}

#define XB_TEAM(pm) (3520 + 8 * (pm))
DEV void team_barrier(unsigned* bar, int pm, unsigned target) {
  asm volatile("s_waitcnt vmcnt(0)" ::: "memory");
  __syncthreads();
  if (threadIdx.x == 0) {
    __builtin_amdgcn_s_waitcnt(0);
    xb_add(&bar[XB_TEAM(pm)], 1u);
    XB_SPIN(xb_ld(&bar[XB_TEAM(pm)]) < target, bar);
    __builtin_amdgcn_fence(__ATOMIC_ACQUIRE, "agent");
    asm volatile("s_waitcnt vmcnt(0)" ::: "memory");
  }
  __syncthreads();
}
DEV void team_ln(const Params& p, int l, int mode, unsigned round) {
  int pm, pn;
  if (!g8::unit_of(0, MT / 256, 4, pm, pn)) return;
  team_barrier(p.bar, pm, 4u * round);
  ln_mod_phase(p, l, mode, pm * 256 + pn * 64);
}

#define PH(i, call) if (ph_lo <= (i) && (i) < ph_hi) { if ((i) > ph_lo) { if ((i) >= 2 && xcd_local) xcd_barrier_local(xb); else xcd_barrier(xb); } call; }
#define LAYER_REST(l, b) \
  PH(b + 1, gemm_phase<1>(p, l, p.abuf, p.wt_in + (size_t)l * 1792 * 1024, 1792, 1024, (LAS3 unsigned char*)smem_raw)) \
  PH(b + 2, prep_phase_full(p, l, smem)) \
  PH(b + 3, mixer_phase(p, l, smem_raw, smem)) \
  PH(b + 4, if (l == 0 && xcd_local) { if (threadIdx.x == 0) { XB_SPIN(xb_ld(&p.bar[XB_WREADY]) < 128u, p.bar); __builtin_amdgcn_fence(__ATOMIC_ACQUIRE, "agent"); asm volatile("s_waitcnt vmcnt(0)" ::: "memory"); } __syncthreads(); } \
            gemm_phase<2>(p, l, p.abuf, p.wt_out + (size_t)l * 1024 * 1024, 1024, 1024, (LAS3 unsigned char*)smem_raw); \
            if (xcd_local) team_ln(p, l, 2, 2u * l + 1u)) \
  if (!xcd_local) { PH(b + 5, ln_mod_phase(p, l, 2)) } \
  PH(b + 6, gemm_phase<3>(p, l, p.abuf, p.wt_ff1 + (size_t)l * 4096 * 1024, 4096, 1024, (LAS3 unsigned char*)smem_raw)) \
  PH(b + 7, gemm_phase<4>(p, l, p.zf, p.wt_ff2 + (size_t)l * 1024 * 4096, 1024, 4096, (LAS3 unsigned char*)smem_raw); \
            if (xcd_local) team_ln(p, l == 0 ? 1 : 1, l == 0 ? 1 : 3, 2u * l + 2u))

__global__ void __launch_bounds__(512, 2) mega_kernel(Params p, int ph_lo, int ph_hi) {
  extern __shared__ __attribute__((aligned(16))) char smem_raw[];
  char* smem = smem_raw + (threadIdx.x >> 8) * 65536;
  __shared__ uint4 xb_words;
  if (threadIdx.x == 0) xb_words = make_uint4(0u, 0u, 0u, 0u);
  __syncthreads();
  XcdBarrier xb = xcd_barrier_post(p.bar, (volatile LAS unsigned*)&xb_words);
  if (threadIdx.x == 0) atomicOr(&p.bar[XB_MISMATCH + (blockIdx.x & 7u)], 1u << xb.x);
  if (ph_hi > 1000) { cg::grid_group grid = cg::this_grid(); grid.sync(); }
  bool xcd_local = false;
  PH(0, phase0(p, smem))
  PH(1, { unsigned all = 0u; bool one = true;
          for (int c = 0; c < 8; ++c) { const unsigned m = xb_ld(&p.bar[XB_MISMATCH + c]); one = one && (__builtin_popcount(m) == 1); all |= m; }
          xcd_local = one && all == 0xFFu && gridDim.x == 256; }
        if (xcd_local) {
          if (blockIdx.x & 4u) {
            transpose_all(p, smem, 1, ((int)(blockIdx.x & 3u) + 4 * (int)(blockIdx.x >> 3)) * 2 + (int)(threadIdx.x >> 8), 256);
            asm volatile("s_waitcnt vmcnt(0)" ::: "memory");
            __syncthreads();
            if (threadIdx.x == 0) { __builtin_amdgcn_fence(__ATOMIC_RELEASE, "agent"); asm volatile("s_waitcnt vmcnt(0)" ::: "memory"); xb_add(&p.bar[XB_WREADY], 1u); }
          }
        } else { transpose_all(p, smem, 1, VBID, VNB); xcd_barrier(xb); }
        ln_mod_phase(p, 0, 0))
#undef LAYER0_P1
  LAYER_REST(0, 1)
  if (!xcd_local) { PH(9, ln_mod_phase(p, 1, 1)) }
  LAYER_REST(1, 9)
  if (!xcd_local) { PH(17, ln_mod_phase(p, 1, 3)) }
}

extern "C" void kernel_launch(void* const* d_in, const int* in_sizes, int n_in, void* d_out, int out_size, void* d_ws, size_t ws_size,
                              hipStream_t stream) {
  static int grid_blocks = 0;
  if (!grid_blocks) {
    int dev = 0, cus = 0, per_cu = 0;
    hipGetDevice(&dev);
    hipDeviceGetAttribute(&cus, hipDeviceAttributeMultiprocessorCount, dev);
    hipFuncSetAttribute((const void*)mega_kernel, hipFuncAttributeMaxDynamicSharedMemorySize, SMEM_BYTES);
    hipOccupancyMaxActiveBlocksPerMultiprocessor(&per_cu, (const void*)mega_kernel, 512, SMEM_BYTES);
    if (per_cu < 1) per_cu = 1;
    if (per_cu > 1) per_cu = 1;
    grid_blocks = cus * per_cu;
  }
  Params p{};
  const float** pin = (const float**)&p;
  for (int i = 0; i < 32; ++i) pin[i] = (const float*)d_in[i];
  p.out = (float*)d_out;
  char* ws = (char*)d_ws;
  size_t off = 0;
  p.bar = (unsigned*)(ws + off); off += 16384;
  p.rstat = (float*)(ws + off); off += (size_t)MT * 2 * 4;
  p.kb_lat = (bf16_t*)(ws + off); off += (size_t)2 * 8 * 2 * 1280 * 64 * 2;
  p.vt_lat = (bf16_t*)(ws + off); off += (size_t)2 * 8 * 2 * 1280 * 64 * 2;
  p.kb_ctx = (bf16_t*)(ws + off); off += (size_t)32 * 2 * 256 * 64 * 2;
  p.vt_ctx = (bf16_t*)(ws + off); off += (size_t)32 * 2 * 256 * 64 * 2;
  p.wt_in = (bf16_t*)(ws + off); off += (size_t)2 * 1792 * 1024 * 2;
  p.wt_out = (bf16_t*)(ws + off); off += (size_t)2 * 1024 * 1024 * 2;
  p.wt_ff1 = (bf16_t*)(ws + off); off += (size_t)2 * 4096 * 1024 * 2;
  p.wt_ff2 = (bf16_t*)(ws + off); off += (size_t)2 * 4096 * 1024 * 2;
  p.wt_lru = (bf16_t*)(ws + off); off += (size_t)64 * 4096 * 2;
  p.mod = (float*)(ws + off); off += (size_t)2 * 9 * 6144 * 4;
  p.rope = (float*)(ws + off); off += (size_t)2048 * 4;
  p.cdec = (float*)(ws + off); off += (size_t)1024 * 4;
  p.abuf = (bf16_t*)(ws + off); off += (size_t)MT * 1024 * 2;
  p.zf = (bf16_t*)(ws + off);
  p.au = (float*)(ws + off + (size_t)MT * 1792 * 2);
  off += (size_t)MT * 4096 * 2;
  if (off > ws_size) { fprintf(stderr, "workspace too small: need %zu have %zu\n", off, ws_size); return; }
  (void)hipMemsetAsync(p.bar, 0, 16384, stream);
#if MULTI_LAUNCH
  for (int ph = 0; ph < NPHASE; ++ph) {
    hipLaunchKernelGGL(mega_kernel, dim3(grid_blocks), dim3(512), SMEM_BYTES, stream, p, ph, ph + 1);
  }
#else
  int lo = 0, hi = NPHASE;
  void* args[] = {&p, &lo, &hi};
  hipError_t e = hipLaunchCooperativeKernel((void*)mega_kernel, dim3(grid_blocks), dim3(512), args, SMEM_BYTES, stream);
  if (e != hipSuccess) fprintf(stderr, "cooperative launch failed: %s (grid %d)\n", hipGetErrorString(e), grid_blocks);
#endif
}
```

```cpp
#include <hip/hip_runtime.h>
#include <hip/hip_cooperative_groups.h>
#include <cstdio>
#include <cstdint>
namespace cg = cooperative_groups;

#ifndef MULTI_LAUNCH
#define MULTI_LAUNCH 0
#endif

typedef unsigned short bf16_t;
using bf16x8 = __attribute__((ext_vector_type(8))) short;
using f32x4 = __attribute__((ext_vector_type(4))) float;
#define DEV __device__ __forceinline__
#define VTID ((int)(threadIdx.x & 255))
#define VBID ((int)(blockIdx.x * 2 + (threadIdx.x >> 8)))
#define VNB ((int)(gridDim.x * 2))

constexpr int MT = 16384;
constexpr int NPHASE = 18;
constexpr size_t OFF_YK = 16777216, OFF_YV = OFF_YK + 2097152, OFF_ST = OFF_YV + 2097152;
constexpr float ALPHA = 1.41421356237f;
constexpr float QSCALE = 0.125f * 1.4426950408889634f;
constexpr int SMEM_BYTES = 131072;

struct Params {
  const float *x_prompt, *x_sample, *c, *cache_k, *cache_v, *state_lru, *c_ctx, *w_ada, *b_ada, *w_in,
      *q_g, *k_g, *conv_w, *conv_b, *lru_wa, *lru_ba, *lru_wx, *lru_bx, *lru_lam, *mlp_g, *mlp_b, *mlp_ws, *mlp_bs,
      *w_out, *ln1_g, *ln1_b, *w_ff1, *b_ff1, *w_ff2, *b_ff2, *ln2_g, *ln2_b;
  float* out;
  bf16_t *wt_in, *wt_out, *wt_ff1, *wt_ff2, *wt_lru;
  float *mod, *rope, *cdec;
  bf16_t *abuf;
  bf16_t *zf;
  float *au;
  bf16_t *kb_lat, *vt_lat;
  bf16_t *kb_ctx, *vt_ctx;
  unsigned *bar;
  float *rstat;
};

union U8 { uint4 u; bf16x8 v; bf16_t h[8]; unsigned w[4]; };

DEV float bf2f(bf16_t h) { return __uint_as_float(((unsigned)h) << 16); }
DEV bf16_t f2bf(float f) { unsigned u = __float_as_uint(f); u += 0x7fffu + ((u >> 16) & 1u); return (bf16_t)(u >> 16); }
DEV unsigned pack2(float a, float b) { unsigned r; asm volatile("v_cvt_pk_bf16_f32 %0, %1, %2" : "=v"(r) : "v"(a), "v"(b)); return r; }
DEV float gelu_t(float x) { float y = 0.7978845608028654f * (x + 0.044715f * x * x * x); float t = 1.f - 2.f * __builtin_amdgcn_rcpf(1.f + __expf(2.f * y)); return 0.5f * x * (1.f + t); }
DEV float sigmoidf_(float x) { return __builtin_amdgcn_rcpf(1.f + __expf(-x)); }
DEV int own_row(int x, int r) { return r < 1024 ? (x << 10) + r : 8192 + (x << 10) + (r - 1024); }
DEV int own_panel(int vp) { const int x = vp >> 3, lp = vp & 7; return lp < 4 ? 4 * x + lp : 32 + 4 * x + (lp - 4); }
DEV int xrow(int vm) { const int k = vm >> 11, c = (vm & 2047) >> 3, w = vm & 7; return own_row(c & 7, (k << 8) + ((c >> 3) << 3) + w); }
DEV int cond_of(int m) { return m < 8192 ? 0 : 1 + ((m - 8192) >> 10); }
DEV f32x4 mfma16(bf16x8 a, bf16x8 b, f32x4 c) { return __builtin_amdgcn_mfma_f32_16x16x32_bf16(a, b, c, 0, 0, 0); }
DEV float wave_sum(float v) {
#pragma unroll
  for (int o = 32; o >= 1; o >>= 1) v += __shfl_xor(v, o);
  return v;
}

DEV void transpose_tile(const float* __restrict__ src, bf16_t* __restrict__ dst, int lds_, int ldd, char* smem) {
  float* T = (float*)smem;
  const int tid = VTID;
#pragma unroll
  for (int i = 0; i < 4; ++i) {
    int k = (tid >> 4) + 16 * i, n4 = (tid & 15) * 4;
    float4 v = *(const float4*)(src + (size_t)k * lds_ + n4);
    T[k * 65 + n4 + 0] = v.x; T[k * 65 + n4 + 1] = v.y; T[k * 65 + n4 + 2] = v.z; T[k * 65 + n4 + 3] = v.w;
  }
  __syncthreads();
#pragma unroll
  for (int i = 0; i < 2; ++i) {
    int n = (tid >> 3) + 32 * i, k8 = (tid & 7) * 8;
    U8 o;
#pragma unroll
    for (int j = 0; j < 4; ++j) o.w[j] = pack2(T[(k8 + 2 * j) * 65 + n], T[(k8 + 2 * j + 1) * 65 + n]);
    *(uint4*)(dst + (size_t)n * ldd + k8) = o.u;
  }
  __syncthreads();
}
DEV void transpose_w(const float* __restrict__ W, bf16_t* __restrict__ Wt, int K, int N, int tk, int tn, char* smem) {
  transpose_tile(W + (size_t)(tk * 64) * N + tn * 64, Wt + (size_t)(tn * 64) * K + tk * 64, N, K, smem);
}

DEV void tr_desc(const Params& p, int t, const float*& src, int& lds_, bf16_t*& dst, int& ldd) {
  if (t < 2 * 2768) {
    const int l = t / 2768, r = t % 2768;
    const float* W; bf16_t* Wt; int K, N, tk, tn;
    if (r < 448) { W = p.w_in + (size_t)l * 1024 * 1792; Wt = p.wt_in + (size_t)l * 1792 * 1024; K = 1024; N = 1792; tk = r / 28; tn = r % 28; }
    else if (r < 704) { const int i = r - 448; W = p.w_out + (size_t)l * 1024 * 1024; Wt = p.wt_out + (size_t)l * 1024 * 1024; K = 1024; N = 1024; tk = i / 16; tn = i % 16; }
    else if (r < 1728) { const int i = r - 704; W = p.w_ff1 + (size_t)l * 1024 * 4096; Wt = p.wt_ff1 + (size_t)l * 4096 * 1024; K = 1024; N = 4096; tk = i / 64; tn = i % 64; }
    else if (r < 2752) { const int i = r - 1728; W = p.w_ff2 + (size_t)l * 4096 * 1024; Wt = p.wt_ff2 + (size_t)l * 1024 * 4096; K = 4096; N = 1024; tk = i / 16; tn = i % 16; }
    else {
      const int idx = r - 2752, dir = idx >> 3, blk = (idx >> 1) & 3, mat = idx & 1;
      src = (mat == 0 ? p.lru_wa : p.lru_wx) + (size_t)(((l * 2 + dir) * 4 + blk)) * 4096; lds_ = 64;
      dst = p.wt_lru + (size_t)((((l * 2 + dir) * 4 + blk) * 2 + mat)) * 4096; ldd = 64; return;
    }
    src = W + (size_t)(tk * 64) * N + tn * 64; lds_ = N; dst = Wt + (size_t)(tn * 64) * K + tk * 64; ldd = K;
  } else {
    const int j = t - 2 * 2768, tt = j & 3, kvh = (j >> 2) & 1, l = (j >> 3) & 1, b = j >> 4;
    src = p.cache_v + ((size_t)(b * 2 + l) * 256 + tt * 64) * 128 + kvh * 64; lds_ = 128;
    dst = p.vt_lat + ((size_t)((l * 8 + b) * 2 + kvh) * 64) * 1280 + tt * 64; ldd = 1280;
  }
}

DEV int tr_map(int list, int idx) {
  if (list == 0) return idx < 448 ? idx : (idx < 464 ? 2752 + (idx - 448) : (idx < 480 ? 5520 + (idx - 464) : 5536 + (idx - 480)));
  return idx < 2304 ? 448 + idx : 2768 + (idx - 2304);
}
DEV void transpose_all(const Params& p, char* smem, int list, int hb, int nhb) {
  const int NTR = list == 0 ? 608 : 5056;
  float* T = (float*)smem;
  const int tid = VTID, kr = tid >> 4, n4 = (tid & 15) * 4;
  int t = hb;
  if (t >= NTR) return;
  const float* src; bf16_t* dst; int lds_, ldd;
  tr_desc(p, tr_map(list, t), src, lds_, dst, ldd);
  float4 cur[4];
#pragma unroll
  for (int i = 0; i < 4; ++i) cur[i] = *(const float4*)(src + (size_t)(kr + 16 * i) * lds_ + n4);
  while (t < NTR) {
    const int tn = t + nhb;
    const float* nsrc = src; bf16_t* ndst = dst; int nlds = lds_, nldd = ldd;
    float4 nxt[4];
    if (tn < NTR) {
      tr_desc(p, tr_map(list, tn), nsrc, nlds, ndst, nldd);
#pragma unroll
      for (int i = 0; i < 4; ++i) nxt[i] = *(const float4*)(nsrc + (size_t)(kr + 16 * i) * nlds + n4);
    }
#pragma unroll
    for (int i = 0; i < 4; ++i) {
      const int k = kr + 16 * i;
      T[k * 65 + n4 + 0] = cur[i].x; T[k * 65 + n4 + 1] = cur[i].y; T[k * 65 + n4 + 2] = cur[i].z; T[k * 65 + n4 + 3] = cur[i].w;
    }
    __syncthreads();
#pragma unroll
    for (int i = 0; i < 2; ++i) {
      const int n = (tid >> 3) + 32 * i, k8 = (tid & 7) * 8;
      U8 o;
#pragma unroll
      for (int j = 0; j < 4; ++j) o.w[j] = pack2(T[(k8 + 2 * j) * 65 + n], T[(k8 + 2 * j + 1) * 65 + n]);
      *(uint4*)(dst + (size_t)n * ldd + k8) = o.u;
    }
    __syncthreads();
    if (tn < NTR) {
#pragma unroll
      for (int i = 0; i < 4; ++i) cur[i] = nxt[i];
    }
    src = nsrc; dst = ndst; lds_ = nlds; ldd = nldd; t = tn;
  }
}

DEV void phase0(const Params& p, char* smem) {
  const int tid = VTID;
  const int NT0 = 192 - 128, NITEMS = 192 + 64 + 2;
  for (int it = VBID; it < NITEMS; it += VNB) {
    if (it < 192) {
      const int l = it / 96, n0 = (it % 96) * 64;
      float* s = (float*)smem;
      float* red = s + 9 * 1024;
      for (int idx = tid; idx < 9 * 1024; idx += 256) {
        int c = idx >> 10, k = idx & 1023;
        float v = (c == 0) ? p.c_ctx[k] : p.c[(c - 1) * 1024 + k];
        s[idx] = v / (1.f + __expf(-v));
      }
      __syncthreads();
      const int w = tid >> 6, lane = tid & 63, cq = lane & 15, ks = lane >> 4;
      const int kbase = (w * 4 + ks) * 64;
      float acc[9][4];
#pragma unroll
      for (int c = 0; c < 9; ++c) { acc[c][0] = 0.f; acc[c][1] = 0.f; acc[c][2] = 0.f; acc[c][3] = 0.f; }
      const float* wp = p.w_ada + ((size_t)l * 1024 + kbase) * 6144 + n0 + cq * 4;
      for (int kb = 0; kb < 64; kb += 16) {
        float4 wv[16];
#pragma unroll
        for (int j = 0; j < 16; ++j) wv[j] = *(const float4*)(wp + (size_t)(kb + j) * 6144);
#pragma unroll
        for (int j = 0; j < 16; ++j)
#pragma unroll
          for (int c = 0; c < 9; ++c) {
            const float sv = s[c * 1024 + kbase + kb + j];
            acc[c][0] += sv * wv[j].x; acc[c][1] += sv * wv[j].y; acc[c][2] += sv * wv[j].z; acc[c][3] += sv * wv[j].w;
          }
      }
#pragma unroll
      for (int c = 0; c < 9; ++c)
#pragma unroll
        for (int e = 0; e < 4; ++e) {
          float a = acc[c][e];
          a += __shfl_xor(a, 16); a += __shfl_xor(a, 32);
          if (ks == 0) red[(w * 9 + c) * 64 + cq * 4 + e] = a;
        }
      __syncthreads();
      for (int idx = tid; idx < 576; idx += 256) {
        int c = idx >> 6, nn = idx & 63;
        float v = red[(0 * 9 + c) * 64 + nn] + red[(1 * 9 + c) * 64 + nn] + red[(2 * 9 + c) * 64 + nn] + red[(3 * 9 + c) * 64 + nn] +
                  p.b_ada[l * 6144 + n0 + nn];
        p.mod[((size_t)l * 9 + c) * 6144 + n0 + nn] = v;
      }
      __syncthreads();
    } else if (it >= NT0 + 128 && it < NT0 + 192) {
      const int j = it - NT0 - 128;
#pragma unroll
      for (int i = 0; i < 4; ++i) {
        const int e = (j * 1024 + i * 256 + tid) * 8;
        const int d = e & 63, kvh = (e >> 6) & 1, t = (e >> 7) & 255, l = (e >> 15) & 1, b = e >> 16;
        const float4 a0 = *(const float4*)(p.cache_k + e), a1 = *(const float4*)(p.cache_k + e + 4);
        U8 o; o.w[0] = pack2(a0.x, a0.y); o.w[1] = pack2(a0.z, a0.w); o.w[2] = pack2(a1.x, a1.y); o.w[3] = pack2(a1.z, a1.w);
        *(uint4*)(p.kb_lat + ((size_t)((l * 8 + b) * 2 + kvh) * 1280 + t) * 64 + d) = o.u;
      }
    } else if (it >= NT0 + 192) {
      if (it == NT0 + 192)
      for (int idx = tid; idx < 1024; idx += 256) {
        int pp = idx >> 4, f = idx & 15;
        float inv = powf(10000.f, -(float)f / 16.f);
        float ang = (float)pp * inv;
        float nrev = rintf(ang * 0.15915494309189535f);
        float r = fmaf(-nrev, 6.28125f, ang);
        r = fmaf(-nrev, 0.0019353071795864769f, r);
        p.rope[idx * 2 + 0] = __cosf(r);
        p.rope[idx * 2 + 1] = __sinf(r);
      }
      if (it == NT0 + 192)
      for (int idx = tid; idx < 1024; idx += 256) {
        const float xn = -p.lru_lam[idx];
        p.cdec[idx] = -8.f * (fmaxf(xn, 0.f) + log1pf(expf(-fabsf(xn))));
      }
    }
  }
  transpose_all(p, smem, 0, VBID, VNB);
}

DEV void ln_mod_phase(const Params& p, int l, int mode, int team_base = -1) {
  int tz = 0; asm volatile("" : "+v"(tz));
  const int lane = (threadIdx.x + tz) & 63, w = threadIdx.x >> 6;
  const float* lg = nullptr; const float* lb = nullptr;
  if (mode == 1) { lg = p.ln2_g + (l - 1) * 1024; lb = p.ln2_b + (l - 1) * 1024; }
  else if (mode == 2) { lg = p.ln1_g + l * 1024; lb = p.ln1_b + l * 1024; }
  else if (mode == 3) { lg = p.ln2_g + l * 1024; lb = p.ln2_b + l * 1024; }
  const int shoff = (mode == 2) ? 3072 : 0;
  const int mstride = gridDim.x * 8;
  float4 nv[4];
#define LNM_ROW(vm_) (team_base >= 0 ? team_base + w + 8 * ((vm_) >> 11) : xrow(vm_))
  {
    const int m = LNM_ROW(blockIdx.x * 8 + w);
    const float* src = (mode == 0) ? ((m < 8192) ? p.x_prompt + (size_t)m * 1024 : p.x_sample + (size_t)(m - 8192) * 1024) : p.out + (size_t)m * 1024;
#pragma unroll
    for (int i = 0; i < 4; ++i) nv[i] = *(const float4*)(src + i * 256 + lane * 4);
  }
  for (int vm = blockIdx.x * 8 + w; vm < MT; vm += mstride) {
    const int m = LNM_ROW(vm);
    float4 v[4];
#pragma unroll
    for (int i = 0; i < 4; ++i) v[i] = nv[i];
    {
      const int mn = LNM_ROW((vm + mstride < MT) ? vm + mstride : vm);
      const float* src = (mode == 0) ? ((mn < 8192) ? p.x_prompt + (size_t)mn * 1024 : p.x_sample + (size_t)(mn - 8192) * 1024) : p.out + (size_t)mn * 1024;
#pragma unroll
      for (int i = 0; i < 4; ++i) nv[i] = *(const float4*)(src + i * 256 + lane * 4);
    }
    if (mode != 0) {
      float s = 0.f;
#pragma unroll
      for (int i = 0; i < 4; ++i) s += v[i].x + v[i].y + v[i].z + v[i].w;
      const float mean = wave_sum(s) * (1.f / 1024.f);
      float s2 = 0.f;
#pragma unroll
      for (int i = 0; i < 4; ++i) { float a = v[i].x - mean, b = v[i].y - mean, c = v[i].z - mean, d = v[i].w - mean; s2 += a * a + b * b + c * c + d * d; }
      const float rstd = rsqrtf(wave_sum(s2) * (1.f / 1024.f) + 1e-6f);
#pragma unroll
      for (int i = 0; i < 4; ++i) {
        float4 g = *(const float4*)(lg + i * 256 + lane * 4), b = *(const float4*)(lb + i * 256 + lane * 4);
        v[i].x = (v[i].x - mean) * rstd * g.x + b.x; v[i].y = (v[i].y - mean) * rstd * g.y + b.y;
        v[i].z = (v[i].z - mean) * rstd * g.z + b.z; v[i].w = (v[i].w - mean) * rstd * g.w + b.w;
        if (mode == 3) *(float4*)(p.out + (size_t)m * 1024 + i * 256 + lane * 4) = v[i];
      }
      if (mode != 3 && lane == 0) *(float2*)(p.rstat + (size_t)m * 2) = make_float2(mean, rstd);
    }
    if (mode != 3) {
      const float* md = p.mod + ((size_t)l * 9 + cond_of(m)) * 6144 + shoff;
#pragma unroll
      for (int i = 0; i < 4; ++i) {
        float4 sh = *(const float4*)(md + i * 256 + lane * 4), sc = *(const float4*)(md + 1024 + i * 256 + lane * 4);
        uint2 o;
        o.x = pack2(v[i].x * (1.f + sc.x) + sh.x, v[i].y * (1.f + sc.y) + sh.y);
        o.y = pack2(v[i].z * (1.f + sc.z) + sh.z, v[i].w * (1.f + sc.w) + sh.w);
        *(uint2*)(p.abuf + (size_t)m * 1024 + i * 256 + lane * 4) = o;
      }
    }
  }
}

#define LAS3 __attribute__((address_space(3)))
namespace g8 {
constexpr int BM = 256, BK = 64, HALF = 128, HTB = HALF * BK * 2, NXCD = 8, WGM = 4;
DEV int lds_byte(int r, int c) { const int st = (r >> 4) * 2 + (c >> 5), rr = r & 15, cc = c & 31, ob = rr * 64 + cc * 2; return st * 1024 + (ob ^ (((ob >> 9) & 1) << 5)); }
DEV void stage_rc(int b, int& R, int& C) { const int st = b / 1024, sb = b % 1024, swz = sb ^ (((sb >> 9) & 1) << 5); R = (st >> 1) * 16 + swz / 64; C = (st & 1) * 32 + (swz % 64) / 2; }
DEV bool unit_of(int i, int nM, int nN, int& pm, int& pn) {
  const int nwg = nM * nN;
  const long L = (long)i * gridDim.x + blockIdx.x; if (L >= nwg) return false;
  int wgid = (int)L; { const int q = nwg / NXCD, r = nwg % NXCD, xcd = wgid % NXCD, off = wgid / NXCD; wgid = (xcd < r ? xcd * (q + 1) : r * (q + 1) + (xcd - r) * q) + off; }
  const int nig = WGM * nN, gid = wgid / nig, fm = gid * WGM, gsz = (nM - fm) < WGM ? (nM - fm) : WGM;
  pm = own_panel(fm + ((wgid % nig) % gsz)); pn = (wgid % nig) / gsz; return true;
}
}

template <int EPI>
DEV void gemm_epilogue(const Params& p, int l, f32x4 (&acc)[2][2][4][2], int pm, int pn, int wr, int wc, int fr, int fq) {
  const int brow = pm * 256, bcol = pn * 256;
  const float* md = p.mod + ((size_t)l * 9 + cond_of(brow)) * 6144;
#pragma unroll
  for (int bj = 0; bj < 2; ++bj)
#pragma unroll
    for (int n = 0; n < 2; ++n) {
      const int col = bcol + bj * 128 + wc * 32 + n * 16 + fq * 4;
      float4 gate = make_float4(0.f, 0.f, 0.f, 0.f), bias = make_float4(0.f, 0.f, 0.f, 0.f);
      if (EPI == 2) gate = *(const float4*)(md + 2048 + col);
      if (EPI == 3) bias = *(const float4*)(p.b_ff1 + l * 4096 + col);
      if (EPI == 4) { gate = *(const float4*)(md + 5120 + col); bias = *(const float4*)(p.b_ff2 + l * 1024 + col); }
#pragma unroll
      for (int ai = 0; ai < 2; ++ai)
#pragma unroll
        for (int m = 0; m < 4; ++m) {
          const int row = brow + ai * 128 + wr * 64 + m * 16 + fr;
          const f32x4 v = acc[ai][bj][m][n];
          if (EPI == 1) {
            uint2 o; o.x = pack2(v[0], v[1]); o.y = pack2(v[2], v[3]);
            *(uint2*)(p.zf + (size_t)row * 1792 + col) = o;
          } else if (EPI == 2) {
            const float* xs = (l == 0) ? ((row < 8192) ? p.x_prompt + (size_t)row * 1024 : p.x_sample + (size_t)(row - 8192) * 1024) : p.out + (size_t)row * 1024;
            const float4 x = *(const float4*)(xs + col);
            *(float4*)(p.out + (size_t)row * 1024 + col) = make_float4(ALPHA * x.x + gate.x * v[0], ALPHA * x.y + gate.y * v[1], ALPHA * x.z + gate.z * v[2], ALPHA * x.w + gate.w * v[3]);
          } else if (EPI == 3) {
            const float t0 = fmaxf(v[0] + bias.x, 0.f), t1 = fmaxf(v[1] + bias.y, 0.f), t2 = fmaxf(v[2] + bias.z, 0.f), t3 = fmaxf(v[3] + bias.w, 0.f);
            uint2 o; o.x = pack2(t0 * t0, t1 * t1); o.y = pack2(t2 * t2, t3 * t3);
            *(uint2*)(p.zf + (size_t)row * 4096 + col) = o;
          } else {
            float* xo = p.out + (size_t)row * 1024 + col;
            const float4 x = *(const float4*)xo;
            *(float4*)xo = make_float4(ALPHA * x.x + gate.x * (v[0] + bias.x), ALPHA * x.y + gate.y * (v[1] + bias.y), ALPHA * x.z + gate.z * (v[2] + bias.z), ALPHA * x.w + gate.w * (v[3] + bias.w));
          }
        }
    }
}

template <int EPI>
DEV void gemm_epilogue_lnres(const Params& p, int l, f32x4 (&acc)[2][2][4][2], int pm, int pn, int wr, int wc, int fr, int fq) {
  const int brow = pm * 256, bcol = pn * 256;
  const float* md = p.mod + ((size_t)l * 9 + cond_of(brow)) * 6144;
  float mean[2][4], rstd[2][4];
  {
    const unsigned so = (unsigned)(brow + wr * 64 + fr) * 2u;
#pragma unroll
    for (int ai = 0; ai < 2; ++ai)
#pragma unroll
      for (int m = 0; m < 4; ++m) { const float2 t = *(const float2*)(p.rstat + (so + (unsigned)((ai * 128 + m * 16) * 2))); mean[ai][m] = t.x; rstd[ai][m] = t.y; }
  }
  const float* lg = (EPI == 2) ? p.ln2_g + (l - 1) * 1024 : p.ln1_g + l * 1024;
  const float* lb = (EPI == 2) ? p.ln2_b + (l - 1) * 1024 : p.ln1_b + l * 1024;
  const unsigned co = (unsigned)(bcol + wc * 32 + fq * 4);
  const unsigned ro = (unsigned)(brow + wr * 64 + fr) * 1024u + co;
#pragma unroll
  for (int bj = 0; bj < 2; ++bj)
#pragma unroll
    for (int n = 0; n < 2; ++n) {
      unsigned col = co + (unsigned)(bj * 128 + n * 16), rb = ro + (unsigned)(bj * 128 + n * 16);
      asm volatile("" : "+v"(col), "+v"(rb));
      float4 gate, bias = make_float4(0.f, 0.f, 0.f, 0.f);
      if (EPI == 2) gate = *(const float4*)(md + 2048 + col);
      else { gate = *(const float4*)(md + 5120 + col); bias = *(const float4*)(p.b_ff2 + l * 1024 + col); }
      const float4 g4 = *(const float4*)(lg + col), b4 = *(const float4*)(lb + col);
#pragma unroll
      for (int ai = 0; ai < 2; ++ai)
#pragma unroll
        for (int m = 0; m < 4; ++m) {
          float* xo = p.out + (rb + (unsigned)((ai * 128 + m * 16) * 1024));
          const float4 x = *(const float4*)xo;
          const float mu = mean[ai][m], rr = rstd[ai][m];
          const f32x4 v = acc[ai][bj][m][n];
          const float x0 = (x.x - mu) * rr * g4.x + b4.x, x1 = (x.y - mu) * rr * g4.y + b4.y, x2 = (x.z - mu) * rr * g4.z + b4.z, x3 = (x.w - mu) * rr * g4.w + b4.w;
          *(float4*)xo = make_float4(ALPHA * x0 + gate.x * (v[0] + bias.x), ALPHA * x1 + gate.y * (v[1] + bias.y), ALPHA * x2 + gate.z * (v[2] + bias.z), ALPHA * x3 + gate.w * (v[3] + bias.w));
        }
    }
}

template <int EPI>
DEV void gemm_phase(const Params& p, int l, const bf16_t* Ag, const bf16_t* Btg, int N, int K, LAS3 unsigned char* lds, int tpm = -1, int tq = 0) {
#define UNIT_OF(i_, pm_, pn_) (tpm >= 0 ? ((pm_) = tpm, (pn_) = tq + 4 * (i_), (pn_) < nN) : unit_of(i_, nM, nN, pm_, pn_))
  using namespace g8;
  int tz = 0; asm volatile("" : "+v"(tz));
  const int tid = threadIdx.x + tz, wid = __builtin_amdgcn_readfirstlane(tid >> 6), lane = tid & 63, wr = wid >> 2, wc = wid & 3, fr = lane & 15, fq = lane >> 4;
  const int nt = K / BK, nM = MT / BM, nN = N / BM;
  unsigned voff[2];
#pragma unroll
  for (int i = 0; i < 2; ++i) { int R, C; stage_rc(tid * 16 + i * 8192, R, C); voff[i] = (unsigned)(R * K + C) * 2u; }
  const size_t kstep = (size_t)(BK * 2);
  const size_t hstep = (size_t)HALF * K * 2;
  const size_t tstep = 2 * hstep;
  const unsigned ldsw = (unsigned)wid * 1024u;
  const int aoff = lds_byte(wr * 64 + fr, fq * 8), boff = lds_byte(wc * 32 + fr, fq * 8);
#define PG8_SA(b, h) (((b) * 2 + (h)) * HTB)
#define PG8_SB(b, h) ((4 + (b) * 2 + (h)) * HTB)
#define PG8_STAGE(bufoff, gbase) do { _Pragma("unroll") for (int _i = 0; _i < 2; ++_i) \
    __builtin_amdgcn_global_load_lds((const unsigned*)((const char*)(gbase) + voff[_i]), (LAS3 unsigned*)(lds + (bufoff) + ldsw + _i * 8192), 16, 0, 0); } while (0)
#define PG8_LDA(dst, b, h) do { _Pragma("unroll") for (int m = 0; m < 4; ++m) _Pragma("unroll") for (int k = 0; k < 2; ++k) dst[m][k] = *(const LAS3 bf16x8*)(lds + PG8_SA(b, h) + aoff + m * 2048 + k * 1024); } while (0)
#define PG8_LDB(dst, b, h) do { _Pragma("unroll") for (int n = 0; n < 2; ++n) _Pragma("unroll") for (int k = 0; k < 2; ++k) dst[n][k] = *(const LAS3 bf16x8*)(lds + PG8_SB(b, h) + boff + n * 2048 + k * 1024); } while (0)
#define PG8_MMA(ai, bj, At_, Bt_) do { __builtin_amdgcn_s_setprio(1); _Pragma("unroll") for (int m = 0; m < 4; ++m) _Pragma("unroll") for (int n = 0; n < 2; ++n) _Pragma("unroll") for (int k = 0; k < 2; ++k) \
    acc[ai][bj][m][n] = __builtin_amdgcn_mfma_f32_16x16x32_bf16(Bt_[n][k], At_[m][k], acc[ai][bj][m][n], 0, 0, 0); __builtin_amdgcn_s_setprio(0); } while (0)
#define PG8_WAIT_V(n) asm volatile("s_waitcnt vmcnt(" #n ")" ::: "memory")
#define PG8_WAIT_L(n) asm volatile("s_waitcnt lgkmcnt(" #n ")" ::: "memory")
#define PG8_BAR __builtin_amdgcn_s_barrier()
#define PG8_SCHED __builtin_amdgcn_sched_barrier(0)
  int cpm, cpn, npm = 0, npn = 0, ui = 0;
  if (!UNIT_OF(0, cpm, cpn)) return;
  f32x4 acc[2][2][4][2];
#pragma unroll
  for (int a = 0; a < 2; ++a)
#pragma unroll
    for (int b = 0; b < 2; ++b)
#pragma unroll
      for (int m = 0; m < 4; ++m)
#pragma unroll
        for (int n = 0; n < 2; ++n) acc[a][b][m][n] = (f32x4){0.f, 0.f, 0.f, 0.f};
  bf16x8 At[4][2], B0[2][2], B1[2][2];
  const char* cA = (const char*)Ag + (size_t)cpm * tstep; const char* cB = (const char*)Btg + (size_t)cpn * tstep;
  PG8_STAGE(PG8_SB(0, 0), cB); PG8_STAGE(PG8_SA(0, 0), cA); PG8_STAGE(PG8_SB(0, 1), cB + hstep); PG8_STAGE(PG8_SA(0, 1), cA + hstep);
  if (wr == 1) PG8_BAR;
  PG8_WAIT_V(4); PG8_BAR;
  PG8_STAGE(PG8_SB(1, 0), cB + kstep); PG8_STAGE(PG8_SA(1, 0), cA + kstep); PG8_STAGE(PG8_SB(1, 1), cB + hstep + kstep);
  PG8_WAIT_V(6); PG8_BAR;
  for (;;) {
    const bool has_next = UNIT_OF(ui + 1, npm, npn);
    const char* nA = has_next ? (const char*)Ag + (size_t)npm * tstep : cA; const char* nB = has_next ? (const char*)Btg + (size_t)npn * tstep : cB;
    for (int t = 0; t < nt; t += 2) {
      const bool last = (t == nt - 2);
      const char* a1 = cA + (size_t)(t + 1) * kstep;
      const char* a2 = last ? nA : cA + (size_t)(t + 2) * kstep; const char* b2 = last ? nB : cB + (size_t)(t + 2) * kstep;
      const char* a3 = a2 + kstep; const char* b3 = b2 + kstep;
      PG8_LDB(B0, 0, 0); PG8_SCHED; PG8_LDA(At, 0, 0); PG8_STAGE(PG8_SA(1, 1), a1 + hstep);
      PG8_WAIT_L(8); PG8_BAR; PG8_WAIT_L(0); PG8_MMA(0, 0, At, B0); PG8_BAR; PG8_SCHED;
      PG8_LDB(B1, 0, 1); PG8_STAGE(PG8_SB(0, 0), b2);
      PG8_BAR; PG8_WAIT_L(0); PG8_MMA(0, 1, At, B1); PG8_BAR;
      PG8_LDA(At, 0, 1); PG8_STAGE(PG8_SA(0, 0), a2);
      PG8_BAR; PG8_WAIT_L(0); PG8_MMA(1, 0, At, B0); PG8_BAR; PG8_SCHED;
      PG8_STAGE(PG8_SB(0, 1), b2 + hstep);
      PG8_WAIT_V(6); PG8_BAR; PG8_MMA(1, 1, At, B1); PG8_BAR;
      PG8_LDB(B0, 1, 0); PG8_SCHED; PG8_LDA(At, 1, 0); PG8_STAGE(PG8_SA(0, 1), a2 + hstep);
      PG8_WAIT_L(8); PG8_BAR; PG8_WAIT_L(0); PG8_MMA(0, 0, At, B0); PG8_BAR; PG8_SCHED;
      PG8_LDB(B1, 1, 1); PG8_STAGE(PG8_SB(1, 0), b3);
      PG8_BAR; PG8_WAIT_L(0); PG8_MMA(0, 1, At, B1); PG8_BAR;
      PG8_LDA(At, 1, 1); PG8_STAGE(PG8_SA(1, 0), a3);
      PG8_BAR; PG8_WAIT_L(0); PG8_MMA(1, 0, At, B0); PG8_BAR; PG8_SCHED;
      PG8_STAGE(PG8_SB(1, 1), b3 + hstep);
      PG8_WAIT_V(6); PG8_BAR; PG8_MMA(1, 1, At, B1); PG8_BAR;
    }
    if (EPI == 4 || (EPI == 2 && l > 0)) gemm_epilogue_lnres<EPI>(p, l, acc, cpm, cpn, wr, wc, fr, fq);
    else gemm_epilogue<EPI>(p, l, acc, cpm, cpn, wr, wc, fr, fq);
    if (!has_next) break;
#pragma unroll
    for (int a = 0; a < 2; ++a)
#pragma unroll
      for (int b = 0; b < 2; ++b)
#pragma unroll
        for (int m = 0; m < 4; ++m)
#pragma unroll
          for (int n = 0; n < 2; ++n) acc[a][b][m][n] = (f32x4){0.f, 0.f, 0.f, 0.f};
    cpm = npm; cpn = npn; cA = nA; cB = nB; ++ui;
  }
  PG8_WAIT_V(0);
  if (wr == 0) PG8_BAR;
  PG8_BAR;
#undef PG8_SA
#undef UNIT_OF
#undef PG8_SB
#undef PG8_STAGE
#undef PG8_LDA
#undef PG8_LDB
#undef PG8_MMA
#undef PG8_WAIT_V
#undef PG8_WAIT_L
#undef PG8_BAR
#undef PG8_SCHED
}

DEV void rope8(float (&v)[8], int d0, int prow, int pcol, const float* __restrict__ rope) {
  const int pp = (d0 < 32) ? prow : pcol;
#pragma unroll
  for (int i = 0; i < 4; ++i) {
    const int f = ((d0 >> 1) + i) & 15;
    const float cs = rope[(pp * 16 + f) * 2], sn = rope[(pp * 16 + f) * 2 + 1];
    const float x1 = v[2 * i], x2 = v[2 * i + 1];
    v[2 * i] = x1 * cs - x2 * sn; v[2 * i + 1] = x1 * sn + x2 * cs;
  }
}

DEV void prep_token_row(const Params& p, int l, int m, int lane, uint4 c) {
  bf16_t* zr = p.zf + (size_t)m * 1792;
  const bool lat = m >= 8192;
  const int pos = lat ? ((m - 8192) & 1023) : (m & 255);
  const int prow = pos >> 6, pcol = pos & 63;
  const int d0 = (lane & 7) * 8;
  U8 u; u.u = c;
  float v[8], gl[8]; float ss = 0.f, sg = 0.f;
#pragma unroll
  for (int j = 0; j < 8; ++j) { v[j] = bf2f(u.h[j]); ss += v[j] * v[j]; gl[j] = gelu_t(v[j]); sg += gl[j]; }
  ss += __shfl_xor(ss, 1); ss += __shfl_xor(ss, 2); ss += __shfl_xor(ss, 4);
#pragma unroll
  for (int o = 1; o <= 16; o <<= 1) sg += __shfl_xor(sg, o);
  const float mean = sg * (1.f / 256.f);
  float s2 = 0.f;
#pragma unroll
  for (int j = 0; j < 8; ++j) { const float d = gl[j] - mean; s2 += d * d; }
#pragma unroll
  for (int o = 1; o <= 16; o <<= 1) s2 += __shfl_xor(s2, o);
  if (lane < 16) {
    const float rinv = rsqrtf(ss * (1.f / 64.f) + 1e-6f);
#pragma unroll
    for (int j = 0; j < 8; ++j) v[j] = v[j] * rinv * p.k_g[l * 64 + d0 + j];
    if (!lat) {
      float* o = p.out + OFF_YK + ((((size_t)(m >> 8)) * 2 + l) * 256 + pos) * 128 + lane * 8;
      *(float4*)o = make_float4(v[0], v[1], v[2], v[3]); *(float4*)(o + 4) = make_float4(v[4], v[5], v[6], v[7]);
    } else rope8(v, d0, prow, pcol, p.rope);
#pragma unroll
    for (int j = 0; j < 4; ++j) u.w[j] = pack2(v[2 * j], v[2 * j + 1]);
    const int kvh = lane >> 3;
    bf16_t* kd = lat ? p.kb_lat + ((size_t)((l * 8 + ((m - 8192) >> 10)) * 2 + kvh) * 1280 + 256 + pos) * 64 + d0
                     : p.kb_ctx + ((size_t)((m >> 8) * 2 + kvh) * 256 + pos) * 64 + d0;
    *(uint4*)kd = u.u;
  } else if (lane < 32) {
    if (!lat) {
      float* o = p.out + OFF_YV + ((((size_t)(m >> 8)) * 2 + l) * 256 + pos) * 128 + (lane - 16) * 8;
      *(float4*)o = make_float4(v[0], v[1], v[2], v[3]); *(float4*)(o + 4) = make_float4(v[4], v[5], v[6], v[7]);
    }
    const int kvh = (lane - 16) >> 3;
    bf16_t* vd; int T;
    if (lat) { T = 1280; vd = p.vt_lat + ((size_t)((l * 8 + ((m - 8192) >> 10)) * 2 + kvh) * 64 + d0) * 1280 + 256 + pos; }
    else { T = 256; vd = p.vt_ctx + ((size_t)((m >> 8) * 2 + kvh) * 64 + d0) * 256 + pos; }
#pragma unroll
    for (int j = 0; j < 8; ++j) vd[(size_t)j * T] = u.h[j];
  } else {
    const float rstd = rsqrtf(s2 * (1.f / 256.f) + 1e-6f);
    const int ch = (lane - 32) * 8;
#pragma unroll
    for (int j = 0; j < 8; ++j) gl[j] = (gl[j] - mean) * rstd * p.mlp_g[l * 256 + ch + j] + p.mlp_b[l * 256 + ch + j];
#pragma unroll
    for (int j = 0; j < 4; ++j) u.w[j] = pack2(gl[2 * j], gl[2 * j + 1]);
    *(uint4*)(zr + 1536 + ch) = u.u;
  }
}

template <bool REV>
DEV void tile_scan(float (&a)[4][4], float (&u)[4][4], int lane) {
  const int q = lane >> 4;
  float C = 0.f, CP = 1.f;
  const int src1 = (REV ? lane + 16 : lane - 16) & 63;
  const int src2 = (REV ? lane + 32 : lane - 32) & 63;
  const int srcT = (lane & 15) + (REV ? 0 : 48);
  const bool c1 = REV ? (q <= 2) : (q >= 1);
  const bool c2 = REV ? (q <= 1) : (q >= 2);
  const bool first = REV ? (q == 3) : (q == 0);
#pragma unroll
  for (int mi = 0; mi < 4; ++mi) {
    const int mt = REV ? 3 - mi : mi;
    float P = 1.f, H = 0.f, pl[4], hl[4];
#pragma unroll
    for (int ri = 0; ri < 4; ++ri) {
      const int r = REV ? 3 - ri : ri;
      H = a[mt][r] * H + u[mt][r]; P *= a[mt][r]; pl[r] = P; hl[r] = H;
    }
    float Pi = P, Hi = H;
    float Pp = __shfl(Pi, src1), Hp = __shfl(Hi, src1);
    if (c1) { Hi = Pi * Hp + Hi; Pi = Pi * Pp; }
    Pp = __shfl(Pi, src2); Hp = __shfl(Hi, src2);
    if (c2) { Hi = Pi * Hp + Hi; Pi = Pi * Pp; }
    float Pe = __shfl(Pi, src1), He = __shfl(Hi, src1);
    if (first) { Pe = 1.f; He = 0.f; }
    const float hin = Pe * C + He, pin = Pe * CP;
#pragma unroll
    for (int r = 0; r < 4; ++r) { u[mt][r] = pl[r] * hin + hl[r]; a[mt][r] = pl[r] * pin; }
    const float Pt = __shfl(Pi, srcT), Ht = __shfl(Hi, srcT);
    C = Pt * C + Ht; CP = Pt * CP;
  }
}

DEV void lru_gate_item(const Params& p, int l, int item, char* smem) {
  const int tid = VTID, lane = tid & 63, w = tid >> 6;
  const int tile = item >> 2, blk = item & 3;
  const int m0 = tile * 64;
  int ms, L;
  if (m0 < 8192) { ms = m0 & ~255; L = 256; } else { ms = 8192 + ((m0 - 8192) & ~1023); L = 1024; }
  const int dir = w >> 1, half = w & 1, q = lane >> 4, c15 = lane & 15;
  const bf16_t* wt = p.wt_lru + (size_t)((((l * 2 + dir) * 4 + blk) * 2)) * 4096;
  bf16x8 bfr[2][2][2];
#pragma unroll
  for (int mat = 0; mat < 2; ++mat)
#pragma unroll
    for (int j = 0; j < 2; ++j)
#pragma unroll
      for (int s = 0; s < 2; ++s) bfr[mat][j][s] = *(const bf16x8*)(wt + mat * 4096 + (half * 32 + j * 16 + c15) * 64 + s * 32 + q * 8);
  float* xs = (float*)smem;
  float* xcf = xs + 67 * 64;
  bf16_t* xcb = (bf16_t*)(xcf + 64 * 64);
  for (int idx = tid; idx < 67 * 8; idx += 256) {
    const int rr = idx >> 3, cc = idx & 7;
    const int m = m0 - 1 + rr;
    float v[8];
    if (m >= ms && m < ms + L) {
      U8 u; u.u = *(const uint4*)(p.zf + (size_t)m * 1792 + 768 + blk * 64 + cc * 8);
#pragma unroll
      for (int j = 0; j < 8; ++j) v[j] = bf2f(u.h[j]);
    } else {
#pragma unroll
      for (int j = 0; j < 8; ++j) v[j] = 0.f;
    }
#pragma unroll
    for (int j = 0; j < 8; ++j) xs[rr * 64 + cc * 8 + j] = v[j];
  }
  __syncthreads();
  {
    const int ch = tid & 63, Cg = blk * 64 + ch;
    const float w0 = p.conv_w[(l * 4 + 0) * 256 + Cg], w1 = p.conv_w[(l * 4 + 1) * 256 + Cg], w2 = p.conv_w[(l * 4 + 2) * 256 + Cg],
                w3 = p.conv_w[(l * 4 + 3) * 256 + Cg], cb = p.conv_b[l * 256 + Cg];
#pragma unroll 4
    for (int tt = 0; tt < 16; ++tt) {
      const int t = (tid >> 6) * 16 + tt;
      const float v = cb + w0 * xs[t * 64 + ch] + w1 * xs[(t + 1) * 64 + ch] + w2 * xs[(t + 2) * 64 + ch] + w3 * xs[(t + 3) * 64 + ch];
      xcf[t * 64 + ch] = v; xcb[t * 72 + ch] = f2bf(v);
    }
  }
  __syncthreads();
  f32x4 acc[2][4][2];
#pragma unroll
  for (int mat = 0; mat < 2; ++mat)
#pragma unroll
    for (int mt = 0; mt < 4; ++mt)
#pragma unroll
      for (int j = 0; j < 2; ++j) acc[mat][mt][j] = f32x4{0.f, 0.f, 0.f, 0.f};
#pragma unroll
  for (int mt = 0; mt < 4; ++mt)
#pragma unroll
    for (int s = 0; s < 2; ++s) {
      const bf16x8 af = *(const bf16x8*)(xcb + (mt * 16 + c15) * 72 + s * 32 + q * 8);
#pragma unroll
      for (int mat = 0; mat < 2; ++mat)
#pragma unroll
        for (int j = 0; j < 2; ++j) acc[mat][mt][j] = mfma16(af, bfr[mat][j][s], acc[mat][mt][j]);
    }
  float* PCp = p.au + (size_t)(dir * 2 + 0) * MT * 256;
  float* HLp = p.au + (size_t)(dir * 2 + 1) * MT * 256;
#pragma unroll
  for (int j = 0; j < 2; ++j) {
    const int ch = half * 32 + j * 16 + c15, Cg = blk * 64 + ch, pidx = (l * 2 + dir) * 256 + Cg;
    const float ba = p.lru_ba[pidx], bx = p.lru_bx[pidx];
    const float cdec = p.cdec[pidx];
    float a[4][4], u[4][4];
#pragma unroll
    for (int mt = 0; mt < 4; ++mt)
#pragma unroll
      for (int r = 0; r < 4; ++r) {
        const int t = mt * 16 + q * 4 + r;
        const float rg = sigmoidf_(acc[0][mt][j][r] + ba), ig = sigmoidf_(acc[1][mt][j][r] + bx);
        const float la = cdec * rg;
        a[mt][r] = __expf(la);
        const float x2 = 2.f * la;
        const float em = (x2 < -0.25f) ? 1.f - __expf(x2) : -x2 * (1.f + x2 * (0.5f + x2 * (1.f / 6.f + x2 * (1.f / 24.f + x2 * (1.f / 120.f + x2 * (1.f / 720.f))))));
        u[mt][r] = __builtin_amdgcn_sqrtf(em) * ig * xcf[t * 64 + ch];
      }
    if (dir == 0) tile_scan<false>(a, u, lane); else tile_scan<true>(a, u, lane);
#pragma unroll
    for (int mt = 0; mt < 4; ++mt)
#pragma unroll
      for (int r = 0; r < 4; ++r) {
        const size_t m = m0 + mt * 16 + q * 4 + r;
        PCp[m * 256 + Cg] = a[mt][r]; HLp[m * 256 + Cg] = u[mt][r];
      }
  }
  __syncthreads();
}

DEV void attn_item(const Params& p, int l, int it, char* sm) {
  const int tid = threadIdx.x, lane = tid & 63, w = tid >> 6, q = lane >> 4, c15 = lane & 15;
  const int qg = w >> 1, kh = w & 1;
  int h, ms, nkt, T; const bf16_t* Kg; const bf16_t* Vg;
  if (it < 512) {
    const int b = it >> 6, qb = it & 7; h = (it >> 3) & 7; ms = 8192 + b * 1024 + qb * 128; nkt = 10; T = 1280;
    Kg = p.kb_lat + (size_t)((l * 8 + b) * 2 + (h >> 2)) * 1280 * 64; Vg = p.vt_lat + (size_t)((l * 8 + b) * 2 + (h >> 2)) * 64 * 1280;
  } else {
    const int i2 = it - 512, b = i2 >> 4, qb = i2 & 1; h = (i2 >> 1) & 7; ms = b * 256 + qb * 128; nkt = 2; T = 256;
    Kg = p.kb_ctx + (size_t)(b * 2 + (h >> 2)) * 256 * 64; Vg = p.vt_ctx + (size_t)(b * 2 + (h >> 2)) * 64 * 256;
  }
  const int kc0 = tid, kc1 = tid + 512;
  const int vd0 = tid >> 4, vk = (tid & 15) * 8;
  const int vpos = ((tid & 15) >> 2) * 32 + 16 * (tid & 1) + 4 * ((tid & 3) >> 1);
  const bf16_t* vg0 = Vg + (size_t)vd0 * T + vk;
  const bf16_t* vg1 = Vg + (size_t)(vd0 + 32) * T + vk;
  uint4 rk0, rk1, rv0, rv1;
#define ATT_LOAD(kt) do { rk0 = *(const uint4*)(Kg + (size_t)(kt) * 8192 + kc0 * 8); rk1 = *(const uint4*)(Kg + (size_t)(kt) * 8192 + kc1 * 8); \
    rv0 = *(const uint4*)(vg0 + (kt) * 128); rv1 = *(const uint4*)(vg1 + (kt) * 128); } while (0)
#define ATT_STORE(buf) do { bf16_t* Ks_ = (bf16_t*)(sm + (buf) * 36864); bf16_t* Vs_ = Ks_ + 9216; \
    *(uint4*)(Ks_ + (kc0 >> 3) * 72 + (kc0 & 7) * 8) = rk0; *(uint4*)(Ks_ + (kc1 >> 3) * 72 + (kc1 & 7) * 8) = rk1; \
    *(uint2*)(Vs_ + vd0 * 136 + vpos) = make_uint2(rv0.x, rv0.y); *(uint2*)(Vs_ + vd0 * 136 + vpos + 8) = make_uint2(rv0.z, rv0.w); \
    *(uint2*)(Vs_ + (vd0 + 32) * 136 + vpos) = make_uint2(rv1.x, rv1.y); *(uint2*)(Vs_ + (vd0 + 32) * 136 + vpos + 8) = make_uint2(rv1.z, rv1.w); } while (0)
  ATT_LOAD(0);
  const int mq = ms + qg * 32;
  bf16x8 qf[2][2];
#pragma unroll
  for (int t = 0; t < 2; ++t)
#pragma unroll
    for (int s = 0; s < 2; ++s) qf[t][s] = *(const bf16x8*)(p.zf + (size_t)(mq + t * 16 + c15) * 1792 + h * 64 + s * 32 + q * 8);
  ATT_STORE(0);
  if (nkt > 1) ATT_LOAD(1);
#pragma unroll
  for (int t = 0; t < 2; ++t) {
    float f[2][8]; float ss = 0.f;
#pragma unroll
    for (int s = 0; s < 2; ++s)
#pragma unroll
      for (int j = 0; j < 8; ++j) { f[s][j] = bf2f((bf16_t)qf[t][s][j]); ss += f[s][j] * f[s][j]; }
    ss += __shfl_xor(ss, 16); ss += __shfl_xor(ss, 32);
    const float rinv = rsqrtf(ss * (1.f / 64.f) + 1e-6f);
    const int mrow_ = mq + t * 16 + c15;
    const int pos = (mrow_ - 8192) & 1023;
#pragma unroll
    for (int s = 0; s < 2; ++s) {
      const int dd = s * 32 + q * 8;
#pragma unroll
      for (int j = 0; j < 8; ++j) f[s][j] = f[s][j] * rinv * p.q_g[l * 64 + dd + j];
      if (it < 512) rope8(f[s], dd, pos >> 6, pos & 63, p.rope);
      U8 pk;
#pragma unroll
      for (int j = 0; j < 4; ++j) pk.w[j] = pack2(f[s][2 * j] * QSCALE, f[s][2 * j + 1] * QSCALE);
      qf[t][s] = pk.v;
    }
  }
  __syncthreads();
  f32x4 o[2][4];
  float mrow[2], lrow[2];
#pragma unroll
  for (int t = 0; t < 2; ++t) { mrow[t] = -1e30f; lrow[t] = 0.f;
#pragma unroll
    for (int j = 0; j < 4; ++j) o[t][j] = f32x4{0.f, 0.f, 0.f, 0.f}; }
  for (int kt = 0; kt < nkt; ++kt) {
    const int cur = kt & 1;
    const bf16_t* Ks = (const bf16_t*)(sm + cur * 36864) + kh * 64 * 72;
    const bf16_t* Vs = (const bf16_t*)(sm + cur * 36864) + 9216 + kh * 64;
    f32x4 s4[2][4];
    {
      bf16x8 kf[4][2];
#pragma unroll
      for (int jn = 0; jn < 4; ++jn)
#pragma unroll
        for (int s = 0; s < 2; ++s) kf[jn][s] = *(const bf16x8*)(Ks + (jn * 16 + c15) * 72 + s * 32 + q * 8);
      __builtin_amdgcn_sched_barrier(0);
#pragma unroll
      for (int jn = 0; jn < 4; ++jn)
#pragma unroll
        for (int t = 0; t < 2; ++t) s4[t][jn] = mfma16(kf[jn][0], qf[t][0], f32x4{0.f, 0.f, 0.f, 0.f});
#pragma unroll
      for (int jn = 0; jn < 4; ++jn)
#pragma unroll
        for (int t = 0; t < 2; ++t) s4[t][jn] = mfma16(kf[jn][1], qf[t][1], s4[t][jn]);
      __builtin_amdgcn_sched_barrier(0);
    }
    U8 vf[4][2];
#pragma unroll
    for (int jn = 0; jn < 4; ++jn)
#pragma unroll
      for (int ks = 0; ks < 2; ++ks) vf[jn][ks].u = *(const uint4*)(Vs + (jn * 16 + c15) * 136 + ks * 32 + q * 8);
    __builtin_amdgcn_sched_barrier(0);
    U8 pb[2][2];
#pragma unroll
    for (int t = 0; t < 2; ++t) {
      float mx = s4[t][0][0];
#pragma unroll
      for (int jn = 0; jn < 4; ++jn)
#pragma unroll
        for (int r = 0; r < 4; ++r) mx = fmaxf(mx, s4[t][jn][r]);
      mx = fmaxf(mx, __shfl_xor(mx, 16)); mx = fmaxf(mx, __shfl_xor(mx, 32));
      const float mnew = fmaxf(mrow[t], mx);
      const float alpha = __builtin_amdgcn_exp2f(mrow[t] - mnew);
      mrow[t] = mnew;
      float ls = 0.f;
#pragma unroll
      for (int jn = 0; jn < 4; ++jn)
#pragma unroll
        for (int r = 0; r < 4; ++r) { const float pv = __builtin_amdgcn_exp2f(s4[t][jn][r] - mnew); s4[t][jn][r] = pv; ls += pv; }
      lrow[t] = lrow[t] * alpha + ls;
#pragma unroll
      for (int jn = 0; jn < 4; ++jn) { o[t][jn][0] *= alpha; o[t][jn][1] *= alpha; o[t][jn][2] *= alpha; o[t][jn][3] *= alpha; }
#pragma unroll
      for (int ks = 0; ks < 2; ++ks) {
        pb[t][ks].w[0] = pack2(s4[t][2 * ks][0], s4[t][2 * ks][1]); pb[t][ks].w[1] = pack2(s4[t][2 * ks][2], s4[t][2 * ks][3]);
        pb[t][ks].w[2] = pack2(s4[t][2 * ks + 1][0], s4[t][2 * ks + 1][1]); pb[t][ks].w[3] = pack2(s4[t][2 * ks + 1][2], s4[t][2 * ks + 1][3]);
      }
    }
#pragma unroll
    for (int ks = 0; ks < 2; ++ks)
#pragma unroll
      for (int jn = 0; jn < 4; ++jn)
#pragma unroll
        for (int t = 0; t < 2; ++t) o[t][jn] = mfma16(vf[jn][ks].v, pb[t][ks].v, o[t][jn]);
    if (kt + 1 < nkt) {
      ATT_STORE(cur ^ 1);
      if (kt + 2 < nkt) ATT_LOAD(kt + 2);
    }
    __syncthreads();
  }
#undef ATT_LOAD
#undef ATT_STORE
  float* mrg = (float*)(sm + 73728) + (size_t)(qg * 64 + lane) * 37;
  float lt[2];
#pragma unroll
  for (int t = 0; t < 2; ++t) { float a = lrow[t]; a += __shfl_xor(a, 16); a += __shfl_xor(a, 32); lt[t] = a; }
  if (kh == 1) {
#pragma unroll
    for (int t = 0; t < 2; ++t) {
      mrg[t * 18 + 0] = mrow[t]; mrg[t * 18 + 1] = lt[t];
#pragma unroll
      for (int jn = 0; jn < 4; ++jn)
#pragma unroll
        for (int r = 0; r < 4; ++r) mrg[t * 18 + 2 + jn * 4 + r] = o[t][jn][r];
    }
  }
  __syncthreads();
  if (kh == 0) {
#pragma unroll
    for (int t = 0; t < 2; ++t) {
      const float m1 = mrg[t * 18 + 0], l1 = mrg[t * 18 + 1];
      const float mm = fmaxf(mrow[t], m1);
      const float a0 = __builtin_amdgcn_exp2f(mrow[t] - mm), a1 = __builtin_amdgcn_exp2f(m1 - mm);
      const float inv = 1.f / (a0 * lt[t] + a1 * l1);
      const float c0 = a0 * inv, c1 = a1 * inv;
      bf16_t* orow = p.abuf + (size_t)(mq + t * 16 + c15) * 1024 + h * 64 + q * 4;
#pragma unroll
      for (int jn = 0; jn < 4; ++jn) {
        const float x0 = c0 * o[t][jn][0] + c1 * mrg[t * 18 + 2 + jn * 4 + 0], x1 = c0 * o[t][jn][1] + c1 * mrg[t * 18 + 2 + jn * 4 + 1];
        const float x2 = c0 * o[t][jn][2] + c1 * mrg[t * 18 + 2 + jn * 4 + 2], x3 = c0 * o[t][jn][3] + c1 * mrg[t * 18 + 2 + jn * 4 + 3];
        uint2 ov; ov.x = pack2(x0, x1); ov.y = pack2(x2, x3);
        *(uint2*)(orow + jn * 16) = ov;
      }
    }
  }
  __syncthreads();
}

DEV void gmlp_item(const Params& p, int l, int it, char* smem) {
  const int tid = VTID, lane = tid & 63, w = tid >> 6, q = lane >> 4, c15 = lane & 15;
  const int chunk = it >> 2, g = it & 3, m0 = chunk * 128;
  bf16_t* vt = (bf16_t*)smem;
  const float* wsg = p.mlp_ws + (size_t)(l * 4 + g) * 16384;
  float4 wa[2][4][2];
#pragma unroll
  for (int nt = 0; nt < 2; ++nt)
#pragma unroll
    for (int s = 0; s < 4; ++s) {
      const float* ap = wsg + ((2 * w + nt) * 16 + c15) * 128 + s * 32 + q * 8;
      wa[nt][s][0] = *(const float4*)ap; wa[nt][s][1] = *(const float4*)(ap + 4);
    }
  uint4 vin[4];
#pragma unroll
  for (int i = 0; i < 4; ++i) { const int id = tid + 256 * i; vin[i] = *(const uint4*)(p.zf + (size_t)(m0 + (id >> 3)) * 1792 + 1536 + g * 64 + (id & 7) * 8); }
#pragma unroll
  for (int i = 0; i < 4; ++i) {
    const int id = tid + 256 * i, qq = id >> 3, cc = id & 7;
    U8 v; v.u = vin[i];
#pragma unroll
    for (int j = 0; j < 8; ++j) vt[(cc * 8 + j) * 136 + qq] = v.h[j];
  }
  __syncthreads();
  f32x4 acc[4][2];
#pragma unroll
  for (int mt = 0; mt < 4; ++mt)
#pragma unroll
    for (int nt = 0; nt < 2; ++nt) acc[mt][nt] = f32x4{0.f, 0.f, 0.f, 0.f};
#pragma unroll
  for (int s = 0; s < 4; ++s) {
    bf16x8 af[4];
#pragma unroll
    for (int mt = 0; mt < 4; ++mt) af[mt] = *(const bf16x8*)(vt + (mt * 16 + c15) * 136 + s * 32 + q * 8);
#pragma unroll
    for (int nt = 0; nt < 2; ++nt) {
      U8 bb;
      bb.w[0] = pack2(wa[nt][s][0].x, wa[nt][s][0].y); bb.w[1] = pack2(wa[nt][s][0].z, wa[nt][s][0].w);
      bb.w[2] = pack2(wa[nt][s][1].x, wa[nt][s][1].y); bb.w[3] = pack2(wa[nt][s][1].z, wa[nt][s][1].w);
#pragma unroll
      for (int mt = 0; mt < 4; ++mt) acc[mt][nt] = mfma16(af[mt], bb.v, acc[mt][nt]);
    }
  }
#pragma unroll
  for (int nt = 0; nt < 2; ++nt) {
    const int pp = (2 * w + nt) * 16 + c15;
    const size_t m = m0 + pp;
    const float bsv = p.mlp_bs[(l * 4 + g) * 128 + pp];
#pragma unroll
    for (int mt = 0; mt < 4; ++mt) {
      const int c = mt * 16 + q * 4;
      const uint2 uu = *(const uint2*)(p.zf + m * 1792 + 1280 + g * 64 + c);
      const float u0 = gelu_t(__uint_as_float(uu.x << 16)), u1 = gelu_t(__uint_as_float(uu.x & 0xffff0000u)), u2 = gelu_t(__uint_as_float(uu.y << 16)), u3 = gelu_t(__uint_as_float(uu.y & 0xffff0000u));
      uint2 o; o.x = pack2(u0 * (acc[mt][nt][0] + bsv), u1 * (acc[mt][nt][1] + bsv)); o.y = pack2(u2 * (acc[mt][nt][2] + bsv), u3 * (acc[mt][nt][3] + bsv));
      *(uint2*)(p.abuf + m * 1024 + 768 + g * 64 + c) = o;
    }
  }
  __syncthreads();
}

DEV void lru_apply_item(const Params& p, int l, int ti2) {
  const int C = VTID;
  const int ti = ti2 >> 1, th = (ti2 & 1) * 32;
  const int m0 = ti * 64;
  int ms, L, b; bool lat = m0 >= 8192;
  if (!lat) { ms = m0 & ~255; L = 256; b = m0 >> 8; } else { ms = 8192 + ((m0 - 8192) & ~1023); L = 1024; b = (m0 - 8192) >> 10; }
  const int k = (m0 - ms) >> 6, nt = L >> 6;
  const float* PCf = p.au; const float* HLf = p.au + (size_t)MT * 256;
  const float* PCb = p.au + (size_t)2 * MT * 256; const float* HLb = p.au + (size_t)3 * MT * 256;
  float cf = lat ? p.state_lru[((size_t)(b * 2 + l) * 2 + 0) * 256 + C] : 0.f;
  float cb = lat ? p.state_lru[((size_t)(b * 2 + l) * 2 + 1) * 256 + C] : 0.f;
  {
    float pc[15], hl[15];
#pragma unroll
    for (int i = 0; i < 15; ++i) {
      const bool act = i < k;
      const size_t e = (size_t)(ms + 64 * i + 63) * 256 + C;
      pc[i] = act ? PCf[e] : 1.f; hl[i] = act ? HLf[e] : 0.f;
    }
#pragma unroll
    for (int i = 0; i < 15; ++i) cf = pc[i] * cf + hl[i];
  }
  {
    float pc[15], hl[15];
#pragma unroll
    for (int i = 0; i < 15; ++i) {
      const int tix = nt - 1 - i;
      const bool act = tix > k;
      const size_t e = (size_t)(ms + 64 * tix) * 256 + C;
      pc[i] = act ? PCb[e] : 1.f; hl[i] = act ? HLb[e] : 0.f;
    }
#pragma unroll
    for (int i = 0; i < 15; ++i) cb = pc[i] * cb + hl[i];
  }
  float hf_last = 0.f, hb_first = 0.f;
#pragma unroll 16
  for (int t = th; t < th + 32; ++t) {
    const size_t m = m0 + t;
    const float hf = PCf[m * 256 + C] * cf + HLf[m * 256 + C];
    const float hb = PCb[m * 256 + C] * cb + HLb[m * 256 + C];
    const float g = gelu_t(bf2f(p.zf[m * 1792 + 1024 + C]));
    p.abuf[m * 1024 + 512 + C] = f2bf((hf + hb) * g);
    if (t == 0) hb_first = hb;
    if (t == 63) hf_last = hf;
  }
  if (!lat) {
    if (k == nt - 1 && th == 32) p.out[OFF_ST + ((size_t)(b * 2 + l) * 2 + 0) * 256 + C] = hf_last;
    if (k == 0 && th == 0) p.out[OFF_ST + ((size_t)(b * 2 + l) * 2 + 1) * 256 + C] = hb_first;
  }
}

DEV void mixer_phase(const Params& p, int l, char* smem_raw, char* smem) {
  {
    const int x = blockIdx.x & 7, j = blockIdx.x >> 3;
#pragma unroll 1
    for (int k = 0; k < 4; ++k) attn_item(p, l, ((k >> 1) << 9) + 64 * x + j + 32 * (k & 1), smem_raw);
  }
  {
    const int x = blockIdx.x & 7, lh = (blockIdx.x >> 3) * 2 + (threadIdx.x >> 8);
    lru_apply_item(p, l, (own_row(x, (lh >> 1) * 64) >> 6) * 2 + (lh & 1));
    gmlp_item(p, l, (own_row(x, (lh >> 2) * 128) >> 7) * 4 + (lh & 3), smem);
  }
}

DEV void prep_phase_full(const Params& p, int l, char* smem) {
  {
    const int xcd = blockIdx.x & 7, lh = (blockIdx.x >> 3) * 2 + (threadIdx.x >> 8);
#pragma unroll 1
    for (int k = 0; k < 2; ++k) { const int li = lh + 64 * k; lru_gate_item(p, l, (own_row(xcd, (li >> 2) * 64) >> 6) * 4 + (li & 3), smem); }
  }
  const int lane = threadIdx.x & 63, mstride = gridDim.x * 8;
  int vm = blockIdx.x * 8 + (threadIdx.x >> 6);
  const int coff = lane < 32 ? 512 + lane * 8 : 1536 + (lane - 32) * 8;
  uint4 n1 = *(const uint4*)(p.zf + (size_t)xrow(vm) * 1792 + coff);
  uint4 n2 = *(const uint4*)(p.zf + (size_t)xrow((vm + mstride < MT) ? vm + mstride : vm) * 1792 + coff);
  for (; vm < MT; vm += mstride) {
    const uint4 c = n1; n1 = n2;
    const int mn = xrow((vm + 2 * mstride < MT) ? vm + 2 * mstride : vm);
    n2 = *(const uint4*)(p.zf + (size_t)mn * 1792 + coff);
    prep_token_row(p, l, xrow(vm), lane, c);
  }
}


#define XB_TMO      128
#define XB_XCNT(j)  (256  + 64 * (j))
#define XB_XSUB(j)  (1280 + 64 * (j))
#define XB_XGEN(j)  (2304 + 64 * (j))
#define XB_TOP      3328
#define XB_TOPGEN   3392
#define XCD_BAR_WORDS 3456
#define XB_SPIN_CAP (1u << 18)
#define LAS __attribute__((address_space(3)))
DEV unsigned xb_ld(unsigned* p) { return __hip_atomic_load(p, __ATOMIC_RELAXED, __HIP_MEMORY_SCOPE_AGENT); }
DEV unsigned xb_add(unsigned* p, unsigned v) { return __hip_atomic_fetch_add(p, v, __ATOMIC_RELAXED, __HIP_MEMORY_SCOPE_AGENT); }
DEV unsigned xb_xcc_id() { return (unsigned)__builtin_amdgcn_s_getreg((3 << 11) | 20) & 0xFu; }
#define XB_SPIN(cond, bar) do { unsigned _sp = 0; while (cond) { __builtin_amdgcn_s_sleep(1); \
    if ((++_sp & 255u) == 0u) { if (xb_ld(&(bar)[XB_TMO])) break; if (_sp > XB_SPIN_CAP) { atomicAdd(&(bar)[XB_TMO], 1u); break; } } } } while (0)
struct XcdBarrier { unsigned* bar; unsigned x; volatile LAS unsigned* st; };
DEV XcdBarrier xcd_barrier_post(unsigned* bar, volatile LAS unsigned* st) {
  XcdBarrier b; b.bar = bar; b.x = xb_xcc_id(); b.st = st;
  if (threadIdx.x == 0) (void)xb_add(&bar[XB_XCNT(b.x)], 1u);
  return b;
}
DEV void xcd_barrier_complete(unsigned* bar, unsigned x, unsigned& nloc, unsigned& nx) {
  const unsigned G = gridDim.x * gridDim.y * gridDim.z;
  unsigned sum, cnt, mine, sp = 0u;
  for (;;) {
    sum = 0u; cnt = 0u; mine = 0u;
#pragma unroll
    for (unsigned j = 0; j < 16; ++j) { const unsigned c = xb_ld(&bar[XB_XCNT(j)]); sum += c; cnt += (c > 0u) ? 1u : 0u; mine = (j == x) ? c : mine; }
    if (sum == G) break;
    __builtin_amdgcn_s_sleep(1);
    if ((++sp & 255u) == 0u) { if (xb_ld(&bar[XB_TMO])) break; if (sp > XB_SPIN_CAP) { atomicAdd(&bar[XB_TMO], 1u); break; } }
  }
  nloc = mine > 0u ? mine : 1u; nx = cnt > 0u ? cnt : 1u;
}
DEV void xcd_barrier(const XcdBarrier& b) {
  asm volatile("s_waitcnt vmcnt(0)" ::: "memory");
  __syncthreads();
  if (threadIdx.x == 0) {
    unsigned* bar = b.bar;
    __builtin_amdgcn_s_waitcnt(0);
    unsigned nloc = b.st[0], nx = b.st[1];
    if (nloc == 0u) { xcd_barrier_complete(bar, b.x, nloc, nx); b.st[0] = nloc; b.st[1] = nx; }
    const unsigned old = xb_add(&bar[XB_XSUB(b.x)], 1u);
    const unsigned gen = old / nloc;
    if (old + 1u == (gen + 1u) * nloc) {
      __builtin_amdgcn_fence(__ATOMIC_RELEASE, "agent");
      asm volatile("s_waitcnt vmcnt(0)" ::: "memory");
      const unsigned og = xb_add(&bar[XB_TOP], 1u);
      const unsigned tg = og / nx;
      if (og + 1u == (tg + 1u) * nx) xb_add(&bar[XB_TOPGEN], 1u);
      else XB_SPIN(xb_ld(&bar[XB_TOPGEN]) == tg, bar);
      __builtin_amdgcn_fence(__ATOMIC_ACQUIRE, "agent");
      xb_add(&bar[XB_XGEN(b.x)], 1u);
      asm volatile("s_waitcnt vmcnt(0)" ::: "memory");
    } else {
      XB_SPIN(xb_ld(&bar[XB_XGEN(b.x)]) == gen, bar);
      __builtin_amdgcn_fence(__ATOMIC_ACQUIRE, "agent");
      asm volatile("s_waitcnt vmcnt(0)" ::: "memory");
    }
  }
  __syncthreads();
}

#define XB_MISMATCH 160
#define XB_WREADY 192
DEV void xcd_barrier_local(const XcdBarrier& b) {
  asm volatile("s_waitcnt vmcnt(0)" ::: "memory");
  __syncthreads();
  if (threadIdx.x == 0) {
    unsigned* bar = b.bar;
    __builtin_amdgcn_s_waitcnt(0);
    const unsigned nloc = b.st[0];
    const unsigned old = xb_add(&bar[XB_XSUB(b.x)], 1u);
    const unsigned gen = old / nloc;
    if (old + 1u == (gen + 1u) * nloc) xb_add(&bar[XB_XGEN(b.x)], 1u);
    else XB_SPIN(xb_ld(&bar[XB_XGEN(b.x)]) == gen, bar);
    __builtin_amdgcn_fence(__ATOMIC_ACQUIRE, "agent");
    asm volatile("s_waitcnt vmcnt(0)" ::: "memory");
  }
  __syncthreads();
}

#define XB_TEAM(pm) (3520 + 8 * (pm))
DEV void team_barrier(unsigned* bar, int pm, unsigned target) {
  asm volatile("s_waitcnt vmcnt(0)" ::: "memory");
  __syncthreads();
  if (threadIdx.x == 0) {
    __builtin_amdgcn_s_waitcnt(0);
    xb_add(&bar[XB_TEAM(pm)], 1u);
    XB_SPIN(xb_ld(&bar[XB_TEAM(pm)]) < target, bar);
    __builtin_amdgcn_fence(__ATOMIC_ACQUIRE, "agent");
    asm volatile("s_waitcnt vmcnt(0)" ::: "memory");
  }
  __syncthreads();
}
DEV void team_chain(const Params& p, int l, LAS3 unsigned char* lds) {
  int pm, pn;
  if (!g8::unit_of(0, MT / 256, 4, pm, pn)) return;
  const unsigned r = 5u * (unsigned)l;
  const int base = pm * 256 + pn * 64;
  team_barrier(p.bar, pm, 4u * (r + 1u)); ln_mod_phase(p, l, 2, base);
  team_barrier(p.bar, pm, 4u * (r + 2u)); gemm_phase<3>(p, l, p.abuf, p.wt_ff1 + (size_t)l * 4096 * 1024, 4096, 1024, lds, pm, pn);
  team_barrier(p.bar, pm, 4u * (r + 3u)); gemm_phase<4>(p, l, p.zf, p.wt_ff2 + (size_t)l * 1024 * 4096, 1024, 4096, lds, pm, pn);
  team_barrier(p.bar, pm, 4u * (r + 4u)); ln_mod_phase(p, 1, l == 0 ? 1 : 3, base);
  if (l == 0) { team_barrier(p.bar, pm, 4u * (r + 5u)); gemm_phase<1>(p, 1, p.abuf, p.wt_in + (size_t)1792 * 1024, 1792, 1024, lds, pm, pn); }
}

#define PH(i, call) if (ph_lo <= (i) && (i) < ph_hi) { if ((i) > ph_lo) { if ((i) >= 2 && xcd_local) xcd_barrier_local(xb); else xcd_barrier(xb); } call; }
#define LAYER_REST(l, b) \
  if (!(xcd_local && l == 1)) { PH(b + 1, gemm_phase<1>(p, l, p.abuf, p.wt_in + (size_t)l * 1792 * 1024, 1792, 1024, (LAS3 unsigned char*)smem_raw)) } \
  PH(b + 2, prep_phase_full(p, l, smem)) \
  PH(b + 3, mixer_phase(p, l, smem_raw, smem)) \
  PH(b + 4, if (l == 0 && xcd_local) { if (threadIdx.x == 0) { XB_SPIN(xb_ld(&p.bar[XB_WREADY]) < 128u, p.bar); __builtin_amdgcn_fence(__ATOMIC_ACQUIRE, "agent"); asm volatile("s_waitcnt vmcnt(0)" ::: "memory"); } __syncthreads(); } \
            gemm_phase<2>(p, l, p.abuf, p.wt_out + (size_t)l * 1024 * 1024, 1024, 1024, (LAS3 unsigned char*)smem_raw); \
            if (xcd_local) team_chain(p, l, (LAS3 unsigned char*)smem_raw)) \
  if (!xcd_local) { \
    PH(b + 5, ln_mod_phase(p, l, 2)) \
    PH(b + 6, gemm_phase<3>(p, l, p.abuf, p.wt_ff1 + (size_t)l * 4096 * 1024, 4096, 1024, (LAS3 unsigned char*)smem_raw)) \
    PH(b + 7, gemm_phase<4>(p, l, p.zf, p.wt_ff2 + (size_t)l * 1024 * 4096, 1024, 4096, (LAS3 unsigned char*)smem_raw)) }

__global__ void __launch_bounds__(512, 2) mega_kernel(Params p, int ph_lo, int ph_hi) {
  extern __shared__ __attribute__((aligned(16))) char smem_raw[];
  char* smem = smem_raw + (threadIdx.x >> 8) * 65536;
  __shared__ uint4 xb_words;
  if (threadIdx.x == 0) xb_words = make_uint4(0u, 0u, 0u, 0u);
  __syncthreads();
  XcdBarrier xb = xcd_barrier_post(p.bar, (volatile LAS unsigned*)&xb_words);
  if (threadIdx.x == 0) atomicOr(&p.bar[XB_MISMATCH + (blockIdx.x & 7u)], 1u << xb.x);
  if (ph_hi > 1000) { cg::grid_group grid = cg::this_grid(); grid.sync(); }
  bool xcd_local = false;
  PH(0, phase0(p, smem))
  PH(1, { unsigned all = 0u; bool one = true;
          for (int c = 0; c < 8; ++c) { const unsigned m = xb_ld(&p.bar[XB_MISMATCH + c]); one = one && (__builtin_popcount(m) == 1); all |= m; }
          xcd_local = one && all == 0xFFu && gridDim.x == 256; }
        if (xcd_local) {
          if (blockIdx.x & 4u) {
            transpose_all(p, smem, 1, ((int)(blockIdx.x & 3u) + 4 * (int)(blockIdx.x >> 3)) * 2 + (int)(threadIdx.x >> 8), 256);
            asm volatile("s_waitcnt vmcnt(0)" ::: "memory");
            __syncthreads();
            if (threadIdx.x == 0) { __builtin_amdgcn_fence(__ATOMIC_RELEASE, "agent"); asm volatile("s_waitcnt vmcnt(0)" ::: "memory"); xb_add(&p.bar[XB_WREADY], 1u); }
          }
        } else { transpose_all(p, smem, 1, VBID, VNB); xcd_barrier(xb); }
        ln_mod_phase(p, 0, 0))
#undef LAYER0_P1
  LAYER_REST(0, 1)
  if (!xcd_local) { PH(9, ln_mod_phase(p, 1, 1)) }
  LAYER_REST(1, 9)
  if (!xcd_local) { PH(17, ln_mod_phase(p, 1, 3)) }
}

extern "C" void kernel_launch(void* const* d_in, const int* in_sizes, int n_in, void* d_out, int out_size, void* d_ws, size_t ws_size,
                              hipStream_t stream) {
  static int grid_blocks = 0;
  if (!grid_blocks) {
    int dev = 0, cus = 0, per_cu = 0;
    hipGetDevice(&dev);
    hipDeviceGetAttribute(&cus, hipDeviceAttributeMultiprocessorCount, dev);
    hipFuncSetAttribute((const void*)mega_kernel, hipFuncAttributeMaxDynamicSharedMemorySize, SMEM_BYTES);
    hipOccupancyMaxActiveBlocksPerMultiprocessor(&per_cu, (const void*)mega_kernel, 512, SMEM_BYTES);
    if (per_cu < 1) per_cu = 1;
    if (per_cu > 1) per_cu = 1;
    grid_blocks = cus * per_cu;
  }
  Params p{};
  const float** pin = (const float**)&p;
  for (int i = 0; i < 32; ++i) pin[i] = (const float*)d_in[i];
  p.out = (float*)d_out;
  char* ws = (char*)d_ws;
  size_t off = 0;
  p.bar = (unsigned*)(ws + off); off += 16384;
  p.rstat = (float*)(ws + off); off += (size_t)MT * 2 * 4;
  p.kb_lat = (bf16_t*)(ws + off); off += (size_t)2 * 8 * 2 * 1280 * 64 * 2;
  p.vt_lat = (bf16_t*)(ws + off); off += (size_t)2 * 8 * 2 * 1280 * 64 * 2;
  p.kb_ctx = (bf16_t*)(ws + off); off += (size_t)32 * 2 * 256 * 64 * 2;
  p.vt_ctx = (bf16_t*)(ws + off); off += (size_t)32 * 2 * 256 * 64 * 2;
  p.wt_in = (bf16_t*)(ws + off); off += (size_t)2 * 1792 * 1024 * 2;
  p.wt_out = (bf16_t*)(ws + off); off += (size_t)2 * 1024 * 1024 * 2;
  p.wt_ff1 = (bf16_t*)(ws + off); off += (size_t)2 * 4096 * 1024 * 2;
  p.wt_ff2 = (bf16_t*)(ws + off); off += (size_t)2 * 4096 * 1024 * 2;
  p.wt_lru = (bf16_t*)(ws + off); off += (size_t)64 * 4096 * 2;
  p.mod = (float*)(ws + off); off += (size_t)2 * 9 * 6144 * 4;
  p.rope = (float*)(ws + off); off += (size_t)2048 * 4;
  p.cdec = (float*)(ws + off); off += (size_t)1024 * 4;
  p.abuf = (bf16_t*)(ws + off); off += (size_t)MT * 1024 * 2;
  p.zf = (bf16_t*)(ws + off);
  p.au = (float*)(ws + off + (size_t)MT * 1792 * 2);
  off += (size_t)MT * 4096 * 2;
  if (off > ws_size) { fprintf(stderr, "workspace too small: need %zu have %zu\n", off, ws_size); return; }
  (void)hipMemsetAsync(p.bar, 0, 16384, stream);
#if MULTI_LAUNCH
  for (int ph = 0; ph < NPHASE; ++ph) {
    hipLaunchKernelGGL(mega_kernel, dim3(grid_blocks), dim3(512), SMEM_BYTES, stream, p, ph, ph + 1);
  }
#else
  int lo = 0, hi = NPHASE;
  void* args[] = {&p, &lo, &hi};
  hipError_t e = hipLaunchCooperativeKernel((void*)mega_kernel, dim3(grid_blocks), dim3(512), args, SMEM_BYTES, stream);
  if (e != hipSuccess) fprintf(stderr, "cooperative launch failed: %s (grid %d)\n", hipGetErrorString(e), grid_blocks);
#endif
}
```

```cpp
#include <hip/hip_runtime.h>
#include <hip/hip_cooperative_groups.h>
#include <cstdio>
#include <cstdint>
namespace cg = cooperative_groups;

#ifndef MULTI_LAUNCH
#define MULTI_LAUNCH 0
#endif

typedef unsigned short bf16_t;
using bf16x8 = __attribute__((ext_vector_type(8))) short;
using f32x4 = __attribute__((ext_vector_type(4))) float;
#define DEV __device__ __forceinline__
#define VTID ((int)(threadIdx.x & 255))
#define VBID ((int)(blockIdx.x * 2 + (threadIdx.x >> 8)))
#define VNB ((int)(gridDim.x * 2))

constexpr int MT = 16384;
constexpr int NPHASE = 18;
constexpr size_t OFF_YK = 16777216, OFF_YV = OFF_YK + 2097152, OFF_ST = OFF_YV + 2097152;
constexpr float ALPHA = 1.41421356237f;
constexpr float QSCALE = 0.125f * 1.4426950408889634f;
constexpr int SMEM_BYTES = 131072;

struct Params {
  const float *x_prompt, *x_sample, *c, *cache_k, *cache_v, *state_lru, *c_ctx, *w_ada, *b_ada, *w_in,
      *q_g, *k_g, *conv_w, *conv_b, *lru_wa, *lru_ba, *lru_wx, *lru_bx, *lru_lam, *mlp_g, *mlp_b, *mlp_ws, *mlp_bs,
      *w_out, *ln1_g, *ln1_b, *w_ff1, *b_ff1, *w_ff2, *b_ff2, *ln2_g, *ln2_b;
  float* out;
  bf16_t *wt_in, *wt_out, *wt_ff1, *wt_ff2, *wt_lru;
  float *mod, *rope, *cdec;
  bf16_t *abuf;
  bf16_t *zf;
  float *au;
  bf16_t *kb_lat, *vt_lat;
  bf16_t *kb_ctx, *vt_ctx;
  unsigned *bar;
  float *rstat;
};

union U8 { uint4 u; bf16x8 v; bf16_t h[8]; unsigned w[4]; };

DEV float bf2f(bf16_t h) { return __uint_as_float(((unsigned)h) << 16); }
DEV bf16_t f2bf(float f) { unsigned u = __float_as_uint(f); u += 0x7fffu + ((u >> 16) & 1u); return (bf16_t)(u >> 16); }
DEV unsigned pack2(float a, float b) { unsigned r; asm volatile("v_cvt_pk_bf16_f32 %0, %1, %2" : "=v"(r) : "v"(a), "v"(b)); return r; }
DEV float gelu_t(float x) { float y = 0.7978845608028654f * (x + 0.044715f * x * x * x); float t = 1.f - 2.f * __builtin_amdgcn_rcpf(1.f + __expf(2.f * y)); return 0.5f * x * (1.f + t); }
DEV float sigmoidf_(float x) { return __builtin_amdgcn_rcpf(1.f + __expf(-x)); }
DEV int own_row(int x, int r) { return r < 1024 ? (x << 10) + r : 8192 + (x << 10) + (r - 1024); }
DEV int own_panel(int vp) { const int x = vp >> 3, lp = vp & 7; return lp < 4 ? 4 * x + lp : 32 + 4 * x + (lp - 4); }
DEV int xrow(int vm) { const int k = vm >> 11, c = (vm & 2047) >> 3, w = vm & 7; return own_row(c & 7, (k << 8) + ((c >> 3) << 3) + w); }
DEV int cond_of(int m) { return m < 8192 ? 0 : 1 + ((m - 8192) >> 10); }
DEV f32x4 mfma16(bf16x8 a, bf16x8 b, f32x4 c) { return __builtin_amdgcn_mfma_f32_16x16x32_bf16(a, b, c, 0, 0, 0); }
DEV float wave_sum(float v) {
#pragma unroll
  for (int o = 32; o >= 1; o >>= 1) v += __shfl_xor(v, o);
  return v;
}

DEV void transpose_tile(const float* __restrict__ src, bf16_t* __restrict__ dst, int lds_, int ldd, char* smem) {
  float* T = (float*)smem;
  const int tid = VTID;
#pragma unroll
  for (int i = 0; i < 4; ++i) {
    int k = (tid >> 4) + 16 * i, n4 = (tid & 15) * 4;
    float4 v = *(const float4*)(src + (size_t)k * lds_ + n4);
    T[k * 65 + n4 + 0] = v.x; T[k * 65 + n4 + 1] = v.y; T[k * 65 + n4 + 2] = v.z; T[k * 65 + n4 + 3] = v.w;
  }
  __syncthreads();
#pragma unroll
  for (int i = 0; i < 2; ++i) {
    int n = (tid >> 3) + 32 * i, k8 = (tid & 7) * 8;
    U8 o;
#pragma unroll
    for (int j = 0; j < 4; ++j) o.w[j] = pack2(T[(k8 + 2 * j) * 65 + n], T[(k8 + 2 * j + 1) * 65 + n]);
    *(uint4*)(dst + (size_t)n * ldd + k8) = o.u;
  }
  __syncthreads();
}
DEV void transpose_w(const float* __restrict__ W, bf16_t* __restrict__ Wt, int K, int N, int tk, int tn, char* smem) {
  transpose_tile(W + (size_t)(tk * 64) * N + tn * 64, Wt + (size_t)(tn * 64) * K + tk * 64, N, K, smem);
}

DEV void tr_desc(const Params& p, int t, const float*& src, int& lds_, bf16_t*& dst, int& ldd) {
  if (t < 2 * 2768) {
    const int l = t / 2768, r = t % 2768;
    const float* W; bf16_t* Wt; int K, N, tk, tn;
    if (r < 448) { W = p.w_in + (size_t)l * 1024 * 1792; Wt = p.wt_in + (size_t)l * 1792 * 1024; K = 1024; N = 1792; tk = r / 28; tn = r % 28; }
    else if (r < 704) { const int i = r - 448; W = p.w_out + (size_t)l * 1024 * 1024; Wt = p.wt_out + (size_t)l * 1024 * 1024; K = 1024; N = 1024; tk = i / 16; tn = i % 16; }
    else if (r < 1728) { const int i = r - 704; W = p.w_ff1 + (size_t)l * 1024 * 4096; Wt = p.wt_ff1 + (size_t)l * 4096 * 1024; K = 1024; N = 4096; tk = i / 64; tn = i % 64; }
    else if (r < 2752) { const int i = r - 1728; W = p.w_ff2 + (size_t)l * 4096 * 1024; Wt = p.wt_ff2 + (size_t)l * 1024 * 4096; K = 4096; N = 1024; tk = i / 16; tn = i % 16; }
    else {
      const int idx = r - 2752, dir = idx >> 3, blk = (idx >> 1) & 3, mat = idx & 1;
      src = (mat == 0 ? p.lru_wa : p.lru_wx) + (size_t)(((l * 2 + dir) * 4 + blk)) * 4096; lds_ = 64;
      dst = p.wt_lru + (size_t)((((l * 2 + dir) * 4 + blk) * 2 + mat)) * 4096; ldd = 64; return;
    }
    src = W + (size_t)(tk * 64) * N + tn * 64; lds_ = N; dst = Wt + (size_t)(tn * 64) * K + tk * 64; ldd = K;
  } else {
    const int j = t - 2 * 2768, tt = j & 3, kvh = (j >> 2) & 1, l = (j >> 3) & 1, b = j >> 4;
    src = p.cache_v + ((size_t)(b * 2 + l) * 256 + tt * 64) * 128 + kvh * 64; lds_ = 128;
    dst = p.vt_lat + ((size_t)((l * 8 + b) * 2 + kvh) * 64) * 1280 + tt * 64; ldd = 1280;
  }
}

DEV int tr_map(int list, int idx) {
  if (list == 0) return idx < 448 ? idx : (idx < 464 ? 2752 + (idx - 448) : (idx < 480 ? 5520 + (idx - 464) : 5536 + (idx - 480)));
  return idx < 2304 ? 448 + idx : 2768 + (idx - 2304);
}
DEV void transpose_all(const Params& p, char* smem, int list, int hb, int nhb) {
  const int NTR = list == 0 ? 608 : 5056;
  float* T = (float*)smem;
  const int tid = VTID, kr = tid >> 4, n4 = (tid & 15) * 4;
  int t = hb;
  if (t >= NTR) return;
  const float* src; bf16_t* dst; int lds_, ldd;
  tr_desc(p, tr_map(list, t), src, lds_, dst, ldd);
  float4 cur[4];
#pragma unroll
  for (int i = 0; i < 4; ++i) cur[i] = *(const float4*)(src + (size_t)(kr + 16 * i) * lds_ + n4);
  while (t < NTR) {
    const int tn = t + nhb;
    const float* nsrc = src; bf16_t* ndst = dst; int nlds = lds_, nldd = ldd;
    float4 nxt[4];
    if (tn < NTR) {
      tr_desc(p, tr_map(list, tn), nsrc, nlds, ndst, nldd);
#pragma unroll
      for (int i = 0; i < 4; ++i) nxt[i] = *(const float4*)(nsrc + (size_t)(kr + 16 * i) * nlds + n4);
    }
#pragma unroll
    for (int i = 0; i < 4; ++i) {
      const int k = kr + 16 * i;
      T[k * 65 + n4 + 0] = cur[i].x; T[k * 65 + n4 + 1] = cur[i].y; T[k * 65 + n4 + 2] = cur[i].z; T[k * 65 + n4 + 3] = cur[i].w;
    }
    __syncthreads();
#pragma unroll
    for (int i = 0; i < 2; ++i) {
      const int n = (tid >> 3) + 32 * i, k8 = (tid & 7) * 8;
      U8 o;
#pragma unroll
      for (int j = 0; j < 4; ++j) o.w[j] = pack2(T[(k8 + 2 * j) * 65 + n], T[(k8 + 2 * j + 1) * 65 + n]);
      *(uint4*)(dst + (size_t)n * ldd + k8) = o.u;
    }
    __syncthreads();
    if (tn < NTR) {
#pragma unroll
      for (int i = 0; i < 4; ++i) cur[i] = nxt[i];
    }
    src = nsrc; dst = ndst; lds_ = nlds; ldd = nldd; t = tn;
  }
}

DEV void phase0(const Params& p, char* smem) {
  const int tid = VTID;
  const int NT0 = 192 - 128, NITEMS = 192 + 64 + 2;
  for (int it = VBID; it < NITEMS; it += VNB) {
    if (it < 192) {
      const int l = it / 96, n0 = (it % 96) * 64;
      float* s = (float*)smem;
      float* red = s + 9 * 1024;
      for (int idx = tid; idx < 9 * 1024; idx += 256) {
        int c = idx >> 10, k = idx & 1023;
        float v = (c == 0) ? p.c_ctx[k] : p.c[(c - 1) * 1024 + k];
        s[idx] = v / (1.f + __expf(-v));
      }
      __syncthreads();
      const int w = tid >> 6, lane = tid & 63, cq = lane & 15, ks = lane >> 4;
      const int kbase = (w * 4 + ks) * 64;
      float acc[9][4];
#pragma unroll
      for (int c = 0; c < 9; ++c) { acc[c][0] = 0.f; acc[c][1] = 0.f; acc[c][2] = 0.f; acc[c][3] = 0.f; }
      const float* wp = p.w_ada + ((size_t)l * 1024 + kbase) * 6144 + n0 + cq * 4;
      for (int kb = 0; kb < 64; kb += 16) {
        float4 wv[16];
#pragma unroll
        for (int j = 0; j < 16; ++j) wv[j] = *(const float4*)(wp + (size_t)(kb + j) * 6144);
#pragma unroll
        for (int j = 0; j < 16; ++j)
#pragma unroll
          for (int c = 0; c < 9; ++c) {
            const float sv = s[c * 1024 + kbase + kb + j];
            acc[c][0] += sv * wv[j].x; acc[c][1] += sv * wv[j].y; acc[c][2] += sv * wv[j].z; acc[c][3] += sv * wv[j].w;
          }
      }
#pragma unroll
      for (int c = 0; c < 9; ++c)
#pragma unroll
        for (int e = 0; e < 4; ++e) {
          float a = acc[c][e];
          a += __shfl_xor(a, 16); a += __shfl_xor(a, 32);
          if (ks == 0) red[(w * 9 + c) * 64 + cq * 4 + e] = a;
        }
      __syncthreads();
      for (int idx = tid; idx < 576; idx += 256) {
        int c = idx >> 6, nn = idx & 63;
        float v = red[(0 * 9 + c) * 64 + nn] + red[(1 * 9 + c) * 64 + nn] + red[(2 * 9 + c) * 64 + nn] + red[(3 * 9 + c) * 64 + nn] +
                  p.b_ada[l * 6144 + n0 + nn];
        p.mod[((size_t)l * 9 + c) * 6144 + n0 + nn] = v;
      }
      __syncthreads();
    } else if (it >= NT0 + 128 && it < NT0 + 192) {
      const int j = it - NT0 - 128;
#pragma unroll
      for (int i = 0; i < 4; ++i) {
        const int e = (j * 1024 + i * 256 + tid) * 8;
        const int d = e & 63, kvh = (e >> 6) & 1, t = (e >> 7) & 255, l = (e >> 15) & 1, b = e >> 16;
        const float4 a0 = *(const float4*)(p.cache_k + e), a1 = *(const float4*)(p.cache_k + e + 4);
        U8 o; o.w[0] = pack2(a0.x, a0.y); o.w[1] = pack2(a0.z, a0.w); o.w[2] = pack2(a1.x, a1.y); o.w[3] = pack2(a1.z, a1.w);
        *(uint4*)(p.kb_lat + ((size_t)((l * 8 + b) * 2 + kvh) * 1280 + t) * 64 + d) = o.u;
      }
    } else if (it >= NT0 + 192) {
      if (it == NT0 + 192)
      for (int idx = tid; idx < 1024; idx += 256) {
        int pp = idx >> 4, f = idx & 15;
        float inv = powf(10000.f, -(float)f / 16.f);
        float ang = (float)pp * inv;
        float nrev = rintf(ang * 0.15915494309189535f);
        float r = fmaf(-nrev, 6.28125f, ang);
        r = fmaf(-nrev, 0.0019353071795864769f, r);
        p.rope[idx * 2 + 0] = __cosf(r);
        p.rope[idx * 2 + 1] = __sinf(r);
      }
      if (it == NT0 + 192)
      for (int idx = tid; idx < 1024; idx += 256) {
        const float xn = -p.lru_lam[idx];
        p.cdec[idx] = -8.f * (fmaxf(xn, 0.f) + log1pf(expf(-fabsf(xn))));
      }
    }
  }
  transpose_all(p, smem, 0, VBID, VNB);
}

DEV void ln_mod_phase(const Params& p, int l, int mode, int team_base = -1) {
  int tz = 0; asm volatile("" : "+v"(tz));
  const int lane = (threadIdx.x + tz) & 63, w = threadIdx.x >> 6;
  const float* lg = nullptr; const float* lb = nullptr;
  if (mode == 1) { lg = p.ln2_g + (l - 1) * 1024; lb = p.ln2_b + (l - 1) * 1024; }
  else if (mode == 2) { lg = p.ln1_g + l * 1024; lb = p.ln1_b + l * 1024; }
  else if (mode == 3) { lg = p.ln2_g + l * 1024; lb = p.ln2_b + l * 1024; }
  const int shoff = (mode == 2) ? 3072 : 0;
  const int mstride = gridDim.x * 8;
  float4 nv[4];
#define LNM_ROW(vm_) (team_base >= 0 ? team_base + w + 8 * ((vm_) >> 11) : xrow(vm_))
  {
    const int m = LNM_ROW(blockIdx.x * 8 + w);
    const float* src = (mode == 0) ? ((m < 8192) ? p.x_prompt + (size_t)m * 1024 : p.x_sample + (size_t)(m - 8192) * 1024) : p.out + (size_t)m * 1024;
#pragma unroll
    for (int i = 0; i < 4; ++i) nv[i] = *(const float4*)(src + i * 256 + lane * 4);
  }
  for (int vm = blockIdx.x * 8 + w; vm < MT; vm += mstride) {
    const int m = LNM_ROW(vm);
    float4 v[4];
#pragma unroll
    for (int i = 0; i < 4; ++i) v[i] = nv[i];
    {
      const int mn = LNM_ROW((vm + mstride < MT) ? vm + mstride : vm);
      const float* src = (mode == 0) ? ((mn < 8192) ? p.x_prompt + (size_t)mn * 1024 : p.x_sample + (size_t)(mn - 8192) * 1024) : p.out + (size_t)mn * 1024;
#pragma unroll
      for (int i = 0; i < 4; ++i) nv[i] = *(const float4*)(src + i * 256 + lane * 4);
    }
    if (mode != 0) {
      float s = 0.f;
#pragma unroll
      for (int i = 0; i < 4; ++i) s += v[i].x + v[i].y + v[i].z + v[i].w;
      const float mean = wave_sum(s) * (1.f / 1024.f);
      float s2 = 0.f;
#pragma unroll
      for (int i = 0; i < 4; ++i) { float a = v[i].x - mean, b = v[i].y - mean, c = v[i].z - mean, d = v[i].w - mean; s2 += a * a + b * b + c * c + d * d; }
      const float rstd = rsqrtf(wave_sum(s2) * (1.f / 1024.f) + 1e-6f);
#pragma unroll
      for (int i = 0; i < 4; ++i) {
        float4 g = *(const float4*)(lg + i * 256 + lane * 4), b = *(const float4*)(lb + i * 256 + lane * 4);
        v[i].x = (v[i].x - mean) * rstd * g.x + b.x; v[i].y = (v[i].y - mean) * rstd * g.y + b.y;
        v[i].z = (v[i].z - mean) * rstd * g.z + b.z; v[i].w = (v[i].w - mean) * rstd * g.w + b.w;
        if (mode == 3) *(float4*)(p.out + (size_t)m * 1024 + i * 256 + lane * 4) = v[i];
      }
      if (mode != 3 && lane == 0) *(float2*)(p.rstat + (size_t)m * 2) = make_float2(mean, rstd);
    }
    if (mode != 3) {
      const float* md = p.mod + ((size_t)l * 9 + cond_of(m)) * 6144 + shoff;
#pragma unroll
      for (int i = 0; i < 4; ++i) {
        float4 sh = *(const float4*)(md + i * 256 + lane * 4), sc = *(const float4*)(md + 1024 + i * 256 + lane * 4);
        uint2 o;
        o.x = pack2(v[i].x * (1.f + sc.x) + sh.x, v[i].y * (1.f + sc.y) + sh.y);
        o.y = pack2(v[i].z * (1.f + sc.z) + sh.z, v[i].w * (1.f + sc.w) + sh.w);
        *(uint2*)(p.abuf + (size_t)m * 1024 + i * 256 + lane * 4) = o;
      }
    }
  }
}

#define LAS3 __attribute__((address_space(3)))
namespace g8 {
constexpr int BM = 256, BK = 64, HALF = 128, HTB = HALF * BK * 2, NXCD = 8, WGM = 4;
DEV int lds_byte(int r, int c) { const int st = (r >> 4) * 2 + (c >> 5), rr = r & 15, cc = c & 31, ob = rr * 64 + cc * 2; return st * 1024 + (ob ^ (((ob >> 9) & 1) << 5)); }
DEV void stage_rc(int b, int& R, int& C) { const int st = b / 1024, sb = b % 1024, swz = sb ^ (((sb >> 9) & 1) << 5); R = (st >> 1) * 16 + swz / 64; C = (st & 1) * 32 + (swz % 64) / 2; }
DEV bool unit_of(int i, int nM, int nN, int& pm, int& pn) {
  const int nwg = nM * nN;
  const long L = (long)i * gridDim.x + blockIdx.x; if (L >= nwg) return false;
  int wgid = (int)L; { const int q = nwg / NXCD, r = nwg % NXCD, xcd = wgid % NXCD, off = wgid / NXCD; wgid = (xcd < r ? xcd * (q + 1) : r * (q + 1) + (xcd - r) * q) + off; }
  const int nig = WGM * nN, gid = wgid / nig, fm = gid * WGM, gsz = (nM - fm) < WGM ? (nM - fm) : WGM;
  pm = own_panel(fm + ((wgid % nig) % gsz)); pn = (wgid % nig) / gsz; return true;
}
}

template <int EPI>
DEV void gemm_epilogue(const Params& p, int l, f32x4 (&acc)[2][2][4][2], int pm, int pn, int wr, int wc, int fr, int fq) {
  const int brow = pm * 256, bcol = pn * 256;
  const float* md = p.mod + ((size_t)l * 9 + cond_of(brow)) * 6144;
#pragma unroll
  for (int bj = 0; bj < 2; ++bj)
#pragma unroll
    for (int n = 0; n < 2; ++n) {
      const int col = bcol + bj * 128 + wc * 32 + n * 16 + fq * 4;
      float4 gate = make_float4(0.f, 0.f, 0.f, 0.f), bias = make_float4(0.f, 0.f, 0.f, 0.f);
      if (EPI == 2) gate = *(const float4*)(md + 2048 + col);
      if (EPI == 3) bias = *(const float4*)(p.b_ff1 + l * 4096 + col);
      if (EPI == 4) { gate = *(const float4*)(md + 5120 + col); bias = *(const float4*)(p.b_ff2 + l * 1024 + col); }
#pragma unroll
      for (int ai = 0; ai < 2; ++ai)
#pragma unroll
        for (int m = 0; m < 4; ++m) {
          const int row = brow + ai * 128 + wr * 64 + m * 16 + fr;
          const f32x4 v = acc[ai][bj][m][n];
          if (EPI == 1) {
            uint2 o; o.x = pack2(v[0], v[1]); o.y = pack2(v[2], v[3]);
            *(uint2*)(p.zf + (size_t)row * 1792 + col) = o;
          } else if (EPI == 2) {
            const float* xs = (l == 0) ? ((row < 8192) ? p.x_prompt + (size_t)row * 1024 : p.x_sample + (size_t)(row - 8192) * 1024) : p.out + (size_t)row * 1024;
            const float4 x = *(const float4*)(xs + col);
            *(float4*)(p.out + (size_t)row * 1024 + col) = make_float4(ALPHA * x.x + gate.x * v[0], ALPHA * x.y + gate.y * v[1], ALPHA * x.z + gate.z * v[2], ALPHA * x.w + gate.w * v[3]);
          } else if (EPI == 3) {
            const float t0 = fmaxf(v[0] + bias.x, 0.f), t1 = fmaxf(v[1] + bias.y, 0.f), t2 = fmaxf(v[2] + bias.z, 0.f), t3 = fmaxf(v[3] + bias.w, 0.f);
            uint2 o; o.x = pack2(t0 * t0, t1 * t1); o.y = pack2(t2 * t2, t3 * t3);
            *(uint2*)(p.zf + (size_t)row * 4096 + col) = o;
          } else {
            float* xo = p.out + (size_t)row * 1024 + col;
            const float4 x = *(const float4*)xo;
            *(float4*)xo = make_float4(ALPHA * x.x + gate.x * (v[0] + bias.x), ALPHA * x.y + gate.y * (v[1] + bias.y), ALPHA * x.z + gate.z * (v[2] + bias.z), ALPHA * x.w + gate.w * (v[3] + bias.w));
          }
        }
    }
}

template <int EPI>
DEV void gemm_epilogue_lnres(const Params& p, int l, f32x4 (&acc)[2][2][4][2], int pm, int pn, int wr, int wc, int fr, int fq) {
  const int brow = pm * 256, bcol = pn * 256;
  const float* md = p.mod + ((size_t)l * 9 + cond_of(brow)) * 6144;
  float mean[2][4], rstd[2][4];
  {
    const unsigned so = (unsigned)(brow + wr * 64 + fr) * 2u;
#pragma unroll
    for (int ai = 0; ai < 2; ++ai)
#pragma unroll
      for (int m = 0; m < 4; ++m) { const float2 t = *(const float2*)(p.rstat + (so + (unsigned)((ai * 128 + m * 16) * 2))); mean[ai][m] = t.x; rstd[ai][m] = t.y; }
  }
  const float* lg = (EPI == 2) ? p.ln2_g + (l - 1) * 1024 : p.ln1_g + l * 1024;
  const float* lb = (EPI == 2) ? p.ln2_b + (l - 1) * 1024 : p.ln1_b + l * 1024;
  const unsigned co = (unsigned)(bcol + wc * 32 + fq * 4);
  const unsigned ro = (unsigned)(brow + wr * 64 + fr) * 1024u + co;
#pragma unroll
  for (int bj = 0; bj < 2; ++bj)
#pragma unroll
    for (int n = 0; n < 2; ++n) {
      unsigned col = co + (unsigned)(bj * 128 + n * 16), rb = ro + (unsigned)(bj * 128 + n * 16);
      asm volatile("" : "+v"(col), "+v"(rb));
      float4 gate, bias = make_float4(0.f, 0.f, 0.f, 0.f);
      if (EPI == 2) gate = *(const float4*)(md + 2048 + col);
      else { gate = *(const float4*)(md + 5120 + col); bias = *(const float4*)(p.b_ff2 + l * 1024 + col); }
      const float4 g4 = *(const float4*)(lg + col), b4 = *(const float4*)(lb + col);
#pragma unroll
      for (int ai = 0; ai < 2; ++ai)
#pragma unroll
        for (int m = 0; m < 4; ++m) {
          float* xo = p.out + (rb + (unsigned)((ai * 128 + m * 16) * 1024));
          const float4 x = *(const float4*)xo;
          const float mu = mean[ai][m], rr = rstd[ai][m];
          const f32x4 v = acc[ai][bj][m][n];
          const float x0 = (x.x - mu) * rr * g4.x + b4.x, x1 = (x.y - mu) * rr * g4.y + b4.y, x2 = (x.z - mu) * rr * g4.z + b4.z, x3 = (x.w - mu) * rr * g4.w + b4.w;
          *(float4*)xo = make_float4(ALPHA * x0 + gate.x * (v[0] + bias.x), ALPHA * x1 + gate.y * (v[1] + bias.y), ALPHA * x2 + gate.z * (v[2] + bias.z), ALPHA * x3 + gate.w * (v[3] + bias.w));
        }
    }
}

template <int EPI>
DEV void gemm_phase(const Params& p, int l, const bf16_t* Ag, const bf16_t* Btg, int N, int K, LAS3 unsigned char* lds, int tpm = -1, int tq = 0) {
#define UNIT_OF(i_, pm_, pn_) (tpm >= 0 ? ((pm_) = tpm, (pn_) = tq + 4 * (i_), (pn_) < nN) : unit_of(i_, nM, nN, pm_, pn_))
  using namespace g8;
  int tz = 0; asm volatile("" : "+v"(tz));
  const int tid = threadIdx.x + tz, wid = __builtin_amdgcn_readfirstlane(tid >> 6), lane = tid & 63, wr = wid >> 2, wc = wid & 3, fr = lane & 15, fq = lane >> 4;
  const int nt = K / BK, nM = MT / BM, nN = N / BM;
  unsigned voff[2];
#pragma unroll
  for (int i = 0; i < 2; ++i) { int R, C; stage_rc(tid * 16 + i * 8192, R, C); voff[i] = (unsigned)(R * K + C) * 2u; }
  const size_t kstep = (size_t)(BK * 2);
  const size_t hstep = (size_t)HALF * K * 2;
  const size_t tstep = 2 * hstep;
  const unsigned ldsw = (unsigned)wid * 1024u;
  const int aoff = lds_byte(wr * 64 + fr, fq * 8), boff = lds_byte(wc * 32 + fr, fq * 8);
#define PG8_SA(b, h) (((b) * 2 + (h)) * HTB)
#define PG8_SB(b, h) ((4 + (b) * 2 + (h)) * HTB)
#define PG8_STAGE(bufoff, gbase) do { _Pragma("unroll") for (int _i = 0; _i < 2; ++_i) \
    __builtin_amdgcn_global_load_lds((const unsigned*)((const char*)(gbase) + voff[_i]), (LAS3 unsigned*)(lds + (bufoff) + ldsw + _i * 8192), 16, 0, 0); } while (0)
#define PG8_LDA(dst, b, h) do { _Pragma("unroll") for (int m = 0; m < 4; ++m) _Pragma("unroll") for (int k = 0; k < 2; ++k) dst[m][k] = *(const LAS3 bf16x8*)(lds + PG8_SA(b, h) + aoff + m * 2048 + k * 1024); } while (0)
#define PG8_LDB(dst, b, h) do { _Pragma("unroll") for (int n = 0; n < 2; ++n) _Pragma("unroll") for (int k = 0; k < 2; ++k) dst[n][k] = *(const LAS3 bf16x8*)(lds + PG8_SB(b, h) + boff + n * 2048 + k * 1024); } while (0)
#define PG8_MMA(ai, bj, At_, Bt_) do { __builtin_amdgcn_s_setprio(1); _Pragma("unroll") for (int m = 0; m < 4; ++m) _Pragma("unroll") for (int n = 0; n < 2; ++n) _Pragma("unroll") for (int k = 0; k < 2; ++k) \
    acc[ai][bj][m][n] = __builtin_amdgcn_mfma_f32_16x16x32_bf16(Bt_[n][k], At_[m][k], acc[ai][bj][m][n], 0, 0, 0); __builtin_amdgcn_s_setprio(0); } while (0)
#define PG8_WAIT_V(n) asm volatile("s_waitcnt vmcnt(" #n ")" ::: "memory")
#define PG8_WAIT_L(n) asm volatile("s_waitcnt lgkmcnt(" #n ")" ::: "memory")
#define PG8_BAR __builtin_amdgcn_s_barrier()
#define PG8_SCHED __builtin_amdgcn_sched_barrier(0)
  int cpm, cpn, npm = 0, npn = 0, ui = 0;
  if (!UNIT_OF(0, cpm, cpn)) return;
  f32x4 acc[2][2][4][2];
#pragma unroll
  for (int a = 0; a < 2; ++a)
#pragma unroll
    for (int b = 0; b < 2; ++b)
#pragma unroll
      for (int m = 0; m < 4; ++m)
#pragma unroll
        for (int n = 0; n < 2; ++n) acc[a][b][m][n] = (f32x4){0.f, 0.f, 0.f, 0.f};
  bf16x8 At[4][2], B0[2][2], B1[2][2];
  const char* cA = (const char*)Ag + (size_t)cpm * tstep; const char* cB = (const char*)Btg + (size_t)cpn * tstep;
  PG8_STAGE(PG8_SB(0, 0), cB); PG8_STAGE(PG8_SA(0, 0), cA); PG8_STAGE(PG8_SB(0, 1), cB + hstep); PG8_STAGE(PG8_SA(0, 1), cA + hstep);
  if (wr == 1) PG8_BAR;
  PG8_WAIT_V(4); PG8_BAR;
  PG8_STAGE(PG8_SB(1, 0), cB + kstep); PG8_STAGE(PG8_SA(1, 0), cA + kstep); PG8_STAGE(PG8_SB(1, 1), cB + hstep + kstep);
  PG8_WAIT_V(6); PG8_BAR;
  for (;;) {
    const bool has_next = UNIT_OF(ui + 1, npm, npn);
    const char* nA = has_next ? (const char*)Ag + (size_t)npm * tstep : cA; const char* nB = has_next ? (const char*)Btg + (size_t)npn * tstep : cB;
    for (int t = 0; t < nt; t += 2) {
      const bool last = (t == nt - 2);
      const char* a1 = cA + (size_t)(t + 1) * kstep;
      const char* a2 = last ? nA : cA + (size_t)(t + 2) * kstep; const char* b2 = last ? nB : cB + (size_t)(t + 2) * kstep;
      const char* a3 = a2 + kstep; const char* b3 = b2 + kstep;
      PG8_LDB(B0, 0, 0); PG8_SCHED; PG8_LDA(At, 0, 0); PG8_STAGE(PG8_SA(1, 1), a1 + hstep);
      PG8_WAIT_L(8); PG8_BAR; PG8_WAIT_L(0); PG8_MMA(0, 0, At, B0); PG8_BAR; PG8_SCHED;
      PG8_LDB(B1, 0, 1); PG8_STAGE(PG8_SB(0, 0), b2);
      PG8_BAR; PG8_WAIT_L(0); PG8_MMA(0, 1, At, B1); PG8_BAR;
      PG8_LDA(At, 0, 1); PG8_STAGE(PG8_SA(0, 0), a2);
      PG8_BAR; PG8_WAIT_L(0); PG8_MMA(1, 0, At, B0); PG8_BAR; PG8_SCHED;
      PG8_STAGE(PG8_SB(0, 1), b2 + hstep);
      PG8_WAIT_V(6); PG8_BAR; PG8_MMA(1, 1, At, B1); PG8_BAR;
      PG8_LDB(B0, 1, 0); PG8_SCHED; PG8_LDA(At, 1, 0); PG8_STAGE(PG8_SA(0, 1), a2 + hstep);
      PG8_WAIT_L(8); PG8_BAR; PG8_WAIT_L(0); PG8_MMA(0, 0, At, B0); PG8_BAR; PG8_SCHED;
      PG8_LDB(B1, 1, 1); PG8_STAGE(PG8_SB(1, 0), b3);
      PG8_BAR; PG8_WAIT_L(0); PG8_MMA(0, 1, At, B1); PG8_BAR;
      PG8_LDA(At, 1, 1); PG8_STAGE(PG8_SA(1, 0), a3);
      PG8_BAR; PG8_WAIT_L(0); PG8_MMA(1, 0, At, B0); PG8_BAR; PG8_SCHED;
      PG8_STAGE(PG8_SB(1, 1), b3 + hstep);
      PG8_WAIT_V(6); PG8_BAR; PG8_MMA(1, 1, At, B1); PG8_BAR;
    }
    if (EPI == 4 || (EPI == 2 && l > 0)) gemm_epilogue_lnres<EPI>(p, l, acc, cpm, cpn, wr, wc, fr, fq);
    else gemm_epilogue<EPI>(p, l, acc, cpm, cpn, wr, wc, fr, fq);
    if (!has_next) break;
#pragma unroll
    for (int a = 0; a < 2; ++a)
#pragma unroll
      for (int b = 0; b < 2; ++b)
#pragma unroll
        for (int m = 0; m < 4; ++m)
#pragma unroll
          for (int n = 0; n < 2; ++n) acc[a][b][m][n] = (f32x4){0.f, 0.f, 0.f, 0.f};
    cpm = npm; cpn = npn; cA = nA; cB = nB; ++ui;
  }
  PG8_WAIT_V(0);
  if (wr == 0) PG8_BAR;
  PG8_BAR;
#undef PG8_SA
#undef UNIT_OF
#undef PG8_SB
#undef PG8_STAGE
#undef PG8_LDA
#undef PG8_LDB
#undef PG8_MMA
#undef PG8_WAIT_V
#undef PG8_WAIT_L
#undef PG8_BAR
#undef PG8_SCHED
}

DEV void rope8(float (&v)[8], int d0, int prow, int pcol, const float* __restrict__ rope) {
  const int pp = (d0 < 32) ? prow : pcol;
#pragma unroll
  for (int i = 0; i < 4; ++i) {
    const int f = ((d0 >> 1) + i) & 15;
    const float cs = rope[(pp * 16 + f) * 2], sn = rope[(pp * 16 + f) * 2 + 1];
    const float x1 = v[2 * i], x2 = v[2 * i + 1];
    v[2 * i] = x1 * cs - x2 * sn; v[2 * i + 1] = x1 * sn + x2 * cs;
  }
}

DEV void prep_token_row(const Params& p, int l, int m, int lane, uint4 c) {
  bf16_t* zr = p.zf + (size_t)m * 1792;
  const bool lat = m >= 8192;
  const int pos = lat ? ((m - 8192) & 1023) : (m & 255);
  const int prow = pos >> 6, pcol = pos & 63;
  const int d0 = (lane & 7) * 8;
  U8 u; u.u = c;
  float v[8], gl[8]; float ss = 0.f, sg = 0.f;
#pragma unroll
  for (int j = 0; j < 8; ++j) { v[j] = bf2f(u.h[j]); ss += v[j] * v[j]; gl[j] = gelu_t(v[j]); sg += gl[j]; }
  ss += __shfl_xor(ss, 1); ss += __shfl_xor(ss, 2); ss += __shfl_xor(ss, 4);
#pragma unroll
  for (int o = 1; o <= 16; o <<= 1) sg += __shfl_xor(sg, o);
  const float mean = sg * (1.f / 256.f);
  float s2 = 0.f;
#pragma unroll
  for (int j = 0; j < 8; ++j) { const float d = gl[j] - mean; s2 += d * d; }
#pragma unroll
  for (int o = 1; o <= 16; o <<= 1) s2 += __shfl_xor(s2, o);
  if (lane < 16) {
    const float rinv = rsqrtf(ss * (1.f / 64.f) + 1e-6f);
#pragma unroll
    for (int j = 0; j < 8; ++j) v[j] = v[j] * rinv * p.k_g[l * 64 + d0 + j];
    if (!lat) {
      float* o = p.out + OFF_YK + ((((size_t)(m >> 8)) * 2 + l) * 256 + pos) * 128 + lane * 8;
      *(float4*)o = make_float4(v[0], v[1], v[2], v[3]); *(float4*)(o + 4) = make_float4(v[4], v[5], v[6], v[7]);
    } else rope8(v, d0, prow, pcol, p.rope);
#pragma unroll
    for (int j = 0; j < 4; ++j) u.w[j] = pack2(v[2 * j], v[2 * j + 1]);
    const int kvh = lane >> 3;
    bf16_t* kd = lat ? p.kb_lat + ((size_t)((l * 8 + ((m - 8192) >> 10)) * 2 + kvh) * 1280 + 256 + pos) * 64 + d0
                     : p.kb_ctx + ((size_t)((m >> 8) * 2 + kvh) * 256 + pos) * 64 + d0;
    *(uint4*)kd = u.u;
  } else if (lane < 32) {
    if (!lat) {
      float* o = p.out + OFF_YV + ((((size_t)(m >> 8)) * 2 + l) * 256 + pos) * 128 + (lane - 16) * 8;
      *(float4*)o = make_float4(v[0], v[1], v[2], v[3]); *(float4*)(o + 4) = make_float4(v[4], v[5], v[6], v[7]);
    }
    const int kvh = (lane - 16) >> 3;
    bf16_t* vd; int T;
    if (lat) { T = 1280; vd = p.vt_lat + ((size_t)((l * 8 + ((m - 8192) >> 10)) * 2 + kvh) * 64 + d0) * 1280 + 256 + pos; }
    else { T = 256; vd = p.vt_ctx + ((size_t)((m >> 8) * 2 + kvh) * 64 + d0) * 256 + pos; }
#pragma unroll
    for (int j = 0; j < 8; ++j) vd[(size_t)j * T] = u.h[j];
  } else {
    const float rstd = rsqrtf(s2 * (1.f / 256.f) + 1e-6f);
    const int ch = (lane - 32) * 8;
#pragma unroll
    for (int j = 0; j < 8; ++j) gl[j] = (gl[j] - mean) * rstd * p.mlp_g[l * 256 + ch + j] + p.mlp_b[l * 256 + ch + j];
#pragma unroll
    for (int j = 0; j < 4; ++j) u.w[j] = pack2(gl[2 * j], gl[2 * j + 1]);
    *(uint4*)(zr + 1536 + ch) = u.u;
  }
}

template <bool REV>
DEV void tile_scan(float (&a)[4][4], float (&u)[4][4], int lane) {
  const int q = lane >> 4;
  float C = 0.f, CP = 1.f;
  const int src1 = (REV ? lane + 16 : lane - 16) & 63;
  const int src2 = (REV ? lane + 32 : lane - 32) & 63;
  const int srcT = (lane & 15) + (REV ? 0 : 48);
  const bool c1 = REV ? (q <= 2) : (q >= 1);
  const bool c2 = REV ? (q <= 1) : (q >= 2);
  const bool first = REV ? (q == 3) : (q == 0);
#pragma unroll
  for (int mi = 0; mi < 4; ++mi) {
    const int mt = REV ? 3 - mi : mi;
    float P = 1.f, H = 0.f, pl[4], hl[4];
#pragma unroll
    for (int ri = 0; ri < 4; ++ri) {
      const int r = REV ? 3 - ri : ri;
      H = a[mt][r] * H + u[mt][r]; P *= a[mt][r]; pl[r] = P; hl[r] = H;
    }
    float Pi = P, Hi = H;
    float Pp = __shfl(Pi, src1), Hp = __shfl(Hi, src1);
    if (c1) { Hi = Pi * Hp + Hi; Pi = Pi * Pp; }
    Pp = __shfl(Pi, src2); Hp = __shfl(Hi, src2);
    if (c2) { Hi = Pi * Hp + Hi; Pi = Pi * Pp; }
    float Pe = __shfl(Pi, src1), He = __shfl(Hi, src1);
    if (first) { Pe = 1.f; He = 0.f; }
    const float hin = Pe * C + He, pin = Pe * CP;
#pragma unroll
    for (int r = 0; r < 4; ++r) { u[mt][r] = pl[r] * hin + hl[r]; a[mt][r] = pl[r] * pin; }
    const float Pt = __shfl(Pi, srcT), Ht = __shfl(Hi, srcT);
    C = Pt * C + Ht; CP = Pt * CP;
  }
}

DEV void lru_gate_item(const Params& p, int l, int item, char* smem) {
  const int tid = VTID, lane = tid & 63, w = tid >> 6;
  const int tile = item >> 2, blk = item & 3;
  const int m0 = tile * 64;
  int ms, L;
  if (m0 < 8192) { ms = m0 & ~255; L = 256; } else { ms = 8192 + ((m0 - 8192) & ~1023); L = 1024; }
  const int dir = w >> 1, half = w & 1, q = lane >> 4, c15 = lane & 15;
  const bf16_t* wt = p.wt_lru + (size_t)((((l * 2 + dir) * 4 + blk) * 2)) * 4096;
  bf16x8 bfr[2][2][2];
#pragma unroll
  for (int mat = 0; mat < 2; ++mat)
#pragma unroll
    for (int j = 0; j < 2; ++j)
#pragma unroll
      for (int s = 0; s < 2; ++s) bfr[mat][j][s] = *(const bf16x8*)(wt + mat * 4096 + (half * 32 + j * 16 + c15) * 64 + s * 32 + q * 8);
  float* xs = (float*)smem;
  float* xcf = xs + 67 * 64;
  bf16_t* xcb = (bf16_t*)(xcf + 64 * 64);
  for (int idx = tid; idx < 67 * 8; idx += 256) {
    const int rr = idx >> 3, cc = idx & 7;
    const int m = m0 - 1 + rr;
    float v[8];
    if (m >= ms && m < ms + L) {
      U8 u; u.u = *(const uint4*)(p.zf + (size_t)m * 1792 + 768 + blk * 64 + cc * 8);
#pragma unroll
      for (int j = 0; j < 8; ++j) v[j] = bf2f(u.h[j]);
    } else {
#pragma unroll
      for (int j = 0; j < 8; ++j) v[j] = 0.f;
    }
#pragma unroll
    for (int j = 0; j < 8; ++j) xs[rr * 64 + cc * 8 + j] = v[j];
  }
  __syncthreads();
  {
    const int ch = tid & 63, Cg = blk * 64 + ch;
    const float w0 = p.conv_w[(l * 4 + 0) * 256 + Cg], w1 = p.conv_w[(l * 4 + 1) * 256 + Cg], w2 = p.conv_w[(l * 4 + 2) * 256 + Cg],
                w3 = p.conv_w[(l * 4 + 3) * 256 + Cg], cb = p.conv_b[l * 256 + Cg];
#pragma unroll 4
    for (int tt = 0; tt < 16; ++tt) {
      const int t = (tid >> 6) * 16 + tt;
      const float v = cb + w0 * xs[t * 64 + ch] + w1 * xs[(t + 1) * 64 + ch] + w2 * xs[(t + 2) * 64 + ch] + w3 * xs[(t + 3) * 64 + ch];
      xcf[t * 64 + ch] = v; xcb[t * 72 + ch] = f2bf(v);
    }
  }
  __syncthreads();
  f32x4 acc[2][4][2];
#pragma unroll
  for (int mat = 0; mat < 2; ++mat)
#pragma unroll
    for (int mt = 0; mt < 4; ++mt)
#pragma unroll
      for (int j = 0; j < 2; ++j) acc[mat][mt][j] = f32x4{0.f, 0.f, 0.f, 0.f};
#pragma unroll
  for (int mt = 0; mt < 4; ++mt)
#pragma unroll
    for (int s = 0; s < 2; ++s) {
      const bf16x8 af = *(const bf16x8*)(xcb + (mt * 16 + c15) * 72 + s * 32 + q * 8);
#pragma unroll
      for (int mat = 0; mat < 2; ++mat)
#pragma unroll
        for (int j = 0; j < 2; ++j) acc[mat][mt][j] = mfma16(af, bfr[mat][j][s], acc[mat][mt][j]);
    }
  float* PCp = p.au + (size_t)(dir * 2 + 0) * MT * 256;
  float* HLp = p.au + (size_t)(dir * 2 + 1) * MT * 256;
#pragma unroll
  for (int j = 0; j < 2; ++j) {
    const int ch = half * 32 + j * 16 + c15, Cg = blk * 64 + ch, pidx = (l * 2 + dir) * 256 + Cg;
    const float ba = p.lru_ba[pidx], bx = p.lru_bx[pidx];
    const float cdec = p.cdec[pidx];
    float a[4][4], u[4][4];
#pragma unroll
    for (int mt = 0; mt < 4; ++mt)
#pragma unroll
      for (int r = 0; r < 4; ++r) {
        const int t = mt * 16 + q * 4 + r;
        const float rg = sigmoidf_(acc[0][mt][j][r] + ba), ig = sigmoidf_(acc[1][mt][j][r] + bx);
        const float la = cdec * rg;
        a[mt][r] = __expf(la);
        const float x2 = 2.f * la;
        const float em = (x2 < -0.25f) ? 1.f - __expf(x2) : -x2 * (1.f + x2 * (0.5f + x2 * (1.f / 6.f + x2 * (1.f / 24.f + x2 * (1.f / 120.f + x2 * (1.f / 720.f))))));
        u[mt][r] = __builtin_amdgcn_sqrtf(em) * ig * xcf[t * 64 + ch];
      }
    if (dir == 0) tile_scan<false>(a, u, lane); else tile_scan<true>(a, u, lane);
#pragma unroll
    for (int mt = 0; mt < 4; ++mt)
#pragma unroll
      for (int r = 0; r < 4; ++r) {
        const size_t m = m0 + mt * 16 + q * 4 + r;
        PCp[m * 256 + Cg] = a[mt][r]; HLp[m * 256 + Cg] = u[mt][r];
      }
  }
  __syncthreads();
}

DEV void attn_item(const Params& p, int l, int it, char* sm) {
  const int tid = threadIdx.x, lane = tid & 63, w = tid >> 6, q = lane >> 4, c15 = lane & 15;
  const int qg = w >> 1, kh = w & 1;
  int h, ms, nkt, T; const bf16_t* Kg; const bf16_t* Vg;
  if (it < 512) {
    const int b = it >> 6, qb = it & 7; h = (it >> 3) & 7; ms = 8192 + b * 1024 + qb * 128; nkt = 10; T = 1280;
    Kg = p.kb_lat + (size_t)((l * 8 + b) * 2 + (h >> 2)) * 1280 * 64; Vg = p.vt_lat + (size_t)((l * 8 + b) * 2 + (h >> 2)) * 64 * 1280;
  } else {
    const int i2 = it - 512, b = i2 >> 4, qb = i2 & 1; h = (i2 >> 1) & 7; ms = b * 256 + qb * 128; nkt = 2; T = 256;
    Kg = p.kb_ctx + (size_t)(b * 2 + (h >> 2)) * 256 * 64; Vg = p.vt_ctx + (size_t)(b * 2 + (h >> 2)) * 64 * 256;
  }
  const int kc0 = tid, kc1 = tid + 512;
  const int vd0 = tid >> 4, vk = (tid & 15) * 8;
  const int vpos = ((tid & 15) >> 2) * 32 + 16 * (tid & 1) + 4 * ((tid & 3) >> 1);
  const bf16_t* vg0 = Vg + (size_t)vd0 * T + vk;
  const bf16_t* vg1 = Vg + (size_t)(vd0 + 32) * T + vk;
  uint4 rk0, rk1, rv0, rv1;
#define ATT_LOAD(kt) do { rk0 = *(const uint4*)(Kg + (size_t)(kt) * 8192 + kc0 * 8); rk1 = *(const uint4*)(Kg + (size_t)(kt) * 8192 + kc1 * 8); \
    rv0 = *(const uint4*)(vg0 + (kt) * 128); rv1 = *(const uint4*)(vg1 + (kt) * 128); } while (0)
#define ATT_STORE(buf) do { bf16_t* Ks_ = (bf16_t*)(sm + (buf) * 36864); bf16_t* Vs_ = Ks_ + 9216; \
    *(uint4*)(Ks_ + (kc0 >> 3) * 72 + (kc0 & 7) * 8) = rk0; *(uint4*)(Ks_ + (kc1 >> 3) * 72 + (kc1 & 7) * 8) = rk1; \
    *(uint2*)(Vs_ + vd0 * 136 + vpos) = make_uint2(rv0.x, rv0.y); *(uint2*)(Vs_ + vd0 * 136 + vpos + 8) = make_uint2(rv0.z, rv0.w); \
    *(uint2*)(Vs_ + (vd0 + 32) * 136 + vpos) = make_uint2(rv1.x, rv1.y); *(uint2*)(Vs_ + (vd0 + 32) * 136 + vpos + 8) = make_uint2(rv1.z, rv1.w); } while (0)
  ATT_LOAD(0);
  const int mq = ms + qg * 32;
  bf16x8 qf[2][2];
#pragma unroll
  for (int t = 0; t < 2; ++t)
#pragma unroll
    for (int s = 0; s < 2; ++s) qf[t][s] = *(const bf16x8*)(p.zf + (size_t)(mq + t * 16 + c15) * 1792 + h * 64 + s * 32 + q * 8);
  ATT_STORE(0);
  if (nkt > 1) ATT_LOAD(1);
#pragma unroll
  for (int t = 0; t < 2; ++t) {
    float f[2][8]; float ss = 0.f;
#pragma unroll
    for (int s = 0; s < 2; ++s)
#pragma unroll
      for (int j = 0; j < 8; ++j) { f[s][j] = bf2f((bf16_t)qf[t][s][j]); ss += f[s][j] * f[s][j]; }
    ss += __shfl_xor(ss, 16); ss += __shfl_xor(ss, 32);
    const float rinv = rsqrtf(ss * (1.f / 64.f) + 1e-6f);
    const int mrow_ = mq + t * 16 + c15;
    const int pos = (mrow_ - 8192) & 1023;
#pragma unroll
    for (int s = 0; s < 2; ++s) {
      const int dd = s * 32 + q * 8;
#pragma unroll
      for (int j = 0; j < 8; ++j) f[s][j] = f[s][j] * rinv * p.q_g[l * 64 + dd + j];
      if (it < 512) rope8(f[s], dd, pos >> 6, pos & 63, p.rope);
      U8 pk;
#pragma unroll
      for (int j = 0; j < 4; ++j) pk.w[j] = pack2(f[s][2 * j] * QSCALE, f[s][2 * j + 1] * QSCALE);
      qf[t][s] = pk.v;
    }
  }
  __syncthreads();
  f32x4 o[2][4];
  float mrow[2], lrow[2];
#pragma unroll
  for (int t = 0; t < 2; ++t) { mrow[t] = -1e30f; lrow[t] = 0.f;
#pragma unroll
    for (int j = 0; j < 4; ++j) o[t][j] = f32x4{0.f, 0.f, 0.f, 0.f}; }
  for (int kt = 0; kt < nkt; ++kt) {
    const int cur = kt & 1;
    const bf16_t* Ks = (const bf16_t*)(sm + cur * 36864) + kh * 64 * 72;
    const bf16_t* Vs = (const bf16_t*)(sm + cur * 36864) + 9216 + kh * 64;
    f32x4 s4[2][4];
    {
      bf16x8 kf[4][2];
#pragma unroll
      for (int jn = 0; jn < 4; ++jn)
#pragma unroll
        for (int s = 0; s < 2; ++s) kf[jn][s] = *(const bf16x8*)(Ks + (jn * 16 + c15) * 72 + s * 32 + q * 8);
      __builtin_amdgcn_sched_barrier(0);
#pragma unroll
      for (int jn = 0; jn < 4; ++jn)
#pragma unroll
        for (int t = 0; t < 2; ++t) s4[t][jn] = mfma16(kf[jn][0], qf[t][0], f32x4{0.f, 0.f, 0.f, 0.f});
#pragma unroll
      for (int jn = 0; jn < 4; ++jn)
#pragma unroll
        for (int t = 0; t < 2; ++t) s4[t][jn] = mfma16(kf[jn][1], qf[t][1], s4[t][jn]);
      __builtin_amdgcn_sched_barrier(0);
    }
    U8 vf[4][2];
#pragma unroll
    for (int jn = 0; jn < 4; ++jn)
#pragma unroll
      for (int ks = 0; ks < 2; ++ks) vf[jn][ks].u = *(const uint4*)(Vs + (jn * 16 + c15) * 136 + ks * 32 + q * 8);
    __builtin_amdgcn_sched_barrier(0);
    U8 pb[2][2];
#pragma unroll
    for (int t = 0; t < 2; ++t) {
      float mx = s4[t][0][0];
#pragma unroll
      for (int jn = 0; jn < 4; ++jn)
#pragma unroll
        for (int r = 0; r < 4; ++r) mx = fmaxf(mx, s4[t][jn][r]);
      mx = fmaxf(mx, __shfl_xor(mx, 16)); mx = fmaxf(mx, __shfl_xor(mx, 32));
      const float mnew = fmaxf(mrow[t], mx);
      const float alpha = __builtin_amdgcn_exp2f(mrow[t] - mnew);
      mrow[t] = mnew;
      float ls = 0.f;
#pragma unroll
      for (int jn = 0; jn < 4; ++jn)
#pragma unroll
        for (int r = 0; r < 4; ++r) { const float pv = __builtin_amdgcn_exp2f(s4[t][jn][r] - mnew); s4[t][jn][r] = pv; ls += pv; }
      lrow[t] = lrow[t] * alpha + ls;
#pragma unroll
      for (int jn = 0; jn < 4; ++jn) { o[t][jn][0] *= alpha; o[t][jn][1] *= alpha; o[t][jn][2] *= alpha; o[t][jn][3] *= alpha; }
#pragma unroll
      for (int ks = 0; ks < 2; ++ks) {
        pb[t][ks].w[0] = pack2(s4[t][2 * ks][0], s4[t][2 * ks][1]); pb[t][ks].w[1] = pack2(s4[t][2 * ks][2], s4[t][2 * ks][3]);
        pb[t][ks].w[2] = pack2(s4[t][2 * ks + 1][0], s4[t][2 * ks + 1][1]); pb[t][ks].w[3] = pack2(s4[t][2 * ks + 1][2], s4[t][2 * ks + 1][3]);
      }
    }
#pragma unroll
    for (int ks = 0; ks < 2; ++ks)
#pragma unroll
      for (int jn = 0; jn < 4; ++jn)
#pragma unroll
        for (int t = 0; t < 2; ++t) o[t][jn] = mfma16(vf[jn][ks].v, pb[t][ks].v, o[t][jn]);
    if (kt + 1 < nkt) {
      ATT_STORE(cur ^ 1);
      if (kt + 2 < nkt) ATT_LOAD(kt + 2);
    }
    __syncthreads();
  }
#undef ATT_LOAD
#undef ATT_STORE
  float* mrg = (float*)(sm + 73728) + (size_t)(qg * 64 + lane) * 37;
  float lt[2];
#pragma unroll
  for (int t = 0; t < 2; ++t) { float a = lrow[t]; a += __shfl_xor(a, 16); a += __shfl_xor(a, 32); lt[t] = a; }
  if (kh == 1) {
#pragma unroll
    for (int t = 0; t < 2; ++t) {
      mrg[t * 18 + 0] = mrow[t]; mrg[t * 18 + 1] = lt[t];
#pragma unroll
      for (int jn = 0; jn < 4; ++jn)
#pragma unroll
        for (int r = 0; r < 4; ++r) mrg[t * 18 + 2 + jn * 4 + r] = o[t][jn][r];
    }
  }
  __syncthreads();
  if (kh == 0) {
#pragma unroll
    for (int t = 0; t < 2; ++t) {
      const float m1 = mrg[t * 18 + 0], l1 = mrg[t * 18 + 1];
      const float mm = fmaxf(mrow[t], m1);
      const float a0 = __builtin_amdgcn_exp2f(mrow[t] - mm), a1 = __builtin_amdgcn_exp2f(m1 - mm);
      const float inv = 1.f / (a0 * lt[t] + a1 * l1);
      const float c0 = a0 * inv, c1 = a1 * inv;
      bf16_t* orow = p.abuf + (size_t)(mq + t * 16 + c15) * 1024 + h * 64 + q * 4;
#pragma unroll
      for (int jn = 0; jn < 4; ++jn) {
        const float x0 = c0 * o[t][jn][0] + c1 * mrg[t * 18 + 2 + jn * 4 + 0], x1 = c0 * o[t][jn][1] + c1 * mrg[t * 18 + 2 + jn * 4 + 1];
        const float x2 = c0 * o[t][jn][2] + c1 * mrg[t * 18 + 2 + jn * 4 + 2], x3 = c0 * o[t][jn][3] + c1 * mrg[t * 18 + 2 + jn * 4 + 3];
        uint2 ov; ov.x = pack2(x0, x1); ov.y = pack2(x2, x3);
        *(uint2*)(orow + jn * 16) = ov;
      }
    }
  }
  __syncthreads();
}

DEV void gmlp_item(const Params& p, int l, int it, char* smem) {
  const int tid = VTID, lane = tid & 63, w = tid >> 6, q = lane >> 4, c15 = lane & 15;
  const int chunk = it >> 2, g = it & 3, m0 = chunk * 128;
  bf16_t* vt = (bf16_t*)smem;
  const float* wsg = p.mlp_ws + (size_t)(l * 4 + g) * 16384;
  float4 wa[2][4][2];
#pragma unroll
  for (int nt = 0; nt < 2; ++nt)
#pragma unroll
    for (int s = 0; s < 4; ++s) {
      const float* ap = wsg + ((2 * w + nt) * 16 + c15) * 128 + s * 32 + q * 8;
      wa[nt][s][0] = *(const float4*)ap; wa[nt][s][1] = *(const float4*)(ap + 4);
    }
  uint4 vin[4];
#pragma unroll
  for (int i = 0; i < 4; ++i) { const int id = tid + 256 * i; vin[i] = *(const uint4*)(p.zf + (size_t)(m0 + (id >> 3)) * 1792 + 1536 + g * 64 + (id & 7) * 8); }
#pragma unroll
  for (int i = 0; i < 4; ++i) {
    const int id = tid + 256 * i, qq = id >> 3, cc = id & 7;
    U8 v; v.u = vin[i];
#pragma unroll
    for (int j = 0; j < 8; ++j) vt[(cc * 8 + j) * 136 + qq] = v.h[j];
  }
  __syncthreads();
  f32x4 acc[4][2];
#pragma unroll
  for (int mt = 0; mt < 4; ++mt)
#pragma unroll
    for (int nt = 0; nt < 2; ++nt) acc[mt][nt] = f32x4{0.f, 0.f, 0.f, 0.f};
#pragma unroll
  for (int s = 0; s < 4; ++s) {
    bf16x8 af[4];
#pragma unroll
    for (int mt = 0; mt < 4; ++mt) af[mt] = *(const bf16x8*)(vt + (mt * 16 + c15) * 136 + s * 32 + q * 8);
#pragma unroll
    for (int nt = 0; nt < 2; ++nt) {
      U8 bb;
      bb.w[0] = pack2(wa[nt][s][0].x, wa[nt][s][0].y); bb.w[1] = pack2(wa[nt][s][0].z, wa[nt][s][0].w);
      bb.w[2] = pack2(wa[nt][s][1].x, wa[nt][s][1].y); bb.w[3] = pack2(wa[nt][s][1].z, wa[nt][s][1].w);
#pragma unroll
      for (int mt = 0; mt < 4; ++mt) acc[mt][nt] = mfma16(af[mt], bb.v, acc[mt][nt]);
    }
  }
#pragma unroll
  for (int nt = 0; nt < 2; ++nt) {
    const int pp = (2 * w + nt) * 16 + c15;
    const size_t m = m0 + pp;
    const float bsv = p.mlp_bs[(l * 4 + g) * 128 + pp];
#pragma unroll
    for (int mt = 0; mt < 4; ++mt) {
      const int c = mt * 16 + q * 4;
      const uint2 uu = *(const uint2*)(p.zf + m * 1792 + 1280 + g * 64 + c);
      const float u0 = gelu_t(__uint_as_float(uu.x << 16)), u1 = gelu_t(__uint_as_float(uu.x & 0xffff0000u)), u2 = gelu_t(__uint_as_float(uu.y << 16)), u3 = gelu_t(__uint_as_float(uu.y & 0xffff0000u));
      uint2 o; o.x = pack2(u0 * (acc[mt][nt][0] + bsv), u1 * (acc[mt][nt][1] + bsv)); o.y = pack2(u2 * (acc[mt][nt][2] + bsv), u3 * (acc[mt][nt][3] + bsv));
      *(uint2*)(p.abuf + m * 1024 + 768 + g * 64 + c) = o;
    }
  }
  __syncthreads();
}

DEV void lru_apply_item(const Params& p, int l, int ti2) {
  const int C = VTID;
  const int ti = ti2 >> 1, th = (ti2 & 1) * 32;
  const int m0 = ti * 64;
  int ms, L, b; bool lat = m0 >= 8192;
  if (!lat) { ms = m0 & ~255; L = 256; b = m0 >> 8; } else { ms = 8192 + ((m0 - 8192) & ~1023); L = 1024; b = (m0 - 8192) >> 10; }
  const int k = (m0 - ms) >> 6, nt = L >> 6;
  const float* PCf = p.au; const float* HLf = p.au + (size_t)MT * 256;
  const float* PCb = p.au + (size_t)2 * MT * 256; const float* HLb = p.au + (size_t)3 * MT * 256;
  float cf = lat ? p.state_lru[((size_t)(b * 2 + l) * 2 + 0) * 256 + C] : 0.f;
  float cb = lat ? p.state_lru[((size_t)(b * 2 + l) * 2 + 1) * 256 + C] : 0.f;
  {
    float pc[15], hl[15];
#pragma unroll
    for (int i = 0; i < 15; ++i) {
      const bool act = i < k;
      const size_t e = (size_t)(ms + 64 * i + 63) * 256 + C;
      pc[i] = act ? PCf[e] : 1.f; hl[i] = act ? HLf[e] : 0.f;
    }
#pragma unroll
    for (int i = 0; i < 15; ++i) cf = pc[i] * cf + hl[i];
  }
  {
    float pc[15], hl[15];
#pragma unroll
    for (int i = 0; i < 15; ++i) {
      const int tix = nt - 1 - i;
      const bool act = tix > k;
      const size_t e = (size_t)(ms + 64 * tix) * 256 + C;
      pc[i] = act ? PCb[e] : 1.f; hl[i] = act ? HLb[e] : 0.f;
    }
#pragma unroll
    for (int i = 0; i < 15; ++i) cb = pc[i] * cb + hl[i];
  }
  float hf_last = 0.f, hb_first = 0.f;
#pragma unroll 16
  for (int t = th; t < th + 32; ++t) {
    const size_t m = m0 + t;
    const float hf = PCf[m * 256 + C] * cf + HLf[m * 256 + C];
    const float hb = PCb[m * 256 + C] * cb + HLb[m * 256 + C];
    const float g = gelu_t(bf2f(p.zf[m * 1792 + 1024 + C]));
    p.abuf[m * 1024 + 512 + C] = f2bf((hf + hb) * g);
    if (t == 0) hb_first = hb;
    if (t == 63) hf_last = hf;
  }
  if (!lat) {
    if (k == nt - 1 && th == 32) p.out[OFF_ST + ((size_t)(b * 2 + l) * 2 + 0) * 256 + C] = hf_last;
    if (k == 0 && th == 0) p.out[OFF_ST + ((size_t)(b * 2 + l) * 2 + 1) * 256 + C] = hb_first;
  }
}

DEV void mixer_phase(const Params& p, int l, char* smem_raw, char* smem) {
  {
    const int x = blockIdx.x & 7, j = blockIdx.x >> 3;
#pragma unroll 1
    for (int k = 0; k < 4; ++k) attn_item(p, l, ((k >> 1) << 9) + 64 * x + j + 32 * (k & 1), smem_raw);
  }
  {
    const int x = blockIdx.x & 7, lh = (blockIdx.x >> 3) * 2 + (threadIdx.x >> 8);
    lru_apply_item(p, l, (own_row(x, (lh >> 1) * 64) >> 6) * 2 + (lh & 1));
    gmlp_item(p, l, (own_row(x, (lh >> 2) * 128) >> 7) * 4 + (lh & 3), smem);
  }
}

DEV void prep_phase_full(const Params& p, int l, char* smem) {
  {
    const int xcd = blockIdx.x & 7, lh = (blockIdx.x >> 3) * 2 + (threadIdx.x >> 8);
#pragma unroll 1
    for (int k = 0; k < 2; ++k) { const int li = lh + 64 * k; lru_gate_item(p, l, (own_row(xcd, (li >> 2) * 64) >> 6) * 4 + (li & 3), smem); }
  }
  const int lane = threadIdx.x & 63, mstride = gridDim.x * 8;
  int vm = blockIdx.x * 8 + (threadIdx.x >> 6);
  const int coff = lane < 32 ? 512 + lane * 8 : 1536 + (lane - 32) * 8;
  uint4 n1 = *(const uint4*)(p.zf + (size_t)xrow(vm) * 1792 + coff);
  uint4 n2 = *(const uint4*)(p.zf + (size_t)xrow((vm + mstride < MT) ? vm + mstride : vm) * 1792 + coff);
  for (; vm < MT; vm += mstride) {
    const uint4 c = n1; n1 = n2;
    const int mn = xrow((vm + 2 * mstride < MT) ? vm + 2 * mstride : vm);
    n2 = *(const uint4*)(p.zf + (size_t)mn * 1792 + coff);
    prep_token_row(p, l, xrow(vm), lane, c);
  }
}


#define XB_TMO      128
#define XB_XCNT(j)  (256  + 64 * (j))
#define XB_XSUB(j)  (1280 + 64 * (j))
#define XB_XGEN(j)  (2304 + 64 * (j))
#define XB_TOP      3328
#define XB_TOPGEN   3392
#define XCD_BAR_WORDS 3456
#define XB_SPIN_CAP (1u << 18)
#define LAS __attribute__((address_space(3)))
DEV unsigned xb_ld(unsigned* p) { return __hip_atomic_load(p, __ATOMIC_RELAXED, __HIP_MEMORY_SCOPE_AGENT); }
DEV unsigned xb_add(unsigned* p, unsigned v) { return __hip_atomic_fetch_add(p, v, __ATOMIC_RELAXED, __HIP_MEMORY_SCOPE_AGENT); }
DEV unsigned xb_xcc_id() { return (unsigned)__builtin_amdgcn_s_getreg((3 << 11) | 20) & 0xFu; }
#define XB_SPIN(cond, bar) do { unsigned _sp = 0; while (cond) { __builtin_amdgcn_s_sleep(1); \
    if ((++_sp & 255u) == 0u) { if (xb_ld(&(bar)[XB_TMO])) break; if (_sp > XB_SPIN_CAP) { atomicAdd(&(bar)[XB_TMO], 1u); break; } } } } while (0)
struct XcdBarrier { unsigned* bar; unsigned x; volatile LAS unsigned* st; };
DEV XcdBarrier xcd_barrier_post(unsigned* bar, volatile LAS unsigned* st) {
  XcdBarrier b; b.bar = bar; b.x = xb_xcc_id(); b.st = st;
  if (threadIdx.x == 0) (void)xb_add(&bar[XB_XCNT(b.x)], 1u);
  return b;
}
DEV void xcd_barrier_complete(unsigned* bar, unsigned x, unsigned& nloc, unsigned& nx) {
  const unsigned G = gridDim.x * gridDim.y * gridDim.z;
  unsigned sum, cnt, mine, sp = 0u;
  for (;;) {
    sum = 0u; cnt = 0u; mine = 0u;
#pragma unroll
    for (unsigned j = 0; j < 16; ++j) { const unsigned c = xb_ld(&bar[XB_XCNT(j)]); sum += c; cnt += (c > 0u) ? 1u : 0u; mine = (j == x) ? c : mine; }
    if (sum == G) break;
    __builtin_amdgcn_s_sleep(1);
    if ((++sp & 255u) == 0u) { if (xb_ld(&bar[XB_TMO])) break; if (sp > XB_SPIN_CAP) { atomicAdd(&bar[XB_TMO], 1u); break; } }
  }
  nloc = mine > 0u ? mine : 1u; nx = cnt > 0u ? cnt : 1u;
}
DEV void xcd_barrier(const XcdBarrier& b) {
  asm volatile("s_waitcnt vmcnt(0)" ::: "memory");
  __syncthreads();
  if (threadIdx.x == 0) {
    unsigned* bar = b.bar;
    __builtin_amdgcn_s_waitcnt(0);
    unsigned nloc = b.st[0], nx = b.st[1];
    if (nloc == 0u) { xcd_barrier_complete(bar, b.x, nloc, nx); b.st[0] = nloc; b.st[1] = nx; }
    const unsigned old = xb_add(&bar[XB_XSUB(b.x)], 1u);
    const unsigned gen = old / nloc;
    if (old + 1u == (gen + 1u) * nloc) {
      __builtin_amdgcn_fence(__ATOMIC_RELEASE, "agent");
      asm volatile("s_waitcnt vmcnt(0)" ::: "memory");
      const unsigned og = xb_add(&bar[XB_TOP], 1u);
      const unsigned tg = og / nx;
      if (og + 1u == (tg + 1u) * nx) xb_add(&bar[XB_TOPGEN], 1u);
      else XB_SPIN(xb_ld(&bar[XB_TOPGEN]) == tg, bar);
      __builtin_amdgcn_fence(__ATOMIC_ACQUIRE, "agent");
      xb_add(&bar[XB_XGEN(b.x)], 1u);
      asm volatile("s_waitcnt vmcnt(0)" ::: "memory");
    } else {
      XB_SPIN(xb_ld(&bar[XB_XGEN(b.x)]) == gen, bar);
      __builtin_amdgcn_fence(__ATOMIC_ACQUIRE, "agent");
      asm volatile("s_waitcnt vmcnt(0)" ::: "memory");
    }
  }
  __syncthreads();
}

#define XB_MISMATCH 160
#define XB_WREADY 192
DEV void xcd_barrier_local(const XcdBarrier& b) {
  asm volatile("s_waitcnt vmcnt(0)" ::: "memory");
  __syncthreads();
  if (threadIdx.x == 0) {
    unsigned* bar = b.bar;
    __builtin_amdgcn_s_waitcnt(0);
    const unsigned nloc = b.st[0];
    const unsigned old = xb_add(&bar[XB_XSUB(b.x)], 1u);
    const unsigned gen = old / nloc;
    if (old + 1u == (gen + 1u) * nloc) xb_add(&bar[XB_XGEN(b.x)], 1u);
    else XB_SPIN(xb_ld(&bar[XB_XGEN(b.x)]) == gen, bar);
    __builtin_amdgcn_fence(__ATOMIC_ACQUIRE, "agent");
    asm volatile("s_waitcnt vmcnt(0)" ::: "memory");
  }
  __syncthreads();
}

#define XB_TEAM(pm) (3520 + 8 * (pm))
DEV void team_barrier(unsigned* bar, int pm, unsigned target) {
  asm volatile("s_waitcnt vmcnt(0)" ::: "memory");
  __syncthreads();
  if (threadIdx.x == 0) {
    __builtin_amdgcn_s_waitcnt(0);
    xb_add(&bar[XB_TEAM(pm)], 1u);
    XB_SPIN(xb_ld(&bar[XB_TEAM(pm)]) < target, bar);
    __builtin_amdgcn_fence(__ATOMIC_ACQUIRE, "agent");
    asm volatile("s_waitcnt vmcnt(0)" ::: "memory");
  }
  __syncthreads();
}
DEV void team_chain(const Params& p, int l, LAS3 unsigned char* lds) {
  int pm, pn;
  if (!g8::unit_of(0, MT / 256, 4, pm, pn)) return;
  const unsigned r = 5u * (unsigned)l;
  const int base = pm * 256 + pn * 64;
  team_barrier(p.bar, pm, 4u * (r + 1u)); ln_mod_phase(p, l, 2, base);
  team_barrier(p.bar, pm, 4u * (r + 2u)); gemm_phase<3>(p, l, p.abuf, p.wt_ff1 + (size_t)l * 4096 * 1024, 4096, 1024, lds, pm, pn);
  team_barrier(p.bar, pm, 4u * (r + 3u)); gemm_phase<4>(p, l, p.zf, p.wt_ff2 + (size_t)l * 1024 * 4096, 1024, 4096, lds, pm, pn);
  team_barrier(p.bar, pm, 4u * (r + 4u)); ln_mod_phase(p, 1, l == 0 ? 1 : 3, base);
  if (l == 0) { team_barrier(p.bar, pm, 4u * (r + 5u)); gemm_phase<1>(p, 1, p.abuf, p.wt_in + (size_t)1792 * 1024, 1792, 1024, lds, pm, pn); }
}

#define PH(i, call) if (ph_lo <= (i) && (i) < ph_hi) { if ((i) > ph_lo) { if ((i) >= 2 && xcd_local) xcd_barrier_local(xb); else xcd_barrier(xb); } call; }
#define LAYER_REST(l, b) \
  if (!(xcd_local && l == 1)) { PH(b + 1, gemm_phase<1>(p, l, p.abuf, p.wt_in + (size_t)l * 1792 * 1024, 1792, 1024, (LAS3 unsigned char*)smem_raw)) } \
  PH(b + 2, prep_phase_full(p, l, smem)) \
  PH(b + 3, mixer_phase(p, l, smem_raw, smem)) \
  PH(b + 4, if (l == 0 && xcd_local) { if (threadIdx.x == 0) { XB_SPIN(xb_ld(&p.bar[XB_WREADY]) < 128u, p.bar); __builtin_amdgcn_fence(__ATOMIC_ACQUIRE, "agent"); asm volatile("s_waitcnt vmcnt(0)" ::: "memory"); } __syncthreads(); } \
            gemm_phase<2>(p, l, p.abuf, p.wt_out + (size_t)l * 1024 * 1024, 1024, 1024, (LAS3 unsigned char*)smem_raw); \
            if (xcd_local) team_chain(p, l, (LAS3 unsigned char*)smem_raw)) \
  if (!xcd_local) { \
    PH(b + 5, ln_mod_phase(p, l, 2)) \
    PH(b + 6, gemm_phase<3>(p, l, p.abuf, p.wt_ff1 + (size_t)l * 4096 * 1024, 4096, 1024, (LAS3 unsigned char*)smem_raw)) \
    PH(b + 7, gemm_phase<4>(p, l, p.zf, p.wt_ff2 + (size_t)l * 1024 * 4096, 1024, 4096, (LAS3 unsigned char*)smem_raw)) }

__global__ void __launch_bounds__(512, 2) mega_kernel(Params p, int ph_lo, int ph_hi) {
  extern __shared__ __attribute__((aligned(16))) char smem_raw[];
  char* smem = smem_raw + (threadIdx.x >> 8) * 65536;
  __shared__ uint4 xb_words;
  if (threadIdx.x == 0) xb_words = make_uint4(0u, 0u, 0u, 0u);
  __syncthreads();
  XcdBarrier xb = xcd_barrier_post(p.bar, (volatile LAS unsigned*)&xb_words);
  if (threadIdx.x == 0) atomicOr(&p.bar[XB_MISMATCH + (blockIdx.x & 7u)], 1u << xb.x);
  if (ph_hi > 1000) { cg::grid_group grid = cg::this_grid(); grid.sync(); }
  bool xcd_local = false;
  PH(0, phase0(p, smem))
  PH(1, { unsigned all = 0u; bool one = true;
          for (int c = 0; c < 8; ++c) { const unsigned m = xb_ld(&p.bar[XB_MISMATCH + c]); one = one && (__builtin_popcount(m) == 1); all |= m; }
          xcd_local = one && all == 0xFFu && gridDim.x == 256; }
        if (xcd_local) {
          if (blockIdx.x & 1u) {
            transpose_all(p, smem, 1, ((int)((blockIdx.x >> 1) & 3u) + 4 * (int)(blockIdx.x >> 3)) * 2 + (int)(threadIdx.x >> 8), 256);
            asm volatile("s_waitcnt vmcnt(0)" ::: "memory");
            __syncthreads();
            if (threadIdx.x == 0) { __builtin_amdgcn_fence(__ATOMIC_RELEASE, "agent"); asm volatile("s_waitcnt vmcnt(0)" ::: "memory"); xb_add(&p.bar[XB_WREADY], 1u); }
          }
        } else { transpose_all(p, smem, 1, VBID, VNB); xcd_barrier(xb); }
        ln_mod_phase(p, 0, 0))
#undef LAYER0_P1
  LAYER_REST(0, 1)
  if (!xcd_local) { PH(9, ln_mod_phase(p, 1, 1)) }
  LAYER_REST(1, 9)
  if (!xcd_local) { PH(17, ln_mod_phase(p, 1, 3)) }
}

extern "C" void kernel_launch(void* const* d_in, const int* in_sizes, int n_in, void* d_out, int out_size, void* d_ws, size_t ws_size,
                              hipStream_t stream) {
  static int grid_blocks = 0;
  if (!grid_blocks) {
    int dev = 0, cus = 0, per_cu = 0;
    hipGetDevice(&dev);
    hipDeviceGetAttribute(&cus, hipDeviceAttributeMultiprocessorCount, dev);
    hipFuncSetAttribute((const void*)mega_kernel, hipFuncAttributeMaxDynamicSharedMemorySize, SMEM_BYTES);
    hipOccupancyMaxActiveBlocksPerMultiprocessor(&per_cu, (const void*)mega_kernel, 512, SMEM_BYTES);
    if (per_cu < 1) per_cu = 1;
    if (per_cu > 1) per_cu = 1;
    grid_blocks = cus * per_cu;
  }
  Params p{};
  const float** pin = (const float**)&p;
  for (int i = 0; i < 32; ++i) pin[i] = (const float*)d_in[i];
  p.out = (float*)d_out;
  char* ws = (char*)d_ws;
  size_t off = 0;
  p.bar = (unsigned*)(ws + off); off += 16384;
  p.rstat = (float*)(ws + off); off += (size_t)MT * 2 * 4;
  p.kb_lat = (bf16_t*)(ws + off); off += (size_t)2 * 8 * 2 * 1280 * 64 * 2;
  p.vt_lat = (bf16_t*)(ws + off); off += (size_t)2 * 8 * 2 * 1280 * 64 * 2;
  p.kb_ctx = (bf16_t*)(ws + off); off += (size_t)32 * 2 * 256 * 64 * 2;
  p.vt_ctx = (bf16_t*)(ws + off); off += (size_t)32 * 2 * 256 * 64 * 2;
  p.wt_in = (bf16_t*)(ws + off); off += (size_t)2 * 1792 * 1024 * 2;
  p.wt_out = (bf16_t*)(ws + off); off += (size_t)2 * 1024 * 1024 * 2;
  p.wt_ff1 = (bf16_t*)(ws + off); off += (size_t)2 * 4096 * 1024 * 2;
  p.wt_ff2 = (bf16_t*)(ws + off); off += (size_t)2 * 4096 * 1024 * 2;
  p.wt_lru = (bf16_t*)(ws + off); off += (size_t)64 * 4096 * 2;
  p.mod = (float*)(ws + off); off += (size_t)2 * 9 * 6144 * 4;
  p.rope = (float*)(ws + off); off += (size_t)2048 * 4;
  p.cdec = (float*)(ws + off); off += (size_t)1024 * 4;
  p.abuf = (bf16_t*)(ws + off); off += (size_t)MT * 1024 * 2;
  p.zf = (bf16_t*)(ws + off);
  p.au = (float*)(ws + off + (size_t)MT * 1792 * 2);
  off += (size_t)MT * 4096 * 2;
  if (off > ws_size) { fprintf(stderr, "workspace too small: need %zu have %zu\n", off, ws_size); return; }
  (void)hipMemsetAsync(p.bar, 0, 16384, stream);
#if MULTI_LAUNCH
  for (int ph = 0; ph < NPHASE; ++ph) {
    hipLaunchKernelGGL(mega_kernel, dim3(grid_blocks), dim3(512), SMEM_BYTES, stream, p, ph, ph + 1);
  }
#else
  int lo = 0, hi = NPHASE;
  void* args[] = {&p, &lo, &hi};
  hipError_t e = hipLaunchCooperativeKernel((void*)mega_kernel, dim3(grid_blocks), dim3(512), args, SMEM_BYTES, stream);
  if (e != hipSuccess) fprintf(stderr, "cooperative launch failed: %s (grid %d)\n", hipGetErrorString(e), grid_blocks);
#endif
}
```

```cpp
#include <hip/hip_runtime.h>
#include <hip/hip_cooperative_groups.h>
#include <cstdio>
#include <cstdint>
namespace cg = cooperative_groups;

#ifndef MULTI_LAUNCH
#define MULTI_LAUNCH 0
#endif

typedef unsigned short bf16_t;
using bf16x8 = __attribute__((ext_vector_type(8))) short;
using f32x4 = __attribute__((ext_vector_type(4))) float;
#define DEV __device__ __forceinline__
#define VTID ((int)(threadIdx.x & 255))
#define VBID ((int)(blockIdx.x * 2 + (threadIdx.x >> 8)))
#define VNB ((int)(gridDim.x * 2))

constexpr int MT = 16384;
constexpr int NPHASE = 18;
constexpr size_t OFF_YK = 16777216, OFF_YV = OFF_YK + 2097152, OFF_ST = OFF_YV + 2097152;
constexpr float ALPHA = 1.41421356237f;
constexpr float QSCALE = 0.125f * 1.4426950408889634f;
constexpr int SMEM_BYTES = 131072;

struct Params {
  const float *x_prompt, *x_sample, *c, *cache_k, *cache_v, *state_lru, *c_ctx, *w_ada, *b_ada, *w_in,
      *q_g, *k_g, *conv_w, *conv_b, *lru_wa, *lru_ba, *lru_wx, *lru_bx, *lru_lam, *mlp_g, *mlp_b, *mlp_ws, *mlp_bs,
      *w_out, *ln1_g, *ln1_b, *w_ff1, *b_ff1, *w_ff2, *b_ff2, *ln2_g, *ln2_b;
  float* out;
  bf16_t *wt_in, *wt_out, *wt_ff1, *wt_ff2, *wt_lru;
  float *mod, *rope, *cdec;
  bf16_t *abuf;
  bf16_t *zf;
  float *au;
  bf16_t *kb_lat, *vt_lat;
  bf16_t *kb_ctx, *vt_ctx;
  unsigned *bar;
  float *rstat;
};

union U8 { uint4 u; bf16x8 v; bf16_t h[8]; unsigned w[4]; };

DEV float bf2f(bf16_t h) { return __uint_as_float(((unsigned)h) << 16); }
DEV bf16_t f2bf(float f) { unsigned u = __float_as_uint(f); u += 0x7fffu + ((u >> 16) & 1u); return (bf16_t)(u >> 16); }
DEV unsigned pack2(float a, float b) { unsigned r; asm volatile("v_cvt_pk_bf16_f32 %0, %1, %2" : "=v"(r) : "v"(a), "v"(b)); return r; }
DEV float gelu_t(float x) { float y = 0.7978845608028654f * (x + 0.044715f * x * x * x); float t = 1.f - 2.f * __builtin_amdgcn_rcpf(1.f + __expf(2.f * y)); return 0.5f * x * (1.f + t); }
DEV float sigmoidf_(float x) { return __builtin_amdgcn_rcpf(1.f + __expf(-x)); }
DEV int own_row(int x, int r) { return r < 1024 ? (x << 10) + r : 8192 + (x << 10) + (r - 1024); }
DEV int own_panel(int vp) { const int x = vp >> 3, lp = vp & 7; return lp < 4 ? 4 * x + lp : 32 + 4 * x + (lp - 4); }
DEV int xrow(int vm) { const int k = vm >> 11, c = (vm & 2047) >> 3, w = vm & 7; return own_row(c & 7, (k << 8) + ((c >> 3) << 3) + w); }
DEV int cond_of(int m) { return m < 8192 ? 0 : 1 + ((m - 8192) >> 10); }
DEV f32x4 mfma16(bf16x8 a, bf16x8 b, f32x4 c) { return __builtin_amdgcn_mfma_f32_16x16x32_bf16(a, b, c, 0, 0, 0); }
DEV float wave_sum(float v) {
#pragma unroll
  for (int o = 32; o >= 1; o >>= 1) v += __shfl_xor(v, o);
  return v;
}

DEV void transpose_tile(const float* __restrict__ src, bf16_t* __restrict__ dst, int lds_, int ldd, char* smem) {
  float* T = (float*)smem;
  const int tid = VTID;
#pragma unroll
  for (int i = 0; i < 4; ++i) {
    int k = (tid >> 4) + 16 * i, n4 = (tid & 15) * 4;
    float4 v = *(const float4*)(src + (size_t)k * lds_ + n4);
    T[k * 65 + n4 + 0] = v.x; T[k * 65 + n4 + 1] = v.y; T[k * 65 + n4 + 2] = v.z; T[k * 65 + n4 + 3] = v.w;
  }
  __syncthreads();
#pragma unroll
  for (int i = 0; i < 2; ++i) {
    int n = (tid >> 3) + 32 * i, k8 = (tid & 7) * 8;
    U8 o;
#pragma unroll
    for (int j = 0; j < 4; ++j) o.w[j] = pack2(T[(k8 + 2 * j) * 65 + n], T[(k8 + 2 * j + 1) * 65 + n]);
    *(uint4*)(dst + (size_t)n * ldd + k8) = o.u;
  }
  __syncthreads();
}
DEV void transpose_w(const float* __restrict__ W, bf16_t* __restrict__ Wt, int K, int N, int tk, int tn, char* smem) {
  transpose_tile(W + (size_t)(tk * 64) * N + tn * 64, Wt + (size_t)(tn * 64) * K + tk * 64, N, K, smem);
}

DEV void tr_desc(const Params& p, int t, const float*& src, int& lds_, bf16_t*& dst, int& ldd) {
  if (t < 2 * 2768) {
    const int l = t / 2768, r = t % 2768;
    const float* W; bf16_t* Wt; int K, N, tk, tn;
    if (r < 448) { W = p.w_in + (size_t)l * 1024 * 1792; Wt = p.wt_in + (size_t)l * 1792 * 1024; K = 1024; N = 1792; tk = r / 28; tn = r % 28; }
    else if (r < 704) { const int i = r - 448; W = p.w_out + (size_t)l * 1024 * 1024; Wt = p.wt_out + (size_t)l * 1024 * 1024; K = 1024; N = 1024; tk = i / 16; tn = i % 16; }
    else if (r < 1728) { const int i = r - 704; W = p.w_ff1 + (size_t)l * 1024 * 4096; Wt = p.wt_ff1 + (size_t)l * 4096 * 1024; K = 1024; N = 4096; tk = i / 64; tn = i % 64; }
    else if (r < 2752) { const int i = r - 1728; W = p.w_ff2 + (size_t)l * 4096 * 1024; Wt = p.wt_ff2 + (size_t)l * 1024 * 4096; K = 4096; N = 1024; tk = i / 16; tn = i % 16; }
    else {
      const int idx = r - 2752, dir = idx >> 3, blk = (idx >> 1) & 3, mat = idx & 1;
      src = (mat == 0 ? p.lru_wa : p.lru_wx) + (size_t)(((l * 2 + dir) * 4 + blk)) * 4096; lds_ = 64;
      dst = p.wt_lru + (size_t)((((l * 2 + dir) * 4 + blk) * 2 + mat)) * 4096; ldd = 64; return;
    }
    src = W + (size_t)(tk * 64) * N + tn * 64; lds_ = N; dst = Wt + (size_t)(tn * 64) * K + tk * 64; ldd = K;
  } else {
    const int j = t - 2 * 2768, tt = j & 3, kvh = (j >> 2) & 1, l = (j >> 3) & 1, b = j >> 4;
    src = p.cache_v + ((size_t)(b * 2 + l) * 256 + tt * 64) * 128 + kvh * 64; lds_ = 128;
    dst = p.vt_lat + ((size_t)((l * 8 + b) * 2 + kvh) * 64) * 1280 + tt * 64; ldd = 1280;
  }
}

DEV int tr_map(int list, int idx) {
  if (list == 0) return idx < 448 ? idx : (idx < 464 ? 2752 + (idx - 448) : (idx < 480 ? 5520 + (idx - 464) : 5536 + (idx - 480)));
  return idx < 2304 ? 448 + idx : 2768 + (idx - 2304);
}
DEV void transpose_all(const Params& p, char* smem, int list, int hb, int nhb) {
  const int NTR = list == 0 ? 608 : 5056;
  float* T = (float*)smem;
  const int tid = VTID, kr = tid >> 4, n4 = (tid & 15) * 4;
  int t = hb;
  if (t >= NTR) return;
  const float* src; bf16_t* dst; int lds_, ldd;
  tr_desc(p, tr_map(list, t), src, lds_, dst, ldd);
  float4 cur[4];
#pragma unroll
  for (int i = 0; i < 4; ++i) cur[i] = *(const float4*)(src + (size_t)(kr + 16 * i) * lds_ + n4);
  while (t < NTR) {
    const int tn = t + nhb;
    const float* nsrc = src; bf16_t* ndst = dst; int nlds = lds_, nldd = ldd;
    float4 nxt[4];
    if (tn < NTR) {
      tr_desc(p, tr_map(list, tn), nsrc, nlds, ndst, nldd);
#pragma unroll
      for (int i = 0; i < 4; ++i) nxt[i] = *(const float4*)(nsrc + (size_t)(kr + 16 * i) * nlds + n4);
    }
#pragma unroll
    for (int i = 0; i < 4; ++i) {
      const int k = kr + 16 * i;
      T[k * 65 + n4 + 0] = cur[i].x; T[k * 65 + n4 + 1] = cur[i].y; T[k * 65 + n4 + 2] = cur[i].z; T[k * 65 + n4 + 3] = cur[i].w;
    }
    __syncthreads();
#pragma unroll
    for (int i = 0; i < 2; ++i) {
      const int n = (tid >> 3) + 32 * i, k8 = (tid & 7) * 8;
      U8 o;
#pragma unroll
      for (int j = 0; j < 4; ++j) o.w[j] = pack2(T[(k8 + 2 * j) * 65 + n], T[(k8 + 2 * j + 1) * 65 + n]);
      *(uint4*)(dst + (size_t)n * ldd + k8) = o.u;
    }
    __syncthreads();
    if (tn < NTR) {
#pragma unroll
      for (int i = 0; i < 4; ++i) cur[i] = nxt[i];
    }
    src = nsrc; dst = ndst; lds_ = nlds; ldd = nldd; t = tn;
  }
}

DEV void phase0(const Params& p, char* smem) {
  const int tid = VTID;
  const int NT0 = 384 - 128, NITEMS = 384 + 64 + 2;
  for (int it = VBID; it < NITEMS; it += VNB) {
    if (it < 384) {
      const int l = it / 192, n0 = (it % 192) * 32;
      float* s = (float*)smem;
      float* red = s + 9 * 1024;
      for (int idx = tid; idx < 9 * 1024; idx += 256) {
        int c = idx >> 10, k = idx & 1023;
        float v = (c == 0) ? p.c_ctx[k] : p.c[(c - 1) * 1024 + k];
        s[idx] = v / (1.f + __expf(-v));
      }
      __syncthreads();
      const int w = tid >> 6, lane = tid & 63, cq = lane & 7, ks = lane >> 3;
      const int kbase = (w * 8 + ks) * 32;
      float acc[9][4];
#pragma unroll
      for (int c = 0; c < 9; ++c) { acc[c][0] = 0.f; acc[c][1] = 0.f; acc[c][2] = 0.f; acc[c][3] = 0.f; }
      const float* wp = p.w_ada + ((size_t)l * 1024 + kbase) * 6144 + n0 + cq * 4;
#pragma unroll 1
      for (int kb = 0; kb < 32; kb += 16) {
        float4 wv[16];
#pragma unroll
        for (int j = 0; j < 16; ++j) wv[j] = *(const float4*)(wp + (size_t)(kb + j) * 6144);
#pragma unroll
        for (int j = 0; j < 16; ++j)
#pragma unroll
          for (int c = 0; c < 9; ++c) {
            const float sv = s[c * 1024 + kbase + kb + j];
            acc[c][0] += sv * wv[j].x; acc[c][1] += sv * wv[j].y; acc[c][2] += sv * wv[j].z; acc[c][3] += sv * wv[j].w;
          }
      }
#pragma unroll
      for (int c = 0; c < 9; ++c)
#pragma unroll
        for (int e = 0; e < 4; ++e) {
          float a = acc[c][e];
          a += __shfl_xor(a, 8); a += __shfl_xor(a, 16); a += __shfl_xor(a, 32);
          if (ks == 0) red[(w * 9 + c) * 32 + cq * 4 + e] = a;
        }
      __syncthreads();
      for (int idx = tid; idx < 288; idx += 256) {
        int c = idx >> 5, nn = idx & 31;
        float v = red[(0 * 9 + c) * 32 + nn] + red[(1 * 9 + c) * 32 + nn] + red[(2 * 9 + c) * 32 + nn] + red[(3 * 9 + c) * 32 + nn] +
                  p.b_ada[l * 6144 + n0 + nn];
        p.mod[((size_t)l * 9 + c) * 6144 + n0 + nn] = v;
      }
      __syncthreads();
    } else if (it >= NT0 + 128 && it < NT0 + 192) {
      const int j = it - NT0 - 128;
#pragma unroll
      for (int i = 0; i < 4; ++i) {
        const int e = (j * 1024 + i * 256 + tid) * 8;
        const int d = e & 63, kvh = (e >> 6) & 1, t = (e >> 7) & 255, l = (e >> 15) & 1, b = e >> 16;
        const float4 a0 = *(const float4*)(p.cache_k + e), a1 = *(const float4*)(p.cache_k + e + 4);
        U8 o; o.w[0] = pack2(a0.x, a0.y); o.w[1] = pack2(a0.z, a0.w); o.w[2] = pack2(a1.x, a1.y); o.w[3] = pack2(a1.z, a1.w);
        *(uint4*)(p.kb_lat + ((size_t)((l * 8 + b) * 2 + kvh) * 1280 + t) * 64 + d) = o.u;
      }
    } else if (it >= NT0 + 192) {
      if (it == NT0 + 192)
      for (int idx = tid; idx < 1024; idx += 256) {
        int pp = idx >> 4, f = idx & 15;
        float inv = powf(10000.f, -(float)f / 16.f);
        float ang = (float)pp * inv;
        float nrev = rintf(ang * 0.15915494309189535f);
        float r = fmaf(-nrev, 6.28125f, ang);
        r = fmaf(-nrev, 0.0019353071795864769f, r);
        p.rope[idx * 2 + 0] = __cosf(r);
        p.rope[idx * 2 + 1] = __sinf(r);
      }
      if (it == NT0 + 192)
      for (int idx = tid; idx < 1024; idx += 256) {
        const float xn = -p.lru_lam[idx];
        p.cdec[idx] = -8.f * (fmaxf(xn, 0.f) + log1pf(expf(-fabsf(xn))));
      }
    }
  }
  transpose_all(p, smem, 0, VBID, VNB);
}

DEV void ln_mod_phase(const Params& p, int l, int mode, int team_base = -1) {
  int tz = 0; asm volatile("" : "+v"(tz));
  const int lane = (threadIdx.x + tz) & 63, w = threadIdx.x >> 6;
  const float* lg = nullptr; const float* lb = nullptr;
  if (mode == 1) { lg = p.ln2_g + (l - 1) * 1024; lb = p.ln2_b + (l - 1) * 1024; }
  else if (mode == 2) { lg = p.ln1_g + l * 1024; lb = p.ln1_b + l * 1024; }
  else if (mode == 3) { lg = p.ln2_g + l * 1024; lb = p.ln2_b + l * 1024; }
  const int shoff = (mode == 2) ? 3072 : 0;
  const int mstride = gridDim.x * 8;
  float4 nv[4];
#define LNM_ROW(vm_) (team_base >= 0 ? team_base + w + 8 * ((vm_) >> 11) : xrow(vm_))
  {
    const int m = LNM_ROW(blockIdx.x * 8 + w);
    const float* src = (mode == 0) ? ((m < 8192) ? p.x_prompt + (size_t)m * 1024 : p.x_sample + (size_t)(m - 8192) * 1024) : p.out + (size_t)m * 1024;
#pragma unroll
    for (int i = 0; i < 4; ++i) nv[i] = *(const float4*)(src + i * 256 + lane * 4);
  }
  for (int vm = blockIdx.x * 8 + w; vm < MT; vm += mstride) {
    const int m = LNM_ROW(vm);
    float4 v[4];
#pragma unroll
    for (int i = 0; i < 4; ++i) v[i] = nv[i];
    {
      const int mn = LNM_ROW((vm + mstride < MT) ? vm + mstride : vm);
      const float* src = (mode == 0) ? ((mn < 8192) ? p.x_prompt + (size_t)mn * 1024 : p.x_sample + (size_t)(mn - 8192) * 1024) : p.out + (size_t)mn * 1024;
#pragma unroll
      for (int i = 0; i < 4; ++i) nv[i] = *(const float4*)(src + i * 256 + lane * 4);
    }
    if (mode != 0) {
      float s = 0.f;
#pragma unroll
      for (int i = 0; i < 4; ++i) s += v[i].x + v[i].y + v[i].z + v[i].w;
      const float mean = wave_sum(s) * (1.f / 1024.f);
      float s2 = 0.f;
#pragma unroll
      for (int i = 0; i < 4; ++i) { float a = v[i].x - mean, b = v[i].y - mean, c = v[i].z - mean, d = v[i].w - mean; s2 += a * a + b * b + c * c + d * d; }
      const float rstd = rsqrtf(wave_sum(s2) * (1.f / 1024.f) + 1e-6f);
#pragma unroll
      for (int i = 0; i < 4; ++i) {
        float4 g = *(const float4*)(lg + i * 256 + lane * 4), b = *(const float4*)(lb + i * 256 + lane * 4);
        v[i].x = (v[i].x - mean) * rstd * g.x + b.x; v[i].y = (v[i].y - mean) * rstd * g.y + b.y;
        v[i].z = (v[i].z - mean) * rstd * g.z + b.z; v[i].w = (v[i].w - mean) * rstd * g.w + b.w;
        if (mode == 3) *(float4*)(p.out + (size_t)m * 1024 + i * 256 + lane * 4) = v[i];
      }
      if (mode != 3 && lane == 0) *(float2*)(p.rstat + (size_t)m * 2) = make_float2(mean, rstd);
    }
    if (mode != 3) {
      const float* md = p.mod + ((size_t)l * 9 + cond_of(m)) * 6144 + shoff;
#pragma unroll
      for (int i = 0; i < 4; ++i) {
        float4 sh = *(const float4*)(md + i * 256 + lane * 4), sc = *(const float4*)(md + 1024 + i * 256 + lane * 4);
        uint2 o;
        o.x = pack2(v[i].x * (1.f + sc.x) + sh.x, v[i].y * (1.f + sc.y) + sh.y);
        o.y = pack2(v[i].z * (1.f + sc.z) + sh.z, v[i].w * (1.f + sc.w) + sh.w);
        *(uint2*)(p.abuf + (size_t)m * 1024 + i * 256 + lane * 4) = o;
      }
    }
  }
}

#define LAS3 __attribute__((address_space(3)))
namespace g8 {
constexpr int BM = 256, BK = 64, HALF = 128, HTB = HALF * BK * 2, NXCD = 8, WGM = 4;
DEV int lds_byte(int r, int c) { const int st = (r >> 4) * 2 + (c >> 5), rr = r & 15, cc = c & 31, ob = rr * 64 + cc * 2; return st * 1024 + (ob ^ (((ob >> 9) & 1) << 5)); }
DEV void stage_rc(int b, int& R, int& C) { const int st = b / 1024, sb = b % 1024, swz = sb ^ (((sb >> 9) & 1) << 5); R = (st >> 1) * 16 + swz / 64; C = (st & 1) * 32 + (swz % 64) / 2; }
DEV bool unit_of(int i, int nM, int nN, int& pm, int& pn) {
  const int nwg = nM * nN;
  const long L = (long)i * gridDim.x + blockIdx.x; if (L >= nwg) return false;
  int wgid = (int)L; { const int q = nwg / NXCD, r = nwg % NXCD, xcd = wgid % NXCD, off = wgid / NXCD; wgid = (xcd < r ? xcd * (q + 1) : r * (q + 1) + (xcd - r) * q) + off; }
  const int nig = WGM * nN, gid = wgid / nig, fm = gid * WGM, gsz = (nM - fm) < WGM ? (nM - fm) : WGM;
  pm = own_panel(fm + ((wgid % nig) % gsz)); pn = (wgid % nig) / gsz; return true;
}
}

template <int EPI>
DEV void gemm_epilogue(const Params& p, int l, f32x4 (&acc)[2][2][4][2], int pm, int pn, int wr, int wc, int fr, int fq) {
  const int brow = pm * 256, bcol = pn * 256;
  const float* md = p.mod + ((size_t)l * 9 + cond_of(brow)) * 6144;
#pragma unroll
  for (int bj = 0; bj < 2; ++bj)
#pragma unroll
    for (int n = 0; n < 2; ++n) {
      const int col = bcol + bj * 128 + wc * 32 + n * 16 + fq * 4;
      float4 gate = make_float4(0.f, 0.f, 0.f, 0.f), bias = make_float4(0.f, 0.f, 0.f, 0.f);
      if (EPI == 2) gate = *(const float4*)(md + 2048 + col);
      if (EPI == 3) bias = *(const float4*)(p.b_ff1 + l * 4096 + col);
      if (EPI == 4) { gate = *(const float4*)(md + 5120 + col); bias = *(const float4*)(p.b_ff2 + l * 1024 + col); }
#pragma unroll
      for (int ai = 0; ai < 2; ++ai)
#pragma unroll
        for (int m = 0; m < 4; ++m) {
          const int row = brow + ai * 128 + wr * 64 + m * 16 + fr;
          const f32x4 v = acc[ai][bj][m][n];
          if (EPI == 1) {
            uint2 o; o.x = pack2(v[0], v[1]); o.y = pack2(v[2], v[3]);
            *(uint2*)(p.zf + (size_t)row * 1792 + col) = o;
          } else if (EPI == 2) {
            const float* xs = (l == 0) ? ((row < 8192) ? p.x_prompt + (size_t)row * 1024 : p.x_sample + (size_t)(row - 8192) * 1024) : p.out + (size_t)row * 1024;
            const float4 x = *(const float4*)(xs + col);
            *(float4*)(p.out + (size_t)row * 1024 + col) = make_float4(ALPHA * x.x + gate.x * v[0], ALPHA * x.y + gate.y * v[1], ALPHA * x.z + gate.z * v[2], ALPHA * x.w + gate.w * v[3]);
          } else if (EPI == 3) {
            const float t0 = fmaxf(v[0] + bias.x, 0.f), t1 = fmaxf(v[1] + bias.y, 0.f), t2 = fmaxf(v[2] + bias.z, 0.f), t3 = fmaxf(v[3] + bias.w, 0.f);
            uint2 o; o.x = pack2(t0 * t0, t1 * t1); o.y = pack2(t2 * t2, t3 * t3);
            *(uint2*)(p.zf + (size_t)row * 4096 + col) = o;
          } else {
            float* xo = p.out + (size_t)row * 1024 + col;
            const float4 x = *(const float4*)xo;
            *(float4*)xo = make_float4(ALPHA * x.x + gate.x * (v[0] + bias.x), ALPHA * x.y + gate.y * (v[1] + bias.y), ALPHA * x.z + gate.z * (v[2] + bias.z), ALPHA * x.w + gate.w * (v[3] + bias.w));
          }
        }
    }
}

template <int EPI>
DEV void gemm_epilogue_lnres(const Params& p, int l, f32x4 (&acc)[2][2][4][2], int pm, int pn, int wr, int wc, int fr, int fq) {
  const int brow = pm * 256, bcol = pn * 256;
  const float* md = p.mod + ((size_t)l * 9 + cond_of(brow)) * 6144;
  float mean[2][4], rstd[2][4];
  {
    const unsigned so = (unsigned)(brow + wr * 64 + fr) * 2u;
#pragma unroll
    for (int ai = 0; ai < 2; ++ai)
#pragma unroll
      for (int m = 0; m < 4; ++m) { const float2 t = *(const float2*)(p.rstat + (so + (unsigned)((ai * 128 + m * 16) * 2))); mean[ai][m] = t.x; rstd[ai][m] = t.y; }
  }
  const float* lg = (EPI == 2) ? p.ln2_g + (l - 1) * 1024 : p.ln1_g + l * 1024;
  const float* lb = (EPI == 2) ? p.ln2_b + (l - 1) * 1024 : p.ln1_b + l * 1024;
  const unsigned co = (unsigned)(bcol + wc * 32 + fq * 4);
  const unsigned ro = (unsigned)(brow + wr * 64 + fr) * 1024u + co;
#pragma unroll
  for (int bj = 0; bj < 2; ++bj)
#pragma unroll
    for (int n = 0; n < 2; ++n) {
      unsigned col = co + (unsigned)(bj * 128 + n * 16), rb = ro + (unsigned)(bj * 128 + n * 16);
      asm volatile("" : "+v"(col), "+v"(rb));
      float4 gate, bias = make_float4(0.f, 0.f, 0.f, 0.f);
      if (EPI == 2) gate = *(const float4*)(md + 2048 + col);
      else { gate = *(const float4*)(md + 5120 + col); bias = *(const float4*)(p.b_ff2 + l * 1024 + col); }
      const float4 g4 = *(const float4*)(lg + col), b4 = *(const float4*)(lb + col);
#pragma unroll
      for (int ai = 0; ai < 2; ++ai)
#pragma unroll
        for (int m = 0; m < 4; ++m) {
          float* xo = p.out + (rb + (unsigned)((ai * 128 + m * 16) * 1024));
          const float4 x = *(const float4*)xo;
          const float mu = mean[ai][m], rr = rstd[ai][m];
          const f32x4 v = acc[ai][bj][m][n];
          const float x0 = (x.x - mu) * rr * g4.x + b4.x, x1 = (x.y - mu) * rr * g4.y + b4.y, x2 = (x.z - mu) * rr * g4.z + b4.z, x3 = (x.w - mu) * rr * g4.w + b4.w;
          *(float4*)xo = make_float4(ALPHA * x0 + gate.x * (v[0] + bias.x), ALPHA * x1 + gate.y * (v[1] + bias.y), ALPHA * x2 + gate.z * (v[2] + bias.z), ALPHA * x3 + gate.w * (v[3] + bias.w));
        }
    }
}

template <int EPI>
DEV void gemm_phase(const Params& p, int l, const bf16_t* Ag, const bf16_t* Btg, int N, int K, LAS3 unsigned char* lds, int tpm = -1, int tq = 0) {
#define UNIT_OF(i_, pm_, pn_) (tpm >= 0 ? ((pm_) = tpm, (pn_) = tq + 4 * (i_), (pn_) < nN) : unit_of(i_, nM, nN, pm_, pn_))
  using namespace g8;
  int tz = 0; asm volatile("" : "+v"(tz));
  const int tid = threadIdx.x + tz, wid = __builtin_amdgcn_readfirstlane(tid >> 6), lane = tid & 63, wr = wid >> 2, wc = wid & 3, fr = lane & 15, fq = lane >> 4;
  const int nt = K / BK, nM = MT / BM, nN = N / BM;
  unsigned voff[2];
#pragma unroll
  for (int i = 0; i < 2; ++i) { int R, C; stage_rc(tid * 16 + i * 8192, R, C); voff[i] = (unsigned)(R * K + C) * 2u; }
  const size_t kstep = (size_t)(BK * 2);
  const size_t hstep = (size_t)HALF * K * 2;
  const size_t tstep = 2 * hstep;
  const unsigned ldsw = (unsigned)wid * 1024u;
  const int aoff = lds_byte(wr * 64 + fr, fq * 8), boff = lds_byte(wc * 32 + fr, fq * 8);
#define PG8_SA(b, h) (((b) * 2 + (h)) * HTB)
#define PG8_SB(b, h) ((4 + (b) * 2 + (h)) * HTB)
#define PG8_STAGE(bufoff, gbase) do { _Pragma("unroll") for (int _i = 0; _i < 2; ++_i) \
    __builtin_amdgcn_global_load_lds((const unsigned*)((const char*)(gbase) + voff[_i]), (LAS3 unsigned*)(lds + (bufoff) + ldsw + _i * 8192), 16, 0, 0); } while (0)
#define PG8_LDA(dst, b, h) do { _Pragma("unroll") for (int m = 0; m < 4; ++m) _Pragma("unroll") for (int k = 0; k < 2; ++k) dst[m][k] = *(const LAS3 bf16x8*)(lds + PG8_SA(b, h) + aoff + m * 2048 + k * 1024); } while (0)
#define PG8_LDB(dst, b, h) do { _Pragma("unroll") for (int n = 0; n < 2; ++n) _Pragma("unroll") for (int k = 0; k < 2; ++k) dst[n][k] = *(const LAS3 bf16x8*)(lds + PG8_SB(b, h) + boff + n * 2048 + k * 1024); } while (0)
#define PG8_MMA(ai, bj, At_, Bt_) do { __builtin_amdgcn_s_setprio(1); _Pragma("unroll") for (int m = 0; m < 4; ++m) _Pragma("unroll") for (int n = 0; n < 2; ++n) _Pragma("unroll") for (int k = 0; k < 2; ++k) \
    acc[ai][bj][m][n] = __builtin_amdgcn_mfma_f32_16x16x32_bf16(Bt_[n][k], At_[m][k], acc[ai][bj][m][n], 0, 0, 0); __builtin_amdgcn_s_setprio(0); } while (0)
#define PG8_WAIT_V(n) asm volatile("s_waitcnt vmcnt(" #n ")" ::: "memory")
#define PG8_WAIT_L(n) asm volatile("s_waitcnt lgkmcnt(" #n ")" ::: "memory")
#define PG8_BAR __builtin_amdgcn_s_barrier()
#define PG8_SCHED __builtin_amdgcn_sched_barrier(0)
  int cpm, cpn, npm = 0, npn = 0, ui = 0;
  if (!UNIT_OF(0, cpm, cpn)) return;
  f32x4 acc[2][2][4][2];
#pragma unroll
  for (int a = 0; a < 2; ++a)
#pragma unroll
    for (int b = 0; b < 2; ++b)
#pragma unroll
      for (int m = 0; m < 4; ++m)
#pragma unroll
        for (int n = 0; n < 2; ++n) acc[a][b][m][n] = (f32x4){0.f, 0.f, 0.f, 0.f};
  bf16x8 At[4][2], B0[2][2], B1[2][2];
  const char* cA = (const char*)Ag + (size_t)cpm * tstep; const char* cB = (const char*)Btg + (size_t)cpn * tstep;
  PG8_STAGE(PG8_SB(0, 0), cB); PG8_STAGE(PG8_SA(0, 0), cA); PG8_STAGE(PG8_SB(0, 1), cB + hstep); PG8_STAGE(PG8_SA(0, 1), cA + hstep);
  if (wr == 1) PG8_BAR;
  PG8_WAIT_V(4); PG8_BAR;
  PG8_STAGE(PG8_SB(1, 0), cB + kstep); PG8_STAGE(PG8_SA(1, 0), cA + kstep); PG8_STAGE(PG8_SB(1, 1), cB + hstep + kstep);
  PG8_WAIT_V(6); PG8_BAR;
  for (;;) {
    const bool has_next = UNIT_OF(ui + 1, npm, npn);
    const char* nA = has_next ? (const char*)Ag + (size_t)npm * tstep : cA; const char* nB = has_next ? (const char*)Btg + (size_t)npn * tstep : cB;
    for (int t = 0; t < nt; t += 2) {
      const bool last = (t == nt - 2);
      const char* a1 = cA + (size_t)(t + 1) * kstep;
      const char* a2 = last ? nA : cA + (size_t)(t + 2) * kstep; const char* b2 = last ? nB : cB + (size_t)(t + 2) * kstep;
      const char* a3 = a2 + kstep; const char* b3 = b2 + kstep;
      PG8_LDB(B0, 0, 0); PG8_SCHED; PG8_LDA(At, 0, 0); PG8_STAGE(PG8_SA(1, 1), a1 + hstep);
      PG8_WAIT_L(8); PG8_BAR; PG8_WAIT_L(0); PG8_MMA(0, 0, At, B0); PG8_BAR; PG8_SCHED;
      PG8_LDB(B1, 0, 1); PG8_STAGE(PG8_SB(0, 0), b2);
      PG8_BAR; PG8_WAIT_L(0); PG8_MMA(0, 1, At, B1); PG8_BAR;
      PG8_LDA(At, 0, 1); PG8_STAGE(PG8_SA(0, 0), a2);
      PG8_BAR; PG8_WAIT_L(0); PG8_MMA(1, 0, At, B0); PG8_BAR; PG8_SCHED;
      PG8_STAGE(PG8_SB(0, 1), b2 + hstep);
      PG8_WAIT_V(6); PG8_BAR; PG8_MMA(1, 1, At, B1); PG8_BAR;
      PG8_LDB(B0, 1, 0); PG8_SCHED; PG8_LDA(At, 1, 0); PG8_STAGE(PG8_SA(0, 1), a2 + hstep);
      PG8_WAIT_L(8); PG8_BAR; PG8_WAIT_L(0); PG8_MMA(0, 0, At, B0); PG8_BAR; PG8_SCHED;
      PG8_LDB(B1, 1, 1); PG8_STAGE(PG8_SB(1, 0), b3);
      PG8_BAR; PG8_WAIT_L(0); PG8_MMA(0, 1, At, B1); PG8_BAR;
      PG8_LDA(At, 1, 1); PG8_STAGE(PG8_SA(1, 0), a3);
      PG8_BAR; PG8_WAIT_L(0); PG8_MMA(1, 0, At, B0); PG8_BAR; PG8_SCHED;
      PG8_STAGE(PG8_SB(1, 1), b3 + hstep);
      PG8_WAIT_V(6); PG8_BAR; PG8_MMA(1, 1, At, B1); PG8_BAR;
    }
    if (EPI == 4 || (EPI == 2 && l > 0)) gemm_epilogue_lnres<EPI>(p, l, acc, cpm, cpn, wr, wc, fr, fq);
    else gemm_epilogue<EPI>(p, l, acc, cpm, cpn, wr, wc, fr, fq);
    if (!has_next) break;
#pragma unroll
    for (int a = 0; a < 2; ++a)
#pragma unroll
      for (int b = 0; b < 2; ++b)
#pragma unroll
        for (int m = 0; m < 4; ++m)
#pragma unroll
          for (int n = 0; n < 2; ++n) acc[a][b][m][n] = (f32x4){0.f, 0.f, 0.f, 0.f};
    cpm = npm; cpn = npn; cA = nA; cB = nB; ++ui;
  }
  PG8_WAIT_V(0);
  if (wr == 0) PG8_BAR;
  PG8_BAR;
#undef PG8_SA
#undef UNIT_OF
#undef PG8_SB
#undef PG8_STAGE
#undef PG8_LDA
#undef PG8_LDB
#undef PG8_MMA
#undef PG8_WAIT_V
#undef PG8_WAIT_L
#undef PG8_BAR
#undef PG8_SCHED
}

DEV void rope8(float (&v)[8], int d0, int prow, int pcol, const float* __restrict__ rope) {
  const int pp = (d0 < 32) ? prow : pcol;
#pragma unroll
  for (int i = 0; i < 4; ++i) {
    const int f = ((d0 >> 1) + i) & 15;
    const float cs = rope[(pp * 16 + f) * 2], sn = rope[(pp * 16 + f) * 2 + 1];
    const float x1 = v[2 * i], x2 = v[2 * i + 1];
    v[2 * i] = x1 * cs - x2 * sn; v[2 * i + 1] = x1 * sn + x2 * cs;
  }
}

DEV void prep_token_row(const Params& p, int l, int m, int lane, uint4 c) {
  bf16_t* zr = p.zf + (size_t)m * 1792;
  const bool lat = m >= 8192;
  const int pos = lat ? ((m - 8192) & 1023) : (m & 255);
  const int prow = pos >> 6, pcol = pos & 63;
  const int d0 = (lane & 7) * 8;
  U8 u; u.u = c;
  float v[8], gl[8]; float ss = 0.f, sg = 0.f;
#pragma unroll
  for (int j = 0; j < 8; ++j) { v[j] = bf2f(u.h[j]); ss += v[j] * v[j]; gl[j] = gelu_t(v[j]); sg += gl[j]; }
  ss += __shfl_xor(ss, 1); ss += __shfl_xor(ss, 2); ss += __shfl_xor(ss, 4);
#pragma unroll
  for (int o = 1; o <= 16; o <<= 1) sg += __shfl_xor(sg, o);
  const float mean = sg * (1.f / 256.f);
  float s2 = 0.f;
#pragma unroll
  for (int j = 0; j < 8; ++j) { const float d = gl[j] - mean; s2 += d * d; }
#pragma unroll
  for (int o = 1; o <= 16; o <<= 1) s2 += __shfl_xor(s2, o);
  if (lane < 16) {
    const float rinv = rsqrtf(ss * (1.f / 64.f) + 1e-6f);
#pragma unroll
    for (int j = 0; j < 8; ++j) v[j] = v[j] * rinv * p.k_g[l * 64 + d0 + j];
    if (!lat) {
      float* o = p.out + OFF_YK + ((((size_t)(m >> 8)) * 2 + l) * 256 + pos) * 128 + lane * 8;
      *(float4*)o = make_float4(v[0], v[1], v[2], v[3]); *(float4*)(o + 4) = make_float4(v[4], v[5], v[6], v[7]);
    } else rope8(v, d0, prow, pcol, p.rope);
#pragma unroll
    for (int j = 0; j < 4; ++j) u.w[j] = pack2(v[2 * j], v[2 * j + 1]);
    const int kvh = lane >> 3;
    bf16_t* kd = lat ? p.kb_lat + ((size_t)((l * 8 + ((m - 8192) >> 10)) * 2 + kvh) * 1280 + 256 + pos) * 64 + d0
                     : p.kb_ctx + ((size_t)((m >> 8) * 2 + kvh) * 256 + pos) * 64 + d0;
    *(uint4*)kd = u.u;
  } else if (lane < 32) {
    if (!lat) {
      float* o = p.out + OFF_YV + ((((size_t)(m >> 8)) * 2 + l) * 256 + pos) * 128 + (lane - 16) * 8;
      *(float4*)o = make_float4(v[0], v[1], v[2], v[3]); *(float4*)(o + 4) = make_float4(v[4], v[5], v[6], v[7]);
    }
    const int kvh = (lane - 16) >> 3;
    bf16_t* vd; int T;
    if (lat) { T = 1280; vd = p.vt_lat + ((size_t)((l * 8 + ((m - 8192) >> 10)) * 2 + kvh) * 64 + d0) * 1280 + 256 + pos; }
    else { T = 256; vd = p.vt_ctx + ((size_t)((m >> 8) * 2 + kvh) * 64 + d0) * 256 + pos; }
#pragma unroll
    for (int j = 0; j < 8; ++j) vd[(size_t)j * T] = u.h[j];
  } else {
    const float rstd = rsqrtf(s2 * (1.f / 256.f) + 1e-6f);
    const int ch = (lane - 32) * 8;
#pragma unroll
    for (int j = 0; j < 8; ++j) gl[j] = (gl[j] - mean) * rstd * p.mlp_g[l * 256 + ch + j] + p.mlp_b[l * 256 + ch + j];
#pragma unroll
    for (int j = 0; j < 4; ++j) u.w[j] = pack2(gl[2 * j], gl[2 * j + 1]);
    *(uint4*)(zr + 1536 + ch) = u.u;
  }
}

template <bool REV>
DEV void tile_scan(float (&a)[4][4], float (&u)[4][4], int lane) {
  const int q = lane >> 4;
  float C = 0.f, CP = 1.f;
  const int src1 = (REV ? lane + 16 : lane - 16) & 63;
  const int src2 = (REV ? lane + 32 : lane - 32) & 63;
  const int srcT = (lane & 15) + (REV ? 0 : 48);
  const bool c1 = REV ? (q <= 2) : (q >= 1);
  const bool c2 = REV ? (q <= 1) : (q >= 2);
  const bool first = REV ? (q == 3) : (q == 0);
#pragma unroll
  for (int mi = 0; mi < 4; ++mi) {
    const int mt = REV ? 3 - mi : mi;
    float P = 1.f, H = 0.f, pl[4], hl[4];
#pragma unroll
    for (int ri = 0; ri < 4; ++ri) {
      const int r = REV ? 3 - ri : ri;
      H = a[mt][r] * H + u[mt][r]; P *= a[mt][r]; pl[r] = P; hl[r] = H;
    }
    float Pi = P, Hi = H;
    float Pp = __shfl(Pi, src1), Hp = __shfl(Hi, src1);
    if (c1) { Hi = Pi * Hp + Hi; Pi = Pi * Pp; }
    Pp = __shfl(Pi, src2); Hp = __shfl(Hi, src2);
    if (c2) { Hi = Pi * Hp + Hi; Pi = Pi * Pp; }
    float Pe = __shfl(Pi, src1), He = __shfl(Hi, src1);
    if (first) { Pe = 1.f; He = 0.f; }
    const float hin = Pe * C + He, pin = Pe * CP;
#pragma unroll
    for (int r = 0; r < 4; ++r) { u[mt][r] = pl[r] * hin + hl[r]; a[mt][r] = pl[r] * pin; }
    const float Pt = __shfl(Pi, srcT), Ht = __shfl(Hi, srcT);
    C = Pt * C + Ht; CP = Pt * CP;
  }
}

DEV void lru_gate_item(const Params& p, int l, int item, char* smem) {
  const int tid = VTID, lane = tid & 63, w = tid >> 6;
  const int tile = item >> 2, blk = item & 3;
  const int m0 = tile * 64;
  int ms, L;
  if (m0 < 8192) { ms = m0 & ~255; L = 256; } else { ms = 8192 + ((m0 - 8192) & ~1023); L = 1024; }
  const int dir = w >> 1, half = w & 1, q = lane >> 4, c15 = lane & 15;
  const bf16_t* wt = p.wt_lru + (size_t)((((l * 2 + dir) * 4 + blk) * 2)) * 4096;
  bf16x8 bfr[2][2][2];
#pragma unroll
  for (int mat = 0; mat < 2; ++mat)
#pragma unroll
    for (int j = 0; j < 2; ++j)
#pragma unroll
      for (int s = 0; s < 2; ++s) bfr[mat][j][s] = *(const bf16x8*)(wt + mat * 4096 + (half * 32 + j * 16 + c15) * 64 + s * 32 + q * 8);
  float* xs = (float*)smem;
  float* xcf = xs + 67 * 64;
  bf16_t* xcb = (bf16_t*)(xcf + 64 * 64);
  for (int idx = tid; idx < 67 * 8; idx += 256) {
    const int rr = idx >> 3, cc = idx & 7;
    const int m = m0 - 1 + rr;
    float v[8];
    if (m >= ms && m < ms + L) {
      U8 u; u.u = *(const uint4*)(p.zf + (size_t)m * 1792 + 768 + blk * 64 + cc * 8);
#pragma unroll
      for (int j = 0; j < 8; ++j) v[j] = bf2f(u.h[j]);
    } else {
#pragma unroll
      for (int j = 0; j < 8; ++j) v[j] = 0.f;
    }
#pragma unroll
    for (int j = 0; j < 8; ++j) xs[rr * 64 + cc * 8 + j] = v[j];
  }
  __syncthreads();
  {
    const int ch = tid & 63, Cg = blk * 64 + ch;
    const float w0 = p.conv_w[(l * 4 + 0) * 256 + Cg], w1 = p.conv_w[(l * 4 + 1) * 256 + Cg], w2 = p.conv_w[(l * 4 + 2) * 256 + Cg],
                w3 = p.conv_w[(l * 4 + 3) * 256 + Cg], cb = p.conv_b[l * 256 + Cg];
#pragma unroll 4
    for (int tt = 0; tt < 16; ++tt) {
      const int t = (tid >> 6) * 16 + tt;
      const float v = cb + w0 * xs[t * 64 + ch] + w1 * xs[(t + 1) * 64 + ch] + w2 * xs[(t + 2) * 64 + ch] + w3 * xs[(t + 3) * 64 + ch];
      xcf[t * 64 + ch] = v; xcb[t * 72 + ch] = f2bf(v);
    }
  }
  __syncthreads();
  f32x4 acc[2][4][2];
#pragma unroll
  for (int mat = 0; mat < 2; ++mat)
#pragma unroll
    for (int mt = 0; mt < 4; ++mt)
#pragma unroll
      for (int j = 0; j < 2; ++j) acc[mat][mt][j] = f32x4{0.f, 0.f, 0.f, 0.f};
#pragma unroll
  for (int mt = 0; mt < 4; ++mt)
#pragma unroll
    for (int s = 0; s < 2; ++s) {
      const bf16x8 af = *(const bf16x8*)(xcb + (mt * 16 + c15) * 72 + s * 32 + q * 8);
#pragma unroll
      for (int mat = 0; mat < 2; ++mat)
#pragma unroll
        for (int j = 0; j < 2; ++j) acc[mat][mt][j] = mfma16(af, bfr[mat][j][s], acc[mat][mt][j]);
    }
  float* PCp = p.au + (size_t)(dir * 2 + 0) * MT * 256;
  float* HLp = p.au + (size_t)(dir * 2 + 1) * MT * 256;
#pragma unroll
  for (int j = 0; j < 2; ++j) {
    const int ch = half * 32 + j * 16 + c15, Cg = blk * 64 + ch, pidx = (l * 2 + dir) * 256 + Cg;
    const float ba = p.lru_ba[pidx], bx = p.lru_bx[pidx];
    const float cdec = p.cdec[pidx];
    float a[4][4], u[4][4];
#pragma unroll
    for (int mt = 0; mt < 4; ++mt)
#pragma unroll
      for (int r = 0; r < 4; ++r) {
        const int t = mt * 16 + q * 4 + r;
        const float rg = sigmoidf_(acc[0][mt][j][r] + ba), ig = sigmoidf_(acc[1][mt][j][r] + bx);
        const float la = cdec * rg;
        a[mt][r] = __expf(la);
        const float x2 = 2.f * la;
        const float em = (x2 < -0.25f) ? 1.f - __expf(x2) : -x2 * (1.f + x2 * (0.5f + x2 * (1.f / 6.f + x2 * (1.f / 24.f + x2 * (1.f / 120.f + x2 * (1.f / 720.f))))));
        u[mt][r] = __builtin_amdgcn_sqrtf(em) * ig * xcf[t * 64 + ch];
      }
    if (dir == 0) tile_scan<false>(a, u, lane); else tile_scan<true>(a, u, lane);
#pragma unroll
    for (int mt = 0; mt < 4; ++mt)
#pragma unroll
      for (int r = 0; r < 4; ++r) {
        const size_t m = m0 + mt * 16 + q * 4 + r;
        PCp[m * 256 + Cg] = a[mt][r]; HLp[m * 256 + Cg] = u[mt][r];
      }
  }
  __syncthreads();
}

DEV void attn_item(const Params& p, int l, int it, char* sm) {
  const int tid = threadIdx.x, lane = tid & 63, w = tid >> 6, q = lane >> 4, c15 = lane & 15;
  const int qg = w >> 1, kh = w & 1;
  int h, ms, nkt, T; const bf16_t* Kg; const bf16_t* Vg;
  if (it < 512) {
    const int b = it >> 6, qb = it & 7; h = (it >> 3) & 7; ms = 8192 + b * 1024 + qb * 128; nkt = 10; T = 1280;
    Kg = p.kb_lat + (size_t)((l * 8 + b) * 2 + (h >> 2)) * 1280 * 64; Vg = p.vt_lat + (size_t)((l * 8 + b) * 2 + (h >> 2)) * 64 * 1280;
  } else {
    const int i2 = it - 512, b = i2 >> 4, qb = i2 & 1; h = (i2 >> 1) & 7; ms = b * 256 + qb * 128; nkt = 2; T = 256;
    Kg = p.kb_ctx + (size_t)(b * 2 + (h >> 2)) * 256 * 64; Vg = p.vt_ctx + (size_t)(b * 2 + (h >> 2)) * 64 * 256;
  }
  const int kc0 = tid, kc1 = tid + 512;
  const int vd0 = tid >> 4, vk = (tid & 15) * 8;
  const int vpos = ((tid & 15) >> 2) * 32 + 16 * (tid & 1) + 4 * ((tid & 3) >> 1);
  const bf16_t* vg0 = Vg + (size_t)vd0 * T + vk;
  const bf16_t* vg1 = Vg + (size_t)(vd0 + 32) * T + vk;
  uint4 rk0, rk1, rv0, rv1;
#define ATT_LOAD(kt) do { rk0 = *(const uint4*)(Kg + (size_t)(kt) * 8192 + kc0 * 8); rk1 = *(const uint4*)(Kg + (size_t)(kt) * 8192 + kc1 * 8); \
    rv0 = *(const uint4*)(vg0 + (kt) * 128); rv1 = *(const uint4*)(vg1 + (kt) * 128); } while (0)
#define ATT_STORE(buf) do { bf16_t* Ks_ = (bf16_t*)(sm + (buf) * 36864); bf16_t* Vs_ = Ks_ + 9216; \
    *(uint4*)(Ks_ + (kc0 >> 3) * 72 + (kc0 & 7) * 8) = rk0; *(uint4*)(Ks_ + (kc1 >> 3) * 72 + (kc1 & 7) * 8) = rk1; \
    *(uint2*)(Vs_ + vd0 * 136 + vpos) = make_uint2(rv0.x, rv0.y); *(uint2*)(Vs_ + vd0 * 136 + vpos + 8) = make_uint2(rv0.z, rv0.w); \
    *(uint2*)(Vs_ + (vd0 + 32) * 136 + vpos) = make_uint2(rv1.x, rv1.y); *(uint2*)(Vs_ + (vd0 + 32) * 136 + vpos + 8) = make_uint2(rv1.z, rv1.w); } while (0)
  ATT_LOAD(0);
  const int mq = ms + qg * 32;
  bf16x8 qf[2][2];
#pragma unroll
  for (int t = 0; t < 2; ++t)
#pragma unroll
    for (int s = 0; s < 2; ++s) qf[t][s] = *(const bf16x8*)(p.zf + (size_t)(mq + t * 16 + c15) * 1792 + h * 64 + s * 32 + q * 8);
  ATT_STORE(0);
  if (nkt > 1) ATT_LOAD(1);
#pragma unroll
  for (int t = 0; t < 2; ++t) {
    float f[2][8]; float ss = 0.f;
#pragma unroll
    for (int s = 0; s < 2; ++s)
#pragma unroll
      for (int j = 0; j < 8; ++j) { f[s][j] = bf2f((bf16_t)qf[t][s][j]); ss += f[s][j] * f[s][j]; }
    ss += __shfl_xor(ss, 16); ss += __shfl_xor(ss, 32);
    const float rinv = rsqrtf(ss * (1.f / 64.f) + 1e-6f);
    const int mrow_ = mq + t * 16 + c15;
    const int pos = (mrow_ - 8192) & 1023;
#pragma unroll
    for (int s = 0; s < 2; ++s) {
      const int dd = s * 32 + q * 8;
#pragma unroll
      for (int j = 0; j < 8; ++j) f[s][j] = f[s][j] * rinv * p.q_g[l * 64 + dd + j];
      if (it < 512) rope8(f[s], dd, pos >> 6, pos & 63, p.rope);
      U8 pk;
#pragma unroll
      for (int j = 0; j < 4; ++j) pk.w[j] = pack2(f[s][2 * j] * QSCALE, f[s][2 * j + 1] * QSCALE);
      qf[t][s] = pk.v;
    }
  }
  __syncthreads();
  f32x4 o[2][4];
  float mrow[2], lrow[2];
#pragma unroll
  for (int t = 0; t < 2; ++t) { mrow[t] = -1e30f; lrow[t] = 0.f;
#pragma unroll
    for (int j = 0; j < 4; ++j) o[t][j] = f32x4{0.f, 0.f, 0.f, 0.f}; }
  for (int kt = 0; kt < nkt; ++kt) {
    const int cur = kt & 1;
    const bf16_t* Ks = (const bf16_t*)(sm + cur * 36864) + kh * 64 * 72;
    const bf16_t* Vs = (const bf16_t*)(sm + cur * 36864) + 9216 + kh * 64;
    f32x4 s4[2][4];
    {
      bf16x8 kf[4][2];
#pragma unroll
      for (int jn = 0; jn < 4; ++jn)
#pragma unroll
        for (int s = 0; s < 2; ++s) kf[jn][s] = *(const bf16x8*)(Ks + (jn * 16 + c15) * 72 + s * 32 + q * 8);
      __builtin_amdgcn_sched_barrier(0);
#pragma unroll
      for (int jn = 0; jn < 4; ++jn)
#pragma unroll
        for (int t = 0; t < 2; ++t) s4[t][jn] = mfma16(kf[jn][0], qf[t][0], f32x4{0.f, 0.f, 0.f, 0.f});
#pragma unroll
      for (int jn = 0; jn < 4; ++jn)
#pragma unroll
        for (int t = 0; t < 2; ++t) s4[t][jn] = mfma16(kf[jn][1], qf[t][1], s4[t][jn]);
      __builtin_amdgcn_sched_barrier(0);
    }
    U8 vf[4][2];
#pragma unroll
    for (int jn = 0; jn < 4; ++jn)
#pragma unroll
      for (int ks = 0; ks < 2; ++ks) vf[jn][ks].u = *(const uint4*)(Vs + (jn * 16 + c15) * 136 + ks * 32 + q * 8);
    __builtin_amdgcn_sched_barrier(0);
    U8 pb[2][2];
#pragma unroll
    for (int t = 0; t < 2; ++t) {
      float mx = s4[t][0][0];
#pragma unroll
      for (int jn = 0; jn < 4; ++jn)
#pragma unroll
        for (int r = 0; r < 4; ++r) mx = fmaxf(mx, s4[t][jn][r]);
      mx = fmaxf(mx, __shfl_xor(mx, 16)); mx = fmaxf(mx, __shfl_xor(mx, 32));
      const float mnew = fmaxf(mrow[t], mx);
      const float alpha = __builtin_amdgcn_exp2f(mrow[t] - mnew);
      mrow[t] = mnew;
      float ls = 0.f;
#pragma unroll
      for (int jn = 0; jn < 4; ++jn)
#pragma unroll
        for (int r = 0; r < 4; ++r) { const float pv = __builtin_amdgcn_exp2f(s4[t][jn][r] - mnew); s4[t][jn][r] = pv; ls += pv; }
      lrow[t] = lrow[t] * alpha + ls;
#pragma unroll
      for (int jn = 0; jn < 4; ++jn) { o[t][jn][0] *= alpha; o[t][jn][1] *= alpha; o[t][jn][2] *= alpha; o[t][jn][3] *= alpha; }
#pragma unroll
      for (int ks = 0; ks < 2; ++ks) {
        pb[t][ks].w[0] = pack2(s4[t][2 * ks][0], s4[t][2 * ks][1]); pb[t][ks].w[1] = pack2(s4[t][2 * ks][2], s4[t][2 * ks][3]);
        pb[t][ks].w[2] = pack2(s4[t][2 * ks + 1][0], s4[t][2 * ks + 1][1]); pb[t][ks].w[3] = pack2(s4[t][2 * ks + 1][2], s4[t][2 * ks + 1][3]);
      }
    }
#pragma unroll
    for (int ks = 0; ks < 2; ++ks)
#pragma unroll
      for (int jn = 0; jn < 4; ++jn)
#pragma unroll
        for (int t = 0; t < 2; ++t) o[t][jn] = mfma16(vf[jn][ks].v, pb[t][ks].v, o[t][jn]);
    if (kt + 1 < nkt) {
      ATT_STORE(cur ^ 1);
      if (kt + 2 < nkt) ATT_LOAD(kt + 2);
    }
    __syncthreads();
  }
#undef ATT_LOAD
#undef ATT_STORE
  float* mrg = (float*)(sm + 73728) + (size_t)(qg * 64 + lane) * 37;
  float lt[2];
#pragma unroll
  for (int t = 0; t < 2; ++t) { float a = lrow[t]; a += __shfl_xor(a, 16); a += __shfl_xor(a, 32); lt[t] = a; }
  if (kh == 1) {
#pragma unroll
    for (int t = 0; t < 2; ++t) {
      mrg[t * 18 + 0] = mrow[t]; mrg[t * 18 + 1] = lt[t];
#pragma unroll
      for (int jn = 0; jn < 4; ++jn)
#pragma unroll
        for (int r = 0; r < 4; ++r) mrg[t * 18 + 2 + jn * 4 + r] = o[t][jn][r];
    }
  }
  __syncthreads();
  if (kh == 0) {
#pragma unroll
    for (int t = 0; t < 2; ++t) {
      const float m1 = mrg[t * 18 + 0], l1 = mrg[t * 18 + 1];
      const float mm = fmaxf(mrow[t], m1);
      const float a0 = __builtin_amdgcn_exp2f(mrow[t] - mm), a1 = __builtin_amdgcn_exp2f(m1 - mm);
      const float inv = 1.f / (a0 * lt[t] + a1 * l1);
      const float c0 = a0 * inv, c1 = a1 * inv;
      bf16_t* orow = p.abuf + (size_t)(mq + t * 16 + c15) * 1024 + h * 64 + q * 4;
#pragma unroll
      for (int jn = 0; jn < 4; ++jn) {
        const float x0 = c0 * o[t][jn][0] + c1 * mrg[t * 18 + 2 + jn * 4 + 0], x1 = c0 * o[t][jn][1] + c1 * mrg[t * 18 + 2 + jn * 4 + 1];
        const float x2 = c0 * o[t][jn][2] + c1 * mrg[t * 18 + 2 + jn * 4 + 2], x3 = c0 * o[t][jn][3] + c1 * mrg[t * 18 + 2 + jn * 4 + 3];
        uint2 ov; ov.x = pack2(x0, x1); ov.y = pack2(x2, x3);
        *(uint2*)(orow + jn * 16) = ov;
      }
    }
  }
  __syncthreads();
}

DEV void gmlp_item(const Params& p, int l, int it, char* smem) {
  const int tid = VTID, lane = tid & 63, w = tid >> 6, q = lane >> 4, c15 = lane & 15;
  const int chunk = it >> 2, g = it & 3, m0 = chunk * 128;
  bf16_t* vt = (bf16_t*)smem;
  const float* wsg = p.mlp_ws + (size_t)(l * 4 + g) * 16384;
  float4 wa[2][4][2];
#pragma unroll
  for (int nt = 0; nt < 2; ++nt)
#pragma unroll
    for (int s = 0; s < 4; ++s) {
      const float* ap = wsg + ((2 * w + nt) * 16 + c15) * 128 + s * 32 + q * 8;
      wa[nt][s][0] = *(const float4*)ap; wa[nt][s][1] = *(const float4*)(ap + 4);
    }
  uint4 vin[4];
#pragma unroll
  for (int i = 0; i < 4; ++i) { const int id = tid + 256 * i; vin[i] = *(const uint4*)(p.zf + (size_t)(m0 + (id >> 3)) * 1792 + 1536 + g * 64 + (id & 7) * 8); }
#pragma unroll
  for (int i = 0; i < 4; ++i) {
    const int id = tid + 256 * i, qq = id >> 3, cc = id & 7;
    U8 v; v.u = vin[i];
#pragma unroll
    for (int j = 0; j < 8; ++j) vt[(cc * 8 + j) * 136 + qq] = v.h[j];
  }
  __syncthreads();
  f32x4 acc[4][2];
#pragma unroll
  for (int mt = 0; mt < 4; ++mt)
#pragma unroll
    for (int nt = 0; nt < 2; ++nt) acc[mt][nt] = f32x4{0.f, 0.f, 0.f, 0.f};
#pragma unroll
  for (int s = 0; s < 4; ++s) {
    bf16x8 af[4];
#pragma unroll
    for (int mt = 0; mt < 4; ++mt) af[mt] = *(const bf16x8*)(vt + (mt * 16 + c15) * 136 + s * 32 + q * 8);
#pragma unroll
    for (int nt = 0; nt < 2; ++nt) {
      U8 bb;
      bb.w[0] = pack2(wa[nt][s][0].x, wa[nt][s][0].y); bb.w[1] = pack2(wa[nt][s][0].z, wa[nt][s][0].w);
      bb.w[2] = pack2(wa[nt][s][1].x, wa[nt][s][1].y); bb.w[3] = pack2(wa[nt][s][1].z, wa[nt][s][1].w);
#pragma unroll
      for (int mt = 0; mt < 4; ++mt) acc[mt][nt] = mfma16(af[mt], bb.v, acc[mt][nt]);
    }
  }
#pragma unroll
  for (int nt = 0; nt < 2; ++nt) {
    const int pp = (2 * w + nt) * 16 + c15;
    const size_t m = m0 + pp;
    const float bsv = p.mlp_bs[(l * 4 + g) * 128 + pp];
#pragma unroll
    for (int mt = 0; mt < 4; ++mt) {
      const int c = mt * 16 + q * 4;
      const uint2 uu = *(const uint2*)(p.zf + m * 1792 + 1280 + g * 64 + c);
      const float u0 = gelu_t(__uint_as_float(uu.x << 16)), u1 = gelu_t(__uint_as_float(uu.x & 0xffff0000u)), u2 = gelu_t(__uint_as_float(uu.y << 16)), u3 = gelu_t(__uint_as_float(uu.y & 0xffff0000u));
      uint2 o; o.x = pack2(u0 * (acc[mt][nt][0] + bsv), u1 * (acc[mt][nt][1] + bsv)); o.y = pack2(u2 * (acc[mt][nt][2] + bsv), u3 * (acc[mt][nt][3] + bsv));
      *(uint2*)(p.abuf + m * 1024 + 768 + g * 64 + c) = o;
    }
  }
  __syncthreads();
}

DEV void lru_apply_item(const Params& p, int l, int ti2) {
  const int C = VTID;
  const int ti = ti2 >> 1, th = (ti2 & 1) * 32;
  const int m0 = ti * 64;
  int ms, L, b; bool lat = m0 >= 8192;
  if (!lat) { ms = m0 & ~255; L = 256; b = m0 >> 8; } else { ms = 8192 + ((m0 - 8192) & ~1023); L = 1024; b = (m0 - 8192) >> 10; }
  const int k = (m0 - ms) >> 6, nt = L >> 6;
  const float* PCf = p.au; const float* HLf = p.au + (size_t)MT * 256;
  const float* PCb = p.au + (size_t)2 * MT * 256; const float* HLb = p.au + (size_t)3 * MT * 256;
  float cf = lat ? p.state_lru[((size_t)(b * 2 + l) * 2 + 0) * 256 + C] : 0.f;
  float cb = lat ? p.state_lru[((size_t)(b * 2 + l) * 2 + 1) * 256 + C] : 0.f;
  {
    float pc[15], hl[15];
#pragma unroll
    for (int i = 0; i < 15; ++i) {
      const bool act = i < k;
      const size_t e = (size_t)(ms + 64 * i + 63) * 256 + C;
      pc[i] = act ? PCf[e] : 1.f; hl[i] = act ? HLf[e] : 0.f;
    }
#pragma unroll
    for (int i = 0; i < 15; ++i) cf = pc[i] * cf + hl[i];
  }
  {
    float pc[15], hl[15];
#pragma unroll
    for (int i = 0; i < 15; ++i) {
      const int tix = nt - 1 - i;
      const bool act = tix > k;
      const size_t e = (size_t)(ms + 64 * tix) * 256 + C;
      pc[i] = act ? PCb[e] : 1.f; hl[i] = act ? HLb[e] : 0.f;
    }
#pragma unroll
    for (int i = 0; i < 15; ++i) cb = pc[i] * cb + hl[i];
  }
  float hf_last = 0.f, hb_first = 0.f;
#pragma unroll 16
  for (int t = th; t < th + 32; ++t) {
    const size_t m = m0 + t;
    const float hf = PCf[m * 256 + C] * cf + HLf[m * 256 + C];
    const float hb = PCb[m * 256 + C] * cb + HLb[m * 256 + C];
    const float g = gelu_t(bf2f(p.zf[m * 1792 + 1024 + C]));
    p.abuf[m * 1024 + 512 + C] = f2bf((hf + hb) * g);
    if (t == 0) hb_first = hb;
    if (t == 63) hf_last = hf;
  }
  if (!lat) {
    if (k == nt - 1 && th == 32) p.out[OFF_ST + ((size_t)(b * 2 + l) * 2 + 0) * 256 + C] = hf_last;
    if (k == 0 && th == 0) p.out[OFF_ST + ((size_t)(b * 2 + l) * 2 + 1) * 256 + C] = hb_first;
  }
}

DEV void mixer_phase(const Params& p, int l, char* smem_raw, char* smem) {
  {
    const int x = blockIdx.x & 7, j = blockIdx.x >> 3;
#pragma unroll 1
    for (int k = 0; k < 4; ++k) attn_item(p, l, ((k >> 1) << 9) + 64 * x + j + 32 * (k & 1), smem_raw);
  }
  {
    const int x = blockIdx.x & 7, lh = (blockIdx.x >> 3) * 2 + (threadIdx.x >> 8);
    lru_apply_item(p, l, (own_row(x, (lh >> 1) * 64) >> 6) * 2 + (lh & 1));
    gmlp_item(p, l, (own_row(x, (lh >> 2) * 128) >> 7) * 4 + (lh & 3), smem);
  }
}

DEV void prep_phase_full(const Params& p, int l, char* smem) {
  {
    const int xcd = blockIdx.x & 7, lh = (blockIdx.x >> 3) * 2 + (threadIdx.x >> 8);
#pragma unroll 1
    for (int k = 0; k < 2; ++k) { const int li = lh + 64 * k; lru_gate_item(p, l, (own_row(xcd, (li >> 2) * 64) >> 6) * 4 + (li & 3), smem); }
  }
  const int lane = threadIdx.x & 63, mstride = gridDim.x * 8;
  int vm = blockIdx.x * 8 + (threadIdx.x >> 6);
  const int coff = lane < 32 ? 512 + lane * 8 : 1536 + (lane - 32) * 8;
  uint4 n1 = *(const uint4*)(p.zf + (size_t)xrow(vm) * 1792 + coff);
  uint4 n2 = *(const uint4*)(p.zf + (size_t)xrow((vm + mstride < MT) ? vm + mstride : vm) * 1792 + coff);
  for (; vm < MT; vm += mstride) {
    const uint4 c = n1; n1 = n2;
    const int mn = xrow((vm + 2 * mstride < MT) ? vm + 2 * mstride : vm);
    n2 = *(const uint4*)(p.zf + (size_t)mn * 1792 + coff);
    prep_token_row(p, l, xrow(vm), lane, c);
  }
}


#define XB_TMO      128
#define XB_XCNT(j)  (256  + 64 * (j))
#define XB_XSUB(j)  (1280 + 64 * (j))
#define XB_XGEN(j)  (2304 + 64 * (j))
#define XB_TOP      3328
#define XB_TOPGEN   3392
#define XCD_BAR_WORDS 3456
#define XB_SPIN_CAP (1u << 18)
#define LAS __attribute__((address_space(3)))
DEV unsigned xb_ld(unsigned* p) { return __hip_atomic_load(p, __ATOMIC_RELAXED, __HIP_MEMORY_SCOPE_AGENT); }
DEV unsigned xb_add(unsigned* p, unsigned v) { return __hip_atomic_fetch_add(p, v, __ATOMIC_RELAXED, __HIP_MEMORY_SCOPE_AGENT); }
DEV unsigned xb_xcc_id() { return (unsigned)__builtin_amdgcn_s_getreg((3 << 11) | 20) & 0xFu; }
#define XB_SPIN(cond, bar) do { unsigned _sp = 0; while (cond) { __builtin_amdgcn_s_sleep(1); \
    if ((++_sp & 255u) == 0u) { if (xb_ld(&(bar)[XB_TMO])) break; if (_sp > XB_SPIN_CAP) { atomicAdd(&(bar)[XB_TMO], 1u); break; } } } } while (0)
struct XcdBarrier { unsigned* bar; unsigned x; volatile LAS unsigned* st; };
DEV XcdBarrier xcd_barrier_post(unsigned* bar, volatile LAS unsigned* st) {
  XcdBarrier b; b.bar = bar; b.x = xb_xcc_id(); b.st = st;
  if (threadIdx.x == 0) (void)xb_add(&bar[XB_XCNT(b.x)], 1u);
  return b;
}
DEV void xcd_barrier_complete(unsigned* bar, unsigned x, unsigned& nloc, unsigned& nx) {
  const unsigned G = gridDim.x * gridDim.y * gridDim.z;
  unsigned sum, cnt, mine, sp = 0u;
  for (;;) {
    sum = 0u; cnt = 0u; mine = 0u;
#pragma unroll
    for (unsigned j = 0; j < 16; ++j) { const unsigned c = xb_ld(&bar[XB_XCNT(j)]); sum += c; cnt += (c > 0u) ? 1u : 0u; mine = (j == x) ? c : mine; }
    if (sum == G) break;
    __builtin_amdgcn_s_sleep(1);
    if ((++sp & 255u) == 0u) { if (xb_ld(&bar[XB_TMO])) break; if (sp > XB_SPIN_CAP) { atomicAdd(&bar[XB_TMO], 1u); break; } }
  }
  nloc = mine > 0u ? mine : 1u; nx = cnt > 0u ? cnt : 1u;
}
DEV void xcd_barrier(const XcdBarrier& b) {
  asm volatile("s_waitcnt vmcnt(0)" ::: "memory");
  __syncthreads();
  if (threadIdx.x == 0) {
    unsigned* bar = b.bar;
    __builtin_amdgcn_s_waitcnt(0);
    unsigned nloc = b.st[0], nx = b.st[1];
    if (nloc == 0u) { xcd_barrier_complete(bar, b.x, nloc, nx); b.st[0] = nloc; b.st[1] = nx; }
    const unsigned old = xb_add(&bar[XB_XSUB(b.x)], 1u);
    const unsigned gen = old / nloc;
    if (old + 1u == (gen + 1u) * nloc) {
      __builtin_amdgcn_fence(__ATOMIC_RELEASE, "agent");
      asm volatile("s_waitcnt vmcnt(0)" ::: "memory");
      const unsigned og = xb_add(&bar[XB_TOP], 1u);
      const unsigned tg = og / nx;
      if (og + 1u == (tg + 1u) * nx) xb_add(&bar[XB_TOPGEN], 1u);
      else XB_SPIN(xb_ld(&bar[XB_TOPGEN]) == tg, bar);
      __builtin_amdgcn_fence(__ATOMIC_ACQUIRE, "agent");
      xb_add(&bar[XB_XGEN(b.x)], 1u);
      asm volatile("s_waitcnt vmcnt(0)" ::: "memory");
    } else {
      XB_SPIN(xb_ld(&bar[XB_XGEN(b.x)]) == gen, bar);
      __builtin_amdgcn_fence(__ATOMIC_ACQUIRE, "agent");
      asm volatile("s_waitcnt vmcnt(0)" ::: "memory");
    }
  }
  __syncthreads();
}

#define XB_MISMATCH 160
#define XB_WREADY 192
DEV void xcd_barrier_local(const XcdBarrier& b) {
  asm volatile("s_waitcnt vmcnt(0)" ::: "memory");
  __syncthreads();
  if (threadIdx.x == 0) {
    unsigned* bar = b.bar;
    __builtin_amdgcn_s_waitcnt(0);
    const unsigned nloc = b.st[0];
    const unsigned old = xb_add(&bar[XB_XSUB(b.x)], 1u);
    const unsigned gen = old / nloc;
    if (old + 1u == (gen + 1u) * nloc) xb_add(&bar[XB_XGEN(b.x)], 1u);
    else XB_SPIN(xb_ld(&bar[XB_XGEN(b.x)]) == gen, bar);
    __builtin_amdgcn_fence(__ATOMIC_ACQUIRE, "agent");
    asm volatile("s_waitcnt vmcnt(0)" ::: "memory");
  }
  __syncthreads();
}

#define XB_TEAM(pm) (3520 + 8 * (pm))
DEV void team_barrier(unsigned* bar, int pm, unsigned target) {
  asm volatile("s_waitcnt vmcnt(0)" ::: "memory");
  __syncthreads();
  if (threadIdx.x == 0) {
    __builtin_amdgcn_s_waitcnt(0);
    xb_add(&bar[XB_TEAM(pm)], 1u);
    XB_SPIN(xb_ld(&bar[XB_TEAM(pm)]) < target, bar);
    __builtin_amdgcn_fence(__ATOMIC_ACQUIRE, "agent");
    asm volatile("s_waitcnt vmcnt(0)" ::: "memory");
  }
  __syncthreads();
}
DEV void team_chain(const Params& p, int l, LAS3 unsigned char* lds) {
  int pm, pn;
  if (!g8::unit_of(0, MT / 256, 4, pm, pn)) return;
  const unsigned r = 5u * (unsigned)l;
  const int base = pm * 256 + pn * 64;
  team_barrier(p.bar, pm, 4u * (r + 1u)); ln_mod_phase(p, l, 2, base);
  team_barrier(p.bar, pm, 4u * (r + 2u)); gemm_phase<3>(p, l, p.abuf, p.wt_ff1 + (size_t)l * 4096 * 1024, 4096, 1024, lds, pm, pn);
  team_barrier(p.bar, pm, 4u * (r + 3u)); gemm_phase<4>(p, l, p.zf, p.wt_ff2 + (size_t)l * 1024 * 4096, 1024, 4096, lds, pm, pn);
  team_barrier(p.bar, pm, 4u * (r + 4u)); ln_mod_phase(p, 1, l == 0 ? 1 : 3, base);
  if (l == 0) { team_barrier(p.bar, pm, 4u * (r + 5u)); gemm_phase<1>(p, 1, p.abuf, p.wt_in + (size_t)1792 * 1024, 1792, 1024, lds, pm, pn); }
}

#define PH(i, call) if (ph_lo <= (i) && (i) < ph_hi) { if ((i) > ph_lo) { if ((i) >= 2 && xcd_local) xcd_barrier_local(xb); else xcd_barrier(xb); } call; }
#define LAYER_REST(l, b) \
  if (!(xcd_local && l == 1)) { PH(b + 1, gemm_phase<1>(p, l, p.abuf, p.wt_in + (size_t)l * 1792 * 1024, 1792, 1024, (LAS3 unsigned char*)smem_raw)) } \
  PH(b + 2, prep_phase_full(p, l, smem)) \
  PH(b + 3, mixer_phase(p, l, smem_raw, smem)) \
  PH(b + 4, if (l == 0 && xcd_local) { if (threadIdx.x == 0) { XB_SPIN(xb_ld(&p.bar[XB_WREADY]) < 128u, p.bar); __builtin_amdgcn_fence(__ATOMIC_ACQUIRE, "agent"); asm volatile("s_waitcnt vmcnt(0)" ::: "memory"); } __syncthreads(); } \
            gemm_phase<2>(p, l, p.abuf, p.wt_out + (size_t)l * 1024 * 1024, 1024, 1024, (LAS3 unsigned char*)smem_raw); \
            if (xcd_local) team_chain(p, l, (LAS3 unsigned char*)smem_raw)) \
  if (!xcd_local) { \
    PH(b + 5, ln_mod_phase(p, l, 2)) \
    PH(b + 6, gemm_phase<3>(p, l, p.abuf, p.wt_ff1 + (size_t)l * 4096 * 1024, 4096, 1024, (LAS3 unsigned char*)smem_raw)) \
    PH(b + 7, gemm_phase<4>(p, l, p.zf, p.wt_ff2 + (size_t)l * 1024 * 4096, 1024, 4096, (LAS3 unsigned char*)smem_raw)) }

__global__ void __launch_bounds__(512, 2) mega_kernel(Params p, int ph_lo, int ph_hi) {
  extern __shared__ __attribute__((aligned(16))) char smem_raw[];
  char* smem = smem_raw + (threadIdx.x >> 8) * 65536;
  __shared__ uint4 xb_words;
  if (threadIdx.x == 0) xb_words = make_uint4(0u, 0u, 0u, 0u);
  __syncthreads();
  XcdBarrier xb = xcd_barrier_post(p.bar, (volatile LAS unsigned*)&xb_words);
  if (threadIdx.x == 0) atomicOr(&p.bar[XB_MISMATCH + (blockIdx.x & 7u)], 1u << xb.x);
  if (ph_hi > 1000) { cg::grid_group grid = cg::this_grid(); grid.sync(); }
  bool xcd_local = false;
  PH(0, phase0(p, smem))
  PH(1, { unsigned all = 0u; bool one = true;
          for (int c = 0; c < 8; ++c) { const unsigned m = xb_ld(&p.bar[XB_MISMATCH + c]); one = one && (__builtin_popcount(m) == 1); all |= m; }
          xcd_local = one && all == 0xFFu && gridDim.x == 256; }
        if (xcd_local) {
          if (blockIdx.x & 1u) {
            transpose_all(p, smem, 1, ((int)((blockIdx.x >> 1) & 3u) + 4 * (int)(blockIdx.x >> 3)) * 2 + (int)(threadIdx.x >> 8), 256);
            asm volatile("s_waitcnt vmcnt(0)" ::: "memory");
            __syncthreads();
            if (threadIdx.x == 0) { __builtin_amdgcn_fence(__ATOMIC_RELEASE, "agent"); asm volatile("s_waitcnt vmcnt(0)" ::: "memory"); xb_add(&p.bar[XB_WREADY], 1u); }
          }
        } else { transpose_all(p, smem, 1, VBID, VNB); xcd_barrier(xb); }
        ln_mod_phase(p, 0, 0))
#undef LAYER0_P1
  LAYER_REST(0, 1)
  if (!xcd_local) { PH(9, ln_mod_phase(p, 1, 1)) }
  LAYER_REST(1, 9)
  if (!xcd_local) { PH(17, ln_mod_phase(p, 1, 3)) }
}

extern "C" void kernel_launch(void* const* d_in, const int* in_sizes, int n_in, void* d_out, int out_size, void* d_ws, size_t ws_size,
                              hipStream_t stream) {
  static int grid_blocks = 0;
  if (!grid_blocks) {
    int dev = 0, cus = 0, per_cu = 0;
    hipGetDevice(&dev);
    hipDeviceGetAttribute(&cus, hipDeviceAttributeMultiprocessorCount, dev);
    hipFuncSetAttribute((const void*)mega_kernel, hipFuncAttributeMaxDynamicSharedMemorySize, SMEM_BYTES);
    hipOccupancyMaxActiveBlocksPerMultiprocessor(&per_cu, (const void*)mega_kernel, 512, SMEM_BYTES);
    if (per_cu < 1) per_cu = 1;
    if (per_cu > 1) per_cu = 1;
    grid_blocks = cus * per_cu;
  }
  Params p{};
  const float** pin = (const float**)&p;
  for (int i = 0; i < 32; ++i) pin[i] = (const float*)d_in[i];
  p.out = (float*)d_out;
  char* ws = (char*)d_ws;
  size_t off = 0;
  p.bar = (unsigned*)(ws + off); off += 16384;
  p.rstat = (float*)(ws + off); off += (size_t)MT * 2 * 4;
  p.kb_lat = (bf16_t*)(ws + off); off += (size_t)2 * 8 * 2 * 1280 * 64 * 2;
  p.vt_lat = (bf16_t*)(ws + off); off += (size_t)2 * 8 * 2 * 1280 * 64 * 2;
  p.kb_ctx = (bf16_t*)(ws + off); off += (size_t)32 * 2 * 256 * 64 * 2;
  p.vt_ctx = (bf16_t*)(ws + off); off += (size_t)32 * 2 * 256 * 64 * 2;
  p.wt_in = (bf16_t*)(ws + off); off += (size_t)2 * 1792 * 1024 * 2;
  p.wt_out = (bf16_t*)(ws + off); off += (size_t)2 * 1024 * 1024 * 2;
  p.wt_ff1 = (bf16_t*)(ws + off); off += (size_t)2 * 4096 * 1024 * 2;
  p.wt_ff2 = (bf16_t*)(ws + off); off += (size_t)2 * 4096 * 1024 * 2;
  p.wt_lru = (bf16_t*)(ws + off); off += (size_t)64 * 4096 * 2;
  p.mod = (float*)(ws + off); off += (size_t)2 * 9 * 6144 * 4;
  p.rope = (float*)(ws + off); off += (size_t)2048 * 4;
  p.cdec = (float*)(ws + off); off += (size_t)1024 * 4;
  p.abuf = (bf16_t*)(ws + off); off += (size_t)MT * 1024 * 2;
  p.zf = (bf16_t*)(ws + off);
  p.au = (float*)(ws + off + (size_t)MT * 1792 * 2);
  off += (size_t)MT * 4096 * 2;
  if (off > ws_size) { fprintf(stderr, "workspace too small: need %zu have %zu\n", off, ws_size); return; }
  (void)hipMemsetAsync(p.bar, 0, 16384, stream);
#if MULTI_LAUNCH
  for (int ph = 0; ph < NPHASE; ++ph) {
    hipLaunchKernelGGL(mega_kernel, dim3(grid_blocks), dim3(512), SMEM_BYTES, stream, p, ph, ph + 1);
  }
#else
  int lo = 0, hi = NPHASE;
  void* args[] = {&p, &lo, &hi};
  hipError_t e = hipLaunchCooperativeKernel((void*)mega_kernel, dim3(grid_blocks), dim3(512), args, SMEM_BYTES, stream);
  if (e != hipSuccess) fprintf(stderr, "cooperative launch failed: %s (grid %d)\n", hipGetErrorString(e), grid_blocks);
#endif
}
```
